# Optimizing an MI355X kernel written in HIP

```python
import math
import numpy as np
import jax, jax.numpy as jnp
from jax import lax

D_MODEL = 1024
BATCH = 8
SEQ = 4096
DEPTH = 1

HEAD_DIM = 64
ROT_DIM = HEAD_DIM // 4
ROPE_THETA = 500000.0
NORM_EPS = 1e-6
NEG_INF = -1e30
BIG = 1e30

A_HEADS = 8
A_BLOCK = 256
A_TOPK = 3
A_QBLOCK = 64

B_HEADS = 8
B_KV_HEADS = 2
B_GROUP = B_HEADS // B_KV_HEADS
CMP_LEN = 32
CMP_STRIDE = 16
CMP_HIDDEN = 256
SLC_BLOCK = 64
SLC_TOPN = 16
WINDOW = 512
B_QBLOCK = 64

PEER_HEADS = 8
PEER_NKEYS = 128
PEER_N = PEER_NKEYS * PEER_NKEYS
PEER_QDIM = 256
PEER_HALF = PEER_QDIM // 2
PEER_TOPK = 16
PEER_CHUNK = 128

A_WIDTH = A_HEADS * HEAD_DIM
B_WIDTH = B_HEADS * HEAD_DIM
B_KV_WIDTH = B_KV_HEADS * HEAD_DIM
N_BRANCH = 2
IN_COLS = 3 * A_WIDTH + B_WIDTH + 6 * B_KV_WIDTH + 3 * B_HEADS + N_BRANCH * D_MODEL

kernel_name = "hybrid_moba_nsa_peer_block"


def rmsnorm(x, g):
    xf = x.astype(jnp.float32)
    y = xf * lax.rsqrt(jnp.mean(xf * xf, axis=-1, keepdims=True) + NORM_EPS)
    return (y * g.astype(jnp.float32)).astype(x.dtype)


def rope_tables(S):
    inv = ROPE_THETA ** (-jnp.arange(0, ROT_DIM, 2, dtype=jnp.float32) / ROT_DIM)
    ang = jnp.arange(S, dtype=jnp.float32)[:, None] * inv[None, :]
    return jnp.cos(ang), jnp.sin(ang)


def partial_rope(x, cos, sin):
    c = cos[None, :, None, :].astype(x.dtype)
    s = sin[None, :, None, :].astype(x.dtype)
    x1 = x[..., :ROT_DIM // 2]
    x2 = x[..., ROT_DIM // 2:ROT_DIM]
    return jnp.concatenate([x1 * c - x2 * s, x2 * c + x1 * s, x[..., ROT_DIM:]], axis=-1)


def masked_softmax(s, mask):
    p = jax.nn.softmax(jnp.where(mask, s.astype(jnp.float32), NEG_INF), axis=-1)
    return p * jnp.any(mask, axis=-1, keepdims=True)


def split_columns(t):
    sizes = (A_WIDTH, A_WIDTH, A_WIDTH, B_WIDTH, B_KV_WIDTH, B_KV_WIDTH, B_KV_WIDTH,
             B_KV_WIDTH, B_KV_WIDTH, B_KV_WIDTH, 3 * B_HEADS, N_BRANCH * D_MODEL)
    points, acc = [], 0
    for s in sizes[:-1]:
        acc += s
        points.append(acc)
    return jnp.split(t, points, axis=-1)


def moba_attention(q, k, v):
    B, S, H, D = q.shape
    n_blk = -(-S // A_BLOCK)
    pad = n_blk * A_BLOCK - S
    topk = min(A_TOPK, n_blk)
    nc = S // A_QBLOCK
    Q = A_QBLOCK
    L = A_BLOCK
    scale = HEAD_DIM ** -0.5

    def to_blocks(t):
        t = jnp.pad(t, ((0, 0), (0, pad), (0, 0), (0, 0)))
        return t.reshape(B, n_blk, L, H, D).transpose(0, 3, 1, 2, 4)

    kb, vb = to_blocks(k), to_blocks(v)
    qh = q.transpose(0, 2, 1, 3)
    k_mean = jnp.mean(kb.astype(jnp.float32), axis=3)
    gate = jnp.einsum('bhsd,bhnd->bhsn', qh.astype(jnp.float32), k_mean)
    own = jnp.arange(S) // A_BLOCK
    past = jnp.arange(n_blk)[None, :] < own[:, None]
    gate = jnp.where(past, gate, NEG_INF)
    top_v, sel = lax.top_k(gate, topk)
    valid = top_v > 0.5 * NEG_INF

    def per_batch(args):
        q_b, kb_b, vb_b, sel_b, valid_b = args

        def per_chunk(c):
            start = c * Q
            pos = start + jnp.arange(Q)
            qc = lax.dynamic_slice_in_dim(q_b, start, Q, axis=1)
            sc = lax.dynamic_slice_in_dim(sel_b, start, Q, axis=1)
            vc = lax.dynamic_slice_in_dim(valid_b, start, Q, axis=1)
            kg = jax.vmap(lambda kbh, ih: kbh[ih])(kb_b, sc)
            vg = jax.vmap(lambda vbh, ih: vbh[ih])(vb_b, sc)
            blk = start // A_BLOCK
            k_own = lax.dynamic_index_in_dim(kb_b, blk, axis=1, keepdims=False)
            v_own = lax.dynamic_index_in_dim(vb_b, blk, axis=1, keepdims=False)
            s_sel = jnp.einsum('hqd,hqkld->hqkl', qc, kg).reshape(H, Q, topk * L)
            s_own = jnp.einsum('hqd,hld->hql', qc, k_own)
            m_sel = jnp.broadcast_to(vc[..., None], (H, Q, topk, L)).reshape(H, Q, topk * L)
            kpos = blk * A_BLOCK + jnp.arange(L)
            m_own = jnp.broadcast_to(kpos[None, None, :] <= pos[None, :, None], (H, Q, L))
            s = jnp.concatenate([s_sel, s_own], axis=-1).astype(jnp.float32) * scale
            p = masked_softmax(s, jnp.concatenate([m_sel, m_own], axis=-1)).astype(v.dtype)
            o = jnp.einsum('hqkl,hqkld->hqd', p[..., :topk * L].reshape(H, Q, topk, L), vg)
            return o + jnp.einsum('hql,hld->hqd', p[..., topk * L:], v_own)

        outs = lax.map(per_chunk, jnp.arange(nc))
        return outs.transpose(0, 2, 1, 3).reshape(S, H, D)

    return lax.map(per_batch, (qh, kb, vb, sel, valid))


def compress(t, pos_emb, w1, b1, w2, b2):
    B, S, G, D = t.shape
    n_cmp = (S - CMP_LEN) // CMP_STRIDE + 1
    idx = np.arange(n_cmp)[:, None] * CMP_STRIDE + np.arange(CMP_LEN)[None, :]
    blocks = t[:, idx] + pos_emb[None, None, :, None, :]
    flat = blocks.transpose(0, 3, 1, 2, 4).reshape(B, G, n_cmp, CMP_LEN * D)
    return jax.nn.gelu(flat @ w1 + b1) @ w2 + b2


def nsa_attention(q, kc, vc, ks, vs, kw, vw, gates):
    B, S, H, D = q.shape
    G, R, Q = B_KV_HEADS, B_GROUP, B_QBLOCK
    n_cmp = kc.shape[2]
    n_slc = S // SLC_BLOCK
    topn = min(SLC_TOPN, n_slc)
    nc = S // Q
    scale = HEAD_DIM ** -0.5
    cmp_end = jnp.arange(n_cmp) * CMP_STRIDE + (CMP_LEN - 1)
    ci = np.arange(n_cmp)[:, None]
    sj = np.arange(n_slc)[None, :]
    overlap = jnp.asarray(((ci * CMP_STRIDE < (sj + 1) * SLC_BLOCK) &
                           (ci * CMP_STRIDE + CMP_LEN > sj * SLC_BLOCK)).astype(np.float32))

    qg = q.reshape(B, S, G, R, D).transpose(0, 2, 3, 1, 4)
    ksb = ks.transpose(0, 2, 1, 3).reshape(B, G, n_slc, SLC_BLOCK, D)
    vsb = vs.transpose(0, 2, 1, 3).reshape(B, G, n_slc, SLC_BLOCK, D)
    kwp = jnp.pad(kw.transpose(0, 2, 1, 3), ((0, 0), (0, 0), (WINDOW, 0), (0, 0)))
    vwp = jnp.pad(vw.transpose(0, 2, 1, 3), ((0, 0), (0, 0), (WINDOW, 0), (0, 0)))
    gg = gates.reshape(B, S, G, R, 3).transpose(0, 2, 3, 1, 4)

    def per_batch(args):
        q_b, kc_b, vc_b, ks_b, vs_b, kw_b, vw_b, g_b = args

        def per_chunk(c):
            start = c * Q
            pos = start + jnp.arange(Q)
            qc = lax.dynamic_slice_in_dim(q_b, start, Q, axis=2)
            gc = lax.dynamic_slice_in_dim(g_b, start, Q, axis=2)
            s = jnp.einsum('grqd,gnd->grqn', qc, kc_b).astype(jnp.float32) * scale
            p_cmp = masked_softmax(s, cmp_end[None, :] <= pos[:, None])
            o_cmp = jnp.einsum('grqn,gnd->grqd', p_cmp.astype(vc_b.dtype), vc_b)
            imp = jnp.einsum('grqn,nj->gqj', p_cmp, overlap)
            own = pos // SLC_BLOCK
            blk = jnp.arange(n_slc)[None, :]
            forced = (blk == 0) | (blk == own[:, None]) | (blk == own[:, None] - 1)
            imp = jnp.where(forced, BIG, imp)
            imp = jnp.where(blk <= own[:, None], imp, NEG_INF)
            top_v, sel = lax.top_k(imp, topn)
            valid = top_v > 0.5 * NEG_INF
            kg = jax.vmap(lambda kbg, ig: kbg[ig])(ks_b, sel)
            vg = jax.vmap(lambda vbg, ig: vbg[ig])(vs_b, sel)
            s = jnp.einsum('grqd,gqnld->grqnl', qc, kg).astype(jnp.float32) * scale
            kpos = sel[..., None] * SLC_BLOCK + jnp.arange(SLC_BLOCK)
            m = valid[..., None] & (kpos <= pos[None, :, None, None])
            p = masked_softmax(s.reshape(G, R, Q, topn * SLC_BLOCK),
                               m.reshape(G, 1, Q, topn * SLC_BLOCK))
            o_slc = jnp.einsum('grqnl,gqnld->grqd',
                               p.reshape(G, R, Q, topn, SLC_BLOCK).astype(vs_b.dtype), vg)
            kwc = lax.dynamic_slice_in_dim(kw_b, start, WINDOW + Q, axis=1)
            vwc = lax.dynamic_slice_in_dim(vw_b, start, WINDOW + Q, axis=1)
            kpos_w = start - WINDOW + jnp.arange(WINDOW + Q)
            m_w = ((kpos_w[None, :] <= pos[:, None]) & (kpos_w[None, :] > pos[:, None] - WINDOW)
                   & (kpos_w[None, :] >= 0))
            s = jnp.einsum('grqd,gkd->grqk', qc, kwc).astype(jnp.float32) * scale
            p = masked_softmax(s, m_w)
            o_win = jnp.einsum('grqk,gkd->grqd', p.astype(vwc.dtype), vwc)
            return gc[..., 0:1] * o_cmp + gc[..., 1:2] * o_slc + gc[..., 2:3] * o_win

        outs = lax.map(per_chunk, jnp.arange(nc))
        return outs.transpose(0, 3, 1, 2, 4).reshape(S, H, D)

    return lax.map(per_batch, (qg, kc, vc, ksb, vsb, kwp, vwp, gg))


def peer_ffn(h, w_q, sub_k1, sub_k2, expert_u, expert_v):
    B, S, Dm = h.shape
    T = B * S
    ht = h.reshape(T, Dm)
    q = (ht @ w_q).reshape(T, PEER_HEADS, PEER_QDIM)
    s1 = jnp.einsum('thd,nd->thn', q[..., :PEER_HALF], sub_k1).astype(jnp.float32)
    s2 = jnp.einsum('thd,nd->thn', q[..., PEER_HALF:], sub_k2).astype(jnp.float32)
    v1, i1 = lax.top_k(s1, PEER_TOPK)
    v2, i2 = lax.top_k(s2, PEER_TOPK)
    cand = (v1[..., :, None] + v2[..., None, :]).reshape(T, PEER_HEADS, PEER_TOPK * PEER_TOPK)
    cand_idx = (i1[..., :, None] * PEER_NKEYS + i2[..., None, :]).reshape(T, PEER_HEADS, PEER_TOPK * PEER_TOPK)
    vals, pos = lax.top_k(cand, PEER_TOPK)
    experts = jnp.take_along_axis(cand_idx, pos, axis=-1)
    gates = jax.nn.softmax(vals, axis=-1)

    def per_chunk(args):
        xc, ec, gc = args
        u = expert_u[ec]
        a = jnp.einsum('cd,chkd->chk', xc, u).astype(jnp.float32)
        w = (jax.nn.gelu(a) * gc).astype(xc.dtype)
        return jnp.einsum('chk,chkd->cd', w, expert_v[ec])

    nc = T // PEER_CHUNK
    out = lax.map(per_chunk, (ht.reshape(nc, PEER_CHUNK, Dm),
                              experts.reshape(nc, PEER_CHUNK, PEER_HEADS, PEER_TOPK),
                              gates.reshape(nc, PEER_CHUNK, PEER_HEADS, PEER_TOPK)))
    return out.reshape(B, S, Dm)


def hybrid_layer(x, cos, sin, norm1_g, w_in, b_merge, a_q_g, a_k_g, b_q_g, b_kc_g, b_ks_g, b_kw_g,
                 cmp_pos_k, cmp_k_w1, cmp_k_b1, cmp_k_w2, cmp_k_b2,
                 cmp_pos_v, cmp_v_w1, cmp_v_b1, cmp_v_w2, cmp_v_b2,
                 w_up_a, w_up_b, w_out, norm2_g, peer_wq, peer_k1, peer_k2, peer_u, peer_v):
    B, S, _ = x.shape
    h = rmsnorm(x, norm1_g)
    (aq, ak, av, bq, bkc, bvc, bks, bvs, bkw, bvw, bgate, mgate) = split_columns(h @ w_in)

    def heads(t, n):
        return t.reshape(B, S, n, HEAD_DIM)

    qa = partial_rope(rmsnorm(heads(aq, A_HEADS), a_q_g), cos, sin)
    ka = partial_rope(rmsnorm(heads(ak, A_HEADS), a_k_g), cos, sin)
    ya = moba_attention(qa, ka, heads(av, A_HEADS)).reshape(B, S, A_WIDTH)

    qb = partial_rope(rmsnorm(heads(bq, B_HEADS), b_q_g), cos, sin)
    kc = rmsnorm(compress(heads(bkc, B_KV_HEADS), cmp_pos_k, cmp_k_w1, cmp_k_b1, cmp_k_w2, cmp_k_b2), b_kc_g)
    vc = compress(heads(bvc, B_KV_HEADS), cmp_pos_v, cmp_v_w1, cmp_v_b1, cmp_v_w2, cmp_v_b2)
    ks = partial_rope(rmsnorm(heads(bks, B_KV_HEADS), b_ks_g), cos, sin)
    kw = partial_rope(rmsnorm(heads(bkw, B_KV_HEADS), b_kw_g), cos, sin)
    gb = jax.nn.sigmoid(bgate.astype(jnp.float32)).astype(x.dtype).reshape(B, S, B_HEADS, 3)
    yb = nsa_attention(qb, kc, vc, ks, heads(bvs, B_KV_HEADS), kw, heads(bvw, B_KV_HEADS), gb)
    yb = yb.reshape(B, S, B_WIDTH)

    g = jax.nn.sigmoid((mgate.reshape(B, S, N_BRANCH, D_MODEL) + b_merge).astype(jnp.float32)).astype(x.dtype)
    merged = g[:, :, 0] * (ya @ w_up_a) + g[:, :, 1] * (yb @ w_up_b)
    x = x + merged @ w_out

    return x + peer_ffn(rmsnorm(x, norm2_g), peer_wq, peer_k1, peer_k2, peer_u, peer_v)


def setup_inputs(seed: int = 0) -> dict:
    key = jax.random.key(seed)
    ks = jax.random.split(key, 32)
    L = DEPTH
    f32 = jnp.float32

    def nrm(k, shape, scale):
        return jax.random.normal(k, shape, f32) * scale

    def gain(k, shape):
        return 1.0 + 0.05 * jax.random.normal(k, shape, f32)

    return {
        "x": nrm(ks[0], (BATCH, SEQ, D_MODEL), 1.0),
        "norm1_g": gain(ks[1], (L, D_MODEL)),
        "w_in": nrm(ks[2], (L, D_MODEL, IN_COLS), D_MODEL ** -0.5),
        "b_merge": nrm(ks[3], (L, N_BRANCH, D_MODEL), 0.1),
        "a_q_g": gain(ks[4], (L, HEAD_DIM)),
        "a_k_g": gain(ks[5], (L, HEAD_DIM)),
        "b_q_g": gain(ks[6], (L, HEAD_DIM)),
        "b_kc_g": gain(ks[7], (L, HEAD_DIM)),
        "b_ks_g": gain(ks[8], (L, HEAD_DIM)),
        "b_kw_g": gain(ks[9], (L, HEAD_DIM)),
        "cmp_pos_k": nrm(ks[10], (L, CMP_LEN, HEAD_DIM), 0.1),
        "cmp_k_w1": nrm(ks[11], (L, CMP_LEN * HEAD_DIM, CMP_HIDDEN), (CMP_LEN * HEAD_DIM) ** -0.5),
        "cmp_k_b1": nrm(ks[12], (L, CMP_HIDDEN), 0.02),
        "cmp_k_w2": nrm(ks[13], (L, CMP_HIDDEN, HEAD_DIM), CMP_HIDDEN ** -0.5),
        "cmp_k_b2": nrm(ks[14], (L, HEAD_DIM), 0.02),
        "cmp_pos_v": nrm(ks[15], (L, CMP_LEN, HEAD_DIM), 0.1),
        "cmp_v_w1": nrm(ks[16], (L, CMP_LEN * HEAD_DIM, CMP_HIDDEN), (CMP_LEN * HEAD_DIM) ** -0.5),
        "cmp_v_b1": nrm(ks[17], (L, CMP_HIDDEN), 0.02),
        "cmp_v_w2": nrm(ks[18], (L, CMP_HIDDEN, HEAD_DIM), CMP_HIDDEN ** -0.5),
        "cmp_v_b2": nrm(ks[19], (L, HEAD_DIM), 0.02),
        "w_up_a": nrm(ks[20], (L, A_WIDTH, D_MODEL), A_WIDTH ** -0.5),
        "w_up_b": nrm(ks[21], (L, B_WIDTH, D_MODEL), B_WIDTH ** -0.5),
        "w_out": nrm(ks[22], (L, D_MODEL, D_MODEL), D_MODEL ** -0.5),
        "norm2_g": gain(ks[23], (L, D_MODEL)),
        "peer_wq": nrm(ks[24], (L, D_MODEL, PEER_HEADS * PEER_QDIM), D_MODEL ** -0.5),
        "peer_k1": nrm(ks[25], (L, PEER_NKEYS, PEER_HALF), PEER_HALF ** -0.5),
        "peer_k2": nrm(ks[26], (L, PEER_NKEYS, PEER_HALF), PEER_HALF ** -0.5),
        "peer_u": nrm(ks[27], (L, PEER_N, D_MODEL), D_MODEL ** -0.5),
        "peer_v": nrm(ks[28], (L, PEER_N, D_MODEL), 0.3),
    }


def reference(x, norm1_g, w_in, b_merge, a_q_g, a_k_g, b_q_g, b_kc_g, b_ks_g, b_kw_g,
              cmp_pos_k, cmp_k_w1, cmp_k_b1, cmp_k_w2, cmp_k_b2,
              cmp_pos_v, cmp_v_w1, cmp_v_b1, cmp_v_w2, cmp_v_b2,
              w_up_a, w_up_b, w_out, norm2_g, peer_wq, peer_k1, peer_k2, peer_u, peer_v):
    cos, sin = rope_tables(x.shape[1])
    for l in range(DEPTH):
        x = hybrid_layer(x, cos, sin, norm1_g[l], w_in[l], b_merge[l], a_q_g[l], a_k_g[l],
                         b_q_g[l], b_kc_g[l], b_ks_g[l], b_kw_g[l],
                         cmp_pos_k[l], cmp_k_w1[l], cmp_k_b1[l], cmp_k_w2[l], cmp_k_b2[l],
                         cmp_pos_v[l], cmp_v_w1[l], cmp_v_b1[l], cmp_v_w2[l], cmp_v_b2[l],
                         w_up_a[l], w_up_b[l], w_out[l], norm2_g[l],
                         peer_wq[l], peer_k1[l], peer_k2[l], peer_u[l], peer_v[l])
    return x
```

```cpp
#include <hip/hip_runtime.h>
#include <hip/hip_cooperative_groups.h>
#include <stdint.h>
#include <stdio.h>
#define SELFCHECK 0
namespace cg = cooperative_groups;

#define LDSP __attribute__((address_space(3)))
typedef unsigned short bf16_t;
typedef short bf16x8 __attribute__((ext_vector_type(8)));
typedef short s16x4 __attribute__((ext_vector_type(4)));
typedef float f32x2 __attribute__((ext_vector_type(2)));
typedef float f32x4 __attribute__((ext_vector_type(4)));
typedef float f32x16 __attribute__((ext_vector_type(16)));
typedef unsigned u32x2 __attribute__((ext_vector_type(2)));
typedef unsigned u32x4 __attribute__((ext_vector_type(4)));
typedef __bf16 bf16x2_t __attribute__((ext_vector_type(2)));

constexpr int BATCH = 8, SEQ = 4096, DM = 1024, T = BATCH * SEQ;
constexpr int HD = 64;
constexpr int NPROJ = 5120;
constexpr int PEER_NE = 16384;
constexpr float NORM_EPS = 1e-6f;
constexpr float PEER_US = 64.0f, PEER_VS = 16.0f;
constexpr float QSCALE = 0.125f * 1.4426950408889634f;
constexpr int NTHREADS = 512, NWAVES = 8;
constexpr int LDS_BYTES = 140 * 1024;

constexpr size_t MiB = 1u << 20;
constexpr size_t OFF_RS1 = 1 * MiB;
constexpr size_t OFF_RS2 = 1 * MiB + 256 * 1024;
constexpr size_t OFF_ROPE_C = 2 * MiB;
constexpr size_t OFF_ROPE_S = 2 * MiB + 128 * 1024;
constexpr size_t OFF_POSB = 2 * MiB + 512 * 1024;
constexpr size_t OFF_KMEAN = 3 * MiB;
constexpr size_t OFF_BGATE = 4 * MiB;
constexpr size_t OFF_WIN_T = 8 * MiB;
constexpr size_t OFF_WUPA_T = 19 * MiB;
constexpr size_t OFF_WUPB_T = 20 * MiB;
constexpr size_t OFF_WOUT_T = 21 * MiB;
constexpr size_t OFF_WPQ_T = 23 * MiB;
constexpr size_t OFF_W1K_T = 27 * MiB;
constexpr size_t OFF_W1V_T = 28 * MiB;
constexpr size_t OFF_W2K_T = 29 * MiB;
constexpr size_t OFF_W2V_T = 29 * MiB + 128 * 1024;
constexpr size_t OFF_K1B = 29 * MiB + 256 * 1024;
constexpr size_t OFF_K2B = 29 * MiB + 320 * 1024;
constexpr size_t OFF_HID = 30 * MiB;
constexpr size_t OFF_KC = 34 * MiB;
constexpr size_t OFF_VC = 35 * MiB;
constexpr size_t OFF_EXPERTS = 36 * MiB;
constexpr size_t OFF_GATES = 52 * MiB;
constexpr size_t OFF_U = 68 * MiB;
constexpr size_t OFF_V = 100 * MiB;
constexpr size_t OFF_R0 = 132 * MiB;
constexpr size_t OFF_R1 = 196 * MiB;
constexpr size_t OFF_R2 = 324 * MiB;
constexpr size_t OFF_R3 = 372 * MiB;
constexpr size_t WS_END = 500 * MiB;

struct Params {
    const float* in[29];
    float* out;
    unsigned char* ws;
    int ph_lo, ph_hi;
};
static_assert(sizeof(Params) == 31 * 8 + 8, "Params has no padding");

enum { I_X = 0, I_NORM1, I_WIN, I_BMERGE, I_AQG, I_AKG, I_BQG, I_BKCG, I_BKSG, I_BKWG,
       I_CPK, I_CKW1, I_CKB1, I_CKW2, I_CKB2, I_CPV, I_CVW1, I_CVB1, I_CVW2, I_CVB2,
       I_WUPA, I_WUPB, I_WOUT, I_NORM2, I_PWQ, I_PK1, I_PK2, I_PU, I_PV };

__device__ __forceinline__ int opaque_tid() { int t = threadIdx.x; asm volatile("" : "+v"(t)); return t; }
__device__ __forceinline__ unsigned pk2(float lo, float hi) {
    f32x2 v = {lo, hi};
    bf16x2_t b = __builtin_convertvector(v, bf16x2_t);
    return __builtin_bit_cast(unsigned, b);
}
__device__ __forceinline__ float bf2f(bf16_t b) { return __uint_as_float(((unsigned)b) << 16); }
__device__ __forceinline__ float wave_sum(float v) {
#pragma unroll
    for (int o = 1; o < 64; o <<= 1) v += __shfl_xor(v, o);
    return v;
}
__device__ __forceinline__ float gelu_tanh(float x) {
    const float u = 0.7978845608028654f * (x + 0.044715f * x * x * x);
    return x / (1.0f + __expf(-2.0f * u));
}
__device__ __forceinline__ float sigmoidf_(float x) { return 1.0f / (1.0f + __expf(-x)); }
__device__ __forceinline__ void cvt8(const u32x4 w, float (&f)[8]) {
    f[0] = __uint_as_float(w.x << 16); f[1] = __uint_as_float(w.x & 0xffff0000u); f[2] = __uint_as_float(w.y << 16); f[3] = __uint_as_float(w.y & 0xffff0000u);
    f[4] = __uint_as_float(w.z << 16); f[5] = __uint_as_float(w.z & 0xffff0000u); f[6] = __uint_as_float(w.w << 16); f[7] = __uint_as_float(w.w & 0xffff0000u);
}
__device__ __forceinline__ int swz_off(int row, int chunk) { return row * 128 + ((chunk ^ ((row >> 1) & 7)) << 4); }

__device__ __forceinline__ void transpose_item(const float* W, int ldw, int k0, int src_c0, int nvalid, const float* kscale,
                                               bf16_t* WT, int ldwt, int n0, LDSP float* scr, int lane) {
#pragma unroll 8
    for (int i = 0; i < 32; ++i) {
        const int kk = 2 * i + (lane >> 5), nn = lane & 31;
        float v = 0.f;
        if (nn < nvalid) v = W[(size_t)(k0 + kk) * ldw + src_c0 + nn];
        if (kscale) v *= kscale[k0 + kk];
        scr[kk * 33 + nn] = v;
    }
    asm volatile("s_waitcnt lgkmcnt(0)" ::: "memory");
    const int c = lane & 7;
#pragma unroll
    for (int j = 0; j < 4; ++j) {
        const int n = (lane >> 3) + 8 * j;
        const LDSP float* s = scr + (8 * c) * 33 + n;
        u32x4 o;
        o.x = pk2(s[0 * 33], s[1 * 33]); o.y = pk2(s[2 * 33], s[3 * 33]); o.z = pk2(s[4 * 33], s[5 * 33]); o.w = pk2(s[6 * 33], s[7 * 33]);
        *(u32x4*)(WT + (size_t)(n0 + n) * ldwt + k0 + 8 * c) = o;
    }
    asm volatile("s_waitcnt lgkmcnt(0)" ::: "memory");
}

struct TrJob { const float* W; int K, N, ldw; const float* kscale; bf16_t* WT; int kind; };

__device__ __forceinline__ void run_tr_job(const TrJob& J, int item, LDSP float* scr, int lane) {
    const int nblk = J.N / 32, kb = item / nblk, nb = item % nblk;
    int src_c0 = nb * 32, nvalid = 32;
    if (J.kind == 1) {
        const int p0 = nb * 32, pn = p0 >> 8, q = p0 & 255, bj = q >> 7, wc = (q >> 5) & 3, H = 4 * pn + wc, d0 = 32 * bj;
        if (H < 44) src_c0 = 64 * H + d0;
        else if (H < 76) src_c0 = 64 * H + d0 + 24;
        else if (H == 76 && bj == 0) { src_c0 = 2816; nvalid = 24; }
        else { src_c0 = 0; nvalid = 0; }
    } else if (J.kind == 2) {
        if (nb * 32 >= 64) { src_c0 = 0; nvalid = 0; }
    }
    transpose_item(J.W, J.ldw, kb * 64, src_c0, nvalid, J.kscale, J.WT, J.K, nb * 32, scr, lane);
}

__device__ __forceinline__ void phase_prep(const Params& P, LDSP unsigned char* lds, int vcu, int G) {
    const int tid = opaque_tid(), lane = tid & 63, wave = tid >> 6;
    const int gw = vcu * NWAVES + wave, NGW = G * NWAVES;
    unsigned char* ws = P.ws;
    LDSP float* scr = (LDSP float*)(lds + wave * 8704);
    int base = 0;
#define TR_JOB(Wp, Kk, Nn, LDW, KS, WTp, KIND) do { TrJob J{Wp, Kk, Nn, LDW, KS, WTp, KIND}; const int nitems = ((Kk) / 64) * ((Nn) / 32); \
        const int first = (gw - base % NGW + NGW) % NGW; for (int it = first; it < nitems; it += NGW) run_tr_job(J, it, scr, lane); base += nitems; } while (0)
    TR_JOB(P.in[I_WIN], 1024, NPROJ, 4888, P.in[I_NORM1], (bf16_t*)(ws + OFF_WIN_T), 1);
    TR_JOB(P.in[I_WUPA], 512, 1024, 1024, nullptr, (bf16_t*)(ws + OFF_WUPA_T), 0);
    TR_JOB(P.in[I_WUPB], 512, 1024, 1024, nullptr, (bf16_t*)(ws + OFF_WUPB_T), 0);
    TR_JOB(P.in[I_WOUT], 1024, 1024, 1024, nullptr, (bf16_t*)(ws + OFF_WOUT_T), 0);
    TR_JOB(P.in[I_PWQ], 1024, 2048, 2048, P.in[I_NORM2], (bf16_t*)(ws + OFF_WPQ_T), 0);
    TR_JOB(P.in[I_CKW1], 2048, 256, 256, nullptr, (bf16_t*)(ws + OFF_W1K_T), 0);
    TR_JOB(P.in[I_CVW1], 2048, 256, 256, nullptr, (bf16_t*)(ws + OFF_W1V_T), 0);
    TR_JOB(P.in[I_CKW2], 256, 128, 64, nullptr, (bf16_t*)(ws + OFF_W2K_T), 2);
    TR_JOB(P.in[I_CVW2], 256, 128, 64, nullptr, (bf16_t*)(ws + OFF_W2V_T), 2);
#undef TR_JOB
    {
        const float* x = P.in[I_X];
        bf16_t* xb = (bf16_t*)(ws + OFF_R0);
        float* rs1 = (float*)(ws + OFF_RS1);
        for (int m = gw; m < T; m += NGW) {
            const f32x4* xr = (const f32x4*)(x + (size_t)m * DM) + lane;
            f32x4 v[4]; float s = 0.f;
#pragma unroll
            for (int j = 0; j < 4; ++j) { v[j] = xr[64 * j]; s += (v[j].x * v[j].x + v[j].y * v[j].y) + (v[j].z * v[j].z + v[j].w * v[j].w); }
            s = wave_sum(s);
            if (lane == 0) rs1[m] = 1.0f / sqrtf(s * (1.0f / DM) + NORM_EPS);
            u32x2* o = (u32x2*)(xb + (size_t)m * DM) + lane;
#pragma unroll
            for (int j = 0; j < 4; ++j) { u32x2 w; w.x = pk2(v[j].x, v[j].y); w.y = pk2(v[j].z, v[j].w); o[64 * j] = w; }
        }
    }
    {
        const float* g2 = P.in[I_NORM2];
        const size_t n16 = (size_t)PEER_NE * DM / 16;
        const size_t gt = (size_t)gw * 64 + lane, NGT = (size_t)NGW * 64;
        for (int which = 0; which < 2; ++which) {
            const float* src = P.in[which ? I_PV : I_PU];
            unsigned char* dst = ws + (which ? OFF_V : OFF_U);
            const float sc = which ? PEER_VS : PEER_US;
            for (size_t i = gt; i < n16; i += NGT) {
                u32x4 o;
#pragma unroll
                for (int q = 0; q < 4; ++q) {
                    f32x4 a4 = *(const f32x4*)(src + i * 16 + q * 4);
                    if (!which) { const int c = (int)((i * 16 + q * 4) & (DM - 1)); const f32x4 g4 = *(const f32x4*)(g2 + c); a4 = a4 * g4; }
                    a4 = a4 * sc;
                    int p = __builtin_amdgcn_cvt_pk_fp8_f32(a4.x, a4.y, 0, false);
                    p = __builtin_amdgcn_cvt_pk_fp8_f32(a4.z, a4.w, p, true);
                    o[q] = (unsigned)p;
                }
                { const size_t e_ = (i * 16) >> 10, c_ = (i * 16) & 1023;
                  *(u32x4*)(dst + ((c_ >> 7) * (size_t)PEER_NE + e_) * 128 + (c_ & 127)) = o; }
            }
        }
    }
    {
        const int gt = gw * 64 + lane, NGT = NGW * 64;
        for (int i = gt; i < 2 * 128 * 128; i += NGT) {
            const int w = i >> 14, e = i & 16383;
            const float v = P.in[w ? I_PK2 : I_PK1][e];
            ((bf16_t*)(ws + (w ? OFF_K2B : OFF_K1B)))[e] = (bf16_t)(pk2(v, 0.f) & 0xffff);
        }
        for (int i = gt; i < 4096 * 8; i += NGT) {
            const int pos = i >> 3, f = i & 7;
            const float inv = powf(500000.0f, -(float)(2 * f) / 16.0f);
            const float ang = (float)pos * inv;
            ((float*)(ws + OFF_ROPE_C))[i] = cosf(ang);
            ((float*)(ws + OFF_ROPE_S))[i] = sinf(ang);
        }
        for (int i = gt; i < T; i += NGT) ((float*)(ws + OFF_RS2))[i] = 0.f;
        if (gt < 2) ((unsigned*)(ws + 512 * 1024))[gt] = 0u;
        for (int o = gw; o < 512; o += NGW) {
            const int w = o >> 8, j = o & 255;
            const float* pos = P.in[w ? I_CPV : I_CPK];
            const float* w1 = P.in[w ? I_CVW1 : I_CKW1];
            float s = 0.f;
            for (int i = lane; i < 2048; i += 64) s += pos[i] * w1[(size_t)i * 256 + j];
            s = wave_sum(s);
            if (lane == 0) ((float*)(ws + OFF_POSB))[o] = s + P.in[w ? I_CVB1 : I_CKB1][j];
        }
    }
}

constexpr int G_BM = 256, G_BN = 128, G_BK = 64;
constexpr int G_ABYTES = G_BM * 128, G_BBYTES = G_BN * 128, G_STAGE = G_ABYTES + G_BBYTES;

__device__ __forceinline__ void gemm_kloop(f32x4 (&acc)[4][4], const bf16_t* A, size_t lda, const bf16_t* Bt, size_t ldb, int K, LDSP unsigned char* lds) {
    const int tid = opaque_tid(), lane = tid & 63, wid = tid >> 6, wm = wid >> 1, wn = wid & 1, fr = lane & 15, fq = lane >> 4;
    const int lrow = tid >> 3, lch = tid & 7;
    const bf16_t* ga = A + (size_t)lrow * lda + lch * 8;
    const bf16_t* gb = Bt + (size_t)lrow * ldb + lch * 8;
    u32x4 ra[4], rb[2];
    const int nk = K / G_BK;
#pragma unroll
    for (int p = 0; p < 4; ++p) ra[p] = *(const u32x4*)(ga + (size_t)(64 * p) * lda);
#pragma unroll
    for (int p = 0; p < 2; ++p) rb[p] = *(const u32x4*)(gb + (size_t)(64 * p) * ldb);
    __syncthreads();
#pragma unroll
    for (int p = 0; p < 4; ++p) *(LDSP u32x4*)(lds + swz_off(lrow + 64 * p, lch)) = ra[p];
#pragma unroll
    for (int p = 0; p < 2; ++p) *(LDSP u32x4*)(lds + G_ABYTES + swz_off(lrow + 64 * p, lch)) = rb[p];
    __syncthreads();
    for (int kt = 0; kt < nk; ++kt) {
        LDSP unsigned char* cur = lds + (kt & 1) * G_STAGE;
        LDSP unsigned char* nxt = lds + ((kt + 1) & 1) * G_STAGE;
        if (kt + 1 < nk) {
#pragma unroll
            for (int p = 0; p < 4; ++p) ra[p] = *(const u32x4*)(ga + (size_t)(64 * p) * lda + (kt + 1) * G_BK);
#pragma unroll
            for (int p = 0; p < 2; ++p) rb[p] = *(const u32x4*)(gb + (size_t)(64 * p) * ldb + (kt + 1) * G_BK);
        }
#pragma unroll
        for (int ks = 0; ks < 2; ++ks) {
            bf16x8 af[4], bfr[4];
#pragma unroll
            for (int m = 0; m < 4; ++m) af[m] = *(const LDSP bf16x8*)(cur + swz_off(wm * 64 + m * 16 + fr, ks * 4 + fq));
#pragma unroll
            for (int n = 0; n < 4; ++n) bfr[n] = *(const LDSP bf16x8*)(cur + G_ABYTES + swz_off(wn * 64 + n * 16 + fr, ks * 4 + fq));
#pragma unroll
            for (int m = 0; m < 4; ++m)
#pragma unroll
                for (int n = 0; n < 4; ++n) acc[m][n] = __builtin_amdgcn_mfma_f32_16x16x32_bf16(bfr[n], af[m], acc[m][n], 0, 0, 0);
        }
        if (kt + 1 < nk) {
#pragma unroll
            for (int p = 0; p < 4; ++p) *(LDSP u32x4*)(nxt + swz_off(lrow + 64 * p, lch)) = ra[p];
#pragma unroll
            for (int p = 0; p < 2; ++p) *(LDSP u32x4*)(nxt + G_ABYTES + swz_off(lrow + 64 * p, lch)) = rb[p];
        }
        __syncthreads();
    }
}

__device__ __forceinline__ void zero_acc(f32x4 (&acc)[4][4]) {
#pragma unroll
    for (int m = 0; m < 4; ++m)
#pragma unroll
        for (int n = 0; n < 4; ++n) acc[m][n] = (f32x4){0.f, 0.f, 0.f, 0.f};
}

__device__ __forceinline__ bool tile_order(int it, int vcu, int G, int nM, int nN, int& tm, int& tn) {
    if (G == 256 && (nM % 32) == 0) {
        const int xcd = vcu >> 5, cu = vcu & 31, mper = nM / 8;
        const int L = it * 32 + cu, per_group = 4 * nN;
        if (L >= mper * nN) return false;
        const int mg = L / per_group, rem = L % per_group;
        tm = xcd * mper + mg * 4 + (rem & 3); tn = rem >> 2;
        return true;
    }
    const int L = it * G + vcu;
    if (L >= nM * nN) return false;
    tm = L / nN; tn = L % nN;
    return true;
}

namespace pg8 {
constexpr int BM = 256, BK = 64, HALF = 128, HTB = HALF * BK * 2, NXCD = 8, WGM = 8;
__device__ __forceinline__ int lds_byte(int r, int c) { const int st = (r >> 4) * 2 + (c >> 5), rr = r & 15, cc = c & 31, ob = rr * 64 + cc * 2; return st * 1024 + (ob ^ (((ob >> 9) & 1) << 5)); }
__device__ __forceinline__ void stage_rc(int b, int& R, int& C) { const int st = b / 1024, sb = b % 1024, swz = sb ^ (((sb >> 9) & 1) << 5); R = (st >> 1) * 16 + swz / 64; C = (st & 1) * 32 + (swz % 64) / 2; }
struct Unit { int pm, pn, z; };
__device__ __forceinline__ bool tile_of(int L, int nM, int nN, int& pm, int& pn) {
    const int nwg = nM * nN; if (L >= nwg) return false;
    int wgid = L; { const int q = nwg / NXCD, r = nwg % NXCD, xcd = wgid % NXCD, off = wgid / NXCD; wgid = (xcd < r ? xcd * (q + 1) : r * (q + 1) + (xcd - r) * q) + off; }
    const int nig = WGM * nN, gid = wgid / nig, fm = gid * WGM, gsz = (nM - fm) < WGM ? (nM - fm) : WGM;
    pm = fm + ((wgid % nig) % gsz); pn = (wgid % nig) / gsz; return true;
}
struct Sched {
    const bf16_t *A0, *A1, *B0, *B1; size_t lda, ldb; int K, nM, nN, NZ, G, c;
    __device__ __forceinline__ bool next(int i, Unit& u) const { u.z = (NZ == 2) ? (i & 1) : 0; const int ti = (NZ == 2) ? (i >> 1) : i; return tile_of(ti * G + c, nM, nN, u.pm, u.pn); }
    __device__ __forceinline__ const char* aptr(const Unit& u) const { return (const char*)((u.z ? A1 : A0) + (size_t)u.pm * BM * lda); }
    __device__ __forceinline__ const char* bptr(const Unit& u) const { return (const char*)((u.z ? B1 : B0) + (size_t)u.pn * BM * ldb); }
};
template <class Epi>
__device__ __forceinline__ void gemm_phase(LDSP unsigned char* lds, const Sched& S, const Epi& E) {
    const int tid = opaque_tid(), wid = __builtin_amdgcn_readfirstlane(tid >> 6), lane = tid & 63, wr = wid >> 2, wc = wid & 3, fr = lane & 15, fq = lane >> 4;
    const int nt = S.K / BK;
    unsigned voffA[2], voffB[2];
#pragma unroll
    for (int i = 0; i < 2; ++i) { int R, C; stage_rc(tid * 16 + i * 8192, R, C); voffA[i] = (unsigned)(R * S.lda + C) * 2u; voffB[i] = (unsigned)(R * S.ldb + C) * 2u; }
    const size_t kstep = (size_t)(BK * 2);
    const size_t hstepA = (size_t)HALF * S.lda * 2, hstepB = (size_t)HALF * S.ldb * 2;
    const unsigned ldsw = (unsigned)wid * 1024u;
    const int aoff = lds_byte(wr * 64 + fr, fq * 8), boff = lds_byte(wc * 32 + fr, fq * 8);
#define PG8_SA(b, h) (((b) * 2 + (h)) * HTB)
#define PG8_SB(b, h) ((4 + (b) * 2 + (h)) * HTB)
#define PG8_STAGE(bufoff, gbase, voff) do { _Pragma("unroll") for (int _i = 0; _i < 2; ++_i) \
        __builtin_amdgcn_global_load_lds((const unsigned*)((const char*)(gbase) + (voff)[_i]), (LDSP unsigned*)(lds + (bufoff) + ldsw + _i * 8192), 16, 0, 0); } while (0)
#define PG8_LDA(dst, b, h) do { _Pragma("unroll") for (int m = 0; m < 4; ++m) _Pragma("unroll") for (int k = 0; k < 2; ++k) dst[m][k] = *(const LDSP bf16x8*)(lds + PG8_SA(b, h) + aoff + m * 2048 + k * 1024); } while (0)
#define PG8_LDB(dst, b, h) do { _Pragma("unroll") for (int n = 0; n < 2; ++n) _Pragma("unroll") for (int k = 0; k < 2; ++k) dst[n][k] = *(const LDSP bf16x8*)(lds + PG8_SB(b, h) + boff + n * 2048 + k * 1024); } while (0)
#define PG8_MMA(ai, bj, At, Bt) do { __builtin_amdgcn_s_setprio(1); _Pragma("unroll") for (int m = 0; m < 4; ++m) _Pragma("unroll") for (int n = 0; n < 2; ++n) _Pragma("unroll") for (int k = 0; k < 2; ++k) \
        acc[ai][bj][m][n] = __builtin_amdgcn_mfma_f32_16x16x32_bf16(Bt[n][k], At[m][k], acc[ai][bj][m][n], 0, 0, 0); __builtin_amdgcn_s_setprio(0); } while (0)
#define PG8_WAIT_V(n) asm volatile("s_waitcnt vmcnt(" #n ")" ::: "memory")
#define PG8_WAIT_L(n) asm volatile("s_waitcnt lgkmcnt(" #n ")" ::: "memory")
#define PG8_BAR __builtin_amdgcn_s_barrier()
#define PG8_SCHED __builtin_amdgcn_sched_barrier(0)
    Unit cur, nxt; int ui = 0;
    if (!S.next(0, cur)) return;
    f32x4 acc[2][2][4][2];
#pragma unroll
    for (int a = 0; a < 2; ++a)
#pragma unroll
        for (int b = 0; b < 2; ++b)
#pragma unroll
            for (int m = 0; m < 4; ++m)
#pragma unroll
                for (int n = 0; n < 2; ++n) acc[a][b][m][n] = (f32x4){0.f, 0.f, 0.f, 0.f};
    bf16x8 At[4][2], B0[2][2], B1[2][2];
    const char* cA = S.aptr(cur); const char* cB = S.bptr(cur);
    PG8_STAGE(PG8_SB(0, 0), cB, voffB); PG8_STAGE(PG8_SB(0, 1), cB + hstepB, voffB); PG8_STAGE(PG8_SA(0, 0), cA, voffA); PG8_STAGE(PG8_SA(0, 1), cA + hstepA, voffA);
    if (wr == 1) PG8_BAR;
    PG8_WAIT_V(2); PG8_BAR;
    PG8_STAGE(PG8_SB(1, 0), cB + kstep, voffB); PG8_STAGE(PG8_SA(1, 0), cA + kstep, voffA); PG8_STAGE(PG8_SB(1, 1), cB + hstepB + kstep, voffB);
    PG8_WAIT_V(6); PG8_BAR;
    for (;;) {
        const bool has_next = S.next(ui + 1, nxt);
        const char* nA = has_next ? S.aptr(nxt) : cA; const char* nB = has_next ? S.bptr(nxt) : cB;
        for (int t = 0; t < nt; t += 2) {
            const bool last = (t == nt - 2);
            const char* a1 = cA + (size_t)(t + 1) * kstep;
            const char* a2 = last ? nA : cA + (size_t)(t + 2) * kstep; const char* b2 = last ? nB : cB + (size_t)(t + 2) * kstep;
            const char* a3 = a2 + kstep; const char* b3 = b2 + kstep;
            PG8_LDB(B0, 0, 0); PG8_LDB(B1, 0, 1); PG8_SCHED; PG8_LDA(At, 0, 0); PG8_STAGE(PG8_SA(1, 1), a1 + hstepA, voffA);
            PG8_WAIT_V(8); PG8_WAIT_L(0); PG8_BAR; PG8_MMA(0, 0, At, B0); PG8_MMA(0, 1, At, B1); PG8_BAR; PG8_SCHED;
            PG8_LDA(At, 0, 1); PG8_STAGE(PG8_SB(0, 0), b2, voffB); PG8_STAGE(PG8_SB(0, 1), b2 + hstepB, voffB); PG8_STAGE(PG8_SA(0, 0), a2, voffA);
            PG8_WAIT_V(8); PG8_WAIT_L(0); PG8_BAR; PG8_MMA(1, 0, At, B0); PG8_MMA(1, 1, At, B1); PG8_BAR; PG8_SCHED;
            PG8_LDB(B0, 1, 0); PG8_LDB(B1, 1, 1); PG8_SCHED; PG8_LDA(At, 1, 0); PG8_STAGE(PG8_SA(0, 1), a2 + hstepA, voffA);
            PG8_WAIT_V(8); PG8_WAIT_L(0); PG8_BAR; PG8_MMA(0, 0, At, B0); PG8_MMA(0, 1, At, B1); PG8_BAR; PG8_SCHED;
            PG8_LDA(At, 1, 1); PG8_STAGE(PG8_SB(1, 0), b3, voffB); PG8_STAGE(PG8_SB(1, 1), b3 + hstepB, voffB); PG8_STAGE(PG8_SA(1, 0), a3, voffA);
            PG8_WAIT_V(8); PG8_WAIT_L(0); PG8_BAR; PG8_MMA(1, 0, At, B0); PG8_MMA(1, 1, At, B1); PG8_BAR; PG8_SCHED;
        }
        if (wr == 0) PG8_BAR;
        E(acc, cur, wr, wc, fr, fq);
        if (!has_next) break;
#pragma unroll
        for (int a = 0; a < 2; ++a)
#pragma unroll
            for (int b = 0; b < 2; ++b)
#pragma unroll
                for (int m = 0; m < 4; ++m)
#pragma unroll
                    for (int n = 0; n < 2; ++n) acc[a][b][m][n] = (f32x4){0.f, 0.f, 0.f, 0.f};
        cur = nxt; cA = nA; cB = nB; ++ui;
        if (wr == 1) PG8_BAR;
    }
    PG8_WAIT_V(0);
    PG8_BAR;
#undef PG8_SA
#undef PG8_SB
#undef PG8_STAGE
#undef PG8_LDA
#undef PG8_LDB
#undef PG8_MMA
#undef PG8_WAIT_V
#undef PG8_WAIT_L
#undef PG8_BAR
#undef PG8_SCHED
}
}

struct EpiProj {
    const Params* P;
    __device__ __forceinline__ void operator()(f32x4 (&acc)[2][2][4][2], const pg8::Unit& u, int wr, int wc, int fr, int fq) const {
        unsigned char* ws = P->ws;
        const int H = 4 * u.pn + wc;
        if (H > 76) return;
        const float* rs1 = (const float*)(ws + OFF_RS1);
        int kind; bf16_t* dst = nullptr; int pitch = 0, cb = 0; const float* gain = nullptr; float oscale = 1.f; bool slab = false; int sg = 0;
        if (H < 8)        { kind = 1; dst = (bf16_t*)(ws + OFF_R1);            pitch = 512; cb = H * 64;        gain = P->in[I_AQG]; oscale = QSCALE; }
        else if (H < 16)  { kind = 1; dst = (bf16_t*)(ws + OFF_R1 + 32 * MiB); pitch = 512; cb = (H - 8) * 64;  gain = P->in[I_AKG]; }
        else if (H < 24)  { kind = 0; dst = (bf16_t*)(ws + OFF_R1 + 64 * MiB); pitch = 512; cb = (H - 16) * 64; }
        else if (H < 32)  { kind = 1; dst = (bf16_t*)(ws + OFF_R1 + 96 * MiB); pitch = 512; cb = (H - 24) * 64; gain = P->in[I_BQG]; oscale = QSCALE; }
        else if (H < 34)  { kind = 0; dst = (bf16_t*)(ws + OFF_R2);            slab = true; sg = H - 32; }
        else if (H < 36)  { kind = 0; dst = (bf16_t*)(ws + OFF_R2 + 8 * MiB);  slab = true; sg = H - 34; }
        else if (H < 38)  { kind = 1; dst = (bf16_t*)(ws + OFF_R2 + 16 * MiB); pitch = 128; cb = (H - 36) * 64; gain = P->in[I_BKSG]; }
        else if (H < 40)  { kind = 0; dst = (bf16_t*)(ws + OFF_R2 + 24 * MiB); pitch = 128; cb = (H - 38) * 64; }
        else if (H < 42)  { kind = 1; dst = (bf16_t*)(ws + OFF_R2 + 32 * MiB); pitch = 128; cb = (H - 40) * 64; gain = P->in[I_BKWG]; }
        else if (H < 44)  { kind = 0; dst = (bf16_t*)(ws + OFF_R2 + 40 * MiB); pitch = 128; cb = (H - 42) * 64; }
        else if (H < 76)  { kind = 2; dst = (bf16_t*)(ws + OFF_R3);            pitch = 2048; cb = (H - 44) * 64; }
        else              { kind = 3; }
        const float* ropec = (const float*)(ws + OFF_ROPE_C);
        const float* ropes = (const float*)(ws + OFF_ROPE_S);
        float gv[2][2][4];
        if (kind == 1) {
#pragma unroll
            for (int bj = 0; bj < 2; ++bj)
#pragma unroll
                for (int n = 0; n < 2; ++n) { const f32x4 g4 = *(const f32x4*)(gain + 32 * bj + 16 * n + 4 * fq); gv[bj][n][0] = g4.x; gv[bj][n][1] = g4.y; gv[bj][n][2] = g4.z; gv[bj][n][3] = g4.w; }
        } else if (kind == 2) {
#pragma unroll
            for (int bj = 0; bj < 2; ++bj)
#pragma unroll
                for (int n = 0; n < 2; ++n) { const f32x4 g4 = *(const f32x4*)(P->in[I_BMERGE] + cb + 32 * bj + 16 * n + 4 * fq); gv[bj][n][0] = g4.x; gv[bj][n][1] = g4.y; gv[bj][n][2] = g4.z; gv[bj][n][3] = g4.w; }
        }
#pragma unroll
        for (int ai = 0; ai < 2; ++ai)
#pragma unroll
            for (int m = 0; m < 4; ++m) {
                const int row = u.pm * 256 + ai * 128 + wr * 64 + m * 16 + fr;
                const float rs = rs1[row];
                f32x4 v[2][2];
#pragma unroll
                for (int bj = 0; bj < 2; ++bj)
#pragma unroll
                    for (int n = 0; n < 2; ++n) v[bj][n] = acc[ai][bj][m][n] * rs;
                if (kind == 1) {
                    float ss = 0.f;
#pragma unroll
                    for (int bj = 0; bj < 2; ++bj)
#pragma unroll
                        for (int n = 0; n < 2; ++n) ss += (v[bj][n][0] * v[bj][n][0] + v[bj][n][1] * v[bj][n][1]) + (v[bj][n][2] * v[bj][n][2] + v[bj][n][3] * v[bj][n][3]);
                    ss += __shfl_xor(ss, 16); ss += __shfl_xor(ss, 32);
                    const float r = oscale / sqrtf(ss * (1.0f / 64.0f) + NORM_EPS);
#pragma unroll
                    for (int bj = 0; bj < 2; ++bj)
#pragma unroll
                        for (int n = 0; n < 2; ++n)
#pragma unroll
                            for (int i = 0; i < 4; ++i) v[bj][n][i] *= r * gv[bj][n][i];
                    const int pos = row & (SEQ - 1);
                    const f32x4 c4 = *(const f32x4*)(ropec + pos * 8 + 4 * (fq & 1));
                    const f32x4 s4 = *(const f32x4*)(ropes + pos * 8 + 4 * (fq & 1));
                    const f32x4 me = v[0][0]; f32x4 ot;
#pragma unroll
                    for (int i = 0; i < 4; ++i) ot[i] = __shfl_xor(me[i], 32);
                    const float sgn = (fq < 2) ? -1.f : 1.f;
#pragma unroll
                    for (int i = 0; i < 4; ++i) v[0][0][i] = me[i] * c4[i] + sgn * ot[i] * s4[i];
                } else if (kind == 2) {
#pragma unroll
                    for (int bj = 0; bj < 2; ++bj)
#pragma unroll
                        for (int n = 0; n < 2; ++n)
#pragma unroll
                            for (int i = 0; i < 4; ++i) v[bj][n][i] = sigmoidf_(v[bj][n][i] + gv[bj][n][i]);
                }
                if (kind == 3) {
                    float* bg = (float*)(ws + OFF_BGATE) + (size_t)row * 24;
#pragma unroll
                    for (int n = 0; n < 2; ++n) { const int d = 16 * n + 4 * fq;
                        if (d < 24) { f32x4 o; o.x = sigmoidf_(v[0][n][0]); o.y = sigmoidf_(v[0][n][1]); o.z = sigmoidf_(v[0][n][2]); o.w = sigmoidf_(v[0][n][3]); *(f32x4*)(bg + d) = o; } }
                } else {
                    bf16_t* rp;
                    if (slab) { const int b = row >> 12, s = row & (SEQ - 1); rp = dst + ((size_t)((b * 2 + sg) * SEQ + s)) * 64 + 4 * fq; }
                    else rp = dst + (size_t)row * pitch + cb + 4 * fq;
#pragma unroll
                    for (int bj = 0; bj < 2; ++bj)
#pragma unroll
                        for (int n = 0; n < 2; ++n) { u32x2 w; w.x = pk2(v[bj][n][0], v[bj][n][1]); w.y = pk2(v[bj][n][2], v[bj][n][3]); *(u32x2*)(rp + 32 * bj + 16 * n) = w; }
                }
            }
    }
};
__device__ __forceinline__ void phase_proj(const Params& P, LDSP unsigned char* lds, int vcu, int G) {
    pg8::Sched S; S.A0 = S.A1 = (const bf16_t*)(P.ws + OFF_R0); S.B0 = S.B1 = (const bf16_t*)(P.ws + OFF_WIN_T);
    S.lda = DM; S.ldb = DM; S.K = DM; S.nM = T / 256; S.nN = NPROJ / 256; S.NZ = 1; S.G = G; S.c = blockIdx.x;
    EpiProj E{&P};
    pg8::gemm_phase(lds, S, E);
}

__device__ __forceinline__ void phase_cmp1(const Params& P, LDSP unsigned char* lds, int vcu, int G) {
    unsigned char* ws = P.ws;
    const int tid = opaque_tid(), lane = tid & 63, wid = tid >> 6, wm = wid >> 1, wn = wid & 1, fr = lane & 15, fq = lane >> 4;
    const int NG = (G > 64) ? 64 : G;
    if (vcu < NG) {
        for (int item = vcu; item < 64; item += NG) {
            const int kv = item >> 5, tm = (item >> 1) & 15, tn = item & 1;
            const bf16_t* A = (const bf16_t*)(ws + OFF_R2 + (size_t)kv * 8 * MiB) + (size_t)tm * SEQ * 64;
            const bf16_t* Bt = (const bf16_t*)(ws + (kv ? OFF_W1V_T : OFF_W1K_T)) + (size_t)tn * G_BN * 2048;
            const float* posb = (const float*)(ws + OFF_POSB) + kv * 256;
            bf16_t* hid = (bf16_t*)(ws + OFF_HID) + (size_t)kv * 4096 * 256;
            f32x4 acc[4][4];
            zero_acc(acc);
            gemm_kloop(acc, A, 1024, Bt, 2048, 2048, lds);
            const int row0 = tm * 256 + wm * 64 + fr, col0 = tn * 128 + wn * 64 + 4 * fq;
#pragma unroll
            for (int n = 0; n < 4; ++n) {
                const f32x4 pb = *(const f32x4*)(posb + col0 + n * 16);
#pragma unroll
                for (int m = 0; m < 4; ++m) {
                    u32x2 w; w.x = pk2(gelu_tanh(acc[m][n][0] + pb.x), gelu_tanh(acc[m][n][1] + pb.y)); w.y = pk2(gelu_tanh(acc[m][n][2] + pb.z), gelu_tanh(acc[m][n][3] + pb.w));
                    *(u32x2*)(hid + (size_t)(row0 + m * 16) * 256 + col0 + n * 16) = w;
                }
            }
        }
    }
    if (vcu >= NG || G <= 64) {
        const int nb = (G <= 64) ? G : G - NG, bi = (G <= 64) ? vcu : vcu - NG;
        const bf16_t* ka = (const bf16_t*)(ws + OFF_R1 + 32 * MiB);
        float* kmean = (float*)(ws + OFF_KMEAN);
        for (int item = bi * NWAVES + wid; item < 1024; item += nb * NWAVES) {
            const int b = item >> 7, h = (item >> 4) & 7, blk = item & 15;
            const bf16_t* p = ka + (size_t)(b * SEQ + blk * 256) * 512 + h * 64 + lane;
            float s0 = 0.f, s1 = 0.f, s2 = 0.f, s3 = 0.f;
            for (int k = 0; k < 256; k += 4) {
                s0 += bf2f(p[(size_t)(k + 0) * 512]); s1 += bf2f(p[(size_t)(k + 1) * 512]); s2 += bf2f(p[(size_t)(k + 2) * 512]); s3 += bf2f(p[(size_t)(k + 3) * 512]);
            }
            kmean[(size_t)item * 64 + lane] = ((s0 + s1) + (s2 + s3)) * (1.0f / 256.0f);
        }
    }
}

__device__ __forceinline__ void phase_cmp2(const Params& P, LDSP unsigned char* lds, int vcu, int G) {
    unsigned char* ws = P.ws;
    const int tid = opaque_tid(), lane = tid & 63, wid = tid >> 6, wm = wid >> 1, wn = wid & 1, fr = lane & 15, fq = lane >> 4;
    for (int item = vcu; item < 32; item += G) {
        const int kv = item >> 4, tm = item & 15;
        const bf16_t* A = (const bf16_t*)(ws + OFF_HID) + (size_t)kv * 4096 * 256 + (size_t)tm * 256 * 256;
        const bf16_t* Bt = (const bf16_t*)(ws + (kv ? OFF_W2V_T : OFF_W2K_T));
        const float* b2 = P.in[kv ? I_CVB2 : I_CKB2];
        bf16_t* dst = (bf16_t*)(ws + (kv ? OFF_VC : OFF_KC)) + (size_t)tm * 256 * 64;
        f32x4 acc[4][4];
        zero_acc(acc);
        gemm_kloop(acc, A, 256, Bt, 256, 256, lds);
        if (wn == 0) {
            float gv[4][4];
#pragma unroll
            for (int n = 0; n < 4; ++n) {
                const f32x4 bb = *(const f32x4*)(b2 + n * 16 + 4 * fq);
                const f32x4 g4 = kv ? (f32x4){1.f, 1.f, 1.f, 1.f} : *(const f32x4*)(P.in[I_BKCG] + n * 16 + 4 * fq);
                gv[n][0] = g4.x; gv[n][1] = g4.y; gv[n][2] = g4.z; gv[n][3] = g4.w;
#pragma unroll
                for (int m = 0; m < 4; ++m) acc[m][n] += bb;
            }
#pragma unroll
            for (int m = 0; m < 4; ++m) {
                float r = 1.f;
                if (kv == 0) {
                    float ss = 0.f;
#pragma unroll
                    for (int n = 0; n < 4; ++n) ss += (acc[m][n][0] * acc[m][n][0] + acc[m][n][1] * acc[m][n][1]) + (acc[m][n][2] * acc[m][n][2] + acc[m][n][3] * acc[m][n][3]);
                    ss += __shfl_xor(ss, 16); ss += __shfl_xor(ss, 32);
                    r = 1.0f / sqrtf(ss * (1.0f / 64.0f) + NORM_EPS);
                }
                const int row = wm * 64 + m * 16 + fr;
                if (row == 255) r = 0.f;
#pragma unroll
                for (int n = 0; n < 4; ++n) {
                    f32x4 o = acc[m][n];
                    if (row == 255) o = (f32x4){0.f, 0.f, 0.f, 0.f};
                    u32x2 w; w.x = pk2(o[0] * r * gv[n][0], o[1] * r * gv[n][1]); w.y = pk2(o[2] * r * gv[n][2], o[3] * r * gv[n][3]);
                    *(u32x2*)(dst + (size_t)row * 64 + n * 16 + 4 * fq) = w;
                }
            }
        }
    }
}

constexpr int A_GS = 32768, A_ES = 49152, A_MISC = 65536, A_Y = 73728;
typedef short v4i16_t __attribute__((ext_vector_type(4)));
struct ASt { f32x16 o0, o1; float m, l; };
struct KVStage { u32x4 k, v; };
__device__ __forceinline__ void kv_load(KVStage& s, const bf16_t* Kg, const bf16_t* Vg, size_t pitch, int tid) {
    const int key = tid >> 3, ch = tid & 7;
    s.k = *(const u32x4*)(Kg + (size_t)key * pitch + ch * 8);
    s.v = *(const u32x4*)(Vg + (size_t)key * pitch + ch * 8);
}
__device__ __forceinline__ void kv_store(const KVStage& s, LDSP unsigned char* buf, int tid) {
    const int key = tid >> 3, ch = tid & 7;
    *(LDSP u32x4*)(buf + swz_off(key, ch)) = s.k;
    *(LDSP u32x4*)(buf + 8192 + ((ch >> 2) * 4 + (key >> 4)) * 1024 + (key & 15) * 64 + (ch & 3) * 16) = s.v;
}
__device__ __forceinline__ float swap32f(float v) { return __shfl_xor(v, 32); }
__device__ __forceinline__ void ast_reset(ASt& st) {
#pragma unroll
    for (int r = 0; r < 16; ++r) { st.o0[r] = 0.f; st.o1[r] = 0.f; }
    st.m = 0.f; st.l = 0.f;
}
constexpr float ATT_THR = 8.0f;
template <int MODE>
__device__ __forceinline__ void attn_tile(ASt& st, const bf16x8 (&qf)[4], LDSP const unsigned char* kt, int lane, bool rowoff, int kl, int kh, bool need_mask,
                                          float linv, LDSP float* gs, LDSP float* es, int jbase, int ql) {
    const int r32 = lane & 31, hi = lane >> 5;
    const float cin = rowoff ? -INFINITY : -st.m;
    f32x16 p0, p1;
#pragma unroll
    for (int r = 0; r < 16; ++r) { p0[r] = cin; p1[r] = cin; }
#pragma unroll
    for (int d0 = 0; d0 < 4; ++d0) {
        const bf16x8 k0f = *(const LDSP bf16x8*)(kt + swz_off(r32, 2 * d0 + hi));
        const bf16x8 k1f = *(const LDSP bf16x8*)(kt + swz_off(r32 + 32, 2 * d0 + hi));
        p0 = __builtin_amdgcn_mfma_f32_32x32x16_bf16(k0f, qf[d0], p0, 0, 0, 0);
        p1 = __builtin_amdgcn_mfma_f32_32x32x16_bf16(k1f, qf[d0], p1, 0, 0, 0);
    }
    if (need_mask) {
        const int kl2 = kl - 4 * hi, kh2 = kh - 4 * hi;
#pragma unroll
        for (int r = 0; r < 16; ++r) {
            const int c = (r & 3) + 8 * (r >> 2);
            const bool v0 = c >= kl2 && c <= kh2, v1 = (c + 32) >= kl2 && (c + 32) <= kh2;
            p0[r] = v0 ? p0[r] : -INFINITY; p1[r] = v1 ? p1[r] : -INFINITY;
        }
    }
    if (MODE != 2) {
        float mx = fmaxf(fmaxf(p0[0], p1[0]), fmaxf(p0[1], p1[1]));
#pragma unroll
        for (int r = 2; r < 16; r += 2) mx = fmaxf(fmaxf(mx, fmaxf(p0[r], p1[r])), fmaxf(p0[r + 1], p1[r + 1]));
        mx = fmaxf(mx, swap32f(mx));
        if (__any(mx > ATT_THR)) {
            const float dl = (mx > ATT_THR) ? mx : 0.f;
            const float alpha = __builtin_amdgcn_exp2f(-dl);
            st.m += dl; st.l *= alpha;
#pragma unroll
            for (int r = 0; r < 16; ++r) { p0[r] -= dl; p1[r] -= dl; }
            if (MODE == 0) {
#pragma unroll
                for (int r = 0; r < 16; ++r) { st.o0[r] *= alpha; st.o1[r] *= alpha; }
            }
        }
    }
#pragma unroll
    for (int r = 0; r < 16; ++r) { p0[r] = __builtin_amdgcn_exp2f(p0[r]); p1[r] = __builtin_amdgcn_exp2f(p1[r]); }
    if (MODE != 2) {
        const f32x16 t = p0 + p1;
        st.l += ((t[0] + t[1]) + (t[2] + t[3])) + ((t[4] + t[5]) + (t[6] + t[7])) + (((t[8] + t[9]) + (t[10] + t[11])) + ((t[12] + t[13]) + (t[14] + t[15])));
    } else {
#pragma unroll
        for (int r = 0; r < 16; ++r) { p0[r] *= linv; p1[r] *= linv; }
#pragma unroll
        for (int qd = 0; qd < 4; ++qd) {
            float g0 = (p0[4 * qd] + p0[4 * qd + 1]) + (p0[4 * qd + 2] + p0[4 * qd + 3]), e0 = p0[4 * qd + 3];
            float g1 = (p1[4 * qd] + p1[4 * qd + 1]) + (p1[4 * qd + 2] + p1[4 * qd + 3]), e1 = p1[4 * qd + 3];
            g0 += __shfl_xor(g0, 1); g0 += __shfl_xor(g0, 2); e0 += __shfl_xor(e0, 1); e0 += __shfl_xor(e0, 2);
            g1 += __shfl_xor(g1, 1); g1 += __shfl_xor(g1, 2); e1 += __shfl_xor(e1, 1); e1 += __shfl_xor(e1, 2);
            if ((r32 & 3) == 0) {
                const int j = jbase + 2 * qd + hi;
                gs[ql * 64 + j] = g0; es[ql * 64 + j] = e0; gs[ql * 64 + j + 8] = g1; es[ql * 64 + j + 8] = e1;
            }
        }
    }
    if (MODE != 1) {
        u32x4 pw[4];
        pw[0] = (u32x4){pk2(p0[0], p0[1]), pk2(p0[2], p0[3]), pk2(p0[4], p0[5]), pk2(p0[6], p0[7])};
        pw[1] = (u32x4){pk2(p0[8], p0[9]), pk2(p0[10], p0[11]), pk2(p0[12], p0[13]), pk2(p0[14], p0[15])};
        pw[2] = (u32x4){pk2(p1[0], p1[1]), pk2(p1[2], p1[3]), pk2(p1[4], p1[5]), pk2(p1[6], p1[7])};
        pw[3] = (u32x4){pk2(p1[8], p1[9]), pk2(p1[10], p1[11]), pk2(p1[12], p1[13]), pk2(p1[14], p1[15])};
        LDSP const unsigned char* vb = kt + 8192 + ((lane >> 4) & 1) * 32 + (lane & 3) * 8 + (4 * hi + ((lane & 15) >> 2)) * 64;
#pragma unroll
        for (int ks = 0; ks < 4; ++ks) {
            const bf16x8 pf = __builtin_bit_cast(bf16x8, pw[ks]);
#pragma unroll
            for (int d0 = 0; d0 < 2; ++d0) {
                const v4i16_t lo = __builtin_amdgcn_ds_read_tr16_b64_v4i16((LDSP v4i16_t*)(vb + (d0 * 4 + ks) * 1024));
                const v4i16_t hh = __builtin_amdgcn_ds_read_tr16_b64_v4i16((LDSP v4i16_t*)(vb + (d0 * 4 + ks) * 1024 + 512));
                const bf16x8 vf = (bf16x8){lo[0], lo[1], lo[2], lo[3], hh[0], hh[1], hh[2], hh[3]};
                if (d0 == 0) st.o0 = __builtin_amdgcn_mfma_f32_32x32x16_bf16(vf, pf, st.o0, 0, 0, 0);
                else         st.o1 = __builtin_amdgcn_mfma_f32_32x32x16_bf16(vf, pf, st.o1, 0, 0, 0);
            }
            if (ks & 1) __builtin_amdgcn_sched_barrier(0);
        }
    }
}

#define KV_LOOP(NT, KPTR, VPTR, PITCH, ...) do { const int nt_ = (NT); KVStage stg_; __syncthreads(); \
    { const int i = 0; kv_load(stg_, (KPTR), (VPTR), (PITCH), tid); } kv_store(stg_, lds, tid); __syncthreads(); \
    _Pragma("unroll 1") for (int i_ = 0; i_ < nt_; ++i_) { LDSP unsigned char* cur = lds + (i_ & 1) * 16384; \
        if (i_ + 1 < nt_) { const int i = i_ + 1; kv_load(stg_, (KPTR), (VPTR), (PITCH), tid); } \
        { const int i = i_; __VA_ARGS__ } \
        if (i_ + 1 < nt_) kv_store(stg_, lds + ((i_ + 1) & 1) * 16384, tid); \
        __syncthreads(); } } while (0)

__device__ __forceinline__ void store_ot(bf16_t* dst, const f32x16& o0, const f32x16& o1, int hi) {
#pragma unroll
    for (int qd = 0; qd < 4; ++qd) {
        u32x2 w0, w1;
        w0.x = pk2(o0[4 * qd], o0[4 * qd + 1]); w0.y = pk2(o0[4 * qd + 2], o0[4 * qd + 3]);
        w1.x = pk2(o1[4 * qd], o1[4 * qd + 1]); w1.y = pk2(o1[4 * qd + 2], o1[4 * qd + 3]);
        *(u32x2*)(dst + 8 * qd + 4 * hi) = w0; *(u32x2*)(dst + 32 + 8 * qd + 4 * hi) = w1;
    }
}

__device__ __forceinline__ void moba_unit(const Params& P, LDSP unsigned char* lds, int b, int h, int blk) {
    unsigned char* ws = P.ws;
    const int tid = opaque_tid(), lane = tid & 63, wid = tid >> 6, r32 = lane & 31, hi = lane >> 5;
    const bf16_t* qa = (const bf16_t*)(ws + OFF_R1);
    const bf16_t* ka = (const bf16_t*)(ws + OFF_R1 + 32 * MiB);
    const bf16_t* va = (const bf16_t*)(ws + OFF_R1 + 64 * MiB);
    bf16_t* ya = (bf16_t*)(ws + OFF_R0);
    const float* kmean = (const float*)(ws + OFF_KMEAN) + (size_t)((b * 8 + h) * 16) * 64;
    LDSP float* km = (LDSP float*)(lds + A_MISC);
    LDSP unsigned short* sel16 = (LDSP unsigned short*)(lds + A_MISC + 4096);
    __syncthreads();
    for (int i = tid; i < blk * 64; i += NTHREADS) km[i] = kmean[i];
    __syncthreads();
    {
        const int qi = tid >> 1, hf = tid & 1;
        const bf16_t* qrow = qa + (size_t)(b * SEQ + blk * 256 + qi) * 512 + h * 64 + hf * 32;
        float q[32];
#pragma unroll
        for (int c = 0; c < 4; ++c) { float f[8]; cvt8(*(const u32x4*)(qrow + c * 8), f);
#pragma unroll
            for (int i = 0; i < 8; ++i) q[c * 8 + i] = f[i]; }
        float g0 = -INFINITY, g1 = -INFINITY, g2 = -INFINITY; int i0 = -1, i1 = -1, i2 = -1;
        for (int j = 0; j < blk; ++j) {
            float d = 0.f;
#pragma unroll
            for (int i = 0; i < 32; ++i) d += q[i] * km[j * 64 + hf * 32 + i];
            d += __shfl_xor(d, 1);
            if (d > g0) { g2 = g1; i2 = i1; g1 = g0; i1 = i0; g0 = d; i0 = j; }
            else if (d > g1) { g2 = g1; i2 = i1; g1 = d; i1 = j; }
            else if (d > g2) { g2 = d; i2 = j; }
        }
        unsigned mask = 0;
        if (i0 >= 0) mask |= 1u << i0;
        if (i1 >= 0) mask |= 1u << i1;
        if (i2 >= 0) mask |= 1u << i2;
        if (hf == 0) sel16[qi] = (unsigned short)mask;
    }
    __syncthreads();
    const int qloc = wid * 32 + r32;
    const size_t qrow_g = (size_t)(b * SEQ + blk * 256 + qloc);
    bf16x8 qf[4];
#pragma unroll
    for (int d0 = 0; d0 < 4; ++d0) qf[d0] = *(const bf16x8*)(qa + qrow_g * 512 + h * 64 + d0 * 16 + hi * 8);
    const unsigned selbits = sel16[qloc];
    ASt st; ast_reset(st);
    const bf16_t* kbase = ka + (size_t)(b * SEQ) * 512 + h * 64;
    const bf16_t* vbase = va + (size_t)(b * SEQ) * 512 + h * 64;
    KV_LOOP(4 * (blk + 1), kbase + (size_t)i * 64 * 512, vbase + (size_t)i * 64 * 512, 512, {
        const int jb = i >> 2;
        if (jb < blk) {
            const bool rowoff = !((selbits >> jb) & 1u);
            attn_tile<0>(st, qf, cur, lane, rowoff, 0, 63, false, 0.f, nullptr, nullptr, 0, 0);
        } else {
            const int t4 = i & 3;
            if (64 * t4 <= wid * 32 + 31)
                attn_tile<0>(st, qf, cur, lane, false, 0, qloc - 64 * t4, 64 * t4 + 63 > wid * 32, 0.f, nullptr, nullptr, 0, 0);
        }
    });
    const float lt = st.l + swap32f(st.l);
    const float inv = 1.0f / lt;
#pragma unroll
    for (int r = 0; r < 16; ++r) { st.o0[r] *= inv; st.o1[r] *= inv; }
    store_ot(ya + qrow_g * 512 + h * 64, st.o0, st.o1, hi);
}

__device__ __forceinline__ void nsa_unit(const Params& P, LDSP unsigned char* lds, int b, int g, int c) {
    unsigned char* ws = P.ws;
    const int tid = opaque_tid(), lane = tid & 63, wid = tid >> 6, r32 = lane & 31, hi = lane >> 5;
    const bf16_t* qb = (const bf16_t*)(ws + OFF_R1 + 96 * MiB);
    const bf16_t* kc = (const bf16_t*)(ws + OFF_KC) + (size_t)(b * 2 + g) * 256 * 64;
    const bf16_t* vc = (const bf16_t*)(ws + OFF_VC) + (size_t)(b * 2 + g) * 256 * 64;
    const bf16_t* ks = (const bf16_t*)(ws + OFF_R2 + 16 * MiB) + (size_t)(b * SEQ) * 128 + g * 64;
    const bf16_t* vs = (const bf16_t*)(ws + OFF_R2 + 24 * MiB) + (size_t)(b * SEQ) * 128 + g * 64;
    const bf16_t* kw = (const bf16_t*)(ws + OFF_R2 + 32 * MiB) + (size_t)(b * SEQ) * 128 + g * 64;
    const bf16_t* vw = (const bf16_t*)(ws + OFF_R2 + 40 * MiB) + (size_t)(b * SEQ) * 128 + g * 64;
    const float* bgate = (const float*)(ws + OFF_BGATE);
    bf16_t* yb = (bf16_t*)(ws + OFF_R0 + 32 * MiB);
    LDSP float* gs = (LDSP float*)(lds + A_GS);
    LDSP float* es = (LDSP float*)(lds + A_ES);
    LDSP unsigned long long* selm = (LDSP unsigned long long*)(lds + A_MISC);
    const int ql = wid * 8 + (r32 >> 2), hr = r32 & 3, head = g * 4 + hr, pos = c * 64 + ql;
    const size_t trow = (size_t)(b * SEQ + pos);
    bf16x8 qf[4];
#pragma unroll
    for (int d0 = 0; d0 < 4; ++d0) qf[d0] = *(const bf16x8*)(qb + trow * 512 + head * 64 + d0 * 16 + hi * 8);
    const int nmax = (pos >= 31) ? ((pos - 31) >> 4) : -1;
    const int ntc = ((4 * c + 2) >> 6) + 1;
    ASt st; ast_reset(st);
    KV_LOOP(ntc, kc + (size_t)i * 64 * 64, vc + (size_t)i * 64 * 64, 64, {
        attn_tile<1>(st, qf, cur, lane, nmax < 0, 0, nmax - 64 * i, true, 0.f, nullptr, nullptr, 0, 0);
    });
    {
        const float lt = st.l + swap32f(st.l);
        const float linv = (lt > 0.f) ? 1.0f / lt : 0.f;
        KV_LOOP(ntc, kc + (size_t)i * 64 * 64, vc + (size_t)i * 64 * 64, 64, {
            attn_tile<2>(st, qf, cur, lane, nmax < 0, 0, nmax - 64 * i, true, linv, gs, es, 16 * i, ql);
        });
    }
    LDSP float* yl = (LDSP float*)(lds + A_Y) + wid * 2048 + lane;
    { const float gt0 = bgate[trow * 24 + head * 3 + 0];
#pragma unroll
    for (int r = 0; r < 16; ++r) { yl[r * 64] = gt0 * st.o0[r]; yl[(16 + r) * 64] = gt0 * st.o1[r]; } }
    __syncthreads();
    for (int qq = 0; qq < 8; ++qq) {
        const int q = wid * 8 + qq, j = lane;
        unsigned long long m;
        if (c < 16) m = (2ull << c) - 1ull;
        else {
            const bool cand = (j >= 1 && j <= c - 2);
            float imp = 0.f;
            if (cand) imp = gs[q * 64 + j] + es[q * 64 + j - 1];
            int rank = 0;
            for (int jp = 1; jp <= c - 2; ++jp) {
                const float o = __uint_as_float(__builtin_amdgcn_readlane(__float_as_uint(imp), jp));
                rank += (o > imp || (o == imp && jp < j)) ? 1 : 0;
            }
            const bool sel = (j == 0) || (j == c) || (j == c - 1) || (cand && rank < 13);
            m = __ballot(sel);
        }
        if (lane == 0) selm[q] = m;
    }
    __syncthreads();
    const unsigned long long selmask = selm[ql];
    ast_reset(st);
    KV_LOOP(c + 1, ks + (size_t)i * 64 * 128, vs + (size_t)i * 64 * 128, 128, {
        const bool rowoff = !((selmask >> i) & 1ull);
        const bool own = (i == c);
        attn_tile<0>(st, qf, cur, lane, rowoff, 0, own ? ql : 63, own, 0.f, nullptr, nullptr, 0, 0);
    });
    {
        const float lt = st.l + swap32f(st.l);
        const float sc = bgate[trow * 24 + head * 3 + 1] / lt;
#pragma unroll
        for (int r = 0; r < 16; ++r) { yl[r * 64] += sc * st.o0[r]; yl[(16 + r) * 64] += sc * st.o1[r]; }
    }
    ast_reset(st);
    const int j0 = (c >= 8) ? c - 8 : 0;
    KV_LOOP(c - j0 + 1, kw + (size_t)(j0 + i) * 64 * 128, vw + (size_t)(j0 + i) * 64 * 128, 128, {
        const int j = j0 + i;
        const bool first = (j == c - 8), own = (j == c);
        attn_tile<0>(st, qf, cur, lane, false, first ? ql + 1 : 0, own ? ql : 63, first || own, 0.f, nullptr, nullptr, 0, 0);
    });
    {
        const float lt = st.l + swap32f(st.l);
        const float sc = bgate[trow * 24 + head * 3 + 2] / lt;
        f32x16 y0, y1;
#pragma unroll
        for (int r = 0; r < 16; ++r) { y0[r] = yl[r * 64] + sc * st.o0[r]; y1[r] = yl[(16 + r) * 64] + sc * st.o1[r]; }
        store_ot(yb + trow * 512 + head * 64, y0, y1, hi);
    }
}

__device__ __forceinline__ void phase_attn(const Params& P, LDSP unsigned char* lds, int vcu, int G) {
    const int nloc = (G == 256) ? 8 : (2048 - vcu + G - 1) / G;
    for (int k = 0; k < nloc; ++k) {
        int u;
        if (G == 256) {
            const int kk = k >> 1;
            if (!(k & 1)) { const int bh = vcu >> 2, jm = vcu & 3; const int blk = (kk == 0) ? 15 - jm : (kk == 1) ? 8 + jm : (kk == 2) ? 7 - jm : jm; u = bh * 16 + blk; }
            else { const int bg = vcu >> 4, jn = vcu & 15; const int c = (kk == 0) ? 63 - jn : (kk == 1) ? 32 + jn : (kk == 2) ? 31 - jn : jn; u = 1024 + bg * 64 + c; }
        } else u = vcu + k * G;
        if (u < 1024) moba_unit(P, lds, u >> 7, (u >> 4) & 7, u & 15);
        else { const int v = u - 1024; nsa_unit(P, lds, v >> 7, (v >> 6) & 1, v & 63); }
    }
}

struct EpiUp {
    const Params* P;
    __device__ __forceinline__ void operator()(f32x4 (&acc)[2][2][4][2], const pg8::Unit& u, int wr, int wc, int fr, int fq) const {
        bf16_t* g = (bf16_t*)(P->ws + OFF_R3);
#pragma unroll
        for (int ai = 0; ai < 2; ++ai)
#pragma unroll
            for (int m = 0; m < 4; ++m) {
                const int row = u.pm * 256 + ai * 128 + wr * 64 + m * 16 + fr;
#pragma unroll
                for (int bj = 0; bj < 2; ++bj)
#pragma unroll
                    for (int n = 0; n < 2; ++n) {
                        bf16_t* rp = g + (size_t)row * 2048 + u.pn * 256 + bj * 128 + wc * 32 + n * 16 + 4 * fq;
                        const u32x2 gg = *(const u32x2*)(rp + (u.z ? 1024 : 0));
                        const f32x4 a = acc[ai][bj][m][n];
                        float o0 = __uint_as_float(gg.x << 16) * a[0], o1 = __uint_as_float(gg.x & 0xffff0000u) * a[1];
                        float o2 = __uint_as_float(gg.y << 16) * a[2], o3 = __uint_as_float(gg.y & 0xffff0000u) * a[3];
                        if (u.z) { const u32x2 pr = *(const u32x2*)rp; o0 += __uint_as_float(pr.x << 16); o1 += __uint_as_float(pr.x & 0xffff0000u); o2 += __uint_as_float(pr.y << 16); o3 += __uint_as_float(pr.y & 0xffff0000u); }
                        u32x2 w; w.x = pk2(o0, o1); w.y = pk2(o2, o3);
                        *(u32x2*)rp = w;
                    }
            }
    }
};
__device__ __forceinline__ void phase_up(const Params& P, LDSP unsigned char* lds, int vcu, int G) {
    pg8::Sched S; S.A0 = (const bf16_t*)(P.ws + OFF_R0); S.A1 = (const bf16_t*)(P.ws + OFF_R0 + 32 * MiB);
    S.B0 = (const bf16_t*)(P.ws + OFF_WUPA_T); S.B1 = (const bf16_t*)(P.ws + OFF_WUPB_T);
    S.lda = 512; S.ldb = 512; S.K = 512; S.nM = T / 256; S.nN = DM / 256; S.NZ = 2; S.G = G; S.c = blockIdx.x;
    EpiUp E{&P};
    pg8::gemm_phase(lds, S, E);
}

struct EpiOut {
    const Params* P;
    __device__ __forceinline__ void operator()(f32x4 (&acc)[2][2][4][2], const pg8::Unit& u, int wr, int wc, int fr, int fq) const {
        bf16_t* x1b = (bf16_t*)(P->ws + OFF_R0);
        float* rs2 = (float*)(P->ws + OFF_RS2);
        const float* x = P->in[I_X];
#pragma unroll
        for (int ai = 0; ai < 2; ++ai)
#pragma unroll
            for (int m = 0; m < 4; ++m) {
                const int row = u.pm * 256 + ai * 128 + wr * 64 + m * 16 + fr;
                float ss = 0.f;
#pragma unroll
                for (int bj = 0; bj < 2; ++bj)
#pragma unroll
                    for (int n = 0; n < 2; ++n) {
                        const size_t off = (size_t)row * DM + u.pn * 256 + bj * 128 + wc * 32 + n * 16 + 4 * fq;
                        const f32x4 o = *(const f32x4*)(x + off) + acc[ai][bj][m][n];
                        *(f32x4*)(P->out + off) = o;
                        u32x2 w; w.x = pk2(o.x, o.y); w.y = pk2(o.z, o.w);
                        *(u32x2*)(x1b + off) = w;
                        ss += (o.x * o.x + o.y * o.y) + (o.z * o.z + o.w * o.w);
                    }
                ss += __shfl_xor(ss, 16); ss += __shfl_xor(ss, 32);
                if (fq == 0) atomicAdd(rs2 + row, ss);
            }
    }
};
__device__ __forceinline__ void phase_out(const Params& P, LDSP unsigned char* lds, int vcu, int G) {
    pg8::Sched S; S.A0 = S.A1 = (const bf16_t*)(P.ws + OFF_R3); S.B0 = S.B1 = (const bf16_t*)(P.ws + OFF_WOUT_T);
    S.lda = 2048; S.ldb = DM; S.K = DM; S.nM = T / 256; S.nN = DM / 256; S.NZ = 1; S.G = G; S.c = blockIdx.x;
    EpiOut E{&P};
    pg8::gemm_phase(lds, S, E);
}

struct EpiPq {
    const Params* P;
    __device__ __forceinline__ void operator()(f32x4 (&acc)[2][2][4][2], const pg8::Unit& u, int wr, int wc, int fr, int fq) const {
        bf16_t* qp = (bf16_t*)(P->ws + OFF_R1);
        const float* rs2 = (const float*)(P->ws + OFF_RS2);
#pragma unroll
        for (int ai = 0; ai < 2; ++ai)
#pragma unroll
            for (int m = 0; m < 4; ++m) {
                const int row = u.pm * 256 + ai * 128 + wr * 64 + m * 16 + fr;
                const float r = 1.0f / sqrtf(rs2[row] * (1.0f / DM) + NORM_EPS);
#pragma unroll
                for (int bj = 0; bj < 2; ++bj)
#pragma unroll
                    for (int n = 0; n < 2; ++n) {
                        const f32x4 a = acc[ai][bj][m][n];
                        u32x2 w; w.x = pk2(a[0] * r, a[1] * r); w.y = pk2(a[2] * r, a[3] * r);
                        *(u32x2*)(qp + (size_t)row * 2048 + u.pn * 256 + bj * 128 + wc * 32 + n * 16 + 4 * fq) = w;
                    }
            }
    }
};
__device__ __forceinline__ void phase_pq(const Params& P, LDSP unsigned char* lds, int vcu, int G) {
    pg8::Sched S; S.A0 = S.A1 = (const bf16_t*)(P.ws + OFF_R0); S.B0 = S.B1 = (const bf16_t*)(P.ws + OFF_WPQ_T);
    S.lda = DM; S.ldb = DM; S.K = DM; S.nM = T / 256; S.nN = 2048 / 256; S.NZ = 1; S.G = G; S.c = blockIdx.x;
    EpiPq E{&P};
    pg8::gemm_phase(lds, S, E);
}

__device__ __forceinline__ unsigned f2ord(float f) { const unsigned u = __float_as_uint(f); return u ^ ((unsigned)((int)u >> 31) | 0x80000000u); }
__device__ __forceinline__ float ord2f(unsigned o) { const unsigned u = (o & 0x80000000u) ? (o ^ 0x80000000u) : ~o; return __uint_as_float(u); }
__device__ __forceinline__ void ins16(unsigned (&top)[16], unsigned x) {
#pragma unroll
    for (int j = 0; j < 16; ++j) { const unsigned t = max(x, top[j]); x = min(x, top[j]); top[j] = t; }
}
__device__ __forceinline__ int crow(int r, int hi) { return (r & 3) + 8 * (r >> 2) + 4 * hi; }
__device__ __forceinline__ void ce_desc(unsigned& a, unsigned& b) { const unsigned hi_ = max(a, b), lo_ = min(a, b); a = hi_; b = lo_; }
__device__ __forceinline__ void bitonic_merge16_desc(unsigned (&a)[16]) {
#pragma unroll
    for (int j = 8; j > 0; j >>= 1)
#pragma unroll
        for (int i = 0; i < 16; ++i) { const int l = i ^ j; if (l > i) ce_desc(a[i], a[l]); }
}
__device__ __forceinline__ void sort16_desc(unsigned (&a)[16]) {
#pragma unroll
    for (int k = 2; k <= 16; k <<= 1)
#pragma unroll
        for (int j = k >> 1; j > 0; j >>= 1)
#pragma unroll
            for (int i = 0; i < 16; ++i) { const int l = i ^ j; if (l > i) { if ((i & k) == 0) ce_desc(a[i], a[l]); else ce_desc(a[l], a[i]); } }
}
__device__ __forceinline__ void merge_top16(unsigned (&top)[16], const unsigned (&blk)[16]) {
#pragma unroll
    for (int i = 0; i < 16; ++i) top[i] = max(top[i], blk[15 - i]);
    bitonic_merge16_desc(top);
}
constexpr int cand_prefix(int i) { int n = 0; for (int a = 0; a < i; ++a) n += 16 / (a + 1); return n; }

constexpr int P8_KOFF = 0, P8_IDX = 65536;
__device__ __forceinline__ void phase_topk(const Params& P, LDSP unsigned char* lds, int vcu, int G) {
    unsigned char* ws = P.ws;
    const bf16_t* qp = (const bf16_t*)(ws + OFF_R1);
    int* experts = (int*)(ws + OFF_EXPERTS);
    float* gates = (float*)(ws + OFF_GATES);
    const int tid = opaque_tid(), lane = tid & 63, wave = tid >> 6, r32 = lane & 31, hi = lane >> 5;
    __syncthreads();
    for (int i = tid; i < 2 * 128 * 16; i += NTHREADS) {
        const int w = i >> 11, row = (i >> 4) & 127, ch = i & 15;
        const u32x4 v = *(const u32x4*)((const bf16_t*)(ws + (w ? OFF_K2B : OFF_K1B)) + row * 128 + ch * 8);
        *(LDSP u32x4*)(lds + P8_KOFF + w * 32768 + row * 256 + ((ch ^ (row & 15)) << 4)) = v;
    }
    __syncthreads();
    LDSP unsigned char* myidx = lds + P8_IDX + (wave * 64 + lane) * 32;
    const int gw = vcu * NWAVES + wave, NGW = G * NWAVES;
    for (int item = gw; item < (T / 32) * 8; item += NGW) {
        const int tg = item >> 3, h = item & 7;
        const int tok = tg * 32 + r32;
        unsigned tops[2][16];
#pragma unroll
        for (int L = 0; L < 2; ++L) {
            bf16x8 qf[8];
            const bf16_t* qrow = qp + (size_t)tok * 2048 + h * 256 + L * 128 + hi * 8;
#pragma unroll
            for (int s8 = 0; s8 < 8; ++s8) qf[s8] = *(const bf16x8*)(qrow + s8 * 16);
            unsigned top[16];
#pragma unroll
            for (int kb = 0; kb < 4; ++kb) {
                f32x16 acc = {0.f, 0.f, 0.f, 0.f, 0.f, 0.f, 0.f, 0.f, 0.f, 0.f, 0.f, 0.f, 0.f, 0.f, 0.f, 0.f};
                const int row = kb * 32 + r32;
#pragma unroll
                for (int s8 = 0; s8 < 8; ++s8) {
                    const bf16x8 kf = *(const LDSP bf16x8*)(lds + P8_KOFF + L * 32768 + row * 256 + (((2 * s8 + hi) ^ (row & 15)) << 4));
                    acc = __builtin_amdgcn_mfma_f32_32x32x16_bf16(kf, qf[s8], acc, 0, 0, 0);
                }
                unsigned blk[16];
#pragma unroll
                for (int r = 0; r < 16; ++r) {
                    const int key = kb * 32 + (r & 3) + 8 * (r >> 2) + 4 * hi;
                    blk[r] = (f2ord(acc[r]) & ~0x7Fu) | (unsigned)(127 - key);
                }
                sort16_desc(blk);
                if (kb == 0) {
#pragma unroll
                    for (int j = 0; j < 16; ++j) top[j] = blk[j];
                } else merge_top16(top, blk);
            }
            unsigned oth[16];
#pragma unroll
            for (int j = 0; j < 16; ++j) oth[j] = (unsigned)__shfl_xor((int)top[j], 32);
            merge_top16(top, oth);
#pragma unroll
            for (int j = 0; j < 16; ++j) tops[L][j] = top[j];
        }
        float v1[16], v2[16];
#pragma unroll
        for (int j = 0; j < 16; j += 4) {
            unsigned w1 = 0, w2 = 0;
#pragma unroll
            for (int q = 0; q < 4; ++q) { w1 |= (127u - (tops[0][j + q] & 127u)) << (8 * q); w2 |= (127u - (tops[1][j + q] & 127u)) << (8 * q); }
            *(LDSP unsigned*)(myidx + j) = w1; *(LDSP unsigned*)(myidx + 16 + j) = w2;
        }
#pragma unroll
        for (int j = 0; j < 16; ++j) { v1[j] = ord2f(tops[0][j] & ~0x7Fu); v2[j] = ord2f(tops[1][j] & ~0x7Fu); }
        unsigned ct[16];
        {
            unsigned cand[64];
#pragma unroll
            for (int n = 0; n < 64; ++n) cand[n] = 0u;
#pragma unroll
            for (int i = 0; i < 16; ++i)
#pragma unroll
                for (int j = 0; j < 16; ++j)
                    if ((i + 1) * (j + 1) <= 16) cand[cand_prefix(i) + j] = (f2ord(v1[i] + v2[j]) & ~0xFFu) | (unsigned)(255 - (i * 16 + j));
#pragma unroll
            for (int bk = 0; bk < 4; ++bk) {
                unsigned blk[16];
#pragma unroll
                for (int r = 0; r < 16; ++r) blk[r] = cand[bk * 16 + r];
                sort16_desc(blk);
                if (bk == 0) {
#pragma unroll
                    for (int j = 0; j < 16; ++j) ct[j] = blk[j];
                } else merge_top16(ct, blk);
            }
        }
        float vals[16], ssum = 0.f;
        const float vmax = ord2f(ct[0] & ~0xFFu);
#pragma unroll
        for (int k = 0; k < 16; ++k) { vals[k] = __expf(ord2f(ct[k] & ~0xFFu) - vmax); ssum += vals[k]; }
        const float inv = 1.0f / ssum;
        asm volatile("s_waitcnt lgkmcnt(0)" ::: "memory");
        if (hi == 0) {
            int* ep = experts + (size_t)tok * 128 + h * 16;
            float* gp = gates + (size_t)tok * 128 + h * 16;
#pragma unroll
            for (int k = 0; k < 16; k += 4) {
                int e4[4];
#pragma unroll
                for (int q = 0; q < 4; ++q) {
                    const unsigned flat = 255u - (ct[k + q] & 255u);
                    const int i1 = myidx[flat >> 4], i2 = myidx[16 + (flat & 15)];
                    e4[q] = i1 * 128 + i2;
                }
                *(u32x4*)(ep + k) = (u32x4){(unsigned)e4[0], (unsigned)e4[1], (unsigned)e4[2], (unsigned)e4[3]};
                *(f32x4*)(gp + k) = (f32x4){vals[k] * inv, vals[k + 1] * inv, vals[k + 2] * inv, vals[k + 3] * inv};
            }
        }
        asm volatile("s_waitcnt lgkmcnt(0)" ::: "memory");
    }
}

__device__ __forceinline__ void cvt16_fp8(const u32x4 w, float (&f)[16]) {
#pragma unroll
    for (int q = 0; q < 4; ++q) {
        const f32x2 lo = __builtin_amdgcn_cvt_pk_f32_fp8((int)w[q], false), hi = __builtin_amdgcn_cvt_pk_f32_fp8((int)w[q], true);
        f[4 * q] = lo.x; f[4 * q + 1] = lo.y; f[4 * q + 2] = hi.x; f[4 * q + 3] = hi.y;
    }
}
__device__ __forceinline__ void peer_slice_map(const Params& P, LDSP unsigned char* lds, int vcu, int G, int wave, int& slice, int& wslot, int& nslot) {
    volatile LDSP unsigned* bst = (volatile LDSP unsigned*)(lds + LDS_BYTES - 16);
    LDSP unsigned* info = (LDSP unsigned*)(lds + LDS_BYTES - 64);
    __syncthreads();
    if (threadIdx.x == 0) {
        unsigned* bar = (unsigned*)(P.ws + 16384);
        const unsigned x = (unsigned)__builtin_amdgcn_s_getreg((3 << 11) | 20) & 0xFu;
        bool ok = true; unsigned sum = 0, mine = 0;
        for (unsigned j = 0; j < 16; ++j) { const unsigned c = __hip_atomic_load(&bar[256 + 64 * j], __ATOMIC_RELAXED, __HIP_MEMORY_SCOPE_AGENT); sum += c; if (j < 8 && c == 0) ok = false; if (j >= 8 && c != 0) ok = false; if (j == x) mine = c; }
        ok = ok && (sum == (unsigned)G) && (bst[2] < mine);
        info[0] = ok ? 1u : 0u; info[1] = x; info[2] = mine; info[3] = bst[2];
    }
    __syncthreads();
    if (info[0]) { slice = (int)info[1]; wslot = (int)info[3] * NWAVES + wave; nslot = (int)info[2] * NWAVES; }
    else if ((G & 7) == 0) { slice = vcu / (G >> 3); wslot = (vcu % (G >> 3)) * NWAVES + wave; nslot = (G >> 3) * NWAVES; }
    else { slice = -1; wslot = vcu * NWAVES + wave; nslot = G * NWAVES; }
}
struct PeerMetaA { int eA, eB; u32x4 h0, h1; };
struct PeerMetaB { int eA, eB; float aA, aB; };
#define PEER_IDX(m, j) __shfl(((j) < 8) ? (m).eA : (m).eB, (8 * (j) + grp) & 63)
__device__ __forceinline__ float dpp_xor1(float v) { return __builtin_bit_cast(float, __builtin_amdgcn_mov_dpp(__builtin_bit_cast(int, v), 0xB1, 0xF, 0xF, true)); }
__device__ __forceinline__ float dpp_xor2(float v) { return __builtin_bit_cast(float, __builtin_amdgcn_mov_dpp(__builtin_bit_cast(int, v), 0x4E, 0xF, 0xF, true)); }
__device__ __forceinline__ float dpp_hmirror(float v) { return __builtin_bit_cast(float, __builtin_amdgcn_mov_dpp(__builtin_bit_cast(int, v), 0x141, 0xF, 0xF, true)); }
__device__ __forceinline__ float dpp_ror8(float v) { return __builtin_bit_cast(float, __builtin_amdgcn_mov_dpp(__builtin_bit_cast(int, v), 0x128, 0xF, 0xF, true)); }
__device__ __forceinline__ float swap32_sum(float X, float Y) {
    const auto r = __builtin_amdgcn_permlane32_swap(__float_as_uint(X), __float_as_uint(Y), false, false);
    return __uint_as_float(r[0]) + __uint_as_float(r[1]);
}
__device__ __forceinline__ float swap16_sum(float X, float Y) {
    const auto r = __builtin_amdgcn_permlane16_swap(__float_as_uint(X), __float_as_uint(Y), false, false);
    return __uint_as_float(r[0]) + __uint_as_float(r[1]);
}
__device__ __forceinline__ void cvt16_fp8_pk(const u32x4 w, f32x2 (&f)[8]) {
#pragma unroll
    for (int q = 0; q < 4; ++q) { f[2 * q] = __builtin_amdgcn_cvt_pk_f32_fp8((int)w[q], false); f[2 * q + 1] = __builtin_amdgcn_cvt_pk_f32_fp8((int)w[q], true); }
}
__device__ __forceinline__ void phase_peer_a(const Params& P, LDSP unsigned char* lds, int vcu, int G) {
    unsigned char* ws = P.ws;
    const bf16_t* x1b = (const bf16_t*)(ws + OFF_R0);
    const unsigned char* U8 = ws + OFF_U;
    const int* experts = (const int*)(ws + OFF_EXPERTS);
    float* apart = (float*)(ws + OFF_R1);
    const int tid = opaque_tid(), lane = tid & 63, wave = tid >> 6, grp = lane >> 3, sub = lane & 7;
    const bool b2 = lane & 4, b1 = lane & 2, b0 = lane & 1;
    int slice, wslot, nslot;
    peer_slice_map(P, lds, vcu, G, wave, slice, wslot, nslot);
    const int nitems = (slice >= 0) ? T : T * 8;
#define PA_T(it) ((slice >= 0) ? (it) : ((it) >> 3))
#define PA_X(it) ((slice >= 0) ? slice : ((it) & 7))
#define PA_META(m, it) do { const int it_ = ((it) < nitems) ? (it) : wslot; { const int t_ = PA_T(it_), x_ = PA_X(it_); \
        (m).eA = experts[(size_t)t_ * 128 + lane]; (m).eB = experts[(size_t)t_ * 128 + 64 + lane]; \
        (m).h0 = *(const u32x4*)(x1b + (size_t)t_ * DM + 128 * x_ + 16 * sub); (m).h1 = *(const u32x4*)(x1b + (size_t)t_ * DM + 128 * x_ + 16 * sub + 8); } } while (0)
#define PA_GATHER(R, m, it, J0) do { const int x_ = PA_X(it); _Pragma("unroll") for (int j = 0; j < 8; ++j) { const int e_ = PEER_IDX(m, (J0) + j); \
        (R)[j] = *(const u32x4*)(U8 + ((size_t)x_ * PEER_NE + e_) * 128 + 16 * sub); } } while (0)
#define PA_COMPUTE(R, J0) do { _Pragma("unroll") for (int j = 0; j < 8; ++j) { f32x2 f[8]; asm volatile("" : "+v"((R)[j])); cvt16_fp8_pk((R)[j], f); f32x2 sd = f[0] * h2[0]; \
        _Pragma("unroll") for (int i = 1; i < 8; ++i) sd = __builtin_elementwise_fma(f[i], h2[i], sd); part[(J0) + j] = sd.x + sd.y; asm volatile("" : "+v"(part[(J0) + j])); } } while (0)
    PeerMetaA m0, m1, m2;
    m0.eA = m0.eB = m1.eA = m1.eB = m2.eA = m2.eB = 0; m0.h0 = m0.h1 = m1.h0 = m1.h1 = m2.h0 = m2.h1 = (u32x4){0u, 0u, 0u, 0u};
    u32x4 R0[8], R1[8];
    PA_META(m0, wslot); PA_META(m1, wslot + nslot);
    if (wslot >= nitems) return;
    PA_GATHER(R0, m0, wslot, 0); PA_GATHER(R1, m0, wslot, 8);
#pragma unroll 1
    for (int it = wslot; it < nitems; it += nslot) {
        PA_META(m2, it + 2 * nslot);
        f32x2 h2[8]; float part[16];
        { float f[8]; cvt8(m0.h0, f);
#pragma unroll
          for (int i = 0; i < 4; ++i) h2[i] = (f32x2){f[2 * i], f[2 * i + 1]};
          cvt8(m0.h1, f);
#pragma unroll
          for (int i = 0; i < 4; ++i) h2[4 + i] = (f32x2){f[2 * i], f[2 * i + 1]}; }
        PA_COMPUTE(R0, 0);
        const int itn = (it + nslot < nitems) ? it + nslot : it;
        PA_GATHER(R0, m1, itn, 0);
        PA_COMPUTE(R1, 8);
        PA_GATHER(R1, m1, itn, 8);
        float q8[8], q4[4], q2[2];
#pragma unroll
        for (int i = 0; i < 8; ++i) { const float send = b2 ? part[i] : part[i + 8], keep = b2 ? part[i + 8] : part[i]; q8[i] = keep + dpp_hmirror(send); }
#pragma unroll
        for (int i = 0; i < 4; ++i) { const float send = b1 ? q8[i] : q8[i + 4], keep = b1 ? q8[i + 4] : q8[i]; q4[i] = keep + dpp_xor2(send); }
#pragma unroll
        for (int i = 0; i < 2; ++i) { const float send = b0 ? q4[i] : q4[i + 2], keep = b0 ? q4[i + 2] : q4[i]; q2[i] = keep + dpp_xor1(send); }
        float* ap = apart + ((size_t)PA_X(it) * T + PA_T(it)) * 128 + lane;
        ap[0] = q2[0]; ap[64] = q2[1];
        m0 = m1; m1 = m2;
    }
#undef PA_META
#undef PA_GATHER
#undef PA_COMPUTE
}
__device__ __forceinline__ void phase_peer_w(const Params& P, LDSP unsigned char* lds, int vcu, int G) {
    unsigned char* ws = P.ws;
    float* gates = (float*)(ws + OFF_GATES);
    const float* rs2 = (const float*)(ws + OFF_RS2);
    const float* apart = (const float*)(ws + OFF_R1);
    const size_t gt = (size_t)(vcu * NTHREADS + threadIdx.x), NGT = (size_t)G * NTHREADS;
    for (size_t i = gt; i < (size_t)T * 128; i += NGT) {
        const int t = (int)(i >> 7), k = (int)(i & 127);
        const int sub = k >> 4, s1 = (k >> 3) & 1, grp = k & 7, idx = s1 * 64 + grp * 8 + sub;
        float a = 0.f;
#pragma unroll
        for (int xs = 0; xs < 8; ++xs) a += apart[((size_t)xs * T + t) * 128 + idx];
        const float rs = (1.0f / PEER_US) / sqrtf(rs2[t] * (1.0f / DM) + NORM_EPS);
        gates[i] = gelu_tanh(a * rs) * gates[i] * (1.0f / PEER_VS);
    }
}
__device__ __forceinline__ void phase_peer_b(const Params& P, LDSP unsigned char* lds, int vcu, int G) {
    unsigned char* ws = P.ws;
    const unsigned char* V8 = ws + OFF_V;
    const int* experts = (const int*)(ws + OFF_EXPERTS);
    const float* wtok = (const float*)(ws + OFF_GATES);
    const int tid = opaque_tid(), lane = tid & 63, wave = tid >> 6, grp = lane >> 3, sub = lane & 7;
    const bool b3 = lane & 8;
    const int k0 = 16 * sub + grp, k1 = k0 + 8;
    LDSP float* wbuf = (LDSP float*)(lds + wave * 1024);
    int slice, wslot, nslot;
    peer_slice_map(P, lds, vcu, G, wave, slice, wslot, nslot);
    const int nitems = (slice >= 0) ? T : T * 8;
#define PB_META(m, it) do { const int it_ = ((it) < nitems) ? (it) : wslot; { const int t_ = PA_T(it_); \
        (m).eA = experts[(size_t)t_ * 128 + lane]; (m).eB = experts[(size_t)t_ * 128 + 64 + lane]; \
        (m).aA = wtok[(size_t)t_ * 128 + k0]; (m).aB = wtok[(size_t)t_ * 128 + k1]; } } while (0)
#define PB_GATHER(R, m, it, J0) do { const int x_ = PA_X(it); _Pragma("unroll") for (int j = 0; j < 8; ++j) { const int e_ = PEER_IDX(m, (J0) + j); \
        (R)[j] = *(const u32x4*)(V8 + ((size_t)x_ * PEER_NE + e_) * 128 + 16 * sub); } } while (0)
#define PB_COMPUTE(R, J0) do { _Pragma("unroll") for (int j = 0; j < 8; ++j) { f32x2 f[8]; asm volatile("" : "+v"((R)[j])); cvt16_fp8_pk((R)[j], f); const float wk = wb[8 * ((J0) + j) + grp]; const f32x2 wk2 = {wk, wk}; \
        _Pragma("unroll") for (int i = 0; i < 8; ++i) acc2[i] = __builtin_elementwise_fma(wk2, f[i], acc2[i]); \
        asm volatile("" : "+v"(acc2[0]), "+v"(acc2[1]), "+v"(acc2[2]), "+v"(acc2[3]), "+v"(acc2[4]), "+v"(acc2[5]), "+v"(acc2[6]), "+v"(acc2[7])); } } while (0)
    PeerMetaB m0, m1, m2;
    m0.eA = m0.eB = m1.eA = m1.eB = m2.eA = m2.eB = 0; m0.aA = m0.aB = m1.aA = m1.aB = m2.aA = m2.aB = 0.f;
    u32x4 R0[8], R1[8];
    PB_META(m0, wslot); PB_META(m1, wslot + nslot);
    if (wslot >= nitems) return;
    PB_GATHER(R0, m0, wslot, 0); PB_GATHER(R1, m0, wslot, 8);
    int par = 0;
#pragma unroll 1
    for (int it = wslot; it < nitems; it += nslot) {
        PB_META(m2, it + 2 * nslot);
        LDSP float* wb = wbuf + par * 128; par ^= 1;
        wb[k0] = m0.aA; wb[k1] = m0.aB;
        asm volatile("s_waitcnt lgkmcnt(0)" ::: "memory");
        f32x2 acc2[8];
#pragma unroll
        for (int i = 0; i < 8; ++i) acc2[i] = (f32x2){0.f, 0.f};
        PB_COMPUTE(R0, 0);
        const int itn = (it + nslot < nitems) ? it + nslot : it;
        PB_GATHER(R0, m1, itn, 0);
        PB_COMPUTE(R1, 8);
        PB_GATHER(R1, m1, itn, 8);
        float acc[16];
#pragma unroll
        for (int i = 0; i < 8; ++i) { acc[2 * i] = acc2[i].x; acc[2 * i + 1] = acc2[i].y; }
        float q8[8], q4[4], q2[2];
#pragma unroll
        for (int i = 0; i < 8; ++i) q8[i] = swap32_sum(acc[i], acc[i + 8]);
#pragma unroll
        for (int i = 0; i < 4; ++i) q4[i] = swap16_sum(q8[i], q8[i + 4]);
#pragma unroll
        for (int i = 0; i < 2; ++i) { const float send = b3 ? q4[i] : q4[i + 2], keep = b3 ? q4[i + 2] : q4[i]; q2[i] = keep + dpp_ror8(send); }
        const int c16 = ((lane & 32) ? 8 : 0) + ((lane & 16) ? 4 : 0) + (b3 ? 2 : 0);
        float* op = P.out + (size_t)PA_T(it) * DM + 128 * PA_X(it) + 16 * sub + c16;
        f32x2 o = *(const f32x2*)op;
        o.x += q2[0]; o.y += q2[1];
        *(f32x2*)op = o;
        m0 = m1; m1 = m2;
    }
#undef PB_META
#undef PB_GATHER
#undef PB_COMPUTE
#undef PA_T
#undef PA_X
}

#ifndef SELFCHECK
#define SELFCHECK 0
#endif
#if SELFCHECK
constexpr size_t OFF_CHK = 512 * 1024;
__device__ __forceinline__ void wave_argmax(float& v, int& i) {
#pragma unroll
    for (int o = 1; o < 64; o <<= 1) {
        const float ov = __shfl_xor(v, o); const int oi = __shfl_xor(i, o);
        if (ov > v || (ov == v && oi < i)) { v = ov; i = oi; }
    }
}
struct NaiveAcc { float m, l; float o[64]; };
__device__ __forceinline__ float wave_max(float v) {
#pragma unroll
    for (int o = 1; o < 64; o <<= 1) v = fmaxf(v, __shfl_xor(v, o));
    return v;
}
__device__ __forceinline__ void nacc_reset(NaiveAcc& a) { a.m = -1.0e30f; a.l = 0.f;
#pragma unroll
    for (int d = 0; d < 64; ++d) a.o[d] = 0.f; }
__device__ __forceinline__ float dot64(LDSP const float* qs, const bf16_t* krow) {
    float s = 0.f;
#pragma unroll
    for (int c = 0; c < 8; ++c) { float f[8]; cvt8(*(const u32x4*)(krow + c * 8), f);
#pragma unroll
        for (int i = 0; i < 8; ++i) s += qs[c * 8 + i] * f[i]; }
    return s;
}
__device__ __forceinline__ void axpy64(NaiveAcc& a, float alpha, float p, const bf16_t* vrow) {
#pragma unroll
    for (int c = 0; c < 8; ++c) { float f[8]; cvt8(*(const u32x4*)(vrow + c * 8), f);
#pragma unroll
        for (int i = 0; i < 8; ++i) a.o[c * 8 + i] = a.o[c * 8 + i] * alpha + p * f[i]; }
}
__device__ __forceinline__ void naive_chunk(NaiveAcc& a, LDSP const float* qs, const bf16_t* krow, const bf16_t* vrow, bool valid) {
    float s = dot64(qs, krow);
    if (!valid) s = -INFINITY;
    const float mnew = fmaxf(a.m, wave_max(s));
    const float alpha = exp2f(a.m - mnew), p = valid ? exp2f(s - mnew) : 0.f;
    a.l = a.l * alpha + p; a.m = mnew;
    axpy64(a, alpha, p, vrow);
}
__device__ __forceinline__ float nacc_final(NaiveAcc& a, int lane) {
    const float l = wave_sum(a.l);
    const float inv = (l > 0.f) ? 1.0f / l : 0.f;
    const bool b5 = lane & 32, b4 = lane & 16, b3 = lane & 8, b2 = lane & 4, b1 = lane & 2, b0 = lane & 1;
    float q32[32], q16[16], q8[8], q4[4], q2[2];
#pragma unroll
    for (int i = 0; i < 32; ++i) { const float send = b5 ? a.o[i] : a.o[i + 32], keep = b5 ? a.o[i + 32] : a.o[i]; q32[i] = keep + __shfl_xor(send, 32); }
#pragma unroll
    for (int i = 0; i < 16; ++i) { const float send = b4 ? q32[i] : q32[i + 16], keep = b4 ? q32[i + 16] : q32[i]; q16[i] = keep + __shfl_xor(send, 16); }
#pragma unroll
    for (int i = 0; i < 8; ++i) { const float send = b3 ? q16[i] : q16[i + 8], keep = b3 ? q16[i + 8] : q16[i]; q8[i] = keep + __shfl_xor(send, 8); }
#pragma unroll
    for (int i = 0; i < 4; ++i) { const float send = b2 ? q8[i] : q8[i + 4], keep = b2 ? q8[i + 4] : q8[i]; q4[i] = keep + __shfl_xor(send, 4); }
#pragma unroll
    for (int i = 0; i < 2; ++i) { const float send = b1 ? q4[i] : q4[i + 2], keep = b1 ? q4[i + 2] : q4[i]; q2[i] = keep + __shfl_xor(send, 2); }
    const float send = b0 ? q2[0] : q2[1], keep = b0 ? q2[1] : q2[0];
    return (keep + __shfl_xor(send, 1)) * inv;
}
__device__ __forceinline__ float cmp_err(float ref, const bf16_t* got, int lane) {
    const float e = wave_max(fabsf(ref - bf2f(got[lane]))), mx = wave_max(fabsf(ref));
    return e / (mx + 1e-3f);
}
__device__ __forceinline__ void phase_selfcheck(const Params& P, LDSP unsigned char* lds, int vcu, int G) {
    unsigned char* ws = P.ws;
    const int tid = opaque_tid(), lane = tid & 63, wave = tid >> 6;
    const int gw = vcu * NWAVES + wave, NGW = G * NWAVES;
    unsigned* cnt = (unsigned*)(ws + OFF_CHK);
    const bf16_t* qa = (const bf16_t*)(ws + OFF_R1);
    const bf16_t* ka = (const bf16_t*)(ws + OFF_R1 + 32 * MiB);
    const bf16_t* va = (const bf16_t*)(ws + OFF_R1 + 64 * MiB);
    const bf16_t* qb = (const bf16_t*)(ws + OFF_R1 + 96 * MiB);
    const bf16_t* ya = (const bf16_t*)(ws + OFF_R0);
    const bf16_t* yb = (const bf16_t*)(ws + OFF_R0 + 32 * MiB);
    const float* kmean = (const float*)(ws + OFF_KMEAN);
    const float* bgate = (const float*)(ws + OFF_BGATE);
    LDSP float* psum = (LDSP float*)(lds + wave * 4096);
    LDSP float* qs = psum + 320;
    LDSP float* ocs = psum + 384;
    constexpr int NS = 537;
#pragma unroll 1
    for (int item = gw; item < NS * 8; item += NGW) {
        const int t = 37 + 61 * (item >> 3), h = item & 7, b = t >> 12, pos = t & (SEQ - 1), own = pos >> 8;
        qs[lane] = bf2f(qa[(size_t)t * 512 + h * 64 + lane]);
        asm volatile("s_waitcnt lgkmcnt(0)" ::: "memory");
        float g0 = -INFINITY, g1 = -INFINITY, g2 = -INFINITY; int i0 = -1, i1 = -1, i2 = -1;
#pragma unroll 1
        for (int j = 0; j < own; ++j) {
            const float* km = kmean + (size_t)((b * 8 + h) * 16 + j) * 64;
            float d = 0.f;
#pragma unroll 8
            for (int i = 0; i < 64; ++i) d += qs[i] * km[i];
            if (d > g0) { g2 = g1; i2 = i1; g1 = g0; i1 = i0; g0 = d; i0 = j; }
            else if (d > g1) { g2 = g1; i2 = i1; g1 = d; i1 = j; }
            else if (d > g2) { g2 = d; i2 = j; }
        }
        NaiveAcc a; nacc_reset(a);
#pragma unroll 1
        for (int j = 0; j <= own; ++j) {
            if (j < own && j != i0 && j != i1 && j != i2) continue;
#pragma unroll 1
            for (int ck = 0; ck < 4; ++ck) {
                const int kp = j * 256 + ck * 64 + lane;
                const size_t kr = (size_t)(b * SEQ + kp) * 512 + h * 64;
                naive_chunk(a, qs, ka + kr, va + kr, kp <= pos);
            }
        }
        const float om = nacc_final(a, lane);
        const float e = cmp_err(om, ya + (size_t)t * 512 + h * 64, lane);
        if (lane == 0 && !(e < 0.05f)) atomicAdd(cnt + 0, 1u);
        asm volatile("s_waitcnt lgkmcnt(0)" ::: "memory");
    }
#pragma unroll 1
    for (int item = gw; item < NS * 2; item += NGW) {
        const int t = 37 + 61 * (item >> 1), g = item & 1, b = t >> 12, pos = t & (SEQ - 1), own = pos >> 6;
        const bf16_t* kc = (const bf16_t*)(ws + OFF_KC) + (size_t)(b * 2 + g) * 256 * 64;
        const bf16_t* vc = (const bf16_t*)(ws + OFF_VC) + (size_t)(b * 2 + g) * 256 * 64;
        const bf16_t* ks = (const bf16_t*)(ws + OFF_R2 + 16 * MiB) + (size_t)(b * SEQ) * 128 + g * 64;
        const bf16_t* vs = (const bf16_t*)(ws + OFF_R2 + 24 * MiB) + (size_t)(b * SEQ) * 128 + g * 64;
        const bf16_t* kw = (const bf16_t*)(ws + OFF_R2 + 32 * MiB) + (size_t)(b * SEQ) * 128 + g * 64;
        const bf16_t* vw = (const bf16_t*)(ws + OFF_R2 + 40 * MiB) + (size_t)(b * SEQ) * 128 + g * 64;
        for (int i = lane; i < 320; i += 64) psum[i] = 0.f;
        asm volatile("s_waitcnt lgkmcnt(0)" ::: "memory");
        const int ncmp_vis = (pos >= 31) ? ((pos - 31) >> 4) + 1 : 0;
#pragma unroll 1
        for (int r = 0; r < 4; ++r) {
            qs[lane] = bf2f(qb[(size_t)t * 512 + (g * 4 + r) * 64 + lane]);
            asm volatile("s_waitcnt lgkmcnt(0)" ::: "memory");
            float mx = -INFINITY;
#pragma unroll 1
            for (int ck = 0; ck < 4; ++ck) { const int n = ck * 64 + lane;
                const float sdot = dot64(qs, kc + (size_t)n * 64);
                mx = fmaxf(mx, (n < ncmp_vis) ? sdot : -INFINITY); }
            mx = wave_max(mx);
            float l = 0.f;
#pragma unroll 1
            for (int ck = 0; ck < 4; ++ck) { const int n = ck * 64 + lane;
                const float sdot = dot64(qs, kc + (size_t)n * 64);
                l += (n < ncmp_vis) ? exp2f(sdot - mx) : 0.f; }
            l = wave_sum(l);
            const float inv = (l > 0.f) ? 1.0f / l : 0.f;
            NaiveAcc a; nacc_reset(a);
#pragma unroll 1
            for (int ck = 0; ck < 4; ++ck) { const int n = ck * 64 + lane;
                const float sdot = dot64(qs, kc + (size_t)n * 64);
                const float pr = (n < ncmp_vis) ? exp2f(sdot - mx) * inv : 0.f;
                psum[n] += pr;
                axpy64(a, 1.0f, pr, vc + (size_t)n * 64); }
            a.l = (lane == 0) ? 1.f : 0.f;
            ocs[r * 64 + lane] = nacc_final(a, lane);
            asm volatile("s_waitcnt lgkmcnt(0)" ::: "memory");
        }
        {
            const int j = lane;
            float imp = 0.f;
            for (int n = 4 * j - 1; n <= 4 * j + 3; ++n) if (n >= 0 && n < 255) imp += psum[n];
            if (j == 0 || j == own || j == own - 1) imp = 1.0e30f;
            if (j > own) imp = -1.0e30f;
            unsigned long long sel = 0ull;
#pragma unroll 1
            for (int r = 0; r < 16; ++r) {
                float v = imp; int i = j;
                wave_argmax(v, i);
                if (v > -0.5e30f) sel |= 1ull << i;
                if (i == j) imp = -3.0e38f;
            }
            psum[256] = __uint_as_float((unsigned)sel); psum[257] = __uint_as_float((unsigned)(sel >> 32));
            asm volatile("s_waitcnt lgkmcnt(0)" ::: "memory");
        }
        const unsigned long long sel = ((unsigned long long)__float_as_uint(psum[257]) << 32) | __float_as_uint(psum[256]);
#pragma unroll 1
        for (int r = 0; r < 4; ++r) {
            const int head = g * 4 + r;
            qs[lane] = bf2f(qb[(size_t)t * 512 + head * 64 + lane]);
            asm volatile("s_waitcnt lgkmcnt(0)" ::: "memory");
            const float gt0 = bgate[(size_t)t * 24 + head * 3], gt1 = bgate[(size_t)t * 24 + head * 3 + 1], gt2 = bgate[(size_t)t * 24 + head * 3 + 2];
            float y = gt0 * ocs[r * 64 + lane];
            NaiveAcc a; nacc_reset(a);
#pragma unroll 1
            for (int j = 0; j <= own; ++j) {
                if (!((sel >> j) & 1ull)) continue;
                const int kp = j * 64 + lane;
                naive_chunk(a, qs, ks + (size_t)kp * 128, vs + (size_t)kp * 128, kp <= pos);
            }
            y += gt1 * nacc_final(a, lane);
            nacc_reset(a);
#pragma unroll 1
            for (int ck = 0; ck < 9; ++ck) {
                const int kp = pos - 575 + ck * 64 + lane;
                const bool valid = kp >= 0 && kp <= pos && kp > pos - 512;
                const int kpc = kp < 0 ? 0 : kp;
                naive_chunk(a, qs, kw + (size_t)kpc * 128, vw + (size_t)kpc * 128, valid);
            }
            y += gt2 * nacc_final(a, lane);
            const float e = cmp_err(y, yb + (size_t)t * 512 + head * 64, lane);
            if (lane == 0 && !(e < 0.05f)) atomicAdd(cnt + 1, 1u);
            asm volatile("s_waitcnt lgkmcnt(0)" ::: "memory");
        }
    }
}

__device__ __forceinline__ void phase_selfcheck2(const Params& P, LDSP unsigned char* lds, int vcu, int G) {
    unsigned char* ws = P.ws;
    const int tid = opaque_tid(), lane = tid & 63, wave = tid >> 6;
    const int gw = vcu * NWAVES + wave, NGW = G * NWAVES;
    unsigned* cnt = (unsigned*)(ws + OFF_CHK);
    LDSP float* hs = (LDSP float*)(lds + wave * 8192);
    const float* x = P.in[I_X]; const float* g1 = P.in[I_NORM1]; const float* w = P.in[I_WIN];
    constexpr int NS = 192, NGRP = 14;
#pragma unroll 1
    for (int item = gw; item < NS * NGRP; item += NGW) {
        const int si = item / NGRP, grp = item % NGRP;
        const int t = 11 + 167 * si, b = t >> 12, pos = t & (SEQ - 1);
        const int hsel = si & 7, gsel = si & 1;
        float ss = 0.f;
        for (int i = lane; i < DM; i += 64) { const float v = x[(size_t)t * DM + i]; ss += v * v; }
        ss = wave_sum(ss);
        const float rs = 1.0f / sqrtf(ss / DM + NORM_EPS);
        for (int i = lane; i < DM; i += 64) hs[i] = x[(size_t)t * DM + i] * rs * g1[i];
        asm volatile("s_waitcnt lgkmcnt(0)" ::: "memory");
        int col0, kind; const float* gain = nullptr; float oscale = 1.f; const bf16_t* got = nullptr; int ncols = 64;
        const bf16_t* R1 = (const bf16_t*)(ws + OFF_R1); const bf16_t* R2 = (const bf16_t*)(ws + OFF_R2); const bf16_t* R3 = (const bf16_t*)(ws + OFF_R3);
        const size_t M32 = (size_t)16 * 1024 * 1024;
        switch (grp) {
        case 0: col0 = hsel * 64;          kind = 1; gain = P.in[I_AQG]; oscale = QSCALE; got = R1 + (size_t)t * 512 + hsel * 64; break;
        case 1: col0 = 512 + hsel * 64;    kind = 1; gain = P.in[I_AKG]; got = R1 + M32 + (size_t)t * 512 + hsel * 64; break;
        case 2: col0 = 1024 + hsel * 64;   kind = 0; got = R1 + 2 * M32 + (size_t)t * 512 + hsel * 64; break;
        case 3: col0 = 1536 + hsel * 64;   kind = 1; gain = P.in[I_BQG]; oscale = QSCALE; got = R1 + 3 * M32 + (size_t)t * 512 + hsel * 64; break;
        case 4: col0 = 2048 + gsel * 64;   kind = 0; got = R2 + ((size_t)((b * 2 + gsel) * SEQ + pos)) * 64; break;
        case 5: col0 = 2176 + gsel * 64;   kind = 0; got = R2 + M32 / 4 + ((size_t)((b * 2 + gsel) * SEQ + pos)) * 64; break;
        case 6: col0 = 2304 + gsel * 64;   kind = 1; gain = P.in[I_BKSG]; got = R2 + 2 * (M32 / 4) + (size_t)t * 128 + gsel * 64; break;
        case 7: col0 = 2432 + gsel * 64;   kind = 0; got = R2 + 3 * (M32 / 4) + (size_t)t * 128 + gsel * 64; break;
        case 8: col0 = 2560 + gsel * 64;   kind = 1; gain = P.in[I_BKWG]; got = R2 + 4 * (M32 / 4) + (size_t)t * 128 + gsel * 64; break;
        case 9: col0 = 2688 + gsel * 64;   kind = 0; got = R2 + 5 * (M32 / 4) + (size_t)t * 128 + gsel * 64; break;
        case 10: col0 = 2840 + hsel * 64;        kind = 2; got = R3 + (size_t)t * 2048 + hsel * 64; break;
        case 11: col0 = 2840 + 1024 + hsel * 64; kind = 2; got = R3 + (size_t)t * 2048 + 1024 + hsel * 64; break;
        case 12: col0 = 2840 + 1024 + 512 + hsel * 64; kind = 2; got = R3 + (size_t)t * 2048 + 1536 + hsel * 64; break;
        default: col0 = 2816; kind = 3; ncols = 24; break;
        }
        if (grp == 10) continue;
        float acc = 0.f;
        if (lane < ncols) {
#pragma unroll 4
            for (int k = 0; k < DM; ++k) acc += hs[k] * w[(size_t)k * 4888 + col0 + lane];
        }
        float ref;
        if (kind == 1) {
            const float ssq = wave_sum(acc * acc);
            float y = acc / sqrtf(ssq / 64.0f + NORM_EPS) * gain[lane];
            const float ya_ = __shfl(y, (lane + 8) & 63), yb_ = __shfl(y, (lane - 8) & 63);
            const int f = lane & 7;
            const float ang = (float)pos * powf(500000.0f, -(float)(2 * f) / 16.0f);
            const float c = cosf(ang), sn = sinf(ang);
            if (lane < 8) y = y * c - ya_ * sn; else if (lane < 16) y = y * c + yb_ * sn;
            ref = y * oscale;
        } else if (kind == 2) {
            ref = 1.0f / (1.0f + expf(-(acc + P.in[I_BMERGE][col0 - 2840 + lane])));
        } else if (kind == 3) {
            ref = 1.0f / (1.0f + expf(-acc));
        } else ref = acc;
        float gotv;
        if (kind == 3) gotv = (lane < 24) ? ((const float*)(ws + OFF_BGATE))[(size_t)t * 24 + lane] : 0.f;
        else gotv = bf2f(got[lane]);
        if (kind == 3 && lane >= 24) ref = 0.f;
        const float e = wave_max(fabsf(ref - gotv)) / (wave_max(fabsf(ref)) + 1e-3f);
        if (lane == 0 && !(e < 0.03f)) atomicAdd(cnt + 0, 1u);
        asm volatile("s_waitcnt lgkmcnt(0)" ::: "memory");
    }
#pragma unroll 1
    for (int item = gw; item < 96 * 2; item += NGW) {
        const int si = item >> 1, kv = item & 1;
        const int slab = si & 15, n = (si * 37 + 3) % 255;
        const bf16_t* raw = (const bf16_t*)(ws + OFF_R2 + (size_t)kv * 8 * MiB) + (size_t)slab * SEQ * 64 + (size_t)n * 16 * 64;
        const float* posv = P.in[kv ? I_CPV : I_CPK]; const float* w1 = P.in[kv ? I_CVW1 : I_CKW1]; const float* b1 = P.in[kv ? I_CVB1 : I_CKB1];
        const float* w2 = P.in[kv ? I_CVW2 : I_CKW2]; const float* b2 = P.in[kv ? I_CVB2 : I_CKB2];
        float hacc[4] = {0.f, 0.f, 0.f, 0.f};
#pragma unroll 1
        for (int i = 0; i < 2048; ++i) {
            const float a = bf2f(raw[i]) + posv[i];
#pragma unroll
            for (int u = 0; u < 4; ++u) hacc[u] += a * w1[(size_t)i * 256 + lane + 64 * u];
        }
#pragma unroll
        for (int u = 0; u < 4; ++u) { const float z = hacc[u] + b1[lane + 64 * u]; hs[1024 + lane + 64 * u] = 0.5f * z * (1.0f + tanhf(0.7978845608028654f * (z + 0.044715f * z * z * z))); }
        asm volatile("s_waitcnt lgkmcnt(0)" ::: "memory");
        float o = b2[lane];
#pragma unroll 4
        for (int j = 0; j < 256; ++j) o += hs[1024 + j] * w2[(size_t)j * 64 + lane];
        if (!kv) { const float ssq = wave_sum(o * o); o = o / sqrtf(ssq / 64.0f + NORM_EPS) * P.in[I_BKCG][lane]; }
        const float gotv = bf2f(((const bf16_t*)(ws + (kv ? OFF_VC : OFF_KC)))[((size_t)slab * 256 + n) * 64 + lane]);
        const float e = wave_max(fabsf(o - gotv)) / (wave_max(fabsf(o)) + 1e-3f);
        if (lane == 0 && !(e < 0.03f)) atomicAdd(cnt + 1, 1u);
        asm volatile("s_waitcnt lgkmcnt(0)" ::: "memory");
    }
}
#endif

#define XB_TMO      128
#define XB_XCNT(j)  (256  + 64 * (j))
#define XB_XSUB(j)  (1280 + 64 * (j))
#define XB_XGEN(j)  (2304 + 64 * (j))
#define XB_TOP      3328
#define XB_TOPGEN   3392
#define XCD_BAR_WORDS 3456
#define XB_SPIN_CAP (1u << 22)
__device__ __forceinline__ unsigned xb_ld(unsigned* p)              { return __hip_atomic_load(p, __ATOMIC_RELAXED, __HIP_MEMORY_SCOPE_AGENT); }
__device__ __forceinline__ unsigned xb_add(unsigned* p, unsigned v) { return __hip_atomic_fetch_add(p, v, __ATOMIC_RELAXED, __HIP_MEMORY_SCOPE_AGENT); }
__device__ __forceinline__ unsigned xb_xcc_id() { return (unsigned)__builtin_amdgcn_s_getreg((3 << 11) | 20) & 0xFu; }
#define XB_SPIN(cond, bar) do { unsigned _sp = 0; while (cond) { __builtin_amdgcn_s_sleep(1); \
    if ((++_sp & 255u) == 0u) { if (xb_ld(&(bar)[XB_TMO])) break; if (_sp > XB_SPIN_CAP) { atomicAdd(&(bar)[XB_TMO], 1u); break; } } } } while (0)
struct XcdBarrier { unsigned* bar; unsigned x; volatile LDSP unsigned* st; };
__device__ __forceinline__ XcdBarrier xcd_barrier_post(unsigned* bar, volatile LDSP unsigned* st) {
    XcdBarrier b; b.bar = bar; b.x = xb_xcc_id(); b.st = st;
    if (threadIdx.x == 0) (void)xb_add(&bar[XB_XCNT(b.x)], 1u);
    return b;
}
__device__ __forceinline__ void xcd_barrier_complete(unsigned* bar, unsigned x, unsigned& nloc, unsigned& nx) {
    const unsigned G = gridDim.x * gridDim.y * gridDim.z;
    unsigned sum, cnt, mine, sp = 0u;
    for (;;) {
        sum = 0u; cnt = 0u; mine = 0u;
#pragma unroll
        for (unsigned j = 0; j < 16; ++j) { const unsigned c = xb_ld(&bar[XB_XCNT(j)]); sum += c; cnt += (c > 0u) ? 1u : 0u; mine = (j == x) ? c : mine; }
        if (sum == G) break;
        __builtin_amdgcn_s_sleep(1);
        if ((++sp & 255u) == 0u) { if (xb_ld(&bar[XB_TMO])) break; if (sp > XB_SPIN_CAP) { atomicAdd(&bar[XB_TMO], 1u); break; } }
    }
    nloc = mine > 0u ? mine : 1u; nx = cnt > 0u ? cnt : 1u;
}
__device__ __forceinline__ void xcd_barrier(const XcdBarrier& b) {
    asm volatile("s_waitcnt vmcnt(0)" ::: "memory");
    __syncthreads();
    if (threadIdx.x == 0) {
        unsigned* bar = b.bar;
        __builtin_amdgcn_s_waitcnt(0);
        unsigned nloc = b.st[0], nx = b.st[1];
        if (nloc == 0u) { xcd_barrier_complete(bar, b.x, nloc, nx); b.st[0] = nloc; b.st[1] = nx; }
        const unsigned old = xb_add(&bar[XB_XSUB(b.x)], 1u);
        const unsigned gen = old / nloc;
        if (old + 1u == (gen + 1u) * nloc) {
            __builtin_amdgcn_fence(__ATOMIC_RELEASE, "agent");
            asm volatile("s_waitcnt vmcnt(0)" ::: "memory");
            const unsigned og = xb_add(&bar[XB_TOP], 1u);
            const unsigned tg = og / nx;
            if (og + 1u == (tg + 1u) * nx) xb_add(&bar[XB_TOPGEN], 1u);
            else XB_SPIN(xb_ld(&bar[XB_TOPGEN]) == tg, bar);
            __builtin_amdgcn_fence(__ATOMIC_ACQUIRE, "agent");
            xb_add(&bar[XB_XGEN(b.x)], 1u);
            asm volatile("s_waitcnt vmcnt(0)" ::: "memory");
        } else {
            XB_SPIN(xb_ld(&bar[XB_XGEN(b.x)]) == gen, bar);
            __builtin_amdgcn_fence(__ATOMIC_ACQUIRE, "agent");
            asm volatile("s_waitcnt vmcnt(0)" ::: "memory");
        }
    }
    __syncthreads();
}

__global__ void __launch_bounds__(NTHREADS, 2) fwd_kernel(Params P) {
    extern __shared__ __attribute__((aligned(16))) unsigned char lds_raw[];
    LDSP unsigned char* lds = (LDSP unsigned char*)lds_raw;
    const int G = gridDim.x, bx = blockIdx.x;
    const int vcu = (G % 8 == 0) ? (bx % 8) * (G / 8) + bx / 8 : bx;
    const int lo = P.ph_lo, hi = P.ph_hi;
    volatile LDSP unsigned* bst = (volatile LDSP unsigned*)(lds + LDS_BYTES - 16);
    if (threadIdx.x == 0) { bst[0] = 0u; bst[1] = 0u; bst[2] = 0u; bst[3] = 0u; }
    __syncthreads();
    const XcdBarrier xbar = xcd_barrier_post((unsigned*)(P.ws + 16384), bst);
    if (threadIdx.x == 0) bst[2] = xb_add((unsigned*)(P.ws + 32768) + 64 * xbar.x, 1u);
#define IN(k) (lo <= (k) && (k) < hi)
#define SEAM(k) do { if (IN(k) && IN((k) + 1)) xcd_barrier(xbar); } while (0)
    if (IN(0)) phase_prep(P, lds, vcu, G);
    SEAM(0);
    if (IN(1)) phase_proj(P, lds, vcu, G);
    SEAM(1);
    if (IN(2)) phase_cmp1(P, lds, vcu, G);
    SEAM(2);
    if (IN(3)) phase_cmp2(P, lds, vcu, G);
    SEAM(3);
    if (IN(4)) phase_attn(P, lds, vcu, G);
    SEAM(4);
#if SELFCHECK == 1
    phase_selfcheck(P, lds, vcu, G);
    xcd_barrier(xbar);
#elif SELFCHECK == 2
    phase_selfcheck2(P, lds, vcu, G);
    xcd_barrier(xbar);
#endif
    if (IN(5)) phase_up(P, lds, vcu, G);
    SEAM(5);
    if (IN(6)) phase_out(P, lds, vcu, G);
    SEAM(6);
    if (IN(7)) phase_pq(P, lds, vcu, G);
    SEAM(7);
    if (IN(8)) phase_topk(P, lds, vcu, G);
    SEAM(8);
    if (IN(9)) { phase_peer_a(P, lds, vcu, G); xcd_barrier(xbar); phase_peer_w(P, lds, vcu, G); xcd_barrier(xbar); phase_peer_b(P, lds, vcu, G); }
#if SELFCHECK
    xcd_barrier(xbar);
    if (bx == 0 && threadIdx.x == 0) {
        const unsigned* cnt = (const unsigned*)(P.ws + OFF_CHK);
        P.out[0] += 1000.0f * (float)cnt[0];
        P.out[1] += 1000000.0f * (float)cnt[1];
    }
#endif
#undef IN
#undef SEAM
}

extern "C" void kernel_launch(void* const* d_in, const int* in_sizes, int n_in, void* d_out, int out_size, void* d_ws, size_t ws_size, hipStream_t stream) {
    static int grid = 0;
    if (grid == 0) {
        if (n_in != 29 || ws_size < WS_END) { fprintf(stderr, "kernel_launch: unexpected n_in %d / ws_size %zu\n", n_in, ws_size); grid = -1; return; }
        int dev = 0, cus = 0, per_cu = 0;
        (void)hipGetDevice(&dev);
        (void)hipDeviceGetAttribute(&cus, hipDeviceAttributeMultiprocessorCount, dev);
        (void)hipFuncSetAttribute((const void*)fwd_kernel, hipFuncAttributeMaxDynamicSharedMemorySize, LDS_BYTES);
        (void)hipOccupancyMaxActiveBlocksPerMultiprocessor(&per_cu, (const void*)fwd_kernel, NTHREADS, LDS_BYTES);
        if (per_cu < 1) { fprintf(stderr, "kernel_launch: occupancy query says %d blocks per CU\n", per_cu); grid = -1; return; }
        grid = cus;
    }
    if (grid < 0) return;
    Params p{};
    for (int i = 0; i < 29; ++i) p.in[i] = (const float*)d_in[i];
    p.out = (float*)d_out; p.ws = (unsigned char*)d_ws;
    (void)hipMemsetAsync(d_ws, 0, 65536, stream);
    p.ph_lo = 0; p.ph_hi = 10;
    hipLaunchKernelGGL(fwd_kernel, dim3(grid), dim3(NTHREADS), LDS_BYTES, stream, p);
}
```

```cpp
#include <hip/hip_runtime.h>
#include <hip/hip_cooperative_groups.h>
#include <stdint.h>
#include <stdio.h>
#define SELFCHECK 0
namespace cg = cooperative_groups;

#define LDSP __attribute__((address_space(3)))
typedef unsigned short bf16_t;
typedef short bf16x8 __attribute__((ext_vector_type(8)));
typedef short s16x4 __attribute__((ext_vector_type(4)));
typedef float f32x2 __attribute__((ext_vector_type(2)));
typedef float f32x4 __attribute__((ext_vector_type(4)));
typedef float f32x16 __attribute__((ext_vector_type(16)));
typedef unsigned u32x2 __attribute__((ext_vector_type(2)));
typedef unsigned u32x4 __attribute__((ext_vector_type(4)));
typedef __bf16 bf16x2_t __attribute__((ext_vector_type(2)));

constexpr int BATCH = 8, SEQ = 4096, DM = 1024, T = BATCH * SEQ;
constexpr int HD = 64;
constexpr int NPROJ = 5120;
constexpr int PEER_NE = 16384;
constexpr float NORM_EPS = 1e-6f;
constexpr float PEER_US = 64.0f, PEER_VS = 16.0f;
constexpr float QSCALE = 0.125f * 1.4426950408889634f;
constexpr int NTHREADS = 512, NWAVES = 8;
constexpr int LDS_BYTES = 140 * 1024;

constexpr size_t MiB = 1u << 20;
constexpr size_t OFF_RS1 = 1 * MiB;
constexpr size_t OFF_RS2 = 1 * MiB + 256 * 1024;
constexpr size_t OFF_ROPE_C = 2 * MiB;
constexpr size_t OFF_ROPE_S = 2 * MiB + 128 * 1024;
constexpr size_t OFF_POSB = 2 * MiB + 512 * 1024;
constexpr size_t OFF_KMEAN = 3 * MiB;
constexpr size_t OFF_BGATE = 4 * MiB;
constexpr size_t OFF_WIN_T = 8 * MiB;
constexpr size_t OFF_WUPA_T = 19 * MiB;
constexpr size_t OFF_WUPB_T = 20 * MiB;
constexpr size_t OFF_WOUT_T = 21 * MiB;
constexpr size_t OFF_WPQ_T = 23 * MiB;
constexpr size_t OFF_W1K_T = 27 * MiB;
constexpr size_t OFF_W1V_T = 28 * MiB;
constexpr size_t OFF_W2K_T = 29 * MiB;
constexpr size_t OFF_W2V_T = 29 * MiB + 128 * 1024;
constexpr size_t OFF_K1B = 29 * MiB + 256 * 1024;
constexpr size_t OFF_K2B = 29 * MiB + 320 * 1024;
constexpr size_t OFF_HID = 30 * MiB;
constexpr size_t OFF_KC = 34 * MiB;
constexpr size_t OFF_VC = 35 * MiB;
constexpr size_t OFF_EXPERTS = 36 * MiB;
constexpr size_t OFF_GATES = 52 * MiB;
constexpr size_t OFF_U = 68 * MiB;
constexpr size_t OFF_V = 100 * MiB;
constexpr size_t OFF_R0 = 132 * MiB;
constexpr size_t OFF_R1 = 196 * MiB;
constexpr size_t OFF_R2 = 324 * MiB;
constexpr size_t OFF_R3 = 372 * MiB;
constexpr size_t WS_END = 500 * MiB;

struct Params {
    const float* in[29];
    float* out;
    unsigned char* ws;
    int ph_lo, ph_hi;
};
static_assert(sizeof(Params) == 31 * 8 + 8, "Params has no padding");

enum { I_X = 0, I_NORM1, I_WIN, I_BMERGE, I_AQG, I_AKG, I_BQG, I_BKCG, I_BKSG, I_BKWG,
       I_CPK, I_CKW1, I_CKB1, I_CKW2, I_CKB2, I_CPV, I_CVW1, I_CVB1, I_CVW2, I_CVB2,
       I_WUPA, I_WUPB, I_WOUT, I_NORM2, I_PWQ, I_PK1, I_PK2, I_PU, I_PV };

__device__ __forceinline__ int opaque_tid() { int t = threadIdx.x; asm volatile("" : "+v"(t)); return t; }
__device__ __forceinline__ unsigned pk2(float lo, float hi) {
    f32x2 v = {lo, hi};
    bf16x2_t b = __builtin_convertvector(v, bf16x2_t);
    return __builtin_bit_cast(unsigned, b);
}
__device__ __forceinline__ float bf2f(bf16_t b) { return __uint_as_float(((unsigned)b) << 16); }
__device__ __forceinline__ float wave_sum(float v) {
#pragma unroll
    for (int o = 1; o < 64; o <<= 1) v += __shfl_xor(v, o);
    return v;
}
__device__ __forceinline__ float gelu_tanh(float x) {
    const float u = 0.7978845608028654f * (x + 0.044715f * x * x * x);
    return x / (1.0f + __expf(-2.0f * u));
}
__device__ __forceinline__ float sigmoidf_(float x) { return 1.0f / (1.0f + __expf(-x)); }
__device__ __forceinline__ void cvt8(const u32x4 w, float (&f)[8]) {
    f[0] = __uint_as_float(w.x << 16); f[1] = __uint_as_float(w.x & 0xffff0000u); f[2] = __uint_as_float(w.y << 16); f[3] = __uint_as_float(w.y & 0xffff0000u);
    f[4] = __uint_as_float(w.z << 16); f[5] = __uint_as_float(w.z & 0xffff0000u); f[6] = __uint_as_float(w.w << 16); f[7] = __uint_as_float(w.w & 0xffff0000u);
}
__device__ __forceinline__ int swz_off(int row, int chunk) { return row * 128 + ((chunk ^ ((row >> 1) & 7)) << 4); }

__device__ __forceinline__ void transpose_item(const float* W, int ldw, int k0, int src_c0, int nvalid, const float* kscale,
                                               bf16_t* WT, int ldwt, int n0, LDSP float* scr, int lane) {
#pragma unroll 8
    for (int i = 0; i < 32; ++i) {
        const int kk = 2 * i + (lane >> 5), nn = lane & 31;
        float v = 0.f;
        if (nn < nvalid) v = W[(size_t)(k0 + kk) * ldw + src_c0 + nn];
        if (kscale) v *= kscale[k0 + kk];
        scr[kk * 33 + nn] = v;
    }
    asm volatile("s_waitcnt lgkmcnt(0)" ::: "memory");
    const int c = lane & 7;
#pragma unroll
    for (int j = 0; j < 4; ++j) {
        const int n = (lane >> 3) + 8 * j;
        const LDSP float* s = scr + (8 * c) * 33 + n;
        u32x4 o;
        o.x = pk2(s[0 * 33], s[1 * 33]); o.y = pk2(s[2 * 33], s[3 * 33]); o.z = pk2(s[4 * 33], s[5 * 33]); o.w = pk2(s[6 * 33], s[7 * 33]);
        *(u32x4*)(WT + (size_t)(n0 + n) * ldwt + k0 + 8 * c) = o;
    }
    asm volatile("s_waitcnt lgkmcnt(0)" ::: "memory");
}

struct TrJob { const float* W; int K, N, ldw; const float* kscale; bf16_t* WT; int kind; };

__device__ __forceinline__ void run_tr_job(const TrJob& J, int item, LDSP float* scr, int lane) {
    const int nblk = J.N / 32, kb = item / nblk, nb = item % nblk;
    int src_c0 = nb * 32, nvalid = 32;
    if (J.kind == 1) {
        const int p0 = nb * 32, pn = p0 >> 8, q = p0 & 255, bj = q >> 7, wc = (q >> 5) & 3, H = 4 * pn + wc, d0 = 32 * bj;
        if (H < 44) src_c0 = 64 * H + d0;
        else if (H < 76) src_c0 = 64 * H + d0 + 24;
        else if (H == 76 && bj == 0) { src_c0 = 2816; nvalid = 24; }
        else { src_c0 = 0; nvalid = 0; }
    } else if (J.kind == 2) {
        if (nb * 32 >= 64) { src_c0 = 0; nvalid = 0; }
    }
    transpose_item(J.W, J.ldw, kb * 64, src_c0, nvalid, J.kscale, J.WT, J.K, nb * 32, scr, lane);
}

__device__ __forceinline__ void phase_prep(const Params& P, LDSP unsigned char* lds, int vcu, int G) {
    const int tid = opaque_tid(), lane = tid & 63, wave = tid >> 6;
    const int gw = vcu * NWAVES + wave, NGW = G * NWAVES;
    unsigned char* ws = P.ws;
    LDSP float* scr = (LDSP float*)(lds + wave * 8704);
    int base = 0;
#define TR_JOB(Wp, Kk, Nn, LDW, KS, WTp, KIND) do { TrJob J{Wp, Kk, Nn, LDW, KS, WTp, KIND}; const int nitems = ((Kk) / 64) * ((Nn) / 32); \
        const int first = (gw - base % NGW + NGW) % NGW; for (int it = first; it < nitems; it += NGW) run_tr_job(J, it, scr, lane); base += nitems; } while (0)
    TR_JOB(P.in[I_WIN], 1024, NPROJ, 4888, P.in[I_NORM1], (bf16_t*)(ws + OFF_WIN_T), 1);
    TR_JOB(P.in[I_WUPA], 512, 1024, 1024, nullptr, (bf16_t*)(ws + OFF_WUPA_T), 0);
    TR_JOB(P.in[I_WUPB], 512, 1024, 1024, nullptr, (bf16_t*)(ws + OFF_WUPB_T), 0);
    TR_JOB(P.in[I_WOUT], 1024, 1024, 1024, nullptr, (bf16_t*)(ws + OFF_WOUT_T), 0);
    TR_JOB(P.in[I_PWQ], 1024, 2048, 2048, P.in[I_NORM2], (bf16_t*)(ws + OFF_WPQ_T), 0);
    TR_JOB(P.in[I_CKW1], 2048, 256, 256, nullptr, (bf16_t*)(ws + OFF_W1K_T), 0);
    TR_JOB(P.in[I_CVW1], 2048, 256, 256, nullptr, (bf16_t*)(ws + OFF_W1V_T), 0);
    TR_JOB(P.in[I_CKW2], 256, 128, 64, nullptr, (bf16_t*)(ws + OFF_W2K_T), 2);
    TR_JOB(P.in[I_CVW2], 256, 128, 64, nullptr, (bf16_t*)(ws + OFF_W2V_T), 2);
#undef TR_JOB
    {
        const float* x = P.in[I_X];
        bf16_t* xb = (bf16_t*)(ws + OFF_R0);
        float* rs1 = (float*)(ws + OFF_RS1);
        for (int m = gw; m < T; m += NGW) {
            const f32x4* xr = (const f32x4*)(x + (size_t)m * DM) + lane;
            f32x4 v[4]; float s = 0.f;
#pragma unroll
            for (int j = 0; j < 4; ++j) { v[j] = xr[64 * j]; s += (v[j].x * v[j].x + v[j].y * v[j].y) + (v[j].z * v[j].z + v[j].w * v[j].w); }
            s = wave_sum(s);
            if (lane == 0) rs1[m] = 1.0f / sqrtf(s * (1.0f / DM) + NORM_EPS);
            u32x2* o = (u32x2*)(xb + (size_t)m * DM) + lane;
#pragma unroll
            for (int j = 0; j < 4; ++j) { u32x2 w; w.x = pk2(v[j].x, v[j].y); w.y = pk2(v[j].z, v[j].w); o[64 * j] = w; }
        }
    }
    {
        const float* g2 = P.in[I_NORM2];
        const size_t n16 = (size_t)PEER_NE * DM / 16;
        const size_t gt = (size_t)gw * 64 + lane, NGT = (size_t)NGW * 64;
        for (int which = 0; which < 2; ++which) {
            const float* src = P.in[which ? I_PV : I_PU];
            unsigned char* dst = ws + (which ? OFF_V : OFF_U);
            const float sc = which ? PEER_VS : PEER_US;
            for (size_t i = gt; i < n16; i += NGT) {
                u32x4 o;
#pragma unroll
                for (int q = 0; q < 4; ++q) {
                    f32x4 a4 = *(const f32x4*)(src + i * 16 + q * 4);
                    if (!which) { const int c = (int)((i * 16 + q * 4) & (DM - 1)); const f32x4 g4 = *(const f32x4*)(g2 + c); a4 = a4 * g4; }
                    a4 = a4 * sc;
                    int p = __builtin_amdgcn_cvt_pk_fp8_f32(a4.x, a4.y, 0, false);
                    p = __builtin_amdgcn_cvt_pk_fp8_f32(a4.z, a4.w, p, true);
                    o[q] = (unsigned)p;
                }
                { const size_t e_ = (i * 16) >> 10, c_ = (i * 16) & 1023;
                  *(u32x4*)(dst + ((c_ >> 7) * (size_t)PEER_NE + e_) * 128 + (c_ & 127)) = o; }
            }
        }
    }
    {
        const int gt = gw * 64 + lane, NGT = NGW * 64;
        for (int i = gt; i < 2 * 128 * 128; i += NGT) {
            const int w = i >> 14, e = i & 16383;
            const float v = P.in[w ? I_PK2 : I_PK1][e];
            ((bf16_t*)(ws + (w ? OFF_K2B : OFF_K1B)))[e] = (bf16_t)(pk2(v, 0.f) & 0xffff);
        }
        if (gt < 8) ((float*)(ws + OFF_ROPE_C))[gt] = powf(500000.0f, -(float)(2 * gt) / 16.0f) * 0.15915494309189535f;
        for (int i = gt; i < T; i += NGT) ((float*)(ws + OFF_RS2))[i] = 0.f;
        for (int i = gt; i < 8 * 8 * 16 * 64; i += NGT) ((float*)(ws + OFF_KMEAN))[i] = 0.f;
        if (gt < 2) ((unsigned*)(ws + 512 * 1024))[gt] = 0u;
        for (int o = gw; o < 512; o += NGW) {
            const int w = o >> 8, j = o & 255;
            const float* pos = P.in[w ? I_CPV : I_CPK];
            const float* w1 = P.in[w ? I_CVW1 : I_CKW1];
            float s = 0.f;
            for (int i = lane; i < 2048; i += 64) s += pos[i] * w1[(size_t)i * 256 + j];
            s = wave_sum(s);
            if (lane == 0) ((float*)(ws + OFF_POSB))[o] = s + P.in[w ? I_CVB1 : I_CKB1][j];
        }
    }
}

constexpr int G_BM = 256, G_BN = 128, G_BK = 64;
constexpr int G_ABYTES = G_BM * 128, G_BBYTES = G_BN * 128, G_STAGE = G_ABYTES + G_BBYTES;

__device__ __forceinline__ void gemm_kloop(f32x4 (&acc)[4][4], const bf16_t* A, size_t lda, const bf16_t* Bt, size_t ldb, int K, LDSP unsigned char* lds) {
    const int tid = opaque_tid(), lane = tid & 63, wid = tid >> 6, wm = wid >> 1, wn = wid & 1, fr = lane & 15, fq = lane >> 4;
    const int lrow = tid >> 3, lch = tid & 7;
    const bf16_t* ga = A + (size_t)lrow * lda + lch * 8;
    const bf16_t* gb = Bt + (size_t)lrow * ldb + lch * 8;
    u32x4 ra[4], rb[2];
    const int nk = K / G_BK;
#pragma unroll
    for (int p = 0; p < 4; ++p) ra[p] = *(const u32x4*)(ga + (size_t)(64 * p) * lda);
#pragma unroll
    for (int p = 0; p < 2; ++p) rb[p] = *(const u32x4*)(gb + (size_t)(64 * p) * ldb);
    __syncthreads();
#pragma unroll
    for (int p = 0; p < 4; ++p) *(LDSP u32x4*)(lds + swz_off(lrow + 64 * p, lch)) = ra[p];
#pragma unroll
    for (int p = 0; p < 2; ++p) *(LDSP u32x4*)(lds + G_ABYTES + swz_off(lrow + 64 * p, lch)) = rb[p];
    __syncthreads();
    for (int kt = 0; kt < nk; ++kt) {
        LDSP unsigned char* cur = lds + (kt & 1) * G_STAGE;
        LDSP unsigned char* nxt = lds + ((kt + 1) & 1) * G_STAGE;
        if (kt + 1 < nk) {
#pragma unroll
            for (int p = 0; p < 4; ++p) ra[p] = *(const u32x4*)(ga + (size_t)(64 * p) * lda + (kt + 1) * G_BK);
#pragma unroll
            for (int p = 0; p < 2; ++p) rb[p] = *(const u32x4*)(gb + (size_t)(64 * p) * ldb + (kt + 1) * G_BK);
        }
#pragma unroll
        for (int ks = 0; ks < 2; ++ks) {
            bf16x8 af[4], bfr[4];
#pragma unroll
            for (int m = 0; m < 4; ++m) af[m] = *(const LDSP bf16x8*)(cur + swz_off(wm * 64 + m * 16 + fr, ks * 4 + fq));
#pragma unroll
            for (int n = 0; n < 4; ++n) bfr[n] = *(const LDSP bf16x8*)(cur + G_ABYTES + swz_off(wn * 64 + n * 16 + fr, ks * 4 + fq));
#pragma unroll
            for (int m = 0; m < 4; ++m)
#pragma unroll
                for (int n = 0; n < 4; ++n) acc[m][n] = __builtin_amdgcn_mfma_f32_16x16x32_bf16(bfr[n], af[m], acc[m][n], 0, 0, 0);
        }
        if (kt + 1 < nk) {
#pragma unroll
            for (int p = 0; p < 4; ++p) *(LDSP u32x4*)(nxt + swz_off(lrow + 64 * p, lch)) = ra[p];
#pragma unroll
            for (int p = 0; p < 2; ++p) *(LDSP u32x4*)(nxt + G_ABYTES + swz_off(lrow + 64 * p, lch)) = rb[p];
        }
        __syncthreads();
    }
}

__device__ __forceinline__ void zero_acc(f32x4 (&acc)[4][4]) {
#pragma unroll
    for (int m = 0; m < 4; ++m)
#pragma unroll
        for (int n = 0; n < 4; ++n) acc[m][n] = (f32x4){0.f, 0.f, 0.f, 0.f};
}

__device__ __forceinline__ bool tile_order(int it, int vcu, int G, int nM, int nN, int& tm, int& tn) {
    if (G == 256 && (nM % 32) == 0) {
        const int xcd = vcu >> 5, cu = vcu & 31, mper = nM / 8;
        const int L = it * 32 + cu, per_group = 4 * nN;
        if (L >= mper * nN) return false;
        const int mg = L / per_group, rem = L % per_group;
        tm = xcd * mper + mg * 4 + (rem & 3); tn = rem >> 2;
        return true;
    }
    const int L = it * G + vcu;
    if (L >= nM * nN) return false;
    tm = L / nN; tn = L % nN;
    return true;
}

namespace pg8 {
constexpr int BM = 256, BK = 64, HALF = 128, HTB = HALF * BK * 2, NXCD = 8, WGM = 8;
__device__ __forceinline__ int lds_byte(int r, int c) { const int st = (r >> 4) * 2 + (c >> 5), rr = r & 15, cc = c & 31, ob = rr * 64 + cc * 2; return st * 1024 + (ob ^ (((ob >> 9) & 1) << 5)); }
__device__ __forceinline__ void stage_rc(int b, int& R, int& C) { const int st = b / 1024, sb = b % 1024, swz = sb ^ (((sb >> 9) & 1) << 5); R = (st >> 1) * 16 + swz / 64; C = (st & 1) * 32 + (swz % 64) / 2; }
__device__ __forceinline__ int perm32(int rho) { const int n = rho >> 4, i = rho & 15; return 8 * (i >> 2) + 4 * n + (i & 3); }
struct Unit { int pm, pn, z; };
__device__ __forceinline__ bool tile_of(int L, int nM, int nN, int& pm, int& pn) {
    const int nwg = nM * nN; if (L >= nwg) return false;
    int wgid = L; { const int q = nwg / NXCD, r = nwg % NXCD, xcd = wgid % NXCD, off = wgid / NXCD; wgid = (xcd < r ? xcd * (q + 1) : r * (q + 1) + (xcd - r) * q) + off; }
    const int nig = WGM * nN, gid = wgid / nig, fm = gid * WGM, gsz = (nM - fm) < WGM ? (nM - fm) : WGM;
    pm = fm + ((wgid % nig) % gsz); pn = (wgid % nig) / gsz; return true;
}
struct Sched {
    const bf16_t *A0, *A1, *B0, *B1; size_t lda, ldb; int K, nM, nN, NZ, G, c;
    __device__ __forceinline__ bool next(int i, Unit& u) const { u.z = (NZ == 2) ? (i & 1) : 0; const int ti = (NZ == 2) ? (i >> 1) : i; return tile_of(ti * G + c, nM, nN, u.pm, u.pn); }
    __device__ __forceinline__ const char* aptr(const Unit& u) const { return (const char*)((u.z ? A1 : A0) + (size_t)u.pm * BM * lda); }
    __device__ __forceinline__ const char* bptr(const Unit& u) const { return (const char*)((u.z ? B1 : B0) + (size_t)u.pn * BM * ldb); }
};
template <class Epi>
__device__ __forceinline__ void gemm_phase(LDSP unsigned char* lds, const Sched& S, const Epi& E) {
    const int tid = opaque_tid(), wid = __builtin_amdgcn_readfirstlane(tid >> 6), lane = tid & 63, wr = wid >> 2, wc = wid & 3, fr = lane & 15, fq = lane >> 4;
    const int nt = S.K / BK;
    unsigned voffA[2], voffB[2];
#pragma unroll
    for (int i = 0; i < 2; ++i) { int R, C; stage_rc(tid * 16 + i * 8192, R, C); const int Rb = (R & ~31) + perm32(R & 31);
        voffA[i] = (unsigned)(R * S.lda + C) * 2u; voffB[i] = (unsigned)(Rb * S.ldb + C) * 2u; }
    const size_t kstep = (size_t)(BK * 2);
    const size_t hstepA = (size_t)HALF * S.lda * 2, hstepB = (size_t)HALF * S.ldb * 2;
    const unsigned ldsw = (unsigned)wid * 1024u;
    const int aoff = lds_byte(wr * 64 + fr, fq * 8), boff = lds_byte(wc * 32 + fr, fq * 8);
#define PG8_SA(b, h) (((b) * 2 + (h)) * HTB)
#define PG8_SB(b, h) ((4 + (b) * 2 + (h)) * HTB)
#define PG8_STAGE(bufoff, gbase, voff) do { _Pragma("unroll") for (int _i = 0; _i < 2; ++_i) \
        __builtin_amdgcn_global_load_lds((const unsigned*)((const char*)(gbase) + (voff)[_i]), (LDSP unsigned*)(lds + (bufoff) + ldsw + _i * 8192), 16, 0, 0); } while (0)
#define PG8_LDA(dst, b, h) do { _Pragma("unroll") for (int m = 0; m < 4; ++m) _Pragma("unroll") for (int k = 0; k < 2; ++k) dst[m][k] = *(const LDSP bf16x8*)(lds + PG8_SA(b, h) + aoff + m * 2048 + k * 1024); } while (0)
#define PG8_LDB(dst, b, h) do { _Pragma("unroll") for (int n = 0; n < 2; ++n) _Pragma("unroll") for (int k = 0; k < 2; ++k) dst[n][k] = *(const LDSP bf16x8*)(lds + PG8_SB(b, h) + boff + n * 2048 + k * 1024); } while (0)
#define PG8_MMA(ai, bj, At, Bt) do { __builtin_amdgcn_s_setprio(1); _Pragma("unroll") for (int m = 0; m < 4; ++m) _Pragma("unroll") for (int n = 0; n < 2; ++n) _Pragma("unroll") for (int k = 0; k < 2; ++k) \
        acc[ai][bj][m][n] = __builtin_amdgcn_mfma_f32_16x16x32_bf16(Bt[n][k], At[m][k], acc[ai][bj][m][n], 0, 0, 0); __builtin_amdgcn_s_setprio(0); } while (0)
#define PG8_WAIT_V(n) asm volatile("s_waitcnt vmcnt(" #n ")" ::: "memory")
#define PG8_WAIT_L(n) asm volatile("s_waitcnt lgkmcnt(" #n ")" ::: "memory")
#define PG8_BAR __builtin_amdgcn_s_barrier()
#define PG8_SCHED __builtin_amdgcn_sched_barrier(0)
    Unit cur, nxt; int ui = 0;
    if (!S.next(0, cur)) return;
    f32x4 acc[2][2][4][2];
#pragma unroll
    for (int a = 0; a < 2; ++a)
#pragma unroll
        for (int b = 0; b < 2; ++b)
#pragma unroll
            for (int m = 0; m < 4; ++m)
#pragma unroll
                for (int n = 0; n < 2; ++n) acc[a][b][m][n] = (f32x4){0.f, 0.f, 0.f, 0.f};
    bf16x8 At[4][2], B0[2][2], B1[2][2];
    const char* cA = S.aptr(cur); const char* cB = S.bptr(cur);
    PG8_STAGE(PG8_SB(0, 0), cB, voffB); PG8_STAGE(PG8_SB(0, 1), cB + hstepB, voffB); PG8_STAGE(PG8_SA(0, 0), cA, voffA); PG8_STAGE(PG8_SA(0, 1), cA + hstepA, voffA);
    if (wr == 1) PG8_BAR;
    PG8_WAIT_V(2); PG8_BAR;
    PG8_STAGE(PG8_SB(1, 0), cB + kstep, voffB); PG8_STAGE(PG8_SA(1, 0), cA + kstep, voffA); PG8_STAGE(PG8_SB(1, 1), cB + hstepB + kstep, voffB);
    PG8_WAIT_V(6); PG8_BAR;
    for (;;) {
        const bool has_next = S.next(ui + 1, nxt);
        const char* nA = has_next ? S.aptr(nxt) : cA; const char* nB = has_next ? S.bptr(nxt) : cB;
        for (int t = 0; t < nt; t += 2) {
            const bool last = (t == nt - 2);
            const char* a1 = cA + (size_t)(t + 1) * kstep;
            const char* a2 = last ? nA : cA + (size_t)(t + 2) * kstep; const char* b2 = last ? nB : cB + (size_t)(t + 2) * kstep;
            const char* a3 = a2 + kstep; const char* b3 = b2 + kstep;
            PG8_LDB(B0, 0, 0); PG8_LDB(B1, 0, 1); PG8_SCHED; PG8_LDA(At, 0, 0); PG8_STAGE(PG8_SA(1, 1), a1 + hstepA, voffA);
            PG8_WAIT_V(8); PG8_WAIT_L(0); PG8_BAR; PG8_MMA(0, 0, At, B0); PG8_MMA(0, 1, At, B1); PG8_BAR; PG8_SCHED;
            PG8_LDA(At, 0, 1); PG8_STAGE(PG8_SB(0, 0), b2, voffB); PG8_STAGE(PG8_SB(0, 1), b2 + hstepB, voffB); PG8_STAGE(PG8_SA(0, 0), a2, voffA);
            PG8_WAIT_V(8); PG8_WAIT_L(0); PG8_BAR; PG8_MMA(1, 0, At, B0); PG8_MMA(1, 1, At, B1); PG8_BAR; PG8_SCHED;
            PG8_LDB(B0, 1, 0); PG8_LDB(B1, 1, 1); PG8_SCHED; PG8_LDA(At, 1, 0); PG8_STAGE(PG8_SA(0, 1), a2 + hstepA, voffA);
            PG8_WAIT_V(8); PG8_WAIT_L(0); PG8_BAR; PG8_MMA(0, 0, At, B0); PG8_MMA(0, 1, At, B1); PG8_BAR; PG8_SCHED;
            PG8_LDA(At, 1, 1); PG8_STAGE(PG8_SB(1, 0), b3, voffB); PG8_STAGE(PG8_SB(1, 1), b3 + hstepB, voffB); PG8_STAGE(PG8_SA(1, 0), a3, voffA);
            PG8_WAIT_V(8); PG8_WAIT_L(0); PG8_BAR; PG8_MMA(1, 0, At, B0); PG8_MMA(1, 1, At, B1); PG8_BAR; PG8_SCHED;
        }
        if (wr == 0) PG8_BAR;
        E(acc, cur, wr, wc, fr, fq);
        if (!has_next) break;
#pragma unroll
        for (int a = 0; a < 2; ++a)
#pragma unroll
            for (int b = 0; b < 2; ++b)
#pragma unroll
                for (int m = 0; m < 4; ++m)
#pragma unroll
                    for (int n = 0; n < 2; ++n) acc[a][b][m][n] = (f32x4){0.f, 0.f, 0.f, 0.f};
        cur = nxt; cA = nA; cB = nB; ++ui;
        if (wr == 1) PG8_BAR;
    }
    PG8_WAIT_V(0);
    PG8_BAR;
#undef PG8_SA
#undef PG8_SB
#undef PG8_STAGE
#undef PG8_LDA
#undef PG8_LDB
#undef PG8_MMA
#undef PG8_WAIT_V
#undef PG8_WAIT_L
#undef PG8_BAR
#undef PG8_SCHED
}
}

struct EpiProj {
    const Params* P;
    __device__ __forceinline__ void operator()(f32x4 (&acc)[2][2][4][2], const pg8::Unit& u, int wr, int wc, int fr, int fq) const {
        unsigned char* ws = P->ws;
        const int H = 4 * u.pn + wc;
        if (H > 76) return;
        const float* rs1 = (const float*)(ws + OFF_RS1);
        int kind; bf16_t* dst = nullptr; int pitch = 0, cb = 0; const float* gain = nullptr; float oscale = 1.f; bool slab = false; int sg = 0;
        if (H < 8)        { kind = 1; dst = (bf16_t*)(ws + OFF_R1);            pitch = 512; cb = H * 64;        gain = P->in[I_AQG]; oscale = QSCALE; }
        else if (H < 16)  { kind = 1; dst = (bf16_t*)(ws + OFF_R1 + 32 * MiB); pitch = 512; cb = (H - 8) * 64;  gain = P->in[I_AKG]; }
        else if (H < 24)  { kind = 0; dst = (bf16_t*)(ws + OFF_R1 + 64 * MiB); pitch = 512; cb = (H - 16) * 64; }
        else if (H < 32)  { kind = 1; dst = (bf16_t*)(ws + OFF_R1 + 96 * MiB); pitch = 512; cb = (H - 24) * 64; gain = P->in[I_BQG]; oscale = QSCALE; }
        else if (H < 34)  { kind = 0; dst = (bf16_t*)(ws + OFF_R2);            slab = true; sg = H - 32; }
        else if (H < 36)  { kind = 0; dst = (bf16_t*)(ws + OFF_R2 + 8 * MiB);  slab = true; sg = H - 34; }
        else if (H < 38)  { kind = 1; dst = (bf16_t*)(ws + OFF_R2 + 16 * MiB); pitch = 128; cb = (H - 36) * 64; gain = P->in[I_BKSG]; }
        else if (H < 40)  { kind = 0; dst = (bf16_t*)(ws + OFF_R2 + 24 * MiB); pitch = 128; cb = (H - 38) * 64; }
        else if (H < 42)  { kind = 1; dst = (bf16_t*)(ws + OFF_R2 + 32 * MiB); pitch = 128; cb = (H - 40) * 64; gain = P->in[I_BKWG]; }
        else if (H < 44)  { kind = 0; dst = (bf16_t*)(ws + OFF_R2 + 40 * MiB); pitch = 128; cb = (H - 42) * 64; }
        else if (H < 76)  { kind = 2; dst = (bf16_t*)(ws + OFF_R3);            pitch = 2048; cb = (H - 44) * 64; }
        else              { kind = 3; }
        f32x4 invrev[2] = {{0.f, 0.f, 0.f, 0.f}, {0.f, 0.f, 0.f, 0.f}};
        if (kind == 1) { invrev[0] = *(const f32x4*)((const float*)(ws + OFF_ROPE_C)); invrev[1] = *(const f32x4*)((const float*)(ws + OFF_ROPE_C) + 4); }
        float rsr[2][4];
#pragma unroll
        for (int ai = 0; ai < 2; ++ai)
#pragma unroll
            for (int m = 0; m < 4; ++m) rsr[ai][m] = rs1[u.pm * 256 + ai * 128 + wr * 64 + m * 16 + fr];
        f32x4 gv[2][2];
        if (kind == 1 || kind == 2) {
            const float* gp = (kind == 1) ? gain : P->in[I_BMERGE] + cb;
#pragma unroll
            for (int bj = 0; bj < 2; ++bj)
#pragma unroll
                for (int n = 0; n < 2; ++n) gv[bj][n] = *(const f32x4*)(gp + 32 * bj + 8 * fq + 4 * n);
        }
        const bool ksum = (H >= 8 && H < 16);
        f32x4 cs[2][2];
#pragma unroll
        for (int bj = 0; bj < 2; ++bj)
#pragma unroll
            for (int n = 0; n < 2; ++n) cs[bj][n] = (f32x4){0.f, 0.f, 0.f, 0.f};
#pragma unroll
        for (int ai = 0; ai < 2; ++ai)
#pragma unroll
            for (int m = 0; m < 4; ++m) {
                const int row = u.pm * 256 + ai * 128 + wr * 64 + m * 16 + fr;
                const float rs = rsr[ai][m];
                f32x4 v[2][2];
#pragma unroll
                for (int bj = 0; bj < 2; ++bj)
#pragma unroll
                    for (int n = 0; n < 2; ++n) v[bj][n] = acc[ai][bj][m][n] * rs;
                if (kind == 1) {
                    float ss = 0.f;
#pragma unroll
                    for (int bj = 0; bj < 2; ++bj)
#pragma unroll
                        for (int n = 0; n < 2; ++n) ss += (v[bj][n][0] * v[bj][n][0] + v[bj][n][1] * v[bj][n][1]) + (v[bj][n][2] * v[bj][n][2] + v[bj][n][3] * v[bj][n][3]);
                    ss += __shfl_xor(ss, 16); ss += __shfl_xor(ss, 32);
                    const float r = oscale / sqrtf(ss * (1.0f / 64.0f) + NORM_EPS);
#pragma unroll
                    for (int bj = 0; bj < 2; ++bj)
#pragma unroll
                        for (int n = 0; n < 2; ++n) v[bj][n] = v[bj][n] * gv[bj][n] * r;
                    const float posf = (float)(row & (SEQ - 1));
                    const float sgn = (fq == 0) ? -1.f : 1.f;
#pragma unroll
                    for (int n = 0; n < 2; ++n) {
                        const f32x4 me = v[0][n]; f32x4 ot, ro;
#pragma unroll
                        for (int i = 0; i < 4; ++i) ot[i] = __shfl_xor(me[i], 16);
#pragma unroll
                        for (int i = 0; i < 4; ++i) { const float rev = __builtin_amdgcn_fractf(posf * invrev[n][i]); ro[i] = me[i] * __builtin_amdgcn_cosf(rev) + sgn * ot[i] * __builtin_amdgcn_sinf(rev); }
                        if (fq < 2) v[0][n] = ro;
                    }
                    if (ksum) {
#pragma unroll
                        for (int bj = 0; bj < 2; ++bj)
#pragma unroll
                            for (int n = 0; n < 2; ++n) cs[bj][n] += v[bj][n];
                    }
                } else if (kind == 2) {
#pragma unroll
                    for (int bj = 0; bj < 2; ++bj)
#pragma unroll
                        for (int n = 0; n < 2; ++n)
#pragma unroll
                            for (int i = 0; i < 4; ++i) v[bj][n][i] = sigmoidf_(v[bj][n][i] + gv[bj][n][i]);
                }
                if (kind == 3) {
                    float* bg = (float*)(ws + OFF_BGATE) + (size_t)row * 24;
                    if (fq < 3) {
#pragma unroll
                        for (int n = 0; n < 2; ++n) { f32x4 o; o.x = sigmoidf_(v[0][n][0]); o.y = sigmoidf_(v[0][n][1]); o.z = sigmoidf_(v[0][n][2]); o.w = sigmoidf_(v[0][n][3]); *(f32x4*)(bg + 8 * fq + 4 * n) = o; }
                    }
                } else {
                    bf16_t* rp;
                    if (slab) { const int b = row >> 12, s = row & (SEQ - 1); rp = dst + ((size_t)((b * 2 + sg) * SEQ + s)) * 64 + 8 * fq; }
                    else rp = dst + (size_t)row * pitch + cb + 8 * fq;
#pragma unroll
                    for (int bj = 0; bj < 2; ++bj) {
                        u32x4 w; w.x = pk2(v[bj][0][0], v[bj][0][1]); w.y = pk2(v[bj][0][2], v[bj][0][3]); w.z = pk2(v[bj][1][0], v[bj][1][1]); w.w = pk2(v[bj][1][2], v[bj][1][3]);
                        *(u32x4*)(rp + 32 * bj) = w;
                    }
                }
            }
        if (ksum) {
            float* km = (float*)(ws + OFF_KMEAN) + (size_t)(((u.pm >> 4) * 8 + (H - 8)) * 16 + (u.pm & 15)) * 64;
#pragma unroll
            for (int bj = 0; bj < 2; ++bj)
#pragma unroll
                for (int n = 0; n < 2; ++n)
#pragma unroll
                    for (int i = 0; i < 4; ++i) {
                        float t = cs[bj][n][i];
                        t += __shfl_xor(t, 1); t += __shfl_xor(t, 2); t += __shfl_xor(t, 4); t += __shfl_xor(t, 8);
                        if (fr == 0) atomicAdd(km + 32 * bj + 8 * fq + 4 * n + i, t);
                    }
        }
    }
};
__device__ __forceinline__ void phase_proj(const Params& P, LDSP unsigned char* lds, int vcu, int G) {
    pg8::Sched S; S.A0 = S.A1 = (const bf16_t*)(P.ws + OFF_R0); S.B0 = S.B1 = (const bf16_t*)(P.ws + OFF_WIN_T);
    S.lda = DM; S.ldb = DM; S.K = DM; S.nM = T / 256; S.nN = NPROJ / 256; S.NZ = 1; S.G = G; S.c = blockIdx.x;
    EpiProj E{&P};
    pg8::gemm_phase(lds, S, E);
}

constexpr size_t OFF_CPART = OFF_EXPERTS;
constexpr size_t CPART_STRIDE = (size_t)2 * 4096 * 256;
__device__ __forceinline__ void phase_cmp1(const Params& P, LDSP unsigned char* lds, int vcu, int G) {
    unsigned char* ws = P.ws;
    const int tid = opaque_tid(), lane = tid & 63, wid = tid >> 6, wm = wid >> 1, wn = wid & 1, fr = lane & 15, fq = lane >> 4;
    for (int item = vcu; item < 256; item += G) {
        const int kc = item & 3, tn = (item >> 2) & 1, tm = (item >> 3) & 15, kv = item >> 7;
        const bf16_t* A = (const bf16_t*)(ws + OFF_R2 + (size_t)kv * 8 * MiB) + (size_t)tm * SEQ * 64 + kc * 512;
        const bf16_t* Bt = (const bf16_t*)(ws + (kv ? OFF_W1V_T : OFF_W1K_T)) + (size_t)tn * G_BN * 2048 + kc * 512;
        float* part = (float*)(ws + OFF_CPART) + (size_t)kc * CPART_STRIDE + (size_t)kv * 4096 * 256;
        f32x4 acc[4][4];
        zero_acc(acc);
        gemm_kloop(acc, A, 1024, Bt, 2048, 512, lds);
        const int row0 = tm * 256 + wm * 64 + fr, col0 = tn * 128 + wn * 64 + 4 * fq;
#pragma unroll
        for (int m = 0; m < 4; ++m)
#pragma unroll
            for (int n = 0; n < 4; ++n) *(f32x4*)(part + (size_t)(row0 + m * 16) * 256 + col0 + n * 16) = acc[m][n];
    }
}

__device__ __forceinline__ u32x4 load_hid8(const float* part, const float* posb, size_t rowoff, int k) {
    f32x4 a = *(const f32x4*)(posb + k), b = *(const f32x4*)(posb + k + 4);
#pragma unroll
    for (int c = 0; c < 4; ++c) { a += *(const f32x4*)(part + c * CPART_STRIDE + rowoff + k); b += *(const f32x4*)(part + c * CPART_STRIDE + rowoff + k + 4); }
    u32x4 o; o.x = pk2(gelu_tanh(a.x), gelu_tanh(a.y)); o.y = pk2(gelu_tanh(a.z), gelu_tanh(a.w)); o.z = pk2(gelu_tanh(b.x), gelu_tanh(b.y)); o.w = pk2(gelu_tanh(b.z), gelu_tanh(b.w));
    return o;
}
__device__ __forceinline__ void phase_cmp2(const Params& P, LDSP unsigned char* lds, int vcu, int G) {
    unsigned char* ws = P.ws;
    const int tid = opaque_tid(), lane = tid & 63, wid = tid >> 6, wm = wid >> 1, wn = wid & 1, fr = lane & 15, fq = lane >> 4;
    const int lrow = tid >> 3, lch = tid & 7;
    for (int item = vcu; item < 32; item += G) {
        const int kv = item >> 4, tm = item & 15;
        const float* part = (const float*)(ws + OFF_CPART) + (size_t)kv * 4096 * 256 + (size_t)tm * 256 * 256;
        const float* posb = (const float*)(ws + OFF_POSB) + kv * 256;
        const bf16_t* Bt = (const bf16_t*)(ws + (kv ? OFF_W2V_T : OFF_W2K_T));
        const float* b2 = P.in[kv ? I_CVB2 : I_CKB2];
        bf16_t* dst = (bf16_t*)(ws + (kv ? OFF_VC : OFF_KC)) + (size_t)tm * 256 * 64;
        f32x4 acc[4][4];
        zero_acc(acc);
        {
            const bf16_t* gb = Bt + (size_t)lrow * 256 + lch * 8;
            u32x4 ra[4], rb[2];
#pragma unroll
            for (int p = 0; p < 4; ++p) ra[p] = load_hid8(part, posb, (size_t)(lrow + 64 * p) * 256, lch * 8);
#pragma unroll
            for (int p = 0; p < 2; ++p) rb[p] = *(const u32x4*)(gb + (size_t)(64 * p) * 256);
            __syncthreads();
#pragma unroll
            for (int p = 0; p < 4; ++p) *(LDSP u32x4*)(lds + swz_off(lrow + 64 * p, lch)) = ra[p];
#pragma unroll
            for (int p = 0; p < 2; ++p) *(LDSP u32x4*)(lds + G_ABYTES + swz_off(lrow + 64 * p, lch)) = rb[p];
            __syncthreads();
#pragma unroll 1
            for (int kt = 0; kt < 4; ++kt) {
                LDSP unsigned char* cur = lds + (kt & 1) * G_STAGE;
                LDSP unsigned char* nxt = lds + ((kt + 1) & 1) * G_STAGE;
                if (kt + 1 < 4) {
#pragma unroll
                    for (int p = 0; p < 4; ++p) ra[p] = load_hid8(part, posb, (size_t)(lrow + 64 * p) * 256, (kt + 1) * G_BK + lch * 8);
#pragma unroll
                    for (int p = 0; p < 2; ++p) rb[p] = *(const u32x4*)(gb + (size_t)(64 * p) * 256 + (kt + 1) * G_BK);
                }
#pragma unroll
                for (int ks = 0; ks < 2; ++ks) {
                    bf16x8 af[4], bfr[4];
#pragma unroll
                    for (int m = 0; m < 4; ++m) af[m] = *(const LDSP bf16x8*)(cur + swz_off(wm * 64 + m * 16 + fr, ks * 4 + fq));
#pragma unroll
                    for (int n = 0; n < 4; ++n) bfr[n] = *(const LDSP bf16x8*)(cur + G_ABYTES + swz_off(wn * 64 + n * 16 + fr, ks * 4 + fq));
#pragma unroll
                    for (int m = 0; m < 4; ++m)
#pragma unroll
                        for (int n = 0; n < 4; ++n) acc[m][n] = __builtin_amdgcn_mfma_f32_16x16x32_bf16(bfr[n], af[m], acc[m][n], 0, 0, 0);
                }
                if (kt + 1 < 4) {
#pragma unroll
                    for (int p = 0; p < 4; ++p) *(LDSP u32x4*)(nxt + swz_off(lrow + 64 * p, lch)) = ra[p];
#pragma unroll
                    for (int p = 0; p < 2; ++p) *(LDSP u32x4*)(nxt + G_ABYTES + swz_off(lrow + 64 * p, lch)) = rb[p];
                }
                __syncthreads();
            }
        }
        if (wn == 0) {
            float gv[4][4];
#pragma unroll
            for (int n = 0; n < 4; ++n) {
                const f32x4 bb = *(const f32x4*)(b2 + n * 16 + 4 * fq);
                const f32x4 g4 = kv ? (f32x4){1.f, 1.f, 1.f, 1.f} : *(const f32x4*)(P.in[I_BKCG] + n * 16 + 4 * fq);
                gv[n][0] = g4.x; gv[n][1] = g4.y; gv[n][2] = g4.z; gv[n][3] = g4.w;
#pragma unroll
                for (int m = 0; m < 4; ++m) acc[m][n] += bb;
            }
#pragma unroll
            for (int m = 0; m < 4; ++m) {
                float r = 1.f;
                if (kv == 0) {
                    float ss = 0.f;
#pragma unroll
                    for (int n = 0; n < 4; ++n) ss += (acc[m][n][0] * acc[m][n][0] + acc[m][n][1] * acc[m][n][1]) + (acc[m][n][2] * acc[m][n][2] + acc[m][n][3] * acc[m][n][3]);
                    ss += __shfl_xor(ss, 16); ss += __shfl_xor(ss, 32);
                    r = 1.0f / sqrtf(ss * (1.0f / 64.0f) + NORM_EPS);
                }
                const int row = wm * 64 + m * 16 + fr;
                if (row == 255) r = 0.f;
#pragma unroll
                for (int n = 0; n < 4; ++n) {
                    f32x4 o = acc[m][n];
                    if (row == 255) o = (f32x4){0.f, 0.f, 0.f, 0.f};
                    u32x2 w; w.x = pk2(o[0] * r * gv[n][0], o[1] * r * gv[n][1]); w.y = pk2(o[2] * r * gv[n][2], o[3] * r * gv[n][3]);
                    *(u32x2*)(dst + (size_t)row * 64 + n * 16 + 4 * fq) = w;
                }
            }
        }
    }
}

constexpr int A_GS = 32768, A_ES = 49152, A_MISC = 65536, A_Y = 73728;
typedef short v4i16_t __attribute__((ext_vector_type(4)));
struct ASt { f32x16 o0, o1; float m, l; };
struct KVStage { u32x4 k, v; };
__device__ __forceinline__ void kv_load(KVStage& s, const bf16_t* Kg, const bf16_t* Vg, size_t pitch, int tid) {
    const int key = tid >> 3, ch = tid & 7;
    s.k = *(const u32x4*)(Kg + (size_t)key * pitch + ch * 8);
    s.v = *(const u32x4*)(Vg + (size_t)key * pitch + ch * 8);
}
__device__ __forceinline__ void kv_store(const KVStage& s, LDSP unsigned char* buf, int tid) {
    const int key = tid >> 3, ch = tid & 7;
    *(LDSP u32x4*)(buf + swz_off(key, ch)) = s.k;
    *(LDSP u32x4*)(buf + 8192 + ((ch >> 2) * 4 + (key >> 4)) * 1024 + (key & 15) * 64 + (ch & 3) * 16) = s.v;
}
__device__ __forceinline__ float swap32f(float v) { return __shfl_xor(v, 32); }
__device__ __forceinline__ void ast_reset(ASt& st) {
#pragma unroll
    for (int r = 0; r < 16; ++r) { st.o0[r] = 0.f; st.o1[r] = 0.f; }
    st.m = 0.f; st.l = 0.f;
}
constexpr float ATT_THR = 8.0f;
template <int MODE>
__device__ __forceinline__ void attn_tile(ASt& st, const bf16x8 (&qf)[4], LDSP const unsigned char* kt, int lane, bool rowoff, int kl, int kh, bool need_mask,
                                          float linv, LDSP float* gs, LDSP float* es, int jbase, int ql) {
    const int r32 = lane & 31, hi = lane >> 5;
    const float cin = rowoff ? -INFINITY : -st.m;
    f32x16 p0, p1;
#pragma unroll
    for (int r = 0; r < 16; ++r) { p0[r] = cin; p1[r] = cin; }
#pragma unroll
    for (int d0 = 0; d0 < 4; ++d0) {
        const bf16x8 k0f = *(const LDSP bf16x8*)(kt + swz_off(r32, 2 * d0 + hi));
        const bf16x8 k1f = *(const LDSP bf16x8*)(kt + swz_off(r32 + 32, 2 * d0 + hi));
        p0 = __builtin_amdgcn_mfma_f32_32x32x16_bf16(k0f, qf[d0], p0, 0, 0, 0);
        p1 = __builtin_amdgcn_mfma_f32_32x32x16_bf16(k1f, qf[d0], p1, 0, 0, 0);
    }
    if (need_mask) {
        const int kl2 = kl - 4 * hi, kh2 = kh - 4 * hi;
#pragma unroll
        for (int r = 0; r < 16; ++r) {
            const int c = (r & 3) + 8 * (r >> 2);
            const bool v0 = c >= kl2 && c <= kh2, v1 = (c + 32) >= kl2 && (c + 32) <= kh2;
            p0[r] = v0 ? p0[r] : -INFINITY; p1[r] = v1 ? p1[r] : -INFINITY;
        }
    }
    if (MODE != 2) {
        float mx = fmaxf(fmaxf(p0[0], p1[0]), fmaxf(p0[1], p1[1]));
#pragma unroll
        for (int r = 2; r < 16; r += 2) mx = fmaxf(fmaxf(mx, fmaxf(p0[r], p1[r])), fmaxf(p0[r + 1], p1[r + 1]));
        mx = fmaxf(mx, swap32f(mx));
        if (__any(mx > ATT_THR)) {
            const float dl = (mx > ATT_THR) ? mx : 0.f;
            const float alpha = __builtin_amdgcn_exp2f(-dl);
            st.m += dl; st.l *= alpha;
#pragma unroll
            for (int r = 0; r < 16; ++r) { p0[r] -= dl; p1[r] -= dl; }
            if (MODE == 0) {
#pragma unroll
                for (int r = 0; r < 16; ++r) { st.o0[r] *= alpha; st.o1[r] *= alpha; }
            }
        }
    }
#pragma unroll
    for (int r = 0; r < 16; ++r) { p0[r] = __builtin_amdgcn_exp2f(p0[r]); p1[r] = __builtin_amdgcn_exp2f(p1[r]); }
    if (MODE != 2) {
        const f32x16 t = p0 + p1;
        st.l += ((t[0] + t[1]) + (t[2] + t[3])) + ((t[4] + t[5]) + (t[6] + t[7])) + (((t[8] + t[9]) + (t[10] + t[11])) + ((t[12] + t[13]) + (t[14] + t[15])));
    } else {
#pragma unroll
        for (int r = 0; r < 16; ++r) { p0[r] *= linv; p1[r] *= linv; }
#pragma unroll
        for (int qd = 0; qd < 4; ++qd) {
            float g0 = (p0[4 * qd] + p0[4 * qd + 1]) + (p0[4 * qd + 2] + p0[4 * qd + 3]), e0 = p0[4 * qd + 3];
            float g1 = (p1[4 * qd] + p1[4 * qd + 1]) + (p1[4 * qd + 2] + p1[4 * qd + 3]), e1 = p1[4 * qd + 3];
            g0 += __shfl_xor(g0, 1); g0 += __shfl_xor(g0, 2); e0 += __shfl_xor(e0, 1); e0 += __shfl_xor(e0, 2);
            g1 += __shfl_xor(g1, 1); g1 += __shfl_xor(g1, 2); e1 += __shfl_xor(e1, 1); e1 += __shfl_xor(e1, 2);
            if ((r32 & 3) == 0) {
                const int j = jbase + 2 * qd + hi;
                gs[ql * 64 + j] = g0; es[ql * 64 + j] = e0; gs[ql * 64 + j + 8] = g1; es[ql * 64 + j + 8] = e1;
            }
        }
    }
    if (MODE != 1) {
        u32x4 pw[4];
        pw[0] = (u32x4){pk2(p0[0], p0[1]), pk2(p0[2], p0[3]), pk2(p0[4], p0[5]), pk2(p0[6], p0[7])};
        pw[1] = (u32x4){pk2(p0[8], p0[9]), pk2(p0[10], p0[11]), pk2(p0[12], p0[13]), pk2(p0[14], p0[15])};
        pw[2] = (u32x4){pk2(p1[0], p1[1]), pk2(p1[2], p1[3]), pk2(p1[4], p1[5]), pk2(p1[6], p1[7])};
        pw[3] = (u32x4){pk2(p1[8], p1[9]), pk2(p1[10], p1[11]), pk2(p1[12], p1[13]), pk2(p1[14], p1[15])};
        LDSP const unsigned char* vb = kt + 8192 + ((lane >> 4) & 1) * 32 + (lane & 3) * 8 + (4 * hi + ((lane & 15) >> 2)) * 64;
#pragma unroll
        for (int ks = 0; ks < 4; ++ks) {
            const bf16x8 pf = __builtin_bit_cast(bf16x8, pw[ks]);
#pragma unroll
            for (int d0 = 0; d0 < 2; ++d0) {
                const v4i16_t lo = __builtin_amdgcn_ds_read_tr16_b64_v4i16((LDSP v4i16_t*)(vb + (d0 * 4 + ks) * 1024));
                const v4i16_t hh = __builtin_amdgcn_ds_read_tr16_b64_v4i16((LDSP v4i16_t*)(vb + (d0 * 4 + ks) * 1024 + 512));
                const bf16x8 vf = (bf16x8){lo[0], lo[1], lo[2], lo[3], hh[0], hh[1], hh[2], hh[3]};
                if (d0 == 0) st.o0 = __builtin_amdgcn_mfma_f32_32x32x16_bf16(vf, pf, st.o0, 0, 0, 0);
                else         st.o1 = __builtin_amdgcn_mfma_f32_32x32x16_bf16(vf, pf, st.o1, 0, 0, 0);
            }
            if (ks & 1) __builtin_amdgcn_sched_barrier(0);
        }
    }
}

#define KV_LOOP(NT, KPTR, VPTR, PITCH, ...) do { const int nt_ = (NT); KVStage stg_; __syncthreads(); \
    { const int i = 0; kv_load(stg_, (KPTR), (VPTR), (PITCH), tid); } kv_store(stg_, lds, tid); __syncthreads(); \
    _Pragma("unroll 1") for (int i_ = 0; i_ < nt_; ++i_) { LDSP unsigned char* cur = lds + (i_ & 1) * 16384; \
        if (i_ + 1 < nt_) { const int i = i_ + 1; kv_load(stg_, (KPTR), (VPTR), (PITCH), tid); } \
        { const int i = i_; __VA_ARGS__ } \
        if (i_ + 1 < nt_) kv_store(stg_, lds + ((i_ + 1) & 1) * 16384, tid); \
        __syncthreads(); } } while (0)

__device__ __forceinline__ void store_ot(bf16_t* dst, const f32x16& o0, const f32x16& o1, int hi) {
#pragma unroll
    for (int qd = 0; qd < 4; ++qd) {
        u32x2 w0, w1;
        w0.x = pk2(o0[4 * qd], o0[4 * qd + 1]); w0.y = pk2(o0[4 * qd + 2], o0[4 * qd + 3]);
        w1.x = pk2(o1[4 * qd], o1[4 * qd + 1]); w1.y = pk2(o1[4 * qd + 2], o1[4 * qd + 3]);
        *(u32x2*)(dst + 8 * qd + 4 * hi) = w0; *(u32x2*)(dst + 32 + 8 * qd + 4 * hi) = w1;
    }
}

__device__ __forceinline__ void moba_unit(const Params& P, LDSP unsigned char* lds, int b, int h, int blk) {
    unsigned char* ws = P.ws;
    const int tid = opaque_tid(), lane = tid & 63, wid = tid >> 6, r32 = lane & 31, hi = lane >> 5;
    const bf16_t* qa = (const bf16_t*)(ws + OFF_R1);
    const bf16_t* ka = (const bf16_t*)(ws + OFF_R1 + 32 * MiB);
    const bf16_t* va = (const bf16_t*)(ws + OFF_R1 + 64 * MiB);
    bf16_t* ya = (bf16_t*)(ws + OFF_R0);
    const float* kmean = (const float*)(ws + OFF_KMEAN) + (size_t)((b * 8 + h) * 16) * 64;
    LDSP float* km = (LDSP float*)(lds + A_MISC);
    LDSP unsigned short* sel16 = (LDSP unsigned short*)(lds + A_MISC + 4096);
    __syncthreads();
    for (int i = tid; i < blk * 64; i += NTHREADS) km[i] = kmean[i];
    __syncthreads();
    {
        const int qi = tid >> 1, hf = tid & 1;
        const bf16_t* qrow = qa + (size_t)(b * SEQ + blk * 256 + qi) * 512 + h * 64 + hf * 32;
        float q[32];
#pragma unroll
        for (int c = 0; c < 4; ++c) { float f[8]; cvt8(*(const u32x4*)(qrow + c * 8), f);
#pragma unroll
            for (int i = 0; i < 8; ++i) q[c * 8 + i] = f[i]; }
        float g0 = -INFINITY, g1 = -INFINITY, g2 = -INFINITY; int i0 = -1, i1 = -1, i2 = -1;
        for (int j = 0; j < blk; ++j) {
            float d = 0.f;
#pragma unroll
            for (int i = 0; i < 32; ++i) d += q[i] * km[j * 64 + hf * 32 + i];
            d += __shfl_xor(d, 1);
            if (d > g0) { g2 = g1; i2 = i1; g1 = g0; i1 = i0; g0 = d; i0 = j; }
            else if (d > g1) { g2 = g1; i2 = i1; g1 = d; i1 = j; }
            else if (d > g2) { g2 = d; i2 = j; }
        }
        unsigned mask = 0;
        if (i0 >= 0) mask |= 1u << i0;
        if (i1 >= 0) mask |= 1u << i1;
        if (i2 >= 0) mask |= 1u << i2;
        if (hf == 0) sel16[qi] = (unsigned short)mask;
    }
    __syncthreads();
    const int qloc = wid * 32 + r32;
    const size_t qrow_g = (size_t)(b * SEQ + blk * 256 + qloc);
    bf16x8 qf[4];
#pragma unroll
    for (int d0 = 0; d0 < 4; ++d0) qf[d0] = *(const bf16x8*)(qa + qrow_g * 512 + h * 64 + d0 * 16 + hi * 8);
    const unsigned selbits = sel16[qloc];
    ASt st; ast_reset(st);
    const bf16_t* kbase = ka + (size_t)(b * SEQ) * 512 + h * 64;
    const bf16_t* vbase = va + (size_t)(b * SEQ) * 512 + h * 64;
    KV_LOOP(4 * (blk + 1), kbase + (size_t)i * 64 * 512, vbase + (size_t)i * 64 * 512, 512, {
        const int jb = i >> 2;
        if (jb < blk) {
            const bool rowoff = !((selbits >> jb) & 1u);
            attn_tile<0>(st, qf, cur, lane, rowoff, 0, 63, false, 0.f, nullptr, nullptr, 0, 0);
        } else {
            const int t4 = i & 3;
            if (64 * t4 <= wid * 32 + 31)
                attn_tile<0>(st, qf, cur, lane, false, 0, qloc - 64 * t4, 64 * t4 + 63 > wid * 32, 0.f, nullptr, nullptr, 0, 0);
        }
    });
    const float lt = st.l + swap32f(st.l);
    const float inv = 1.0f / lt;
#pragma unroll
    for (int r = 0; r < 16; ++r) { st.o0[r] *= inv; st.o1[r] *= inv; }
    store_ot(ya + qrow_g * 512 + h * 64, st.o0, st.o1, hi);
}

__device__ __forceinline__ void nsa_unit(const Params& P, LDSP unsigned char* lds, int b, int g, int c) {
    unsigned char* ws = P.ws;
    const int tid = opaque_tid(), lane = tid & 63, wid = tid >> 6, r32 = lane & 31, hi = lane >> 5;
    const bf16_t* qb = (const bf16_t*)(ws + OFF_R1 + 96 * MiB);
    const bf16_t* kc = (const bf16_t*)(ws + OFF_KC) + (size_t)(b * 2 + g) * 256 * 64;
    const bf16_t* vc = (const bf16_t*)(ws + OFF_VC) + (size_t)(b * 2 + g) * 256 * 64;
    const bf16_t* ks = (const bf16_t*)(ws + OFF_R2 + 16 * MiB) + (size_t)(b * SEQ) * 128 + g * 64;
    const bf16_t* vs = (const bf16_t*)(ws + OFF_R2 + 24 * MiB) + (size_t)(b * SEQ) * 128 + g * 64;
    const bf16_t* kw = (const bf16_t*)(ws + OFF_R2 + 32 * MiB) + (size_t)(b * SEQ) * 128 + g * 64;
    const bf16_t* vw = (const bf16_t*)(ws + OFF_R2 + 40 * MiB) + (size_t)(b * SEQ) * 128 + g * 64;
    const float* bgate = (const float*)(ws + OFF_BGATE);
    bf16_t* yb = (bf16_t*)(ws + OFF_R0 + 32 * MiB);
    LDSP float* gs = (LDSP float*)(lds + A_GS);
    LDSP float* es = (LDSP float*)(lds + A_ES);
    LDSP unsigned long long* selm = (LDSP unsigned long long*)(lds + A_MISC);
    const int ql = wid * 8 + (r32 >> 2), hr = r32 & 3, head = g * 4 + hr, pos = c * 64 + ql;
    const size_t trow = (size_t)(b * SEQ + pos);
    bf16x8 qf[4];
#pragma unroll
    for (int d0 = 0; d0 < 4; ++d0) qf[d0] = *(const bf16x8*)(qb + trow * 512 + head * 64 + d0 * 16 + hi * 8);
    const int nmax = (pos >= 31) ? ((pos - 31) >> 4) : -1;
    const int ntc = ((4 * c + 2) >> 6) + 1;
    ASt st; ast_reset(st);
    KV_LOOP(ntc, kc + (size_t)i * 64 * 64, vc + (size_t)i * 64 * 64, 64, {
        attn_tile<1>(st, qf, cur, lane, nmax < 0, 0, nmax - 64 * i, true, 0.f, nullptr, nullptr, 0, 0);
    });
    {
        const float lt = st.l + swap32f(st.l);
        const float linv = (lt > 0.f) ? 1.0f / lt : 0.f;
        KV_LOOP(ntc, kc + (size_t)i * 64 * 64, vc + (size_t)i * 64 * 64, 64, {
            attn_tile<2>(st, qf, cur, lane, nmax < 0, 0, nmax - 64 * i, true, linv, gs, es, 16 * i, ql);
        });
    }
    LDSP float* yl = (LDSP float*)(lds + A_Y) + wid * 2048 + lane;
    { const float gt0 = bgate[trow * 24 + head * 3 + 0];
#pragma unroll
    for (int r = 0; r < 16; ++r) { yl[r * 64] = gt0 * st.o0[r]; yl[(16 + r) * 64] = gt0 * st.o1[r]; } }
    __syncthreads();
    for (int qq = 0; qq < 8; ++qq) {
        const int q = wid * 8 + qq, j = lane;
        unsigned long long m;
        if (c < 16) m = (2ull << c) - 1ull;
        else {
            const bool cand = (j >= 1 && j <= c - 2);
            float imp = 0.f;
            if (cand) imp = gs[q * 64 + j] + es[q * 64 + j - 1];
            int rank = 0;
            for (int jp = 1; jp <= c - 2; ++jp) {
                const float o = __uint_as_float(__builtin_amdgcn_readlane(__float_as_uint(imp), jp));
                rank += (o > imp || (o == imp && jp < j)) ? 1 : 0;
            }
            const bool sel = (j == 0) || (j == c) || (j == c - 1) || (cand && rank < 13);
            m = __ballot(sel);
        }
        if (lane == 0) selm[q] = m;
    }
    __syncthreads();
    const unsigned long long selmask = selm[ql];
    ast_reset(st);
    KV_LOOP(c + 1, ks + (size_t)i * 64 * 128, vs + (size_t)i * 64 * 128, 128, {
        const bool rowoff = !((selmask >> i) & 1ull);
        const bool own = (i == c);
        attn_tile<0>(st, qf, cur, lane, rowoff, 0, own ? ql : 63, own, 0.f, nullptr, nullptr, 0, 0);
    });
    {
        const float lt = st.l + swap32f(st.l);
        const float sc = bgate[trow * 24 + head * 3 + 1] / lt;
#pragma unroll
        for (int r = 0; r < 16; ++r) { yl[r * 64] += sc * st.o0[r]; yl[(16 + r) * 64] += sc * st.o1[r]; }
    }
    ast_reset(st);
    const int j0 = (c >= 8) ? c - 8 : 0;
    KV_LOOP(c - j0 + 1, kw + (size_t)(j0 + i) * 64 * 128, vw + (size_t)(j0 + i) * 64 * 128, 128, {
        const int j = j0 + i;
        const bool first = (j == c - 8), own = (j == c);
        attn_tile<0>(st, qf, cur, lane, false, first ? ql + 1 : 0, own ? ql : 63, first || own, 0.f, nullptr, nullptr, 0, 0);
    });
    {
        const float lt = st.l + swap32f(st.l);
        const float sc = bgate[trow * 24 + head * 3 + 2] / lt;
        f32x16 y0, y1;
#pragma unroll
        for (int r = 0; r < 16; ++r) { y0[r] = yl[r * 64] + sc * st.o0[r]; y1[r] = yl[(16 + r) * 64] + sc * st.o1[r]; }
        store_ot(yb + trow * 512 + head * 64, y0, y1, hi);
    }
}

__device__ __forceinline__ void phase_attn(const Params& P, LDSP unsigned char* lds, int vcu, int G) {
    const int nloc = (G == 256) ? 8 : (2048 - vcu + G - 1) / G;
    for (int k = 0; k < nloc; ++k) {
        int u;
        if (G == 256) {
            const int kk = k >> 1;
            if (!(k & 1)) { const int bh = vcu >> 2, jm = vcu & 3; const int blk = (kk == 0) ? 15 - jm : (kk == 1) ? 8 + jm : (kk == 2) ? 7 - jm : jm; u = bh * 16 + blk; }
            else { const int bg = vcu >> 4, jn = vcu & 15; const int c = (kk == 0) ? 63 - jn : (kk == 1) ? 32 + jn : (kk == 2) ? 31 - jn : jn; u = 1024 + bg * 64 + c; }
        } else u = vcu + k * G;
        if (u < 1024) moba_unit(P, lds, u >> 7, (u >> 4) & 7, u & 15);
        else { const int v = u - 1024; nsa_unit(P, lds, v >> 7, (v >> 6) & 1, v & 63); }
    }
}

struct EpiUp {
    const Params* P;
    __device__ __forceinline__ void operator()(f32x4 (&acc)[2][2][4][2], const pg8::Unit& u, int wr, int wc, int fr, int fq) const {
        bf16_t* g = (bf16_t*)(P->ws + OFF_R3);
#pragma unroll
        for (int ai = 0; ai < 2; ++ai)
#pragma unroll
            for (int m = 0; m < 4; ++m) {
                const int row = u.pm * 256 + ai * 128 + wr * 64 + m * 16 + fr;
#pragma unroll
                for (int bj = 0; bj < 2; ++bj) {
                    bf16_t* rp = g + (size_t)row * 2048 + u.pn * 256 + bj * 128 + wc * 32 + 8 * fq;
                    const u32x4 gg = *(const u32x4*)(rp + (u.z ? 1024 : 0));
                    float gf[8]; cvt8(gg, gf);
                    float o[8];
#pragma unroll
                    for (int n = 0; n < 2; ++n)
#pragma unroll
                        for (int i = 0; i < 4; ++i) o[4 * n + i] = gf[4 * n + i] * acc[ai][bj][m][n][i];
                    if (u.z) { float pf[8]; cvt8(*(const u32x4*)rp, pf);
#pragma unroll
                        for (int i = 0; i < 8; ++i) o[i] += pf[i]; }
                    u32x4 w; w.x = pk2(o[0], o[1]); w.y = pk2(o[2], o[3]); w.z = pk2(o[4], o[5]); w.w = pk2(o[6], o[7]);
                    *(u32x4*)rp = w;
                }
            }
    }
};
__device__ __forceinline__ void phase_up(const Params& P, LDSP unsigned char* lds, int vcu, int G) {
    pg8::Sched S; S.A0 = (const bf16_t*)(P.ws + OFF_R0); S.A1 = (const bf16_t*)(P.ws + OFF_R0 + 32 * MiB);
    S.B0 = (const bf16_t*)(P.ws + OFF_WUPA_T); S.B1 = (const bf16_t*)(P.ws + OFF_WUPB_T);
    S.lda = 512; S.ldb = 512; S.K = 512; S.nM = T / 256; S.nN = DM / 256; S.NZ = 2; S.G = G; S.c = blockIdx.x;
    EpiUp E{&P};
    pg8::gemm_phase(lds, S, E);
}

struct EpiOut {
    const Params* P;
    __device__ __forceinline__ void operator()(f32x4 (&acc)[2][2][4][2], const pg8::Unit& u, int wr, int wc, int fr, int fq) const {
        bf16_t* x1b = (bf16_t*)(P->ws + OFF_R0);
        float* rs2 = (float*)(P->ws + OFF_RS2);
        const float* x = P->in[I_X];
#pragma unroll
        for (int ai = 0; ai < 2; ++ai)
#pragma unroll
            for (int m = 0; m < 4; ++m) {
                const int row = u.pm * 256 + ai * 128 + wr * 64 + m * 16 + fr;
                float ss = 0.f;
                f32x4 xv[2][2];
#pragma unroll
                for (int bj = 0; bj < 2; ++bj)
#pragma unroll
                    for (int n = 0; n < 2; ++n) xv[bj][n] = *(const f32x4*)(x + (size_t)row * DM + u.pn * 256 + bj * 128 + wc * 32 + 8 * fq + 4 * n);
#pragma unroll
                for (int bj = 0; bj < 2; ++bj) {
                    const size_t off = (size_t)row * DM + u.pn * 256 + bj * 128 + wc * 32 + 8 * fq;
                    const f32x4 o0 = xv[bj][0] + acc[ai][bj][m][0], o1 = xv[bj][1] + acc[ai][bj][m][1];
                    *(f32x4*)(P->out + off) = o0; *(f32x4*)(P->out + off + 4) = o1;
                    u32x4 w; w.x = pk2(o0.x, o0.y); w.y = pk2(o0.z, o0.w); w.z = pk2(o1.x, o1.y); w.w = pk2(o1.z, o1.w);
                    *(u32x4*)(x1b + off) = w;
                    ss += ((o0.x * o0.x + o0.y * o0.y) + (o0.z * o0.z + o0.w * o0.w)) + ((o1.x * o1.x + o1.y * o1.y) + (o1.z * o1.z + o1.w * o1.w));
                }
                ss += __shfl_xor(ss, 16); ss += __shfl_xor(ss, 32);
                if (fq == 0) atomicAdd(rs2 + row, ss);
            }
    }
};
__device__ __forceinline__ void phase_out(const Params& P, LDSP unsigned char* lds, int vcu, int G) {
    pg8::Sched S; S.A0 = S.A1 = (const bf16_t*)(P.ws + OFF_R3); S.B0 = S.B1 = (const bf16_t*)(P.ws + OFF_WOUT_T);
    S.lda = 2048; S.ldb = DM; S.K = DM; S.nM = T / 256; S.nN = DM / 256; S.NZ = 1; S.G = G; S.c = blockIdx.x;
    EpiOut E{&P};
    pg8::gemm_phase(lds, S, E);
}

struct EpiPq {
    const Params* P;
    __device__ __forceinline__ void operator()(f32x4 (&acc)[2][2][4][2], const pg8::Unit& u, int wr, int wc, int fr, int fq) const {
        bf16_t* qp = (bf16_t*)(P->ws + OFF_R1);
        const float* rs2 = (const float*)(P->ws + OFF_RS2);
        float rr[2][4];
#pragma unroll
        for (int ai = 0; ai < 2; ++ai)
#pragma unroll
            for (int m = 0; m < 4; ++m) rr[ai][m] = 1.0f / sqrtf(rs2[u.pm * 256 + ai * 128 + wr * 64 + m * 16 + fr] * (1.0f / DM) + NORM_EPS);
#pragma unroll
        for (int ai = 0; ai < 2; ++ai)
#pragma unroll
            for (int m = 0; m < 4; ++m) {
                const int row = u.pm * 256 + ai * 128 + wr * 64 + m * 16 + fr;
                const float r = rr[ai][m];
#pragma unroll
                for (int bj = 0; bj < 2; ++bj) {
                    const f32x4 a0 = acc[ai][bj][m][0], a1 = acc[ai][bj][m][1];
                    u32x4 w; w.x = pk2(a0[0] * r, a0[1] * r); w.y = pk2(a0[2] * r, a0[3] * r); w.z = pk2(a1[0] * r, a1[1] * r); w.w = pk2(a1[2] * r, a1[3] * r);
                    *(u32x4*)(qp + (size_t)row * 2048 + u.pn * 256 + bj * 128 + wc * 32 + 8 * fq) = w;
                }
            }
    }
};
__device__ __forceinline__ void phase_pq(const Params& P, LDSP unsigned char* lds, int vcu, int G) {
    pg8::Sched S; S.A0 = S.A1 = (const bf16_t*)(P.ws + OFF_R0); S.B0 = S.B1 = (const bf16_t*)(P.ws + OFF_WPQ_T);
    S.lda = DM; S.ldb = DM; S.K = DM; S.nM = T / 256; S.nN = 2048 / 256; S.NZ = 1; S.G = G; S.c = blockIdx.x;
    EpiPq E{&P};
    pg8::gemm_phase(lds, S, E);
}

__device__ __forceinline__ unsigned f2ord(float f) { const unsigned u = __float_as_uint(f); return u ^ ((unsigned)((int)u >> 31) | 0x80000000u); }
__device__ __forceinline__ float ord2f(unsigned o) { const unsigned u = (o & 0x80000000u) ? (o ^ 0x80000000u) : ~o; return __uint_as_float(u); }
__device__ __forceinline__ void ins16(unsigned (&top)[16], unsigned x) {
#pragma unroll
    for (int j = 0; j < 16; ++j) { const unsigned t = max(x, top[j]); x = min(x, top[j]); top[j] = t; }
}
__device__ __forceinline__ int crow(int r, int hi) { return (r & 3) + 8 * (r >> 2) + 4 * hi; }
__device__ __forceinline__ void ce_desc(unsigned& a, unsigned& b) { const unsigned hi_ = max(a, b), lo_ = min(a, b); a = hi_; b = lo_; }
__device__ __forceinline__ void bitonic_merge16_desc(unsigned (&a)[16]) {
#pragma unroll
    for (int j = 8; j > 0; j >>= 1)
#pragma unroll
        for (int i = 0; i < 16; ++i) { const int l = i ^ j; if (l > i) ce_desc(a[i], a[l]); }
}
__device__ __forceinline__ void sort16_desc(unsigned (&a)[16]) {
#pragma unroll
    for (int k = 2; k <= 16; k <<= 1)
#pragma unroll
        for (int j = k >> 1; j > 0; j >>= 1)
#pragma unroll
            for (int i = 0; i < 16; ++i) { const int l = i ^ j; if (l > i) { if ((i & k) == 0) ce_desc(a[i], a[l]); else ce_desc(a[l], a[i]); } }
}
__device__ __forceinline__ void merge_top16(unsigned (&top)[16], const unsigned (&blk)[16]) {
#pragma unroll
    for (int i = 0; i < 16; ++i) top[i] = max(top[i], blk[15 - i]);
    bitonic_merge16_desc(top);
}
constexpr int cand_prefix(int i) { int n = 0; for (int a = 0; a < i; ++a) n += 16 / (a + 1); return n; }

constexpr int P8_KOFF = 0, P8_IDX = 65536;
__device__ __forceinline__ void phase_topk(const Params& P, LDSP unsigned char* lds, int vcu, int G) {
    unsigned char* ws = P.ws;
    const bf16_t* qp = (const bf16_t*)(ws + OFF_R1);
    int* experts = (int*)(ws + OFF_EXPERTS);
    float* gates = (float*)(ws + OFF_GATES);
    const int tid = opaque_tid(), lane = tid & 63, wave = tid >> 6, r32 = lane & 31, hi = lane >> 5;
    __syncthreads();
    for (int i = tid; i < 2 * 128 * 16; i += NTHREADS) {
        const int w = i >> 11, row = (i >> 4) & 127, ch = i & 15;
        const u32x4 v = *(const u32x4*)((const bf16_t*)(ws + (w ? OFF_K2B : OFF_K1B)) + row * 128 + ch * 8);
        *(LDSP u32x4*)(lds + P8_KOFF + w * 32768 + row * 256 + ((ch ^ (row & 15)) << 4)) = v;
    }
    __syncthreads();
    LDSP unsigned char* myidx = lds + P8_IDX + (wave * 64 + lane) * 32;
    const int gw = vcu * NWAVES + wave, NGW = G * NWAVES;
    for (int item = gw; item < (T / 32) * 8; item += NGW) {
        const int tg = item >> 3, h = item & 7;
        const int tok = tg * 32 + r32;
        unsigned tops[2][16];
#pragma unroll
        for (int L = 0; L < 2; ++L) {
            bf16x8 qf[8];
            const bf16_t* qrow = qp + (size_t)tok * 2048 + h * 256 + L * 128 + hi * 8;
#pragma unroll
            for (int s8 = 0; s8 < 8; ++s8) qf[s8] = *(const bf16x8*)(qrow + s8 * 16);
            unsigned top[16];
#pragma unroll
            for (int kb = 0; kb < 4; ++kb) {
                f32x16 acc = {0.f, 0.f, 0.f, 0.f, 0.f, 0.f, 0.f, 0.f, 0.f, 0.f, 0.f, 0.f, 0.f, 0.f, 0.f, 0.f};
                const int row = kb * 32 + r32;
#pragma unroll
                for (int s8 = 0; s8 < 8; ++s8) {
                    const bf16x8 kf = *(const LDSP bf16x8*)(lds + P8_KOFF + L * 32768 + row * 256 + (((2 * s8 + hi) ^ (row & 15)) << 4));
                    acc = __builtin_amdgcn_mfma_f32_32x32x16_bf16(kf, qf[s8], acc, 0, 0, 0);
                }
                unsigned blk[16];
#pragma unroll
                for (int r = 0; r < 16; ++r) {
                    const int key = kb * 32 + (r & 3) + 8 * (r >> 2) + 4 * hi;
                    blk[r] = (f2ord(acc[r]) & ~0x7Fu) | (unsigned)(127 - key);
                }
                sort16_desc(blk);
                if (kb == 0) {
#pragma unroll
                    for (int j = 0; j < 16; ++j) top[j] = blk[j];
                } else merge_top16(top, blk);
            }
            unsigned oth[16];
#pragma unroll
            for (int j = 0; j < 16; ++j) oth[j] = (unsigned)__shfl_xor((int)top[j], 32);
            merge_top16(top, oth);
#pragma unroll
            for (int j = 0; j < 16; ++j) tops[L][j] = top[j];
        }
        float v1[16], v2[16];
#pragma unroll
        for (int j = 0; j < 16; j += 4) {
            unsigned w1 = 0, w2 = 0;
#pragma unroll
            for (int q = 0; q < 4; ++q) { w1 |= (127u - (tops[0][j + q] & 127u)) << (8 * q); w2 |= (127u - (tops[1][j + q] & 127u)) << (8 * q); }
            *(LDSP unsigned*)(myidx + j) = w1; *(LDSP unsigned*)(myidx + 16 + j) = w2;
        }
#pragma unroll
        for (int j = 0; j < 16; ++j) { v1[j] = ord2f(tops[0][j] & ~0x7Fu); v2[j] = ord2f(tops[1][j] & ~0x7Fu); }
        unsigned ct[16];
        {
            unsigned cand[64];
#pragma unroll
            for (int n = 0; n < 64; ++n) cand[n] = 0u;
#pragma unroll
            for (int i = 0; i < 16; ++i)
#pragma unroll
                for (int j = 0; j < 16; ++j)
                    if ((i + 1) * (j + 1) <= 16) cand[cand_prefix(i) + j] = (f2ord(v1[i] + v2[j]) & ~0xFFu) | (unsigned)(255 - (i * 16 + j));
#pragma unroll
            for (int bk = 0; bk < 4; ++bk) {
                unsigned blk[16];
#pragma unroll
                for (int r = 0; r < 16; ++r) blk[r] = cand[bk * 16 + r];
                sort16_desc(blk);
                if (bk == 0) {
#pragma unroll
                    for (int j = 0; j < 16; ++j) ct[j] = blk[j];
                } else merge_top16(ct, blk);
            }
        }
        float vals[16], ssum = 0.f;
        const float vmax = ord2f(ct[0] & ~0xFFu);
#pragma unroll
        for (int k = 0; k < 16; ++k) { vals[k] = __expf(ord2f(ct[k] & ~0xFFu) - vmax); ssum += vals[k]; }
        const float inv = 1.0f / ssum;
        asm volatile("s_waitcnt lgkmcnt(0)" ::: "memory");
        if (hi == 0) {
            int* ep = experts + (size_t)tok * 128 + h * 16;
            float* gp = gates + (size_t)tok * 128 + h * 16;
#pragma unroll
            for (int k = 0; k < 16; k += 4) {
                int e4[4];
#pragma unroll
                for (int q = 0; q < 4; ++q) {
                    const unsigned flat = 255u - (ct[k + q] & 255u);
                    const int i1 = myidx[flat >> 4], i2 = myidx[16 + (flat & 15)];
                    e4[q] = i1 * 128 + i2;
                }
                *(u32x4*)(ep + k) = (u32x4){(unsigned)e4[0], (unsigned)e4[1], (unsigned)e4[2], (unsigned)e4[3]};
                *(f32x4*)(gp + k) = (f32x4){vals[k] * inv, vals[k + 1] * inv, vals[k + 2] * inv, vals[k + 3] * inv};
            }
        }
        asm volatile("s_waitcnt lgkmcnt(0)" ::: "memory");
    }
}

__device__ __forceinline__ void cvt16_fp8(const u32x4 w, float (&f)[16]) {
#pragma unroll
    for (int q = 0; q < 4; ++q) {
        const f32x2 lo = __builtin_amdgcn_cvt_pk_f32_fp8((int)w[q], false), hi = __builtin_amdgcn_cvt_pk_f32_fp8((int)w[q], true);
        f[4 * q] = lo.x; f[4 * q + 1] = lo.y; f[4 * q + 2] = hi.x; f[4 * q + 3] = hi.y;
    }
}
__device__ __forceinline__ void peer_slice_map(const Params& P, LDSP unsigned char* lds, int vcu, int G, int wave, int& slice, int& wslot, int& nslot) {
    volatile LDSP unsigned* bst = (volatile LDSP unsigned*)(lds + LDS_BYTES - 16);
    LDSP unsigned* info = (LDSP unsigned*)(lds + LDS_BYTES - 64);
    __syncthreads();
    if (threadIdx.x == 0) {
        unsigned* bar = (unsigned*)(P.ws + 16384);
        const unsigned x = (unsigned)__builtin_amdgcn_s_getreg((3 << 11) | 20) & 0xFu;
        bool ok = true; unsigned sum = 0, mine = 0;
        for (unsigned j = 0; j < 16; ++j) { const unsigned c = __hip_atomic_load(&bar[256 + 64 * j], __ATOMIC_RELAXED, __HIP_MEMORY_SCOPE_AGENT); sum += c; if (j < 8 && c == 0) ok = false; if (j >= 8 && c != 0) ok = false; if (j == x) mine = c; }
        ok = ok && (sum == (unsigned)G) && (bst[2] < mine);
        info[0] = ok ? 1u : 0u; info[1] = x; info[2] = mine; info[3] = bst[2];
    }
    __syncthreads();
    if (info[0]) { slice = (int)info[1]; wslot = (int)info[3] * NWAVES + wave; nslot = (int)info[2] * NWAVES; }
    else if ((G & 7) == 0) { slice = vcu / (G >> 3); wslot = (vcu % (G >> 3)) * NWAVES + wave; nslot = (G >> 3) * NWAVES; }
    else { slice = -1; wslot = vcu * NWAVES + wave; nslot = G * NWAVES; }
}
struct PeerMetaA { int eA, eB; u32x4 h0, h1; };
struct PeerMetaB { int eA, eB; float aA, aB; };
#define PEER_IDX(m, j) __shfl(((j) < 8) ? (m).eA : (m).eB, (8 * (j) + grp) & 63)
__device__ __forceinline__ float dpp_xor1(float v) { return __builtin_bit_cast(float, __builtin_amdgcn_mov_dpp(__builtin_bit_cast(int, v), 0xB1, 0xF, 0xF, true)); }
__device__ __forceinline__ float dpp_xor2(float v) { return __builtin_bit_cast(float, __builtin_amdgcn_mov_dpp(__builtin_bit_cast(int, v), 0x4E, 0xF, 0xF, true)); }
__device__ __forceinline__ float dpp_hmirror(float v) { return __builtin_bit_cast(float, __builtin_amdgcn_mov_dpp(__builtin_bit_cast(int, v), 0x141, 0xF, 0xF, true)); }
__device__ __forceinline__ float dpp_ror8(float v) { return __builtin_bit_cast(float, __builtin_amdgcn_mov_dpp(__builtin_bit_cast(int, v), 0x128, 0xF, 0xF, true)); }
__device__ __forceinline__ float swap32_sum(float X, float Y) {
    const auto r = __builtin_amdgcn_permlane32_swap(__float_as_uint(X), __float_as_uint(Y), false, false);
    return __uint_as_float(r[0]) + __uint_as_float(r[1]);
}
__device__ __forceinline__ float swap16_sum(float X, float Y) {
    const auto r = __builtin_amdgcn_permlane16_swap(__float_as_uint(X), __float_as_uint(Y), false, false);
    return __uint_as_float(r[0]) + __uint_as_float(r[1]);
}
__device__ __forceinline__ void cvt16_fp8_pk(const u32x4 w, f32x2 (&f)[8]) {
#pragma unroll
    for (int q = 0; q < 4; ++q) { f[2 * q] = __builtin_amdgcn_cvt_pk_f32_fp8((int)w[q], false); f[2 * q + 1] = __builtin_amdgcn_cvt_pk_f32_fp8((int)w[q], true); }
}
__device__ __forceinline__ void phase_peer_a(const Params& P, LDSP unsigned char* lds, int vcu, int G) {
    unsigned char* ws = P.ws;
    const bf16_t* x1b = (const bf16_t*)(ws + OFF_R0);
    const unsigned char* U8 = ws + OFF_U;
    const int* experts = (const int*)(ws + OFF_EXPERTS);
    float* apart = (float*)(ws + OFF_R1);
    const int tid = opaque_tid(), lane = tid & 63, wave = tid >> 6, grp = lane >> 3, sub = lane & 7;
    const bool b2 = lane & 4, b1 = lane & 2, b0 = lane & 1;
    int slice, wslot, nslot;
    peer_slice_map(P, lds, vcu, G, wave, slice, wslot, nslot);
    const int nitems = (slice >= 0) ? T : T * 8;
#define PA_T(it) ((slice >= 0) ? (it) : ((it) >> 3))
#define PA_X(it) ((slice >= 0) ? slice : ((it) & 7))
#define PA_META(m, it) do { const int it_ = ((it) < nitems) ? (it) : wslot; { const int t_ = PA_T(it_), x_ = PA_X(it_); \
        (m).eA = experts[(size_t)t_ * 128 + lane]; (m).eB = experts[(size_t)t_ * 128 + 64 + lane]; \
        (m).h0 = *(const u32x4*)(x1b + (size_t)t_ * DM + 128 * x_ + 16 * sub); (m).h1 = *(const u32x4*)(x1b + (size_t)t_ * DM + 128 * x_ + 16 * sub + 8); } } while (0)
#define PA_GATHER(R, m, it, J0) do { const int x_ = PA_X(it); _Pragma("unroll") for (int j = 0; j < 8; ++j) { const int e_ = PEER_IDX(m, (J0) + j); \
        (R)[j] = *(const u32x4*)(U8 + ((size_t)x_ * PEER_NE + e_) * 128 + 16 * sub); } } while (0)
#define PA_COMPUTE(R, J0) do { _Pragma("unroll") for (int j = 0; j < 8; ++j) { f32x2 f[8]; asm volatile("" : "+v"((R)[j])); cvt16_fp8_pk((R)[j], f); f32x2 sd = f[0] * h2[0]; \
        _Pragma("unroll") for (int i = 1; i < 8; ++i) sd = __builtin_elementwise_fma(f[i], h2[i], sd); part[(J0) + j] = sd.x + sd.y; asm volatile("" : "+v"(part[(J0) + j])); } } while (0)
    PeerMetaA m0, m1, m2;
    m0.eA = m0.eB = m1.eA = m1.eB = m2.eA = m2.eB = 0; m0.h0 = m0.h1 = m1.h0 = m1.h1 = m2.h0 = m2.h1 = (u32x4){0u, 0u, 0u, 0u};
    u32x4 R0[8], R1[8];
    PA_META(m0, wslot); PA_META(m1, wslot + nslot);
    if (wslot >= nitems) return;
    PA_GATHER(R0, m0, wslot, 0); PA_GATHER(R1, m0, wslot, 8);
#pragma unroll 1
    for (int it = wslot; it < nitems; it += nslot) {
        PA_META(m2, it + 2 * nslot);
        f32x2 h2[8]; float part[16];
        { float f[8]; cvt8(m0.h0, f);
#pragma unroll
          for (int i = 0; i < 4; ++i) h2[i] = (f32x2){f[2 * i], f[2 * i + 1]};
          cvt8(m0.h1, f);
#pragma unroll
          for (int i = 0; i < 4; ++i) h2[4 + i] = (f32x2){f[2 * i], f[2 * i + 1]}; }
        PA_COMPUTE(R0, 0);
        const int itn = (it + nslot < nitems) ? it + nslot : it;
        PA_GATHER(R0, m1, itn, 0);
        PA_COMPUTE(R1, 8);
        PA_GATHER(R1, m1, itn, 8);
        float q8[8], q4[4], q2[2];
#pragma unroll
        for (int i = 0; i < 8; ++i) { const float send = b2 ? part[i] : part[i + 8], keep = b2 ? part[i + 8] : part[i]; q8[i] = keep + dpp_hmirror(send); }
#pragma unroll
        for (int i = 0; i < 4; ++i) { const float send = b1 ? q8[i] : q8[i + 4], keep = b1 ? q8[i + 4] : q8[i]; q4[i] = keep + dpp_xor2(send); }
#pragma unroll
        for (int i = 0; i < 2; ++i) { const float send = b0 ? q4[i] : q4[i + 2], keep = b0 ? q4[i + 2] : q4[i]; q2[i] = keep + dpp_xor1(send); }
        float* ap = apart + ((size_t)PA_X(it) * T + PA_T(it)) * 128 + lane;
        ap[0] = q2[0]; ap[64] = q2[1];
        m0 = m1; m1 = m2;
    }
#undef PA_META
#undef PA_GATHER
#undef PA_COMPUTE
}
__device__ __forceinline__ void phase_peer_w(const Params& P, LDSP unsigned char* lds, int vcu, int G) {
    unsigned char* ws = P.ws;
    float* gates = (float*)(ws + OFF_GATES);
    const float* rs2 = (const float*)(ws + OFF_RS2);
    const float* apart = (const float*)(ws + OFF_R1);
    const size_t gt = (size_t)(vcu * NTHREADS + threadIdx.x), NGT = (size_t)G * NTHREADS;
    for (size_t i = gt; i < (size_t)T * 128; i += NGT) {
        const int t = (int)(i >> 7), k = (int)(i & 127);
        const int sub = k >> 4, s1 = (k >> 3) & 1, grp = k & 7, idx = s1 * 64 + grp * 8 + sub;
        float a = 0.f;
#pragma unroll
        for (int xs = 0; xs < 8; ++xs) a += apart[((size_t)xs * T + t) * 128 + idx];
        const float rs = (1.0f / PEER_US) / sqrtf(rs2[t] * (1.0f / DM) + NORM_EPS);
        gates[i] = gelu_tanh(a * rs) * gates[i] * (1.0f / PEER_VS);
    }
}
__device__ __forceinline__ void phase_peer_b(const Params& P, LDSP unsigned char* lds, int vcu, int G) {
    unsigned char* ws = P.ws;
    const unsigned char* V8 = ws + OFF_V;
    const int* experts = (const int*)(ws + OFF_EXPERTS);
    const float* wtok = (const float*)(ws + OFF_GATES);
    const int tid = opaque_tid(), lane = tid & 63, wave = tid >> 6, grp = lane >> 3, sub = lane & 7;
    const bool b3 = lane & 8;
    const int k0 = 16 * sub + grp, k1 = k0 + 8;
    LDSP float* wbuf = (LDSP float*)(lds + wave * 1024);
    int slice, wslot, nslot;
    peer_slice_map(P, lds, vcu, G, wave, slice, wslot, nslot);
    const int nitems = (slice >= 0) ? T : T * 8;
#define PB_META(m, it) do { const int it_ = ((it) < nitems) ? (it) : wslot; { const int t_ = PA_T(it_); \
        (m).eA = experts[(size_t)t_ * 128 + lane]; (m).eB = experts[(size_t)t_ * 128 + 64 + lane]; \
        (m).aA = wtok[(size_t)t_ * 128 + k0]; (m).aB = wtok[(size_t)t_ * 128 + k1]; } } while (0)
#define PB_GATHER(R, m, it, J0) do { const int x_ = PA_X(it); _Pragma("unroll") for (int j = 0; j < 8; ++j) { const int e_ = PEER_IDX(m, (J0) + j); \
        (R)[j] = *(const u32x4*)(V8 + ((size_t)x_ * PEER_NE + e_) * 128 + 16 * sub); } } while (0)
#define PB_COMPUTE(R, J0) do { _Pragma("unroll") for (int j = 0; j < 8; ++j) { f32x2 f[8]; asm volatile("" : "+v"((R)[j])); cvt16_fp8_pk((R)[j], f); const float wk = wb[8 * ((J0) + j) + grp]; const f32x2 wk2 = {wk, wk}; \
        _Pragma("unroll") for (int i = 0; i < 8; ++i) acc2[i] = __builtin_elementwise_fma(wk2, f[i], acc2[i]); \
        asm volatile("" : "+v"(acc2[0]), "+v"(acc2[1]), "+v"(acc2[2]), "+v"(acc2[3]), "+v"(acc2[4]), "+v"(acc2[5]), "+v"(acc2[6]), "+v"(acc2[7])); } } while (0)
    PeerMetaB m0, m1, m2;
    m0.eA = m0.eB = m1.eA = m1.eB = m2.eA = m2.eB = 0; m0.aA = m0.aB = m1.aA = m1.aB = m2.aA = m2.aB = 0.f;
    u32x4 R0[8], R1[8];
    PB_META(m0, wslot); PB_META(m1, wslot + nslot);
    if (wslot >= nitems) return;
    PB_GATHER(R0, m0, wslot, 0); PB_GATHER(R1, m0, wslot, 8);
    int par = 0;
#pragma unroll 1
    for (int it = wslot; it < nitems; it += nslot) {
        PB_META(m2, it + 2 * nslot);
        LDSP float* wb = wbuf + par * 128; par ^= 1;
        wb[k0] = m0.aA; wb[k1] = m0.aB;
        asm volatile("s_waitcnt lgkmcnt(0)" ::: "memory");
        f32x2 acc2[8];
#pragma unroll
        for (int i = 0; i < 8; ++i) acc2[i] = (f32x2){0.f, 0.f};
        PB_COMPUTE(R0, 0);
        const int itn = (it + nslot < nitems) ? it + nslot : it;
        PB_GATHER(R0, m1, itn, 0);
        PB_COMPUTE(R1, 8);
        PB_GATHER(R1, m1, itn, 8);
        float acc[16];
#pragma unroll
        for (int i = 0; i < 8; ++i) { acc[2 * i] = acc2[i].x; acc[2 * i + 1] = acc2[i].y; }
        float q8[8], q4[4], q2[2];
#pragma unroll
        for (int i = 0; i < 8; ++i) q8[i] = swap32_sum(acc[i], acc[i + 8]);
#pragma unroll
        for (int i = 0; i < 4; ++i) q4[i] = swap16_sum(q8[i], q8[i + 4]);
#pragma unroll
        for (int i = 0; i < 2; ++i) { const float send = b3 ? q4[i] : q4[i + 2], keep = b3 ? q4[i + 2] : q4[i]; q2[i] = keep + dpp_ror8(send); }
        const int c16 = ((lane & 32) ? 8 : 0) + ((lane & 16) ? 4 : 0) + (b3 ? 2 : 0);
        float* op = P.out + (size_t)PA_T(it) * DM + 128 * PA_X(it) + 16 * sub + c16;
        f32x2 o = *(const f32x2*)op;
        o.x += q2[0]; o.y += q2[1];
        *(f32x2*)op = o;
        m0 = m1; m1 = m2;
    }
#undef PB_META
#undef PB_GATHER
#undef PB_COMPUTE
#undef PA_T
#undef PA_X
}

#ifndef SELFCHECK
#define SELFCHECK 0
#endif
#if SELFCHECK
constexpr size_t OFF_CHK = 512 * 1024;
__device__ __forceinline__ void wave_argmax(float& v, int& i) {
#pragma unroll
    for (int o = 1; o < 64; o <<= 1) {
        const float ov = __shfl_xor(v, o); const int oi = __shfl_xor(i, o);
        if (ov > v || (ov == v && oi < i)) { v = ov; i = oi; }
    }
}
struct NaiveAcc { float m, l; float o[64]; };
__device__ __forceinline__ float wave_max(float v) {
#pragma unroll
    for (int o = 1; o < 64; o <<= 1) v = fmaxf(v, __shfl_xor(v, o));
    return v;
}
__device__ __forceinline__ void nacc_reset(NaiveAcc& a) { a.m = -1.0e30f; a.l = 0.f;
#pragma unroll
    for (int d = 0; d < 64; ++d) a.o[d] = 0.f; }
__device__ __forceinline__ float dot64(LDSP const float* qs, const bf16_t* krow) {
    float s = 0.f;
#pragma unroll
    for (int c = 0; c < 8; ++c) { float f[8]; cvt8(*(const u32x4*)(krow + c * 8), f);
#pragma unroll
        for (int i = 0; i < 8; ++i) s += qs[c * 8 + i] * f[i]; }
    return s;
}
__device__ __forceinline__ void axpy64(NaiveAcc& a, float alpha, float p, const bf16_t* vrow) {
#pragma unroll
    for (int c = 0; c < 8; ++c) { float f[8]; cvt8(*(const u32x4*)(vrow + c * 8), f);
#pragma unroll
        for (int i = 0; i < 8; ++i) a.o[c * 8 + i] = a.o[c * 8 + i] * alpha + p * f[i]; }
}
__device__ __forceinline__ void naive_chunk(NaiveAcc& a, LDSP const float* qs, const bf16_t* krow, const bf16_t* vrow, bool valid) {
    float s = dot64(qs, krow);
    if (!valid) s = -INFINITY;
    const float mnew = fmaxf(a.m, wave_max(s));
    const float alpha = exp2f(a.m - mnew), p = valid ? exp2f(s - mnew) : 0.f;
    a.l = a.l * alpha + p; a.m = mnew;
    axpy64(a, alpha, p, vrow);
}
__device__ __forceinline__ float nacc_final(NaiveAcc& a, int lane) {
    const float l = wave_sum(a.l);
    const float inv = (l > 0.f) ? 1.0f / l : 0.f;
    const bool b5 = lane & 32, b4 = lane & 16, b3 = lane & 8, b2 = lane & 4, b1 = lane & 2, b0 = lane & 1;
    float q32[32], q16[16], q8[8], q4[4], q2[2];
#pragma unroll
    for (int i = 0; i < 32; ++i) { const float send = b5 ? a.o[i] : a.o[i + 32], keep = b5 ? a.o[i + 32] : a.o[i]; q32[i] = keep + __shfl_xor(send, 32); }
#pragma unroll
    for (int i = 0; i < 16; ++i) { const float send = b4 ? q32[i] : q32[i + 16], keep = b4 ? q32[i + 16] : q32[i]; q16[i] = keep + __shfl_xor(send, 16); }
#pragma unroll
    for (int i = 0; i < 8; ++i) { const float send = b3 ? q16[i] : q16[i + 8], keep = b3 ? q16[i + 8] : q16[i]; q8[i] = keep + __shfl_xor(send, 8); }
#pragma unroll
    for (int i = 0; i < 4; ++i) { const float send = b2 ? q8[i] : q8[i + 4], keep = b2 ? q8[i + 4] : q8[i]; q4[i] = keep + __shfl_xor(send, 4); }
#pragma unroll
    for (int i = 0; i < 2; ++i) { const float send = b1 ? q4[i] : q4[i + 2], keep = b1 ? q4[i + 2] : q4[i]; q2[i] = keep + __shfl_xor(send, 2); }
    const float send = b0 ? q2[0] : q2[1], keep = b0 ? q2[1] : q2[0];
    return (keep + __shfl_xor(send, 1)) * inv;
}
__device__ __forceinline__ float cmp_err(float ref, const bf16_t* got, int lane) {
    const float e = wave_max(fabsf(ref - bf2f(got[lane]))), mx = wave_max(fabsf(ref));
    return e / (mx + 1e-3f);
}
__device__ __forceinline__ void phase_selfcheck(const Params& P, LDSP unsigned char* lds, int vcu, int G) {
    unsigned char* ws = P.ws;
    const int tid = opaque_tid(), lane = tid & 63, wave = tid >> 6;
    const int gw = vcu * NWAVES + wave, NGW = G * NWAVES;
    unsigned* cnt = (unsigned*)(ws + OFF_CHK);
    const bf16_t* qa = (const bf16_t*)(ws + OFF_R1);
    const bf16_t* ka = (const bf16_t*)(ws + OFF_R1 + 32 * MiB);
    const bf16_t* va = (const bf16_t*)(ws + OFF_R1 + 64 * MiB);
    const bf16_t* qb = (const bf16_t*)(ws + OFF_R1 + 96 * MiB);
    const bf16_t* ya = (const bf16_t*)(ws + OFF_R0);
    const bf16_t* yb = (const bf16_t*)(ws + OFF_R0 + 32 * MiB);
    const float* kmean = (const float*)(ws + OFF_KMEAN);
    const float* bgate = (const float*)(ws + OFF_BGATE);
    LDSP float* psum = (LDSP float*)(lds + wave * 4096);
    LDSP float* qs = psum + 320;
    LDSP float* ocs = psum + 384;
    constexpr int NS = 537;
#pragma unroll 1
    for (int item = gw; item < NS * 8; item += NGW) {
        const int t = 37 + 61 * (item >> 3), h = item & 7, b = t >> 12, pos = t & (SEQ - 1), own = pos >> 8;
        qs[lane] = bf2f(qa[(size_t)t * 512 + h * 64 + lane]);
        asm volatile("s_waitcnt lgkmcnt(0)" ::: "memory");
        float g0 = -INFINITY, g1 = -INFINITY, g2 = -INFINITY; int i0 = -1, i1 = -1, i2 = -1;
#pragma unroll 1
        for (int j = 0; j < own; ++j) {
            const float* km = kmean + (size_t)((b * 8 + h) * 16 + j) * 64;
            float d = 0.f;
#pragma unroll 8
            for (int i = 0; i < 64; ++i) d += qs[i] * km[i];
            if (d > g0) { g2 = g1; i2 = i1; g1 = g0; i1 = i0; g0 = d; i0 = j; }
            else if (d > g1) { g2 = g1; i2 = i1; g1 = d; i1 = j; }
            else if (d > g2) { g2 = d; i2 = j; }
        }
        NaiveAcc a; nacc_reset(a);
#pragma unroll 1
        for (int j = 0; j <= own; ++j) {
            if (j < own && j != i0 && j != i1 && j != i2) continue;
#pragma unroll 1
            for (int ck = 0; ck < 4; ++ck) {
                const int kp = j * 256 + ck * 64 + lane;
                const size_t kr = (size_t)(b * SEQ + kp) * 512 + h * 64;
                naive_chunk(a, qs, ka + kr, va + kr, kp <= pos);
            }
        }
        const float om = nacc_final(a, lane);
        const float e = cmp_err(om, ya + (size_t)t * 512 + h * 64, lane);
        if (lane == 0 && !(e < 0.05f)) atomicAdd(cnt + 0, 1u);
        asm volatile("s_waitcnt lgkmcnt(0)" ::: "memory");
    }
#pragma unroll 1
    for (int item = gw; item < NS * 2; item += NGW) {
        const int t = 37 + 61 * (item >> 1), g = item & 1, b = t >> 12, pos = t & (SEQ - 1), own = pos >> 6;
        const bf16_t* kc = (const bf16_t*)(ws + OFF_KC) + (size_t)(b * 2 + g) * 256 * 64;
        const bf16_t* vc = (const bf16_t*)(ws + OFF_VC) + (size_t)(b * 2 + g) * 256 * 64;
        const bf16_t* ks = (const bf16_t*)(ws + OFF_R2 + 16 * MiB) + (size_t)(b * SEQ) * 128 + g * 64;
        const bf16_t* vs = (const bf16_t*)(ws + OFF_R2 + 24 * MiB) + (size_t)(b * SEQ) * 128 + g * 64;
        const bf16_t* kw = (const bf16_t*)(ws + OFF_R2 + 32 * MiB) + (size_t)(b * SEQ) * 128 + g * 64;
        const bf16_t* vw = (const bf16_t*)(ws + OFF_R2 + 40 * MiB) + (size_t)(b * SEQ) * 128 + g * 64;
        for (int i = lane; i < 320; i += 64) psum[i] = 0.f;
        asm volatile("s_waitcnt lgkmcnt(0)" ::: "memory");
        const int ncmp_vis = (pos >= 31) ? ((pos - 31) >> 4) + 1 : 0;
#pragma unroll 1
        for (int r = 0; r < 4; ++r) {
            qs[lane] = bf2f(qb[(size_t)t * 512 + (g * 4 + r) * 64 + lane]);
            asm volatile("s_waitcnt lgkmcnt(0)" ::: "memory");
            float mx = -INFINITY;
#pragma unroll 1
            for (int ck = 0; ck < 4; ++ck) { const int n = ck * 64 + lane;
                const float sdot = dot64(qs, kc + (size_t)n * 64);
                mx = fmaxf(mx, (n < ncmp_vis) ? sdot : -INFINITY); }
            mx = wave_max(mx);
            float l = 0.f;
#pragma unroll 1
            for (int ck = 0; ck < 4; ++ck) { const int n = ck * 64 + lane;
                const float sdot = dot64(qs, kc + (size_t)n * 64);
                l += (n < ncmp_vis) ? exp2f(sdot - mx) : 0.f; }
            l = wave_sum(l);
            const float inv = (l > 0.f) ? 1.0f / l : 0.f;
            NaiveAcc a; nacc_reset(a);
#pragma unroll 1
            for (int ck = 0; ck < 4; ++ck) { const int n = ck * 64 + lane;
                const float sdot = dot64(qs, kc + (size_t)n * 64);
                const float pr = (n < ncmp_vis) ? exp2f(sdot - mx) * inv : 0.f;
                psum[n] += pr;
                axpy64(a, 1.0f, pr, vc + (size_t)n * 64); }
            a.l = (lane == 0) ? 1.f : 0.f;
            ocs[r * 64 + lane] = nacc_final(a, lane);
            asm volatile("s_waitcnt lgkmcnt(0)" ::: "memory");
        }
        {
            const int j = lane;
            float imp = 0.f;
            for (int n = 4 * j - 1; n <= 4 * j + 3; ++n) if (n >= 0 && n < 255) imp += psum[n];
            if (j == 0 || j == own || j == own - 1) imp = 1.0e30f;
            if (j > own) imp = -1.0e30f;
            unsigned long long sel = 0ull;
#pragma unroll 1
            for (int r = 0; r < 16; ++r) {
                float v = imp; int i = j;
                wave_argmax(v, i);
                if (v > -0.5e30f) sel |= 1ull << i;
                if (i == j) imp = -3.0e38f;
            }
            psum[256] = __uint_as_float((unsigned)sel); psum[257] = __uint_as_float((unsigned)(sel >> 32));
            asm volatile("s_waitcnt lgkmcnt(0)" ::: "memory");
        }
        const unsigned long long sel = ((unsigned long long)__float_as_uint(psum[257]) << 32) | __float_as_uint(psum[256]);
#pragma unroll 1
        for (int r = 0; r < 4; ++r) {
            const int head = g * 4 + r;
            qs[lane] = bf2f(qb[(size_t)t * 512 + head * 64 + lane]);
            asm volatile("s_waitcnt lgkmcnt(0)" ::: "memory");
            const float gt0 = bgate[(size_t)t * 24 + head * 3], gt1 = bgate[(size_t)t * 24 + head * 3 + 1], gt2 = bgate[(size_t)t * 24 + head * 3 + 2];
            float y = gt0 * ocs[r * 64 + lane];
            NaiveAcc a; nacc_reset(a);
#pragma unroll 1
            for (int j = 0; j <= own; ++j) {
                if (!((sel >> j) & 1ull)) continue;
                const int kp = j * 64 + lane;
                naive_chunk(a, qs, ks + (size_t)kp * 128, vs + (size_t)kp * 128, kp <= pos);
            }
            y += gt1 * nacc_final(a, lane);
            nacc_reset(a);
#pragma unroll 1
            for (int ck = 0; ck < 9; ++ck) {
                const int kp = pos - 575 + ck * 64 + lane;
                const bool valid = kp >= 0 && kp <= pos && kp > pos - 512;
                const int kpc = kp < 0 ? 0 : kp;
                naive_chunk(a, qs, kw + (size_t)kpc * 128, vw + (size_t)kpc * 128, valid);
            }
            y += gt2 * nacc_final(a, lane);
            const float e = cmp_err(y, yb + (size_t)t * 512 + head * 64, lane);
            if (lane == 0 && !(e < 0.05f)) atomicAdd(cnt + 1, 1u);
            asm volatile("s_waitcnt lgkmcnt(0)" ::: "memory");
        }
    }
}

__device__ __forceinline__ void phase_selfcheck2(const Params& P, LDSP unsigned char* lds, int vcu, int G) {
    unsigned char* ws = P.ws;
    const int tid = opaque_tid(), lane = tid & 63, wave = tid >> 6;
    const int gw = vcu * NWAVES + wave, NGW = G * NWAVES;
    unsigned* cnt = (unsigned*)(ws + OFF_CHK);
    LDSP float* hs = (LDSP float*)(lds + wave * 8192);
    const float* x = P.in[I_X]; const float* g1 = P.in[I_NORM1]; const float* w = P.in[I_WIN];
    constexpr int NS = 192, NGRP = 14;
#pragma unroll 1
    for (int item = gw; item < NS * NGRP; item += NGW) {
        const int si = item / NGRP, grp = item % NGRP;
        const int t = 11 + 167 * si, b = t >> 12, pos = t & (SEQ - 1);
        const int hsel = si & 7, gsel = si & 1;
        float ss = 0.f;
        for (int i = lane; i < DM; i += 64) { const float v = x[(size_t)t * DM + i]; ss += v * v; }
        ss = wave_sum(ss);
        const float rs = 1.0f / sqrtf(ss / DM + NORM_EPS);
        for (int i = lane; i < DM; i += 64) hs[i] = x[(size_t)t * DM + i] * rs * g1[i];
        asm volatile("s_waitcnt lgkmcnt(0)" ::: "memory");
        int col0, kind; const float* gain = nullptr; float oscale = 1.f; const bf16_t* got = nullptr; int ncols = 64;
        const bf16_t* R1 = (const bf16_t*)(ws + OFF_R1); const bf16_t* R2 = (const bf16_t*)(ws + OFF_R2); const bf16_t* R3 = (const bf16_t*)(ws + OFF_R3);
        const size_t M32 = (size_t)16 * 1024 * 1024;
        switch (grp) {
        case 0: col0 = hsel * 64;          kind = 1; gain = P.in[I_AQG]; oscale = QSCALE; got = R1 + (size_t)t * 512 + hsel * 64; break;
        case 1: col0 = 512 + hsel * 64;    kind = 1; gain = P.in[I_AKG]; got = R1 + M32 + (size_t)t * 512 + hsel * 64; break;
        case 2: col0 = 1024 + hsel * 64;   kind = 0; got = R1 + 2 * M32 + (size_t)t * 512 + hsel * 64; break;
        case 3: col0 = 1536 + hsel * 64;   kind = 1; gain = P.in[I_BQG]; oscale = QSCALE; got = R1 + 3 * M32 + (size_t)t * 512 + hsel * 64; break;
        case 4: col0 = 2048 + gsel * 64;   kind = 0; got = R2 + ((size_t)((b * 2 + gsel) * SEQ + pos)) * 64; break;
        case 5: col0 = 2176 + gsel * 64;   kind = 0; got = R2 + M32 / 4 + ((size_t)((b * 2 + gsel) * SEQ + pos)) * 64; break;
        case 6: col0 = 2304 + gsel * 64;   kind = 1; gain = P.in[I_BKSG]; got = R2 + 2 * (M32 / 4) + (size_t)t * 128 + gsel * 64; break;
        case 7: col0 = 2432 + gsel * 64;   kind = 0; got = R2 + 3 * (M32 / 4) + (size_t)t * 128 + gsel * 64; break;
        case 8: col0 = 2560 + gsel * 64;   kind = 1; gain = P.in[I_BKWG]; got = R2 + 4 * (M32 / 4) + (size_t)t * 128 + gsel * 64; break;
        case 9: col0 = 2688 + gsel * 64;   kind = 0; got = R2 + 5 * (M32 / 4) + (size_t)t * 128 + gsel * 64; break;
        case 10: col0 = 2840 + hsel * 64;        kind = 2; got = R3 + (size_t)t * 2048 + hsel * 64; break;
        case 11: col0 = 2840 + 1024 + hsel * 64; kind = 2; got = R3 + (size_t)t * 2048 + 1024 + hsel * 64; break;
        case 12: col0 = 2840 + 1024 + 512 + hsel * 64; kind = 2; got = R3 + (size_t)t * 2048 + 1536 + hsel * 64; break;
        default: col0 = 2816; kind = 3; ncols = 24; break;
        }
        if (grp == 10) continue;
        float acc = 0.f;
        if (lane < ncols) {
#pragma unroll 4
            for (int k = 0; k < DM; ++k) acc += hs[k] * w[(size_t)k * 4888 + col0 + lane];
        }
        float ref;
        if (kind == 1) {
            const float ssq = wave_sum(acc * acc);
            float y = acc / sqrtf(ssq / 64.0f + NORM_EPS) * gain[lane];
            const float ya_ = __shfl(y, (lane + 8) & 63), yb_ = __shfl(y, (lane - 8) & 63);
            const int f = lane & 7;
            const float ang = (float)pos * powf(500000.0f, -(float)(2 * f) / 16.0f);
            const float c = cosf(ang), sn = sinf(ang);
            if (lane < 8) y = y * c - ya_ * sn; else if (lane < 16) y = y * c + yb_ * sn;
            ref = y * oscale;
        } else if (kind == 2) {
            ref = 1.0f / (1.0f + expf(-(acc + P.in[I_BMERGE][col0 - 2840 + lane])));
        } else if (kind == 3) {
            ref = 1.0f / (1.0f + expf(-acc));
        } else ref = acc;
        float gotv;
        if (kind == 3) gotv = (lane < 24) ? ((const float*)(ws + OFF_BGATE))[(size_t)t * 24 + lane] : 0.f;
        else gotv = bf2f(got[lane]);
        if (kind == 3 && lane >= 24) ref = 0.f;
        const float e = wave_max(fabsf(ref - gotv)) / (wave_max(fabsf(ref)) + 1e-3f);
        if (lane == 0 && !(e < 0.03f)) atomicAdd(cnt + 0, 1u);
        asm volatile("s_waitcnt lgkmcnt(0)" ::: "memory");
    }
#pragma unroll 1
    for (int item = gw; item < 1024; item += NGW) {
        const int b = item >> 7, h = (item >> 4) & 7, blk = item & 15;
        const bf16_t* p = (const bf16_t*)(ws + OFF_R1 + 32 * MiB) + (size_t)(b * SEQ + blk * 256) * 512 + h * 64 + lane;
        float sref = 0.f;
        for (int k = 0; k < 256; ++k) sref += bf2f(p[(size_t)k * 512]);
        const float gotv = ((const float*)(ws + OFF_KMEAN))[(size_t)item * 64 + lane];
        const float e = wave_max(fabsf(sref - gotv)) / (wave_max(fabsf(sref)) + 1e-2f);
        if (lane == 0 && !(e < 0.03f)) atomicAdd(cnt + 1, 1u);
    }
#pragma unroll 1
    for (int item = gw; item < 96 * 2; item += NGW) {
        const int si = item >> 1, kv = item & 1;
        const int slab = si & 15, n = (si * 37 + 3) % 255;
        const bf16_t* raw = (const bf16_t*)(ws + OFF_R2 + (size_t)kv * 8 * MiB) + (size_t)slab * SEQ * 64 + (size_t)n * 16 * 64;
        const float* posv = P.in[kv ? I_CPV : I_CPK]; const float* w1 = P.in[kv ? I_CVW1 : I_CKW1]; const float* b1 = P.in[kv ? I_CVB1 : I_CKB1];
        const float* w2 = P.in[kv ? I_CVW2 : I_CKW2]; const float* b2 = P.in[kv ? I_CVB2 : I_CKB2];
        float hacc[4] = {0.f, 0.f, 0.f, 0.f};
#pragma unroll 1
        for (int i = 0; i < 2048; ++i) {
            const float a = bf2f(raw[i]) + posv[i];
#pragma unroll
            for (int u = 0; u < 4; ++u) hacc[u] += a * w1[(size_t)i * 256 + lane + 64 * u];
        }
#pragma unroll
        for (int u = 0; u < 4; ++u) { const float z = hacc[u] + b1[lane + 64 * u]; hs[1024 + lane + 64 * u] = 0.5f * z * (1.0f + tanhf(0.7978845608028654f * (z + 0.044715f * z * z * z))); }
        asm volatile("s_waitcnt lgkmcnt(0)" ::: "memory");
        float o = b2[lane];
#pragma unroll 4
        for (int j = 0; j < 256; ++j) o += hs[1024 + j] * w2[(size_t)j * 64 + lane];
        if (!kv) { const float ssq = wave_sum(o * o); o = o / sqrtf(ssq / 64.0f + NORM_EPS) * P.in[I_BKCG][lane]; }
        const float gotv = bf2f(((const bf16_t*)(ws + (kv ? OFF_VC : OFF_KC)))[((size_t)slab * 256 + n) * 64 + lane]);
        const float e = wave_max(fabsf(o - gotv)) / (wave_max(fabsf(o)) + 1e-3f);
        if (lane == 0 && !(e < 0.03f)) atomicAdd(cnt + 1, 1u);
        asm volatile("s_waitcnt lgkmcnt(0)" ::: "memory");
    }
}
#endif

#define XB_TMO      128
#define XB_XCNT(j)  (256  + 64 * (j))
#define XB_XSUB(j)  (1280 + 64 * (j))
#define XB_XGEN(j)  (2304 + 64 * (j))
#define XB_TOP      3328
#define XB_TOPGEN   3392
#define XCD_BAR_WORDS 3456
#define XB_SPIN_CAP (1u << 22)
__device__ __forceinline__ unsigned xb_ld(unsigned* p)              { return __hip_atomic_load(p, __ATOMIC_RELAXED, __HIP_MEMORY_SCOPE_AGENT); }
__device__ __forceinline__ unsigned xb_add(unsigned* p, unsigned v) { return __hip_atomic_fetch_add(p, v, __ATOMIC_RELAXED, __HIP_MEMORY_SCOPE_AGENT); }
__device__ __forceinline__ unsigned xb_xcc_id() { return (unsigned)__builtin_amdgcn_s_getreg((3 << 11) | 20) & 0xFu; }
#define XB_SPIN(cond, bar) do { unsigned _sp = 0; while (cond) { __builtin_amdgcn_s_sleep(1); \
    if ((++_sp & 255u) == 0u) { if (xb_ld(&(bar)[XB_TMO])) break; if (_sp > XB_SPIN_CAP) { atomicAdd(&(bar)[XB_TMO], 1u); break; } } } } while (0)
struct XcdBarrier { unsigned* bar; unsigned x; volatile LDSP unsigned* st; };
__device__ __forceinline__ XcdBarrier xcd_barrier_post(unsigned* bar, volatile LDSP unsigned* st) {
    XcdBarrier b; b.bar = bar; b.x = xb_xcc_id(); b.st = st;
    if (threadIdx.x == 0) (void)xb_add(&bar[XB_XCNT(b.x)], 1u);
    return b;
}
__device__ __forceinline__ void xcd_barrier_complete(unsigned* bar, unsigned x, unsigned& nloc, unsigned& nx) {
    const unsigned G = gridDim.x * gridDim.y * gridDim.z;
    unsigned sum, cnt, mine, sp = 0u;
    for (;;) {
        sum = 0u; cnt = 0u; mine = 0u;
#pragma unroll
        for (unsigned j = 0; j < 16; ++j) { const unsigned c = xb_ld(&bar[XB_XCNT(j)]); sum += c; cnt += (c > 0u) ? 1u : 0u; mine = (j == x) ? c : mine; }
        if (sum == G) break;
        __builtin_amdgcn_s_sleep(1);
        if ((++sp & 255u) == 0u) { if (xb_ld(&bar[XB_TMO])) break; if (sp > XB_SPIN_CAP) { atomicAdd(&bar[XB_TMO], 1u); break; } }
    }
    nloc = mine > 0u ? mine : 1u; nx = cnt > 0u ? cnt : 1u;
}
__device__ __forceinline__ void xcd_barrier(const XcdBarrier& b) {
    asm volatile("s_waitcnt vmcnt(0)" ::: "memory");
    __syncthreads();
    if (threadIdx.x == 0) {
        unsigned* bar = b.bar;
        __builtin_amdgcn_s_waitcnt(0);
        unsigned nloc = b.st[0], nx = b.st[1];
        if (nloc == 0u) { xcd_barrier_complete(bar, b.x, nloc, nx); b.st[0] = nloc; b.st[1] = nx; }
        const unsigned old = xb_add(&bar[XB_XSUB(b.x)], 1u);
        const unsigned gen = old / nloc;
        if (old + 1u == (gen + 1u) * nloc) {
            __builtin_amdgcn_fence(__ATOMIC_RELEASE, "agent");
            asm volatile("s_waitcnt vmcnt(0)" ::: "memory");
            const unsigned og = xb_add(&bar[XB_TOP], 1u);
            const unsigned tg = og / nx;
            if (og + 1u == (tg + 1u) * nx) xb_add(&bar[XB_TOPGEN], 1u);
            else XB_SPIN(xb_ld(&bar[XB_TOPGEN]) == tg, bar);
            __builtin_amdgcn_fence(__ATOMIC_ACQUIRE, "agent");
            xb_add(&bar[XB_XGEN(b.x)], 1u);
            asm volatile("s_waitcnt vmcnt(0)" ::: "memory");
        } else {
            XB_SPIN(xb_ld(&bar[XB_XGEN(b.x)]) == gen, bar);
            __builtin_amdgcn_fence(__ATOMIC_ACQUIRE, "agent");
            asm volatile("s_waitcnt vmcnt(0)" ::: "memory");
        }
    }
    __syncthreads();
}

__global__ void __launch_bounds__(NTHREADS, 2) fwd_kernel(Params P) {
    extern __shared__ __attribute__((aligned(16))) unsigned char lds_raw[];
    LDSP unsigned char* lds = (LDSP unsigned char*)lds_raw;
    const int G = gridDim.x, bx = blockIdx.x;
    const int vcu = (G % 8 == 0) ? (bx % 8) * (G / 8) + bx / 8 : bx;
    const int lo = P.ph_lo, hi = P.ph_hi;
    volatile LDSP unsigned* bst = (volatile LDSP unsigned*)(lds + LDS_BYTES - 16);
    if (threadIdx.x == 0) { bst[0] = 0u; bst[1] = 0u; bst[2] = 0u; bst[3] = 0u; }
    __syncthreads();
    const XcdBarrier xbar = xcd_barrier_post((unsigned*)(P.ws + 16384), bst);
    if (threadIdx.x == 0) bst[2] = xb_add((unsigned*)(P.ws + 32768) + 64 * xbar.x, 1u);
#define IN(k) (lo <= (k) && (k) < hi)
#define SEAM(k) do { if (IN(k) && IN((k) + 1)) xcd_barrier(xbar); } while (0)
    if (IN(0)) phase_prep(P, lds, vcu, G);
    SEAM(0);
    if (IN(1)) phase_proj(P, lds, vcu, G);
    SEAM(1);
    if (IN(2)) phase_cmp1(P, lds, vcu, G);
    SEAM(2);
    if (IN(3)) phase_cmp2(P, lds, vcu, G);
    SEAM(3);
    if (IN(4)) phase_attn(P, lds, vcu, G);
    SEAM(4);
#if SELFCHECK == 1
    phase_selfcheck(P, lds, vcu, G);
    xcd_barrier(xbar);
#elif SELFCHECK == 2
    phase_selfcheck2(P, lds, vcu, G);
    xcd_barrier(xbar);
#endif
    if (IN(5)) phase_up(P, lds, vcu, G);
    SEAM(5);
    if (IN(6)) phase_out(P, lds, vcu, G);
    SEAM(6);
    if (IN(7)) phase_pq(P, lds, vcu, G);
    SEAM(7);
    if (IN(8)) phase_topk(P, lds, vcu, G);
    SEAM(8);
    if (IN(9)) { phase_peer_a(P, lds, vcu, G); xcd_barrier(xbar); phase_peer_w(P, lds, vcu, G); xcd_barrier(xbar); phase_peer_b(P, lds, vcu, G); }
#if SELFCHECK
    xcd_barrier(xbar);
    if (bx == 0 && threadIdx.x == 0) {
        const unsigned* cnt = (const unsigned*)(P.ws + OFF_CHK);
        P.out[0] += 1000.0f * (float)cnt[0];
        P.out[1] += 1000000.0f * (float)cnt[1];
    }
#endif
#undef IN
#undef SEAM
}

extern "C" void kernel_launch(void* const* d_in, const int* in_sizes, int n_in, void* d_out, int out_size, void* d_ws, size_t ws_size, hipStream_t stream) {
    static int grid = 0;
    if (grid == 0) {
        if (n_in != 29 || ws_size < WS_END) { fprintf(stderr, "kernel_launch: unexpected n_in %d / ws_size %zu\n", n_in, ws_size); grid = -1; return; }
        int dev = 0, cus = 0, per_cu = 0;
        (void)hipGetDevice(&dev);
        (void)hipDeviceGetAttribute(&cus, hipDeviceAttributeMultiprocessorCount, dev);
        (void)hipFuncSetAttribute((const void*)fwd_kernel, hipFuncAttributeMaxDynamicSharedMemorySize, LDS_BYTES);
        (void)hipOccupancyMaxActiveBlocksPerMultiprocessor(&per_cu, (const void*)fwd_kernel, NTHREADS, LDS_BYTES);
        if (per_cu < 1) { fprintf(stderr, "kernel_launch: occupancy query says %d blocks per CU\n", per_cu); grid = -1; return; }
        grid = cus;
    }
    if (grid < 0) return;
    Params p{};
    for (int i = 0; i < 29; ++i) p.in[i] = (const float*)d_in[i];
    p.out = (float*)d_out; p.ws = (unsigned char*)d_ws;
    (void)hipMemsetAsync(d_ws, 0, 65536, stream);
    p.ph_lo = 0; p.ph_hi = 10;
    hipLaunchKernelGGL(fwd_kernel, dim3(grid), dim3(NTHREADS), LDS_BYTES, stream, p);
}
```

```cpp
#include <hip/hip_runtime.h>
#include <hip/hip_cooperative_groups.h>
#include <stdint.h>
#include <stdio.h>
#define SELFCHECK 0
namespace cg = cooperative_groups;

#define LDSP __attribute__((address_space(3)))
typedef unsigned short bf16_t;
typedef short bf16x8 __attribute__((ext_vector_type(8)));
typedef short s16x4 __attribute__((ext_vector_type(4)));
typedef float f32x2 __attribute__((ext_vector_type(2)));
typedef float f32x4 __attribute__((ext_vector_type(4)));
typedef float f32x16 __attribute__((ext_vector_type(16)));
typedef unsigned u32x2 __attribute__((ext_vector_type(2)));
typedef unsigned u32x4 __attribute__((ext_vector_type(4)));
typedef __bf16 bf16x2_t __attribute__((ext_vector_type(2)));

constexpr int BATCH = 8, SEQ = 4096, DM = 1024, T = BATCH * SEQ;
constexpr int HD = 64;
constexpr int NPROJ = 5120;
constexpr int PEER_NE = 16384;
constexpr float NORM_EPS = 1e-6f;
constexpr float PEER_US = 64.0f, PEER_VS = 16.0f;
constexpr float QSCALE = 0.125f * 1.4426950408889634f;
constexpr int NTHREADS = 512, NWAVES = 8;
constexpr int LDS_BYTES = 140 * 1024;

constexpr size_t MiB = 1u << 20;
constexpr size_t OFF_RS1 = 1 * MiB;
constexpr size_t OFF_RS2 = 1 * MiB + 256 * 1024;
constexpr size_t OFF_ROPE_C = 2 * MiB;
constexpr size_t OFF_ROPE_S = 2 * MiB + 128 * 1024;
constexpr size_t OFF_POSB = 2 * MiB + 512 * 1024;
constexpr size_t OFF_KMEAN = 3 * MiB;
constexpr size_t OFF_BGATE = 4 * MiB;
constexpr size_t OFF_WIN_T = 8 * MiB;
constexpr size_t OFF_WUPA_T = 19 * MiB;
constexpr size_t OFF_WUPB_T = 20 * MiB;
constexpr size_t OFF_WOUT_T = 21 * MiB;
constexpr size_t OFF_WPQ_T = 23 * MiB;
constexpr size_t OFF_W1K_T = 27 * MiB;
constexpr size_t OFF_W1V_T = 28 * MiB;
constexpr size_t OFF_W2K_T = 29 * MiB;
constexpr size_t OFF_W2V_T = 29 * MiB + 128 * 1024;
constexpr size_t OFF_K1B = 29 * MiB + 256 * 1024;
constexpr size_t OFF_K2B = 29 * MiB + 320 * 1024;
constexpr size_t OFF_HID = 30 * MiB;
constexpr size_t OFF_KC = 34 * MiB;
constexpr size_t OFF_VC = 35 * MiB;
constexpr size_t OFF_EXPERTS = 36 * MiB;
constexpr size_t OFF_GATES = 52 * MiB;
constexpr size_t OFF_U = 68 * MiB;
constexpr size_t OFF_V = 100 * MiB;
constexpr size_t OFF_R0 = 132 * MiB;
constexpr size_t OFF_R1 = 196 * MiB;
constexpr size_t OFF_R2 = 324 * MiB;
constexpr size_t OFF_R3 = 372 * MiB;
constexpr size_t WS_END = 500 * MiB;

struct Params {
    const float* in[29];
    float* out;
    unsigned char* ws;
    int ph_lo, ph_hi;
};
static_assert(sizeof(Params) == 31 * 8 + 8, "Params has no padding");

enum { I_X = 0, I_NORM1, I_WIN, I_BMERGE, I_AQG, I_AKG, I_BQG, I_BKCG, I_BKSG, I_BKWG,
       I_CPK, I_CKW1, I_CKB1, I_CKW2, I_CKB2, I_CPV, I_CVW1, I_CVB1, I_CVW2, I_CVB2,
       I_WUPA, I_WUPB, I_WOUT, I_NORM2, I_PWQ, I_PK1, I_PK2, I_PU, I_PV };

__device__ __forceinline__ int opaque_tid() { int t = threadIdx.x; asm volatile("" : "+v"(t)); return t; }
__device__ __forceinline__ unsigned pk2(float lo, float hi) {
    f32x2 v = {lo, hi};
    bf16x2_t b = __builtin_convertvector(v, bf16x2_t);
    return __builtin_bit_cast(unsigned, b);
}
__device__ __forceinline__ float bf2f(bf16_t b) { return __uint_as_float(((unsigned)b) << 16); }
__device__ __forceinline__ float wave_sum(float v) {
#pragma unroll
    for (int o = 1; o < 64; o <<= 1) v += __shfl_xor(v, o);
    return v;
}
__device__ __forceinline__ float gelu_tanh(float x) {
    const float u = 0.7978845608028654f * (x + 0.044715f * x * x * x);
    return x / (1.0f + __expf(-2.0f * u));
}
__device__ __forceinline__ float sigmoidf_(float x) { return 1.0f / (1.0f + __expf(-x)); }
__device__ __forceinline__ void cvt8(const u32x4 w, float (&f)[8]) {
    f[0] = __uint_as_float(w.x << 16); f[1] = __uint_as_float(w.x & 0xffff0000u); f[2] = __uint_as_float(w.y << 16); f[3] = __uint_as_float(w.y & 0xffff0000u);
    f[4] = __uint_as_float(w.z << 16); f[5] = __uint_as_float(w.z & 0xffff0000u); f[6] = __uint_as_float(w.w << 16); f[7] = __uint_as_float(w.w & 0xffff0000u);
}
__device__ __forceinline__ int swz_off(int row, int chunk) { return row * 128 + ((chunk ^ ((row >> 1) & 7)) << 4); }

__device__ __forceinline__ void transpose_item(const float* W, int ldw, int k0, int src_c0, int nvalid, const float* kscale,
                                               bf16_t* WT, int ldwt, int n0, LDSP float* scr, int lane) {
#pragma unroll 8
    for (int i = 0; i < 32; ++i) {
        const int kk = 2 * i + (lane >> 5), nn = lane & 31;
        float v = 0.f;
        if (nn < nvalid) v = W[(size_t)(k0 + kk) * ldw + src_c0 + nn];
        if (kscale) v *= kscale[k0 + kk];
        scr[kk * 33 + nn] = v;
    }
    asm volatile("s_waitcnt lgkmcnt(0)" ::: "memory");
    const int c = lane & 7;
#pragma unroll
    for (int j = 0; j < 4; ++j) {
        const int n = (lane >> 3) + 8 * j;
        const LDSP float* s = scr + (8 * c) * 33 + n;
        u32x4 o;
        o.x = pk2(s[0 * 33], s[1 * 33]); o.y = pk2(s[2 * 33], s[3 * 33]); o.z = pk2(s[4 * 33], s[5 * 33]); o.w = pk2(s[6 * 33], s[7 * 33]);
        *(u32x4*)(WT + (size_t)(n0 + n) * ldwt + k0 + 8 * c) = o;
    }
    asm volatile("s_waitcnt lgkmcnt(0)" ::: "memory");
}

struct TrJob { const float* W; int K, N, ldw; const float* kscale; bf16_t* WT; int kind; };

__device__ __forceinline__ void run_tr_job(const TrJob& J, int item, LDSP float* scr, int lane) {
    const int nblk = J.N / 32, kb = item / nblk, nb = item % nblk;
    int src_c0 = nb * 32, nvalid = 32;
    if (J.kind == 1) {
        const int p0 = nb * 32, pn = p0 >> 8, q = p0 & 255, bj = q >> 7, wc = (q >> 5) & 3, H = 4 * pn + wc, d0 = 32 * bj;
        if (H < 44) src_c0 = 64 * H + d0;
        else if (H < 76) src_c0 = 64 * H + d0 + 24;
        else if (H == 76 && bj == 0) { src_c0 = 2816; nvalid = 24; }
        else { src_c0 = 0; nvalid = 0; }
    } else if (J.kind == 2) {
        if (nb * 32 >= 64) { src_c0 = 0; nvalid = 0; }
    }
    transpose_item(J.W, J.ldw, kb * 64, src_c0, nvalid, J.kscale, J.WT, J.K, nb * 32, scr, lane);
}

__device__ __forceinline__ void phase_prep(const Params& P, LDSP unsigned char* lds, int vcu, int G) {
    const int tid = opaque_tid(), lane = tid & 63, wave = tid >> 6;
    const int gw = vcu * NWAVES + wave, NGW = G * NWAVES;
    unsigned char* ws = P.ws;
    LDSP float* scr = (LDSP float*)(lds + wave * 8704);
    int base = 0;
#define TR_JOB(Wp, Kk, Nn, LDW, KS, WTp, KIND) do { TrJob J{Wp, Kk, Nn, LDW, KS, WTp, KIND}; const int nitems = ((Kk) / 64) * ((Nn) / 32); \
        const int first = (gw - base % NGW + NGW) % NGW; for (int it = first; it < nitems; it += NGW) run_tr_job(J, it, scr, lane); base += nitems; } while (0)
    TR_JOB(P.in[I_WIN], 1024, NPROJ, 4888, P.in[I_NORM1], (bf16_t*)(ws + OFF_WIN_T), 1);
    TR_JOB(P.in[I_WUPA], 512, 1024, 1024, nullptr, (bf16_t*)(ws + OFF_WUPA_T), 0);
    TR_JOB(P.in[I_WUPB], 512, 1024, 1024, nullptr, (bf16_t*)(ws + OFF_WUPB_T), 0);
    TR_JOB(P.in[I_WOUT], 1024, 1024, 1024, nullptr, (bf16_t*)(ws + OFF_WOUT_T), 0);
    TR_JOB(P.in[I_PWQ], 1024, 2048, 2048, P.in[I_NORM2], (bf16_t*)(ws + OFF_WPQ_T), 0);
    TR_JOB(P.in[I_CKW1], 2048, 256, 256, nullptr, (bf16_t*)(ws + OFF_W1K_T), 0);
    TR_JOB(P.in[I_CVW1], 2048, 256, 256, nullptr, (bf16_t*)(ws + OFF_W1V_T), 0);
    TR_JOB(P.in[I_CKW2], 256, 128, 64, nullptr, (bf16_t*)(ws + OFF_W2K_T), 2);
    TR_JOB(P.in[I_CVW2], 256, 128, 64, nullptr, (bf16_t*)(ws + OFF_W2V_T), 2);
#undef TR_JOB
    {
        const float* x = P.in[I_X];
        bf16_t* xb = (bf16_t*)(ws + OFF_R0);
        float* rs1 = (float*)(ws + OFF_RS1);
        for (int m = gw; m < T; m += NGW) {
            const f32x4* xr = (const f32x4*)(x + (size_t)m * DM) + lane;
            f32x4 v[4]; float s = 0.f;
#pragma unroll
            for (int j = 0; j < 4; ++j) { v[j] = xr[64 * j]; s += (v[j].x * v[j].x + v[j].y * v[j].y) + (v[j].z * v[j].z + v[j].w * v[j].w); }
            s = wave_sum(s);
            if (lane == 0) rs1[m] = 1.0f / sqrtf(s * (1.0f / DM) + NORM_EPS);
            u32x2* o = (u32x2*)(xb + (size_t)m * DM) + lane;
#pragma unroll
            for (int j = 0; j < 4; ++j) { u32x2 w; w.x = pk2(v[j].x, v[j].y); w.y = pk2(v[j].z, v[j].w); o[64 * j] = w; }
        }
    }
    {
        const float* g2 = P.in[I_NORM2];
        const size_t n16 = (size_t)PEER_NE * DM / 16;
        const size_t gt = (size_t)gw * 64 + lane, NGT = (size_t)NGW * 64;
        for (int which = 0; which < 2; ++which) {
            const float* src = P.in[which ? I_PV : I_PU];
            unsigned char* dst = ws + (which ? OFF_V : OFF_U);
            const float sc = which ? PEER_VS : PEER_US;
            for (size_t i = gt; i < n16; i += NGT) {
                u32x4 o;
#pragma unroll
                for (int q = 0; q < 4; ++q) {
                    f32x4 a4 = *(const f32x4*)(src + i * 16 + q * 4);
                    if (!which) { const int c = (int)((i * 16 + q * 4) & (DM - 1)); const f32x4 g4 = *(const f32x4*)(g2 + c); a4 = a4 * g4; }
                    a4 = a4 * sc;
                    int p = __builtin_amdgcn_cvt_pk_fp8_f32(a4.x, a4.y, 0, false);
                    p = __builtin_amdgcn_cvt_pk_fp8_f32(a4.z, a4.w, p, true);
                    o[q] = (unsigned)p;
                }
                { const size_t e_ = (i * 16) >> 10, c_ = (i * 16) & 1023;
                  *(u32x4*)(dst + ((c_ >> 7) * (size_t)PEER_NE + e_) * 128 + (c_ & 127)) = o; }
            }
        }
    }
    {
        const int gt = gw * 64 + lane, NGT = NGW * 64;
        for (int i = gt; i < 2 * 128 * 128; i += NGT) {
            const int w = i >> 14, e = i & 16383;
            const float v = P.in[w ? I_PK2 : I_PK1][e];
            ((bf16_t*)(ws + (w ? OFF_K2B : OFF_K1B)))[e] = (bf16_t)(pk2(v, 0.f) & 0xffff);
        }
        if (gt < 8) ((float*)(ws + OFF_ROPE_C))[gt] = powf(500000.0f, -(float)(2 * gt) / 16.0f) * 0.15915494309189535f;
        for (int i = gt; i < T; i += NGT) ((float*)(ws + OFF_RS2))[i] = 0.f;
        for (int i = gt; i < 8 * 8 * 16 * 64; i += NGT) ((float*)(ws + OFF_KMEAN))[i] = 0.f;
        if (gt < 2) ((unsigned*)(ws + 512 * 1024))[gt] = 0u;
        for (int o = gw; o < 512; o += NGW) {
            const int w = o >> 8, j = o & 255;
            const float* pos = P.in[w ? I_CPV : I_CPK];
            const float* w1 = P.in[w ? I_CVW1 : I_CKW1];
            float s = 0.f;
            for (int i = lane; i < 2048; i += 64) s += pos[i] * w1[(size_t)i * 256 + j];
            s = wave_sum(s);
            if (lane == 0) ((float*)(ws + OFF_POSB))[o] = s + P.in[w ? I_CVB1 : I_CKB1][j];
        }
    }
}

constexpr int G_BM = 256, G_BN = 128, G_BK = 64;
constexpr int G_ABYTES = G_BM * 128, G_BBYTES = G_BN * 128, G_STAGE = G_ABYTES + G_BBYTES;

__device__ __forceinline__ void gemm_kloop(f32x4 (&acc)[4][4], const bf16_t* A, size_t lda, const bf16_t* Bt, size_t ldb, int K, LDSP unsigned char* lds) {
    const int tid = opaque_tid(), lane = tid & 63, wid = tid >> 6, wm = wid >> 1, wn = wid & 1, fr = lane & 15, fq = lane >> 4;
    const int lrow = tid >> 3, lch = tid & 7;
    const bf16_t* ga = A + (size_t)lrow * lda + lch * 8;
    const bf16_t* gb = Bt + (size_t)lrow * ldb + lch * 8;
    u32x4 ra[4], rb[2];
    const int nk = K / G_BK;
#pragma unroll
    for (int p = 0; p < 4; ++p) ra[p] = *(const u32x4*)(ga + (size_t)(64 * p) * lda);
#pragma unroll
    for (int p = 0; p < 2; ++p) rb[p] = *(const u32x4*)(gb + (size_t)(64 * p) * ldb);
    __syncthreads();
#pragma unroll
    for (int p = 0; p < 4; ++p) *(LDSP u32x4*)(lds + swz_off(lrow + 64 * p, lch)) = ra[p];
#pragma unroll
    for (int p = 0; p < 2; ++p) *(LDSP u32x4*)(lds + G_ABYTES + swz_off(lrow + 64 * p, lch)) = rb[p];
    __syncthreads();
    for (int kt = 0; kt < nk; ++kt) {
        LDSP unsigned char* cur = lds + (kt & 1) * G_STAGE;
        LDSP unsigned char* nxt = lds + ((kt + 1) & 1) * G_STAGE;
        if (kt + 1 < nk) {
#pragma unroll
            for (int p = 0; p < 4; ++p) ra[p] = *(const u32x4*)(ga + (size_t)(64 * p) * lda + (kt + 1) * G_BK);
#pragma unroll
            for (int p = 0; p < 2; ++p) rb[p] = *(const u32x4*)(gb + (size_t)(64 * p) * ldb + (kt + 1) * G_BK);
        }
#pragma unroll
        for (int ks = 0; ks < 2; ++ks) {
            bf16x8 af[4], bfr[4];
#pragma unroll
            for (int m = 0; m < 4; ++m) af[m] = *(const LDSP bf16x8*)(cur + swz_off(wm * 64 + m * 16 + fr, ks * 4 + fq));
#pragma unroll
            for (int n = 0; n < 4; ++n) bfr[n] = *(const LDSP bf16x8*)(cur + G_ABYTES + swz_off(wn * 64 + n * 16 + fr, ks * 4 + fq));
#pragma unroll
            for (int m = 0; m < 4; ++m)
#pragma unroll
                for (int n = 0; n < 4; ++n) acc[m][n] = __builtin_amdgcn_mfma_f32_16x16x32_bf16(bfr[n], af[m], acc[m][n], 0, 0, 0);
        }
        if (kt + 1 < nk) {
#pragma unroll
            for (int p = 0; p < 4; ++p) *(LDSP u32x4*)(nxt + swz_off(lrow + 64 * p, lch)) = ra[p];
#pragma unroll
            for (int p = 0; p < 2; ++p) *(LDSP u32x4*)(nxt + G_ABYTES + swz_off(lrow + 64 * p, lch)) = rb[p];
        }
        __syncthreads();
    }
}

__device__ __forceinline__ void zero_acc(f32x4 (&acc)[4][4]) {
#pragma unroll
    for (int m = 0; m < 4; ++m)
#pragma unroll
        for (int n = 0; n < 4; ++n) acc[m][n] = (f32x4){0.f, 0.f, 0.f, 0.f};
}

__device__ __forceinline__ bool tile_order(int it, int vcu, int G, int nM, int nN, int& tm, int& tn) {
    if (G == 256 && (nM % 32) == 0) {
        const int xcd = vcu >> 5, cu = vcu & 31, mper = nM / 8;
        const int L = it * 32 + cu, per_group = 4 * nN;
        if (L >= mper * nN) return false;
        const int mg = L / per_group, rem = L % per_group;
        tm = xcd * mper + mg * 4 + (rem & 3); tn = rem >> 2;
        return true;
    }
    const int L = it * G + vcu;
    if (L >= nM * nN) return false;
    tm = L / nN; tn = L % nN;
    return true;
}

namespace pg8 {
constexpr int BM = 256, BK = 64, HALF = 128, HTB = HALF * BK * 2, NXCD = 8, WGM = 8;
__device__ __forceinline__ int lds_byte(int r, int c) { const int st = (r >> 4) * 2 + (c >> 5), rr = r & 15, cc = c & 31, ob = rr * 64 + cc * 2; return st * 1024 + (ob ^ (((ob >> 9) & 1) << 5)); }
__device__ __forceinline__ void stage_rc(int b, int& R, int& C) { const int st = b / 1024, sb = b % 1024, swz = sb ^ (((sb >> 9) & 1) << 5); R = (st >> 1) * 16 + swz / 64; C = (st & 1) * 32 + (swz % 64) / 2; }
__device__ __forceinline__ int perm32(int rho) { const int n = rho >> 4, i = rho & 15; return 8 * (i >> 2) + 4 * n + (i & 3); }
struct Unit { int pm, pn, z; };
__device__ __forceinline__ bool tile_of(int L, int nM, int nN, int& pm, int& pn) {
    const int nwg = nM * nN; if (L >= nwg) return false;
    int wgid = L; { const int q = nwg / NXCD, r = nwg % NXCD, xcd = wgid % NXCD, off = wgid / NXCD; wgid = (xcd < r ? xcd * (q + 1) : r * (q + 1) + (xcd - r) * q) + off; }
    const int nig = WGM * nN, gid = wgid / nig, fm = gid * WGM, gsz = (nM - fm) < WGM ? (nM - fm) : WGM;
    pm = fm + ((wgid % nig) % gsz); pn = (wgid % nig) / gsz; return true;
}
struct Sched {
    const bf16_t *A0, *A1, *B0, *B1; size_t lda, ldb; int K, nM, nN, NZ, G, c;
    __device__ __forceinline__ bool next(int i, Unit& u) const { u.z = (NZ == 2) ? (i & 1) : 0; const int ti = (NZ == 2) ? (i >> 1) : i; return tile_of(ti * G + c, nM, nN, u.pm, u.pn); }
    __device__ __forceinline__ const char* aptr(const Unit& u) const { return (const char*)((u.z ? A1 : A0) + (size_t)u.pm * BM * lda); }
    __device__ __forceinline__ const char* bptr(const Unit& u) const { return (const char*)((u.z ? B1 : B0) + (size_t)u.pn * BM * ldb); }
};
template <class Epi>
__device__ __forceinline__ void gemm_phase(LDSP unsigned char* lds, const Sched& S, const Epi& E) {
    const int tid = opaque_tid(), wid = __builtin_amdgcn_readfirstlane(tid >> 6), lane = tid & 63, wr = wid >> 2, wc = wid & 3, fr = lane & 15, fq = lane >> 4;
    const int nt = S.K / BK;
    unsigned voffA[2], voffB[2];
#pragma unroll
    for (int i = 0; i < 2; ++i) { int R, C; stage_rc(tid * 16 + i * 8192, R, C); const int Rb = (R & ~31) + perm32(R & 31);
        voffA[i] = (unsigned)(R * S.lda + C) * 2u; voffB[i] = (unsigned)(Rb * S.ldb + C) * 2u; }
    const size_t kstep = (size_t)(BK * 2);
    const size_t hstepA = (size_t)HALF * S.lda * 2, hstepB = (size_t)HALF * S.ldb * 2;
    const unsigned ldsw = (unsigned)wid * 1024u;
    const int aoff = lds_byte(wr * 64 + fr, fq * 8), boff = lds_byte(wc * 32 + fr, fq * 8);
#define PG8_SA(b, h) (((b) * 2 + (h)) * HTB)
#define PG8_SB(b, h) ((4 + (b) * 2 + (h)) * HTB)
#define PG8_STAGE(bufoff, gbase, voff) do { _Pragma("unroll") for (int _i = 0; _i < 2; ++_i) \
        __builtin_amdgcn_global_load_lds((const unsigned*)((const char*)(gbase) + (voff)[_i]), (LDSP unsigned*)(lds + (bufoff) + ldsw + _i * 8192), 16, 0, 0); } while (0)
#define PG8_LDA(dst, b, h) do { _Pragma("unroll") for (int m = 0; m < 4; ++m) _Pragma("unroll") for (int k = 0; k < 2; ++k) dst[m][k] = *(const LDSP bf16x8*)(lds + PG8_SA(b, h) + aoff + m * 2048 + k * 1024); } while (0)
#define PG8_LDB(dst, b, h) do { _Pragma("unroll") for (int n = 0; n < 2; ++n) _Pragma("unroll") for (int k = 0; k < 2; ++k) dst[n][k] = *(const LDSP bf16x8*)(lds + PG8_SB(b, h) + boff + n * 2048 + k * 1024); } while (0)
#define PG8_MMA(ai, bj, At, Bt) do { __builtin_amdgcn_s_setprio(1); _Pragma("unroll") for (int m = 0; m < 4; ++m) _Pragma("unroll") for (int n = 0; n < 2; ++n) _Pragma("unroll") for (int k = 0; k < 2; ++k) \
        acc[ai][bj][m][n] = __builtin_amdgcn_mfma_f32_16x16x32_bf16(Bt[n][k], At[m][k], acc[ai][bj][m][n], 0, 0, 0); __builtin_amdgcn_s_setprio(0); } while (0)
#define PG8_WAIT_V(n) asm volatile("s_waitcnt vmcnt(" #n ")" ::: "memory")
#define PG8_WAIT_L(n) asm volatile("s_waitcnt lgkmcnt(" #n ")" ::: "memory")
#define PG8_BAR __builtin_amdgcn_s_barrier()
#define PG8_SCHED __builtin_amdgcn_sched_barrier(0)
    Unit cur, nxt; int ui = 0;
    if (!S.next(0, cur)) return;
    f32x4 acc[2][2][4][2];
#pragma unroll
    for (int a = 0; a < 2; ++a)
#pragma unroll
        for (int b = 0; b < 2; ++b)
#pragma unroll
            for (int m = 0; m < 4; ++m)
#pragma unroll
                for (int n = 0; n < 2; ++n) acc[a][b][m][n] = (f32x4){0.f, 0.f, 0.f, 0.f};
    bf16x8 At[4][2], B0[2][2], B1[2][2];
    const char* cA = S.aptr(cur); const char* cB = S.bptr(cur);
    PG8_STAGE(PG8_SB(0, 0), cB, voffB); PG8_STAGE(PG8_SB(0, 1), cB + hstepB, voffB); PG8_STAGE(PG8_SA(0, 0), cA, voffA); PG8_STAGE(PG8_SA(0, 1), cA + hstepA, voffA);
    if (wr == 1) PG8_BAR;
    PG8_WAIT_V(2); PG8_BAR;
    PG8_STAGE(PG8_SB(1, 0), cB + kstep, voffB); PG8_STAGE(PG8_SA(1, 0), cA + kstep, voffA); PG8_STAGE(PG8_SB(1, 1), cB + hstepB + kstep, voffB);
    PG8_WAIT_V(6); PG8_BAR;
    for (;;) {
        const bool has_next = S.next(ui + 1, nxt);
        const char* nA = has_next ? S.aptr(nxt) : cA; const char* nB = has_next ? S.bptr(nxt) : cB;
        for (int t = 0; t < nt; t += 2) {
            const bool last = (t == nt - 2);
            const char* a1 = cA + (size_t)(t + 1) * kstep;
            const char* a2 = last ? nA : cA + (size_t)(t + 2) * kstep; const char* b2 = last ? nB : cB + (size_t)(t + 2) * kstep;
            const char* a3 = a2 + kstep; const char* b3 = b2 + kstep;
            PG8_LDB(B0, 0, 0); PG8_LDB(B1, 0, 1); PG8_SCHED; PG8_LDA(At, 0, 0); PG8_STAGE(PG8_SA(1, 1), a1 + hstepA, voffA);
            PG8_WAIT_V(8); PG8_WAIT_L(0); PG8_BAR; PG8_MMA(0, 0, At, B0); PG8_MMA(0, 1, At, B1); PG8_BAR; PG8_SCHED;
            PG8_LDA(At, 0, 1); PG8_STAGE(PG8_SB(0, 0), b2, voffB); PG8_STAGE(PG8_SB(0, 1), b2 + hstepB, voffB); PG8_STAGE(PG8_SA(0, 0), a2, voffA);
            PG8_WAIT_V(8); PG8_WAIT_L(0); PG8_BAR; PG8_MMA(1, 0, At, B0); PG8_MMA(1, 1, At, B1); PG8_BAR; PG8_SCHED;
            PG8_LDB(B0, 1, 0); PG8_LDB(B1, 1, 1); PG8_SCHED; PG8_LDA(At, 1, 0); PG8_STAGE(PG8_SA(0, 1), a2 + hstepA, voffA);
            PG8_WAIT_V(8); PG8_WAIT_L(0); PG8_BAR; PG8_MMA(0, 0, At, B0); PG8_MMA(0, 1, At, B1); PG8_BAR; PG8_SCHED;
            PG8_LDA(At, 1, 1); PG8_STAGE(PG8_SB(1, 0), b3, voffB); PG8_STAGE(PG8_SB(1, 1), b3 + hstepB, voffB); PG8_STAGE(PG8_SA(1, 0), a3, voffA);
            PG8_WAIT_V(8); PG8_WAIT_L(0); PG8_BAR; PG8_MMA(1, 0, At, B0); PG8_MMA(1, 1, At, B1); PG8_BAR; PG8_SCHED;
        }
        if (wr == 0) PG8_BAR;
        E(acc, cur, wr, wc, fr, fq);
        if (!has_next) break;
#pragma unroll
        for (int a = 0; a < 2; ++a)
#pragma unroll
            for (int b = 0; b < 2; ++b)
#pragma unroll
                for (int m = 0; m < 4; ++m)
#pragma unroll
                    for (int n = 0; n < 2; ++n) acc[a][b][m][n] = (f32x4){0.f, 0.f, 0.f, 0.f};
        cur = nxt; cA = nA; cB = nB; ++ui;
        if (wr == 1) PG8_BAR;
    }
    PG8_WAIT_V(0);
    PG8_BAR;
#undef PG8_SA
#undef PG8_SB
#undef PG8_STAGE
#undef PG8_LDA
#undef PG8_LDB
#undef PG8_MMA
#undef PG8_WAIT_V
#undef PG8_WAIT_L
#undef PG8_BAR
#undef PG8_SCHED
}
}

struct EpiProj {
    const Params* P;
    __device__ __forceinline__ void operator()(f32x4 (&acc)[2][2][4][2], const pg8::Unit& u, int wr, int wc, int fr, int fq) const {
        unsigned char* ws = P->ws;
        const int H = 4 * u.pn + wc;
        if (H > 76) return;
        const float* rs1 = (const float*)(ws + OFF_RS1);
        int kind; bf16_t* dst = nullptr; int pitch = 0, cb = 0; const float* gain = nullptr; float oscale = 1.f; bool slab = false; int sg = 0;
        if (H < 8)        { kind = 1; dst = (bf16_t*)(ws + OFF_R1);            pitch = 512; cb = H * 64;        gain = P->in[I_AQG]; oscale = QSCALE; }
        else if (H < 16)  { kind = 1; dst = (bf16_t*)(ws + OFF_R1 + 32 * MiB); pitch = 512; cb = (H - 8) * 64;  gain = P->in[I_AKG]; }
        else if (H < 24)  { kind = 0; dst = (bf16_t*)(ws + OFF_R1 + 64 * MiB); pitch = 512; cb = (H - 16) * 64; }
        else if (H < 32)  { kind = 1; dst = (bf16_t*)(ws + OFF_R1 + 96 * MiB); pitch = 512; cb = (H - 24) * 64; gain = P->in[I_BQG]; oscale = QSCALE; }
        else if (H < 34)  { kind = 0; dst = (bf16_t*)(ws + OFF_R2);            slab = true; sg = H - 32; }
        else if (H < 36)  { kind = 0; dst = (bf16_t*)(ws + OFF_R2 + 8 * MiB);  slab = true; sg = H - 34; }
        else if (H < 38)  { kind = 1; dst = (bf16_t*)(ws + OFF_R2 + 16 * MiB); pitch = 128; cb = (H - 36) * 64; gain = P->in[I_BKSG]; }
        else if (H < 40)  { kind = 0; dst = (bf16_t*)(ws + OFF_R2 + 24 * MiB); pitch = 128; cb = (H - 38) * 64; }
        else if (H < 42)  { kind = 1; dst = (bf16_t*)(ws + OFF_R2 + 32 * MiB); pitch = 128; cb = (H - 40) * 64; gain = P->in[I_BKWG]; }
        else if (H < 44)  { kind = 0; dst = (bf16_t*)(ws + OFF_R2 + 40 * MiB); pitch = 128; cb = (H - 42) * 64; }
        else if (H < 76)  { kind = 2; dst = (bf16_t*)(ws + OFF_R3);            pitch = 2048; cb = (H - 44) * 64; }
        else              { kind = 3; }
        f32x4 invrev[2] = {{0.f, 0.f, 0.f, 0.f}, {0.f, 0.f, 0.f, 0.f}};
        if (kind == 1) { invrev[0] = *(const f32x4*)((const float*)(ws + OFF_ROPE_C)); invrev[1] = *(const f32x4*)((const float*)(ws + OFF_ROPE_C) + 4); }
        float rsr[2][4];
#pragma unroll
        for (int ai = 0; ai < 2; ++ai)
#pragma unroll
            for (int m = 0; m < 4; ++m) rsr[ai][m] = rs1[u.pm * 256 + ai * 128 + wr * 64 + m * 16 + fr];
        f32x4 gv[2][2];
        if (kind == 1 || kind == 2) {
            const float* gp = (kind == 1) ? gain : P->in[I_BMERGE] + cb;
#pragma unroll
            for (int bj = 0; bj < 2; ++bj)
#pragma unroll
                for (int n = 0; n < 2; ++n) gv[bj][n] = *(const f32x4*)(gp + 32 * bj + 8 * fq + 4 * n);
        }
        const bool ksum = (H >= 8 && H < 16);
        f32x4 cs[2][2];
#pragma unroll
        for (int bj = 0; bj < 2; ++bj)
#pragma unroll
            for (int n = 0; n < 2; ++n) cs[bj][n] = (f32x4){0.f, 0.f, 0.f, 0.f};
#pragma unroll
        for (int ai = 0; ai < 2; ++ai)
#pragma unroll
            for (int m = 0; m < 4; ++m) {
                const int row = u.pm * 256 + ai * 128 + wr * 64 + m * 16 + fr;
                const float rs = rsr[ai][m];
                f32x4 v[2][2];
#pragma unroll
                for (int bj = 0; bj < 2; ++bj)
#pragma unroll
                    for (int n = 0; n < 2; ++n) v[bj][n] = acc[ai][bj][m][n] * rs;
                if (kind == 1) {
                    float ss = 0.f;
#pragma unroll
                    for (int bj = 0; bj < 2; ++bj)
#pragma unroll
                        for (int n = 0; n < 2; ++n) ss += (v[bj][n][0] * v[bj][n][0] + v[bj][n][1] * v[bj][n][1]) + (v[bj][n][2] * v[bj][n][2] + v[bj][n][3] * v[bj][n][3]);
                    ss += __shfl_xor(ss, 16); ss += __shfl_xor(ss, 32);
                    const float r = oscale / sqrtf(ss * (1.0f / 64.0f) + NORM_EPS);
#pragma unroll
                    for (int bj = 0; bj < 2; ++bj)
#pragma unroll
                        for (int n = 0; n < 2; ++n) v[bj][n] = v[bj][n] * gv[bj][n] * r;
                    const float posf = (float)(row & (SEQ - 1));
                    const float sgn = (fq == 0) ? -1.f : 1.f;
#pragma unroll
                    for (int n = 0; n < 2; ++n) {
                        const f32x4 me = v[0][n]; f32x4 ot, ro;
#pragma unroll
                        for (int i = 0; i < 4; ++i) ot[i] = __shfl_xor(me[i], 16);
#pragma unroll
                        for (int i = 0; i < 4; ++i) { const float rev = __builtin_amdgcn_fractf(posf * invrev[n][i]); ro[i] = me[i] * __builtin_amdgcn_cosf(rev) + sgn * ot[i] * __builtin_amdgcn_sinf(rev); }
                        if (fq < 2) v[0][n] = ro;
                    }
                    if (ksum) {
#pragma unroll
                        for (int bj = 0; bj < 2; ++bj)
#pragma unroll
                            for (int n = 0; n < 2; ++n) cs[bj][n] += v[bj][n];
                    }
                } else if (kind == 2) {
#pragma unroll
                    for (int bj = 0; bj < 2; ++bj)
#pragma unroll
                        for (int n = 0; n < 2; ++n)
#pragma unroll
                            for (int i = 0; i < 4; ++i) v[bj][n][i] = sigmoidf_(v[bj][n][i] + gv[bj][n][i]);
                }
                if (kind == 3) {
                    float* bg = (float*)(ws + OFF_BGATE) + (size_t)row * 24;
                    if (fq < 3) {
#pragma unroll
                        for (int n = 0; n < 2; ++n) { f32x4 o; o.x = sigmoidf_(v[0][n][0]); o.y = sigmoidf_(v[0][n][1]); o.z = sigmoidf_(v[0][n][2]); o.w = sigmoidf_(v[0][n][3]); *(f32x4*)(bg + 8 * fq + 4 * n) = o; }
                    }
                } else {
                    bf16_t* rp;
                    if (slab) { const int b = row >> 12, s = row & (SEQ - 1); rp = dst + ((size_t)((b * 2 + sg) * SEQ + s)) * 64 + 8 * fq; }
                    else rp = dst + (size_t)row * pitch + cb + 8 * fq;
#pragma unroll
                    for (int bj = 0; bj < 2; ++bj) {
                        u32x4 w; w.x = pk2(v[bj][0][0], v[bj][0][1]); w.y = pk2(v[bj][0][2], v[bj][0][3]); w.z = pk2(v[bj][1][0], v[bj][1][1]); w.w = pk2(v[bj][1][2], v[bj][1][3]);
                        *(u32x4*)(rp + 32 * bj) = w;
                    }
                }
            }
        if (ksum) {
            float* km = (float*)(ws + OFF_KMEAN) + (size_t)(((u.pm >> 4) * 8 + (H - 8)) * 16 + (u.pm & 15)) * 64;
#pragma unroll
            for (int bj = 0; bj < 2; ++bj)
#pragma unroll
                for (int n = 0; n < 2; ++n)
#pragma unroll
                    for (int i = 0; i < 4; ++i) {
                        float t = cs[bj][n][i];
                        t += __shfl_xor(t, 1); t += __shfl_xor(t, 2); t += __shfl_xor(t, 4); t += __shfl_xor(t, 8);
                        if (fr == 0) atomicAdd(km + 32 * bj + 8 * fq + 4 * n + i, t);
                    }
        }
    }
};
__device__ __forceinline__ void phase_proj(const Params& P, LDSP unsigned char* lds, int vcu, int G) {
    pg8::Sched S; S.A0 = S.A1 = (const bf16_t*)(P.ws + OFF_R0); S.B0 = S.B1 = (const bf16_t*)(P.ws + OFF_WIN_T);
    S.lda = DM; S.ldb = DM; S.K = DM; S.nM = T / 256; S.nN = NPROJ / 256; S.NZ = 1; S.G = G; S.c = blockIdx.x;
    EpiProj E{&P};
    pg8::gemm_phase(lds, S, E);
}

constexpr size_t OFF_CPART = OFF_EXPERTS;
constexpr size_t CPART_STRIDE = (size_t)2 * 4096 * 256;
__device__ __forceinline__ void phase_cmp1(const Params& P, LDSP unsigned char* lds, int vcu, int G) {
    unsigned char* ws = P.ws;
    const int tid = opaque_tid(), lane = tid & 63, wid = tid >> 6, wm = wid >> 1, wn = wid & 1, fr = lane & 15, fq = lane >> 4;
    for (int item = vcu; item < 256; item += G) {
        const int kc = item & 3, tn = (item >> 2) & 1, tm = (item >> 3) & 15, kv = item >> 7;
        const bf16_t* A = (const bf16_t*)(ws + OFF_R2 + (size_t)kv * 8 * MiB) + (size_t)tm * SEQ * 64 + kc * 512;
        const bf16_t* Bt = (const bf16_t*)(ws + (kv ? OFF_W1V_T : OFF_W1K_T)) + (size_t)tn * G_BN * 2048 + kc * 512;
        float* part = (float*)(ws + OFF_CPART) + (size_t)kc * CPART_STRIDE + (size_t)kv * 4096 * 256;
        f32x4 acc[4][4];
        zero_acc(acc);
        gemm_kloop(acc, A, 1024, Bt, 2048, 512, lds);
        const int row0 = tm * 256 + wm * 64 + fr, col0 = tn * 128 + wn * 64 + 4 * fq;
#pragma unroll
        for (int m = 0; m < 4; ++m)
#pragma unroll
            for (int n = 0; n < 4; ++n) *(f32x4*)(part + (size_t)(row0 + m * 16) * 256 + col0 + n * 16) = acc[m][n];
    }
}

__device__ __forceinline__ u32x4 load_hid8(const float* part, const float* posb, size_t rowoff, int k) {
    f32x4 a = *(const f32x4*)(posb + k), b = *(const f32x4*)(posb + k + 4);
#pragma unroll
    for (int c = 0; c < 4; ++c) { a += *(const f32x4*)(part + c * CPART_STRIDE + rowoff + k); b += *(const f32x4*)(part + c * CPART_STRIDE + rowoff + k + 4); }
    u32x4 o; o.x = pk2(gelu_tanh(a.x), gelu_tanh(a.y)); o.y = pk2(gelu_tanh(a.z), gelu_tanh(a.w)); o.z = pk2(gelu_tanh(b.x), gelu_tanh(b.y)); o.w = pk2(gelu_tanh(b.z), gelu_tanh(b.w));
    return o;
}
__device__ __forceinline__ void phase_cmp2(const Params& P, LDSP unsigned char* lds, int vcu, int G) {
    unsigned char* ws = P.ws;
    const int tid = opaque_tid(), lane = tid & 63, wid = tid >> 6, wm = wid >> 1, wn = wid & 1, fr = lane & 15, fq = lane >> 4;
    const int lrow = tid >> 3, lch = tid & 7;
    for (int item = vcu; item < 32; item += G) {
        const int kv = item >> 4, tm = item & 15;
        const float* part = (const float*)(ws + OFF_CPART) + (size_t)kv * 4096 * 256 + (size_t)tm * 256 * 256;
        const float* posb = (const float*)(ws + OFF_POSB) + kv * 256;
        const bf16_t* Bt = (const bf16_t*)(ws + (kv ? OFF_W2V_T : OFF_W2K_T));
        const float* b2 = P.in[kv ? I_CVB2 : I_CKB2];
        bf16_t* dst = (bf16_t*)(ws + (kv ? OFF_VC : OFF_KC)) + (size_t)tm * 256 * 64;
        f32x4 acc[4][4];
        zero_acc(acc);
        {
            const bf16_t* gb = Bt + (size_t)lrow * 256 + lch * 8;
            u32x4 ra[4], rb[2];
#pragma unroll
            for (int p = 0; p < 4; ++p) ra[p] = load_hid8(part, posb, (size_t)(lrow + 64 * p) * 256, lch * 8);
#pragma unroll
            for (int p = 0; p < 2; ++p) rb[p] = *(const u32x4*)(gb + (size_t)(64 * p) * 256);
            __syncthreads();
#pragma unroll
            for (int p = 0; p < 4; ++p) *(LDSP u32x4*)(lds + swz_off(lrow + 64 * p, lch)) = ra[p];
#pragma unroll
            for (int p = 0; p < 2; ++p) *(LDSP u32x4*)(lds + G_ABYTES + swz_off(lrow + 64 * p, lch)) = rb[p];
            __syncthreads();
#pragma unroll 1
            for (int kt = 0; kt < 4; ++kt) {
                LDSP unsigned char* cur = lds + (kt & 1) * G_STAGE;
                LDSP unsigned char* nxt = lds + ((kt + 1) & 1) * G_STAGE;
                if (kt + 1 < 4) {
#pragma unroll
                    for (int p = 0; p < 4; ++p) ra[p] = load_hid8(part, posb, (size_t)(lrow + 64 * p) * 256, (kt + 1) * G_BK + lch * 8);
#pragma unroll
                    for (int p = 0; p < 2; ++p) rb[p] = *(const u32x4*)(gb + (size_t)(64 * p) * 256 + (kt + 1) * G_BK);
                }
#pragma unroll
                for (int ks = 0; ks < 2; ++ks) {
                    bf16x8 af[4], bfr[4];
#pragma unroll
                    for (int m = 0; m < 4; ++m) af[m] = *(const LDSP bf16x8*)(cur + swz_off(wm * 64 + m * 16 + fr, ks * 4 + fq));
#pragma unroll
                    for (int n = 0; n < 4; ++n) bfr[n] = *(const LDSP bf16x8*)(cur + G_ABYTES + swz_off(wn * 64 + n * 16 + fr, ks * 4 + fq));
#pragma unroll
                    for (int m = 0; m < 4; ++m)
#pragma unroll
                        for (int n = 0; n < 4; ++n) acc[m][n] = __builtin_amdgcn_mfma_f32_16x16x32_bf16(bfr[n], af[m], acc[m][n], 0, 0, 0);
                }
                if (kt + 1 < 4) {
#pragma unroll
                    for (int p = 0; p < 4; ++p) *(LDSP u32x4*)(nxt + swz_off(lrow + 64 * p, lch)) = ra[p];
#pragma unroll
                    for (int p = 0; p < 2; ++p) *(LDSP u32x4*)(nxt + G_ABYTES + swz_off(lrow + 64 * p, lch)) = rb[p];
                }
                __syncthreads();
            }
        }
        if (wn == 0) {
            float gv[4][4];
#pragma unroll
            for (int n = 0; n < 4; ++n) {
                const f32x4 bb = *(const f32x4*)(b2 + n * 16 + 4 * fq);
                const f32x4 g4 = kv ? (f32x4){1.f, 1.f, 1.f, 1.f} : *(const f32x4*)(P.in[I_BKCG] + n * 16 + 4 * fq);
                gv[n][0] = g4.x; gv[n][1] = g4.y; gv[n][2] = g4.z; gv[n][3] = g4.w;
#pragma unroll
                for (int m = 0; m < 4; ++m) acc[m][n] += bb;
            }
#pragma unroll
            for (int m = 0; m < 4; ++m) {
                float r = 1.f;
                if (kv == 0) {
                    float ss = 0.f;
#pragma unroll
                    for (int n = 0; n < 4; ++n) ss += (acc[m][n][0] * acc[m][n][0] + acc[m][n][1] * acc[m][n][1]) + (acc[m][n][2] * acc[m][n][2] + acc[m][n][3] * acc[m][n][3]);
                    ss += __shfl_xor(ss, 16); ss += __shfl_xor(ss, 32);
                    r = 1.0f / sqrtf(ss * (1.0f / 64.0f) + NORM_EPS);
                }
                const int row = wm * 64 + m * 16 + fr;
                if (row == 255) r = 0.f;
#pragma unroll
                for (int n = 0; n < 4; ++n) {
                    f32x4 o = acc[m][n];
                    if (row == 255) o = (f32x4){0.f, 0.f, 0.f, 0.f};
                    u32x2 w; w.x = pk2(o[0] * r * gv[n][0], o[1] * r * gv[n][1]); w.y = pk2(o[2] * r * gv[n][2], o[3] * r * gv[n][3]);
                    *(u32x2*)(dst + (size_t)row * 64 + n * 16 + 4 * fq) = w;
                }
            }
        }
    }
}

constexpr int A_GS = 65536, A_ES = 81920, A_Y = 65536, A_MISC = 131072;
typedef short v4i16_t __attribute__((ext_vector_type(4)));
struct ASt { f32x16 o0, o1; float m, l; };
struct KVStage { u32x4 k, v; };
__device__ __forceinline__ void kv_load(KVStage& s, const bf16_t* Kg, const bf16_t* Vg, size_t pitch, int tid) {
    const int key = tid >> 3, ch = tid & 7;
    s.k = *(const u32x4*)(Kg + (size_t)key * pitch + ch * 8);
    s.v = *(const u32x4*)(Vg + (size_t)key * pitch + ch * 8);
}
__device__ __forceinline__ void kv_store(const KVStage& s, LDSP unsigned char* buf, int tid) {
    const int key = tid >> 3, ch = tid & 7;
    *(LDSP u32x4*)(buf + swz_off(key, ch)) = s.k;
    *(LDSP u32x4*)(buf + 8192 + ((ch >> 2) * 4 + (key >> 4)) * 1024 + (key & 15) * 64 + (ch & 3) * 16) = s.v;
}
__device__ __forceinline__ void kv_dma(const bf16_t* Kg, const bf16_t* Vg, size_t pitch, LDSP unsigned char* buf, int wid, int lane) {
    const int row = wid * 8 + (lane >> 3), chunk = (lane & 7) ^ ((row >> 1) & 7);
    __builtin_amdgcn_global_load_lds((const unsigned*)(Kg + (size_t)row * pitch + chunk * 8), (LDSP unsigned*)(buf + wid * 1024), 16, 0, 0);
    const int vrow = (wid & 3) * 16 + (lane >> 2), vcol = (wid >> 2) * 32 + (lane & 3) * 8;
    __builtin_amdgcn_global_load_lds((const unsigned*)(Vg + (size_t)vrow * pitch + vcol), (LDSP unsigned*)(buf + 8192 + wid * 1024), 16, 0, 0);
}
__device__ __forceinline__ float swap32f(float v) { return __shfl_xor(v, 32); }
__device__ __forceinline__ void ast_reset(ASt& st) {
#pragma unroll
    for (int r = 0; r < 16; ++r) { st.o0[r] = 0.f; st.o1[r] = 0.f; }
    st.m = 0.f; st.l = 0.f;
}
constexpr float ATT_THR = 8.0f;
template <int MODE>
__device__ __forceinline__ void attn_tile(ASt& st, const bf16x8 (&qf)[4], LDSP const unsigned char* kt, int lane, bool rowoff, int kl, int kh, bool need_mask,
                                          float linv, LDSP float* gs, LDSP float* es, int jbase, int ql) {
    const int r32 = lane & 31, hi = lane >> 5;
    const float cin = rowoff ? -INFINITY : -st.m;
    f32x16 p0, p1;
#pragma unroll
    for (int r = 0; r < 16; ++r) { p0[r] = cin; p1[r] = cin; }
#pragma unroll
    for (int d0 = 0; d0 < 4; ++d0) {
        const bf16x8 k0f = *(const LDSP bf16x8*)(kt + swz_off(r32, 2 * d0 + hi));
        const bf16x8 k1f = *(const LDSP bf16x8*)(kt + swz_off(r32 + 32, 2 * d0 + hi));
        p0 = __builtin_amdgcn_mfma_f32_32x32x16_bf16(k0f, qf[d0], p0, 0, 0, 0);
        p1 = __builtin_amdgcn_mfma_f32_32x32x16_bf16(k1f, qf[d0], p1, 0, 0, 0);
    }
    if (need_mask) {
        const int kl2 = kl - 4 * hi, kh2 = kh - 4 * hi;
#pragma unroll
        for (int r = 0; r < 16; ++r) {
            const int c = (r & 3) + 8 * (r >> 2);
            const bool v0 = c >= kl2 && c <= kh2, v1 = (c + 32) >= kl2 && (c + 32) <= kh2;
            p0[r] = v0 ? p0[r] : -INFINITY; p1[r] = v1 ? p1[r] : -INFINITY;
        }
    }
    if (MODE != 2) {
        float mx = fmaxf(fmaxf(p0[0], p1[0]), fmaxf(p0[1], p1[1]));
#pragma unroll
        for (int r = 2; r < 16; r += 2) mx = fmaxf(fmaxf(mx, fmaxf(p0[r], p1[r])), fmaxf(p0[r + 1], p1[r + 1]));
        mx = fmaxf(mx, swap32f(mx));
        if (__any(mx > ATT_THR)) {
            const float dl = (mx > ATT_THR) ? mx : 0.f;
            const float alpha = __builtin_amdgcn_exp2f(-dl);
            st.m += dl; st.l *= alpha;
#pragma unroll
            for (int r = 0; r < 16; ++r) { p0[r] -= dl; p1[r] -= dl; }
            if (MODE == 0) {
#pragma unroll
                for (int r = 0; r < 16; ++r) { st.o0[r] *= alpha; st.o1[r] *= alpha; }
            }
        }
    }
#pragma unroll
    for (int r = 0; r < 16; ++r) { p0[r] = __builtin_amdgcn_exp2f(p0[r]); p1[r] = __builtin_amdgcn_exp2f(p1[r]); }
    if (MODE != 2) {
        const f32x16 t = p0 + p1;
        st.l += ((t[0] + t[1]) + (t[2] + t[3])) + ((t[4] + t[5]) + (t[6] + t[7])) + (((t[8] + t[9]) + (t[10] + t[11])) + ((t[12] + t[13]) + (t[14] + t[15])));
    } else {
#pragma unroll
        for (int r = 0; r < 16; ++r) { p0[r] *= linv; p1[r] *= linv; }
#pragma unroll
        for (int qd = 0; qd < 4; ++qd) {
            float g0 = (p0[4 * qd] + p0[4 * qd + 1]) + (p0[4 * qd + 2] + p0[4 * qd + 3]), e0 = p0[4 * qd + 3];
            float g1 = (p1[4 * qd] + p1[4 * qd + 1]) + (p1[4 * qd + 2] + p1[4 * qd + 3]), e1 = p1[4 * qd + 3];
            g0 += __shfl_xor(g0, 1); g0 += __shfl_xor(g0, 2); e0 += __shfl_xor(e0, 1); e0 += __shfl_xor(e0, 2);
            g1 += __shfl_xor(g1, 1); g1 += __shfl_xor(g1, 2); e1 += __shfl_xor(e1, 1); e1 += __shfl_xor(e1, 2);
            if ((r32 & 3) == 0) {
                const int j = jbase + 2 * qd + hi;
                gs[ql * 64 + j] = g0; es[ql * 64 + j] = e0; gs[ql * 64 + j + 8] = g1; es[ql * 64 + j + 8] = e1;
            }
        }
    }
    if (MODE != 1) {
        u32x4 pw[4];
        pw[0] = (u32x4){pk2(p0[0], p0[1]), pk2(p0[2], p0[3]), pk2(p0[4], p0[5]), pk2(p0[6], p0[7])};
        pw[1] = (u32x4){pk2(p0[8], p0[9]), pk2(p0[10], p0[11]), pk2(p0[12], p0[13]), pk2(p0[14], p0[15])};
        pw[2] = (u32x4){pk2(p1[0], p1[1]), pk2(p1[2], p1[3]), pk2(p1[4], p1[5]), pk2(p1[6], p1[7])};
        pw[3] = (u32x4){pk2(p1[8], p1[9]), pk2(p1[10], p1[11]), pk2(p1[12], p1[13]), pk2(p1[14], p1[15])};
        LDSP const unsigned char* vb = kt + 8192 + ((lane >> 4) & 1) * 32 + (lane & 3) * 8 + (4 * hi + ((lane & 15) >> 2)) * 64;
#pragma unroll
        for (int ks = 0; ks < 4; ++ks) {
            const bf16x8 pf = __builtin_bit_cast(bf16x8, pw[ks]);
#pragma unroll
            for (int d0 = 0; d0 < 2; ++d0) {
                const v4i16_t lo = __builtin_amdgcn_ds_read_tr16_b64_v4i16((LDSP v4i16_t*)(vb + (d0 * 4 + ks) * 1024));
                const v4i16_t hh = __builtin_amdgcn_ds_read_tr16_b64_v4i16((LDSP v4i16_t*)(vb + (d0 * 4 + ks) * 1024 + 512));
                const bf16x8 vf = (bf16x8){lo[0], lo[1], lo[2], lo[3], hh[0], hh[1], hh[2], hh[3]};
                if (d0 == 0) st.o0 = __builtin_amdgcn_mfma_f32_32x32x16_bf16(vf, pf, st.o0, 0, 0, 0);
                else         st.o1 = __builtin_amdgcn_mfma_f32_32x32x16_bf16(vf, pf, st.o1, 0, 0, 0);
            }
            if (ks & 1) __builtin_amdgcn_sched_barrier(0);
        }
    }
}

#define KV_LOOP(NT, KPTR, VPTR, PITCH, ...) do { const int nt_ = (NT), np_ = (nt_ + 1) >> 1; KVStage sa_, sb_; __syncthreads(); \
    { const int i = 0; kv_load(sa_, (KPTR), (VPTR), (PITCH), tid); } { const int i = (nt_ > 1) ? 1 : 0; kv_load(sb_, (KPTR), (VPTR), (PITCH), tid); } \
    kv_store(sa_, lds, tid); kv_store(sb_, lds + 16384, tid); __syncthreads(); \
    _Pragma("unroll 1") for (int ip_ = 0; ip_ < np_; ++ip_) { LDSP unsigned char* cur0_ = lds + (ip_ & 1) * 32768; \
        if (ip_ + 1 < np_) { { const int i = 2 * ip_ + 2; kv_load(sa_, (KPTR), (VPTR), (PITCH), tid); } \
                             { const int i = (2 * ip_ + 3 < nt_) ? 2 * ip_ + 3 : 2 * ip_ + 2; kv_load(sb_, (KPTR), (VPTR), (PITCH), tid); } } \
        { const int i = 2 * ip_; LDSP unsigned char* cur = cur0_; __VA_ARGS__ } \
        if (2 * ip_ + 1 < nt_) { const int i = 2 * ip_ + 1; LDSP unsigned char* cur = cur0_ + 16384; __VA_ARGS__ } \
        if (ip_ + 1 < np_) { kv_store(sa_, lds + ((ip_ + 1) & 1) * 32768, tid); kv_store(sb_, lds + ((ip_ + 1) & 1) * 32768 + 16384, tid); } \
        __syncthreads(); } } while (0)

struct TP { bool rowoff, nm; int kl, kh; };
__device__ __forceinline__ void pair_kload(bf16x8 (&kf)[8], LDSP const unsigned char* kt, int r32, int hi) {
#pragma unroll
    for (int d0 = 0; d0 < 4; ++d0) {
        kf[2 * d0]     = *(const LDSP bf16x8*)(kt + swz_off(r32, 2 * d0 + hi));
        kf[2 * d0 + 1] = *(const LDSP bf16x8*)(kt + swz_off(r32 + 32, 2 * d0 + hi));
    }
}
__device__ __forceinline__ void pair_vload(bf16x8 (&vf)[8], LDSP const unsigned char* kt, int lane, int hi) {
    LDSP const unsigned char* vb = kt + 8192 + ((lane >> 4) & 1) * 32 + (lane & 3) * 8 + (4 * hi + ((lane & 15) >> 2)) * 64;
#pragma unroll
    for (int ks = 0; ks < 4; ++ks)
#pragma unroll
        for (int d0 = 0; d0 < 2; ++d0) {
            const v4i16_t lo = __builtin_amdgcn_ds_read_tr16_b64_v4i16((LDSP v4i16_t*)(vb + (d0 * 4 + ks) * 1024));
            const v4i16_t hh = __builtin_amdgcn_ds_read_tr16_b64_v4i16((LDSP v4i16_t*)(vb + (d0 * 4 + ks) * 1024 + 512));
            vf[2 * ks + d0] = (bf16x8){lo[0], lo[1], lo[2], lo[3], hh[0], hh[1], hh[2], hh[3]};
        }
}
#define PAIR_LDS_WAIT() do { asm volatile("s_waitcnt lgkmcnt(0)" ::: "memory"); __builtin_amdgcn_sched_barrier(0); } while (0)
__device__ __forceinline__ void pair_qk(f32x16& p0, f32x16& p1, float cin, const bf16x8 (&qf)[4], const bf16x8 (&kf)[8]) {
    f32x16 c16;
#pragma unroll
    for (int r = 0; r < 16; ++r) c16[r] = cin;
#pragma unroll
    for (int d0 = 0; d0 < 4; ++d0) {
        p0 = __builtin_amdgcn_mfma_f32_32x32x16_bf16(kf[2 * d0], qf[d0], d0 == 0 ? c16 : p0, 0, 0, 0);
        p1 = __builtin_amdgcn_mfma_f32_32x32x16_bf16(kf[2 * d0 + 1], qf[d0], d0 == 0 ? c16 : p1, 0, 0, 0);
    }
}
__device__ __forceinline__ void pair_sm(ASt& st, f32x16& p0, f32x16& p1, u32x4 (&pw)[4], const TP& t, float pend, int hi) {
    if (t.nm) {
        const int kl2 = t.kl - 4 * hi, kh2 = t.kh - 4 * hi;
#pragma unroll
        for (int r = 0; r < 16; ++r) {
            const int c = (r & 3) + 8 * (r >> 2);
            const bool v0 = c >= kl2 && c <= kh2, v1 = (c + 32) >= kl2 && (c + 32) <= kh2;
            p0[r] = v0 ? p0[r] : -INFINITY; p1[r] = v1 ? p1[r] : -INFINITY;
        }
    }
    float mx = fmaxf(fmaxf(p0[0], p1[0]), fmaxf(p0[1], p1[1]));
#pragma unroll
    for (int r = 2; r < 16; r += 2) mx = fmaxf(fmaxf(mx, fmaxf(p0[r], p1[r])), fmaxf(p0[r + 1], p1[r + 1]));
    { const auto rr = __builtin_amdgcn_permlane32_swap(__float_as_uint(mx), __float_as_uint(mx), false, false); mx = fmaxf(__uint_as_float(rr[0]), __uint_as_float(rr[1])); }
    mx -= pend;
    if (__any(mx > ATT_THR || pend != 0.f)) {
        const float dl = (mx > ATT_THR) ? mx : 0.f;
        const float alpha = __builtin_amdgcn_exp2f(-dl), sub = dl + pend;
        st.m += dl; st.l *= alpha;
#pragma unroll
        for (int r = 0; r < 16; ++r) { p0[r] -= sub; p1[r] -= sub; st.o0[r] *= alpha; st.o1[r] *= alpha; }
    }
#pragma unroll
    for (int r = 0; r < 16; ++r) { p0[r] = __builtin_amdgcn_exp2f(p0[r]); p1[r] = __builtin_amdgcn_exp2f(p1[r]); }
    const f32x16 tt = p0 + p1;
    st.l += ((tt[0] + tt[1]) + (tt[2] + tt[3])) + ((tt[4] + tt[5]) + (tt[6] + tt[7])) + (((tt[8] + tt[9]) + (tt[10] + tt[11])) + ((tt[12] + tt[13]) + (tt[14] + tt[15])));
    pw[0] = (u32x4){pk2(p0[0], p0[1]), pk2(p0[2], p0[3]), pk2(p0[4], p0[5]), pk2(p0[6], p0[7])};
    pw[1] = (u32x4){pk2(p0[8], p0[9]), pk2(p0[10], p0[11]), pk2(p0[12], p0[13]), pk2(p0[14], p0[15])};
    pw[2] = (u32x4){pk2(p1[0], p1[1]), pk2(p1[2], p1[3]), pk2(p1[4], p1[5]), pk2(p1[6], p1[7])};
    pw[3] = (u32x4){pk2(p1[8], p1[9]), pk2(p1[10], p1[11]), pk2(p1[12], p1[13]), pk2(p1[14], p1[15])};
}
__device__ __forceinline__ void pair_pv(ASt& st, const u32x4 (&pw)[4], const bf16x8 (&vf)[8]) {
#pragma unroll
    for (int ks = 0; ks < 4; ++ks) {
        const bf16x8 pf = __builtin_bit_cast(bf16x8, pw[ks]);
        st.o0 = __builtin_amdgcn_mfma_f32_32x32x16_bf16(vf[2 * ks], pf, st.o0, 0, 0, 0);
        st.o1 = __builtin_amdgcn_mfma_f32_32x32x16_bf16(vf[2 * ks + 1], pf, st.o1, 0, 0, 0);
    }
}
__device__ __forceinline__ void attn_pair(ASt& st, const bf16x8 (&qf)[4], LDSP const unsigned char* ka, LDSP const unsigned char* kb, int lane, const TP& ta, const TP& tb) {
    const int r32 = lane & 31, hi = lane >> 5;
    const float m0 = st.m;
    f32x16 a0, a1, b0, b1; u32x4 pwa[4], pwb[4];
    bf16x8 kfa[8], kfb[8], vf[8];
    pair_kload(kfa, ka, r32, hi); pair_kload(kfb, kb, r32, hi);
    PAIR_LDS_WAIT();
    pair_qk(a0, a1, ta.rowoff ? -INFINITY : -m0, qf, kfa);
    pair_qk(b0, b1, tb.rowoff ? -INFINITY : -m0, qf, kfb);
    pair_vload(vf, ka, lane, hi);
    __builtin_amdgcn_sched_barrier(0);
    pair_sm(st, a0, a1, pwa, ta, 0.f, hi);
    PAIR_LDS_WAIT();
    pair_pv(st, pwa, vf);
    __builtin_amdgcn_sched_barrier(0);
    pair_vload(vf, kb, lane, hi);
    __builtin_amdgcn_sched_barrier(0);
    pair_sm(st, b0, b1, pwb, tb, st.m - m0, hi);
    PAIR_LDS_WAIT();
    pair_pv(st, pwb, vf);
}
template <int I, bool MASK>
__device__ __forceinline__ void pair_exp_chunk(const f32x16& p0, const f32x16& p1, u32x4 (&pw)[4], float& sacc, int kl2, int kh2) {
    const f32x16& src = (I < 4) ? p0 : p1; constexpr int b = 4 * (I & 3);
    float x0 = src[b], x1 = src[b + 1], x2 = src[b + 2], x3 = src[b + 3];
    if (MASK) {
        constexpr int c0 = 8 * (b >> 2) + ((I < 4) ? 0 : 32);
        x0 = (c0 >= kl2 && c0 <= kh2) ? x0 : -INFINITY; x1 = (c0 + 1 >= kl2 && c0 + 1 <= kh2) ? x1 : -INFINITY;
        x2 = (c0 + 2 >= kl2 && c0 + 2 <= kh2) ? x2 : -INFINITY; x3 = (c0 + 3 >= kl2 && c0 + 3 <= kh2) ? x3 : -INFINITY;
    }
    const float e0 = __builtin_amdgcn_exp2f(x0), e1 = __builtin_amdgcn_exp2f(x1), e2 = __builtin_amdgcn_exp2f(x2), e3 = __builtin_amdgcn_exp2f(x3);
    sacc += (e0 + e1) + (e2 + e3);
    pw[I >> 1][(I & 1) * 2] = pk2(e0, e1); pw[I >> 1][(I & 1) * 2 + 1] = pk2(e2, e3);
}
#define PAIR_SB() __builtin_amdgcn_sched_barrier(0)
__device__ __forceinline__ bf16x8 vfrag_load(LDSP const unsigned char* vb, int idx) {
    const int off = ((idx & 1) * 4 + (idx >> 1)) * 1024;
    const v4i16_t lo = __builtin_amdgcn_ds_read_tr16_b64_v4i16((LDSP v4i16_t*)(vb + off));
    const v4i16_t hh = __builtin_amdgcn_ds_read_tr16_b64_v4i16((LDSP v4i16_t*)(vb + off + 512));
    return (bf16x8){lo[0], lo[1], lo[2], lo[3], hh[0], hh[1], hh[2], hh[3]};
}
template <bool MASK>
__device__ __forceinline__ void attn_pair_fast(ASt& st, const bf16x8 (&qf)[4], LDSP const unsigned char* ka, LDSP const unsigned char* kb, int lane, const TP& ta, const TP& tb) {
    const int r32 = lane & 31, hi = lane >> 5; const bool offa = ta.rowoff, offb = tb.rowoff;
    const int kla = ta.kl - 4 * hi, kha = ta.kh - 4 * hi, klb = tb.kl - 4 * hi, khb = tb.kh - 4 * hi;
    LDSP const unsigned char* vba = ka + 8192 + ((lane >> 4) & 1) * 32 + (lane & 3) * 8 + (4 * hi + ((lane & 15) >> 2)) * 64;
    LDSP const unsigned char* vbb = vba + (kb - ka);
    f32x16 a0, a1, b0, b1; u32x4 pwa[4], pwb[4];
    bf16x8 kfa[8], kfb[8], vfa[8], vfb[8];
    pair_kload(kfa, ka, r32, hi);
    { f32x16 c16; const float cina = offa ? -INFINITY : -st.m;
#pragma unroll
      for (int r = 0; r < 16; ++r) c16[r] = cina;
      asm volatile("s_waitcnt lgkmcnt(0)" ::: "memory"); PAIR_SB();
#define QKA_STEP(I) do { if ((I) & 1) a1 = __builtin_amdgcn_mfma_f32_32x32x16_bf16(kfa[I], qf[(I) >> 1], (I) == 1 ? c16 : a1, 0, 0, 0); \
                         else         a0 = __builtin_amdgcn_mfma_f32_32x32x16_bf16(kfa[I], qf[(I) >> 1], (I) == 0 ? c16 : a0, 0, 0, 0); \
                         kfb[I] = *(const LDSP bf16x8*)(kb + swz_off(r32 + 32 * ((I) & 1), 2 * ((I) >> 1) + hi)); PAIR_SB(); } while (0)
      QKA_STEP(0); QKA_STEP(1); QKA_STEP(2); QKA_STEP(3); QKA_STEP(4); QKA_STEP(5); QKA_STEP(6); QKA_STEP(7);
#undef QKA_STEP
    }
    float sa = 0.f, sbm = 0.f;
    { f32x16 c16; const float cinb = offb ? -INFINITY : -st.m;
#pragma unroll
      for (int r = 0; r < 16; ++r) c16[r] = cinb;
      asm volatile("s_waitcnt lgkmcnt(0)" ::: "memory"); PAIR_SB();
#define QKB_STEP(I) do { if ((I) & 1) b1 = __builtin_amdgcn_mfma_f32_32x32x16_bf16(kfb[I], qf[(I) >> 1], (I) == 1 ? c16 : b1, 0, 0, 0); \
                         else         b0 = __builtin_amdgcn_mfma_f32_32x32x16_bf16(kfb[I], qf[(I) >> 1], (I) == 0 ? c16 : b0, 0, 0, 0); \
                         if ((I) >= 4) vfa[(I) - 4] = vfrag_load(vba, (I) - 4); \
                         pair_exp_chunk<I, MASK>(a0, a1, pwa, sa, kla, kha); PAIR_SB(); } while (0)
      QKB_STEP(0); QKB_STEP(1); QKB_STEP(2); QKB_STEP(3); QKB_STEP(4); QKB_STEP(5); QKB_STEP(6); QKB_STEP(7);
#undef QKB_STEP
    }
    asm volatile("s_waitcnt lgkmcnt(0)" ::: "memory"); PAIR_SB();
#define PVA_STEP(I) do { if ((I) & 1) st.o1 = __builtin_amdgcn_mfma_f32_32x32x16_bf16(vfa[I], __builtin_bit_cast(bf16x8, pwa[(I) >> 1]), st.o1, 0, 0, 0); \
                         else         st.o0 = __builtin_amdgcn_mfma_f32_32x32x16_bf16(vfa[I], __builtin_bit_cast(bf16x8, pwa[(I) >> 1]), st.o0, 0, 0, 0); \
                         if ((I) < 4) vfa[(I) + 4] = vfrag_load(vba, (I) + 4); else vfb[(I) - 4] = vfrag_load(vbb, (I) - 4); \
                         pair_exp_chunk<I, MASK>(b0, b1, pwb, sbm, klb, khb); PAIR_SB(); \
                         if ((I) == 3) { asm volatile("s_waitcnt lgkmcnt(0)" ::: "memory"); PAIR_SB(); } } while (0)
    PVA_STEP(0); PVA_STEP(1); PVA_STEP(2); PVA_STEP(3); PVA_STEP(4); PVA_STEP(5); PVA_STEP(6); PVA_STEP(7);
#undef PVA_STEP
    st.l += sa + sbm;
    asm volatile("s_waitcnt lgkmcnt(0)" ::: "memory"); PAIR_SB();
#define PVB_STEP(I) do { if ((I) & 1) st.o1 = __builtin_amdgcn_mfma_f32_32x32x16_bf16(vfb[I], __builtin_bit_cast(bf16x8, pwb[(I) >> 1]), st.o1, 0, 0, 0); \
                         else         st.o0 = __builtin_amdgcn_mfma_f32_32x32x16_bf16(vfb[I], __builtin_bit_cast(bf16x8, pwb[(I) >> 1]), st.o0, 0, 0, 0); \
                         if ((I) < 4) vfb[(I) + 4] = vfrag_load(vbb, (I) + 4); PAIR_SB(); \
                         if ((I) == 3) { asm volatile("s_waitcnt lgkmcnt(0)" ::: "memory"); PAIR_SB(); } } while (0)
    PVB_STEP(0); PVB_STEP(1); PVB_STEP(2); PVB_STEP(3); PVB_STEP(4); PVB_STEP(5); PVB_STEP(6); PVB_STEP(7);
#undef PVB_STEP
    const float lpair = fmaxf(st.l, swap32f(st.l));
    if (__any(lpair > 1.0e18f)) {
        const float dl = (lpair > 1.0e18f) ? 64.f : 0.f, alpha = __builtin_amdgcn_exp2f(-dl);
        st.m += dl; st.l *= alpha;
#pragma unroll
        for (int r = 0; r < 16; ++r) { st.o0[r] *= alpha; st.o1[r] *= alpha; }
    }
}

#define KV_LOOP_PAIR(NT, KPTR, VDELTA, PITCH, TPF) do { const int nt_ = (NT), np_ = (nt_ + 1) >> 1; const int wu_ = __builtin_amdgcn_readfirstlane(wid); __syncthreads(); \
    { const int i = 0; kv_dma((KPTR), (KPTR) + (VDELTA), (PITCH), lds, wu_, lane); } { const int i = (nt_ > 1) ? 1 : 0; kv_dma((KPTR), (KPTR) + (VDELTA), (PITCH), lds + 16384, wu_, lane); } \
    asm volatile("s_waitcnt vmcnt(0)" ::: "memory"); __syncthreads(); \
    _Pragma("unroll 1") for (int ip_ = 0; ip_ < np_; ++ip_) { LDSP unsigned char* cur0_ = lds + (ip_ & 1) * 32768; LDSP unsigned char* nxt0_ = lds + ((ip_ + 1) & 1) * 32768; \
        if (ip_ + 1 < np_) { { const int i = 2 * ip_ + 2; kv_dma((KPTR), (KPTR) + (VDELTA), (PITCH), nxt0_, wu_, lane); } \
                             { const int i = (2 * ip_ + 3 < nt_) ? 2 * ip_ + 3 : 2 * ip_ + 2; kv_dma((KPTR), (KPTR) + (VDELTA), (PITCH), nxt0_ + 16384, wu_, lane); } } \
        if (2 * ip_ + 1 < nt_) { const TP ta_ = TPF(2 * ip_), tb_ = TPF(2 * ip_ + 1); \
            if (ta_.nm || tb_.nm) attn_pair_fast<true>(st, qf, cur0_, cur0_ + 16384, lane, ta_, tb_); else attn_pair_fast<false>(st, qf, cur0_, cur0_ + 16384, lane, ta_, tb_); } \
        else { const TP ta_ = TPF(2 * ip_); attn_tile<0>(st, qf, cur0_, lane, ta_.rowoff, ta_.kl, ta_.kh, ta_.nm, 0.f, nullptr, nullptr, 0, 0); } \
        asm volatile("s_waitcnt vmcnt(0)" ::: "memory"); \
        __syncthreads(); } } while (0)

__device__ __forceinline__ void store_ot(bf16_t* dst, const f32x16& o0, const f32x16& o1, int hi) {
#pragma unroll
    for (int qd = 0; qd < 4; ++qd) {
        u32x2 w0, w1;
        w0.x = pk2(o0[4 * qd], o0[4 * qd + 1]); w0.y = pk2(o0[4 * qd + 2], o0[4 * qd + 3]);
        w1.x = pk2(o1[4 * qd], o1[4 * qd + 1]); w1.y = pk2(o1[4 * qd + 2], o1[4 * qd + 3]);
        *(u32x2*)(dst + 8 * qd + 4 * hi) = w0; *(u32x2*)(dst + 32 + 8 * qd + 4 * hi) = w1;
    }
}

__device__ __forceinline__ void moba_unit(const Params& P, LDSP unsigned char* lds, int b, int h, int blk) {
    unsigned char* ws = P.ws;
    const int tid = opaque_tid(), lane = tid & 63, wid = tid >> 6, r32 = lane & 31, hi = lane >> 5;
    const bf16_t* qa = (const bf16_t*)(ws + OFF_R1);
    const bf16_t* ka = (const bf16_t*)(ws + OFF_R1 + 32 * MiB);
    const bf16_t* va = (const bf16_t*)(ws + OFF_R1 + 64 * MiB);
    bf16_t* ya = (bf16_t*)(ws + OFF_R0);
    const float* kmean = (const float*)(ws + OFF_KMEAN) + (size_t)((b * 8 + h) * 16) * 64;
    LDSP float* km = (LDSP float*)(lds + A_MISC);
    LDSP unsigned short* sel16 = (LDSP unsigned short*)(lds + A_MISC + 4096);
    __syncthreads();
    for (int i = tid; i < blk * 64; i += NTHREADS) km[i] = kmean[i];
    __syncthreads();
    {
        const int qi = tid >> 1, hf = tid & 1;
        const bf16_t* qrow = qa + (size_t)(b * SEQ + blk * 256 + qi) * 512 + h * 64 + hf * 32;
        float q[32];
#pragma unroll
        for (int c = 0; c < 4; ++c) { float f[8]; cvt8(*(const u32x4*)(qrow + c * 8), f);
#pragma unroll
            for (int i = 0; i < 8; ++i) q[c * 8 + i] = f[i]; }
        float g0 = -INFINITY, g1 = -INFINITY, g2 = -INFINITY; int i0 = -1, i1 = -1, i2 = -1;
        for (int j = 0; j < blk; ++j) {
            float d = 0.f;
#pragma unroll
            for (int i = 0; i < 32; ++i) d += q[i] * km[j * 64 + hf * 32 + i];
            d += __shfl_xor(d, 1);
            if (d > g0) { g2 = g1; i2 = i1; g1 = g0; i1 = i0; g0 = d; i0 = j; }
            else if (d > g1) { g2 = g1; i2 = i1; g1 = d; i1 = j; }
            else if (d > g2) { g2 = d; i2 = j; }
        }
        unsigned mask = 0;
        if (i0 >= 0) mask |= 1u << i0;
        if (i1 >= 0) mask |= 1u << i1;
        if (i2 >= 0) mask |= 1u << i2;
        if (hf == 0) sel16[qi] = (unsigned short)mask;
    }
    __syncthreads();
    const int qloc = wid * 32 + r32;
    const size_t qrow_g = (size_t)(b * SEQ + blk * 256 + qloc);
    bf16x8 qf[4];
#pragma unroll
    for (int d0 = 0; d0 < 4; ++d0) qf[d0] = *(const bf16x8*)(qa + qrow_g * 512 + h * 64 + d0 * 16 + hi * 8);
    const unsigned selbits = sel16[qloc];
    ASt st; ast_reset(st);
    const bf16_t* kbase = ka + (size_t)(b * SEQ) * 512 + h * 64;
    const bf16_t* vbase = va + (size_t)(b * SEQ) * 512 + h * 64;
    auto moba_tp = [=](int ti) -> TP { const int jb = ti >> 2, t4 = ti & 3; const bool past = jb < blk;
        int l_ = lane; asm volatile("" : "+v"(l_)); const int w_ = __builtin_amdgcn_readfirstlane(wid), ql_ = w_ * 32 + (l_ & 31);
        TP t; t.rowoff = past ? !((selbits >> jb) & 1u) : (64 * t4 > ql_); t.nm = !past && (64 * t4 + 63 > w_ * 32); t.kl = 0; t.kh = past ? 63 : ql_ - 64 * t4; return t; };
    KV_LOOP_PAIR(4 * (blk + 1), kbase + (size_t)i * 64 * 512, (size_t)16 * 1024 * 1024, 512, moba_tp);
    const float lt = st.l + swap32f(st.l);
    const float inv = 1.0f / lt;
#pragma unroll
    for (int r = 0; r < 16; ++r) { st.o0[r] *= inv; st.o1[r] *= inv; }
    { const int t2 = opaque_tid(), l2 = t2 & 63;
      const size_t row2 = (size_t)(b * SEQ + blk * 256 + (t2 >> 6) * 32 + (l2 & 31));
      store_ot((bf16_t*)(P.ws + OFF_R0) + row2 * 512 + h * 64, st.o0, st.o1, l2 >> 5); }
}

__device__ __forceinline__ void nsa_unit(const Params& P, LDSP unsigned char* lds, int b, int g, int c) {
    unsigned char* ws = P.ws;
    const int tid = opaque_tid(), lane = tid & 63, wid = tid >> 6, r32 = lane & 31, hi = lane >> 5;
    const bf16_t* qb = (const bf16_t*)(ws + OFF_R1 + 96 * MiB);
    const bf16_t* kc = (const bf16_t*)(ws + OFF_KC) + (size_t)(b * 2 + g) * 256 * 64;
    const bf16_t* vc = (const bf16_t*)(ws + OFF_VC) + (size_t)(b * 2 + g) * 256 * 64;
    const bf16_t* ks = (const bf16_t*)(ws + OFF_R2 + 16 * MiB) + (size_t)(b * SEQ) * 128 + g * 64;
    const bf16_t* vs = (const bf16_t*)(ws + OFF_R2 + 24 * MiB) + (size_t)(b * SEQ) * 128 + g * 64;
    const bf16_t* kw = (const bf16_t*)(ws + OFF_R2 + 32 * MiB) + (size_t)(b * SEQ) * 128 + g * 64;
    const bf16_t* vw = (const bf16_t*)(ws + OFF_R2 + 40 * MiB) + (size_t)(b * SEQ) * 128 + g * 64;
    const float* bgate = (const float*)(ws + OFF_BGATE);
    bf16_t* yb = (bf16_t*)(ws + OFF_R0 + 32 * MiB);
    LDSP float* gs = (LDSP float*)(lds + A_GS);
    LDSP float* es = (LDSP float*)(lds + A_ES);
    LDSP unsigned long long* selm = (LDSP unsigned long long*)(lds + A_MISC);
    const int ql = wid * 8 + (r32 >> 2), hr = r32 & 3, head = g * 4 + hr, pos = c * 64 + ql;
    const size_t trow = (size_t)(b * SEQ + pos);
    bf16x8 qf[4];
#pragma unroll
    for (int d0 = 0; d0 < 4; ++d0) qf[d0] = *(const bf16x8*)(qb + trow * 512 + head * 64 + d0 * 16 + hi * 8);
    const int nmax = (pos >= 31) ? ((pos - 31) >> 4) : -1;
    const int ntc = ((4 * c + 2) >> 6) + 1;
    ASt st; ast_reset(st);
    KV_LOOP(ntc, kc + (size_t)i * 64 * 64, vc + (size_t)i * 64 * 64, 64, {
        attn_tile<1>(st, qf, cur, lane, nmax < 0, 0, nmax - 64 * i, true, 0.f, nullptr, nullptr, 0, 0);
    });
    {
        const float lt = st.l + swap32f(st.l);
        const float linv = (lt > 0.f) ? 1.0f / lt : 0.f;
        KV_LOOP(ntc, kc + (size_t)i * 64 * 64, vc + (size_t)i * 64 * 64, 64, {
            attn_tile<2>(st, qf, cur, lane, nmax < 0, 0, nmax - 64 * i, true, linv, gs, es, 16 * i, ql);
        });
    }
    LDSP float* yl = (LDSP float*)(lds + A_Y) + wid * 2048 + lane;
    __syncthreads();
    for (int qq = 0; qq < 8; ++qq) {
        const int q = wid * 8 + qq, j = lane;
        unsigned long long m;
        if (c < 16) m = (2ull << c) - 1ull;
        else {
            const bool cand = (j >= 1 && j <= c - 2);
            float imp = 0.f;
            if (cand) imp = gs[q * 64 + j] + es[q * 64 + j - 1];
            int rank = 0;
            for (int jp = 1; jp <= c - 2; ++jp) {
                const float o = __uint_as_float(__builtin_amdgcn_readlane(__float_as_uint(imp), jp));
                rank += (o > imp || (o == imp && jp < j)) ? 1 : 0;
            }
            const bool sel = (j == 0) || (j == c) || (j == c - 1) || (cand && rank < 13);
            m = __ballot(sel);
        }
        if (lane == 0) selm[q] = m;
    }
    __syncthreads();
    { const int t2 = opaque_tid(), l2 = t2 & 63; const size_t trow2 = (size_t)(b * SEQ + c * 64 + (t2 >> 6) * 8 + ((l2 & 31) >> 2)); const int head2 = g * 4 + (l2 & 3);
      const float gt0 = ((const float*)(P.ws + OFF_BGATE))[trow2 * 24 + head2 * 3 + 0];
#pragma unroll
    for (int r = 0; r < 16; ++r) { yl[r * 64] = gt0 * st.o0[r]; yl[(16 + r) * 64] = gt0 * st.o1[r]; } }
    const unsigned long long selmask = selm[ql];
    ast_reset(st);
    auto slc_tp = [=](int ti) -> TP { int l_ = lane; asm volatile("" : "+v"(l_)); const int ql_ = __builtin_amdgcn_readfirstlane(wid) * 8 + ((l_ & 31) >> 2);
        TP t; t.rowoff = !((selmask >> ti) & 1ull); t.nm = (ti == c); t.kl = 0; t.kh = (ti == c) ? ql_ : 63; return t; };
    KV_LOOP_PAIR(c + 1, ks + (size_t)i * 64 * 128, (size_t)4 * 1024 * 1024, 128, slc_tp);
    {
        const float lt = st.l + swap32f(st.l);
        const int t2 = opaque_tid(), l2 = t2 & 63; const size_t trow2 = (size_t)(b * SEQ + c * 64 + (t2 >> 6) * 8 + ((l2 & 31) >> 2)); const int head2 = g * 4 + (l2 & 3);
        LDSP float* yl = (LDSP float*)(lds + A_Y) + (t2 >> 6) * 2048 + l2;
        const float sc = ((const float*)(P.ws + OFF_BGATE))[trow2 * 24 + head2 * 3 + 1] / lt;
#pragma unroll
        for (int r = 0; r < 16; ++r) { yl[r * 64] += sc * st.o0[r]; yl[(16 + r) * 64] += sc * st.o1[r]; }
    }
    ast_reset(st);
    const int j0 = (c >= 8) ? c - 8 : 0;
    auto win_tp = [=](int ti) -> TP { const int j = j0 + ti; const bool first = (j == c - 8), own = (j == c);
        int l_ = lane; asm volatile("" : "+v"(l_)); const int ql_ = __builtin_amdgcn_readfirstlane(wid) * 8 + ((l_ & 31) >> 2);
        TP t; t.rowoff = false; t.nm = first || own; t.kl = first ? ql_ + 1 : 0; t.kh = own ? ql_ : 63; return t; };
    KV_LOOP_PAIR(c - j0 + 1, kw + (size_t)(j0 + i) * 64 * 128, (size_t)4 * 1024 * 1024, 128, win_tp);
    {
        const float lt = st.l + swap32f(st.l);
        const int t2 = opaque_tid(), l2 = t2 & 63; const size_t trow2 = (size_t)(b * SEQ + c * 64 + (t2 >> 6) * 8 + ((l2 & 31) >> 2)); const int head2 = g * 4 + (l2 & 3);
        LDSP float* yl = (LDSP float*)(lds + A_Y) + (t2 >> 6) * 2048 + l2;
        const float sc = ((const float*)(P.ws + OFF_BGATE))[trow2 * 24 + head2 * 3 + 2] / lt;
        f32x16 y0, y1;
#pragma unroll
        for (int r = 0; r < 16; ++r) { y0[r] = yl[r * 64] + sc * st.o0[r]; y1[r] = yl[(16 + r) * 64] + sc * st.o1[r]; }
        store_ot((bf16_t*)(P.ws + OFF_R0 + 32 * MiB) + trow2 * 512 + head2 * 64, y0, y1, l2 >> 5);
    }
}

__device__ __forceinline__ void phase_attn(const Params& P, LDSP unsigned char* lds, int vcu, int G) {
    const int nloc = (G == 256) ? 8 : (2048 - vcu + G - 1) / G;
    for (int k = 0; k < nloc; ++k) {
        int u;
        if (G == 256) {
            const int kk = k >> 1;
            if (!(k & 1)) { const int bh = vcu >> 2, jm = vcu & 3; const int blk = (kk == 0) ? 15 - jm : (kk == 1) ? 8 + jm : (kk == 2) ? 7 - jm : jm; u = bh * 16 + blk; }
            else { const int bg = vcu >> 4, jn = vcu & 15; const int c = (kk == 0) ? 63 - jn : (kk == 1) ? 32 + jn : (kk == 2) ? 31 - jn : jn; u = 1024 + bg * 64 + c; }
        } else u = vcu + k * G;
        if (u < 1024) moba_unit(P, lds, u >> 7, (u >> 4) & 7, u & 15);
        else { const int v = u - 1024; nsa_unit(P, lds, v >> 7, (v >> 6) & 1, v & 63); }
    }
}

struct EpiUp {
    const Params* P;
    __device__ __forceinline__ void operator()(f32x4 (&acc)[2][2][4][2], const pg8::Unit& u, int wr, int wc, int fr, int fq) const {
        bf16_t* g = (bf16_t*)(P->ws + OFF_R3);
#pragma unroll
        for (int ai = 0; ai < 2; ++ai)
#pragma unroll
            for (int m = 0; m < 4; ++m) {
                const int row = u.pm * 256 + ai * 128 + wr * 64 + m * 16 + fr;
#pragma unroll
                for (int bj = 0; bj < 2; ++bj) {
                    bf16_t* rp = g + (size_t)row * 2048 + u.pn * 256 + bj * 128 + wc * 32 + 8 * fq;
                    const u32x4 gg = *(const u32x4*)(rp + (u.z ? 1024 : 0));
                    float gf[8]; cvt8(gg, gf);
                    float o[8];
#pragma unroll
                    for (int n = 0; n < 2; ++n)
#pragma unroll
                        for (int i = 0; i < 4; ++i) o[4 * n + i] = gf[4 * n + i] * acc[ai][bj][m][n][i];
                    if (u.z) { float pf[8]; cvt8(*(const u32x4*)rp, pf);
#pragma unroll
                        for (int i = 0; i < 8; ++i) o[i] += pf[i]; }
                    u32x4 w; w.x = pk2(o[0], o[1]); w.y = pk2(o[2], o[3]); w.z = pk2(o[4], o[5]); w.w = pk2(o[6], o[7]);
                    *(u32x4*)rp = w;
                }
            }
    }
};
__device__ __forceinline__ void phase_up(const Params& P, LDSP unsigned char* lds, int vcu, int G) {
    pg8::Sched S; S.A0 = (const bf16_t*)(P.ws + OFF_R0); S.A1 = (const bf16_t*)(P.ws + OFF_R0 + 32 * MiB);
    S.B0 = (const bf16_t*)(P.ws + OFF_WUPA_T); S.B1 = (const bf16_t*)(P.ws + OFF_WUPB_T);
    S.lda = 512; S.ldb = 512; S.K = 512; S.nM = T / 256; S.nN = DM / 256; S.NZ = 2; S.G = G; S.c = blockIdx.x;
    EpiUp E{&P};
    pg8::gemm_phase(lds, S, E);
}

struct EpiOut {
    const Params* P;
    __device__ __forceinline__ void operator()(f32x4 (&acc)[2][2][4][2], const pg8::Unit& u, int wr, int wc, int fr, int fq) const {
        bf16_t* x1b = (bf16_t*)(P->ws + OFF_R0);
        float* rs2 = (float*)(P->ws + OFF_RS2);
        const float* x = P->in[I_X];
#pragma unroll
        for (int ai = 0; ai < 2; ++ai)
#pragma unroll
            for (int m = 0; m < 4; ++m) {
                const int row = u.pm * 256 + ai * 128 + wr * 64 + m * 16 + fr;
                float ss = 0.f;
                f32x4 xv[2][2];
#pragma unroll
                for (int bj = 0; bj < 2; ++bj)
#pragma unroll
                    for (int n = 0; n < 2; ++n) xv[bj][n] = *(const f32x4*)(x + (size_t)row * DM + u.pn * 256 + bj * 128 + wc * 32 + 8 * fq + 4 * n);
#pragma unroll
                for (int bj = 0; bj < 2; ++bj) {
                    const size_t off = (size_t)row * DM + u.pn * 256 + bj * 128 + wc * 32 + 8 * fq;
                    const f32x4 o0 = xv[bj][0] + acc[ai][bj][m][0], o1 = xv[bj][1] + acc[ai][bj][m][1];
                    *(f32x4*)(P->out + off) = o0; *(f32x4*)(P->out + off + 4) = o1;
                    u32x4 w; w.x = pk2(o0.x, o0.y); w.y = pk2(o0.z, o0.w); w.z = pk2(o1.x, o1.y); w.w = pk2(o1.z, o1.w);
                    *(u32x4*)(x1b + off) = w;
                    ss += ((o0.x * o0.x + o0.y * o0.y) + (o0.z * o0.z + o0.w * o0.w)) + ((o1.x * o1.x + o1.y * o1.y) + (o1.z * o1.z + o1.w * o1.w));
                }
                ss += __shfl_xor(ss, 16); ss += __shfl_xor(ss, 32);
                if (fq == 0) atomicAdd(rs2 + row, ss);
            }
    }
};
__device__ __forceinline__ void phase_out(const Params& P, LDSP unsigned char* lds, int vcu, int G) {
    pg8::Sched S; S.A0 = S.A1 = (const bf16_t*)(P.ws + OFF_R3); S.B0 = S.B1 = (const bf16_t*)(P.ws + OFF_WOUT_T);
    S.lda = 2048; S.ldb = DM; S.K = DM; S.nM = T / 256; S.nN = DM / 256; S.NZ = 1; S.G = G; S.c = blockIdx.x;
    EpiOut E{&P};
    pg8::gemm_phase(lds, S, E);
}

struct EpiPq {
    const Params* P;
    __device__ __forceinline__ void operator()(f32x4 (&acc)[2][2][4][2], const pg8::Unit& u, int wr, int wc, int fr, int fq) const {
        bf16_t* qp = (bf16_t*)(P->ws + OFF_R1);
        const float* rs2 = (const float*)(P->ws + OFF_RS2);
        float rr[2][4];
#pragma unroll
        for (int ai = 0; ai < 2; ++ai)
#pragma unroll
            for (int m = 0; m < 4; ++m) rr[ai][m] = 1.0f / sqrtf(rs2[u.pm * 256 + ai * 128 + wr * 64 + m * 16 + fr] * (1.0f / DM) + NORM_EPS);
#pragma unroll
        for (int ai = 0; ai < 2; ++ai)
#pragma unroll
            for (int m = 0; m < 4; ++m) {
                const int row = u.pm * 256 + ai * 128 + wr * 64 + m * 16 + fr;
                const float r = rr[ai][m];
#pragma unroll
                for (int bj = 0; bj < 2; ++bj) {
                    const f32x4 a0 = acc[ai][bj][m][0], a1 = acc[ai][bj][m][1];
                    u32x4 w; w.x = pk2(a0[0] * r, a0[1] * r); w.y = pk2(a0[2] * r, a0[3] * r); w.z = pk2(a1[0] * r, a1[1] * r); w.w = pk2(a1[2] * r, a1[3] * r);
                    *(u32x4*)(qp + (size_t)row * 2048 + u.pn * 256 + bj * 128 + wc * 32 + 8 * fq) = w;
                }
            }
    }
};
__device__ __forceinline__ void phase_pq(const Params& P, LDSP unsigned char* lds, int vcu, int G) {
    pg8::Sched S; S.A0 = S.A1 = (const bf16_t*)(P.ws + OFF_R0); S.B0 = S.B1 = (const bf16_t*)(P.ws + OFF_WPQ_T);
    S.lda = DM; S.ldb = DM; S.K = DM; S.nM = T / 256; S.nN = 2048 / 256; S.NZ = 1; S.G = G; S.c = blockIdx.x;
    EpiPq E{&P};
    pg8::gemm_phase(lds, S, E);
}

__device__ __forceinline__ unsigned f2ord(float f) { const unsigned u = __float_as_uint(f); return u ^ ((unsigned)((int)u >> 31) | 0x80000000u); }
__device__ __forceinline__ float ord2f(unsigned o) { const unsigned u = (o & 0x80000000u) ? (o ^ 0x80000000u) : ~o; return __uint_as_float(u); }
__device__ __forceinline__ void ins16(unsigned (&top)[16], unsigned x) {
#pragma unroll
    for (int j = 0; j < 16; ++j) { const unsigned t = max(x, top[j]); x = min(x, top[j]); top[j] = t; }
}
__device__ __forceinline__ int crow(int r, int hi) { return (r & 3) + 8 * (r >> 2) + 4 * hi; }
__device__ __forceinline__ void ce_desc(unsigned& a, unsigned& b) { const unsigned hi_ = max(a, b), lo_ = min(a, b); a = hi_; b = lo_; }
__device__ __forceinline__ void bitonic_merge16_desc(unsigned (&a)[16]) {
#pragma unroll
    for (int j = 8; j > 0; j >>= 1)
#pragma unroll
        for (int i = 0; i < 16; ++i) { const int l = i ^ j; if (l > i) ce_desc(a[i], a[l]); }
}
__device__ __forceinline__ void sort16_desc(unsigned (&a)[16]) {
#pragma unroll
    for (int k = 2; k <= 16; k <<= 1)
#pragma unroll
        for (int j = k >> 1; j > 0; j >>= 1)
#pragma unroll
            for (int i = 0; i < 16; ++i) { const int l = i ^ j; if (l > i) { if ((i & k) == 0) ce_desc(a[i], a[l]); else ce_desc(a[l], a[i]); } }
}
__device__ __forceinline__ void merge_top16(unsigned (&top)[16], const unsigned (&blk)[16]) {
#pragma unroll
    for (int i = 0; i < 16; ++i) top[i] = max(top[i], blk[15 - i]);
    bitonic_merge16_desc(top);
}
constexpr int cand_prefix(int i) { int n = 0; for (int a = 0; a < i; ++a) n += 16 / (a + 1); return n; }

constexpr int P8_KOFF = 0, P8_IDX = 65536;
__device__ __forceinline__ void phase_topk(const Params& P, LDSP unsigned char* lds, int vcu, int G) {
    unsigned char* ws = P.ws;
    const bf16_t* qp = (const bf16_t*)(ws + OFF_R1);
    int* experts = (int*)(ws + OFF_EXPERTS);
    float* gates = (float*)(ws + OFF_GATES);
    const int tid = opaque_tid(), lane = tid & 63, wave = tid >> 6, r32 = lane & 31, hi = lane >> 5;
    __syncthreads();
    for (int i = tid; i < 2 * 128 * 16; i += NTHREADS) {
        const int w = i >> 11, row = (i >> 4) & 127, ch = i & 15;
        const u32x4 v = *(const u32x4*)((const bf16_t*)(ws + (w ? OFF_K2B : OFF_K1B)) + row * 128 + ch * 8);
        *(LDSP u32x4*)(lds + P8_KOFF + w * 32768 + row * 256 + ((ch ^ (row & 15)) << 4)) = v;
    }
    __syncthreads();
    LDSP unsigned char* myidx = lds + P8_IDX + (wave * 64 + lane) * 32;
    const int gw = vcu * NWAVES + wave, NGW = G * NWAVES;
    for (int item = gw; item < (T / 32) * 8; item += NGW) {
        const int tg = item >> 3, h = item & 7;
        const int tok = tg * 32 + r32;
        unsigned tops[2][16];
#pragma unroll
        for (int L = 0; L < 2; ++L) {
            bf16x8 qf[8];
            const bf16_t* qrow = qp + (size_t)tok * 2048 + h * 256 + L * 128 + hi * 8;
#pragma unroll
            for (int s8 = 0; s8 < 8; ++s8) qf[s8] = *(const bf16x8*)(qrow + s8 * 16);
            unsigned top[16];
#pragma unroll
            for (int kb = 0; kb < 4; ++kb) {
                f32x16 acc = {0.f, 0.f, 0.f, 0.f, 0.f, 0.f, 0.f, 0.f, 0.f, 0.f, 0.f, 0.f, 0.f, 0.f, 0.f, 0.f};
                const int row = kb * 32 + r32;
#pragma unroll
                for (int s8 = 0; s8 < 8; ++s8) {
                    const bf16x8 kf = *(const LDSP bf16x8*)(lds + P8_KOFF + L * 32768 + row * 256 + (((2 * s8 + hi) ^ (row & 15)) << 4));
                    acc = __builtin_amdgcn_mfma_f32_32x32x16_bf16(kf, qf[s8], acc, 0, 0, 0);
                }
                unsigned blk[16];
#pragma unroll
                for (int r = 0; r < 16; ++r) {
                    const int key = kb * 32 + (r & 3) + 8 * (r >> 2) + 4 * hi;
                    blk[r] = (f2ord(acc[r]) & ~0x7Fu) | (unsigned)(127 - key);
                }
                sort16_desc(blk);
                if (kb == 0) {
#pragma unroll
                    for (int j = 0; j < 16; ++j) top[j] = blk[j];
                } else merge_top16(top, blk);
            }
            unsigned oth[16];
#pragma unroll
            for (int j = 0; j < 16; ++j) oth[j] = (unsigned)__shfl_xor((int)top[j], 32);
            merge_top16(top, oth);
#pragma unroll
            for (int j = 0; j < 16; ++j) tops[L][j] = top[j];
        }
        float v1[16], v2[16];
#pragma unroll
        for (int j = 0; j < 16; j += 4) {
            unsigned w1 = 0, w2 = 0;
#pragma unroll
            for (int q = 0; q < 4; ++q) { w1 |= (127u - (tops[0][j + q] & 127u)) << (8 * q); w2 |= (127u - (tops[1][j + q] & 127u)) << (8 * q); }
            *(LDSP unsigned*)(myidx + j) = w1; *(LDSP unsigned*)(myidx + 16 + j) = w2;
        }
#pragma unroll
        for (int j = 0; j < 16; ++j) { v1[j] = ord2f(tops[0][j] & ~0x7Fu); v2[j] = ord2f(tops[1][j] & ~0x7Fu); }
        unsigned ct[16];
        {
            unsigned cand[64];
#pragma unroll
            for (int n = 0; n < 64; ++n) cand[n] = 0u;
#pragma unroll
            for (int i = 0; i < 16; ++i)
#pragma unroll
                for (int j = 0; j < 16; ++j)
                    if ((i + 1) * (j + 1) <= 16) cand[cand_prefix(i) + j] = (f2ord(v1[i] + v2[j]) & ~0xFFu) | (unsigned)(255 - (i * 16 + j));
#pragma unroll
            for (int bk = 0; bk < 4; ++bk) {
                unsigned blk[16];
#pragma unroll
                for (int r = 0; r < 16; ++r) blk[r] = cand[bk * 16 + r];
                sort16_desc(blk);
                if (bk == 0) {
#pragma unroll
                    for (int j = 0; j < 16; ++j) ct[j] = blk[j];
                } else merge_top16(ct, blk);
            }
        }
        float vals[16], ssum = 0.f;
        const float vmax = ord2f(ct[0] & ~0xFFu);
#pragma unroll
        for (int k = 0; k < 16; ++k) { vals[k] = __expf(ord2f(ct[k] & ~0xFFu) - vmax); ssum += vals[k]; }
        const float inv = 1.0f / ssum;
        asm volatile("s_waitcnt lgkmcnt(0)" ::: "memory");
        if (hi == 0) {
            int* ep = experts + (size_t)tok * 128 + h * 16;
            float* gp = gates + (size_t)tok * 128 + h * 16;
#pragma unroll
            for (int k = 0; k < 16; k += 4) {
                int e4[4];
#pragma unroll
                for (int q = 0; q < 4; ++q) {
                    const unsigned flat = 255u - (ct[k + q] & 255u);
                    const int i1 = myidx[flat >> 4], i2 = myidx[16 + (flat & 15)];
                    e4[q] = i1 * 128 + i2;
                }
                *(u32x4*)(ep + k) = (u32x4){(unsigned)e4[0], (unsigned)e4[1], (unsigned)e4[2], (unsigned)e4[3]};
                *(f32x4*)(gp + k) = (f32x4){vals[k] * inv, vals[k + 1] * inv, vals[k + 2] * inv, vals[k + 3] * inv};
            }
        }
        asm volatile("s_waitcnt lgkmcnt(0)" ::: "memory");
    }
}

__device__ __forceinline__ void cvt16_fp8(const u32x4 w, float (&f)[16]) {
#pragma unroll
    for (int q = 0; q < 4; ++q) {
        const f32x2 lo = __builtin_amdgcn_cvt_pk_f32_fp8((int)w[q], false), hi = __builtin_amdgcn_cvt_pk_f32_fp8((int)w[q], true);
        f[4 * q] = lo.x; f[4 * q + 1] = lo.y; f[4 * q + 2] = hi.x; f[4 * q + 3] = hi.y;
    }
}
__device__ __forceinline__ void peer_slice_map(const Params& P, LDSP unsigned char* lds, int vcu, int G, int wave, int& slice, int& wslot, int& nslot) {
    volatile LDSP unsigned* bst = (volatile LDSP unsigned*)(lds + LDS_BYTES - 16);
    LDSP unsigned* info = (LDSP unsigned*)(lds + LDS_BYTES - 64);
    __syncthreads();
    if (threadIdx.x == 0) {
        unsigned* bar = (unsigned*)(P.ws + 16384);
        const unsigned x = (unsigned)__builtin_amdgcn_s_getreg((3 << 11) | 20) & 0xFu;
        bool ok = true; unsigned sum = 0, mine = 0;
        for (unsigned j = 0; j < 16; ++j) { const unsigned c = __hip_atomic_load(&bar[256 + 64 * j], __ATOMIC_RELAXED, __HIP_MEMORY_SCOPE_AGENT); sum += c; if (j < 8 && c == 0) ok = false; if (j >= 8 && c != 0) ok = false; if (j == x) mine = c; }
        ok = ok && (sum == (unsigned)G) && (bst[2] < mine);
        info[0] = ok ? 1u : 0u; info[1] = x; info[2] = mine; info[3] = bst[2];
    }
    __syncthreads();
    if (info[0]) { slice = (int)info[1]; wslot = (int)info[3] * NWAVES + wave; nslot = (int)info[2] * NWAVES; }
    else if ((G & 7) == 0) { slice = vcu / (G >> 3); wslot = (vcu % (G >> 3)) * NWAVES + wave; nslot = (G >> 3) * NWAVES; }
    else { slice = -1; wslot = vcu * NWAVES + wave; nslot = G * NWAVES; }
}
struct PeerMetaA { int eA, eB; u32x4 h0, h1; };
struct PeerMetaB { int eA, eB; float aA, aB; };
#define PEER_IDX(m, j) __shfl(((j) < 8) ? (m).eA : (m).eB, (8 * (j) + grp) & 63)
__device__ __forceinline__ float dpp_xor1(float v) { return __builtin_bit_cast(float, __builtin_amdgcn_mov_dpp(__builtin_bit_cast(int, v), 0xB1, 0xF, 0xF, true)); }
__device__ __forceinline__ float dpp_xor2(float v) { return __builtin_bit_cast(float, __builtin_amdgcn_mov_dpp(__builtin_bit_cast(int, v), 0x4E, 0xF, 0xF, true)); }
__device__ __forceinline__ float dpp_hmirror(float v) { return __builtin_bit_cast(float, __builtin_amdgcn_mov_dpp(__builtin_bit_cast(int, v), 0x141, 0xF, 0xF, true)); }
__device__ __forceinline__ float dpp_ror8(float v) { return __builtin_bit_cast(float, __builtin_amdgcn_mov_dpp(__builtin_bit_cast(int, v), 0x128, 0xF, 0xF, true)); }
__device__ __forceinline__ float swap32_sum(float X, float Y) {
    const auto r = __builtin_amdgcn_permlane32_swap(__float_as_uint(X), __float_as_uint(Y), false, false);
    return __uint_as_float(r[0]) + __uint_as_float(r[1]);
}
__device__ __forceinline__ float swap16_sum(float X, float Y) {
    const auto r = __builtin_amdgcn_permlane16_swap(__float_as_uint(X), __float_as_uint(Y), false, false);
    return __uint_as_float(r[0]) + __uint_as_float(r[1]);
}
__device__ __forceinline__ void cvt16_fp8_pk(const u32x4 w, f32x2 (&f)[8]) {
#pragma unroll
    for (int q = 0; q < 4; ++q) { f[2 * q] = __builtin_amdgcn_cvt_pk_f32_fp8((int)w[q], false); f[2 * q + 1] = __builtin_amdgcn_cvt_pk_f32_fp8((int)w[q], true); }
}
__device__ __forceinline__ void phase_peer_a(const Params& P, LDSP unsigned char* lds, int vcu, int G) {
    unsigned char* ws = P.ws;
    const bf16_t* x1b = (const bf16_t*)(ws + OFF_R0);
    const unsigned char* U8 = ws + OFF_U;
    const int* experts = (const int*)(ws + OFF_EXPERTS);
    float* apart = (float*)(ws + OFF_R1);
    const int tid = opaque_tid(), lane = tid & 63, wave = tid >> 6, grp = lane >> 3, sub = lane & 7;
    const bool b2 = lane & 4, b1 = lane & 2, b0 = lane & 1;
    int slice, wslot, nslot;
    peer_slice_map(P, lds, vcu, G, wave, slice, wslot, nslot);
    const int nitems = (slice >= 0) ? T : T * 8;
#define PA_T(it) ((slice >= 0) ? (it) : ((it) >> 3))
#define PA_X(it) ((slice >= 0) ? slice : ((it) & 7))
#define PA_META(m, it) do { const int it_ = ((it) < nitems) ? (it) : wslot; { const int t_ = PA_T(it_), x_ = PA_X(it_); \
        (m).eA = experts[(size_t)t_ * 128 + lane]; (m).eB = experts[(size_t)t_ * 128 + 64 + lane]; \
        (m).h0 = *(const u32x4*)(x1b + (size_t)t_ * DM + 128 * x_ + 16 * sub); (m).h1 = *(const u32x4*)(x1b + (size_t)t_ * DM + 128 * x_ + 16 * sub + 8); } } while (0)
#define PA_GATHER(R, m, it, J0) do { const int x_ = PA_X(it); _Pragma("unroll") for (int j = 0; j < 8; ++j) { const int e_ = PEER_IDX(m, (J0) + j); \
        (R)[j] = *(const u32x4*)(U8 + ((size_t)x_ * PEER_NE + e_) * 128 + 16 * sub); } } while (0)
#define PA_COMPUTE(R, J0) do { _Pragma("unroll") for (int j = 0; j < 8; ++j) { f32x2 f[8]; asm volatile("" : "+v"((R)[j])); cvt16_fp8_pk((R)[j], f); f32x2 sd = f[0] * h2[0]; \
        _Pragma("unroll") for (int i = 1; i < 8; ++i) sd = __builtin_elementwise_fma(f[i], h2[i], sd); part[(J0) + j] = sd.x + sd.y; asm volatile("" : "+v"(part[(J0) + j])); } } while (0)
    PeerMetaA m0, m1, m2;
    m0.eA = m0.eB = m1.eA = m1.eB = m2.eA = m2.eB = 0; m0.h0 = m0.h1 = m1.h0 = m1.h1 = m2.h0 = m2.h1 = (u32x4){0u, 0u, 0u, 0u};
    u32x4 R0[8], R1[8];
    PA_META(m0, wslot); PA_META(m1, wslot + nslot);
    if (wslot >= nitems) return;
    PA_GATHER(R0, m0, wslot, 0); PA_GATHER(R1, m0, wslot, 8);
#pragma unroll 1
    for (int it = wslot; it < nitems; it += nslot) {
        PA_META(m2, it + 2 * nslot);
        f32x2 h2[8]; float part[16];
        { float f[8]; cvt8(m0.h0, f);
#pragma unroll
          for (int i = 0; i < 4; ++i) h2[i] = (f32x2){f[2 * i], f[2 * i + 1]};
          cvt8(m0.h1, f);
#pragma unroll
          for (int i = 0; i < 4; ++i) h2[4 + i] = (f32x2){f[2 * i], f[2 * i + 1]}; }
        PA_COMPUTE(R0, 0);
        const int itn = (it + nslot < nitems) ? it + nslot : it;
        PA_GATHER(R0, m1, itn, 0);
        PA_COMPUTE(R1, 8);
        PA_GATHER(R1, m1, itn, 8);
        float q8[8], q4[4], q2[2];
#pragma unroll
        for (int i = 0; i < 8; ++i) { const float send = b2 ? part[i] : part[i + 8], keep = b2 ? part[i + 8] : part[i]; q8[i] = keep + dpp_hmirror(send); }
#pragma unroll
        for (int i = 0; i < 4; ++i) { const float send = b1 ? q8[i] : q8[i + 4], keep = b1 ? q8[i + 4] : q8[i]; q4[i] = keep + dpp_xor2(send); }
#pragma unroll
        for (int i = 0; i < 2; ++i) { const float send = b0 ? q4[i] : q4[i + 2], keep = b0 ? q4[i + 2] : q4[i]; q2[i] = keep + dpp_xor1(send); }
        float* ap = apart + ((size_t)PA_X(it) * T + PA_T(it)) * 128 + lane;
        ap[0] = q2[0]; ap[64] = q2[1];
        m0 = m1; m1 = m2;
    }
#undef PA_META
#undef PA_GATHER
#undef PA_COMPUTE
}
__device__ __forceinline__ void phase_peer_w(const Params& P, LDSP unsigned char* lds, int vcu, int G) {
    unsigned char* ws = P.ws;
    float* gates = (float*)(ws + OFF_GATES);
    const float* rs2 = (const float*)(ws + OFF_RS2);
    const float* apart = (const float*)(ws + OFF_R1);
    const size_t gt = (size_t)(vcu * NTHREADS + threadIdx.x), NGT = (size_t)G * NTHREADS;
    for (size_t i = gt; i < (size_t)T * 128; i += NGT) {
        const int t = (int)(i >> 7), k = (int)(i & 127);
        const int sub = k >> 4, s1 = (k >> 3) & 1, grp = k & 7, idx = s1 * 64 + grp * 8 + sub;
        float a = 0.f;
#pragma unroll
        for (int xs = 0; xs < 8; ++xs) a += apart[((size_t)xs * T + t) * 128 + idx];
        const float rs = (1.0f / PEER_US) / sqrtf(rs2[t] * (1.0f / DM) + NORM_EPS);
        gates[i] = gelu_tanh(a * rs) * gates[i] * (1.0f / PEER_VS);
    }
}
__device__ __forceinline__ void phase_peer_b(const Params& P, LDSP unsigned char* lds, int vcu, int G) {
    unsigned char* ws = P.ws;
    const unsigned char* V8 = ws + OFF_V;
    const int* experts = (const int*)(ws + OFF_EXPERTS);
    const float* wtok = (const float*)(ws + OFF_GATES);
    const int tid = opaque_tid(), lane = tid & 63, wave = tid >> 6, grp = lane >> 3, sub = lane & 7;
    const bool b3 = lane & 8;
    const int k0 = 16 * sub + grp, k1 = k0 + 8;
    LDSP float* wbuf = (LDSP float*)(lds + wave * 1024);
    int slice, wslot, nslot;
    peer_slice_map(P, lds, vcu, G, wave, slice, wslot, nslot);
    const int nitems = (slice >= 0) ? T : T * 8;
#define PB_META(m, it) do { const int it_ = ((it) < nitems) ? (it) : wslot; { const int t_ = PA_T(it_); \
        (m).eA = experts[(size_t)t_ * 128 + lane]; (m).eB = experts[(size_t)t_ * 128 + 64 + lane]; \
        (m).aA = wtok[(size_t)t_ * 128 + k0]; (m).aB = wtok[(size_t)t_ * 128 + k1]; } } while (0)
#define PB_GATHER(R, m, it, J0) do { const int x_ = PA_X(it); _Pragma("unroll") for (int j = 0; j < 8; ++j) { const int e_ = PEER_IDX(m, (J0) + j); \
        (R)[j] = *(const u32x4*)(V8 + ((size_t)x_ * PEER_NE + e_) * 128 + 16 * sub); } } while (0)
#define PB_COMPUTE(R, J0) do { _Pragma("unroll") for (int j = 0; j < 8; ++j) { f32x2 f[8]; asm volatile("" : "+v"((R)[j])); cvt16_fp8_pk((R)[j], f); const float wk = wb[8 * ((J0) + j) + grp]; const f32x2 wk2 = {wk, wk}; \
        _Pragma("unroll") for (int i = 0; i < 8; ++i) acc2[i] = __builtin_elementwise_fma(wk2, f[i], acc2[i]); \
        asm volatile("" : "+v"(acc2[0]), "+v"(acc2[1]), "+v"(acc2[2]), "+v"(acc2[3]), "+v"(acc2[4]), "+v"(acc2[5]), "+v"(acc2[6]), "+v"(acc2[7])); } } while (0)
    PeerMetaB m0, m1, m2;
    m0.eA = m0.eB = m1.eA = m1.eB = m2.eA = m2.eB = 0; m0.aA = m0.aB = m1.aA = m1.aB = m2.aA = m2.aB = 0.f;
    u32x4 R0[8], R1[8];
    PB_META(m0, wslot); PB_META(m1, wslot + nslot);
    if (wslot >= nitems) return;
    PB_GATHER(R0, m0, wslot, 0); PB_GATHER(R1, m0, wslot, 8);
    int par = 0;
#pragma unroll 1
    for (int it = wslot; it < nitems; it += nslot) {
        PB_META(m2, it + 2 * nslot);
        LDSP float* wb = wbuf + par * 128; par ^= 1;
        wb[k0] = m0.aA; wb[k1] = m0.aB;
        asm volatile("s_waitcnt lgkmcnt(0)" ::: "memory");
        f32x2 acc2[8];
#pragma unroll
        for (int i = 0; i < 8; ++i) acc2[i] = (f32x2){0.f, 0.f};
        PB_COMPUTE(R0, 0);
        const int itn = (it + nslot < nitems) ? it + nslot : it;
        PB_GATHER(R0, m1, itn, 0);
        PB_COMPUTE(R1, 8);
        PB_GATHER(R1, m1, itn, 8);
        float acc[16];
#pragma unroll
        for (int i = 0; i < 8; ++i) { acc[2 * i] = acc2[i].x; acc[2 * i + 1] = acc2[i].y; }
        float q8[8], q4[4], q2[2];
#pragma unroll
        for (int i = 0; i < 8; ++i) q8[i] = swap32_sum(acc[i], acc[i + 8]);
#pragma unroll
        for (int i = 0; i < 4; ++i) q4[i] = swap16_sum(q8[i], q8[i + 4]);
#pragma unroll
        for (int i = 0; i < 2; ++i) { const float send = b3 ? q4[i] : q4[i + 2], keep = b3 ? q4[i + 2] : q4[i]; q2[i] = keep + dpp_ror8(send); }
        const int c16 = ((lane & 32) ? 8 : 0) + ((lane & 16) ? 4 : 0) + (b3 ? 2 : 0);
        float* op = P.out + (size_t)PA_T(it) * DM + 128 * PA_X(it) + 16 * sub + c16;
        f32x2 o = *(const f32x2*)op;
        o.x += q2[0]; o.y += q2[1];
        *(f32x2*)op = o;
        m0 = m1; m1 = m2;
    }
#undef PB_META
#undef PB_GATHER
#undef PB_COMPUTE
#undef PA_T
#undef PA_X
}

#ifndef SELFCHECK
#define SELFCHECK 0
#endif
#if SELFCHECK
constexpr size_t OFF_CHK = 512 * 1024;
__device__ __forceinline__ void wave_argmax(float& v, int& i) {
#pragma unroll
    for (int o = 1; o < 64; o <<= 1) {
        const float ov = __shfl_xor(v, o); const int oi = __shfl_xor(i, o);
        if (ov > v || (ov == v && oi < i)) { v = ov; i = oi; }
    }
}
struct NaiveAcc { float m, l; float o[64]; };
__device__ __forceinline__ float wave_max(float v) {
#pragma unroll
    for (int o = 1; o < 64; o <<= 1) v = fmaxf(v, __shfl_xor(v, o));
    return v;
}
__device__ __forceinline__ void nacc_reset(NaiveAcc& a) { a.m = -1.0e30f; a.l = 0.f;
#pragma unroll
    for (int d = 0; d < 64; ++d) a.o[d] = 0.f; }
__device__ __forceinline__ float dot64(LDSP const float* qs, const bf16_t* krow) {
    float s = 0.f;
#pragma unroll
    for (int c = 0; c < 8; ++c) { float f[8]; cvt8(*(const u32x4*)(krow + c * 8), f);
#pragma unroll
        for (int i = 0; i < 8; ++i) s += qs[c * 8 + i] * f[i]; }
    return s;
}
__device__ __forceinline__ void axpy64(NaiveAcc& a, float alpha, float p, const bf16_t* vrow) {
#pragma unroll
    for (int c = 0; c < 8; ++c) { float f[8]; cvt8(*(const u32x4*)(vrow + c * 8), f);
#pragma unroll
        for (int i = 0; i < 8; ++i) a.o[c * 8 + i] = a.o[c * 8 + i] * alpha + p * f[i]; }
}
__device__ __forceinline__ void naive_chunk(NaiveAcc& a, LDSP const float* qs, const bf16_t* krow, const bf16_t* vrow, bool valid) {
    float s = dot64(qs, krow);
    if (!valid) s = -INFINITY;
    const float mnew = fmaxf(a.m, wave_max(s));
    const float alpha = exp2f(a.m - mnew), p = valid ? exp2f(s - mnew) : 0.f;
    a.l = a.l * alpha + p; a.m = mnew;
    axpy64(a, alpha, p, vrow);
}
__device__ __forceinline__ float nacc_final(NaiveAcc& a, int lane) {
    const float l = wave_sum(a.l);
    const float inv = (l > 0.f) ? 1.0f / l : 0.f;
    const bool b5 = lane & 32, b4 = lane & 16, b3 = lane & 8, b2 = lane & 4, b1 = lane & 2, b0 = lane & 1;
    float q32[32], q16[16], q8[8], q4[4], q2[2];
#pragma unroll
    for (int i = 0; i < 32; ++i) { const float send = b5 ? a.o[i] : a.o[i + 32], keep = b5 ? a.o[i + 32] : a.o[i]; q32[i] = keep + __shfl_xor(send, 32); }
#pragma unroll
    for (int i = 0; i < 16; ++i) { const float send = b4 ? q32[i] : q32[i + 16], keep = b4 ? q32[i + 16] : q32[i]; q16[i] = keep + __shfl_xor(send, 16); }
#pragma unroll
    for (int i = 0; i < 8; ++i) { const float send = b3 ? q16[i] : q16[i + 8], keep = b3 ? q16[i + 8] : q16[i]; q8[i] = keep + __shfl_xor(send, 8); }
#pragma unroll
    for (int i = 0; i < 4; ++i) { const float send = b2 ? q8[i] : q8[i + 4], keep = b2 ? q8[i + 4] : q8[i]; q4[i] = keep + __shfl_xor(send, 4); }
#pragma unroll
    for (int i = 0; i < 2; ++i) { const float send = b1 ? q4[i] : q4[i + 2], keep = b1 ? q4[i + 2] : q4[i]; q2[i] = keep + __shfl_xor(send, 2); }
    const float send = b0 ? q2[0] : q2[1], keep = b0 ? q2[1] : q2[0];
    return (keep + __shfl_xor(send, 1)) * inv;
}
__device__ __forceinline__ float cmp_err(float ref, const bf16_t* got, int lane) {
    const float e = wave_max(fabsf(ref - bf2f(got[lane]))), mx = wave_max(fabsf(ref));
    return e / (mx + 1e-3f);
}
__device__ __forceinline__ void phase_selfcheck(const Params& P, LDSP unsigned char* lds, int vcu, int G) {
    unsigned char* ws = P.ws;
    const int tid = opaque_tid(), lane = tid & 63, wave = tid >> 6;
    const int gw = vcu * NWAVES + wave, NGW = G * NWAVES;
    unsigned* cnt = (unsigned*)(ws + OFF_CHK);
    const bf16_t* qa = (const bf16_t*)(ws + OFF_R1);
    const bf16_t* ka = (const bf16_t*)(ws + OFF_R1 + 32 * MiB);
    const bf16_t* va = (const bf16_t*)(ws + OFF_R1 + 64 * MiB);
    const bf16_t* qb = (const bf16_t*)(ws + OFF_R1 + 96 * MiB);
    const bf16_t* ya = (const bf16_t*)(ws + OFF_R0);
    const bf16_t* yb = (const bf16_t*)(ws + OFF_R0 + 32 * MiB);
    const float* kmean = (const float*)(ws + OFF_KMEAN);
    const float* bgate = (const float*)(ws + OFF_BGATE);
    LDSP float* psum = (LDSP float*)(lds + wave * 4096);
    LDSP float* qs = psum + 320;
    LDSP float* ocs = psum + 384;
    constexpr int NS = 537;
#pragma unroll 1
    for (int item = gw; item < NS * 8; item += NGW) {
        const int t = 37 + 61 * (item >> 3), h = item & 7, b = t >> 12, pos = t & (SEQ - 1), own = pos >> 8;
        qs[lane] = bf2f(qa[(size_t)t * 512 + h * 64 + lane]);
        asm volatile("s_waitcnt lgkmcnt(0)" ::: "memory");
        float g0 = -INFINITY, g1 = -INFINITY, g2 = -INFINITY; int i0 = -1, i1 = -1, i2 = -1;
#pragma unroll 1
        for (int j = 0; j < own; ++j) {
            const float* km = kmean + (size_t)((b * 8 + h) * 16 + j) * 64;
            float d = 0.f;
#pragma unroll 8
            for (int i = 0; i < 64; ++i) d += qs[i] * km[i];
            if (d > g0) { g2 = g1; i2 = i1; g1 = g0; i1 = i0; g0 = d; i0 = j; }
            else if (d > g1) { g2 = g1; i2 = i1; g1 = d; i1 = j; }
            else if (d > g2) { g2 = d; i2 = j; }
        }
        NaiveAcc a; nacc_reset(a);
#pragma unroll 1
        for (int j = 0; j <= own; ++j) {
            if (j < own && j != i0 && j != i1 && j != i2) continue;
#pragma unroll 1
            for (int ck = 0; ck < 4; ++ck) {
                const int kp = j * 256 + ck * 64 + lane;
                const size_t kr = (size_t)(b * SEQ + kp) * 512 + h * 64;
                naive_chunk(a, qs, ka + kr, va + kr, kp <= pos);
            }
        }
        const float om = nacc_final(a, lane);
        const float e = cmp_err(om, ya + (size_t)t * 512 + h * 64, lane);
        if (lane == 0 && !(e < 0.05f)) atomicAdd(cnt + 0, 1u);
        asm volatile("s_waitcnt lgkmcnt(0)" ::: "memory");
    }
#pragma unroll 1
    for (int item = gw; item < NS * 2; item += NGW) {
        const int t = 37 + 61 * (item >> 1), g = item & 1, b = t >> 12, pos = t & (SEQ - 1), own = pos >> 6;
        const bf16_t* kc = (const bf16_t*)(ws + OFF_KC) + (size_t)(b * 2 + g) * 256 * 64;
        const bf16_t* vc = (const bf16_t*)(ws + OFF_VC) + (size_t)(b * 2 + g) * 256 * 64;
        const bf16_t* ks = (const bf16_t*)(ws + OFF_R2 + 16 * MiB) + (size_t)(b * SEQ) * 128 + g * 64;
        const bf16_t* vs = (const bf16_t*)(ws + OFF_R2 + 24 * MiB) + (size_t)(b * SEQ) * 128 + g * 64;
        const bf16_t* kw = (const bf16_t*)(ws + OFF_R2 + 32 * MiB) + (size_t)(b * SEQ) * 128 + g * 64;
        const bf16_t* vw = (const bf16_t*)(ws + OFF_R2 + 40 * MiB) + (size_t)(b * SEQ) * 128 + g * 64;
        for (int i = lane; i < 320; i += 64) psum[i] = 0.f;
        asm volatile("s_waitcnt lgkmcnt(0)" ::: "memory");
        const int ncmp_vis = (pos >= 31) ? ((pos - 31) >> 4) + 1 : 0;
#pragma unroll 1
        for (int r = 0; r < 4; ++r) {
            qs[lane] = bf2f(qb[(size_t)t * 512 + (g * 4 + r) * 64 + lane]);
            asm volatile("s_waitcnt lgkmcnt(0)" ::: "memory");
            float mx = -INFINITY;
#pragma unroll 1
            for (int ck = 0; ck < 4; ++ck) { const int n = ck * 64 + lane;
                const float sdot = dot64(qs, kc + (size_t)n * 64);
                mx = fmaxf(mx, (n < ncmp_vis) ? sdot : -INFINITY); }
            mx = wave_max(mx);
            float l = 0.f;
#pragma unroll 1
            for (int ck = 0; ck < 4; ++ck) { const int n = ck * 64 + lane;
                const float sdot = dot64(qs, kc + (size_t)n * 64);
                l += (n < ncmp_vis) ? exp2f(sdot - mx) : 0.f; }
            l = wave_sum(l);
            const float inv = (l > 0.f) ? 1.0f / l : 0.f;
            NaiveAcc a; nacc_reset(a);
#pragma unroll 1
            for (int ck = 0; ck < 4; ++ck) { const int n = ck * 64 + lane;
                const float sdot = dot64(qs, kc + (size_t)n * 64);
                const float pr = (n < ncmp_vis) ? exp2f(sdot - mx) * inv : 0.f;
                psum[n] += pr;
                axpy64(a, 1.0f, pr, vc + (size_t)n * 64); }
            a.l = (lane == 0) ? 1.f : 0.f;
            ocs[r * 64 + lane] = nacc_final(a, lane);
            asm volatile("s_waitcnt lgkmcnt(0)" ::: "memory");
        }
        {
            const int j = lane;
            float imp = 0.f;
            for (int n = 4 * j - 1; n <= 4 * j + 3; ++n) if (n >= 0 && n < 255) imp += psum[n];
            if (j == 0 || j == own || j == own - 1) imp = 1.0e30f;
            if (j > own) imp = -1.0e30f;
            unsigned long long sel = 0ull;
#pragma unroll 1
            for (int r = 0; r < 16; ++r) {
                float v = imp; int i = j;
                wave_argmax(v, i);
                if (v > -0.5e30f) sel |= 1ull << i;
                if (i == j) imp = -3.0e38f;
            }
            psum[256] = __uint_as_float((unsigned)sel); psum[257] = __uint_as_float((unsigned)(sel >> 32));
            asm volatile("s_waitcnt lgkmcnt(0)" ::: "memory");
        }
        const unsigned long long sel = ((unsigned long long)__float_as_uint(psum[257]) << 32) | __float_as_uint(psum[256]);
#pragma unroll 1
        for (int r = 0; r < 4; ++r) {
            const int head = g * 4 + r;
            qs[lane] = bf2f(qb[(size_t)t * 512 + head * 64 + lane]);
            asm volatile("s_waitcnt lgkmcnt(0)" ::: "memory");
            const float gt0 = bgate[(size_t)t * 24 + head * 3], gt1 = bgate[(size_t)t * 24 + head * 3 + 1], gt2 = bgate[(size_t)t * 24 + head * 3 + 2];
            float y = gt0 * ocs[r * 64 + lane];
            NaiveAcc a; nacc_reset(a);
#pragma unroll 1
            for (int j = 0; j <= own; ++j) {
                if (!((sel >> j) & 1ull)) continue;
                const int kp = j * 64 + lane;
                naive_chunk(a, qs, ks + (size_t)kp * 128, vs + (size_t)kp * 128, kp <= pos);
            }
            y += gt1 * nacc_final(a, lane);
            nacc_reset(a);
#pragma unroll 1
            for (int ck = 0; ck < 9; ++ck) {
                const int kp = pos - 575 + ck * 64 + lane;
                const bool valid = kp >= 0 && kp <= pos && kp > pos - 512;
                const int kpc = kp < 0 ? 0 : kp;
                naive_chunk(a, qs, kw + (size_t)kpc * 128, vw + (size_t)kpc * 128, valid);
            }
            y += gt2 * nacc_final(a, lane);
            const float e = cmp_err(y, yb + (size_t)t * 512 + head * 64, lane);
            if (lane == 0 && !(e < 0.05f)) atomicAdd(cnt + 1, 1u);
            asm volatile("s_waitcnt lgkmcnt(0)" ::: "memory");
        }
    }
}

__device__ __forceinline__ void phase_selfcheck2(const Params& P, LDSP unsigned char* lds, int vcu, int G) {
    unsigned char* ws = P.ws;
    const int tid = opaque_tid(), lane = tid & 63, wave = tid >> 6;
    const int gw = vcu * NWAVES + wave, NGW = G * NWAVES;
    unsigned* cnt = (unsigned*)(ws + OFF_CHK);
    LDSP float* hs = (LDSP float*)(lds + wave * 8192);
    const float* x = P.in[I_X]; const float* g1 = P.in[I_NORM1]; const float* w = P.in[I_WIN];
    constexpr int NS = 192, NGRP = 14;
#pragma unroll 1
    for (int item = gw; item < NS * NGRP; item += NGW) {
        const int si = item / NGRP, grp = item % NGRP;
        const int t = 11 + 167 * si, b = t >> 12, pos = t & (SEQ - 1);
        const int hsel = si & 7, gsel = si & 1;
        float ss = 0.f;
        for (int i = lane; i < DM; i += 64) { const float v = x[(size_t)t * DM + i]; ss += v * v; }
        ss = wave_sum(ss);
        const float rs = 1.0f / sqrtf(ss / DM + NORM_EPS);
        for (int i = lane; i < DM; i += 64) hs[i] = x[(size_t)t * DM + i] * rs * g1[i];
        asm volatile("s_waitcnt lgkmcnt(0)" ::: "memory");
        int col0, kind; const float* gain = nullptr; float oscale = 1.f; const bf16_t* got = nullptr; int ncols = 64;
        const bf16_t* R1 = (const bf16_t*)(ws + OFF_R1); const bf16_t* R2 = (const bf16_t*)(ws + OFF_R2); const bf16_t* R3 = (const bf16_t*)(ws + OFF_R3);
        const size_t M32 = (size_t)16 * 1024 * 1024;
        switch (grp) {
        case 0: col0 = hsel * 64;          kind = 1; gain = P.in[I_AQG]; oscale = QSCALE; got = R1 + (size_t)t * 512 + hsel * 64; break;
        case 1: col0 = 512 + hsel * 64;    kind = 1; gain = P.in[I_AKG]; got = R1 + M32 + (size_t)t * 512 + hsel * 64; break;
        case 2: col0 = 1024 + hsel * 64;   kind = 0; got = R1 + 2 * M32 + (size_t)t * 512 + hsel * 64; break;
        case 3: col0 = 1536 + hsel * 64;   kind = 1; gain = P.in[I_BQG]; oscale = QSCALE; got = R1 + 3 * M32 + (size_t)t * 512 + hsel * 64; break;
        case 4: col0 = 2048 + gsel * 64;   kind = 0; got = R2 + ((size_t)((b * 2 + gsel) * SEQ + pos)) * 64; break;
        case 5: col0 = 2176 + gsel * 64;   kind = 0; got = R2 + M32 / 4 + ((size_t)((b * 2 + gsel) * SEQ + pos)) * 64; break;
        case 6: col0 = 2304 + gsel * 64;   kind = 1; gain = P.in[I_BKSG]; got = R2 + 2 * (M32 / 4) + (size_t)t * 128 + gsel * 64; break;
        case 7: col0 = 2432 + gsel * 64;   kind = 0; got = R2 + 3 * (M32 / 4) + (size_t)t * 128 + gsel * 64; break;
        case 8: col0 = 2560 + gsel * 64;   kind = 1; gain = P.in[I_BKWG]; got = R2 + 4 * (M32 / 4) + (size_t)t * 128 + gsel * 64; break;
        case 9: col0 = 2688 + gsel * 64;   kind = 0; got = R2 + 5 * (M32 / 4) + (size_t)t * 128 + gsel * 64; break;
        case 10: col0 = 2840 + hsel * 64;        kind = 2; got = R3 + (size_t)t * 2048 + hsel * 64; break;
        case 11: col0 = 2840 + 1024 + hsel * 64; kind = 2; got = R3 + (size_t)t * 2048 + 1024 + hsel * 64; break;
        case 12: col0 = 2840 + 1024 + 512 + hsel * 64; kind = 2; got = R3 + (size_t)t * 2048 + 1536 + hsel * 64; break;
        default: col0 = 2816; kind = 3; ncols = 24; break;
        }
        if (grp == 10) continue;
        float acc = 0.f;
        if (lane < ncols) {
#pragma unroll 4
            for (int k = 0; k < DM; ++k) acc += hs[k] * w[(size_t)k * 4888 + col0 + lane];
        }
        float ref;
        if (kind == 1) {
            const float ssq = wave_sum(acc * acc);
            float y = acc / sqrtf(ssq / 64.0f + NORM_EPS) * gain[lane];
            const float ya_ = __shfl(y, (lane + 8) & 63), yb_ = __shfl(y, (lane - 8) & 63);
            const int f = lane & 7;
            const float ang = (float)pos * powf(500000.0f, -(float)(2 * f) / 16.0f);
            const float c = cosf(ang), sn = sinf(ang);
            if (lane < 8) y = y * c - ya_ * sn; else if (lane < 16) y = y * c + yb_ * sn;
            ref = y * oscale;
        } else if (kind == 2) {
            ref = 1.0f / (1.0f + expf(-(acc + P.in[I_BMERGE][col0 - 2840 + lane])));
        } else if (kind == 3) {
            ref = 1.0f / (1.0f + expf(-acc));
        } else ref = acc;
        float gotv;
        if (kind == 3) gotv = (lane < 24) ? ((const float*)(ws + OFF_BGATE))[(size_t)t * 24 + lane] : 0.f;
        else gotv = bf2f(got[lane]);
        if (kind == 3 && lane >= 24) ref = 0.f;
        const float e = wave_max(fabsf(ref - gotv)) / (wave_max(fabsf(ref)) + 1e-3f);
        if (lane == 0 && !(e < 0.03f)) atomicAdd(cnt + 0, 1u);
        asm volatile("s_waitcnt lgkmcnt(0)" ::: "memory");
    }
#pragma unroll 1
    for (int item = gw; item < 1024; item += NGW) {
        const int b = item >> 7, h = (item >> 4) & 7, blk = item & 15;
        const bf16_t* p = (const bf16_t*)(ws + OFF_R1 + 32 * MiB) + (size_t)(b * SEQ + blk * 256) * 512 + h * 64 + lane;
        float sref = 0.f;
        for (int k = 0; k < 256; ++k) sref += bf2f(p[(size_t)k * 512]);
        const float gotv = ((const float*)(ws + OFF_KMEAN))[(size_t)item * 64 + lane];
        const float e = wave_max(fabsf(sref - gotv)) / (wave_max(fabsf(sref)) + 1e-2f);
        if (lane == 0 && !(e < 0.03f)) atomicAdd(cnt + 1, 1u);
    }
#pragma unroll 1
    for (int item = gw; item < 96 * 2; item += NGW) {
        const int si = item >> 1, kv = item & 1;
        const int slab = si & 15, n = (si * 37 + 3) % 255;
        const bf16_t* raw = (const bf16_t*)(ws + OFF_R2 + (size_t)kv * 8 * MiB) + (size_t)slab * SEQ * 64 + (size_t)n * 16 * 64;
        const float* posv = P.in[kv ? I_CPV : I_CPK]; const float* w1 = P.in[kv ? I_CVW1 : I_CKW1]; const float* b1 = P.in[kv ? I_CVB1 : I_CKB1];
        const float* w2 = P.in[kv ? I_CVW2 : I_CKW2]; const float* b2 = P.in[kv ? I_CVB2 : I_CKB2];
        float hacc[4] = {0.f, 0.f, 0.f, 0.f};
#pragma unroll 1
        for (int i = 0; i < 2048; ++i) {
            const float a = bf2f(raw[i]) + posv[i];
#pragma unroll
            for (int u = 0; u < 4; ++u) hacc[u] += a * w1[(size_t)i * 256 + lane + 64 * u];
        }
#pragma unroll
        for (int u = 0; u < 4; ++u) { const float z = hacc[u] + b1[lane + 64 * u]; hs[1024 + lane + 64 * u] = 0.5f * z * (1.0f + tanhf(0.7978845608028654f * (z + 0.044715f * z * z * z))); }
        asm volatile("s_waitcnt lgkmcnt(0)" ::: "memory");
        float o = b2[lane];
#pragma unroll 4
        for (int j = 0; j < 256; ++j) o += hs[1024 + j] * w2[(size_t)j * 64 + lane];
        if (!kv) { const float ssq = wave_sum(o * o); o = o / sqrtf(ssq / 64.0f + NORM_EPS) * P.in[I_BKCG][lane]; }
        const float gotv = bf2f(((const bf16_t*)(ws + (kv ? OFF_VC : OFF_KC)))[((size_t)slab * 256 + n) * 64 + lane]);
        const float e = wave_max(fabsf(o - gotv)) / (wave_max(fabsf(o)) + 1e-3f);
        if (lane == 0 && !(e < 0.03f)) atomicAdd(cnt + 1, 1u);
        asm volatile("s_waitcnt lgkmcnt(0)" ::: "memory");
    }
}
#endif

#define XB_TMO      128
#define XB_XCNT(j)  (256  + 64 * (j))
#define XB_XSUB(j)  (1280 + 64 * (j))
#define XB_XGEN(j)  (2304 + 64 * (j))
#define XB_TOP      3328
#define XB_TOPGEN   3392
#define XCD_BAR_WORDS 3456
#define XB_SPIN_CAP (1u << 22)
__device__ __forceinline__ unsigned xb_ld(unsigned* p)              { return __hip_atomic_load(p, __ATOMIC_RELAXED, __HIP_MEMORY_SCOPE_AGENT); }
__device__ __forceinline__ unsigned xb_add(unsigned* p, unsigned v) { return __hip_atomic_fetch_add(p, v, __ATOMIC_RELAXED, __HIP_MEMORY_SCOPE_AGENT); }
__device__ __forceinline__ unsigned xb_xcc_id() { return (unsigned)__builtin_amdgcn_s_getreg((3 << 11) | 20) & 0xFu; }
#define XB_SPIN(cond, bar) do { unsigned _sp = 0; while (cond) { __builtin_amdgcn_s_sleep(1); \
    if ((++_sp & 255u) == 0u) { if (xb_ld(&(bar)[XB_TMO])) break; if (_sp > XB_SPIN_CAP) { atomicAdd(&(bar)[XB_TMO], 1u); break; } } } } while (0)
struct XcdBarrier { unsigned* bar; unsigned x; volatile LDSP unsigned* st; };
__device__ __forceinline__ XcdBarrier xcd_barrier_post(unsigned* bar, volatile LDSP unsigned* st) {
    XcdBarrier b; b.bar = bar; b.x = xb_xcc_id(); b.st = st;
    if (threadIdx.x == 0) (void)xb_add(&bar[XB_XCNT(b.x)], 1u);
    return b;
}
__device__ __forceinline__ void xcd_barrier_complete(unsigned* bar, unsigned x, unsigned& nloc, unsigned& nx) {
    const unsigned G = gridDim.x * gridDim.y * gridDim.z;
    unsigned sum, cnt, mine, sp = 0u;
    for (;;) {
        sum = 0u; cnt = 0u; mine = 0u;
#pragma unroll
        for (unsigned j = 0; j < 16; ++j) { const unsigned c = xb_ld(&bar[XB_XCNT(j)]); sum += c; cnt += (c > 0u) ? 1u : 0u; mine = (j == x) ? c : mine; }
        if (sum == G) break;
        __builtin_amdgcn_s_sleep(1);
        if ((++sp & 255u) == 0u) { if (xb_ld(&bar[XB_TMO])) break; if (sp > XB_SPIN_CAP) { atomicAdd(&bar[XB_TMO], 1u); break; } }
    }
    nloc = mine > 0u ? mine : 1u; nx = cnt > 0u ? cnt : 1u;
}
__device__ __forceinline__ void xcd_barrier(const XcdBarrier& b) {
    asm volatile("s_waitcnt vmcnt(0)" ::: "memory");
    __syncthreads();
    if (threadIdx.x == 0) {
        unsigned* bar = b.bar;
        __builtin_amdgcn_s_waitcnt(0);
        unsigned nloc = b.st[0], nx = b.st[1];
        if (nloc == 0u) { xcd_barrier_complete(bar, b.x, nloc, nx); b.st[0] = nloc; b.st[1] = nx; }
        const unsigned old = xb_add(&bar[XB_XSUB(b.x)], 1u);
        const unsigned gen = old / nloc;
        if (old + 1u == (gen + 1u) * nloc) {
            __builtin_amdgcn_fence(__ATOMIC_RELEASE, "agent");
            asm volatile("s_waitcnt vmcnt(0)" ::: "memory");
            const unsigned og = xb_add(&bar[XB_TOP], 1u);
            const unsigned tg = og / nx;
            if (og + 1u == (tg + 1u) * nx) xb_add(&bar[XB_TOPGEN], 1u);
            else XB_SPIN(xb_ld(&bar[XB_TOPGEN]) == tg, bar);
            __builtin_amdgcn_fence(__ATOMIC_ACQUIRE, "agent");
            xb_add(&bar[XB_XGEN(b.x)], 1u);
            asm volatile("s_waitcnt vmcnt(0)" ::: "memory");
        } else {
            XB_SPIN(xb_ld(&bar[XB_XGEN(b.x)]) == gen, bar);
            __builtin_amdgcn_fence(__ATOMIC_ACQUIRE, "agent");
            asm volatile("s_waitcnt vmcnt(0)" ::: "memory");
        }
    }
    __syncthreads();
}

__global__ void __launch_bounds__(NTHREADS, 2) fwd_kernel(Params P) {
    extern __shared__ __attribute__((aligned(16))) unsigned char lds_raw[];
    LDSP unsigned char* lds = (LDSP unsigned char*)lds_raw;
    const int G = gridDim.x, bx = blockIdx.x;
    const int vcu = (G % 8 == 0) ? (bx % 8) * (G / 8) + bx / 8 : bx;
    const int lo = P.ph_lo, hi = P.ph_hi;
    volatile LDSP unsigned* bst = (volatile LDSP unsigned*)(lds + LDS_BYTES - 16);
    if (threadIdx.x == 0) { bst[0] = 0u; bst[1] = 0u; bst[2] = 0u; bst[3] = 0u; }
    __syncthreads();
    const XcdBarrier xbar = xcd_barrier_post((unsigned*)(P.ws + 16384), bst);
    if (threadIdx.x == 0) bst[2] = xb_add((unsigned*)(P.ws + 32768) + 64 * xbar.x, 1u);
#define IN(k) (lo <= (k) && (k) < hi)
#define SEAM(k) do { if (IN(k) && IN((k) + 1)) xcd_barrier(xbar); } while (0)
    if (IN(0)) phase_prep(P, lds, vcu, G);
    SEAM(0);
    if (IN(1)) phase_proj(P, lds, vcu, G);
    SEAM(1);
    if (IN(2)) phase_cmp1(P, lds, vcu, G);
    SEAM(2);
    if (IN(3)) phase_cmp2(P, lds, vcu, G);
    SEAM(3);
    if (IN(4)) phase_attn(P, lds, vcu, G);
    SEAM(4);
#if SELFCHECK == 1
    phase_selfcheck(P, lds, vcu, G);
    xcd_barrier(xbar);
#elif SELFCHECK == 2
    phase_selfcheck2(P, lds, vcu, G);
    xcd_barrier(xbar);
#endif
    if (IN(5)) phase_up(P, lds, vcu, G);
    SEAM(5);
    if (IN(6)) phase_out(P, lds, vcu, G);
    SEAM(6);
    if (IN(7)) phase_pq(P, lds, vcu, G);
    SEAM(7);
    if (IN(8)) phase_topk(P, lds, vcu, G);
    SEAM(8);
    if (IN(9)) { phase_peer_a(P, lds, vcu, G); xcd_barrier(xbar); phase_peer_w(P, lds, vcu, G); xcd_barrier(xbar); phase_peer_b(P, lds, vcu, G); }
#if SELFCHECK
    xcd_barrier(xbar);
    if (bx == 0 && threadIdx.x == 0) {
        const unsigned* cnt = (const unsigned*)(P.ws + OFF_CHK);
        P.out[0] += 1000.0f * (float)cnt[0];
        P.out[1] += 1000000.0f * (float)cnt[1];
    }
#endif
#undef IN
#undef SEAM
}

extern "C" void kernel_launch(void* const* d_in, const int* in_sizes, int n_in, void* d_out, int out_size, void* d_ws, size_t ws_size, hipStream_t stream) {
    static int grid = 0;
    if (grid == 0) {
        if (n_in != 29 || ws_size < WS_END) { fprintf(stderr, "kernel_launch: unexpected n_in %d / ws_size %zu\n", n_in, ws_size); grid = -1; return; }
        int dev = 0, cus = 0, per_cu = 0;
        (void)hipGetDevice(&dev);
        (void)hipDeviceGetAttribute(&cus, hipDeviceAttributeMultiprocessorCount, dev);
        (void)hipFuncSetAttribute((const void*)fwd_kernel, hipFuncAttributeMaxDynamicSharedMemorySize, LDS_BYTES);
        (void)hipOccupancyMaxActiveBlocksPerMultiprocessor(&per_cu, (const void*)fwd_kernel, NTHREADS, LDS_BYTES);
        if (per_cu < 1) { fprintf(stderr, "kernel_launch: occupancy query says %d blocks per CU\n", per_cu); grid = -1; return; }
        grid = cus;
    }
    if (grid < 0) return;
    Params p{};
    for (int i = 0; i < 29; ++i) p.in[i] = (const float*)d_in[i];
    p.out = (float*)d_out; p.ws = (unsigned char*)d_ws;
    (void)hipMemsetAsync(d_ws, 0, 65536, stream);
    p.ph_lo = 0; p.ph_hi = 10;
    hipLaunchKernelGGL(fwd_kernel, dim3(grid), dim3(NTHREADS), LDS_BYTES, stream, p);
}
```

```cpp
#include <hip/hip_runtime.h>
#include <hip/hip_cooperative_groups.h>
#include <stdint.h>
#include <stdio.h>
#define SELFCHECK 0
namespace cg = cooperative_groups;

#define LDSP __attribute__((address_space(3)))
typedef unsigned short bf16_t;
typedef short bf16x8 __attribute__((ext_vector_type(8)));
typedef short s16x4 __attribute__((ext_vector_type(4)));
typedef float f32x2 __attribute__((ext_vector_type(2)));
typedef float f32x4 __attribute__((ext_vector_type(4)));
typedef float f32x16 __attribute__((ext_vector_type(16)));
typedef unsigned u32x2 __attribute__((ext_vector_type(2)));
typedef unsigned u32x4 __attribute__((ext_vector_type(4)));
typedef __bf16 bf16x2_t __attribute__((ext_vector_type(2)));

constexpr int BATCH = 8, SEQ = 4096, DM = 1024, T = BATCH * SEQ;
constexpr int HD = 64;
constexpr int NPROJ = 5120;
constexpr int PEER_NE = 16384;
constexpr float NORM_EPS = 1e-6f;
constexpr float QSCALE = 0.125f * 1.4426950408889634f;
constexpr int NTHREADS = 512, NWAVES = 8;
constexpr int LDS_BYTES = 140 * 1024;

constexpr size_t MiB = 1u << 20;
constexpr size_t OFF_RS1 = 1 * MiB;
constexpr size_t OFF_RS2 = 1 * MiB + 256 * 1024;
constexpr size_t OFF_ROPE_C = 2 * MiB;
constexpr size_t OFF_ROPE_S = 2 * MiB + 128 * 1024;
constexpr size_t OFF_POSB = 2 * MiB + 512 * 1024;
constexpr size_t OFF_KMEAN = 3 * MiB;
constexpr size_t OFF_BGATE = 4 * MiB;
constexpr size_t OFF_WIN_T = 8 * MiB;
constexpr size_t OFF_WUPA_T = 19 * MiB;
constexpr size_t OFF_WUPB_T = 20 * MiB;
constexpr size_t OFF_WOUT_T = 21 * MiB;
constexpr size_t OFF_WPQ_T = 23 * MiB;
constexpr size_t OFF_W1K_T = 27 * MiB;
constexpr size_t OFF_W1V_T = 28 * MiB;
constexpr size_t OFF_W2K_T = 29 * MiB;
constexpr size_t OFF_W2V_T = 29 * MiB + 128 * 1024;
constexpr size_t OFF_K1B = 29 * MiB + 256 * 1024;
constexpr size_t OFF_K2B = 29 * MiB + 320 * 1024;
constexpr size_t OFF_HID = 30 * MiB;
constexpr size_t OFF_KC = 34 * MiB;
constexpr size_t OFF_VC = 35 * MiB;
constexpr size_t OFF_EXPERTS = 36 * MiB;
constexpr size_t OFF_GATES = 52 * MiB;
constexpr size_t OFF_U = 68 * MiB;
constexpr size_t OFF_PSCALE = 84 * MiB;
constexpr size_t OFF_V = 100 * MiB;
constexpr size_t OFF_R0 = 132 * MiB;
constexpr size_t OFF_R1 = 196 * MiB;
constexpr size_t OFF_R2 = 324 * MiB;
constexpr size_t OFF_R3 = 372 * MiB;
constexpr size_t WS_END = 500 * MiB;

struct Params {
    const float* in[29];
    float* out;
    unsigned char* ws;
    int ph_lo, ph_hi;
};
static_assert(sizeof(Params) == 31 * 8 + 8, "Params has no padding");

enum { I_X = 0, I_NORM1, I_WIN, I_BMERGE, I_AQG, I_AKG, I_BQG, I_BKCG, I_BKSG, I_BKWG,
       I_CPK, I_CKW1, I_CKB1, I_CKW2, I_CKB2, I_CPV, I_CVW1, I_CVB1, I_CVW2, I_CVB2,
       I_WUPA, I_WUPB, I_WOUT, I_NORM2, I_PWQ, I_PK1, I_PK2, I_PU, I_PV };

__device__ __forceinline__ int opaque_tid() { int t = threadIdx.x; asm volatile("" : "+v"(t)); return t; }
__device__ __forceinline__ unsigned pk2(float lo, float hi) {
    f32x2 v = {lo, hi};
    bf16x2_t b = __builtin_convertvector(v, bf16x2_t);
    return __builtin_bit_cast(unsigned, b);
}
__device__ __forceinline__ float bf2f(bf16_t b) { return __uint_as_float(((unsigned)b) << 16); }
__device__ __forceinline__ float wave_sum(float v) {
#pragma unroll
    for (int o = 1; o < 64; o <<= 1) v += __shfl_xor(v, o);
    return v;
}
__device__ __forceinline__ float gelu_tanh(float x) {
    const float u = 0.7978845608028654f * (x + 0.044715f * x * x * x);
    return x / (1.0f + __expf(-2.0f * u));
}
__device__ __forceinline__ float sigmoidf_(float x) { return 1.0f / (1.0f + __expf(-x)); }
__device__ __forceinline__ void cvt8(const u32x4 w, float (&f)[8]) {
    f[0] = __uint_as_float(w.x << 16); f[1] = __uint_as_float(w.x & 0xffff0000u); f[2] = __uint_as_float(w.y << 16); f[3] = __uint_as_float(w.y & 0xffff0000u);
    f[4] = __uint_as_float(w.z << 16); f[5] = __uint_as_float(w.z & 0xffff0000u); f[6] = __uint_as_float(w.w << 16); f[7] = __uint_as_float(w.w & 0xffff0000u);
}
__device__ __forceinline__ int swz_off(int row, int chunk) { return row * 128 + ((chunk ^ ((row >> 1) & 7)) << 4); }

__device__ __forceinline__ void transpose_item(const float* W, int ldw, int k0, int src_c0, int nvalid, const float* kscale,
                                               bf16_t* WT, int ldwt, int n0, LDSP float* scr, int lane) {
#pragma unroll 8
    for (int i = 0; i < 32; ++i) {
        const int kk = 2 * i + (lane >> 5), nn = lane & 31;
        float v = 0.f;
        if (nn < nvalid) v = W[(size_t)(k0 + kk) * ldw + src_c0 + nn];
        if (kscale) v *= kscale[k0 + kk];
        scr[kk * 33 + nn] = v;
    }
    asm volatile("s_waitcnt lgkmcnt(0)" ::: "memory");
    const int c = lane & 7;
#pragma unroll
    for (int j = 0; j < 4; ++j) {
        const int n = (lane >> 3) + 8 * j;
        const LDSP float* s = scr + (8 * c) * 33 + n;
        u32x4 o;
        o.x = pk2(s[0 * 33], s[1 * 33]); o.y = pk2(s[2 * 33], s[3 * 33]); o.z = pk2(s[4 * 33], s[5 * 33]); o.w = pk2(s[6 * 33], s[7 * 33]);
        *(u32x4*)(WT + (size_t)(n0 + n) * ldwt + k0 + 8 * c) = o;
    }
    asm volatile("s_waitcnt lgkmcnt(0)" ::: "memory");
}

struct TrJob { const float* W; int K, N, ldw; const float* kscale; bf16_t* WT; int kind; };

__device__ __forceinline__ void run_tr_job(const TrJob& J, int item, LDSP float* scr, int lane) {
    const int nblk = J.N / 32, kb = item / nblk, nb = item % nblk;
    int src_c0 = nb * 32, nvalid = 32;
    if (J.kind == 1) {
        const int p0 = nb * 32, pn = p0 >> 8, q = p0 & 255, bj = q >> 7, wc = (q >> 5) & 3, H = 4 * pn + wc, d0 = 32 * bj;
        if (H < 44) src_c0 = 64 * H + d0;
        else if (H < 76) src_c0 = 64 * H + d0 + 24;
        else if (H == 76 && bj == 0) { src_c0 = 2816; nvalid = 24; }
        else { src_c0 = 0; nvalid = 0; }
    } else if (J.kind == 2) {
        if (nb * 32 >= 64) { src_c0 = 0; nvalid = 0; }
    }
    transpose_item(J.W, J.ldw, kb * 64, src_c0, nvalid, J.kscale, J.WT, J.K, nb * 32, scr, lane);
}

__device__ __forceinline__ void phase_prep(const Params& P, LDSP unsigned char* lds, int vcu, int G) {
    const int tid = opaque_tid(), lane = tid & 63, wave = tid >> 6;
    const int gw = vcu * NWAVES + wave, NGW = G * NWAVES;
    unsigned char* ws = P.ws;
    LDSP float* scr = (LDSP float*)(lds + wave * 8704);
    int base = 0;
#define TR_JOB(Wp, Kk, Nn, LDW, KS, WTp, KIND) do { TrJob J{Wp, Kk, Nn, LDW, KS, WTp, KIND}; const int nitems = ((Kk) / 64) * ((Nn) / 32); \
        const int first = (gw - base % NGW + NGW) % NGW; for (int it = first; it < nitems; it += NGW) run_tr_job(J, it, scr, lane); base += nitems; } while (0)
    TR_JOB(P.in[I_WIN], 1024, NPROJ, 4888, P.in[I_NORM1], (bf16_t*)(ws + OFF_WIN_T), 1);
    TR_JOB(P.in[I_WUPA], 512, 1024, 1024, nullptr, (bf16_t*)(ws + OFF_WUPA_T), 0);
    TR_JOB(P.in[I_WUPB], 512, 1024, 1024, nullptr, (bf16_t*)(ws + OFF_WUPB_T), 0);
    TR_JOB(P.in[I_WOUT], 1024, 1024, 1024, nullptr, (bf16_t*)(ws + OFF_WOUT_T), 0);
    TR_JOB(P.in[I_PWQ], 1024, 2048, 2048, P.in[I_NORM2], (bf16_t*)(ws + OFF_WPQ_T), 0);
    TR_JOB(P.in[I_CKW1], 2048, 256, 256, nullptr, (bf16_t*)(ws + OFF_W1K_T), 0);
    TR_JOB(P.in[I_CVW1], 2048, 256, 256, nullptr, (bf16_t*)(ws + OFF_W1V_T), 0);
    TR_JOB(P.in[I_CKW2], 256, 128, 64, nullptr, (bf16_t*)(ws + OFF_W2K_T), 2);
    TR_JOB(P.in[I_CVW2], 256, 128, 64, nullptr, (bf16_t*)(ws + OFF_W2V_T), 2);
#undef TR_JOB
    {
        const float* x = P.in[I_X];
        bf16_t* xb = (bf16_t*)(ws + OFF_R0);
        float* rs1 = (float*)(ws + OFF_RS1);
        for (int m = gw; m < T; m += NGW) {
            const f32x4* xr = (const f32x4*)(x + (size_t)m * DM) + lane;
            f32x4 v[4]; float s = 0.f;
#pragma unroll
            for (int j = 0; j < 4; ++j) { v[j] = xr[64 * j]; s += (v[j].x * v[j].x + v[j].y * v[j].y) + (v[j].z * v[j].z + v[j].w * v[j].w); }
            s = wave_sum(s);
            if (lane == 0) rs1[m] = 1.0f / sqrtf(s * (1.0f / DM) + NORM_EPS);
            u32x2* o = (u32x2*)(xb + (size_t)m * DM) + lane;
#pragma unroll
            for (int j = 0; j < 4; ++j) { u32x2 w; w.x = pk2(v[j].x, v[j].y); w.y = pk2(v[j].z, v[j].w); o[64 * j] = w; }
        }
    }
    {
        const float* g2 = P.in[I_NORM2];
        f32x4 g4[4];
#pragma unroll
        for (int q = 0; q < 4; ++q) g4[q] = *(const f32x4*)(g2 + 256 * q + 4 * lane);
        float* scales = (float*)(ws + OFF_PSCALE);
#pragma unroll 2
        for (int r = gw; r < 2 * PEER_NE; r += NGW) {
            const int which = (r >= PEER_NE) ? 1 : 0, e = r & (PEER_NE - 1);
            const float* src = P.in[which ? I_PV : I_PU] + (size_t)e * DM + 4 * lane;
            f32x4 a[4]; float ss = 0.f;
#pragma unroll
            for (int q = 0; q < 4; ++q) { a[q] = *(const f32x4*)(src + 256 * q); if (!which) a[q] = a[q] * g4[q];
                ss += (a[q].x * a[q].x + a[q].y * a[q].y) + (a[q].z * a[q].z + a[q].w * a[q].w); }
            ss = wave_sum(ss);
            const float rms = sqrtf(ss * (1.0f / DM)), sc = (rms > 0.f) ? 0.5f * rms : 1.0f, inv = 1.0f / sc;
            unsigned char* dst = ws + (which ? OFF_V : OFF_U) + (size_t)e * 128 + 2 * lane;
#pragma unroll
            for (int q = 0; q < 4; ++q) {
                unsigned pq = 0;
                pq = __builtin_amdgcn_cvt_scalef32_pk_fp4_f32(pq, a[q].x * inv, a[q].y * inv, 1.0f, 0);
                pq = __builtin_amdgcn_cvt_scalef32_pk_fp4_f32(pq, a[q].z * inv, a[q].w * inv, 1.0f, 1);
                *(unsigned short*)(dst + (size_t)q * PEER_NE * 128) = (unsigned short)pq;
            }
            if (lane == 0) scales[r] = sc;
        }
    }
    {
        const int gt = gw * 64 + lane, NGT = NGW * 64;
        for (int i = gt; i < 2 * 128 * 128; i += NGT) {
            const int w = i >> 14, e = i & 16383;
            const float v = P.in[w ? I_PK2 : I_PK1][e];
            ((bf16_t*)(ws + (w ? OFF_K2B : OFF_K1B)))[e] = (bf16_t)(pk2(v, 0.f) & 0xffff);
        }
        if (gt < 8) ((float*)(ws + OFF_ROPE_C))[gt] = powf(500000.0f, -(float)(2 * gt) / 16.0f) * 0.15915494309189535f;
        for (int i = gt; i < T; i += NGT) ((float*)(ws + OFF_RS2))[i] = 0.f;
        for (int i = gt; i < 8 * 8 * 16 * 64; i += NGT) ((float*)(ws + OFF_KMEAN))[i] = 0.f;
        if (gt < 2) ((unsigned*)(ws + 512 * 1024))[gt] = 0u;
        for (int o = gw; o < 512; o += NGW) {
            const int w = o >> 8, j = o & 255;
            const float* pos = P.in[w ? I_CPV : I_CPK];
            const float* w1 = P.in[w ? I_CVW1 : I_CKW1];
            float s = 0.f;
            for (int i = lane; i < 2048; i += 64) s += pos[i] * w1[(size_t)i * 256 + j];
            s = wave_sum(s);
            if (lane == 0) ((float*)(ws + OFF_POSB))[o] = s + P.in[w ? I_CVB1 : I_CKB1][j];
        }
    }
}

constexpr int G_BM = 256, G_BN = 128, G_BK = 64;
constexpr int G_ABYTES = G_BM * 128, G_BBYTES = G_BN * 128, G_STAGE = G_ABYTES + G_BBYTES;

__device__ __forceinline__ void gemm_kloop(f32x4 (&acc)[4][4], const bf16_t* A, size_t lda, const bf16_t* Bt, size_t ldb, int K, LDSP unsigned char* lds) {
    const int tid = opaque_tid(), lane = tid & 63, wid = tid >> 6, wm = wid >> 1, wn = wid & 1, fr = lane & 15, fq = lane >> 4;
    const int lrow = tid >> 3, lch = tid & 7;
    const bf16_t* ga = A + (size_t)lrow * lda + lch * 8;
    const bf16_t* gb = Bt + (size_t)lrow * ldb + lch * 8;
    u32x4 ra[4], rb[2];
    const int nk = K / G_BK;
#pragma unroll
    for (int p = 0; p < 4; ++p) ra[p] = *(const u32x4*)(ga + (size_t)(64 * p) * lda);
#pragma unroll
    for (int p = 0; p < 2; ++p) rb[p] = *(const u32x4*)(gb + (size_t)(64 * p) * ldb);
    __syncthreads();
#pragma unroll
    for (int p = 0; p < 4; ++p) *(LDSP u32x4*)(lds + swz_off(lrow + 64 * p, lch)) = ra[p];
#pragma unroll
    for (int p = 0; p < 2; ++p) *(LDSP u32x4*)(lds + G_ABYTES + swz_off(lrow + 64 * p, lch)) = rb[p];
    __syncthreads();
    for (int kt = 0; kt < nk; ++kt) {
        LDSP unsigned char* cur = lds + (kt & 1) * G_STAGE;
        LDSP unsigned char* nxt = lds + ((kt + 1) & 1) * G_STAGE;
        if (kt + 1 < nk) {
#pragma unroll
            for (int p = 0; p < 4; ++p) ra[p] = *(const u32x4*)(ga + (size_t)(64 * p) * lda + (kt + 1) * G_BK);
#pragma unroll
            for (int p = 0; p < 2; ++p) rb[p] = *(const u32x4*)(gb + (size_t)(64 * p) * ldb + (kt + 1) * G_BK);
        }
#pragma unroll
        for (int ks = 0; ks < 2; ++ks) {
            bf16x8 af[4], bfr[4];
#pragma unroll
            for (int m = 0; m < 4; ++m) af[m] = *(const LDSP bf16x8*)(cur + swz_off(wm * 64 + m * 16 + fr, ks * 4 + fq));
#pragma unroll
            for (int n = 0; n < 4; ++n) bfr[n] = *(const LDSP bf16x8*)(cur + G_ABYTES + swz_off(wn * 64 + n * 16 + fr, ks * 4 + fq));
#pragma unroll
            for (int m = 0; m < 4; ++m)
#pragma unroll
                for (int n = 0; n < 4; ++n) acc[m][n] = __builtin_amdgcn_mfma_f32_16x16x32_bf16(bfr[n], af[m], acc[m][n], 0, 0, 0);
        }
        if (kt + 1 < nk) {
#pragma unroll
            for (int p = 0; p < 4; ++p) *(LDSP u32x4*)(nxt + swz_off(lrow + 64 * p, lch)) = ra[p];
#pragma unroll
            for (int p = 0; p < 2; ++p) *(LDSP u32x4*)(nxt + G_ABYTES + swz_off(lrow + 64 * p, lch)) = rb[p];
        }
        __syncthreads();
    }
}

__device__ __forceinline__ void zero_acc(f32x4 (&acc)[4][4]) {
#pragma unroll
    for (int m = 0; m < 4; ++m)
#pragma unroll
        for (int n = 0; n < 4; ++n) acc[m][n] = (f32x4){0.f, 0.f, 0.f, 0.f};
}

__device__ __forceinline__ bool tile_order(int it, int vcu, int G, int nM, int nN, int& tm, int& tn) {
    if (G == 256 && (nM % 32) == 0) {
        const int xcd = vcu >> 5, cu = vcu & 31, mper = nM / 8;
        const int L = it * 32 + cu, per_group = 4 * nN;
        if (L >= mper * nN) return false;
        const int mg = L / per_group, rem = L % per_group;
        tm = xcd * mper + mg * 4 + (rem & 3); tn = rem >> 2;
        return true;
    }
    const int L = it * G + vcu;
    if (L >= nM * nN) return false;
    tm = L / nN; tn = L % nN;
    return true;
}

namespace pg8 {
constexpr int BM = 256, BK = 64, HALF = 128, HTB = HALF * BK * 2, NXCD = 8, WGM = 8;
__device__ __forceinline__ int lds_byte(int r, int c) { const int st = (r >> 4) * 2 + (c >> 5), rr = r & 15, cc = c & 31, ob = rr * 64 + cc * 2; return st * 1024 + (ob ^ (((ob >> 9) & 1) << 5)); }
__device__ __forceinline__ void stage_rc(int b, int& R, int& C) { const int st = b / 1024, sb = b % 1024, swz = sb ^ (((sb >> 9) & 1) << 5); R = (st >> 1) * 16 + swz / 64; C = (st & 1) * 32 + (swz % 64) / 2; }
__device__ __forceinline__ int perm32(int rho) { const int n = rho >> 4, i = rho & 15; return 8 * (i >> 2) + 4 * n + (i & 3); }
struct Unit { int pm, pn, z; };
__device__ __forceinline__ bool tile_of(int L, int nM, int nN, int& pm, int& pn) {
    const int nwg = nM * nN; if (L >= nwg) return false;
    int wgid = L; { const int q = nwg / NXCD, r = nwg % NXCD, xcd = wgid % NXCD, off = wgid / NXCD; wgid = (xcd < r ? xcd * (q + 1) : r * (q + 1) + (xcd - r) * q) + off; }
    const int nig = WGM * nN, gid = wgid / nig, fm = gid * WGM, gsz = (nM - fm) < WGM ? (nM - fm) : WGM;
    pm = fm + ((wgid % nig) % gsz); pn = (wgid % nig) / gsz; return true;
}
struct Sched {
    const bf16_t *A0, *A1, *B0, *B1; size_t lda, ldb; int K, nM, nN, NZ, G, c;
    __device__ __forceinline__ bool next(int i, Unit& u) const { u.z = (NZ == 2) ? (i & 1) : 0; const int ti = (NZ == 2) ? (i >> 1) : i; return tile_of(ti * G + c, nM, nN, u.pm, u.pn); }
    __device__ __forceinline__ const char* aptr(const Unit& u) const { return (const char*)((u.z ? A1 : A0) + (size_t)u.pm * BM * lda); }
    __device__ __forceinline__ const char* bptr(const Unit& u) const { return (const char*)((u.z ? B1 : B0) + (size_t)u.pn * BM * ldb); }
};
template <class Epi>
__device__ __forceinline__ void gemm_phase(LDSP unsigned char* lds, const Sched& S, const Epi& E) {
    const int tid = opaque_tid(), wid = __builtin_amdgcn_readfirstlane(tid >> 6), lane = tid & 63, wr = wid >> 2, wc = wid & 3, fr = lane & 15, fq = lane >> 4;
    const int nt = S.K / BK;
    unsigned voffA[2], voffB[2];
#pragma unroll
    for (int i = 0; i < 2; ++i) { int R, C; stage_rc(tid * 16 + i * 8192, R, C); const int Rb = (R & ~31) + perm32(R & 31);
        voffA[i] = (unsigned)(R * S.lda + C) * 2u; voffB[i] = (unsigned)(Rb * S.ldb + C) * 2u; }
    const size_t kstep = (size_t)(BK * 2);
    const size_t hstepA = (size_t)HALF * S.lda * 2, hstepB = (size_t)HALF * S.ldb * 2;
    const unsigned ldsw = (unsigned)wid * 1024u;
    const int aoff = lds_byte(wr * 64 + fr, fq * 8), boff = lds_byte(wc * 32 + fr, fq * 8);
#define PG8_SA(b, h) (((b) * 2 + (h)) * HTB)
#define PG8_SB(b, h) ((4 + (b) * 2 + (h)) * HTB)
#define PG8_STAGE(bufoff, gbase, voff) do { _Pragma("unroll") for (int _i = 0; _i < 2; ++_i) \
        __builtin_amdgcn_global_load_lds((const unsigned*)((const char*)(gbase) + (voff)[_i]), (LDSP unsigned*)(lds + (bufoff) + ldsw + _i * 8192), 16, 0, 0); } while (0)
#define PG8_LDA(dst, b, h) do { _Pragma("unroll") for (int m = 0; m < 4; ++m) _Pragma("unroll") for (int k = 0; k < 2; ++k) dst[m][k] = *(const LDSP bf16x8*)(lds + PG8_SA(b, h) + aoff + m * 2048 + k * 1024); } while (0)
#define PG8_LDB(dst, b, h) do { _Pragma("unroll") for (int n = 0; n < 2; ++n) _Pragma("unroll") for (int k = 0; k < 2; ++k) dst[n][k] = *(const LDSP bf16x8*)(lds + PG8_SB(b, h) + boff + n * 2048 + k * 1024); } while (0)
#define PG8_MMA(ai, bj, At, Bt) do { __builtin_amdgcn_s_setprio(1); _Pragma("unroll") for (int m = 0; m < 4; ++m) _Pragma("unroll") for (int n = 0; n < 2; ++n) _Pragma("unroll") for (int k = 0; k < 2; ++k) \
        acc[ai][bj][m][n] = __builtin_amdgcn_mfma_f32_16x16x32_bf16(Bt[n][k], At[m][k], acc[ai][bj][m][n], 0, 0, 0); __builtin_amdgcn_s_setprio(0); } while (0)
#define PG8_WAIT_V(n) asm volatile("s_waitcnt vmcnt(" #n ")" ::: "memory")
#define PG8_WAIT_L(n) asm volatile("s_waitcnt lgkmcnt(" #n ")" ::: "memory")
#define PG8_BAR __builtin_amdgcn_s_barrier()
#define PG8_SCHED __builtin_amdgcn_sched_barrier(0)
    Unit cur, nxt; int ui = 0;
    if (!S.next(0, cur)) return;
    f32x4 acc[2][2][4][2];
#pragma unroll
    for (int a = 0; a < 2; ++a)
#pragma unroll
        for (int b = 0; b < 2; ++b)
#pragma unroll
            for (int m = 0; m < 4; ++m)
#pragma unroll
                for (int n = 0; n < 2; ++n) acc[a][b][m][n] = (f32x4){0.f, 0.f, 0.f, 0.f};
    bf16x8 At[4][2], B0[2][2], B1[2][2];
    const char* cA = S.aptr(cur); const char* cB = S.bptr(cur);
    PG8_STAGE(PG8_SB(0, 0), cB, voffB); PG8_STAGE(PG8_SB(0, 1), cB + hstepB, voffB); PG8_STAGE(PG8_SA(0, 0), cA, voffA); PG8_STAGE(PG8_SA(0, 1), cA + hstepA, voffA);
    if (wr == 1) PG8_BAR;
    PG8_WAIT_V(2); PG8_BAR;
    PG8_STAGE(PG8_SB(1, 0), cB + kstep, voffB); PG8_STAGE(PG8_SA(1, 0), cA + kstep, voffA); PG8_STAGE(PG8_SB(1, 1), cB + hstepB + kstep, voffB);
    PG8_WAIT_V(6); PG8_BAR;
    for (;;) {
        const bool has_next = S.next(ui + 1, nxt);
        const char* nA = has_next ? S.aptr(nxt) : cA; const char* nB = has_next ? S.bptr(nxt) : cB;
        for (int t = 0; t < nt; t += 2) {
            const bool last = (t == nt - 2);
            const char* a1 = cA + (size_t)(t + 1) * kstep;
            const char* a2 = last ? nA : cA + (size_t)(t + 2) * kstep; const char* b2 = last ? nB : cB + (size_t)(t + 2) * kstep;
            const char* a3 = a2 + kstep; const char* b3 = b2 + kstep;
            PG8_LDB(B0, 0, 0); PG8_LDB(B1, 0, 1); PG8_SCHED; PG8_LDA(At, 0, 0); PG8_STAGE(PG8_SA(1, 1), a1 + hstepA, voffA);
            PG8_WAIT_V(8); PG8_WAIT_L(0); PG8_BAR; PG8_MMA(0, 0, At, B0); PG8_MMA(0, 1, At, B1); PG8_BAR; PG8_SCHED;
            PG8_LDA(At, 0, 1); PG8_STAGE(PG8_SB(0, 0), b2, voffB); PG8_STAGE(PG8_SB(0, 1), b2 + hstepB, voffB); PG8_STAGE(PG8_SA(0, 0), a2, voffA);
            PG8_WAIT_V(8); PG8_WAIT_L(0); PG8_BAR; PG8_MMA(1, 0, At, B0); PG8_MMA(1, 1, At, B1); PG8_BAR; PG8_SCHED;
            PG8_LDB(B0, 1, 0); PG8_LDB(B1, 1, 1); PG8_SCHED; PG8_LDA(At, 1, 0); PG8_STAGE(PG8_SA(0, 1), a2 + hstepA, voffA);
            PG8_WAIT_V(8); PG8_WAIT_L(0); PG8_BAR; PG8_MMA(0, 0, At, B0); PG8_MMA(0, 1, At, B1); PG8_BAR; PG8_SCHED;
            PG8_LDA(At, 1, 1); PG8_STAGE(PG8_SB(1, 0), b3, voffB); PG8_STAGE(PG8_SB(1, 1), b3 + hstepB, voffB); PG8_STAGE(PG8_SA(1, 0), a3, voffA);
            PG8_WAIT_V(8); PG8_WAIT_L(0); PG8_BAR; PG8_MMA(1, 0, At, B0); PG8_MMA(1, 1, At, B1); PG8_BAR; PG8_SCHED;
        }
        if (wr == 0) PG8_BAR;
        E(acc, cur, wr, wc, fr, fq);
        if (!has_next) break;
#pragma unroll
        for (int a = 0; a < 2; ++a)
#pragma unroll
            for (int b = 0; b < 2; ++b)
#pragma unroll
                for (int m = 0; m < 4; ++m)
#pragma unroll
                    for (int n = 0; n < 2; ++n) acc[a][b][m][n] = (f32x4){0.f, 0.f, 0.f, 0.f};
        cur = nxt; cA = nA; cB = nB; ++ui;
        if (wr == 1) PG8_BAR;
    }
    PG8_WAIT_V(0);
    PG8_BAR;
#undef PG8_SA
#undef PG8_SB
#undef PG8_STAGE
#undef PG8_LDA
#undef PG8_LDB
#undef PG8_MMA
#undef PG8_WAIT_V
#undef PG8_WAIT_L
#undef PG8_BAR
#undef PG8_SCHED
}
}

struct EpiProj {
    const Params* P;
    __device__ __forceinline__ void operator()(f32x4 (&acc)[2][2][4][2], const pg8::Unit& u, int wr, int wc, int fr, int fq) const {
        unsigned char* ws = P->ws;
        const int H = 4 * u.pn + wc;
        if (H > 76) return;
        const float* rs1 = (const float*)(ws + OFF_RS1);
        int kind; bf16_t* dst = nullptr; int pitch = 0, cb = 0; const float* gain = nullptr; float oscale = 1.f; bool slab = false; int sg = 0;
        if (H < 8)        { kind = 1; dst = (bf16_t*)(ws + OFF_R1);            pitch = 512; cb = H * 64;        gain = P->in[I_AQG]; oscale = QSCALE; }
        else if (H < 16)  { kind = 1; dst = (bf16_t*)(ws + OFF_R1 + 32 * MiB); pitch = 512; cb = (H - 8) * 64;  gain = P->in[I_AKG]; }
        else if (H < 24)  { kind = 0; dst = (bf16_t*)(ws + OFF_R1 + 64 * MiB); pitch = 512; cb = (H - 16) * 64; }
        else if (H < 32)  { kind = 1; dst = (bf16_t*)(ws + OFF_R1 + 96 * MiB); pitch = 512; cb = (H - 24) * 64; gain = P->in[I_BQG]; oscale = QSCALE; }
        else if (H < 34)  { kind = 0; dst = (bf16_t*)(ws + OFF_R2);            slab = true; sg = H - 32; }
        else if (H < 36)  { kind = 0; dst = (bf16_t*)(ws + OFF_R2 + 8 * MiB);  slab = true; sg = H - 34; }
        else if (H < 38)  { kind = 1; dst = (bf16_t*)(ws + OFF_R2 + 16 * MiB); pitch = 128; cb = (H - 36) * 64; gain = P->in[I_BKSG]; }
        else if (H < 40)  { kind = 0; dst = (bf16_t*)(ws + OFF_R2 + 24 * MiB); pitch = 128; cb = (H - 38) * 64; }
        else if (H < 42)  { kind = 1; dst = (bf16_t*)(ws + OFF_R2 + 32 * MiB); pitch = 128; cb = (H - 40) * 64; gain = P->in[I_BKWG]; }
        else if (H < 44)  { kind = 0; dst = (bf16_t*)(ws + OFF_R2 + 40 * MiB); pitch = 128; cb = (H - 42) * 64; }
        else if (H < 76)  { kind = 2; dst = (bf16_t*)(ws + OFF_R3);            pitch = 2048; cb = (H - 44) * 64; }
        else              { kind = 3; }
        f32x4 invrev[2] = {{0.f, 0.f, 0.f, 0.f}, {0.f, 0.f, 0.f, 0.f}};
        if (kind == 1) { invrev[0] = *(const f32x4*)((const float*)(ws + OFF_ROPE_C)); invrev[1] = *(const f32x4*)((const float*)(ws + OFF_ROPE_C) + 4); }
        float rsr[2][4];
#pragma unroll
        for (int ai = 0; ai < 2; ++ai)
#pragma unroll
            for (int m = 0; m < 4; ++m) rsr[ai][m] = rs1[u.pm * 256 + ai * 128 + wr * 64 + m * 16 + fr];
        f32x4 gv[2][2];
        if (kind == 1 || kind == 2) {
            const float* gp = (kind == 1) ? gain : P->in[I_BMERGE] + cb;
#pragma unroll
            for (int bj = 0; bj < 2; ++bj)
#pragma unroll
                for (int n = 0; n < 2; ++n) gv[bj][n] = *(const f32x4*)(gp + 32 * bj + 8 * fq + 4 * n);
        }
        const bool ksum = (H >= 8 && H < 16);
        f32x4 cs[2][2];
#pragma unroll
        for (int bj = 0; bj < 2; ++bj)
#pragma unroll
            for (int n = 0; n < 2; ++n) cs[bj][n] = (f32x4){0.f, 0.f, 0.f, 0.f};
#pragma unroll
        for (int ai = 0; ai < 2; ++ai)
#pragma unroll
            for (int m = 0; m < 4; ++m) {
                const int row = u.pm * 256 + ai * 128 + wr * 64 + m * 16 + fr;
                const float rs = rsr[ai][m];
                f32x4 v[2][2];
#pragma unroll
                for (int bj = 0; bj < 2; ++bj)
#pragma unroll
                    for (int n = 0; n < 2; ++n) v[bj][n] = acc[ai][bj][m][n] * rs;
                if (kind == 1) {
                    float ss = 0.f;
#pragma unroll
                    for (int bj = 0; bj < 2; ++bj)
#pragma unroll
                        for (int n = 0; n < 2; ++n) ss += (v[bj][n][0] * v[bj][n][0] + v[bj][n][1] * v[bj][n][1]) + (v[bj][n][2] * v[bj][n][2] + v[bj][n][3] * v[bj][n][3]);
                    ss += __shfl_xor(ss, 16); ss += __shfl_xor(ss, 32);
                    const float r = oscale / sqrtf(ss * (1.0f / 64.0f) + NORM_EPS);
#pragma unroll
                    for (int bj = 0; bj < 2; ++bj)
#pragma unroll
                        for (int n = 0; n < 2; ++n) v[bj][n] = v[bj][n] * gv[bj][n] * r;
                    const float posf = (float)(row & (SEQ - 1));
                    const float sgn = (fq == 0) ? -1.f : 1.f;
#pragma unroll
                    for (int n = 0; n < 2; ++n) {
                        const f32x4 me = v[0][n]; f32x4 ot, ro;
#pragma unroll
                        for (int i = 0; i < 4; ++i) ot[i] = __shfl_xor(me[i], 16);
#pragma unroll
                        for (int i = 0; i < 4; ++i) { const float rev = __builtin_amdgcn_fractf(posf * invrev[n][i]); ro[i] = me[i] * __builtin_amdgcn_cosf(rev) + sgn * ot[i] * __builtin_amdgcn_sinf(rev); }
                        if (fq < 2) v[0][n] = ro;
                    }
                    if (ksum) {
#pragma unroll
                        for (int bj = 0; bj < 2; ++bj)
#pragma unroll
                            for (int n = 0; n < 2; ++n) cs[bj][n] += v[bj][n];
                    }
                } else if (kind == 2) {
#pragma unroll
                    for (int bj = 0; bj < 2; ++bj)
#pragma unroll
                        for (int n = 0; n < 2; ++n)
#pragma unroll
                            for (int i = 0; i < 4; ++i) v[bj][n][i] = sigmoidf_(v[bj][n][i] + gv[bj][n][i]);
                }
                if (kind == 3) {
                    float* bg = (float*)(ws + OFF_BGATE) + (size_t)row * 24;
                    if (fq < 3) {
#pragma unroll
                        for (int n = 0; n < 2; ++n) { f32x4 o; o.x = sigmoidf_(v[0][n][0]); o.y = sigmoidf_(v[0][n][1]); o.z = sigmoidf_(v[0][n][2]); o.w = sigmoidf_(v[0][n][3]); *(f32x4*)(bg + 8 * fq + 4 * n) = o; }
                    }
                } else {
                    bf16_t* rp;
                    if (slab) { const int b = row >> 12, s = row & (SEQ - 1); rp = dst + ((size_t)((b * 2 + sg) * SEQ + s)) * 64 + 8 * fq; }
                    else rp = dst + (size_t)row * pitch + cb + 8 * fq;
#pragma unroll
                    for (int bj = 0; bj < 2; ++bj) {
                        u32x4 w; w.x = pk2(v[bj][0][0], v[bj][0][1]); w.y = pk2(v[bj][0][2], v[bj][0][3]); w.z = pk2(v[bj][1][0], v[bj][1][1]); w.w = pk2(v[bj][1][2], v[bj][1][3]);
                        *(u32x4*)(rp + 32 * bj) = w;
                    }
                }
            }
        if (ksum) {
            float* km = (float*)(ws + OFF_KMEAN) + (size_t)(((u.pm >> 4) * 8 + (H - 8)) * 16 + (u.pm & 15)) * 64;
#pragma unroll
            for (int bj = 0; bj < 2; ++bj)
#pragma unroll
                for (int n = 0; n < 2; ++n)
#pragma unroll
                    for (int i = 0; i < 4; ++i) {
                        float t = cs[bj][n][i];
                        t += __shfl_xor(t, 1); t += __shfl_xor(t, 2); t += __shfl_xor(t, 4); t += __shfl_xor(t, 8);
                        if (fr == 0) atomicAdd(km + 32 * bj + 8 * fq + 4 * n + i, t);
                    }
        }
    }
};
__device__ __forceinline__ void phase_proj(const Params& P, LDSP unsigned char* lds, int vcu, int G) {
    pg8::Sched S; S.A0 = S.A1 = (const bf16_t*)(P.ws + OFF_R0); S.B0 = S.B1 = (const bf16_t*)(P.ws + OFF_WIN_T);
    S.lda = DM; S.ldb = DM; S.K = DM; S.nM = T / 256; S.nN = NPROJ / 256; S.NZ = 1; S.G = G; S.c = blockIdx.x;
    EpiProj E{&P};
    pg8::gemm_phase(lds, S, E);
}

constexpr size_t OFF_CPART = OFF_EXPERTS;
constexpr size_t CPART_STRIDE = (size_t)2 * 4096 * 256;
__device__ __forceinline__ void phase_cmp1(const Params& P, LDSP unsigned char* lds, int vcu, int G) {
    unsigned char* ws = P.ws;
    const int tid = opaque_tid(), lane = tid & 63, wid = tid >> 6, wm = wid >> 1, wn = wid & 1, fr = lane & 15, fq = lane >> 4;
    for (int item = vcu; item < 256; item += G) {
        const int kc = item & 3, tn = (item >> 2) & 1, tm = (item >> 3) & 15, kv = item >> 7;
        const bf16_t* A = (const bf16_t*)(ws + OFF_R2 + (size_t)kv * 8 * MiB) + (size_t)tm * SEQ * 64 + kc * 512;
        const bf16_t* Bt = (const bf16_t*)(ws + (kv ? OFF_W1V_T : OFF_W1K_T)) + (size_t)tn * G_BN * 2048 + kc * 512;
        float* part = (float*)(ws + OFF_CPART) + (size_t)kc * CPART_STRIDE + (size_t)kv * 4096 * 256;
        f32x4 acc[4][4];
        zero_acc(acc);
        gemm_kloop(acc, A, 1024, Bt, 2048, 512, lds);
        const int row0 = tm * 256 + wm * 64 + fr, col0 = tn * 128 + wn * 64 + 4 * fq;
#pragma unroll
        for (int m = 0; m < 4; ++m)
#pragma unroll
            for (int n = 0; n < 4; ++n) *(f32x4*)(part + (size_t)(row0 + m * 16) * 256 + col0 + n * 16) = acc[m][n];
    }
}

__device__ __forceinline__ u32x4 load_hid8(const float* part, const float* posb, size_t rowoff, int k) {
    f32x4 a = *(const f32x4*)(posb + k), b = *(const f32x4*)(posb + k + 4);
#pragma unroll
    for (int c = 0; c < 4; ++c) { a += *(const f32x4*)(part + c * CPART_STRIDE + rowoff + k); b += *(const f32x4*)(part + c * CPART_STRIDE + rowoff + k + 4); }
    u32x4 o; o.x = pk2(gelu_tanh(a.x), gelu_tanh(a.y)); o.y = pk2(gelu_tanh(a.z), gelu_tanh(a.w)); o.z = pk2(gelu_tanh(b.x), gelu_tanh(b.y)); o.w = pk2(gelu_tanh(b.z), gelu_tanh(b.w));
    return o;
}
__device__ __forceinline__ void phase_cmp2(const Params& P, LDSP unsigned char* lds, int vcu, int G) {
    unsigned char* ws = P.ws;
    const int tid = opaque_tid(), lane = tid & 63, wid = tid >> 6, wm = wid >> 1, wn = wid & 1, fr = lane & 15, fq = lane >> 4;
    const int lrow = tid >> 3, lch = tid & 7;
    for (int item = vcu; item < 32; item += G) {
        const int kv = item >> 4, tm = item & 15;
        const float* part = (const float*)(ws + OFF_CPART) + (size_t)kv * 4096 * 256 + (size_t)tm * 256 * 256;
        const float* posb = (const float*)(ws + OFF_POSB) + kv * 256;
        const bf16_t* Bt = (const bf16_t*)(ws + (kv ? OFF_W2V_T : OFF_W2K_T));
        const float* b2 = P.in[kv ? I_CVB2 : I_CKB2];
        bf16_t* dst = (bf16_t*)(ws + (kv ? OFF_VC : OFF_KC)) + (size_t)tm * 256 * 64;
        f32x4 acc[4][4];
        zero_acc(acc);
        {
            const bf16_t* gb = Bt + (size_t)lrow * 256 + lch * 8;
            u32x4 ra[4], rb[2];
#pragma unroll
            for (int p = 0; p < 4; ++p) ra[p] = load_hid8(part, posb, (size_t)(lrow + 64 * p) * 256, lch * 8);
#pragma unroll
            for (int p = 0; p < 2; ++p) rb[p] = *(const u32x4*)(gb + (size_t)(64 * p) * 256);
            __syncthreads();
#pragma unroll
            for (int p = 0; p < 4; ++p) *(LDSP u32x4*)(lds + swz_off(lrow + 64 * p, lch)) = ra[p];
#pragma unroll
            for (int p = 0; p < 2; ++p) *(LDSP u32x4*)(lds + G_ABYTES + swz_off(lrow + 64 * p, lch)) = rb[p];
            __syncthreads();
#pragma unroll 1
            for (int kt = 0; kt < 4; ++kt) {
                LDSP unsigned char* cur = lds + (kt & 1) * G_STAGE;
                LDSP unsigned char* nxt = lds + ((kt + 1) & 1) * G_STAGE;
                if (kt + 1 < 4) {
#pragma unroll
                    for (int p = 0; p < 4; ++p) ra[p] = load_hid8(part, posb, (size_t)(lrow + 64 * p) * 256, (kt + 1) * G_BK + lch * 8);
#pragma unroll
                    for (int p = 0; p < 2; ++p) rb[p] = *(const u32x4*)(gb + (size_t)(64 * p) * 256 + (kt + 1) * G_BK);
                }
#pragma unroll
                for (int ks = 0; ks < 2; ++ks) {
                    bf16x8 af[4], bfr[4];
#pragma unroll
                    for (int m = 0; m < 4; ++m) af[m] = *(const LDSP bf16x8*)(cur + swz_off(wm * 64 + m * 16 + fr, ks * 4 + fq));
#pragma unroll
                    for (int n = 0; n < 4; ++n) bfr[n] = *(const LDSP bf16x8*)(cur + G_ABYTES + swz_off(wn * 64 + n * 16 + fr, ks * 4 + fq));
#pragma unroll
                    for (int m = 0; m < 4; ++m)
#pragma unroll
                        for (int n = 0; n < 4; ++n) acc[m][n] = __builtin_amdgcn_mfma_f32_16x16x32_bf16(bfr[n], af[m], acc[m][n], 0, 0, 0);
                }
                if (kt + 1 < 4) {
#pragma unroll
                    for (int p = 0; p < 4; ++p) *(LDSP u32x4*)(nxt + swz_off(lrow + 64 * p, lch)) = ra[p];
#pragma unroll
                    for (int p = 0; p < 2; ++p) *(LDSP u32x4*)(nxt + G_ABYTES + swz_off(lrow + 64 * p, lch)) = rb[p];
                }
                __syncthreads();
            }
        }
        if (wn == 0) {
            float gv[4][4];
#pragma unroll
            for (int n = 0; n < 4; ++n) {
                const f32x4 bb = *(const f32x4*)(b2 + n * 16 + 4 * fq);
                const f32x4 g4 = kv ? (f32x4){1.f, 1.f, 1.f, 1.f} : *(const f32x4*)(P.in[I_BKCG] + n * 16 + 4 * fq);
                gv[n][0] = g4.x; gv[n][1] = g4.y; gv[n][2] = g4.z; gv[n][3] = g4.w;
#pragma unroll
                for (int m = 0; m < 4; ++m) acc[m][n] += bb;
            }
#pragma unroll
            for (int m = 0; m < 4; ++m) {
                float r = 1.f;
                if (kv == 0) {
                    float ss = 0.f;
#pragma unroll
                    for (int n = 0; n < 4; ++n) ss += (acc[m][n][0] * acc[m][n][0] + acc[m][n][1] * acc[m][n][1]) + (acc[m][n][2] * acc[m][n][2] + acc[m][n][3] * acc[m][n][3]);
                    ss += __shfl_xor(ss, 16); ss += __shfl_xor(ss, 32);
                    r = 1.0f / sqrtf(ss * (1.0f / 64.0f) + NORM_EPS);
                }
                const int row = wm * 64 + m * 16 + fr;
                if (row == 255) r = 0.f;
#pragma unroll
                for (int n = 0; n < 4; ++n) {
                    f32x4 o = acc[m][n];
                    if (row == 255) o = (f32x4){0.f, 0.f, 0.f, 0.f};
                    u32x2 w; w.x = pk2(o[0] * r * gv[n][0], o[1] * r * gv[n][1]); w.y = pk2(o[2] * r * gv[n][2], o[3] * r * gv[n][3]);
                    *(u32x2*)(dst + (size_t)row * 64 + n * 16 + 4 * fq) = w;
                }
            }
        }
    }
}

__device__ __forceinline__ void phase_cmp(const Params& P, LDSP unsigned char* lds, int vcu, int G) {
    unsigned char* ws = P.ws;
    const int tid = opaque_tid(), lane = tid & 63, r32 = lane & 31, hi = lane >> 5;
    const int wu = __builtin_amdgcn_readfirstlane(tid >> 6);
    for (int item = vcu; item < 256; item += G) {
        const int kv = item >> 7, bg = (item >> 3) & 15, rb = item & 7;
        const bf16_t* A = (const bf16_t*)(ws + OFF_R2 + (size_t)kv * 8 * MiB) + ((size_t)bg * SEQ + 512 * rb) * 64;
        const bf16_t* W1 = (const bf16_t*)(ws + (kv ? OFF_W1V_T : OFF_W1K_T)) + (size_t)(32 * wu + r32) * 2048 + 32 * hi;
        __syncthreads();
        for (int pc = wu; pc < 66; pc += 8) {
            const int g16 = pc >> 1, h8 = pc & 1, tau = 16 * g16 + 8 * h8 + (lane >> 3), c = (lane & 7) ^ ((g16 >> 1) & 7);
            __builtin_amdgcn_global_load_lds((const unsigned*)(A + (size_t)tau * 64 + c * 8), (LDSP unsigned*)(lds + (17 * g16 + 8 * h8) * 128), 16, 0, 0);
        }
        u32x4 Bq[8][4];
#pragma unroll
        for (int j = 0; j < 8; ++j)
#pragma unroll
            for (int i = 0; i < 4; ++i) Bq[j][i] = *(const u32x4*)(W1 + 64 * j + 8 * i);
        const int abase = 17 * r32 * 128;
        int aoff[2][4];
#pragma unroll
        for (int jh = 0; jh < 2; ++jh)
#pragma unroll
            for (int i = 0; i < 4; ++i) aoff[jh][i] = abase + ((((4 * hi + i) ^ (((r32 + jh) >> 1) & 7))) << 4);
        f32x16 acc;
#pragma unroll
        for (int r = 0; r < 16; ++r) acc[r] = 0.f;
        asm volatile("s_waitcnt vmcnt(32)" ::: "memory");
        __syncthreads();
#pragma unroll
        for (int j = 0; j < 32; ++j) {
#pragma unroll
            for (int i = 0; i < 4; ++i) {
                const bf16x8 xf = *(const LDSP bf16x8*)(lds + aoff[j >> 4][i] + (j + (j >> 4)) * 128);
                acc = __builtin_amdgcn_mfma_f32_32x32x16_bf16(__builtin_bit_cast(bf16x8, Bq[j & 7][i]), xf, acc, 0, 0, 0);
            }
            if (j + 8 < 32) {
#pragma unroll
                for (int i = 0; i < 4; ++i) Bq[j & 7][i] = *(const u32x4*)(W1 + 64 * (j + 8) + 8 * i);
            }
            __builtin_amdgcn_sched_barrier(0);
        }
        const float* posb = (const float*)(ws + OFF_POSB) + kv * 256 + 32 * wu + 4 * hi;
        u32x4 pw[2];
#pragma unroll
        for (int q = 0; q < 4; ++q) {
            const f32x4 pb = *(const f32x4*)(posb + 8 * q);
            const float h0 = gelu_tanh(acc[4 * q] + pb.x), h1 = gelu_tanh(acc[4 * q + 1] + pb.y), h2 = gelu_tanh(acc[4 * q + 2] + pb.z), h3 = gelu_tanh(acc[4 * q + 3] + pb.w);
            pw[q >> 1][(q & 1) * 2] = pk2(h0, h1); pw[q >> 1][(q & 1) * 2 + 1] = pk2(h2, h3);
        }
        const bf16_t* W2 = (const bf16_t*)(ws + (kv ? OFF_W2V_T : OFF_W2K_T)) + (size_t)r32 * 256 + 32 * wu + 4 * hi;
        f32x16 o2[2];
#pragma unroll
        for (int mb = 0; mb < 2; ++mb) {
#pragma unroll
            for (int r = 0; r < 16; ++r) o2[mb][r] = 0.f;
#pragma unroll
            for (int s2 = 0; s2 < 2; ++s2) {
                const u32x2 lo = *(const u32x2*)(W2 + (size_t)mb * 32 * 256 + 16 * s2), hh = *(const u32x2*)(W2 + (size_t)mb * 32 * 256 + 16 * s2 + 8);
                const u32x4 a2 = {lo.x, lo.y, hh.x, hh.y};
                o2[mb] = __builtin_amdgcn_mfma_f32_32x32x16_bf16(__builtin_bit_cast(bf16x8, a2), __builtin_bit_cast(bf16x8, pw[s2]), o2[mb], 0, 0, 0);
            }
        }
        __syncthreads();
        {
            LDSP float* part = (LDSP float*)lds + (size_t)(wu * 32 + r32) * 68 + 4 * hi;
#pragma unroll
            for (int mb = 0; mb < 2; ++mb)
#pragma unroll
                for (int q = 0; q < 4; ++q) *(LDSP f32x4*)(part + 32 * mb + 8 * q) = (f32x4){o2[mb][4 * q], o2[mb][4 * q + 1], o2[mb][4 * q + 2], o2[mb][4 * q + 3]};
        }
        __syncthreads();
        {
            const int row = tid >> 4, dq = tid & 15;
            f32x4 v = *(const f32x4*)(P.in[kv ? I_CVB2 : I_CKB2] + 4 * dq);
#pragma unroll
            for (int w = 0; w < 8; ++w) v += *(const LDSP f32x4*)((LDSP float*)lds + (size_t)(w * 32 + row) * 68 + 4 * dq);
            float rr = 1.f; f32x4 g4 = {1.f, 1.f, 1.f, 1.f};
            if (kv == 0) {
                float ss = (v.x * v.x + v.y * v.y) + (v.z * v.z + v.w * v.w);
                ss += __shfl_xor(ss, 1); ss += __shfl_xor(ss, 2); ss += __shfl_xor(ss, 4); ss += __shfl_xor(ss, 8);
                rr = 1.0f / sqrtf(ss * (1.0f / 64.0f) + NORM_EPS);
                g4 = *(const f32x4*)(P.in[I_BKCG] + 4 * dq);
            }
            const int grow = 32 * rb + row;
            u32x2 w2; w2.x = pk2(v.x * rr * g4.x, v.y * rr * g4.y); w2.y = pk2(v.z * rr * g4.z, v.w * rr * g4.w);
            if (grow == 255) w2 = (u32x2){0u, 0u};
            *(u32x2*)((bf16_t*)(ws + (kv ? OFF_VC : OFF_KC)) + ((size_t)bg * 256 + grow) * 64 + 4 * dq) = w2;
        }
    }
    __syncthreads();
}

constexpr int A_GS = 65536, A_ES = 81920, A_Y = 65536, A_MISC = 131072;
typedef short v4i16_t __attribute__((ext_vector_type(4)));
struct ASt { f32x16 o0, o1; float m, l; };
struct KVStage { u32x4 k, v; };
__device__ __forceinline__ void kv_load(KVStage& s, const bf16_t* Kg, const bf16_t* Vg, size_t pitch, int tid) {
    const int key = tid >> 3, ch = tid & 7;
    s.k = *(const u32x4*)(Kg + (size_t)key * pitch + ch * 8);
    s.v = *(const u32x4*)(Vg + (size_t)key * pitch + ch * 8);
}
__device__ __forceinline__ void kv_store(const KVStage& s, LDSP unsigned char* buf, int tid) {
    const int key = tid >> 3, ch = tid & 7;
    *(LDSP u32x4*)(buf + swz_off(key, ch)) = s.k;
    *(LDSP u32x4*)(buf + 8192 + ((ch >> 2) * 4 + (key >> 4)) * 1024 + (key & 15) * 64 + (ch & 3) * 16) = s.v;
}
__device__ __forceinline__ void kv_dma(const bf16_t* Kg, const bf16_t* Vg, size_t pitch, LDSP unsigned char* buf, int wid, int lane) {
    const int row = wid * 8 + (lane >> 3), chunk = (lane & 7) ^ ((row >> 1) & 7);
    __builtin_amdgcn_global_load_lds((const unsigned*)(Kg + (size_t)row * pitch + chunk * 8), (LDSP unsigned*)(buf + wid * 1024), 16, 0, 0);
    const int vrow = (wid & 3) * 16 + (lane >> 2), vcol = (wid >> 2) * 32 + (lane & 3) * 8;
    __builtin_amdgcn_global_load_lds((const unsigned*)(Vg + (size_t)vrow * pitch + vcol), (LDSP unsigned*)(buf + 8192 + wid * 1024), 16, 0, 0);
}
__device__ __forceinline__ float swap32f(float v) { return __shfl_xor(v, 32); }
__device__ __forceinline__ void ast_reset(ASt& st) {
#pragma unroll
    for (int r = 0; r < 16; ++r) { st.o0[r] = 0.f; st.o1[r] = 0.f; }
    st.m = 0.f; st.l = 0.f;
}
constexpr float ATT_THR = 8.0f;
template <int MODE>
__device__ __forceinline__ void attn_tile(ASt& st, const bf16x8 (&qf)[4], LDSP const unsigned char* kt, int lane, bool rowoff, int kl, int kh, bool need_mask,
                                          float linv, LDSP float* gs, LDSP float* es, int jbase, int ql) {
    const int r32 = lane & 31, hi = lane >> 5;
    const float cin = rowoff ? -INFINITY : -st.m;
    f32x16 p0, p1;
#pragma unroll
    for (int r = 0; r < 16; ++r) { p0[r] = cin; p1[r] = cin; }
#pragma unroll
    for (int d0 = 0; d0 < 4; ++d0) {
        const bf16x8 k0f = *(const LDSP bf16x8*)(kt + swz_off(r32, 2 * d0 + hi));
        const bf16x8 k1f = *(const LDSP bf16x8*)(kt + swz_off(r32 + 32, 2 * d0 + hi));
        p0 = __builtin_amdgcn_mfma_f32_32x32x16_bf16(k0f, qf[d0], p0, 0, 0, 0);
        p1 = __builtin_amdgcn_mfma_f32_32x32x16_bf16(k1f, qf[d0], p1, 0, 0, 0);
    }
    if (need_mask) {
        const int kl2 = kl - 4 * hi, kh2 = kh - 4 * hi;
#pragma unroll
        for (int r = 0; r < 16; ++r) {
            const int c = (r & 3) + 8 * (r >> 2);
            const bool v0 = c >= kl2 && c <= kh2, v1 = (c + 32) >= kl2 && (c + 32) <= kh2;
            p0[r] = v0 ? p0[r] : -INFINITY; p1[r] = v1 ? p1[r] : -INFINITY;
        }
    }
    if (MODE != 2) {
        float mx = fmaxf(fmaxf(p0[0], p1[0]), fmaxf(p0[1], p1[1]));
#pragma unroll
        for (int r = 2; r < 16; r += 2) mx = fmaxf(fmaxf(mx, fmaxf(p0[r], p1[r])), fmaxf(p0[r + 1], p1[r + 1]));
        mx = fmaxf(mx, swap32f(mx));
        if (__any(mx > ATT_THR)) {
            const float dl = (mx > ATT_THR) ? mx : 0.f;
            const float alpha = __builtin_amdgcn_exp2f(-dl);
            st.m += dl; st.l *= alpha;
#pragma unroll
            for (int r = 0; r < 16; ++r) { p0[r] -= dl; p1[r] -= dl; }
            if (MODE == 0) {
#pragma unroll
                for (int r = 0; r < 16; ++r) { st.o0[r] *= alpha; st.o1[r] *= alpha; }
            }
        }
    }
#pragma unroll
    for (int r = 0; r < 16; ++r) { p0[r] = __builtin_amdgcn_exp2f(p0[r]); p1[r] = __builtin_amdgcn_exp2f(p1[r]); }
    if (MODE != 2) {
        const f32x16 t = p0 + p1;
        st.l += ((t[0] + t[1]) + (t[2] + t[3])) + ((t[4] + t[5]) + (t[6] + t[7])) + (((t[8] + t[9]) + (t[10] + t[11])) + ((t[12] + t[13]) + (t[14] + t[15])));
    } else {
#pragma unroll
        for (int r = 0; r < 16; ++r) { p0[r] *= linv; p1[r] *= linv; }
#pragma unroll
        for (int qd = 0; qd < 4; ++qd) {
            float g0 = (p0[4 * qd] + p0[4 * qd + 1]) + (p0[4 * qd + 2] + p0[4 * qd + 3]), e0 = p0[4 * qd + 3];
            float g1 = (p1[4 * qd] + p1[4 * qd + 1]) + (p1[4 * qd + 2] + p1[4 * qd + 3]), e1 = p1[4 * qd + 3];
            g0 += __shfl_xor(g0, 1); g0 += __shfl_xor(g0, 2); e0 += __shfl_xor(e0, 1); e0 += __shfl_xor(e0, 2);
            g1 += __shfl_xor(g1, 1); g1 += __shfl_xor(g1, 2); e1 += __shfl_xor(e1, 1); e1 += __shfl_xor(e1, 2);
            if ((r32 & 3) == 0) {
                const int j = jbase + 2 * qd + hi;
                gs[ql * 64 + j] = g0; es[ql * 64 + j] = e0; gs[ql * 64 + j + 8] = g1; es[ql * 64 + j + 8] = e1;
            }
        }
    }
    if (MODE != 1) {
        u32x4 pw[4];
        pw[0] = (u32x4){pk2(p0[0], p0[1]), pk2(p0[2], p0[3]), pk2(p0[4], p0[5]), pk2(p0[6], p0[7])};
        pw[1] = (u32x4){pk2(p0[8], p0[9]), pk2(p0[10], p0[11]), pk2(p0[12], p0[13]), pk2(p0[14], p0[15])};
        pw[2] = (u32x4){pk2(p1[0], p1[1]), pk2(p1[2], p1[3]), pk2(p1[4], p1[5]), pk2(p1[6], p1[7])};
        pw[3] = (u32x4){pk2(p1[8], p1[9]), pk2(p1[10], p1[11]), pk2(p1[12], p1[13]), pk2(p1[14], p1[15])};
        LDSP const unsigned char* vb = kt + 8192 + ((lane >> 4) & 1) * 32 + (lane & 3) * 8 + (4 * hi + ((lane & 15) >> 2)) * 64;
#pragma unroll
        for (int ks = 0; ks < 4; ++ks) {
            const bf16x8 pf = __builtin_bit_cast(bf16x8, pw[ks]);
#pragma unroll
            for (int d0 = 0; d0 < 2; ++d0) {
                const v4i16_t lo = __builtin_amdgcn_ds_read_tr16_b64_v4i16((LDSP v4i16_t*)(vb + (d0 * 4 + ks) * 1024));
                const v4i16_t hh = __builtin_amdgcn_ds_read_tr16_b64_v4i16((LDSP v4i16_t*)(vb + (d0 * 4 + ks) * 1024 + 512));
                const bf16x8 vf = (bf16x8){lo[0], lo[1], lo[2], lo[3], hh[0], hh[1], hh[2], hh[3]};
                if (d0 == 0) st.o0 = __builtin_amdgcn_mfma_f32_32x32x16_bf16(vf, pf, st.o0, 0, 0, 0);
                else         st.o1 = __builtin_amdgcn_mfma_f32_32x32x16_bf16(vf, pf, st.o1, 0, 0, 0);
            }
            if (ks & 1) __builtin_amdgcn_sched_barrier(0);
        }
    }
}

#define KV_LOOP(NT, KPTR, VPTR, PITCH, ...) do { const int nt_ = (NT), np_ = (nt_ + 1) >> 1; KVStage sa_, sb_; __syncthreads(); \
    { const int i = 0; kv_load(sa_, (KPTR), (VPTR), (PITCH), tid); } { const int i = (nt_ > 1) ? 1 : 0; kv_load(sb_, (KPTR), (VPTR), (PITCH), tid); } \
    kv_store(sa_, lds, tid); kv_store(sb_, lds + 16384, tid); __syncthreads(); \
    _Pragma("unroll 1") for (int ip_ = 0; ip_ < np_; ++ip_) { LDSP unsigned char* cur0_ = lds + (ip_ & 1) * 32768; \
        if (ip_ + 1 < np_) { { const int i = 2 * ip_ + 2; kv_load(sa_, (KPTR), (VPTR), (PITCH), tid); } \
                             { const int i = (2 * ip_ + 3 < nt_) ? 2 * ip_ + 3 : 2 * ip_ + 2; kv_load(sb_, (KPTR), (VPTR), (PITCH), tid); } } \
        { const int i = 2 * ip_; LDSP unsigned char* cur = cur0_; __VA_ARGS__ } \
        if (2 * ip_ + 1 < nt_) { const int i = 2 * ip_ + 1; LDSP unsigned char* cur = cur0_ + 16384; __VA_ARGS__ } \
        if (ip_ + 1 < np_) { kv_store(sa_, lds + ((ip_ + 1) & 1) * 32768, tid); kv_store(sb_, lds + ((ip_ + 1) & 1) * 32768 + 16384, tid); } \
        __syncthreads(); } } while (0)

struct TP { bool rowoff, nm; int kl, kh; };
__device__ __forceinline__ void pair_kload(bf16x8 (&kf)[8], LDSP const unsigned char* kt, int r32, int hi) {
#pragma unroll
    for (int d0 = 0; d0 < 4; ++d0) {
        kf[2 * d0]     = *(const LDSP bf16x8*)(kt + swz_off(r32, 2 * d0 + hi));
        kf[2 * d0 + 1] = *(const LDSP bf16x8*)(kt + swz_off(r32 + 32, 2 * d0 + hi));
    }
}
__device__ __forceinline__ void pair_vload(bf16x8 (&vf)[8], LDSP const unsigned char* kt, int lane, int hi) {
    LDSP const unsigned char* vb = kt + 8192 + ((lane >> 4) & 1) * 32 + (lane & 3) * 8 + (4 * hi + ((lane & 15) >> 2)) * 64;
#pragma unroll
    for (int ks = 0; ks < 4; ++ks)
#pragma unroll
        for (int d0 = 0; d0 < 2; ++d0) {
            const v4i16_t lo = __builtin_amdgcn_ds_read_tr16_b64_v4i16((LDSP v4i16_t*)(vb + (d0 * 4 + ks) * 1024));
            const v4i16_t hh = __builtin_amdgcn_ds_read_tr16_b64_v4i16((LDSP v4i16_t*)(vb + (d0 * 4 + ks) * 1024 + 512));
            vf[2 * ks + d0] = (bf16x8){lo[0], lo[1], lo[2], lo[3], hh[0], hh[1], hh[2], hh[3]};
        }
}
#define PAIR_LDS_WAIT() do { asm volatile("s_waitcnt lgkmcnt(0)" ::: "memory"); __builtin_amdgcn_sched_barrier(0); } while (0)
__device__ __forceinline__ void pair_qk(f32x16& p0, f32x16& p1, float cin, const bf16x8 (&qf)[4], const bf16x8 (&kf)[8]) {
    f32x16 c16;
#pragma unroll
    for (int r = 0; r < 16; ++r) c16[r] = cin;
#pragma unroll
    for (int d0 = 0; d0 < 4; ++d0) {
        p0 = __builtin_amdgcn_mfma_f32_32x32x16_bf16(kf[2 * d0], qf[d0], d0 == 0 ? c16 : p0, 0, 0, 0);
        p1 = __builtin_amdgcn_mfma_f32_32x32x16_bf16(kf[2 * d0 + 1], qf[d0], d0 == 0 ? c16 : p1, 0, 0, 0);
    }
}
__device__ __forceinline__ void pair_sm(ASt& st, f32x16& p0, f32x16& p1, u32x4 (&pw)[4], const TP& t, float pend, int hi) {
    if (t.nm) {
        const int kl2 = t.kl - 4 * hi, kh2 = t.kh - 4 * hi;
#pragma unroll
        for (int r = 0; r < 16; ++r) {
            const int c = (r & 3) + 8 * (r >> 2);
            const bool v0 = c >= kl2 && c <= kh2, v1 = (c + 32) >= kl2 && (c + 32) <= kh2;
            p0[r] = v0 ? p0[r] : -INFINITY; p1[r] = v1 ? p1[r] : -INFINITY;
        }
    }
    float mx = fmaxf(fmaxf(p0[0], p1[0]), fmaxf(p0[1], p1[1]));
#pragma unroll
    for (int r = 2; r < 16; r += 2) mx = fmaxf(fmaxf(mx, fmaxf(p0[r], p1[r])), fmaxf(p0[r + 1], p1[r + 1]));
    { const auto rr = __builtin_amdgcn_permlane32_swap(__float_as_uint(mx), __float_as_uint(mx), false, false); mx = fmaxf(__uint_as_float(rr[0]), __uint_as_float(rr[1])); }
    mx -= pend;
    if (__any(mx > ATT_THR || pend != 0.f)) {
        const float dl = (mx > ATT_THR) ? mx : 0.f;
        const float alpha = __builtin_amdgcn_exp2f(-dl), sub = dl + pend;
        st.m += dl; st.l *= alpha;
#pragma unroll
        for (int r = 0; r < 16; ++r) { p0[r] -= sub; p1[r] -= sub; st.o0[r] *= alpha; st.o1[r] *= alpha; }
    }
#pragma unroll
    for (int r = 0; r < 16; ++r) { p0[r] = __builtin_amdgcn_exp2f(p0[r]); p1[r] = __builtin_amdgcn_exp2f(p1[r]); }
    const f32x16 tt = p0 + p1;
    st.l += ((tt[0] + tt[1]) + (tt[2] + tt[3])) + ((tt[4] + tt[5]) + (tt[6] + tt[7])) + (((tt[8] + tt[9]) + (tt[10] + tt[11])) + ((tt[12] + tt[13]) + (tt[14] + tt[15])));
    pw[0] = (u32x4){pk2(p0[0], p0[1]), pk2(p0[2], p0[3]), pk2(p0[4], p0[5]), pk2(p0[6], p0[7])};
    pw[1] = (u32x4){pk2(p0[8], p0[9]), pk2(p0[10], p0[11]), pk2(p0[12], p0[13]), pk2(p0[14], p0[15])};
    pw[2] = (u32x4){pk2(p1[0], p1[1]), pk2(p1[2], p1[3]), pk2(p1[4], p1[5]), pk2(p1[6], p1[7])};
    pw[3] = (u32x4){pk2(p1[8], p1[9]), pk2(p1[10], p1[11]), pk2(p1[12], p1[13]), pk2(p1[14], p1[15])};
}
__device__ __forceinline__ void pair_pv(ASt& st, const u32x4 (&pw)[4], const bf16x8 (&vf)[8]) {
#pragma unroll
    for (int ks = 0; ks < 4; ++ks) {
        const bf16x8 pf = __builtin_bit_cast(bf16x8, pw[ks]);
        st.o0 = __builtin_amdgcn_mfma_f32_32x32x16_bf16(vf[2 * ks], pf, st.o0, 0, 0, 0);
        st.o1 = __builtin_amdgcn_mfma_f32_32x32x16_bf16(vf[2 * ks + 1], pf, st.o1, 0, 0, 0);
    }
}
__device__ __forceinline__ void attn_pair(ASt& st, const bf16x8 (&qf)[4], LDSP const unsigned char* ka, LDSP const unsigned char* kb, int lane, const TP& ta, const TP& tb) {
    const int r32 = lane & 31, hi = lane >> 5;
    const float m0 = st.m;
    f32x16 a0, a1, b0, b1; u32x4 pwa[4], pwb[4];
    bf16x8 kfa[8], kfb[8], vf[8];
    pair_kload(kfa, ka, r32, hi); pair_kload(kfb, kb, r32, hi);
    PAIR_LDS_WAIT();
    pair_qk(a0, a1, ta.rowoff ? -INFINITY : -m0, qf, kfa);
    pair_qk(b0, b1, tb.rowoff ? -INFINITY : -m0, qf, kfb);
    pair_vload(vf, ka, lane, hi);
    __builtin_amdgcn_sched_barrier(0);
    pair_sm(st, a0, a1, pwa, ta, 0.f, hi);
    PAIR_LDS_WAIT();
    pair_pv(st, pwa, vf);
    __builtin_amdgcn_sched_barrier(0);
    pair_vload(vf, kb, lane, hi);
    __builtin_amdgcn_sched_barrier(0);
    pair_sm(st, b0, b1, pwb, tb, st.m - m0, hi);
    PAIR_LDS_WAIT();
    pair_pv(st, pwb, vf);
}
template <int I, bool MASK>
__device__ __forceinline__ void pair_exp_chunk(const f32x16& p0, const f32x16& p1, u32x4 (&pw)[4], float& sacc, int kl2, int kh2) {
    const f32x16& src = (I < 4) ? p0 : p1; constexpr int b = 4 * (I & 3);
    float x0 = src[b], x1 = src[b + 1], x2 = src[b + 2], x3 = src[b + 3];
    if (MASK) {
        constexpr int c0 = 8 * (b >> 2) + ((I < 4) ? 0 : 32);
        x0 = (c0 >= kl2 && c0 <= kh2) ? x0 : -INFINITY; x1 = (c0 + 1 >= kl2 && c0 + 1 <= kh2) ? x1 : -INFINITY;
        x2 = (c0 + 2 >= kl2 && c0 + 2 <= kh2) ? x2 : -INFINITY; x3 = (c0 + 3 >= kl2 && c0 + 3 <= kh2) ? x3 : -INFINITY;
    }
    const float e0 = __builtin_amdgcn_exp2f(x0), e1 = __builtin_amdgcn_exp2f(x1), e2 = __builtin_amdgcn_exp2f(x2), e3 = __builtin_amdgcn_exp2f(x3);
    sacc += (e0 + e1) + (e2 + e3);
    pw[I >> 1][(I & 1) * 2] = pk2(e0, e1); pw[I >> 1][(I & 1) * 2 + 1] = pk2(e2, e3);
}
#define PAIR_SB() __builtin_amdgcn_sched_barrier(0)
__device__ __forceinline__ bf16x8 vfrag_load(LDSP const unsigned char* vb, int idx) {
    const int off = ((idx & 1) * 4 + (idx >> 1)) * 1024;
    const v4i16_t lo = __builtin_amdgcn_ds_read_tr16_b64_v4i16((LDSP v4i16_t*)(vb + off));
    const v4i16_t hh = __builtin_amdgcn_ds_read_tr16_b64_v4i16((LDSP v4i16_t*)(vb + off + 512));
    return (bf16x8){lo[0], lo[1], lo[2], lo[3], hh[0], hh[1], hh[2], hh[3]};
}
template <bool MASK>
__device__ __forceinline__ void attn_pair_fast(ASt& st, const bf16x8 (&qf)[4], LDSP const unsigned char* ka, LDSP const unsigned char* kb, int lane, const TP& ta, const TP& tb) {
    const int r32 = lane & 31, hi = lane >> 5; const bool offa = ta.rowoff, offb = tb.rowoff;
    const int kla = ta.kl - 4 * hi, kha = ta.kh - 4 * hi, klb = tb.kl - 4 * hi, khb = tb.kh - 4 * hi;
    LDSP const unsigned char* vba = ka + 8192 + ((lane >> 4) & 1) * 32 + (lane & 3) * 8 + (4 * hi + ((lane & 15) >> 2)) * 64;
    LDSP const unsigned char* vbb = vba + (kb - ka);
    f32x16 a0, a1, b0, b1; u32x4 pwa[4], pwb[4];
    bf16x8 kfa[8], kfb[8], vfa[8], vfb[8];
    pair_kload(kfa, ka, r32, hi);
    { f32x16 c16; const float cina = offa ? -INFINITY : -st.m;
#pragma unroll
      for (int r = 0; r < 16; ++r) c16[r] = cina;
      asm volatile("s_waitcnt lgkmcnt(0)" ::: "memory"); PAIR_SB();
#define QKA_STEP(I) do { if ((I) & 1) a1 = __builtin_amdgcn_mfma_f32_32x32x16_bf16(kfa[I], qf[(I) >> 1], (I) == 1 ? c16 : a1, 0, 0, 0); \
                         else         a0 = __builtin_amdgcn_mfma_f32_32x32x16_bf16(kfa[I], qf[(I) >> 1], (I) == 0 ? c16 : a0, 0, 0, 0); \
                         kfb[I] = *(const LDSP bf16x8*)(kb + swz_off(r32 + 32 * ((I) & 1), 2 * ((I) >> 1) + hi)); PAIR_SB(); } while (0)
      QKA_STEP(0); QKA_STEP(1); QKA_STEP(2); QKA_STEP(3); QKA_STEP(4); QKA_STEP(5); QKA_STEP(6); QKA_STEP(7);
#undef QKA_STEP
    }
    float sa = 0.f, sbm = 0.f;
    { f32x16 c16; const float cinb = offb ? -INFINITY : -st.m;
#pragma unroll
      for (int r = 0; r < 16; ++r) c16[r] = cinb;
      asm volatile("s_waitcnt lgkmcnt(0)" ::: "memory"); PAIR_SB();
#define QKB_STEP(I) do { if ((I) & 1) b1 = __builtin_amdgcn_mfma_f32_32x32x16_bf16(kfb[I], qf[(I) >> 1], (I) == 1 ? c16 : b1, 0, 0, 0); \
                         else         b0 = __builtin_amdgcn_mfma_f32_32x32x16_bf16(kfb[I], qf[(I) >> 1], (I) == 0 ? c16 : b0, 0, 0, 0); \
                         if ((I) >= 4) vfa[(I) - 4] = vfrag_load(vba, (I) - 4); \
                         pair_exp_chunk<I, MASK>(a0, a1, pwa, sa, kla, kha); PAIR_SB(); } while (0)
      QKB_STEP(0); QKB_STEP(1); QKB_STEP(2); QKB_STEP(3); QKB_STEP(4); QKB_STEP(5); QKB_STEP(6); QKB_STEP(7);
#undef QKB_STEP
    }
    asm volatile("s_waitcnt lgkmcnt(0)" ::: "memory"); PAIR_SB();
#define PVA_STEP(I) do { if ((I) & 1) st.o1 = __builtin_amdgcn_mfma_f32_32x32x16_bf16(vfa[I], __builtin_bit_cast(bf16x8, pwa[(I) >> 1]), st.o1, 0, 0, 0); \
                         else         st.o0 = __builtin_amdgcn_mfma_f32_32x32x16_bf16(vfa[I], __builtin_bit_cast(bf16x8, pwa[(I) >> 1]), st.o0, 0, 0, 0); \
                         if ((I) < 4) vfa[(I) + 4] = vfrag_load(vba, (I) + 4); else vfb[(I) - 4] = vfrag_load(vbb, (I) - 4); \
                         pair_exp_chunk<I, MASK>(b0, b1, pwb, sbm, klb, khb); PAIR_SB(); \
                         if ((I) == 3) { asm volatile("s_waitcnt lgkmcnt(0)" ::: "memory"); PAIR_SB(); } } while (0)
    PVA_STEP(0); PVA_STEP(1); PVA_STEP(2); PVA_STEP(3); PVA_STEP(4); PVA_STEP(5); PVA_STEP(6); PVA_STEP(7);
#undef PVA_STEP
    st.l += sa + sbm;
    asm volatile("s_waitcnt lgkmcnt(0)" ::: "memory"); PAIR_SB();
#define PVB_STEP(I) do { if ((I) & 1) st.o1 = __builtin_amdgcn_mfma_f32_32x32x16_bf16(vfb[I], __builtin_bit_cast(bf16x8, pwb[(I) >> 1]), st.o1, 0, 0, 0); \
                         else         st.o0 = __builtin_amdgcn_mfma_f32_32x32x16_bf16(vfb[I], __builtin_bit_cast(bf16x8, pwb[(I) >> 1]), st.o0, 0, 0, 0); \
                         if ((I) < 4) vfb[(I) + 4] = vfrag_load(vbb, (I) + 4); PAIR_SB(); \
                         if ((I) == 3) { asm volatile("s_waitcnt lgkmcnt(0)" ::: "memory"); PAIR_SB(); } } while (0)
    PVB_STEP(0); PVB_STEP(1); PVB_STEP(2); PVB_STEP(3); PVB_STEP(4); PVB_STEP(5); PVB_STEP(6); PVB_STEP(7);
#undef PVB_STEP
    const float lpair = fmaxf(st.l, swap32f(st.l));
    if (__any(lpair > 1.0e18f)) {
        const float dl = (lpair > 1.0e18f) ? 64.f : 0.f, alpha = __builtin_amdgcn_exp2f(-dl);
        st.m += dl; st.l *= alpha;
#pragma unroll
        for (int r = 0; r < 16; ++r) { st.o0[r] *= alpha; st.o1[r] *= alpha; }
    }
}

#define KV_LOOP_PAIR(NT, KPTR, VDELTA, PITCH, TPF) do { const int nt_ = (NT), np_ = (nt_ + 1) >> 1; const int wu_ = __builtin_amdgcn_readfirstlane(wid); __syncthreads(); \
    { const int i = 0; kv_dma((KPTR), (KPTR) + (VDELTA), (PITCH), lds, wu_, lane); } { const int i = (nt_ > 1) ? 1 : 0; kv_dma((KPTR), (KPTR) + (VDELTA), (PITCH), lds + 16384, wu_, lane); } \
    asm volatile("s_waitcnt vmcnt(0)" ::: "memory"); __syncthreads(); \
    _Pragma("unroll 1") for (int ip_ = 0; ip_ < np_; ++ip_) { LDSP unsigned char* cur0_ = lds + (ip_ & 1) * 32768; LDSP unsigned char* nxt0_ = lds + ((ip_ + 1) & 1) * 32768; \
        if (ip_ + 1 < np_) { { const int i = 2 * ip_ + 2; kv_dma((KPTR), (KPTR) + (VDELTA), (PITCH), nxt0_, wu_, lane); } \
                             { const int i = (2 * ip_ + 3 < nt_) ? 2 * ip_ + 3 : 2 * ip_ + 2; kv_dma((KPTR), (KPTR) + (VDELTA), (PITCH), nxt0_ + 16384, wu_, lane); } } \
        if (2 * ip_ + 1 < nt_) { const TP ta_ = TPF(2 * ip_), tb_ = TPF(2 * ip_ + 1); \
            if (ta_.nm || tb_.nm) attn_pair_fast<true>(st, qf, cur0_, cur0_ + 16384, lane, ta_, tb_); else attn_pair_fast<false>(st, qf, cur0_, cur0_ + 16384, lane, ta_, tb_); } \
        else { const TP ta_ = TPF(2 * ip_); attn_tile<0>(st, qf, cur0_, lane, ta_.rowoff, ta_.kl, ta_.kh, ta_.nm, 0.f, nullptr, nullptr, 0, 0); } \
        asm volatile("s_waitcnt vmcnt(0)" ::: "memory"); \
        __syncthreads(); } } while (0)

__device__ __forceinline__ void store_ot(bf16_t* dst, const f32x16& o0, const f32x16& o1, int hi) {
#pragma unroll
    for (int qd = 0; qd < 4; ++qd) {
        u32x2 w0, w1;
        w0.x = pk2(o0[4 * qd], o0[4 * qd + 1]); w0.y = pk2(o0[4 * qd + 2], o0[4 * qd + 3]);
        w1.x = pk2(o1[4 * qd], o1[4 * qd + 1]); w1.y = pk2(o1[4 * qd + 2], o1[4 * qd + 3]);
        *(u32x2*)(dst + 8 * qd + 4 * hi) = w0; *(u32x2*)(dst + 32 + 8 * qd + 4 * hi) = w1;
    }
}

__device__ __forceinline__ void moba_unit(const Params& P, LDSP unsigned char* lds, int b, int h, int blk) {
    unsigned char* ws = P.ws;
    const int tid = opaque_tid(), lane = tid & 63, wid = tid >> 6, r32 = lane & 31, hi = lane >> 5;
    const bf16_t* qa = (const bf16_t*)(ws + OFF_R1);
    const bf16_t* ka = (const bf16_t*)(ws + OFF_R1 + 32 * MiB);
    const bf16_t* va = (const bf16_t*)(ws + OFF_R1 + 64 * MiB);
    bf16_t* ya = (bf16_t*)(ws + OFF_R0);
    const float* kmean = (const float*)(ws + OFF_KMEAN) + (size_t)((b * 8 + h) * 16) * 64;
    LDSP float* km = (LDSP float*)(lds + A_MISC);
    LDSP unsigned short* sel16 = (LDSP unsigned short*)(lds + A_MISC + 4096);
    __syncthreads();
    for (int i = tid; i < blk * 64; i += NTHREADS) km[i] = kmean[i];
    __syncthreads();
    {
        const int qi = tid >> 1, hf = tid & 1;
        const bf16_t* qrow = qa + (size_t)(b * SEQ + blk * 256 + qi) * 512 + h * 64 + hf * 32;
        float q[32];
#pragma unroll
        for (int c = 0; c < 4; ++c) { float f[8]; cvt8(*(const u32x4*)(qrow + c * 8), f);
#pragma unroll
            for (int i = 0; i < 8; ++i) q[c * 8 + i] = f[i]; }
        float g0 = -INFINITY, g1 = -INFINITY, g2 = -INFINITY; int i0 = -1, i1 = -1, i2 = -1;
        for (int j = 0; j < blk; ++j) {
            float d = 0.f;
#pragma unroll
            for (int i = 0; i < 32; ++i) d += q[i] * km[j * 64 + hf * 32 + i];
            d += __shfl_xor(d, 1);
            if (d > g0) { g2 = g1; i2 = i1; g1 = g0; i1 = i0; g0 = d; i0 = j; }
            else if (d > g1) { g2 = g1; i2 = i1; g1 = d; i1 = j; }
            else if (d > g2) { g2 = d; i2 = j; }
        }
        unsigned mask = 0;
        if (i0 >= 0) mask |= 1u << i0;
        if (i1 >= 0) mask |= 1u << i1;
        if (i2 >= 0) mask |= 1u << i2;
        if (hf == 0) sel16[qi] = (unsigned short)mask;
    }
    __syncthreads();
    const int qloc = wid * 32 + r32;
    const size_t qrow_g = (size_t)(b * SEQ + blk * 256 + qloc);
    bf16x8 qf[4];
#pragma unroll
    for (int d0 = 0; d0 < 4; ++d0) qf[d0] = *(const bf16x8*)(qa + qrow_g * 512 + h * 64 + d0 * 16 + hi * 8);
    const unsigned selbits = sel16[qloc];
    ASt st; ast_reset(st);
    const bf16_t* kbase = ka + (size_t)(b * SEQ) * 512 + h * 64;
    const bf16_t* vbase = va + (size_t)(b * SEQ) * 512 + h * 64;
    auto moba_tp = [=](int ti) -> TP { const int jb = ti >> 2, t4 = ti & 3; const bool past = jb < blk;
        int l_ = lane; asm volatile("" : "+v"(l_)); const int w_ = __builtin_amdgcn_readfirstlane(wid), ql_ = w_ * 32 + (l_ & 31);
        TP t; t.rowoff = past ? !((selbits >> jb) & 1u) : (64 * t4 > ql_); t.nm = !past && (64 * t4 + 63 > w_ * 32); t.kl = 0; t.kh = past ? 63 : ql_ - 64 * t4; return t; };
    KV_LOOP_PAIR(4 * (blk + 1), kbase + (size_t)i * 64 * 512, (size_t)16 * 1024 * 1024, 512, moba_tp);
    const float lt = st.l + swap32f(st.l);
    const float inv = 1.0f / lt;
#pragma unroll
    for (int r = 0; r < 16; ++r) { st.o0[r] *= inv; st.o1[r] *= inv; }
    { const int t2 = opaque_tid(), l2 = t2 & 63;
      const size_t row2 = (size_t)(b * SEQ + blk * 256 + (t2 >> 6) * 32 + (l2 & 31));
      store_ot((bf16_t*)(P.ws + OFF_R0) + row2 * 512 + h * 64, st.o0, st.o1, l2 >> 5); }
}

__device__ __forceinline__ void nsa_unit(const Params& P, LDSP unsigned char* lds, int b, int g, int c) {
    unsigned char* ws = P.ws;
    const int tid = opaque_tid(), lane = tid & 63, wid = tid >> 6, r32 = lane & 31, hi = lane >> 5;
    const bf16_t* qb = (const bf16_t*)(ws + OFF_R1 + 96 * MiB);
    const bf16_t* kc = (const bf16_t*)(ws + OFF_KC) + (size_t)(b * 2 + g) * 256 * 64;
    const bf16_t* vc = (const bf16_t*)(ws + OFF_VC) + (size_t)(b * 2 + g) * 256 * 64;
    const bf16_t* ks = (const bf16_t*)(ws + OFF_R2 + 16 * MiB) + (size_t)(b * SEQ) * 128 + g * 64;
    const bf16_t* vs = (const bf16_t*)(ws + OFF_R2 + 24 * MiB) + (size_t)(b * SEQ) * 128 + g * 64;
    const bf16_t* kw = (const bf16_t*)(ws + OFF_R2 + 32 * MiB) + (size_t)(b * SEQ) * 128 + g * 64;
    const bf16_t* vw = (const bf16_t*)(ws + OFF_R2 + 40 * MiB) + (size_t)(b * SEQ) * 128 + g * 64;
    const float* bgate = (const float*)(ws + OFF_BGATE);
    bf16_t* yb = (bf16_t*)(ws + OFF_R0 + 32 * MiB);
    LDSP float* gs = (LDSP float*)(lds + A_GS);
    LDSP float* es = (LDSP float*)(lds + A_ES);
    LDSP unsigned long long* selm = (LDSP unsigned long long*)(lds + A_MISC);
    const int ql = wid * 8 + (r32 >> 2), hr = r32 & 3, head = g * 4 + hr, pos = c * 64 + ql;
    const size_t trow = (size_t)(b * SEQ + pos);
    bf16x8 qf[4];
#pragma unroll
    for (int d0 = 0; d0 < 4; ++d0) qf[d0] = *(const bf16x8*)(qb + trow * 512 + head * 64 + d0 * 16 + hi * 8);
    const int nmax = (pos >= 31) ? ((pos - 31) >> 4) : -1;
    const int ntc = ((4 * c + 2) >> 6) + 1;
    ASt st; ast_reset(st);
    KV_LOOP(ntc, kc + (size_t)i * 64 * 64, vc + (size_t)i * 64 * 64, 64, {
        attn_tile<1>(st, qf, cur, lane, nmax < 0, 0, nmax - 64 * i, true, 0.f, nullptr, nullptr, 0, 0);
    });
    {
        const float lt = st.l + swap32f(st.l);
        const float linv = (lt > 0.f) ? 1.0f / lt : 0.f;
        KV_LOOP(ntc, kc + (size_t)i * 64 * 64, vc + (size_t)i * 64 * 64, 64, {
            attn_tile<2>(st, qf, cur, lane, nmax < 0, 0, nmax - 64 * i, true, linv, gs, es, 16 * i, ql);
        });
    }
    LDSP float* yl = (LDSP float*)(lds + A_Y) + wid * 2048 + lane;
    __syncthreads();
    for (int qq = 0; qq < 8; ++qq) {
        const int q = wid * 8 + qq, j = lane;
        unsigned long long m;
        if (c < 16) m = (2ull << c) - 1ull;
        else {
            const bool cand = (j >= 1 && j <= c - 2);
            float imp = 0.f;
            if (cand) imp = gs[q * 64 + j] + es[q * 64 + j - 1];
            int rank = 0;
            for (int jp = 1; jp <= c - 2; ++jp) {
                const float o = __uint_as_float(__builtin_amdgcn_readlane(__float_as_uint(imp), jp));
                rank += (o > imp || (o == imp && jp < j)) ? 1 : 0;
            }
            const bool sel = (j == 0) || (j == c) || (j == c - 1) || (cand && rank < 13);
            m = __ballot(sel);
        }
        if (lane == 0) selm[q] = m;
    }
    __syncthreads();
    { const int t2 = opaque_tid(), l2 = t2 & 63; const size_t trow2 = (size_t)(b * SEQ + c * 64 + (t2 >> 6) * 8 + ((l2 & 31) >> 2)); const int head2 = g * 4 + (l2 & 3);
      const float gt0 = ((const float*)(P.ws + OFF_BGATE))[trow2 * 24 + head2 * 3 + 0];
#pragma unroll
    for (int r = 0; r < 16; ++r) { yl[r * 64] = gt0 * st.o0[r]; yl[(16 + r) * 64] = gt0 * st.o1[r]; } }
    const unsigned long long selmask = selm[ql];
    ast_reset(st);
    auto slc_tp = [=](int ti) -> TP { int l_ = lane; asm volatile("" : "+v"(l_)); const int ql_ = __builtin_amdgcn_readfirstlane(wid) * 8 + ((l_ & 31) >> 2);
        TP t; t.rowoff = !((selmask >> ti) & 1ull); t.nm = (ti == c); t.kl = 0; t.kh = (ti == c) ? ql_ : 63; return t; };
    KV_LOOP_PAIR(c + 1, ks + (size_t)i * 64 * 128, (size_t)4 * 1024 * 1024, 128, slc_tp);
    {
        const float lt = st.l + swap32f(st.l);
        const int t2 = opaque_tid(), l2 = t2 & 63; const size_t trow2 = (size_t)(b * SEQ + c * 64 + (t2 >> 6) * 8 + ((l2 & 31) >> 2)); const int head2 = g * 4 + (l2 & 3);
        LDSP float* yl = (LDSP float*)(lds + A_Y) + (t2 >> 6) * 2048 + l2;
        const float sc = ((const float*)(P.ws + OFF_BGATE))[trow2 * 24 + head2 * 3 + 1] / lt;
#pragma unroll
        for (int r = 0; r < 16; ++r) { yl[r * 64] += sc * st.o0[r]; yl[(16 + r) * 64] += sc * st.o1[r]; }
    }
    ast_reset(st);
    const int j0 = (c >= 8) ? c - 8 : 0;
    auto win_tp = [=](int ti) -> TP { const int j = j0 + ti; const bool first = (j == c - 8), own = (j == c);
        int l_ = lane; asm volatile("" : "+v"(l_)); const int ql_ = __builtin_amdgcn_readfirstlane(wid) * 8 + ((l_ & 31) >> 2);
        TP t; t.rowoff = false; t.nm = first || own; t.kl = first ? ql_ + 1 : 0; t.kh = own ? ql_ : 63; return t; };
    KV_LOOP_PAIR(c - j0 + 1, kw + (size_t)(j0 + i) * 64 * 128, (size_t)4 * 1024 * 1024, 128, win_tp);
    {
        const float lt = st.l + swap32f(st.l);
        const int t2 = opaque_tid(), l2 = t2 & 63; const size_t trow2 = (size_t)(b * SEQ + c * 64 + (t2 >> 6) * 8 + ((l2 & 31) >> 2)); const int head2 = g * 4 + (l2 & 3);
        LDSP float* yl = (LDSP float*)(lds + A_Y) + (t2 >> 6) * 2048 + l2;
        const float sc = ((const float*)(P.ws + OFF_BGATE))[trow2 * 24 + head2 * 3 + 2] / lt;
        f32x16 y0, y1;
#pragma unroll
        for (int r = 0; r < 16; ++r) { y0[r] = yl[r * 64] + sc * st.o0[r]; y1[r] = yl[(16 + r) * 64] + sc * st.o1[r]; }
        store_ot((bf16_t*)(P.ws + OFF_R0 + 32 * MiB) + trow2 * 512 + head2 * 64, y0, y1, l2 >> 5);
    }
}

__device__ __forceinline__ void phase_attn(const Params& P, LDSP unsigned char* lds, int vcu, int G) {
    const int nloc = (G == 256) ? 8 : (2048 - vcu + G - 1) / G;
    for (int k = 0; k < nloc; ++k) {
        int u;
        if (G == 256) {
            const int kk = k >> 1;
            if (!(k & 1)) { const int bh = vcu >> 2, jm = vcu & 3; const int blk = (kk == 0) ? 15 - jm : (kk == 1) ? 8 + jm : (kk == 2) ? 7 - jm : jm; u = bh * 16 + blk; }
            else { const int bg = vcu >> 4, jn = vcu & 15; const int c = (kk == 0) ? 63 - jn : (kk == 1) ? 32 + jn : (kk == 2) ? 31 - jn : jn; u = 1024 + bg * 64 + c; }
        } else u = vcu + k * G;
        if (u < 1024) moba_unit(P, lds, u >> 7, (u >> 4) & 7, u & 15);
        else { const int v = u - 1024; nsa_unit(P, lds, v >> 7, (v >> 6) & 1, v & 63); }
    }
}

struct EpiUp {
    const Params* P;
    __device__ __forceinline__ void operator()(f32x4 (&acc)[2][2][4][2], const pg8::Unit& u, int wr, int wc, int fr, int fq) const {
        bf16_t* g = (bf16_t*)(P->ws + OFF_R3);
#pragma unroll
        for (int ai = 0; ai < 2; ++ai)
#pragma unroll
            for (int m = 0; m < 4; ++m) {
                const int row = u.pm * 256 + ai * 128 + wr * 64 + m * 16 + fr;
#pragma unroll
                for (int bj = 0; bj < 2; ++bj) {
                    bf16_t* rp = g + (size_t)row * 2048 + u.pn * 256 + bj * 128 + wc * 32 + 8 * fq;
                    const u32x4 gg = *(const u32x4*)(rp + (u.z ? 1024 : 0));
                    float gf[8]; cvt8(gg, gf);
                    float o[8];
#pragma unroll
                    for (int n = 0; n < 2; ++n)
#pragma unroll
                        for (int i = 0; i < 4; ++i) o[4 * n + i] = gf[4 * n + i] * acc[ai][bj][m][n][i];
                    if (u.z) { float pf[8]; cvt8(*(const u32x4*)rp, pf);
#pragma unroll
                        for (int i = 0; i < 8; ++i) o[i] += pf[i]; }
                    u32x4 w; w.x = pk2(o[0], o[1]); w.y = pk2(o[2], o[3]); w.z = pk2(o[4], o[5]); w.w = pk2(o[6], o[7]);
                    *(u32x4*)rp = w;
                }
            }
    }
};
__device__ __forceinline__ void phase_up(const Params& P, LDSP unsigned char* lds, int vcu, int G) {
    pg8::Sched S; S.A0 = (const bf16_t*)(P.ws + OFF_R0); S.A1 = (const bf16_t*)(P.ws + OFF_R0 + 32 * MiB);
    S.B0 = (const bf16_t*)(P.ws + OFF_WUPA_T); S.B1 = (const bf16_t*)(P.ws + OFF_WUPB_T);
    S.lda = 512; S.ldb = 512; S.K = 512; S.nM = T / 256; S.nN = DM / 256; S.NZ = 2; S.G = G; S.c = blockIdx.x;
    EpiUp E{&P};
    pg8::gemm_phase(lds, S, E);
}

struct EpiOut {
    const Params* P;
    __device__ __forceinline__ void operator()(f32x4 (&acc)[2][2][4][2], const pg8::Unit& u, int wr, int wc, int fr, int fq) const {
        bf16_t* x1b = (bf16_t*)(P->ws + OFF_R0);
        float* rs2 = (float*)(P->ws + OFF_RS2);
        const float* x = P->in[I_X];
#pragma unroll
        for (int ai = 0; ai < 2; ++ai)
#pragma unroll
            for (int m = 0; m < 4; ++m) {
                const int row = u.pm * 256 + ai * 128 + wr * 64 + m * 16 + fr;
                float ss = 0.f;
                f32x4 xv[2][2];
#pragma unroll
                for (int bj = 0; bj < 2; ++bj)
#pragma unroll
                    for (int n = 0; n < 2; ++n) xv[bj][n] = *(const f32x4*)(x + (size_t)row * DM + u.pn * 256 + bj * 128 + wc * 32 + 8 * fq + 4 * n);
#pragma unroll
                for (int bj = 0; bj < 2; ++bj) {
                    const size_t off = (size_t)row * DM + u.pn * 256 + bj * 128 + wc * 32 + 8 * fq;
                    const f32x4 o0 = xv[bj][0] + acc[ai][bj][m][0], o1 = xv[bj][1] + acc[ai][bj][m][1];
                    *(f32x4*)(P->out + off) = o0; *(f32x4*)(P->out + off + 4) = o1;
                    u32x4 w; w.x = pk2(o0.x, o0.y); w.y = pk2(o0.z, o0.w); w.z = pk2(o1.x, o1.y); w.w = pk2(o1.z, o1.w);
                    *(u32x4*)(x1b + off) = w;
                    ss += ((o0.x * o0.x + o0.y * o0.y) + (o0.z * o0.z + o0.w * o0.w)) + ((o1.x * o1.x + o1.y * o1.y) + (o1.z * o1.z + o1.w * o1.w));
                }
                ss += __shfl_xor(ss, 16); ss += __shfl_xor(ss, 32);
                if (fq == 0) atomicAdd(rs2 + row, ss);
            }
    }
};
__device__ __forceinline__ void phase_out(const Params& P, LDSP unsigned char* lds, int vcu, int G) {
    pg8::Sched S; S.A0 = S.A1 = (const bf16_t*)(P.ws + OFF_R3); S.B0 = S.B1 = (const bf16_t*)(P.ws + OFF_WOUT_T);
    S.lda = 2048; S.ldb = DM; S.K = DM; S.nM = T / 256; S.nN = DM / 256; S.NZ = 1; S.G = G; S.c = blockIdx.x;
    EpiOut E{&P};
    pg8::gemm_phase(lds, S, E);
}

struct EpiPq {
    const Params* P;
    __device__ __forceinline__ void operator()(f32x4 (&acc)[2][2][4][2], const pg8::Unit& u, int wr, int wc, int fr, int fq) const {
        bf16_t* qp = (bf16_t*)(P->ws + OFF_R1);
        const float* rs2 = (const float*)(P->ws + OFF_RS2);
        float rr[2][4];
#pragma unroll
        for (int ai = 0; ai < 2; ++ai)
#pragma unroll
            for (int m = 0; m < 4; ++m) rr[ai][m] = 1.0f / sqrtf(rs2[u.pm * 256 + ai * 128 + wr * 64 + m * 16 + fr] * (1.0f / DM) + NORM_EPS);
#pragma unroll
        for (int ai = 0; ai < 2; ++ai)
#pragma unroll
            for (int m = 0; m < 4; ++m) {
                const int row = u.pm * 256 + ai * 128 + wr * 64 + m * 16 + fr;
                const float r = rr[ai][m];
#pragma unroll
                for (int bj = 0; bj < 2; ++bj) {
                    const f32x4 a0 = acc[ai][bj][m][0], a1 = acc[ai][bj][m][1];
                    u32x4 w; w.x = pk2(a0[0] * r, a0[1] * r); w.y = pk2(a0[2] * r, a0[3] * r); w.z = pk2(a1[0] * r, a1[1] * r); w.w = pk2(a1[2] * r, a1[3] * r);
                    *(u32x4*)(qp + (size_t)row * 2048 + u.pn * 256 + bj * 128 + wc * 32 + 8 * fq) = w;
                }
            }
    }
};
__device__ __forceinline__ void phase_pq(const Params& P, LDSP unsigned char* lds, int vcu, int G) {
    pg8::Sched S; S.A0 = S.A1 = (const bf16_t*)(P.ws + OFF_R0); S.B0 = S.B1 = (const bf16_t*)(P.ws + OFF_WPQ_T);
    S.lda = DM; S.ldb = DM; S.K = DM; S.nM = T / 256; S.nN = 2048 / 256; S.NZ = 1; S.G = G; S.c = blockIdx.x;
    EpiPq E{&P};
    pg8::gemm_phase(lds, S, E);
}

__device__ __forceinline__ unsigned f2ord(float f) { const unsigned u = __float_as_uint(f); return u ^ ((unsigned)((int)u >> 31) | 0x80000000u); }
__device__ __forceinline__ float ord2f(unsigned o) { const unsigned u = (o & 0x80000000u) ? (o ^ 0x80000000u) : ~o; return __uint_as_float(u); }
__device__ __forceinline__ void ins16(unsigned (&top)[16], unsigned x) {
#pragma unroll
    for (int j = 0; j < 16; ++j) { const unsigned t = max(x, top[j]); x = min(x, top[j]); top[j] = t; }
}
__device__ __forceinline__ int crow(int r, int hi) { return (r & 3) + 8 * (r >> 2) + 4 * hi; }
__device__ __forceinline__ void ce_desc(unsigned& a, unsigned& b) { const unsigned hi_ = max(a, b), lo_ = min(a, b); a = hi_; b = lo_; }
__device__ __forceinline__ void bitonic_merge16_desc(unsigned (&a)[16]) {
#pragma unroll
    for (int j = 8; j > 0; j >>= 1)
#pragma unroll
        for (int i = 0; i < 16; ++i) { const int l = i ^ j; if (l > i) ce_desc(a[i], a[l]); }
}
__device__ __forceinline__ void sort16_desc(unsigned (&a)[16]) {
#pragma unroll
    for (int k = 2; k <= 16; k <<= 1)
#pragma unroll
        for (int j = k >> 1; j > 0; j >>= 1)
#pragma unroll
            for (int i = 0; i < 16; ++i) { const int l = i ^ j; if (l > i) { if ((i & k) == 0) ce_desc(a[i], a[l]); else ce_desc(a[l], a[i]); } }
}
__device__ __forceinline__ void merge_top16(unsigned (&top)[16], const unsigned (&blk)[16]) {
#pragma unroll
    for (int i = 0; i < 16; ++i) top[i] = max(top[i], blk[15 - i]);
    bitonic_merge16_desc(top);
}
constexpr int cand_prefix(int i) { int n = 0; for (int a = 0; a < i; ++a) n += 16 / (a + 1); return n; }

constexpr int P8_KOFF = 0, P8_IDX = 65536;
__device__ __forceinline__ void phase_topk(const Params& P, LDSP unsigned char* lds, int vcu, int G) {
    unsigned char* ws = P.ws;
    const bf16_t* qp = (const bf16_t*)(ws + OFF_R1);
    int* experts = (int*)(ws + OFF_EXPERTS);
    float* gates = (float*)(ws + OFF_GATES);
    const int tid = opaque_tid(), lane = tid & 63, wave = tid >> 6, r32 = lane & 31, hi = lane >> 5;
    __syncthreads();
    for (int i = tid; i < 2 * 128 * 16; i += NTHREADS) {
        const int w = i >> 11, row = (i >> 4) & 127, ch = i & 15;
        const u32x4 v = *(const u32x4*)((const bf16_t*)(ws + (w ? OFF_K2B : OFF_K1B)) + row * 128 + ch * 8);
        *(LDSP u32x4*)(lds + P8_KOFF + w * 32768 + row * 256 + ((ch ^ (row & 15)) << 4)) = v;
    }
    __syncthreads();
    LDSP unsigned char* myidx = lds + P8_IDX + (wave * 64 + lane) * 32;
    const int gw = vcu * NWAVES + wave, NGW = G * NWAVES;
    for (int item = gw; item < (T / 32) * 8; item += NGW) {
        const int tg = item >> 3, h = item & 7;
        const int tok = tg * 32 + r32;
        unsigned tops[2][16];
#pragma unroll
        for (int L = 0; L < 2; ++L) {
            bf16x8 qf[8];
            const bf16_t* qrow = qp + (size_t)tok * 2048 + h * 256 + L * 128 + hi * 8;
#pragma unroll
            for (int s8 = 0; s8 < 8; ++s8) qf[s8] = *(const bf16x8*)(qrow + s8 * 16);
            unsigned top[16];
#pragma unroll
            for (int kb = 0; kb < 4; ++kb) {
                f32x16 acc = {0.f, 0.f, 0.f, 0.f, 0.f, 0.f, 0.f, 0.f, 0.f, 0.f, 0.f, 0.f, 0.f, 0.f, 0.f, 0.f};
                const int row = kb * 32 + r32;
#pragma unroll
                for (int s8 = 0; s8 < 8; ++s8) {
                    const bf16x8 kf = *(const LDSP bf16x8*)(lds + P8_KOFF + L * 32768 + row * 256 + (((2 * s8 + hi) ^ (row & 15)) << 4));
                    acc = __builtin_amdgcn_mfma_f32_32x32x16_bf16(kf, qf[s8], acc, 0, 0, 0);
                }
                unsigned blk[16];
#pragma unroll
                for (int r = 0; r < 16; ++r) {
                    const int key = kb * 32 + (r & 3) + 8 * (r >> 2) + 4 * hi;
                    blk[r] = (f2ord(acc[r]) & ~0x7Fu) | (unsigned)(127 - key);
                }
                sort16_desc(blk);
                if (kb == 0) {
#pragma unroll
                    for (int j = 0; j < 16; ++j) top[j] = blk[j];
                } else merge_top16(top, blk);
            }
            unsigned oth[16];
#pragma unroll
            for (int j = 0; j < 16; ++j) oth[j] = (unsigned)__shfl_xor((int)top[j], 32);
            merge_top16(top, oth);
#pragma unroll
            for (int j = 0; j < 16; ++j) tops[L][j] = top[j];
        }
        float v1[16], v2[16];
#pragma unroll
        for (int j = 0; j < 16; j += 4) {
            unsigned w1 = 0, w2 = 0;
#pragma unroll
            for (int q = 0; q < 4; ++q) { w1 |= (127u - (tops[0][j + q] & 127u)) << (8 * q); w2 |= (127u - (tops[1][j + q] & 127u)) << (8 * q); }
            *(LDSP unsigned*)(myidx + j) = w1; *(LDSP unsigned*)(myidx + 16 + j) = w2;
        }
#pragma unroll
        for (int j = 0; j < 16; ++j) { v1[j] = ord2f(tops[0][j] & ~0x7Fu); v2[j] = ord2f(tops[1][j] & ~0x7Fu); }
        unsigned ct[16];
        {
            unsigned cand[64];
#pragma unroll
            for (int n = 0; n < 64; ++n) cand[n] = 0u;
#pragma unroll
            for (int i = 0; i < 16; ++i)
#pragma unroll
                for (int j = 0; j < 16; ++j)
                    if ((i + 1) * (j + 1) <= 16) cand[cand_prefix(i) + j] = (f2ord(v1[i] + v2[j]) & ~0xFFu) | (unsigned)(255 - (i * 16 + j));
#pragma unroll
            for (int bk = 0; bk < 4; ++bk) {
                unsigned blk[16];
#pragma unroll
                for (int r = 0; r < 16; ++r) blk[r] = cand[bk * 16 + r];
                sort16_desc(blk);
                if (bk == 0) {
#pragma unroll
                    for (int j = 0; j < 16; ++j) ct[j] = blk[j];
                } else merge_top16(ct, blk);
            }
        }
        float vals[16], ssum = 0.f;
        const float vmax = ord2f(ct[0] & ~0xFFu);
#pragma unroll
        for (int k = 0; k < 16; ++k) { vals[k] = __expf(ord2f(ct[k] & ~0xFFu) - vmax); ssum += vals[k]; }
        const float inv = 1.0f / ssum;
        asm volatile("s_waitcnt lgkmcnt(0)" ::: "memory");
        if (hi == 0) {
            int* ep = experts + (size_t)tok * 128 + h * 16;
            float* gp = gates + (size_t)tok * 128 + h * 16;
#pragma unroll
            for (int k = 0; k < 16; k += 4) {
                int e4[4];
#pragma unroll
                for (int q = 0; q < 4; ++q) {
                    const unsigned flat = 255u - (ct[k + q] & 255u);
                    const int i1 = myidx[flat >> 4], i2 = myidx[16 + (flat & 15)];
                    e4[q] = i1 * 128 + i2;
                }
                *(u32x4*)(ep + k) = (u32x4){(unsigned)e4[0], (unsigned)e4[1], (unsigned)e4[2], (unsigned)e4[3]};
                *(f32x4*)(gp + k) = (f32x4){vals[k] * inv, vals[k + 1] * inv, vals[k + 2] * inv, vals[k + 3] * inv};
            }
        }
        asm volatile("s_waitcnt lgkmcnt(0)" ::: "memory");
    }
}

__device__ __forceinline__ void peer_slice_map(const Params& P, LDSP unsigned char* lds, int vcu, int G, int wave, int& slice, int& half, int& wslot, int& nslot) {
    volatile LDSP unsigned* bst = (volatile LDSP unsigned*)(lds + LDS_BYTES - 16);
    LDSP unsigned* info = (LDSP unsigned*)(lds + LDS_BYTES - 64);
    __syncthreads();
    if (threadIdx.x == 0) {
        unsigned* bar = (unsigned*)(P.ws + 16384);
        const unsigned x = (unsigned)__builtin_amdgcn_s_getreg((3 << 11) | 20) & 0xFu;
        bool ok = true; unsigned sum = 0, mine = 0;
        for (unsigned j = 0; j < 16; ++j) { const unsigned c = __hip_atomic_load(&bar[256 + 64 * j], __ATOMIC_RELAXED, __HIP_MEMORY_SCOPE_AGENT); sum += c; if (j < 8 && c == 0) ok = false; if (j >= 8 && c != 0) ok = false; if (j == x) mine = c; }
        ok = ok && (sum == (unsigned)G) && (bst[2] < mine);
        info[0] = ok ? 1u : 0u; info[1] = x; info[2] = mine; info[3] = bst[2];
    }
    __syncthreads();
    if (info[0]) { slice = (int)(info[1] & 3u); half = (int)(info[1] >> 2); wslot = (int)info[3] * NWAVES + wave; nslot = (int)info[2] * NWAVES; }
    else if ((G & 7) == 0) { const int g8 = vcu / (G >> 3); slice = g8 & 3; half = g8 >> 2; wslot = (vcu % (G >> 3)) * NWAVES + wave; nslot = (G >> 3) * NWAVES; }
    else { slice = -1; half = 0; wslot = vcu * NWAVES + wave; nslot = G * NWAVES; }
}
struct PeerMetaA { int eA, eB; u32x4 h0, h1, h2, h3; };
struct PeerMetaB { int eA, eB; float aA, aB; };
#define PEER_IDX(m, j) __shfl(((j) < 8) ? (m).eA : (m).eB, (8 * (j) + grp) & 63)
__device__ __forceinline__ float dpp_xor1(float v) { return __builtin_bit_cast(float, __builtin_amdgcn_mov_dpp(__builtin_bit_cast(int, v), 0xB1, 0xF, 0xF, true)); }
__device__ __forceinline__ float dpp_xor2(float v) { return __builtin_bit_cast(float, __builtin_amdgcn_mov_dpp(__builtin_bit_cast(int, v), 0x4E, 0xF, 0xF, true)); }
__device__ __forceinline__ float dpp_hmirror(float v) { return __builtin_bit_cast(float, __builtin_amdgcn_mov_dpp(__builtin_bit_cast(int, v), 0x141, 0xF, 0xF, true)); }
__device__ __forceinline__ float dpp_ror8(float v) { return __builtin_bit_cast(float, __builtin_amdgcn_mov_dpp(__builtin_bit_cast(int, v), 0x128, 0xF, 0xF, true)); }
__device__ __forceinline__ float swap32_sum(float X, float Y) {
    const auto r = __builtin_amdgcn_permlane32_swap(__float_as_uint(X), __float_as_uint(Y), false, false);
    return __uint_as_float(r[0]) + __uint_as_float(r[1]);
}
__device__ __forceinline__ float swap16_sum(float X, float Y) {
    const auto r = __builtin_amdgcn_permlane16_swap(__float_as_uint(X), __float_as_uint(Y), false, false);
    return __uint_as_float(r[0]) + __uint_as_float(r[1]);
}
__device__ __forceinline__ void cvt32_fp4_pk(const u32x4 w, f32x2 (&f)[16]) {
#pragma unroll
    for (int q = 0; q < 4; ++q) {
        f[4 * q]     = __builtin_amdgcn_cvt_scalef32_pk_f32_fp4(w[q], 1.0f, 0); f[4 * q + 1] = __builtin_amdgcn_cvt_scalef32_pk_f32_fp4(w[q], 1.0f, 1);
        f[4 * q + 2] = __builtin_amdgcn_cvt_scalef32_pk_f32_fp4(w[q], 1.0f, 2); f[4 * q + 3] = __builtin_amdgcn_cvt_scalef32_pk_f32_fp4(w[q], 1.0f, 3);
    }
}
#define PA_T(it) ((slice >= 0) ? (2 * (it) + half) : ((it) >> 2))
#define PA_X(it) ((slice >= 0) ? slice : ((it) & 3))
__device__ __forceinline__ void phase_peer_a(const Params& P, LDSP unsigned char* lds, int vcu, int G) {
    unsigned char* ws = P.ws;
    const bf16_t* x1b = (const bf16_t*)(ws + OFF_R0);
    const unsigned char* U4 = ws + OFF_U;
    const int* experts = (const int*)(ws + OFF_EXPERTS);
    float* apart = (float*)(ws + OFF_R1);
    const int tid = opaque_tid(), lane = tid & 63, wave = tid >> 6, grp = lane >> 3, sub = lane & 7;
    const bool b2 = lane & 4, b1 = lane & 2, b0 = lane & 1;
    int slice, half, wslot, nslot;
    peer_slice_map(P, lds, vcu, G, wave, slice, half, wslot, nslot);
    const int nitems = (slice >= 0) ? T / 2 : T * 4;
#define PA_META(m, it) do { const int it_ = ((it) < nitems) ? (it) : wslot; { const int t_ = PA_T(it_), x_ = PA_X(it_); \
        (m).eA = experts[(size_t)t_ * 128 + lane]; (m).eB = experts[(size_t)t_ * 128 + 64 + lane]; const bf16_t* hp_ = x1b + (size_t)t_ * DM + 256 * x_ + 32 * sub; \
        (m).h0 = *(const u32x4*)(hp_); (m).h1 = *(const u32x4*)(hp_ + 8); (m).h2 = *(const u32x4*)(hp_ + 16); (m).h3 = *(const u32x4*)(hp_ + 24); } } while (0)
#define PA_GATHER(R, m, it, J0) do { const int x_ = PA_X(it); _Pragma("unroll") for (int j = 0; j < 8; ++j) { const int e_ = PEER_IDX(m, (J0) + j); \
        (R)[j] = *(const u32x4*)(U4 + ((size_t)x_ * PEER_NE + e_) * 128 + 16 * sub); } } while (0)
#define PA_COMPUTE(R, J0) do { _Pragma("unroll") for (int j = 0; j < 8; ++j) { f32x2 f[16]; asm volatile("" : "+v"((R)[j])); cvt32_fp4_pk((R)[j], f); f32x2 sd = f[0] * h2[0]; \
        _Pragma("unroll") for (int i = 1; i < 16; ++i) sd = __builtin_elementwise_fma(f[i], h2[i], sd); part[(J0) + j] = sd.x + sd.y; asm volatile("" : "+v"(part[(J0) + j])); } } while (0)
    PeerMetaA m0, m1, m2;
    m0.eA = m0.eB = m1.eA = m1.eB = m2.eA = m2.eB = 0;
    m0.h0 = m0.h1 = m0.h2 = m0.h3 = m1.h0 = m1.h1 = m1.h2 = m1.h3 = m2.h0 = m2.h1 = m2.h2 = m2.h3 = (u32x4){0u, 0u, 0u, 0u};
    u32x4 R0[8], R1[8];
    PA_META(m0, wslot); PA_META(m1, wslot + nslot);
    if (wslot >= nitems) return;
    PA_GATHER(R0, m0, wslot, 0); PA_GATHER(R1, m0, wslot, 8);
#pragma unroll 1
    for (int it = wslot; it < nitems; it += nslot) {
        PA_META(m2, it + 2 * nslot);
        f32x2 h2[16]; float part[16];
        { float f[8];
#define PA_H(Q, W) do { cvt8((W), f); _Pragma("unroll") for (int i = 0; i < 4; ++i) h2[4 * (Q) + i] = (f32x2){f[2 * i], f[2 * i + 1]}; } while (0)
          PA_H(0, m0.h0); PA_H(1, m0.h1); PA_H(2, m0.h2); PA_H(3, m0.h3);
#undef PA_H
        }
        PA_COMPUTE(R0, 0);
        const int itn = (it + nslot < nitems) ? it + nslot : it;
        PA_GATHER(R0, m1, itn, 0);
        PA_COMPUTE(R1, 8);
        PA_GATHER(R1, m1, itn, 8);
        float q8[8], q4[4], q2[2];
#pragma unroll
        for (int i = 0; i < 8; ++i) { const float send = b2 ? part[i] : part[i + 8], keep = b2 ? part[i + 8] : part[i]; q8[i] = keep + dpp_hmirror(send); }
#pragma unroll
        for (int i = 0; i < 4; ++i) { const float send = b1 ? q8[i] : q8[i + 4], keep = b1 ? q8[i + 4] : q8[i]; q4[i] = keep + dpp_xor2(send); }
#pragma unroll
        for (int i = 0; i < 2; ++i) { const float send = b0 ? q4[i] : q4[i + 2], keep = b0 ? q4[i + 2] : q4[i]; q2[i] = keep + dpp_xor1(send); }
        float* ap = apart + ((size_t)PA_X(it) * T + PA_T(it)) * 128 + lane;
        ap[0] = q2[0]; ap[64] = q2[1];
        m0 = m1; m1 = m2;
    }
#undef PA_META
#undef PA_GATHER
#undef PA_COMPUTE
}
__device__ __forceinline__ void phase_peer_w(const Params& P, LDSP unsigned char* lds, int vcu, int G) {
    unsigned char* ws = P.ws;
    float* gates = (float*)(ws + OFF_GATES);
    const float* rs2 = (const float*)(ws + OFF_RS2);
    const float* apart = (const float*)(ws + OFF_R1);
    const int* experts = (const int*)(ws + OFF_EXPERTS);
    const float* su = (const float*)(ws + OFF_PSCALE);
    const float* sv = su + PEER_NE;
    const size_t gt = (size_t)(vcu * NTHREADS + threadIdx.x), NGT = (size_t)G * NTHREADS;
    for (size_t i = gt; i < (size_t)T * 128; i += NGT) {
        const int t = (int)(i >> 7), k = (int)(i & 127);
        const int sub = k >> 4, s1 = (k >> 3) & 1, grp = k & 7, idx = s1 * 64 + grp * 8 + sub;
        float a = 0.f;
#pragma unroll
        for (int xs = 0; xs < 4; ++xs) a += apart[((size_t)xs * T + t) * 128 + idx];
        const int e = experts[i];
        const float rs = su[e] / sqrtf(rs2[t] * (1.0f / DM) + NORM_EPS);
        gates[i] = gelu_tanh(a * rs) * gates[i] * sv[e];
    }
}
__device__ __forceinline__ void phase_peer_b(const Params& P, LDSP unsigned char* lds, int vcu, int G) {
    unsigned char* ws = P.ws;
    const unsigned char* V4 = ws + OFF_V;
    const int* experts = (const int*)(ws + OFF_EXPERTS);
    const float* wtok = (const float*)(ws + OFF_GATES);
    const int tid = opaque_tid(), lane = tid & 63, wave = tid >> 6, grp = lane >> 3, sub = lane & 7;
    const bool b3 = lane & 8;
    const int k0 = 16 * sub + grp, k1 = k0 + 8;
    LDSP float* wbuf = (LDSP float*)(lds + wave * 1024);
    int slice, half, wslot, nslot;
    peer_slice_map(P, lds, vcu, G, wave, slice, half, wslot, nslot);
    const int nitems = (slice >= 0) ? T / 2 : T * 4;
#define PB_META(m, it) do { const int it_ = ((it) < nitems) ? (it) : wslot; { const int t_ = PA_T(it_); \
        (m).eA = experts[(size_t)t_ * 128 + lane]; (m).eB = experts[(size_t)t_ * 128 + 64 + lane]; \
        (m).aA = wtok[(size_t)t_ * 128 + k0]; (m).aB = wtok[(size_t)t_ * 128 + k1]; } } while (0)
#define PB_GATHER(R, m, it, J0) do { const int x_ = PA_X(it); _Pragma("unroll") for (int j = 0; j < 8; ++j) { const int e_ = PEER_IDX(m, (J0) + j); \
        (R)[j] = *(const u32x4*)(V4 + ((size_t)x_ * PEER_NE + e_) * 128 + 16 * sub); } } while (0)
#define PB_COMPUTE(R, J0) do { _Pragma("unroll") for (int j = 0; j < 8; ++j) { f32x2 f[16]; asm volatile("" : "+v"((R)[j])); cvt32_fp4_pk((R)[j], f); const float wk = wb[8 * ((J0) + j) + grp]; const f32x2 wk2 = {wk, wk}; \
        _Pragma("unroll") for (int i = 0; i < 16; ++i) acc2[i] = __builtin_elementwise_fma(wk2, f[i], acc2[i]); \
        asm volatile("" : "+v"(acc2[0]), "+v"(acc2[1]), "+v"(acc2[2]), "+v"(acc2[3]), "+v"(acc2[4]), "+v"(acc2[5]), "+v"(acc2[6]), "+v"(acc2[7])); \
        asm volatile("" : "+v"(acc2[8]), "+v"(acc2[9]), "+v"(acc2[10]), "+v"(acc2[11]), "+v"(acc2[12]), "+v"(acc2[13]), "+v"(acc2[14]), "+v"(acc2[15])); } } while (0)
    PeerMetaB m0, m1, m2;
    m0.eA = m0.eB = m1.eA = m1.eB = m2.eA = m2.eB = 0; m0.aA = m0.aB = m1.aA = m1.aB = m2.aA = m2.aB = 0.f;
    u32x4 R0[8], R1[8];
    PB_META(m0, wslot); PB_META(m1, wslot + nslot);
    if (wslot >= nitems) return;
    PB_GATHER(R0, m0, wslot, 0); PB_GATHER(R1, m0, wslot, 8);
    int par = 0;
#pragma unroll 1
    for (int it = wslot; it < nitems; it += nslot) {
        PB_META(m2, it + 2 * nslot);
        LDSP float* wb = wbuf + par * 128; par ^= 1;
        wb[k0] = m0.aA; wb[k1] = m0.aB;
        asm volatile("s_waitcnt lgkmcnt(0)" ::: "memory");
        f32x2 acc2[16];
#pragma unroll
        for (int i = 0; i < 16; ++i) acc2[i] = (f32x2){0.f, 0.f};
        PB_COMPUTE(R0, 0);
        const int itn = (it + nslot < nitems) ? it + nslot : it;
        PB_GATHER(R0, m1, itn, 0);
        PB_COMPUTE(R1, 8);
        PB_GATHER(R1, m1, itn, 8);
        float acc[32];
#pragma unroll
        for (int i = 0; i < 16; ++i) { acc[2 * i] = acc2[i].x; acc[2 * i + 1] = acc2[i].y; }
        float q16[16], q8[8], q4[4];
#pragma unroll
        for (int i = 0; i < 16; ++i) q16[i] = swap32_sum(acc[i], acc[i + 16]);
#pragma unroll
        for (int i = 0; i < 8; ++i) q8[i] = swap16_sum(q16[i], q16[i + 8]);
#pragma unroll
        for (int i = 0; i < 4; ++i) { const float send = b3 ? q8[i] : q8[i + 4], keep = b3 ? q8[i + 4] : q8[i]; q4[i] = keep + dpp_ror8(send); }
        const int c32 = ((lane & 32) ? 16 : 0) + ((lane & 16) ? 8 : 0) + (b3 ? 4 : 0);
        float* op = P.out + (size_t)PA_T(it) * DM + 256 * PA_X(it) + 32 * sub + c32;
        f32x4 o = *(const f32x4*)op;
        o.x += q4[0]; o.y += q4[1]; o.z += q4[2]; o.w += q4[3];
        *(f32x4*)op = o;
        m0 = m1; m1 = m2;
    }
#undef PB_META
#undef PB_GATHER
#undef PB_COMPUTE
#undef PA_T
#undef PA_X
}

#ifndef SELFCHECK
#define SELFCHECK 0
#endif
#if SELFCHECK
constexpr size_t OFF_CHK = 512 * 1024;
__device__ __forceinline__ void wave_argmax(float& v, int& i) {
#pragma unroll
    for (int o = 1; o < 64; o <<= 1) {
        const float ov = __shfl_xor(v, o); const int oi = __shfl_xor(i, o);
        if (ov > v || (ov == v && oi < i)) { v = ov; i = oi; }
    }
}
struct NaiveAcc { float m, l; float o[64]; };
__device__ __forceinline__ float wave_max(float v) {
#pragma unroll
    for (int o = 1; o < 64; o <<= 1) v = fmaxf(v, __shfl_xor(v, o));
    return v;
}
__device__ __forceinline__ void nacc_reset(NaiveAcc& a) { a.m = -1.0e30f; a.l = 0.f;
#pragma unroll
    for (int d = 0; d < 64; ++d) a.o[d] = 0.f; }
__device__ __forceinline__ float dot64(LDSP const float* qs, const bf16_t* krow) {
    float s = 0.f;
#pragma unroll
    for (int c = 0; c < 8; ++c) { float f[8]; cvt8(*(const u32x4*)(krow + c * 8), f);
#pragma unroll
        for (int i = 0; i < 8; ++i) s += qs[c * 8 + i] * f[i]; }
    return s;
}
__device__ __forceinline__ void axpy64(NaiveAcc& a, float alpha, float p, const bf16_t* vrow) {
#pragma unroll
    for (int c = 0; c < 8; ++c) { float f[8]; cvt8(*(const u32x4*)(vrow + c * 8), f);
#pragma unroll
        for (int i = 0; i < 8; ++i) a.o[c * 8 + i] = a.o[c * 8 + i] * alpha + p * f[i]; }
}
__device__ __forceinline__ void naive_chunk(NaiveAcc& a, LDSP const float* qs, const bf16_t* krow, const bf16_t* vrow, bool valid) {
    float s = dot64(qs, krow);
    if (!valid) s = -INFINITY;
    const float mnew = fmaxf(a.m, wave_max(s));
    const float alpha = exp2f(a.m - mnew), p = valid ? exp2f(s - mnew) : 0.f;
    a.l = a.l * alpha + p; a.m = mnew;
    axpy64(a, alpha, p, vrow);
}
__device__ __forceinline__ float nacc_final(NaiveAcc& a, int lane) {
    const float l = wave_sum(a.l);
    const float inv = (l > 0.f) ? 1.0f / l : 0.f;
    const bool b5 = lane & 32, b4 = lane & 16, b3 = lane & 8, b2 = lane & 4, b1 = lane & 2, b0 = lane & 1;
    float q32[32], q16[16], q8[8], q4[4], q2[2];
#pragma unroll
    for (int i = 0; i < 32; ++i) { const float send = b5 ? a.o[i] : a.o[i + 32], keep = b5 ? a.o[i + 32] : a.o[i]; q32[i] = keep + __shfl_xor(send, 32); }
#pragma unroll
    for (int i = 0; i < 16; ++i) { const float send = b4 ? q32[i] : q32[i + 16], keep = b4 ? q32[i + 16] : q32[i]; q16[i] = keep + __shfl_xor(send, 16); }
#pragma unroll
    for (int i = 0; i < 8; ++i) { const float send = b3 ? q16[i] : q16[i + 8], keep = b3 ? q16[i + 8] : q16[i]; q8[i] = keep + __shfl_xor(send, 8); }
#pragma unroll
    for (int i = 0; i < 4; ++i) { const float send = b2 ? q8[i] : q8[i + 4], keep = b2 ? q8[i + 4] : q8[i]; q4[i] = keep + __shfl_xor(send, 4); }
#pragma unroll
    for (int i = 0; i < 2; ++i) { const float send = b1 ? q4[i] : q4[i + 2], keep = b1 ? q4[i + 2] : q4[i]; q2[i] = keep + __shfl_xor(send, 2); }
    const float send = b0 ? q2[0] : q2[1], keep = b0 ? q2[1] : q2[0];
    return (keep + __shfl_xor(send, 1)) * inv;
}
__device__ __forceinline__ float cmp_err(float ref, const bf16_t* got, int lane) {
    const float e = wave_max(fabsf(ref - bf2f(got[lane]))), mx = wave_max(fabsf(ref));
    return e / (mx + 1e-3f);
}
__device__ __forceinline__ void phase_selfcheck(const Params& P, LDSP unsigned char* lds, int vcu, int G) {
    unsigned char* ws = P.ws;
    const int tid = opaque_tid(), lane = tid & 63, wave = tid >> 6;
    const int gw = vcu * NWAVES + wave, NGW = G * NWAVES;
    unsigned* cnt = (unsigned*)(ws + OFF_CHK);
    const bf16_t* qa = (const bf16_t*)(ws + OFF_R1);
    const bf16_t* ka = (const bf16_t*)(ws + OFF_R1 + 32 * MiB);
    const bf16_t* va = (const bf16_t*)(ws + OFF_R1 + 64 * MiB);
    const bf16_t* qb = (const bf16_t*)(ws + OFF_R1 + 96 * MiB);
    const bf16_t* ya = (const bf16_t*)(ws + OFF_R0);
    const bf16_t* yb = (const bf16_t*)(ws + OFF_R0 + 32 * MiB);
    const float* kmean = (const float*)(ws + OFF_KMEAN);
    const float* bgate = (const float*)(ws + OFF_BGATE);
    LDSP float* psum = (LDSP float*)(lds + wave * 4096);
    LDSP float* qs = psum + 320;
    LDSP float* ocs = psum + 384;
    constexpr int NS = 537;
#pragma unroll 1
    for (int item = gw; item < NS * 8; item += NGW) {
        const int t = 37 + 61 * (item >> 3), h = item & 7, b = t >> 12, pos = t & (SEQ - 1), own = pos >> 8;
        qs[lane] = bf2f(qa[(size_t)t * 512 + h * 64 + lane]);
        asm volatile("s_waitcnt lgkmcnt(0)" ::: "memory");
        float g0 = -INFINITY, g1 = -INFINITY, g2 = -INFINITY; int i0 = -1, i1 = -1, i2 = -1;
#pragma unroll 1
        for (int j = 0; j < own; ++j) {
            const float* km = kmean + (size_t)((b * 8 + h) * 16 + j) * 64;
            float d = 0.f;
#pragma unroll 8
            for (int i = 0; i < 64; ++i) d += qs[i] * km[i];
            if (d > g0) { g2 = g1; i2 = i1; g1 = g0; i1 = i0; g0 = d; i0 = j; }
            else if (d > g1) { g2 = g1; i2 = i1; g1 = d; i1 = j; }
            else if (d > g2) { g2 = d; i2 = j; }
        }
        NaiveAcc a; nacc_reset(a);
#pragma unroll 1
        for (int j = 0; j <= own; ++j) {
            if (j < own && j != i0 && j != i1 && j != i2) continue;
#pragma unroll 1
            for (int ck = 0; ck < 4; ++ck) {
                const int kp = j * 256 + ck * 64 + lane;
                const size_t kr = (size_t)(b * SEQ + kp) * 512 + h * 64;
                naive_chunk(a, qs, ka + kr, va + kr, kp <= pos);
            }
        }
        const float om = nacc_final(a, lane);
        const float e = cmp_err(om, ya + (size_t)t * 512 + h * 64, lane);
        if (lane == 0 && !(e < 0.05f)) atomicAdd(cnt + 0, 1u);
        asm volatile("s_waitcnt lgkmcnt(0)" ::: "memory");
    }
#pragma unroll 1
    for (int item = gw; item < NS * 2; item += NGW) {
        const int t = 37 + 61 * (item >> 1), g = item & 1, b = t >> 12, pos = t & (SEQ - 1), own = pos >> 6;
        const bf16_t* kc = (const bf16_t*)(ws + OFF_KC) + (size_t)(b * 2 + g) * 256 * 64;
        const bf16_t* vc = (const bf16_t*)(ws + OFF_VC) + (size_t)(b * 2 + g) * 256 * 64;
        const bf16_t* ks = (const bf16_t*)(ws + OFF_R2 + 16 * MiB) + (size_t)(b * SEQ) * 128 + g * 64;
        const bf16_t* vs = (const bf16_t*)(ws + OFF_R2 + 24 * MiB) + (size_t)(b * SEQ) * 128 + g * 64;
        const bf16_t* kw = (const bf16_t*)(ws + OFF_R2 + 32 * MiB) + (size_t)(b * SEQ) * 128 + g * 64;
        const bf16_t* vw = (const bf16_t*)(ws + OFF_R2 + 40 * MiB) + (size_t)(b * SEQ) * 128 + g * 64;
        for (int i = lane; i < 320; i += 64) psum[i] = 0.f;
        asm volatile("s_waitcnt lgkmcnt(0)" ::: "memory");
        const int ncmp_vis = (pos >= 31) ? ((pos - 31) >> 4) + 1 : 0;
#pragma unroll 1
        for (int r = 0; r < 4; ++r) {
            qs[lane] = bf2f(qb[(size_t)t * 512 + (g * 4 + r) * 64 + lane]);
            asm volatile("s_waitcnt lgkmcnt(0)" ::: "memory");
            float mx = -INFINITY;
#pragma unroll 1
            for (int ck = 0; ck < 4; ++ck) { const int n = ck * 64 + lane;
                const float sdot = dot64(qs, kc + (size_t)n * 64);
                mx = fmaxf(mx, (n < ncmp_vis) ? sdot : -INFINITY); }
            mx = wave_max(mx);
            float l = 0.f;
#pragma unroll 1
            for (int ck = 0; ck < 4; ++ck) { const int n = ck * 64 + lane;
                const float sdot = dot64(qs, kc + (size_t)n * 64);
                l += (n < ncmp_vis) ? exp2f(sdot - mx) : 0.f; }
            l = wave_sum(l);
            const float inv = (l > 0.f) ? 1.0f / l : 0.f;
            NaiveAcc a; nacc_reset(a);
#pragma unroll 1
            for (int ck = 0; ck < 4; ++ck) { const int n = ck * 64 + lane;
                const float sdot = dot64(qs, kc + (size_t)n * 64);
                const float pr = (n < ncmp_vis) ? exp2f(sdot - mx) * inv : 0.f;
                psum[n] += pr;
                axpy64(a, 1.0f, pr, vc + (size_t)n * 64); }
            a.l = (lane == 0) ? 1.f : 0.f;
            ocs[r * 64 + lane] = nacc_final(a, lane);
            asm volatile("s_waitcnt lgkmcnt(0)" ::: "memory");
        }
        {
            const int j = lane;
            float imp = 0.f;
            for (int n = 4 * j - 1; n <= 4 * j + 3; ++n) if (n >= 0 && n < 255) imp += psum[n];
            if (j == 0 || j == own || j == own - 1) imp = 1.0e30f;
            if (j > own) imp = -1.0e30f;
            unsigned long long sel = 0ull;
#pragma unroll 1
            for (int r = 0; r < 16; ++r) {
                float v = imp; int i = j;
                wave_argmax(v, i);
                if (v > -0.5e30f) sel |= 1ull << i;
                if (i == j) imp = -3.0e38f;
            }
            psum[256] = __uint_as_float((unsigned)sel); psum[257] = __uint_as_float((unsigned)(sel >> 32));
            asm volatile("s_waitcnt lgkmcnt(0)" ::: "memory");
        }
        const unsigned long long sel = ((unsigned long long)__float_as_uint(psum[257]) << 32) | __float_as_uint(psum[256]);
#pragma unroll 1
        for (int r = 0; r < 4; ++r) {
            const int head = g * 4 + r;
            qs[lane] = bf2f(qb[(size_t)t * 512 + head * 64 + lane]);
            asm volatile("s_waitcnt lgkmcnt(0)" ::: "memory");
            const float gt0 = bgate[(size_t)t * 24 + head * 3], gt1 = bgate[(size_t)t * 24 + head * 3 + 1], gt2 = bgate[(size_t)t * 24 + head * 3 + 2];
            float y = gt0 * ocs[r * 64 + lane];
            NaiveAcc a; nacc_reset(a);
#pragma unroll 1
            for (int j = 0; j <= own; ++j) {
                if (!((sel >> j) & 1ull)) continue;
                const int kp = j * 64 + lane;
                naive_chunk(a, qs, ks + (size_t)kp * 128, vs + (size_t)kp * 128, kp <= pos);
            }
            y += gt1 * nacc_final(a, lane);
            nacc_reset(a);
#pragma unroll 1
            for (int ck = 0; ck < 9; ++ck) {
                const int kp = pos - 575 + ck * 64 + lane;
                const bool valid = kp >= 0 && kp <= pos && kp > pos - 512;
                const int kpc = kp < 0 ? 0 : kp;
                naive_chunk(a, qs, kw + (size_t)kpc * 128, vw + (size_t)kpc * 128, valid);
            }
            y += gt2 * nacc_final(a, lane);
            const float e = cmp_err(y, yb + (size_t)t * 512 + head * 64, lane);
            if (lane == 0 && !(e < 0.05f)) atomicAdd(cnt + 1, 1u);
            asm volatile("s_waitcnt lgkmcnt(0)" ::: "memory");
        }
    }
}

__device__ __forceinline__ void phase_selfcheck2(const Params& P, LDSP unsigned char* lds, int vcu, int G) {
    unsigned char* ws = P.ws;
    const int tid = opaque_tid(), lane = tid & 63, wave = tid >> 6;
    const int gw = vcu * NWAVES + wave, NGW = G * NWAVES;
    unsigned* cnt = (unsigned*)(ws + OFF_CHK);
    LDSP float* hs = (LDSP float*)(lds + wave * 8192);
    const float* x = P.in[I_X]; const float* g1 = P.in[I_NORM1]; const float* w = P.in[I_WIN];
    constexpr int NS = 192, NGRP = 14;
#pragma unroll 1
    for (int item = gw; item < NS * NGRP; item += NGW) {
        const int si = item / NGRP, grp = item % NGRP;
        const int t = 11 + 167 * si, b = t >> 12, pos = t & (SEQ - 1);
        const int hsel = si & 7, gsel = si & 1;
        float ss = 0.f;
        for (int i = lane; i < DM; i += 64) { const float v = x[(size_t)t * DM + i]; ss += v * v; }
        ss = wave_sum(ss);
        const float rs = 1.0f / sqrtf(ss / DM + NORM_EPS);
        for (int i = lane; i < DM; i += 64) hs[i] = x[(size_t)t * DM + i] * rs * g1[i];
        asm volatile("s_waitcnt lgkmcnt(0)" ::: "memory");
        int col0, kind; const float* gain = nullptr; float oscale = 1.f; const bf16_t* got = nullptr; int ncols = 64;
        const bf16_t* R1 = (const bf16_t*)(ws + OFF_R1); const bf16_t* R2 = (const bf16_t*)(ws + OFF_R2); const bf16_t* R3 = (const bf16_t*)(ws + OFF_R3);
        const size_t M32 = (size_t)16 * 1024 * 1024;
        switch (grp) {
        case 0: col0 = hsel * 64;          kind = 1; gain = P.in[I_AQG]; oscale = QSCALE; got = R1 + (size_t)t * 512 + hsel * 64; break;
        case 1: col0 = 512 + hsel * 64;    kind = 1; gain = P.in[I_AKG]; got = R1 + M32 + (size_t)t * 512 + hsel * 64; break;
        case 2: col0 = 1024 + hsel * 64;   kind = 0; got = R1 + 2 * M32 + (size_t)t * 512 + hsel * 64; break;
        case 3: col0 = 1536 + hsel * 64;   kind = 1; gain = P.in[I_BQG]; oscale = QSCALE; got = R1 + 3 * M32 + (size_t)t * 512 + hsel * 64; break;
        case 4: col0 = 2048 + gsel * 64;   kind = 0; got = R2 + ((size_t)((b * 2 + gsel) * SEQ + pos)) * 64; break;
        case 5: col0 = 2176 + gsel * 64;   kind = 0; got = R2 + M32 / 4 + ((size_t)((b * 2 + gsel) * SEQ + pos)) * 64; break;
        case 6: col0 = 2304 + gsel * 64;   kind = 1; gain = P.in[I_BKSG]; got = R2 + 2 * (M32 / 4) + (size_t)t * 128 + gsel * 64; break;
        case 7: col0 = 2432 + gsel * 64;   kind = 0; got = R2 + 3 * (M32 / 4) + (size_t)t * 128 + gsel * 64; break;
        case 8: col0 = 2560 + gsel * 64;   kind = 1; gain = P.in[I_BKWG]; got = R2 + 4 * (M32 / 4) + (size_t)t * 128 + gsel * 64; break;
        case 9: col0 = 2688 + gsel * 64;   kind = 0; got = R2 + 5 * (M32 / 4) + (size_t)t * 128 + gsel * 64; break;
        case 10: col0 = 2840 + hsel * 64;        kind = 2; got = R3 + (size_t)t * 2048 + hsel * 64; break;
        case 11: col0 = 2840 + 1024 + hsel * 64; kind = 2; got = R3 + (size_t)t * 2048 + 1024 + hsel * 64; break;
        case 12: col0 = 2840 + 1024 + 512 + hsel * 64; kind = 2; got = R3 + (size_t)t * 2048 + 1536 + hsel * 64; break;
        default: col0 = 2816; kind = 3; ncols = 24; break;
        }
        if (grp == 10) continue;
        float acc = 0.f;
        if (lane < ncols) {
#pragma unroll 4
            for (int k = 0; k < DM; ++k) acc += hs[k] * w[(size_t)k * 4888 + col0 + lane];
        }
        float ref;
        if (kind == 1) {
            const float ssq = wave_sum(acc * acc);
            float y = acc / sqrtf(ssq / 64.0f + NORM_EPS) * gain[lane];
            const float ya_ = __shfl(y, (lane + 8) & 63), yb_ = __shfl(y, (lane - 8) & 63);
            const int f = lane & 7;
            const float ang = (float)pos * powf(500000.0f, -(float)(2 * f) / 16.0f);
            const float c = cosf(ang), sn = sinf(ang);
            if (lane < 8) y = y * c - ya_ * sn; else if (lane < 16) y = y * c + yb_ * sn;
            ref = y * oscale;
        } else if (kind == 2) {
            ref = 1.0f / (1.0f + expf(-(acc + P.in[I_BMERGE][col0 - 2840 + lane])));
        } else if (kind == 3) {
            ref = 1.0f / (1.0f + expf(-acc));
        } else ref = acc;
        float gotv;
        if (kind == 3) gotv = (lane < 24) ? ((const float*)(ws + OFF_BGATE))[(size_t)t * 24 + lane] : 0.f;
        else gotv = bf2f(got[lane]);
        if (kind == 3 && lane >= 24) ref = 0.f;
        const float e = wave_max(fabsf(ref - gotv)) / (wave_max(fabsf(ref)) + 1e-3f);
        if (lane == 0 && !(e < 0.03f)) atomicAdd(cnt + 0, 1u);
        asm volatile("s_waitcnt lgkmcnt(0)" ::: "memory");
    }
#pragma unroll 1
    for (int item = gw; item < 1024; item += NGW) {
        const int b = item >> 7, h = (item >> 4) & 7, blk = item & 15;
        const bf16_t* p = (const bf16_t*)(ws + OFF_R1 + 32 * MiB) + (size_t)(b * SEQ + blk * 256) * 512 + h * 64 + lane;
        float sref = 0.f;
        for (int k = 0; k < 256; ++k) sref += bf2f(p[(size_t)k * 512]);
        const float gotv = ((const float*)(ws + OFF_KMEAN))[(size_t)item * 64 + lane];
        const float e = wave_max(fabsf(sref - gotv)) / (wave_max(fabsf(sref)) + 1e-2f);
        if (lane == 0 && !(e < 0.03f)) atomicAdd(cnt + 1, 1u);
    }
#pragma unroll 1
    for (int item = gw; item < 96 * 2; item += NGW) {
        const int si = item >> 1, kv = item & 1;
        const int slab = si & 15, n = (si * 37 + 3) % 255;
        const bf16_t* raw = (const bf16_t*)(ws + OFF_R2 + (size_t)kv * 8 * MiB) + (size_t)slab * SEQ * 64 + (size_t)n * 16 * 64;
        const float* posv = P.in[kv ? I_CPV : I_CPK]; const float* w1 = P.in[kv ? I_CVW1 : I_CKW1]; const float* b1 = P.in[kv ? I_CVB1 : I_CKB1];
        const float* w2 = P.in[kv ? I_CVW2 : I_CKW2]; const float* b2 = P.in[kv ? I_CVB2 : I_CKB2];
        float hacc[4] = {0.f, 0.f, 0.f, 0.f};
#pragma unroll 1
        for (int i = 0; i < 2048; ++i) {
            const float a = bf2f(raw[i]) + posv[i];
#pragma unroll
            for (int u = 0; u < 4; ++u) hacc[u] += a * w1[(size_t)i * 256 + lane + 64 * u];
        }
#pragma unroll
        for (int u = 0; u < 4; ++u) { const float z = hacc[u] + b1[lane + 64 * u]; hs[1024 + lane + 64 * u] = 0.5f * z * (1.0f + tanhf(0.7978845608028654f * (z + 0.044715f * z * z * z))); }
        asm volatile("s_waitcnt lgkmcnt(0)" ::: "memory");
        float o = b2[lane];
#pragma unroll 4
        for (int j = 0; j < 256; ++j) o += hs[1024 + j] * w2[(size_t)j * 64 + lane];
        if (!kv) { const float ssq = wave_sum(o * o); o = o / sqrtf(ssq / 64.0f + NORM_EPS) * P.in[I_BKCG][lane]; }
        const float gotv = bf2f(((const bf16_t*)(ws + (kv ? OFF_VC : OFF_KC)))[((size_t)slab * 256 + n) * 64 + lane]);
        const float e = wave_max(fabsf(o - gotv)) / (wave_max(fabsf(o)) + 1e-3f);
        if (lane == 0 && !(e < 0.03f)) atomicAdd(cnt + 1, 1u);
        asm volatile("s_waitcnt lgkmcnt(0)" ::: "memory");
    }
}
#endif

#define XB_TMO      128
#define XB_XCNT(j)  (256  + 64 * (j))
#define XB_XSUB(j)  (1280 + 64 * (j))
#define XB_XGEN(j)  (2304 + 64 * (j))
#define XB_TOP      3328
#define XB_TOPGEN   3392
#define XCD_BAR_WORDS 3456
#define XB_SPIN_CAP (1u << 22)
__device__ __forceinline__ unsigned xb_ld(unsigned* p)              { return __hip_atomic_load(p, __ATOMIC_RELAXED, __HIP_MEMORY_SCOPE_AGENT); }
__device__ __forceinline__ unsigned xb_add(unsigned* p, unsigned v) { return __hip_atomic_fetch_add(p, v, __ATOMIC_RELAXED, __HIP_MEMORY_SCOPE_AGENT); }
__device__ __forceinline__ unsigned xb_xcc_id() { return (unsigned)__builtin_amdgcn_s_getreg((3 << 11) | 20) & 0xFu; }
#define XB_SPIN(cond, bar) do { unsigned _sp = 0; while (cond) { __builtin_amdgcn_s_sleep(1); \
    if ((++_sp & 255u) == 0u) { if (xb_ld(&(bar)[XB_TMO])) break; if (_sp > XB_SPIN_CAP) { atomicAdd(&(bar)[XB_TMO], 1u); break; } } } } while (0)
struct XcdBarrier { unsigned* bar; unsigned x; volatile LDSP unsigned* st; };
__device__ __forceinline__ XcdBarrier xcd_barrier_post(unsigned* bar, volatile LDSP unsigned* st) {
    XcdBarrier b; b.bar = bar; b.x = xb_xcc_id(); b.st = st;
    if (threadIdx.x == 0) (void)xb_add(&bar[XB_XCNT(b.x)], 1u);
    return b;
}
__device__ __forceinline__ void xcd_barrier_complete(unsigned* bar, unsigned x, unsigned& nloc, unsigned& nx) {
    const unsigned G = gridDim.x * gridDim.y * gridDim.z;
    unsigned sum, cnt, mine, sp = 0u;
    for (;;) {
        sum = 0u; cnt = 0u; mine = 0u;
#pragma unroll
        for (unsigned j = 0; j < 16; ++j) { const unsigned c = xb_ld(&bar[XB_XCNT(j)]); sum += c; cnt += (c > 0u) ? 1u : 0u; mine = (j == x) ? c : mine; }
        if (sum == G) break;
        __builtin_amdgcn_s_sleep(1);
        if ((++sp & 255u) == 0u) { if (xb_ld(&bar[XB_TMO])) break; if (sp > XB_SPIN_CAP) { atomicAdd(&bar[XB_TMO], 1u); break; } }
    }
    nloc = mine > 0u ? mine : 1u; nx = cnt > 0u ? cnt : 1u;
}
__device__ __forceinline__ void xcd_barrier(const XcdBarrier& b) {
    asm volatile("s_waitcnt vmcnt(0)" ::: "memory");
    __syncthreads();
    if (threadIdx.x == 0) {
        unsigned* bar = b.bar;
        __builtin_amdgcn_s_waitcnt(0);
        unsigned nloc = b.st[0], nx = b.st[1];
        if (nloc == 0u) { xcd_barrier_complete(bar, b.x, nloc, nx); b.st[0] = nloc; b.st[1] = nx; }
        const unsigned old = xb_add(&bar[XB_XSUB(b.x)], 1u);
        const unsigned gen = old / nloc;
        if (old + 1u == (gen + 1u) * nloc) {
            __builtin_amdgcn_fence(__ATOMIC_RELEASE, "agent");
            asm volatile("s_waitcnt vmcnt(0)" ::: "memory");
            const unsigned og = xb_add(&bar[XB_TOP], 1u);
            const unsigned tg = og / nx;
            if (og + 1u == (tg + 1u) * nx) xb_add(&bar[XB_TOPGEN], 1u);
            else XB_SPIN(xb_ld(&bar[XB_TOPGEN]) == tg, bar);
            __builtin_amdgcn_fence(__ATOMIC_ACQUIRE, "agent");
            xb_add(&bar[XB_XGEN(b.x)], 1u);
            asm volatile("s_waitcnt vmcnt(0)" ::: "memory");
        } else {
            XB_SPIN(xb_ld(&bar[XB_XGEN(b.x)]) == gen, bar);
            __builtin_amdgcn_fence(__ATOMIC_ACQUIRE, "agent");
            asm volatile("s_waitcnt vmcnt(0)" ::: "memory");
        }
    }
    __syncthreads();
}

__global__ void __launch_bounds__(NTHREADS, 2) fwd_kernel(Params P) {
    extern __shared__ __attribute__((aligned(16))) unsigned char lds_raw[];
    LDSP unsigned char* lds = (LDSP unsigned char*)lds_raw;
    const int G = gridDim.x, bx = blockIdx.x;
    const int vcu = (G % 8 == 0) ? (bx % 8) * (G / 8) + bx / 8 : bx;
    const int lo = P.ph_lo, hi = P.ph_hi;
    volatile LDSP unsigned* bst = (volatile LDSP unsigned*)(lds + LDS_BYTES - 16);
    if (threadIdx.x == 0) { bst[0] = 0u; bst[1] = 0u; bst[2] = 0u; bst[3] = 0u; }
    __syncthreads();
    const XcdBarrier xbar = xcd_barrier_post((unsigned*)(P.ws + 16384), bst);
    if (threadIdx.x == 0) bst[2] = xb_add((unsigned*)(P.ws + 32768) + 64 * xbar.x, 1u);
#define IN(k) (lo <= (k) && (k) < hi)
#define SEAM(k) do { if (IN(k) && IN((k) + 1)) xcd_barrier(xbar); } while (0)
    if (IN(0)) phase_prep(P, lds, vcu, G);
    SEAM(0);
    if (IN(1)) phase_proj(P, lds, vcu, G);
    SEAM(1);
    if (IN(2)) phase_cmp(P, lds, vcu, G);
    SEAM(2);
    if (IN(4)) phase_attn(P, lds, vcu, G);
    SEAM(4);
#if SELFCHECK == 1
    phase_selfcheck(P, lds, vcu, G);
    xcd_barrier(xbar);
#elif SELFCHECK == 2
    phase_selfcheck2(P, lds, vcu, G);
    xcd_barrier(xbar);
#endif
    if (IN(5)) phase_up(P, lds, vcu, G);
    SEAM(5);
    if (IN(6)) phase_out(P, lds, vcu, G);
    SEAM(6);
    if (IN(7)) phase_pq(P, lds, vcu, G);
    SEAM(7);
    if (IN(8)) phase_topk(P, lds, vcu, G);
    SEAM(8);
    if (IN(9)) { phase_peer_a(P, lds, vcu, G); xcd_barrier(xbar); phase_peer_w(P, lds, vcu, G); xcd_barrier(xbar); phase_peer_b(P, lds, vcu, G); }
#if SELFCHECK
    xcd_barrier(xbar);
    if (bx == 0 && threadIdx.x == 0) {
        const unsigned* cnt = (const unsigned*)(P.ws + OFF_CHK);
        P.out[0] += 1000.0f * (float)cnt[0];
        P.out[1] += 1000000.0f * (float)cnt[1];
    }
#endif
#undef IN
#undef SEAM
}

extern "C" void kernel_launch(void* const* d_in, const int* in_sizes, int n_in, void* d_out, int out_size, void* d_ws, size_t ws_size, hipStream_t stream) {
    static int grid = 0;
    if (grid == 0) {
        if (n_in != 29 || ws_size < WS_END) { fprintf(stderr, "kernel_launch: unexpected n_in %d / ws_size %zu\n", n_in, ws_size); grid = -1; return; }
        int dev = 0, cus = 0, per_cu = 0;
        (void)hipGetDevice(&dev);
        (void)hipDeviceGetAttribute(&cus, hipDeviceAttributeMultiprocessorCount, dev);
        (void)hipFuncSetAttribute((const void*)fwd_kernel, hipFuncAttributeMaxDynamicSharedMemorySize, LDS_BYTES);
        (void)hipOccupancyMaxActiveBlocksPerMultiprocessor(&per_cu, (const void*)fwd_kernel, NTHREADS, LDS_BYTES);
        if (per_cu < 1) { fprintf(stderr, "kernel_launch: occupancy query says %d blocks per CU\n", per_cu); grid = -1; return; }
        grid = cus;
    }
    if (grid < 0) return;
    Params p{};
    for (int i = 0; i < 29; ++i) p.in[i] = (const float*)d_in[i];
    p.out = (float*)d_out; p.ws = (unsigned char*)d_ws;
    (void)hipMemsetAsync(d_ws, 0, 65536, stream);
    p.ph_lo = 0; p.ph_hi = 10;
    hipLaunchKernelGGL(fwd_kernel, dim3(grid), dim3(NTHREADS), LDS_BYTES, stream, p);
}
```

```cpp
#include <hip/hip_runtime.h>
#include <hip/hip_cooperative_groups.h>
#include <stdint.h>
#include <stdio.h>
#define SELFCHECK 0
namespace cg = cooperative_groups;

#define LDSP __attribute__((address_space(3)))
typedef unsigned short bf16_t;
typedef short bf16x8 __attribute__((ext_vector_type(8)));
typedef short s16x4 __attribute__((ext_vector_type(4)));
typedef float f32x2 __attribute__((ext_vector_type(2)));
typedef float f32x4 __attribute__((ext_vector_type(4)));
typedef float f32x16 __attribute__((ext_vector_type(16)));
typedef unsigned u32x2 __attribute__((ext_vector_type(2)));
typedef unsigned u32x4 __attribute__((ext_vector_type(4)));
typedef __bf16 bf16x2_t __attribute__((ext_vector_type(2)));

constexpr int BATCH = 8, SEQ = 4096, DM = 1024, T = BATCH * SEQ;
constexpr int HD = 64;
constexpr int NPROJ = 5120;
constexpr int PEER_NE = 16384;
constexpr float NORM_EPS = 1e-6f;
constexpr float QSCALE = 0.125f * 1.4426950408889634f;
constexpr int NTHREADS = 512, NWAVES = 8;
constexpr int LDS_BYTES = 140 * 1024;

constexpr size_t MiB = 1u << 20;
constexpr size_t OFF_RS1 = 1 * MiB;
constexpr size_t OFF_RS2 = 1 * MiB + 256 * 1024;
constexpr size_t OFF_ROPE_C = 2 * MiB;
constexpr size_t OFF_ROPE_S = 2 * MiB + 128 * 1024;
constexpr size_t OFF_POSB = 2 * MiB + 512 * 1024;
constexpr size_t OFF_KMEAN = 3 * MiB;
constexpr size_t OFF_BGATE = 4 * MiB;
constexpr size_t OFF_WIN_T = 8 * MiB;
constexpr size_t OFF_WUPA_T = 19 * MiB;
constexpr size_t OFF_WUPB_T = 20 * MiB;
constexpr size_t OFF_WOUT_T = 21 * MiB;
constexpr size_t OFF_WPQ_T = 23 * MiB;
constexpr size_t OFF_W1K_T = 27 * MiB;
constexpr size_t OFF_W1V_T = 28 * MiB;
constexpr size_t OFF_W2K_T = 29 * MiB;
constexpr size_t OFF_W2V_T = 29 * MiB + 128 * 1024;
constexpr size_t OFF_K1B = 29 * MiB + 256 * 1024;
constexpr size_t OFF_K2B = 29 * MiB + 320 * 1024;
constexpr size_t OFF_HID = 30 * MiB;
constexpr size_t OFF_KC = 34 * MiB;
constexpr size_t OFF_VC = 35 * MiB;
constexpr size_t OFF_EXPERTS = 36 * MiB;
constexpr size_t OFF_GATES = 52 * MiB;
constexpr size_t OFF_U = 68 * MiB;
constexpr size_t OFF_PSCALE = 84 * MiB;
constexpr size_t OFF_V = 100 * MiB;
constexpr size_t OFF_R0 = 132 * MiB;
constexpr size_t OFF_R1 = 196 * MiB;
constexpr size_t OFF_R2 = 324 * MiB;
constexpr size_t OFF_R3 = 372 * MiB;
constexpr size_t WS_END = 500 * MiB;

struct Params {
    const float* in[29];
    float* out;
    unsigned char* ws;
    int ph_lo, ph_hi;
};
static_assert(sizeof(Params) == 31 * 8 + 8, "Params has no padding");

enum { I_X = 0, I_NORM1, I_WIN, I_BMERGE, I_AQG, I_AKG, I_BQG, I_BKCG, I_BKSG, I_BKWG,
       I_CPK, I_CKW1, I_CKB1, I_CKW2, I_CKB2, I_CPV, I_CVW1, I_CVB1, I_CVW2, I_CVB2,
       I_WUPA, I_WUPB, I_WOUT, I_NORM2, I_PWQ, I_PK1, I_PK2, I_PU, I_PV };

__device__ __forceinline__ int opaque_tid() { int t = threadIdx.x; asm volatile("" : "+v"(t)); return t; }
__device__ __forceinline__ unsigned pk2(float lo, float hi) {
    f32x2 v = {lo, hi};
    bf16x2_t b = __builtin_convertvector(v, bf16x2_t);
    return __builtin_bit_cast(unsigned, b);
}
__device__ __forceinline__ float bf2f(bf16_t b) { return __uint_as_float(((unsigned)b) << 16); }
__device__ __forceinline__ float wave_sum(float v) {
#pragma unroll
    for (int o = 1; o < 64; o <<= 1) v += __shfl_xor(v, o);
    return v;
}
__device__ __forceinline__ float gelu_tanh(float x) {
    const float u = 0.7978845608028654f * (x + 0.044715f * x * x * x);
    return x / (1.0f + __expf(-2.0f * u));
}
__device__ __forceinline__ float sigmoidf_(float x) { return 1.0f / (1.0f + __expf(-x)); }
__device__ __forceinline__ void cvt8(const u32x4 w, float (&f)[8]) {
    f[0] = __uint_as_float(w.x << 16); f[1] = __uint_as_float(w.x & 0xffff0000u); f[2] = __uint_as_float(w.y << 16); f[3] = __uint_as_float(w.y & 0xffff0000u);
    f[4] = __uint_as_float(w.z << 16); f[5] = __uint_as_float(w.z & 0xffff0000u); f[6] = __uint_as_float(w.w << 16); f[7] = __uint_as_float(w.w & 0xffff0000u);
}
__device__ __forceinline__ int swz_off(int row, int chunk) { return row * 128 + ((chunk ^ ((row >> 1) & 7)) << 4); }

__device__ __forceinline__ void transpose_item(const float* W, int ldw, int k0, int src_c0, int nvalid, const float* kscale,
                                               bf16_t* WT, int ldwt, int n0, LDSP float* scr, int lane) {
#pragma unroll 8
    for (int i = 0; i < 32; ++i) {
        const int kk = 2 * i + (lane >> 5), nn = lane & 31;
        float v = 0.f;
        if (nn < nvalid) v = W[(size_t)(k0 + kk) * ldw + src_c0 + nn];
        if (kscale) v *= kscale[k0 + kk];
        scr[kk * 33 + nn] = v;
    }
    asm volatile("s_waitcnt lgkmcnt(0)" ::: "memory");
    const int c = lane & 7;
#pragma unroll
    for (int j = 0; j < 4; ++j) {
        const int n = (lane >> 3) + 8 * j;
        const LDSP float* s = scr + (8 * c) * 33 + n;
        u32x4 o;
        o.x = pk2(s[0 * 33], s[1 * 33]); o.y = pk2(s[2 * 33], s[3 * 33]); o.z = pk2(s[4 * 33], s[5 * 33]); o.w = pk2(s[6 * 33], s[7 * 33]);
        *(u32x4*)(WT + (size_t)(n0 + n) * ldwt + k0 + 8 * c) = o;
    }
    asm volatile("s_waitcnt lgkmcnt(0)" ::: "memory");
}

struct TrJob { const float* W; int K, N, ldw; const float* kscale; bf16_t* WT; int kind; };

__device__ __forceinline__ void run_tr_job(const TrJob& J, int item, LDSP float* scr, int lane) {
    const int nblk = J.N / 32, kb = item / nblk, nb = item % nblk;
    int src_c0 = nb * 32, nvalid = 32;
    if (J.kind == 1) {
        const int p0 = nb * 32, pn = p0 >> 8, q = p0 & 255, bj = q >> 7, wc = (q >> 5) & 3, H = 4 * pn + wc, d0 = 32 * bj;
        if (H < 44) src_c0 = 64 * H + d0;
        else if (H < 76) src_c0 = 64 * H + d0 + 24;
        else if (H == 76 && bj == 0) { src_c0 = 2816; nvalid = 24; }
        else { src_c0 = 0; nvalid = 0; }
    } else if (J.kind == 2) {
        if (nb * 32 >= 64) { src_c0 = 0; nvalid = 0; }
    }
    transpose_item(J.W, J.ldw, kb * 64, src_c0, nvalid, J.kscale, J.WT, J.K, nb * 32, scr, lane);
}

__device__ __forceinline__ void phase_prep(const Params& P, LDSP unsigned char* lds, int vcu, int G) {
    const int tid = opaque_tid(), lane = tid & 63, wave = tid >> 6;
    const int gw = vcu * NWAVES + wave, NGW = G * NWAVES;
    unsigned char* ws = P.ws;
    LDSP float* scr = (LDSP float*)(lds + wave * 8704);
    int base = 0;
#define TR_JOB(Wp, Kk, Nn, LDW, KS, WTp, KIND) do { TrJob J{Wp, Kk, Nn, LDW, KS, WTp, KIND}; const int nitems = ((Kk) / 64) * ((Nn) / 32); \
        const int first = (gw - base % NGW + NGW) % NGW; for (int it = first; it < nitems; it += NGW) run_tr_job(J, it, scr, lane); base += nitems; } while (0)
    TR_JOB(P.in[I_WIN], 1024, NPROJ, 4888, P.in[I_NORM1], (bf16_t*)(ws + OFF_WIN_T), 1);
    TR_JOB(P.in[I_WUPA], 512, 1024, 1024, nullptr, (bf16_t*)(ws + OFF_WUPA_T), 0);
    TR_JOB(P.in[I_WUPB], 512, 1024, 1024, nullptr, (bf16_t*)(ws + OFF_WUPB_T), 0);
    TR_JOB(P.in[I_WOUT], 1024, 1024, 1024, nullptr, (bf16_t*)(ws + OFF_WOUT_T), 0);
    TR_JOB(P.in[I_PWQ], 1024, 2048, 2048, P.in[I_NORM2], (bf16_t*)(ws + OFF_WPQ_T), 0);
    TR_JOB(P.in[I_CKW1], 2048, 256, 256, nullptr, (bf16_t*)(ws + OFF_W1K_T), 0);
    TR_JOB(P.in[I_CVW1], 2048, 256, 256, nullptr, (bf16_t*)(ws + OFF_W1V_T), 0);
    TR_JOB(P.in[I_CKW2], 256, 128, 64, nullptr, (bf16_t*)(ws + OFF_W2K_T), 2);
    TR_JOB(P.in[I_CVW2], 256, 128, 64, nullptr, (bf16_t*)(ws + OFF_W2V_T), 2);
#undef TR_JOB
    {
        const float* x = P.in[I_X];
        bf16_t* xb = (bf16_t*)(ws + OFF_R0);
        float* rs1 = (float*)(ws + OFF_RS1);
#pragma unroll 4
        for (int m = gw; m < T; m += NGW) {
            const f32x4* xr = (const f32x4*)(x + (size_t)m * DM) + lane;
            f32x4 v[4]; float s = 0.f;
#pragma unroll
            for (int j = 0; j < 4; ++j) { v[j] = xr[64 * j]; s += (v[j].x * v[j].x + v[j].y * v[j].y) + (v[j].z * v[j].z + v[j].w * v[j].w); }
            s = wave_sum(s);
            if (lane == 0) rs1[m] = 1.0f / sqrtf(s * (1.0f / DM) + NORM_EPS);
            u32x2* o = (u32x2*)(xb + (size_t)m * DM) + lane;
#pragma unroll
            for (int j = 0; j < 4; ++j) { u32x2 w; w.x = pk2(v[j].x, v[j].y); w.y = pk2(v[j].z, v[j].w); o[64 * j] = w; }
        }
    }
    {
        const float* g2 = P.in[I_NORM2];
        f32x4 g4[4];
#pragma unroll
        for (int q = 0; q < 4; ++q) g4[q] = *(const f32x4*)(g2 + 256 * q + 4 * lane);
        float* scales = (float*)(ws + OFF_PSCALE);
#pragma unroll 4
        for (int r = gw; r < 2 * PEER_NE; r += NGW) {
            const int which = (r >= PEER_NE) ? 1 : 0, e = r & (PEER_NE - 1);
            const float* src = P.in[which ? I_PV : I_PU] + (size_t)e * DM + 4 * lane;
            f32x4 a[4]; float ss = 0.f;
#pragma unroll
            for (int q = 0; q < 4; ++q) { a[q] = *(const f32x4*)(src + 256 * q); if (!which) a[q] = a[q] * g4[q];
                ss += (a[q].x * a[q].x + a[q].y * a[q].y) + (a[q].z * a[q].z + a[q].w * a[q].w); }
            ss = wave_sum(ss);
            const float rms = sqrtf(ss * (1.0f / DM)), sc = (rms > 0.f) ? 0.5f * rms : 1.0f, inv = 1.0f / sc;
            unsigned char* dst = ws + (which ? OFF_V : OFF_U) + (size_t)e * 128 + 2 * lane;
#pragma unroll
            for (int q = 0; q < 4; ++q) {
                unsigned pq = 0;
                pq = __builtin_amdgcn_cvt_scalef32_pk_fp4_f32(pq, a[q].x * inv, a[q].y * inv, 1.0f, 0);
                pq = __builtin_amdgcn_cvt_scalef32_pk_fp4_f32(pq, a[q].z * inv, a[q].w * inv, 1.0f, 1);
                *(unsigned short*)(dst + (size_t)q * PEER_NE * 128) = (unsigned short)pq;
            }
            if (lane == 0) scales[r] = sc;
        }
    }
    {
        const int gt = gw * 64 + lane, NGT = NGW * 64;
        for (int i = gt; i < 2 * 128 * 128; i += NGT) {
            const int w = i >> 14, e = i & 16383;
            const float v = P.in[w ? I_PK2 : I_PK1][e];
            ((bf16_t*)(ws + (w ? OFF_K2B : OFF_K1B)))[e] = (bf16_t)(pk2(v, 0.f) & 0xffff);
        }
        if (gt < 8) ((float*)(ws + OFF_ROPE_C))[gt] = powf(500000.0f, -(float)(2 * gt) / 16.0f) * 0.15915494309189535f;
        for (int i = gt; i < T; i += NGT) ((float*)(ws + OFF_RS2))[i] = 0.f;
        for (int i = gt; i < 8 * 8 * 16 * 64; i += NGT) ((float*)(ws + OFF_KMEAN))[i] = 0.f;
        if (gt < 2) ((unsigned*)(ws + 512 * 1024))[gt] = 0u;
        for (int o = gw; o < 512; o += NGW) {
            const int w = o >> 8, j = o & 255;
            const float* pos = P.in[w ? I_CPV : I_CPK];
            const float* w1 = P.in[w ? I_CVW1 : I_CKW1];
            float s = 0.f;
            for (int i = lane; i < 2048; i += 64) s += pos[i] * w1[(size_t)i * 256 + j];
            s = wave_sum(s);
            if (lane == 0) ((float*)(ws + OFF_POSB))[o] = s + P.in[w ? I_CVB1 : I_CKB1][j];
        }
    }
}

constexpr int G_BM = 256, G_BN = 128, G_BK = 64;
constexpr int G_ABYTES = G_BM * 128, G_BBYTES = G_BN * 128, G_STAGE = G_ABYTES + G_BBYTES;

__device__ __forceinline__ void gemm_kloop(f32x4 (&acc)[4][4], const bf16_t* A, size_t lda, const bf16_t* Bt, size_t ldb, int K, LDSP unsigned char* lds) {
    const int tid = opaque_tid(), lane = tid & 63, wid = tid >> 6, wm = wid >> 1, wn = wid & 1, fr = lane & 15, fq = lane >> 4;
    const int lrow = tid >> 3, lch = tid & 7;
    const bf16_t* ga = A + (size_t)lrow * lda + lch * 8;
    const bf16_t* gb = Bt + (size_t)lrow * ldb + lch * 8;
    u32x4 ra[4], rb[2];
    const int nk = K / G_BK;
#pragma unroll
    for (int p = 0; p < 4; ++p) ra[p] = *(const u32x4*)(ga + (size_t)(64 * p) * lda);
#pragma unroll
    for (int p = 0; p < 2; ++p) rb[p] = *(const u32x4*)(gb + (size_t)(64 * p) * ldb);
    __syncthreads();
#pragma unroll
    for (int p = 0; p < 4; ++p) *(LDSP u32x4*)(lds + swz_off(lrow + 64 * p, lch)) = ra[p];
#pragma unroll
    for (int p = 0; p < 2; ++p) *(LDSP u32x4*)(lds + G_ABYTES + swz_off(lrow + 64 * p, lch)) = rb[p];
    __syncthreads();
    for (int kt = 0; kt < nk; ++kt) {
        LDSP unsigned char* cur = lds + (kt & 1) * G_STAGE;
        LDSP unsigned char* nxt = lds + ((kt + 1) & 1) * G_STAGE;
        if (kt + 1 < nk) {
#pragma unroll
            for (int p = 0; p < 4; ++p) ra[p] = *(const u32x4*)(ga + (size_t)(64 * p) * lda + (kt + 1) * G_BK);
#pragma unroll
            for (int p = 0; p < 2; ++p) rb[p] = *(const u32x4*)(gb + (size_t)(64 * p) * ldb + (kt + 1) * G_BK);
        }
#pragma unroll
        for (int ks = 0; ks < 2; ++ks) {
            bf16x8 af[4], bfr[4];
#pragma unroll
            for (int m = 0; m < 4; ++m) af[m] = *(const LDSP bf16x8*)(cur + swz_off(wm * 64 + m * 16 + fr, ks * 4 + fq));
#pragma unroll
            for (int n = 0; n < 4; ++n) bfr[n] = *(const LDSP bf16x8*)(cur + G_ABYTES + swz_off(wn * 64 + n * 16 + fr, ks * 4 + fq));
#pragma unroll
            for (int m = 0; m < 4; ++m)
#pragma unroll
                for (int n = 0; n < 4; ++n) acc[m][n] = __builtin_amdgcn_mfma_f32_16x16x32_bf16(bfr[n], af[m], acc[m][n], 0, 0, 0);
        }
        if (kt + 1 < nk) {
#pragma unroll
            for (int p = 0; p < 4; ++p) *(LDSP u32x4*)(nxt + swz_off(lrow + 64 * p, lch)) = ra[p];
#pragma unroll
            for (int p = 0; p < 2; ++p) *(LDSP u32x4*)(nxt + G_ABYTES + swz_off(lrow + 64 * p, lch)) = rb[p];
        }
        __syncthreads();
    }
}

__device__ __forceinline__ void zero_acc(f32x4 (&acc)[4][4]) {
#pragma unroll
    for (int m = 0; m < 4; ++m)
#pragma unroll
        for (int n = 0; n < 4; ++n) acc[m][n] = (f32x4){0.f, 0.f, 0.f, 0.f};
}

__device__ __forceinline__ bool tile_order(int it, int vcu, int G, int nM, int nN, int& tm, int& tn) {
    if (G == 256 && (nM % 32) == 0) {
        const int xcd = vcu >> 5, cu = vcu & 31, mper = nM / 8;
        const int L = it * 32 + cu, per_group = 4 * nN;
        if (L >= mper * nN) return false;
        const int mg = L / per_group, rem = L % per_group;
        tm = xcd * mper + mg * 4 + (rem & 3); tn = rem >> 2;
        return true;
    }
    const int L = it * G + vcu;
    if (L >= nM * nN) return false;
    tm = L / nN; tn = L % nN;
    return true;
}

namespace pg8 {
constexpr int BM = 256, BK = 64, HALF = 128, HTB = HALF * BK * 2, NXCD = 8, WGM = 8;
__device__ __forceinline__ int lds_byte(int r, int c) { const int st = (r >> 4) * 2 + (c >> 5), rr = r & 15, cc = c & 31, ob = rr * 64 + cc * 2; return st * 1024 + (ob ^ (((ob >> 9) & 1) << 5)); }
__device__ __forceinline__ void stage_rc(int b, int& R, int& C) { const int st = b / 1024, sb = b % 1024, swz = sb ^ (((sb >> 9) & 1) << 5); R = (st >> 1) * 16 + swz / 64; C = (st & 1) * 32 + (swz % 64) / 2; }
__device__ __forceinline__ int perm32(int rho) { const int n = rho >> 4, i = rho & 15; return 8 * (i >> 2) + 4 * n + (i & 3); }
struct Unit { int pm, pn, z; };
__device__ __forceinline__ bool tile_of(int L, int nM, int nN, int& pm, int& pn) {
    const int nwg = nM * nN; if (L >= nwg) return false;
    int wgid = L; { const int q = nwg / NXCD, r = nwg % NXCD, xcd = wgid % NXCD, off = wgid / NXCD; wgid = (xcd < r ? xcd * (q + 1) : r * (q + 1) + (xcd - r) * q) + off; }
    const int nig = WGM * nN, gid = wgid / nig, fm = gid * WGM, gsz = (nM - fm) < WGM ? (nM - fm) : WGM;
    pm = fm + ((wgid % nig) % gsz); pn = (wgid % nig) / gsz; return true;
}
struct Sched {
    const bf16_t *A0, *A1, *B0, *B1; size_t lda, ldb; int K, nM, nN, NZ, G, c;
    __device__ __forceinline__ bool next(int i, Unit& u) const { u.z = (NZ == 2) ? (i & 1) : 0; const int ti = (NZ == 2) ? (i >> 1) : i; return tile_of(ti * G + c, nM, nN, u.pm, u.pn); }
    __device__ __forceinline__ const char* aptr(const Unit& u) const { return (const char*)((u.z ? A1 : A0) + (size_t)u.pm * BM * lda); }
    __device__ __forceinline__ const char* bptr(const Unit& u) const { return (const char*)((u.z ? B1 : B0) + (size_t)u.pn * BM * ldb); }
};
template <class Epi>
__device__ __forceinline__ void gemm_phase(LDSP unsigned char* lds, const Sched& S, const Epi& E) {
    const int tid = opaque_tid(), wid = __builtin_amdgcn_readfirstlane(tid >> 6), lane = tid & 63, wr = wid >> 2, wc = wid & 3, fr = lane & 15, fq = lane >> 4;
    const int nt = S.K / BK;
    unsigned voffA[2], voffB[2];
#pragma unroll
    for (int i = 0; i < 2; ++i) { int R, C; stage_rc(tid * 16 + i * 8192, R, C); const int Rb = (R & ~31) + perm32(R & 31);
        voffA[i] = (unsigned)(R * S.lda + C) * 2u; voffB[i] = (unsigned)(Rb * S.ldb + C) * 2u; }
    const size_t kstep = (size_t)(BK * 2);
    const size_t hstepA = (size_t)HALF * S.lda * 2, hstepB = (size_t)HALF * S.ldb * 2;
    const unsigned ldsw = (unsigned)wid * 1024u;
    const int aoff = lds_byte(wr * 64 + fr, fq * 8), boff = lds_byte(wc * 32 + fr, fq * 8);
#define PG8_SA(b, h) (((b) * 2 + (h)) * HTB)
#define PG8_SB(b, h) ((4 + (b) * 2 + (h)) * HTB)
#define PG8_STAGE(bufoff, gbase, voff) do { _Pragma("unroll") for (int _i = 0; _i < 2; ++_i) \
        __builtin_amdgcn_global_load_lds((const unsigned*)((const char*)(gbase) + (voff)[_i]), (LDSP unsigned*)(lds + (bufoff) + ldsw + _i * 8192), 16, 0, 0); } while (0)
#define PG8_LDA(dst, b, h) do { _Pragma("unroll") for (int m = 0; m < 4; ++m) _Pragma("unroll") for (int k = 0; k < 2; ++k) dst[m][k] = *(const LDSP bf16x8*)(lds + PG8_SA(b, h) + aoff + m * 2048 + k * 1024); } while (0)
#define PG8_LDB(dst, b, h) do { _Pragma("unroll") for (int n = 0; n < 2; ++n) _Pragma("unroll") for (int k = 0; k < 2; ++k) dst[n][k] = *(const LDSP bf16x8*)(lds + PG8_SB(b, h) + boff + n * 2048 + k * 1024); } while (0)
#define PG8_MMA(ai, bj, At, Bt) do { __builtin_amdgcn_s_setprio(1); _Pragma("unroll") for (int m = 0; m < 4; ++m) _Pragma("unroll") for (int n = 0; n < 2; ++n) _Pragma("unroll") for (int k = 0; k < 2; ++k) \
        acc[ai][bj][m][n] = __builtin_amdgcn_mfma_f32_16x16x32_bf16(Bt[n][k], At[m][k], acc[ai][bj][m][n], 0, 0, 0); __builtin_amdgcn_s_setprio(0); } while (0)
#define PG8_WAIT_V(n) asm volatile("s_waitcnt vmcnt(" #n ")" ::: "memory")
#define PG8_WAIT_L(n) asm volatile("s_waitcnt lgkmcnt(" #n ")" ::: "memory")
#define PG8_BAR __builtin_amdgcn_s_barrier()
#define PG8_SCHED __builtin_amdgcn_sched_barrier(0)
    Unit cur, nxt; int ui = 0;
    if (!S.next(0, cur)) return;
    f32x4 acc[2][2][4][2];
#pragma unroll
    for (int a = 0; a < 2; ++a)
#pragma unroll
        for (int b = 0; b < 2; ++b)
#pragma unroll
            for (int m = 0; m < 4; ++m)
#pragma unroll
                for (int n = 0; n < 2; ++n) acc[a][b][m][n] = (f32x4){0.f, 0.f, 0.f, 0.f};
    bf16x8 At[4][2], B0[2][2], B1[2][2];
    const char* cA = S.aptr(cur); const char* cB = S.bptr(cur);
    PG8_STAGE(PG8_SB(0, 0), cB, voffB); PG8_STAGE(PG8_SB(0, 1), cB + hstepB, voffB); PG8_STAGE(PG8_SA(0, 0), cA, voffA); PG8_STAGE(PG8_SA(0, 1), cA + hstepA, voffA);
    if (wr == 1) PG8_BAR;
    PG8_WAIT_V(2); PG8_BAR;
    PG8_STAGE(PG8_SB(1, 0), cB + kstep, voffB); PG8_STAGE(PG8_SA(1, 0), cA + kstep, voffA); PG8_STAGE(PG8_SB(1, 1), cB + hstepB + kstep, voffB);
    PG8_WAIT_V(6); PG8_BAR;
    for (;;) {
        const bool has_next = S.next(ui + 1, nxt);
        const char* nA = has_next ? S.aptr(nxt) : cA; const char* nB = has_next ? S.bptr(nxt) : cB;
        for (int t = 0; t < nt; t += 2) {
            const bool last = (t == nt - 2);
            const char* a1 = cA + (size_t)(t + 1) * kstep;
            const char* a2 = last ? nA : cA + (size_t)(t + 2) * kstep; const char* b2 = last ? nB : cB + (size_t)(t + 2) * kstep;
            const char* a3 = a2 + kstep; const char* b3 = b2 + kstep;
            PG8_LDB(B0, 0, 0); PG8_LDB(B1, 0, 1); PG8_SCHED; PG8_LDA(At, 0, 0); PG8_STAGE(PG8_SA(1, 1), a1 + hstepA, voffA);
            PG8_WAIT_V(8); PG8_WAIT_L(0); PG8_BAR; PG8_MMA(0, 0, At, B0); PG8_MMA(0, 1, At, B1); PG8_BAR; PG8_SCHED;
            PG8_LDA(At, 0, 1); PG8_STAGE(PG8_SB(0, 0), b2, voffB); PG8_STAGE(PG8_SB(0, 1), b2 + hstepB, voffB); PG8_STAGE(PG8_SA(0, 0), a2, voffA);
            PG8_WAIT_V(8); PG8_WAIT_L(0); PG8_BAR; PG8_MMA(1, 0, At, B0); PG8_MMA(1, 1, At, B1); PG8_BAR; PG8_SCHED;
            PG8_LDB(B0, 1, 0); PG8_LDB(B1, 1, 1); PG8_SCHED; PG8_LDA(At, 1, 0); PG8_STAGE(PG8_SA(0, 1), a2 + hstepA, voffA);
            PG8_WAIT_V(8); PG8_WAIT_L(0); PG8_BAR; PG8_MMA(0, 0, At, B0); PG8_MMA(0, 1, At, B1); PG8_BAR; PG8_SCHED;
            PG8_LDA(At, 1, 1); PG8_STAGE(PG8_SB(1, 0), b3, voffB); PG8_STAGE(PG8_SB(1, 1), b3 + hstepB, voffB); PG8_STAGE(PG8_SA(1, 0), a3, voffA);
            PG8_WAIT_V(8); PG8_WAIT_L(0); PG8_BAR; PG8_MMA(1, 0, At, B0); PG8_MMA(1, 1, At, B1); PG8_BAR; PG8_SCHED;
        }
        if (wr == 0) PG8_BAR;
        E(acc, cur, wr, wc, fr, fq);
        if (!has_next) break;
#pragma unroll
        for (int a = 0; a < 2; ++a)
#pragma unroll
            for (int b = 0; b < 2; ++b)
#pragma unroll
                for (int m = 0; m < 4; ++m)
#pragma unroll
                    for (int n = 0; n < 2; ++n) acc[a][b][m][n] = (f32x4){0.f, 0.f, 0.f, 0.f};
        cur = nxt; cA = nA; cB = nB; ++ui;
        if (wr == 1) PG8_BAR;
    }
    PG8_WAIT_V(0);
    PG8_BAR;
#undef PG8_SA
#undef PG8_SB
#undef PG8_STAGE
#undef PG8_LDA
#undef PG8_LDB
#undef PG8_MMA
#undef PG8_WAIT_V
#undef PG8_WAIT_L
#undef PG8_BAR
#undef PG8_SCHED
}
}

struct EpiProj {
    const Params* P;
    __device__ __forceinline__ void operator()(f32x4 (&acc)[2][2][4][2], const pg8::Unit& u, int wr, int wc, int fr, int fq) const {
        unsigned char* ws = P->ws;
        const int H = 4 * u.pn + wc;
        if (H > 76) return;
        const float* rs1 = (const float*)(ws + OFF_RS1);
        int kind; bf16_t* dst = nullptr; int pitch = 0, cb = 0; const float* gain = nullptr; float oscale = 1.f; bool slab = false; int sg = 0;
        if (H < 8)        { kind = 1; dst = (bf16_t*)(ws + OFF_R1);            pitch = 512; cb = H * 64;        gain = P->in[I_AQG]; oscale = QSCALE; }
        else if (H < 16)  { kind = 1; dst = (bf16_t*)(ws + OFF_R1 + 32 * MiB); pitch = 512; cb = (H - 8) * 64;  gain = P->in[I_AKG]; }
        else if (H < 24)  { kind = 0; dst = (bf16_t*)(ws + OFF_R1 + 64 * MiB); pitch = 512; cb = (H - 16) * 64; }
        else if (H < 32)  { kind = 1; dst = (bf16_t*)(ws + OFF_R1 + 96 * MiB); pitch = 512; cb = (H - 24) * 64; gain = P->in[I_BQG]; oscale = QSCALE; }
        else if (H < 34)  { kind = 0; dst = (bf16_t*)(ws + OFF_R2);            slab = true; sg = H - 32; }
        else if (H < 36)  { kind = 0; dst = (bf16_t*)(ws + OFF_R2 + 8 * MiB);  slab = true; sg = H - 34; }
        else if (H < 38)  { kind = 1; dst = (bf16_t*)(ws + OFF_R2 + 16 * MiB); pitch = 128; cb = (H - 36) * 64; gain = P->in[I_BKSG]; }
        else if (H < 40)  { kind = 0; dst = (bf16_t*)(ws + OFF_R2 + 24 * MiB); pitch = 128; cb = (H - 38) * 64; }
        else if (H < 42)  { kind = 1; dst = (bf16_t*)(ws + OFF_R2 + 32 * MiB); pitch = 128; cb = (H - 40) * 64; gain = P->in[I_BKWG]; }
        else if (H < 44)  { kind = 0; dst = (bf16_t*)(ws + OFF_R2 + 40 * MiB); pitch = 128; cb = (H - 42) * 64; }
        else if (H < 76)  { kind = 2; dst = (bf16_t*)(ws + OFF_R3);            pitch = 2048; cb = (H - 44) * 64; }
        else              { kind = 3; }
        f32x4 invrev[2] = {{0.f, 0.f, 0.f, 0.f}, {0.f, 0.f, 0.f, 0.f}};
        if (kind == 1) { invrev[0] = *(const f32x4*)((const float*)(ws + OFF_ROPE_C)); invrev[1] = *(const f32x4*)((const float*)(ws + OFF_ROPE_C) + 4); }
        float rsr[2][4];
#pragma unroll
        for (int ai = 0; ai < 2; ++ai)
#pragma unroll
            for (int m = 0; m < 4; ++m) rsr[ai][m] = rs1[u.pm * 256 + ai * 128 + wr * 64 + m * 16 + fr];
        f32x4 gv[2][2];
        if (kind == 1 || kind == 2) {
            const float* gp = (kind == 1) ? gain : P->in[I_BMERGE] + cb;
#pragma unroll
            for (int bj = 0; bj < 2; ++bj)
#pragma unroll
                for (int n = 0; n < 2; ++n) gv[bj][n] = *(const f32x4*)(gp + 32 * bj + 8 * fq + 4 * n);
        }
        const bool ksum = (H >= 8 && H < 16);
        f32x4 cs[2][2];
#pragma unroll
        for (int bj = 0; bj < 2; ++bj)
#pragma unroll
            for (int n = 0; n < 2; ++n) cs[bj][n] = (f32x4){0.f, 0.f, 0.f, 0.f};
#pragma unroll
        for (int ai = 0; ai < 2; ++ai)
#pragma unroll
            for (int m = 0; m < 4; ++m) {
                const int row = u.pm * 256 + ai * 128 + wr * 64 + m * 16 + fr;
                const float rs = rsr[ai][m];
                f32x4 v[2][2];
#pragma unroll
                for (int bj = 0; bj < 2; ++bj)
#pragma unroll
                    for (int n = 0; n < 2; ++n) v[bj][n] = acc[ai][bj][m][n] * rs;
                if (kind == 1) {
                    float ss = 0.f;
#pragma unroll
                    for (int bj = 0; bj < 2; ++bj)
#pragma unroll
                        for (int n = 0; n < 2; ++n) ss += (v[bj][n][0] * v[bj][n][0] + v[bj][n][1] * v[bj][n][1]) + (v[bj][n][2] * v[bj][n][2] + v[bj][n][3] * v[bj][n][3]);
                    ss += __shfl_xor(ss, 16); ss += __shfl_xor(ss, 32);
                    const float r = oscale / sqrtf(ss * (1.0f / 64.0f) + NORM_EPS);
#pragma unroll
                    for (int bj = 0; bj < 2; ++bj)
#pragma unroll
                        for (int n = 0; n < 2; ++n) v[bj][n] = v[bj][n] * gv[bj][n] * r;
                    const float posf = (float)(row & (SEQ - 1));
                    const float sgn = (fq == 0) ? -1.f : 1.f;
#pragma unroll
                    for (int n = 0; n < 2; ++n) {
                        const f32x4 me = v[0][n]; f32x4 ot, ro;
#pragma unroll
                        for (int i = 0; i < 4; ++i) ot[i] = __shfl_xor(me[i], 16);
#pragma unroll
                        for (int i = 0; i < 4; ++i) { const float rev = __builtin_amdgcn_fractf(posf * invrev[n][i]); ro[i] = me[i] * __builtin_amdgcn_cosf(rev) + sgn * ot[i] * __builtin_amdgcn_sinf(rev); }
                        if (fq < 2) v[0][n] = ro;
                    }
                    if (ksum) {
#pragma unroll
                        for (int bj = 0; bj < 2; ++bj)
#pragma unroll
                            for (int n = 0; n < 2; ++n) cs[bj][n] += v[bj][n];
                    }
                } else if (kind == 2) {
#pragma unroll
                    for (int bj = 0; bj < 2; ++bj)
#pragma unroll
                        for (int n = 0; n < 2; ++n)
#pragma unroll
                            for (int i = 0; i < 4; ++i) v[bj][n][i] = sigmoidf_(v[bj][n][i] + gv[bj][n][i]);
                }
                if (kind == 3) {
                    float* bg = (float*)(ws + OFF_BGATE) + (size_t)row * 24;
                    if (fq < 3) {
#pragma unroll
                        for (int n = 0; n < 2; ++n) { f32x4 o; o.x = sigmoidf_(v[0][n][0]); o.y = sigmoidf_(v[0][n][1]); o.z = sigmoidf_(v[0][n][2]); o.w = sigmoidf_(v[0][n][3]); *(f32x4*)(bg + 8 * fq + 4 * n) = o; }
                    }
                } else {
                    bf16_t* rp;
                    if (slab) { const int b = row >> 12, s = row & (SEQ - 1); rp = dst + ((size_t)((b * 2 + sg) * SEQ + s)) * 64 + 8 * fq; }
                    else rp = dst + (size_t)row * pitch + cb + 8 * fq;
#pragma unroll
                    for (int bj = 0; bj < 2; ++bj) {
                        u32x4 w; w.x = pk2(v[bj][0][0], v[bj][0][1]); w.y = pk2(v[bj][0][2], v[bj][0][3]); w.z = pk2(v[bj][1][0], v[bj][1][1]); w.w = pk2(v[bj][1][2], v[bj][1][3]);
                        *(u32x4*)(rp + 32 * bj) = w;
                    }
                }
            }
        if (ksum) {
            float* km = (float*)(ws + OFF_KMEAN) + (size_t)(((u.pm >> 4) * 8 + (H - 8)) * 16 + (u.pm & 15)) * 64;
#pragma unroll
            for (int bj = 0; bj < 2; ++bj)
#pragma unroll
                for (int n = 0; n < 2; ++n)
#pragma unroll
                    for (int i = 0; i < 4; ++i) {
                        float t = cs[bj][n][i];
                        t += __shfl_xor(t, 1); t += __shfl_xor(t, 2); t += __shfl_xor(t, 4); t += __shfl_xor(t, 8);
                        if (fr == 0) atomicAdd(km + 32 * bj + 8 * fq + 4 * n + i, t);
                    }
        }
    }
};
__device__ __forceinline__ void phase_proj(const Params& P, LDSP unsigned char* lds, int vcu, int G) {
    pg8::Sched S; S.A0 = S.A1 = (const bf16_t*)(P.ws + OFF_R0); S.B0 = S.B1 = (const bf16_t*)(P.ws + OFF_WIN_T);
    S.lda = DM; S.ldb = DM; S.K = DM; S.nM = T / 256; S.nN = NPROJ / 256; S.NZ = 1; S.G = G; S.c = blockIdx.x;
    EpiProj E{&P};
    pg8::gemm_phase(lds, S, E);
}

constexpr size_t OFF_CPART = OFF_EXPERTS;
constexpr size_t CPART_STRIDE = (size_t)2 * 4096 * 256;
__device__ __forceinline__ void phase_cmp1(const Params& P, LDSP unsigned char* lds, int vcu, int G) {
    unsigned char* ws = P.ws;
    const int tid = opaque_tid(), lane = tid & 63, wid = tid >> 6, wm = wid >> 1, wn = wid & 1, fr = lane & 15, fq = lane >> 4;
    for (int item = vcu; item < 256; item += G) {
        const int kc = item & 3, tn = (item >> 2) & 1, tm = (item >> 3) & 15, kv = item >> 7;
        const bf16_t* A = (const bf16_t*)(ws + OFF_R2 + (size_t)kv * 8 * MiB) + (size_t)tm * SEQ * 64 + kc * 512;
        const bf16_t* Bt = (const bf16_t*)(ws + (kv ? OFF_W1V_T : OFF_W1K_T)) + (size_t)tn * G_BN * 2048 + kc * 512;
        float* part = (float*)(ws + OFF_CPART) + (size_t)kc * CPART_STRIDE + (size_t)kv * 4096 * 256;
        f32x4 acc[4][4];
        zero_acc(acc);
        gemm_kloop(acc, A, 1024, Bt, 2048, 512, lds);
        const int row0 = tm * 256 + wm * 64 + fr, col0 = tn * 128 + wn * 64 + 4 * fq;
#pragma unroll
        for (int m = 0; m < 4; ++m)
#pragma unroll
            for (int n = 0; n < 4; ++n) *(f32x4*)(part + (size_t)(row0 + m * 16) * 256 + col0 + n * 16) = acc[m][n];
    }
}

__device__ __forceinline__ u32x4 load_hid8(const float* part, const float* posb, size_t rowoff, int k) {
    f32x4 a = *(const f32x4*)(posb + k), b = *(const f32x4*)(posb + k + 4);
#pragma unroll
    for (int c = 0; c < 4; ++c) { a += *(const f32x4*)(part + c * CPART_STRIDE + rowoff + k); b += *(const f32x4*)(part + c * CPART_STRIDE + rowoff + k + 4); }
    u32x4 o; o.x = pk2(gelu_tanh(a.x), gelu_tanh(a.y)); o.y = pk2(gelu_tanh(a.z), gelu_tanh(a.w)); o.z = pk2(gelu_tanh(b.x), gelu_tanh(b.y)); o.w = pk2(gelu_tanh(b.z), gelu_tanh(b.w));
    return o;
}
__device__ __forceinline__ void phase_cmp2(const Params& P, LDSP unsigned char* lds, int vcu, int G) {
    unsigned char* ws = P.ws;
    const int tid = opaque_tid(), lane = tid & 63, wid = tid >> 6, wm = wid >> 1, wn = wid & 1, fr = lane & 15, fq = lane >> 4;
    const int lrow = tid >> 3, lch = tid & 7;
    for (int item = vcu; item < 32; item += G) {
        const int kv = item >> 4, tm = item & 15;
        const float* part = (const float*)(ws + OFF_CPART) + (size_t)kv * 4096 * 256 + (size_t)tm * 256 * 256;
        const float* posb = (const float*)(ws + OFF_POSB) + kv * 256;
        const bf16_t* Bt = (const bf16_t*)(ws + (kv ? OFF_W2V_T : OFF_W2K_T));
        const float* b2 = P.in[kv ? I_CVB2 : I_CKB2];
        bf16_t* dst = (bf16_t*)(ws + (kv ? OFF_VC : OFF_KC)) + (size_t)tm * 256 * 64;
        f32x4 acc[4][4];
        zero_acc(acc);
        {
            const bf16_t* gb = Bt + (size_t)lrow * 256 + lch * 8;
            u32x4 ra[4], rb[2];
#pragma unroll
            for (int p = 0; p < 4; ++p) ra[p] = load_hid8(part, posb, (size_t)(lrow + 64 * p) * 256, lch * 8);
#pragma unroll
            for (int p = 0; p < 2; ++p) rb[p] = *(const u32x4*)(gb + (size_t)(64 * p) * 256);
            __syncthreads();
#pragma unroll
            for (int p = 0; p < 4; ++p) *(LDSP u32x4*)(lds + swz_off(lrow + 64 * p, lch)) = ra[p];
#pragma unroll
            for (int p = 0; p < 2; ++p) *(LDSP u32x4*)(lds + G_ABYTES + swz_off(lrow + 64 * p, lch)) = rb[p];
            __syncthreads();
#pragma unroll 1
            for (int kt = 0; kt < 4; ++kt) {
                LDSP unsigned char* cur = lds + (kt & 1) * G_STAGE;
                LDSP unsigned char* nxt = lds + ((kt + 1) & 1) * G_STAGE;
                if (kt + 1 < 4) {
#pragma unroll
                    for (int p = 0; p < 4; ++p) ra[p] = load_hid8(part, posb, (size_t)(lrow + 64 * p) * 256, (kt + 1) * G_BK + lch * 8);
#pragma unroll
                    for (int p = 0; p < 2; ++p) rb[p] = *(const u32x4*)(gb + (size_t)(64 * p) * 256 + (kt + 1) * G_BK);
                }
#pragma unroll
                for (int ks = 0; ks < 2; ++ks) {
                    bf16x8 af[4], bfr[4];
#pragma unroll
                    for (int m = 0; m < 4; ++m) af[m] = *(const LDSP bf16x8*)(cur + swz_off(wm * 64 + m * 16 + fr, ks * 4 + fq));
#pragma unroll
                    for (int n = 0; n < 4; ++n) bfr[n] = *(const LDSP bf16x8*)(cur + G_ABYTES + swz_off(wn * 64 + n * 16 + fr, ks * 4 + fq));
#pragma unroll
                    for (int m = 0; m < 4; ++m)
#pragma unroll
                        for (int n = 0; n < 4; ++n) acc[m][n] = __builtin_amdgcn_mfma_f32_16x16x32_bf16(bfr[n], af[m], acc[m][n], 0, 0, 0);
                }
                if (kt + 1 < 4) {
#pragma unroll
                    for (int p = 0; p < 4; ++p) *(LDSP u32x4*)(nxt + swz_off(lrow + 64 * p, lch)) = ra[p];
#pragma unroll
                    for (int p = 0; p < 2; ++p) *(LDSP u32x4*)(nxt + G_ABYTES + swz_off(lrow + 64 * p, lch)) = rb[p];
                }
                __syncthreads();
            }
        }
        if (wn == 0) {
            float gv[4][4];
#pragma unroll
            for (int n = 0; n < 4; ++n) {
                const f32x4 bb = *(const f32x4*)(b2 + n * 16 + 4 * fq);
                const f32x4 g4 = kv ? (f32x4){1.f, 1.f, 1.f, 1.f} : *(const f32x4*)(P.in[I_BKCG] + n * 16 + 4 * fq);
                gv[n][0] = g4.x; gv[n][1] = g4.y; gv[n][2] = g4.z; gv[n][3] = g4.w;
#pragma unroll
                for (int m = 0; m < 4; ++m) acc[m][n] += bb;
            }
#pragma unroll
            for (int m = 0; m < 4; ++m) {
                float r = 1.f;
                if (kv == 0) {
                    float ss = 0.f;
#pragma unroll
                    for (int n = 0; n < 4; ++n) ss += (acc[m][n][0] * acc[m][n][0] + acc[m][n][1] * acc[m][n][1]) + (acc[m][n][2] * acc[m][n][2] + acc[m][n][3] * acc[m][n][3]);
                    ss += __shfl_xor(ss, 16); ss += __shfl_xor(ss, 32);
                    r = 1.0f / sqrtf(ss * (1.0f / 64.0f) + NORM_EPS);
                }
                const int row = wm * 64 + m * 16 + fr;
                if (row == 255) r = 0.f;
#pragma unroll
                for (int n = 0; n < 4; ++n) {
                    f32x4 o = acc[m][n];
                    if (row == 255) o = (f32x4){0.f, 0.f, 0.f, 0.f};
                    u32x2 w; w.x = pk2(o[0] * r * gv[n][0], o[1] * r * gv[n][1]); w.y = pk2(o[2] * r * gv[n][2], o[3] * r * gv[n][3]);
                    *(u32x2*)(dst + (size_t)row * 64 + n * 16 + 4 * fq) = w;
                }
            }
        }
    }
}

__device__ __forceinline__ void phase_cmp(const Params& P, LDSP unsigned char* lds, int vcu, int G) {
    unsigned char* ws = P.ws;
    const int tid = opaque_tid(), lane = tid & 63, r32 = lane & 31, hi = lane >> 5;
    const int wu = __builtin_amdgcn_readfirstlane(tid >> 6);
    for (int item = vcu; item < 256; item += G) {
        const int kv = item >> 7, bg = (item >> 3) & 15, rb = item & 7;
        const bf16_t* A = (const bf16_t*)(ws + OFF_R2 + (size_t)kv * 8 * MiB) + ((size_t)bg * SEQ + 512 * rb) * 64;
        const bf16_t* W1 = (const bf16_t*)(ws + (kv ? OFF_W1V_T : OFF_W1K_T)) + (size_t)(32 * wu + r32) * 2048 + 32 * hi;
        __syncthreads();
        for (int pc = wu; pc < 66; pc += 8) {
            const int g16 = pc >> 1, h8 = pc & 1, tau = 16 * g16 + 8 * h8 + (lane >> 3), c = (lane & 7) ^ ((g16 >> 1) & 7);
            __builtin_amdgcn_global_load_lds((const unsigned*)(A + (size_t)tau * 64 + c * 8), (LDSP unsigned*)(lds + (17 * g16 + 8 * h8) * 128), 16, 0, 0);
        }
        u32x4 Bq[8][4];
#pragma unroll
        for (int j = 0; j < 8; ++j)
#pragma unroll
            for (int i = 0; i < 4; ++i) Bq[j][i] = *(const u32x4*)(W1 + 64 * j + 8 * i);
        const int abase = 17 * r32 * 128;
        int aoff[2][4];
#pragma unroll
        for (int jh = 0; jh < 2; ++jh)
#pragma unroll
            for (int i = 0; i < 4; ++i) aoff[jh][i] = abase + ((((4 * hi + i) ^ (((r32 + jh) >> 1) & 7))) << 4);
        f32x16 acc;
#pragma unroll
        for (int r = 0; r < 16; ++r) acc[r] = 0.f;
        asm volatile("s_waitcnt vmcnt(32)" ::: "memory");
        __syncthreads();
#pragma unroll
        for (int j = 0; j < 32; ++j) {
#pragma unroll
            for (int i = 0; i < 4; ++i) {
                const bf16x8 xf = *(const LDSP bf16x8*)(lds + aoff[j >> 4][i] + (j + (j >> 4)) * 128);
                acc = __builtin_amdgcn_mfma_f32_32x32x16_bf16(__builtin_bit_cast(bf16x8, Bq[j & 7][i]), xf, acc, 0, 0, 0);
            }
            if (j + 8 < 32) {
#pragma unroll
                for (int i = 0; i < 4; ++i) Bq[j & 7][i] = *(const u32x4*)(W1 + 64 * (j + 8) + 8 * i);
            }
            __builtin_amdgcn_sched_barrier(0);
        }
        const float* posb = (const float*)(ws + OFF_POSB) + kv * 256 + 32 * wu + 4 * hi;
        u32x4 pw[2];
#pragma unroll
        for (int q = 0; q < 4; ++q) {
            const f32x4 pb = *(const f32x4*)(posb + 8 * q);
            const float h0 = gelu_tanh(acc[4 * q] + pb.x), h1 = gelu_tanh(acc[4 * q + 1] + pb.y), h2 = gelu_tanh(acc[4 * q + 2] + pb.z), h3 = gelu_tanh(acc[4 * q + 3] + pb.w);
            pw[q >> 1][(q & 1) * 2] = pk2(h0, h1); pw[q >> 1][(q & 1) * 2 + 1] = pk2(h2, h3);
        }
        const bf16_t* W2 = (const bf16_t*)(ws + (kv ? OFF_W2V_T : OFF_W2K_T)) + (size_t)r32 * 256 + 32 * wu + 4 * hi;
        f32x16 o2[2];
#pragma unroll
        for (int mb = 0; mb < 2; ++mb) {
#pragma unroll
            for (int r = 0; r < 16; ++r) o2[mb][r] = 0.f;
#pragma unroll
            for (int s2 = 0; s2 < 2; ++s2) {
                const u32x2 lo = *(const u32x2*)(W2 + (size_t)mb * 32 * 256 + 16 * s2), hh = *(const u32x2*)(W2 + (size_t)mb * 32 * 256 + 16 * s2 + 8);
                const u32x4 a2 = {lo.x, lo.y, hh.x, hh.y};
                o2[mb] = __builtin_amdgcn_mfma_f32_32x32x16_bf16(__builtin_bit_cast(bf16x8, a2), __builtin_bit_cast(bf16x8, pw[s2]), o2[mb], 0, 0, 0);
            }
        }
        __syncthreads();
        {
            LDSP float* part = (LDSP float*)lds + (size_t)(wu * 32 + r32) * 68 + 4 * hi;
#pragma unroll
            for (int mb = 0; mb < 2; ++mb)
#pragma unroll
                for (int q = 0; q < 4; ++q) *(LDSP f32x4*)(part + 32 * mb + 8 * q) = (f32x4){o2[mb][4 * q], o2[mb][4 * q + 1], o2[mb][4 * q + 2], o2[mb][4 * q + 3]};
        }
        __syncthreads();
        {
            const int row = tid >> 4, dq = tid & 15;
            f32x4 v = *(const f32x4*)(P.in[kv ? I_CVB2 : I_CKB2] + 4 * dq);
#pragma unroll
            for (int w = 0; w < 8; ++w) v += *(const LDSP f32x4*)((LDSP float*)lds + (size_t)(w * 32 + row) * 68 + 4 * dq);
            float rr = 1.f; f32x4 g4 = {1.f, 1.f, 1.f, 1.f};
            if (kv == 0) {
                float ss = (v.x * v.x + v.y * v.y) + (v.z * v.z + v.w * v.w);
                ss += __shfl_xor(ss, 1); ss += __shfl_xor(ss, 2); ss += __shfl_xor(ss, 4); ss += __shfl_xor(ss, 8);
                rr = 1.0f / sqrtf(ss * (1.0f / 64.0f) + NORM_EPS);
                g4 = *(const f32x4*)(P.in[I_BKCG] + 4 * dq);
            }
            const int grow = 32 * rb + row;
            u32x2 w2; w2.x = pk2(v.x * rr * g4.x, v.y * rr * g4.y); w2.y = pk2(v.z * rr * g4.z, v.w * rr * g4.w);
            if (grow == 255) w2 = (u32x2){0u, 0u};
            *(u32x2*)((bf16_t*)(ws + (kv ? OFF_VC : OFF_KC)) + ((size_t)bg * 256 + grow) * 64 + 4 * dq) = w2;
        }
    }
    __syncthreads();
}

constexpr int A_GS = 65536, A_ES = 81920, A_Y = 65536, A_MISC = 131072;
typedef short v4i16_t __attribute__((ext_vector_type(4)));
struct ASt { f32x16 o0, o1; float m, l; };
struct KVStage { u32x4 k, v; };
__device__ __forceinline__ void kv_load(KVStage& s, const bf16_t* Kg, const bf16_t* Vg, size_t pitch, int tid) {
    const int key = tid >> 3, ch = tid & 7;
    s.k = *(const u32x4*)(Kg + (size_t)key * pitch + ch * 8);
    s.v = *(const u32x4*)(Vg + (size_t)key * pitch + ch * 8);
}
__device__ __forceinline__ void kv_store(const KVStage& s, LDSP unsigned char* buf, int tid) {
    const int key = tid >> 3, ch = tid & 7;
    *(LDSP u32x4*)(buf + swz_off(key, ch)) = s.k;
    *(LDSP u32x4*)(buf + 8192 + ((ch >> 2) * 4 + (key >> 4)) * 1024 + (key & 15) * 64 + (ch & 3) * 16) = s.v;
}
__device__ __forceinline__ void kv_dma(const bf16_t* Kg, const bf16_t* Vg, size_t pitch, LDSP unsigned char* buf, int wid, int lane) {
    const int row = wid * 8 + (lane >> 3), chunk = (lane & 7) ^ ((row >> 1) & 7);
    __builtin_amdgcn_global_load_lds((const unsigned*)(Kg + (size_t)row * pitch + chunk * 8), (LDSP unsigned*)(buf + wid * 1024), 16, 0, 0);
    const int vrow = (wid & 3) * 16 + (lane >> 2), vcol = (wid >> 2) * 32 + (lane & 3) * 8;
    __builtin_amdgcn_global_load_lds((const unsigned*)(Vg + (size_t)vrow * pitch + vcol), (LDSP unsigned*)(buf + 8192 + wid * 1024), 16, 0, 0);
}
__device__ __forceinline__ float swap32f(float v) { return __shfl_xor(v, 32); }
__device__ __forceinline__ void ast_reset(ASt& st) {
#pragma unroll
    for (int r = 0; r < 16; ++r) { st.o0[r] = 0.f; st.o1[r] = 0.f; }
    st.m = 0.f; st.l = 0.f;
}
constexpr float ATT_THR = 8.0f;
template <int MODE>
__device__ __forceinline__ void attn_tile(ASt& st, const bf16x8 (&qf)[4], LDSP const unsigned char* kt, int lane, bool rowoff, int kl, int kh, bool need_mask,
                                          float linv, LDSP float* gs, LDSP float* es, int jbase, int ql) {
    const int r32 = lane & 31, hi = lane >> 5;
    const float cin = rowoff ? -INFINITY : -st.m;
    f32x16 p0, p1;
#pragma unroll
    for (int r = 0; r < 16; ++r) { p0[r] = cin; p1[r] = cin; }
#pragma unroll
    for (int d0 = 0; d0 < 4; ++d0) {
        const bf16x8 k0f = *(const LDSP bf16x8*)(kt + swz_off(r32, 2 * d0 + hi));
        const bf16x8 k1f = *(const LDSP bf16x8*)(kt + swz_off(r32 + 32, 2 * d0 + hi));
        p0 = __builtin_amdgcn_mfma_f32_32x32x16_bf16(k0f, qf[d0], p0, 0, 0, 0);
        p1 = __builtin_amdgcn_mfma_f32_32x32x16_bf16(k1f, qf[d0], p1, 0, 0, 0);
    }
    if (need_mask) {
        const int kl2 = kl - 4 * hi, kh2 = kh - 4 * hi;
#pragma unroll
        for (int r = 0; r < 16; ++r) {
            const int c = (r & 3) + 8 * (r >> 2);
            const bool v0 = c >= kl2 && c <= kh2, v1 = (c + 32) >= kl2 && (c + 32) <= kh2;
            p0[r] = v0 ? p0[r] : -INFINITY; p1[r] = v1 ? p1[r] : -INFINITY;
        }
    }
    if (MODE != 2) {
        float mx = fmaxf(fmaxf(p0[0], p1[0]), fmaxf(p0[1], p1[1]));
#pragma unroll
        for (int r = 2; r < 16; r += 2) mx = fmaxf(fmaxf(mx, fmaxf(p0[r], p1[r])), fmaxf(p0[r + 1], p1[r + 1]));
        mx = fmaxf(mx, swap32f(mx));
        if (__any(mx > ATT_THR)) {
            const float dl = (mx > ATT_THR) ? mx : 0.f;
            const float alpha = __builtin_amdgcn_exp2f(-dl);
            st.m += dl; st.l *= alpha;
#pragma unroll
            for (int r = 0; r < 16; ++r) { p0[r] -= dl; p1[r] -= dl; }
            if (MODE == 0) {
#pragma unroll
                for (int r = 0; r < 16; ++r) { st.o0[r] *= alpha; st.o1[r] *= alpha; }
            }
        }
    }
#pragma unroll
    for (int r = 0; r < 16; ++r) { p0[r] = __builtin_amdgcn_exp2f(p0[r]); p1[r] = __builtin_amdgcn_exp2f(p1[r]); }
    if (MODE != 2) {
        const f32x16 t = p0 + p1;
        st.l += ((t[0] + t[1]) + (t[2] + t[3])) + ((t[4] + t[5]) + (t[6] + t[7])) + (((t[8] + t[9]) + (t[10] + t[11])) + ((t[12] + t[13]) + (t[14] + t[15])));
    } else {
#pragma unroll
        for (int r = 0; r < 16; ++r) { p0[r] *= linv; p1[r] *= linv; }
#pragma unroll
        for (int qd = 0; qd < 4; ++qd) {
            float g0 = (p0[4 * qd] + p0[4 * qd + 1]) + (p0[4 * qd + 2] + p0[4 * qd + 3]), e0 = p0[4 * qd + 3];
            float g1 = (p1[4 * qd] + p1[4 * qd + 1]) + (p1[4 * qd + 2] + p1[4 * qd + 3]), e1 = p1[4 * qd + 3];
            g0 += __shfl_xor(g0, 1); g0 += __shfl_xor(g0, 2); e0 += __shfl_xor(e0, 1); e0 += __shfl_xor(e0, 2);
            g1 += __shfl_xor(g1, 1); g1 += __shfl_xor(g1, 2); e1 += __shfl_xor(e1, 1); e1 += __shfl_xor(e1, 2);
            if ((r32 & 3) == 0) {
                const int j = jbase + 2 * qd + hi;
                gs[ql * 64 + j] = g0; es[ql * 64 + j] = e0; gs[ql * 64 + j + 8] = g1; es[ql * 64 + j + 8] = e1;
            }
        }
    }
    if (MODE != 1) {
        u32x4 pw[4];
        pw[0] = (u32x4){pk2(p0[0], p0[1]), pk2(p0[2], p0[3]), pk2(p0[4], p0[5]), pk2(p0[6], p0[7])};
        pw[1] = (u32x4){pk2(p0[8], p0[9]), pk2(p0[10], p0[11]), pk2(p0[12], p0[13]), pk2(p0[14], p0[15])};
        pw[2] = (u32x4){pk2(p1[0], p1[1]), pk2(p1[2], p1[3]), pk2(p1[4], p1[5]), pk2(p1[6], p1[7])};
        pw[3] = (u32x4){pk2(p1[8], p1[9]), pk2(p1[10], p1[11]), pk2(p1[12], p1[13]), pk2(p1[14], p1[15])};
        LDSP const unsigned char* vb = kt + 8192 + ((lane >> 4) & 1) * 32 + (lane & 3) * 8 + (4 * hi + ((lane & 15) >> 2)) * 64;
#pragma unroll
        for (int ks = 0; ks < 4; ++ks) {
            const bf16x8 pf = __builtin_bit_cast(bf16x8, pw[ks]);
#pragma unroll
            for (int d0 = 0; d0 < 2; ++d0) {
                const v4i16_t lo = __builtin_amdgcn_ds_read_tr16_b64_v4i16((LDSP v4i16_t*)(vb + (d0 * 4 + ks) * 1024));
                const v4i16_t hh = __builtin_amdgcn_ds_read_tr16_b64_v4i16((LDSP v4i16_t*)(vb + (d0 * 4 + ks) * 1024 + 512));
                const bf16x8 vf = (bf16x8){lo[0], lo[1], lo[2], lo[3], hh[0], hh[1], hh[2], hh[3]};
                if (d0 == 0) st.o0 = __builtin_amdgcn_mfma_f32_32x32x16_bf16(vf, pf, st.o0, 0, 0, 0);
                else         st.o1 = __builtin_amdgcn_mfma_f32_32x32x16_bf16(vf, pf, st.o1, 0, 0, 0);
            }
            if (ks & 1) __builtin_amdgcn_sched_barrier(0);
        }
    }
}

#define KV_LOOP(NT, KPTR, VPTR, PITCH, ...) do { const int nt_ = (NT), np_ = (nt_ + 1) >> 1; KVStage sa_, sb_; __syncthreads(); \
    { const int i = 0; kv_load(sa_, (KPTR), (VPTR), (PITCH), tid); } { const int i = (nt_ > 1) ? 1 : 0; kv_load(sb_, (KPTR), (VPTR), (PITCH), tid); } \
    kv_store(sa_, lds, tid); kv_store(sb_, lds + 16384, tid); __syncthreads(); \
    _Pragma("unroll 1") for (int ip_ = 0; ip_ < np_; ++ip_) { LDSP unsigned char* cur0_ = lds + (ip_ & 1) * 32768; \
        if (ip_ + 1 < np_) { { const int i = 2 * ip_ + 2; kv_load(sa_, (KPTR), (VPTR), (PITCH), tid); } \
                             { const int i = (2 * ip_ + 3 < nt_) ? 2 * ip_ + 3 : 2 * ip_ + 2; kv_load(sb_, (KPTR), (VPTR), (PITCH), tid); } } \
        { const int i = 2 * ip_; LDSP unsigned char* cur = cur0_; __VA_ARGS__ } \
        if (2 * ip_ + 1 < nt_) { const int i = 2 * ip_ + 1; LDSP unsigned char* cur = cur0_ + 16384; __VA_ARGS__ } \
        if (ip_ + 1 < np_) { kv_store(sa_, lds + ((ip_ + 1) & 1) * 32768, tid); kv_store(sb_, lds + ((ip_ + 1) & 1) * 32768 + 16384, tid); } \
        __syncthreads(); } } while (0)

struct TP { bool rowoff, nm; int kl, kh; };
__device__ __forceinline__ void pair_kload(bf16x8 (&kf)[8], LDSP const unsigned char* kt, int r32, int hi) {
#pragma unroll
    for (int d0 = 0; d0 < 4; ++d0) {
        kf[2 * d0]     = *(const LDSP bf16x8*)(kt + swz_off(r32, 2 * d0 + hi));
        kf[2 * d0 + 1] = *(const LDSP bf16x8*)(kt + swz_off(r32 + 32, 2 * d0 + hi));
    }
}
__device__ __forceinline__ void pair_vload(bf16x8 (&vf)[8], LDSP const unsigned char* kt, int lane, int hi) {
    LDSP const unsigned char* vb = kt + 8192 + ((lane >> 4) & 1) * 32 + (lane & 3) * 8 + (4 * hi + ((lane & 15) >> 2)) * 64;
#pragma unroll
    for (int ks = 0; ks < 4; ++ks)
#pragma unroll
        for (int d0 = 0; d0 < 2; ++d0) {
            const v4i16_t lo = __builtin_amdgcn_ds_read_tr16_b64_v4i16((LDSP v4i16_t*)(vb + (d0 * 4 + ks) * 1024));
            const v4i16_t hh = __builtin_amdgcn_ds_read_tr16_b64_v4i16((LDSP v4i16_t*)(vb + (d0 * 4 + ks) * 1024 + 512));
            vf[2 * ks + d0] = (bf16x8){lo[0], lo[1], lo[2], lo[3], hh[0], hh[1], hh[2], hh[3]};
        }
}
#define PAIR_LDS_WAIT() do { asm volatile("s_waitcnt lgkmcnt(0)" ::: "memory"); __builtin_amdgcn_sched_barrier(0); } while (0)
__device__ __forceinline__ void pair_qk(f32x16& p0, f32x16& p1, float cin, const bf16x8 (&qf)[4], const bf16x8 (&kf)[8]) {
    f32x16 c16;
#pragma unroll
    for (int r = 0; r < 16; ++r) c16[r] = cin;
#pragma unroll
    for (int d0 = 0; d0 < 4; ++d0) {
        p0 = __builtin_amdgcn_mfma_f32_32x32x16_bf16(kf[2 * d0], qf[d0], d0 == 0 ? c16 : p0, 0, 0, 0);
        p1 = __builtin_amdgcn_mfma_f32_32x32x16_bf16(kf[2 * d0 + 1], qf[d0], d0 == 0 ? c16 : p1, 0, 0, 0);
    }
}
__device__ __forceinline__ void pair_sm(ASt& st, f32x16& p0, f32x16& p1, u32x4 (&pw)[4], const TP& t, float pend, int hi) {
    if (t.nm) {
        const int kl2 = t.kl - 4 * hi, kh2 = t.kh - 4 * hi;
#pragma unroll
        for (int r = 0; r < 16; ++r) {
            const int c = (r & 3) + 8 * (r >> 2);
            const bool v0 = c >= kl2 && c <= kh2, v1 = (c + 32) >= kl2 && (c + 32) <= kh2;
            p0[r] = v0 ? p0[r] : -INFINITY; p1[r] = v1 ? p1[r] : -INFINITY;
        }
    }
    float mx = fmaxf(fmaxf(p0[0], p1[0]), fmaxf(p0[1], p1[1]));
#pragma unroll
    for (int r = 2; r < 16; r += 2) mx = fmaxf(fmaxf(mx, fmaxf(p0[r], p1[r])), fmaxf(p0[r + 1], p1[r + 1]));
    { const auto rr = __builtin_amdgcn_permlane32_swap(__float_as_uint(mx), __float_as_uint(mx), false, false); mx = fmaxf(__uint_as_float(rr[0]), __uint_as_float(rr[1])); }
    mx -= pend;
    if (__any(mx > ATT_THR || pend != 0.f)) {
        const float dl = (mx > ATT_THR) ? mx : 0.f;
        const float alpha = __builtin_amdgcn_exp2f(-dl), sub = dl + pend;
        st.m += dl; st.l *= alpha;
#pragma unroll
        for (int r = 0; r < 16; ++r) { p0[r] -= sub; p1[r] -= sub; st.o0[r] *= alpha; st.o1[r] *= alpha; }
    }
#pragma unroll
    for (int r = 0; r < 16; ++r) { p0[r] = __builtin_amdgcn_exp2f(p0[r]); p1[r] = __builtin_amdgcn_exp2f(p1[r]); }
    const f32x16 tt = p0 + p1;
    st.l += ((tt[0] + tt[1]) + (tt[2] + tt[3])) + ((tt[4] + tt[5]) + (tt[6] + tt[7])) + (((tt[8] + tt[9]) + (tt[10] + tt[11])) + ((tt[12] + tt[13]) + (tt[14] + tt[15])));
    pw[0] = (u32x4){pk2(p0[0], p0[1]), pk2(p0[2], p0[3]), pk2(p0[4], p0[5]), pk2(p0[6], p0[7])};
    pw[1] = (u32x4){pk2(p0[8], p0[9]), pk2(p0[10], p0[11]), pk2(p0[12], p0[13]), pk2(p0[14], p0[15])};
    pw[2] = (u32x4){pk2(p1[0], p1[1]), pk2(p1[2], p1[3]), pk2(p1[4], p1[5]), pk2(p1[6], p1[7])};
    pw[3] = (u32x4){pk2(p1[8], p1[9]), pk2(p1[10], p1[11]), pk2(p1[12], p1[13]), pk2(p1[14], p1[15])};
}
__device__ __forceinline__ void pair_pv(ASt& st, const u32x4 (&pw)[4], const bf16x8 (&vf)[8]) {
#pragma unroll
    for (int ks = 0; ks < 4; ++ks) {
        const bf16x8 pf = __builtin_bit_cast(bf16x8, pw[ks]);
        st.o0 = __builtin_amdgcn_mfma_f32_32x32x16_bf16(vf[2 * ks], pf, st.o0, 0, 0, 0);
        st.o1 = __builtin_amdgcn_mfma_f32_32x32x16_bf16(vf[2 * ks + 1], pf, st.o1, 0, 0, 0);
    }
}
__device__ __forceinline__ void attn_pair(ASt& st, const bf16x8 (&qf)[4], LDSP const unsigned char* ka, LDSP const unsigned char* kb, int lane, const TP& ta, const TP& tb) {
    const int r32 = lane & 31, hi = lane >> 5;
    const float m0 = st.m;
    f32x16 a0, a1, b0, b1; u32x4 pwa[4], pwb[4];
    bf16x8 kfa[8], kfb[8], vf[8];
    pair_kload(kfa, ka, r32, hi); pair_kload(kfb, kb, r32, hi);
    PAIR_LDS_WAIT();
    pair_qk(a0, a1, ta.rowoff ? -INFINITY : -m0, qf, kfa);
    pair_qk(b0, b1, tb.rowoff ? -INFINITY : -m0, qf, kfb);
    pair_vload(vf, ka, lane, hi);
    __builtin_amdgcn_sched_barrier(0);
    pair_sm(st, a0, a1, pwa, ta, 0.f, hi);
    PAIR_LDS_WAIT();
    pair_pv(st, pwa, vf);
    __builtin_amdgcn_sched_barrier(0);
    pair_vload(vf, kb, lane, hi);
    __builtin_amdgcn_sched_barrier(0);
    pair_sm(st, b0, b1, pwb, tb, st.m - m0, hi);
    PAIR_LDS_WAIT();
    pair_pv(st, pwb, vf);
}
template <int I, bool MASK>
__device__ __forceinline__ void pair_exp_chunk(const f32x16& p0, const f32x16& p1, u32x4 (&pw)[4], float& sacc, int kl2, int kh2) {
    const f32x16& src = (I < 4) ? p0 : p1; constexpr int b = 4 * (I & 3);
    float x0 = src[b], x1 = src[b + 1], x2 = src[b + 2], x3 = src[b + 3];
    if (MASK) {
        constexpr int c0 = 8 * (b >> 2) + ((I < 4) ? 0 : 32);
        x0 = (c0 >= kl2 && c0 <= kh2) ? x0 : -INFINITY; x1 = (c0 + 1 >= kl2 && c0 + 1 <= kh2) ? x1 : -INFINITY;
        x2 = (c0 + 2 >= kl2 && c0 + 2 <= kh2) ? x2 : -INFINITY; x3 = (c0 + 3 >= kl2 && c0 + 3 <= kh2) ? x3 : -INFINITY;
    }
    const float e0 = __builtin_amdgcn_exp2f(x0), e1 = __builtin_amdgcn_exp2f(x1), e2 = __builtin_amdgcn_exp2f(x2), e3 = __builtin_amdgcn_exp2f(x3);
    sacc += (e0 + e1) + (e2 + e3);
    pw[I >> 1][(I & 1) * 2] = pk2(e0, e1); pw[I >> 1][(I & 1) * 2 + 1] = pk2(e2, e3);
}
#define PAIR_SB() __builtin_amdgcn_sched_barrier(0)
__device__ __forceinline__ bf16x8 vfrag_load(LDSP const unsigned char* vb, int idx) {
    const int off = ((idx & 1) * 4 + (idx >> 1)) * 1024;
    const v4i16_t lo = __builtin_amdgcn_ds_read_tr16_b64_v4i16((LDSP v4i16_t*)(vb + off));
    const v4i16_t hh = __builtin_amdgcn_ds_read_tr16_b64_v4i16((LDSP v4i16_t*)(vb + off + 512));
    return (bf16x8){lo[0], lo[1], lo[2], lo[3], hh[0], hh[1], hh[2], hh[3]};
}
template <bool MASK>
__device__ __forceinline__ void attn_pair_fast(ASt& st, const bf16x8 (&qf)[4], LDSP const unsigned char* ka, LDSP const unsigned char* kb, int lane, const TP& ta, const TP& tb) {
    const int r32 = lane & 31, hi = lane >> 5; const bool offa = ta.rowoff, offb = tb.rowoff;
    const int kla = ta.kl - 4 * hi, kha = ta.kh - 4 * hi, klb = tb.kl - 4 * hi, khb = tb.kh - 4 * hi;
    LDSP const unsigned char* vba = ka + 8192 + ((lane >> 4) & 1) * 32 + (lane & 3) * 8 + (4 * hi + ((lane & 15) >> 2)) * 64;
    LDSP const unsigned char* vbb = vba + (kb - ka);
    f32x16 a0, a1, b0, b1; u32x4 pwa[4], pwb[4];
    bf16x8 kfa[8], kfb[8], vfa[8], vfb[8];
    pair_kload(kfa, ka, r32, hi);
    { f32x16 c16; const float cina = offa ? -INFINITY : -st.m;
#pragma unroll
      for (int r = 0; r < 16; ++r) c16[r] = cina;
      asm volatile("s_waitcnt lgkmcnt(0)" ::: "memory"); PAIR_SB();
#define QKA_STEP(I) do { if ((I) & 1) a1 = __builtin_amdgcn_mfma_f32_32x32x16_bf16(kfa[I], qf[(I) >> 1], (I) == 1 ? c16 : a1, 0, 0, 0); \
                         else         a0 = __builtin_amdgcn_mfma_f32_32x32x16_bf16(kfa[I], qf[(I) >> 1], (I) == 0 ? c16 : a0, 0, 0, 0); \
                         kfb[I] = *(const LDSP bf16x8*)(kb + swz_off(r32 + 32 * ((I) & 1), 2 * ((I) >> 1) + hi)); PAIR_SB(); } while (0)
      QKA_STEP(0); QKA_STEP(1); QKA_STEP(2); QKA_STEP(3); QKA_STEP(4); QKA_STEP(5); QKA_STEP(6); QKA_STEP(7);
#undef QKA_STEP
    }
    float sa = 0.f, sbm = 0.f;
    { f32x16 c16; const float cinb = offb ? -INFINITY : -st.m;
#pragma unroll
      for (int r = 0; r < 16; ++r) c16[r] = cinb;
      asm volatile("s_waitcnt lgkmcnt(0)" ::: "memory"); PAIR_SB();
#define QKB_STEP(I) do { if ((I) & 1) b1 = __builtin_amdgcn_mfma_f32_32x32x16_bf16(kfb[I], qf[(I) >> 1], (I) == 1 ? c16 : b1, 0, 0, 0); \
                         else         b0 = __builtin_amdgcn_mfma_f32_32x32x16_bf16(kfb[I], qf[(I) >> 1], (I) == 0 ? c16 : b0, 0, 0, 0); \
                         if ((I) >= 4) vfa[(I) - 4] = vfrag_load(vba, (I) - 4); \
                         pair_exp_chunk<I, MASK>(a0, a1, pwa, sa, kla, kha); PAIR_SB(); } while (0)
      QKB_STEP(0); QKB_STEP(1); QKB_STEP(2); QKB_STEP(3); QKB_STEP(4); QKB_STEP(5); QKB_STEP(6); QKB_STEP(7);
#undef QKB_STEP
    }
    asm volatile("s_waitcnt lgkmcnt(0)" ::: "memory"); PAIR_SB();
#define PVA_STEP(I) do { if ((I) & 1) st.o1 = __builtin_amdgcn_mfma_f32_32x32x16_bf16(vfa[I], __builtin_bit_cast(bf16x8, pwa[(I) >> 1]), st.o1, 0, 0, 0); \
                         else         st.o0 = __builtin_amdgcn_mfma_f32_32x32x16_bf16(vfa[I], __builtin_bit_cast(bf16x8, pwa[(I) >> 1]), st.o0, 0, 0, 0); \
                         if ((I) < 4) vfa[(I) + 4] = vfrag_load(vba, (I) + 4); else vfb[(I) - 4] = vfrag_load(vbb, (I) - 4); \
                         pair_exp_chunk<I, MASK>(b0, b1, pwb, sbm, klb, khb); PAIR_SB(); \
                         if ((I) == 3) { asm volatile("s_waitcnt lgkmcnt(0)" ::: "memory"); PAIR_SB(); } } while (0)
    PVA_STEP(0); PVA_STEP(1); PVA_STEP(2); PVA_STEP(3); PVA_STEP(4); PVA_STEP(5); PVA_STEP(6); PVA_STEP(7);
#undef PVA_STEP
    st.l += sa + sbm;
    asm volatile("s_waitcnt lgkmcnt(0)" ::: "memory"); PAIR_SB();
#define PVB_STEP(I) do { if ((I) & 1) st.o1 = __builtin_amdgcn_mfma_f32_32x32x16_bf16(vfb[I], __builtin_bit_cast(bf16x8, pwb[(I) >> 1]), st.o1, 0, 0, 0); \
                         else         st.o0 = __builtin_amdgcn_mfma_f32_32x32x16_bf16(vfb[I], __builtin_bit_cast(bf16x8, pwb[(I) >> 1]), st.o0, 0, 0, 0); \
                         if ((I) < 4) vfb[(I) + 4] = vfrag_load(vbb, (I) + 4); PAIR_SB(); \
                         if ((I) == 3) { asm volatile("s_waitcnt lgkmcnt(0)" ::: "memory"); PAIR_SB(); } } while (0)
    PVB_STEP(0); PVB_STEP(1); PVB_STEP(2); PVB_STEP(3); PVB_STEP(4); PVB_STEP(5); PVB_STEP(6); PVB_STEP(7);
#undef PVB_STEP
    const float lpair = fmaxf(st.l, swap32f(st.l));
    if (__any(lpair > 1.0e18f)) {
        const float dl = (lpair > 1.0e18f) ? 64.f : 0.f, alpha = __builtin_amdgcn_exp2f(-dl);
        st.m += dl; st.l *= alpha;
#pragma unroll
        for (int r = 0; r < 16; ++r) { st.o0[r] *= alpha; st.o1[r] *= alpha; }
    }
}

#define KV_LOOP_PAIR(NT, KPTR, VDELTA, PITCH, TPF) do { const int nt_ = (NT), np_ = (nt_ + 1) >> 1; const int wu_ = __builtin_amdgcn_readfirstlane(wid); __syncthreads(); \
    { const int i = 0; kv_dma((KPTR), (KPTR) + (VDELTA), (PITCH), lds, wu_, lane); } { const int i = (nt_ > 1) ? 1 : 0; kv_dma((KPTR), (KPTR) + (VDELTA), (PITCH), lds + 16384, wu_, lane); } \
    asm volatile("s_waitcnt vmcnt(0)" ::: "memory"); __syncthreads(); \
    _Pragma("unroll 1") for (int ip_ = 0; ip_ < np_; ++ip_) { LDSP unsigned char* cur0_ = lds + (ip_ & 1) * 32768; LDSP unsigned char* nxt0_ = lds + ((ip_ + 1) & 1) * 32768; \
        if (ip_ + 1 < np_) { { const int i = 2 * ip_ + 2; kv_dma((KPTR), (KPTR) + (VDELTA), (PITCH), nxt0_, wu_, lane); } \
                             { const int i = (2 * ip_ + 3 < nt_) ? 2 * ip_ + 3 : 2 * ip_ + 2; kv_dma((KPTR), (KPTR) + (VDELTA), (PITCH), nxt0_ + 16384, wu_, lane); } } \
        if (2 * ip_ + 1 < nt_) { const TP ta_ = TPF(2 * ip_), tb_ = TPF(2 * ip_ + 1); \
            if (ta_.nm || tb_.nm) attn_pair_fast<true>(st, qf, cur0_, cur0_ + 16384, lane, ta_, tb_); else attn_pair_fast<false>(st, qf, cur0_, cur0_ + 16384, lane, ta_, tb_); } \
        else { const TP ta_ = TPF(2 * ip_); attn_tile<0>(st, qf, cur0_, lane, ta_.rowoff, ta_.kl, ta_.kh, ta_.nm, 0.f, nullptr, nullptr, 0, 0); } \
        asm volatile("s_waitcnt vmcnt(0)" ::: "memory"); \
        __syncthreads(); } } while (0)

__device__ __forceinline__ void store_ot(bf16_t* dst, const f32x16& o0, const f32x16& o1, int hi) {
#pragma unroll
    for (int qd = 0; qd < 4; ++qd) {
        u32x2 w0, w1;
        w0.x = pk2(o0[4 * qd], o0[4 * qd + 1]); w0.y = pk2(o0[4 * qd + 2], o0[4 * qd + 3]);
        w1.x = pk2(o1[4 * qd], o1[4 * qd + 1]); w1.y = pk2(o1[4 * qd + 2], o1[4 * qd + 3]);
        *(u32x2*)(dst + 8 * qd + 4 * hi) = w0; *(u32x2*)(dst + 32 + 8 * qd + 4 * hi) = w1;
    }
}

__device__ __forceinline__ void moba_unit(const Params& P, LDSP unsigned char* lds, int b, int h, int blk) {
    unsigned char* ws = P.ws;
    const int tid = opaque_tid(), lane = tid & 63, wid = tid >> 6, r32 = lane & 31, hi = lane >> 5;
    const bf16_t* qa = (const bf16_t*)(ws + OFF_R1);
    const bf16_t* ka = (const bf16_t*)(ws + OFF_R1 + 32 * MiB);
    const bf16_t* va = (const bf16_t*)(ws + OFF_R1 + 64 * MiB);
    bf16_t* ya = (bf16_t*)(ws + OFF_R0);
    const float* kmean = (const float*)(ws + OFF_KMEAN) + (size_t)((b * 8 + h) * 16) * 64;
    LDSP float* km = (LDSP float*)(lds + A_MISC);
    LDSP unsigned short* sel16 = (LDSP unsigned short*)(lds + A_MISC + 4096);
    __syncthreads();
    for (int i = tid; i < blk * 64; i += NTHREADS) km[i] = kmean[i];
    __syncthreads();
    {
        const int qi = tid >> 1, hf = tid & 1;
        const bf16_t* qrow = qa + (size_t)(b * SEQ + blk * 256 + qi) * 512 + h * 64 + hf * 32;
        float q[32];
#pragma unroll
        for (int c = 0; c < 4; ++c) { float f[8]; cvt8(*(const u32x4*)(qrow + c * 8), f);
#pragma unroll
            for (int i = 0; i < 8; ++i) q[c * 8 + i] = f[i]; }
        float g0 = -INFINITY, g1 = -INFINITY, g2 = -INFINITY; int i0 = -1, i1 = -1, i2 = -1;
        for (int j = 0; j < blk; ++j) {
            float d = 0.f;
#pragma unroll
            for (int i = 0; i < 32; ++i) d += q[i] * km[j * 64 + hf * 32 + i];
            d += __shfl_xor(d, 1);
            if (d > g0) { g2 = g1; i2 = i1; g1 = g0; i1 = i0; g0 = d; i0 = j; }
            else if (d > g1) { g2 = g1; i2 = i1; g1 = d; i1 = j; }
            else if (d > g2) { g2 = d; i2 = j; }
        }
        unsigned mask = 0;
        if (i0 >= 0) mask |= 1u << i0;
        if (i1 >= 0) mask |= 1u << i1;
        if (i2 >= 0) mask |= 1u << i2;
        if (hf == 0) sel16[qi] = (unsigned short)mask;
    }
    __syncthreads();
    const int qloc = wid * 32 + r32;
    const size_t qrow_g = (size_t)(b * SEQ + blk * 256 + qloc);
    bf16x8 qf[4];
#pragma unroll
    for (int d0 = 0; d0 < 4; ++d0) qf[d0] = *(const bf16x8*)(qa + qrow_g * 512 + h * 64 + d0 * 16 + hi * 8);
    const unsigned selbits = sel16[qloc];
    ASt st; ast_reset(st);
    const bf16_t* kbase = ka + (size_t)(b * SEQ) * 512 + h * 64;
    const bf16_t* vbase = va + (size_t)(b * SEQ) * 512 + h * 64;
    auto moba_tp = [=](int ti) -> TP { const int jb = ti >> 2, t4 = ti & 3; const bool past = jb < blk;
        int l_ = lane; asm volatile("" : "+v"(l_)); const int w_ = __builtin_amdgcn_readfirstlane(wid), ql_ = w_ * 32 + (l_ & 31);
        TP t; t.rowoff = past ? !((selbits >> jb) & 1u) : (64 * t4 > ql_); t.nm = !past && (64 * t4 + 63 > w_ * 32); t.kl = 0; t.kh = past ? 63 : ql_ - 64 * t4; return t; };
    KV_LOOP_PAIR(4 * (blk + 1), kbase + (size_t)i * 64 * 512, (size_t)16 * 1024 * 1024, 512, moba_tp);
    const float lt = st.l + swap32f(st.l);
    const float inv = 1.0f / lt;
#pragma unroll
    for (int r = 0; r < 16; ++r) { st.o0[r] *= inv; st.o1[r] *= inv; }
    { const int t2 = opaque_tid(), l2 = t2 & 63;
      const size_t row2 = (size_t)(b * SEQ + blk * 256 + (t2 >> 6) * 32 + (l2 & 31));
      store_ot((bf16_t*)(P.ws + OFF_R0) + row2 * 512 + h * 64, st.o0, st.o1, l2 >> 5); }
}

__device__ __forceinline__ void nsa_unit(const Params& P, LDSP unsigned char* lds, int b, int g, int c) {
    unsigned char* ws = P.ws;
    const int tid = opaque_tid(), lane = tid & 63, wid = tid >> 6, r32 = lane & 31, hi = lane >> 5;
    const bf16_t* qb = (const bf16_t*)(ws + OFF_R1 + 96 * MiB);
    const bf16_t* kc = (const bf16_t*)(ws + OFF_KC) + (size_t)(b * 2 + g) * 256 * 64;
    const bf16_t* vc = (const bf16_t*)(ws + OFF_VC) + (size_t)(b * 2 + g) * 256 * 64;
    const bf16_t* ks = (const bf16_t*)(ws + OFF_R2 + 16 * MiB) + (size_t)(b * SEQ) * 128 + g * 64;
    const bf16_t* vs = (const bf16_t*)(ws + OFF_R2 + 24 * MiB) + (size_t)(b * SEQ) * 128 + g * 64;
    const bf16_t* kw = (const bf16_t*)(ws + OFF_R2 + 32 * MiB) + (size_t)(b * SEQ) * 128 + g * 64;
    const bf16_t* vw = (const bf16_t*)(ws + OFF_R2 + 40 * MiB) + (size_t)(b * SEQ) * 128 + g * 64;
    const float* bgate = (const float*)(ws + OFF_BGATE);
    bf16_t* yb = (bf16_t*)(ws + OFF_R0 + 32 * MiB);
    LDSP float* gs = (LDSP float*)(lds + A_GS);
    LDSP float* es = (LDSP float*)(lds + A_ES);
    LDSP unsigned long long* selm = (LDSP unsigned long long*)(lds + A_MISC);
    const int ql = wid * 8 + (r32 >> 2), hr = r32 & 3, head = g * 4 + hr, pos = c * 64 + ql;
    const size_t trow = (size_t)(b * SEQ + pos);
    bf16x8 qf[4];
#pragma unroll
    for (int d0 = 0; d0 < 4; ++d0) qf[d0] = *(const bf16x8*)(qb + trow * 512 + head * 64 + d0 * 16 + hi * 8);
    const int nmax = (pos >= 31) ? ((pos - 31) >> 4) : -1;
    const int ntc = ((4 * c + 2) >> 6) + 1;
    ASt st; ast_reset(st);
    KV_LOOP(ntc, kc + (size_t)i * 64 * 64, vc + (size_t)i * 64 * 64, 64, {
        attn_tile<1>(st, qf, cur, lane, nmax < 0, 0, nmax - 64 * i, true, 0.f, nullptr, nullptr, 0, 0);
    });
    {
        const float lt = st.l + swap32f(st.l);
        const float linv = (lt > 0.f) ? 1.0f / lt : 0.f;
        KV_LOOP(ntc, kc + (size_t)i * 64 * 64, vc + (size_t)i * 64 * 64, 64, {
            attn_tile<2>(st, qf, cur, lane, nmax < 0, 0, nmax - 64 * i, true, linv, gs, es, 16 * i, ql);
        });
    }
    LDSP float* yl = (LDSP float*)(lds + A_Y) + wid * 2048 + lane;
    __syncthreads();
    for (int qq = 0; qq < 8; ++qq) {
        const int q = wid * 8 + qq, j = lane;
        unsigned long long m;
        if (c < 16) m = (2ull << c) - 1ull;
        else {
            const bool cand = (j >= 1 && j <= c - 2);
            float imp = 0.f;
            if (cand) imp = gs[q * 64 + j] + es[q * 64 + j - 1];
            int rank = 0;
            for (int jp = 1; jp <= c - 2; ++jp) {
                const float o = __uint_as_float(__builtin_amdgcn_readlane(__float_as_uint(imp), jp));
                rank += (o > imp || (o == imp && jp < j)) ? 1 : 0;
            }
            const bool sel = (j == 0) || (j == c) || (j == c - 1) || (cand && rank < 13);
            m = __ballot(sel);
        }
        if (lane == 0) selm[q] = m;
    }
    __syncthreads();
    { const int t2 = opaque_tid(), l2 = t2 & 63; const size_t trow2 = (size_t)(b * SEQ + c * 64 + (t2 >> 6) * 8 + ((l2 & 31) >> 2)); const int head2 = g * 4 + (l2 & 3);
      const float gt0 = ((const float*)(P.ws + OFF_BGATE))[trow2 * 24 + head2 * 3 + 0];
#pragma unroll
    for (int r = 0; r < 16; ++r) { yl[r * 64] = gt0 * st.o0[r]; yl[(16 + r) * 64] = gt0 * st.o1[r]; } }
    const unsigned long long selmask = selm[ql];
    ast_reset(st);
    auto slc_tp = [=](int ti) -> TP { int l_ = lane; asm volatile("" : "+v"(l_)); const int ql_ = __builtin_amdgcn_readfirstlane(wid) * 8 + ((l_ & 31) >> 2);
        TP t; t.rowoff = !((selmask >> ti) & 1ull); t.nm = (ti == c); t.kl = 0; t.kh = (ti == c) ? ql_ : 63; return t; };
    KV_LOOP_PAIR(c + 1, ks + (size_t)i * 64 * 128, (size_t)4 * 1024 * 1024, 128, slc_tp);
    {
        const float lt = st.l + swap32f(st.l);
        const int t2 = opaque_tid(), l2 = t2 & 63; const size_t trow2 = (size_t)(b * SEQ + c * 64 + (t2 >> 6) * 8 + ((l2 & 31) >> 2)); const int head2 = g * 4 + (l2 & 3);
        LDSP float* yl = (LDSP float*)(lds + A_Y) + (t2 >> 6) * 2048 + l2;
        const float sc = ((const float*)(P.ws + OFF_BGATE))[trow2 * 24 + head2 * 3 + 1] / lt;
#pragma unroll
        for (int r = 0; r < 16; ++r) { yl[r * 64] += sc * st.o0[r]; yl[(16 + r) * 64] += sc * st.o1[r]; }
    }
    ast_reset(st);
    const int j0 = (c >= 8) ? c - 8 : 0;
    auto win_tp = [=](int ti) -> TP { const int j = j0 + ti; const bool first = (j == c - 8), own = (j == c);
        int l_ = lane; asm volatile("" : "+v"(l_)); const int ql_ = __builtin_amdgcn_readfirstlane(wid) * 8 + ((l_ & 31) >> 2);
        TP t; t.rowoff = false; t.nm = first || own; t.kl = first ? ql_ + 1 : 0; t.kh = own ? ql_ : 63; return t; };
    KV_LOOP_PAIR(c - j0 + 1, kw + (size_t)(j0 + i) * 64 * 128, (size_t)4 * 1024 * 1024, 128, win_tp);
    {
        const float lt = st.l + swap32f(st.l);
        const int t2 = opaque_tid(), l2 = t2 & 63; const size_t trow2 = (size_t)(b * SEQ + c * 64 + (t2 >> 6) * 8 + ((l2 & 31) >> 2)); const int head2 = g * 4 + (l2 & 3);
        LDSP float* yl = (LDSP float*)(lds + A_Y) + (t2 >> 6) * 2048 + l2;
        const float sc = ((const float*)(P.ws + OFF_BGATE))[trow2 * 24 + head2 * 3 + 2] / lt;
        f32x16 y0, y1;
#pragma unroll
        for (int r = 0; r < 16; ++r) { y0[r] = yl[r * 64] + sc * st.o0[r]; y1[r] = yl[(16 + r) * 64] + sc * st.o1[r]; }
        store_ot((bf16_t*)(P.ws + OFF_R0 + 32 * MiB) + trow2 * 512 + head2 * 64, y0, y1, l2 >> 5);
    }
}

__device__ __forceinline__ void phase_attn(const Params& P, LDSP unsigned char* lds, int vcu, int G) {
    const int nloc = (G == 256) ? 8 : (2048 - vcu + G - 1) / G;
    for (int k = 0; k < nloc; ++k) {
        int u;
        if (G == 256) {
            const int kk = k >> 1;
            if (!(k & 1)) { const int bh = vcu >> 2, jm = vcu & 3; const int blk = (kk == 0) ? 15 - jm : (kk == 1) ? 8 + jm : (kk == 2) ? 7 - jm : jm; u = bh * 16 + blk; }
            else { const int bg = vcu >> 4, jn = vcu & 15; const int c = (kk == 0) ? 63 - jn : (kk == 1) ? 32 + jn : (kk == 2) ? 31 - jn : jn; u = 1024 + bg * 64 + c; }
        } else u = vcu + k * G;
        if (u < 1024) moba_unit(P, lds, u >> 7, (u >> 4) & 7, u & 15);
        else { const int v = u - 1024; nsa_unit(P, lds, v >> 7, (v >> 6) & 1, v & 63); }
    }
}

struct EpiUp {
    const Params* P;
    __device__ __forceinline__ void operator()(f32x4 (&acc)[2][2][4][2], const pg8::Unit& u, int wr, int wc, int fr, int fq) const {
        bf16_t* g = (bf16_t*)(P->ws + OFF_R3);
#pragma unroll
        for (int ai = 0; ai < 2; ++ai)
#pragma unroll
            for (int m = 0; m < 4; ++m) {
                const int row = u.pm * 256 + ai * 128 + wr * 64 + m * 16 + fr;
#pragma unroll
                for (int bj = 0; bj < 2; ++bj) {
                    bf16_t* rp = g + (size_t)row * 2048 + u.pn * 256 + bj * 128 + wc * 32 + 8 * fq;
                    const u32x4 gg = *(const u32x4*)(rp + (u.z ? 1024 : 0));
                    float gf[8]; cvt8(gg, gf);
                    float o[8];
#pragma unroll
                    for (int n = 0; n < 2; ++n)
#pragma unroll
                        for (int i = 0; i < 4; ++i) o[4 * n + i] = gf[4 * n + i] * acc[ai][bj][m][n][i];
                    if (u.z) { float pf[8]; cvt8(*(const u32x4*)rp, pf);
#pragma unroll
                        for (int i = 0; i < 8; ++i) o[i] += pf[i]; }
                    u32x4 w; w.x = pk2(o[0], o[1]); w.y = pk2(o[2], o[3]); w.z = pk2(o[4], o[5]); w.w = pk2(o[6], o[7]);
                    *(u32x4*)rp = w;
                }
            }
    }
};
__device__ __forceinline__ void phase_up(const Params& P, LDSP unsigned char* lds, int vcu, int G) {
    pg8::Sched S; S.A0 = (const bf16_t*)(P.ws + OFF_R0); S.A1 = (const bf16_t*)(P.ws + OFF_R0 + 32 * MiB);
    S.B0 = (const bf16_t*)(P.ws + OFF_WUPA_T); S.B1 = (const bf16_t*)(P.ws + OFF_WUPB_T);
    S.lda = 512; S.ldb = 512; S.K = 512; S.nM = T / 256; S.nN = DM / 256; S.NZ = 2; S.G = G; S.c = blockIdx.x;
    EpiUp E{&P};
    pg8::gemm_phase(lds, S, E);
}

struct EpiOut {
    const Params* P;
    __device__ __forceinline__ void operator()(f32x4 (&acc)[2][2][4][2], const pg8::Unit& u, int wr, int wc, int fr, int fq) const {
        bf16_t* x1b = (bf16_t*)(P->ws + OFF_R0);
        float* rs2 = (float*)(P->ws + OFF_RS2);
        const float* x = P->in[I_X];
#pragma unroll
        for (int ai = 0; ai < 2; ++ai)
#pragma unroll
            for (int m = 0; m < 4; ++m) {
                const int row = u.pm * 256 + ai * 128 + wr * 64 + m * 16 + fr;
                float ss = 0.f;
                f32x4 xv[2][2];
#pragma unroll
                for (int bj = 0; bj < 2; ++bj)
#pragma unroll
                    for (int n = 0; n < 2; ++n) xv[bj][n] = *(const f32x4*)(x + (size_t)row * DM + u.pn * 256 + bj * 128 + wc * 32 + 8 * fq + 4 * n);
#pragma unroll
                for (int bj = 0; bj < 2; ++bj) {
                    const size_t off = (size_t)row * DM + u.pn * 256 + bj * 128 + wc * 32 + 8 * fq;
                    const f32x4 o0 = xv[bj][0] + acc[ai][bj][m][0], o1 = xv[bj][1] + acc[ai][bj][m][1];
                    u32x4 w; w.x = pk2(o0.x, o0.y); w.y = pk2(o0.z, o0.w); w.z = pk2(o1.x, o1.y); w.w = pk2(o1.z, o1.w);
                    *(u32x4*)(x1b + off) = w;
                    ss += ((o0.x * o0.x + o0.y * o0.y) + (o0.z * o0.z + o0.w * o0.w)) + ((o1.x * o1.x + o1.y * o1.y) + (o1.z * o1.z + o1.w * o1.w));
                }
                ss += __shfl_xor(ss, 16); ss += __shfl_xor(ss, 32);
                if (fq == 0) atomicAdd(rs2 + row, ss);
            }
    }
};
__device__ __forceinline__ void phase_out(const Params& P, LDSP unsigned char* lds, int vcu, int G) {
    pg8::Sched S; S.A0 = S.A1 = (const bf16_t*)(P.ws + OFF_R3); S.B0 = S.B1 = (const bf16_t*)(P.ws + OFF_WOUT_T);
    S.lda = 2048; S.ldb = DM; S.K = DM; S.nM = T / 256; S.nN = DM / 256; S.NZ = 1; S.G = G; S.c = blockIdx.x;
    EpiOut E{&P};
    pg8::gemm_phase(lds, S, E);
}

struct EpiPq {
    const Params* P;
    __device__ __forceinline__ void operator()(f32x4 (&acc)[2][2][4][2], const pg8::Unit& u, int wr, int wc, int fr, int fq) const {
        bf16_t* qp = (bf16_t*)(P->ws + OFF_R1);
        const float* rs2 = (const float*)(P->ws + OFF_RS2);
        float rr[2][4];
#pragma unroll
        for (int ai = 0; ai < 2; ++ai)
#pragma unroll
            for (int m = 0; m < 4; ++m) rr[ai][m] = 1.0f / sqrtf(rs2[u.pm * 256 + ai * 128 + wr * 64 + m * 16 + fr] * (1.0f / DM) + NORM_EPS);
#pragma unroll
        for (int ai = 0; ai < 2; ++ai)
#pragma unroll
            for (int m = 0; m < 4; ++m) {
                const int row = u.pm * 256 + ai * 128 + wr * 64 + m * 16 + fr;
                const float r = rr[ai][m];
#pragma unroll
                for (int bj = 0; bj < 2; ++bj) {
                    const f32x4 a0 = acc[ai][bj][m][0], a1 = acc[ai][bj][m][1];
                    u32x4 w; w.x = pk2(a0[0] * r, a0[1] * r); w.y = pk2(a0[2] * r, a0[3] * r); w.z = pk2(a1[0] * r, a1[1] * r); w.w = pk2(a1[2] * r, a1[3] * r);
                    *(u32x4*)(qp + (size_t)row * 2048 + u.pn * 256 + bj * 128 + wc * 32 + 8 * fq) = w;
                }
            }
    }
};
__device__ __forceinline__ void phase_pq(const Params& P, LDSP unsigned char* lds, int vcu, int G) {
    pg8::Sched S; S.A0 = S.A1 = (const bf16_t*)(P.ws + OFF_R0); S.B0 = S.B1 = (const bf16_t*)(P.ws + OFF_WPQ_T);
    S.lda = DM; S.ldb = DM; S.K = DM; S.nM = T / 256; S.nN = 2048 / 256; S.NZ = 1; S.G = G; S.c = blockIdx.x;
    EpiPq E{&P};
    pg8::gemm_phase(lds, S, E);
}

__device__ __forceinline__ unsigned f2ord(float f) { const unsigned u = __float_as_uint(f); return u ^ ((unsigned)((int)u >> 31) | 0x80000000u); }
__device__ __forceinline__ float ord2f(unsigned o) { const unsigned u = (o & 0x80000000u) ? (o ^ 0x80000000u) : ~o; return __uint_as_float(u); }
__device__ __forceinline__ void ins16(unsigned (&top)[16], unsigned x) {
#pragma unroll
    for (int j = 0; j < 16; ++j) { const unsigned t = max(x, top[j]); x = min(x, top[j]); top[j] = t; }
}
__device__ __forceinline__ int crow(int r, int hi) { return (r & 3) + 8 * (r >> 2) + 4 * hi; }
__device__ __forceinline__ void ce_desc(unsigned& a, unsigned& b) { const unsigned hi_ = max(a, b), lo_ = min(a, b); a = hi_; b = lo_; }
__device__ __forceinline__ void bitonic_merge16_desc(unsigned (&a)[16]) {
#pragma unroll
    for (int j = 8; j > 0; j >>= 1)
#pragma unroll
        for (int i = 0; i < 16; ++i) { const int l = i ^ j; if (l > i) ce_desc(a[i], a[l]); }
}
__device__ __forceinline__ void sort16_desc(unsigned (&a)[16]) {
#pragma unroll
    for (int k = 2; k <= 16; k <<= 1)
#pragma unroll
        for (int j = k >> 1; j > 0; j >>= 1)
#pragma unroll
            for (int i = 0; i < 16; ++i) { const int l = i ^ j; if (l > i) { if ((i & k) == 0) ce_desc(a[i], a[l]); else ce_desc(a[l], a[i]); } }
}
__device__ __forceinline__ void merge_top16(unsigned (&top)[16], const unsigned (&blk)[16]) {
#pragma unroll
    for (int i = 0; i < 16; ++i) top[i] = max(top[i], blk[15 - i]);
    bitonic_merge16_desc(top);
}
constexpr int cand_prefix(int i) { int n = 0; for (int a = 0; a < i; ++a) n += 16 / (a + 1); return n; }

constexpr int P8_KOFF = 0, P8_IDX = 65536;
__device__ __forceinline__ void phase_topk(const Params& P, LDSP unsigned char* lds, int vcu, int G) {
    unsigned char* ws = P.ws;
    const bf16_t* qp = (const bf16_t*)(ws + OFF_R1);
    int* experts = (int*)(ws + OFF_EXPERTS);
    float* gates = (float*)(ws + OFF_GATES);
    const int tid = opaque_tid(), lane = tid & 63, wave = tid >> 6, r32 = lane & 31, hi = lane >> 5;
    __syncthreads();
    for (int i = tid; i < 2 * 128 * 16; i += NTHREADS) {
        const int w = i >> 11, row = (i >> 4) & 127, ch = i & 15;
        const u32x4 v = *(const u32x4*)((const bf16_t*)(ws + (w ? OFF_K2B : OFF_K1B)) + row * 128 + ch * 8);
        *(LDSP u32x4*)(lds + P8_KOFF + w * 32768 + row * 256 + ((ch ^ (row & 15)) << 4)) = v;
    }
    __syncthreads();
    LDSP unsigned char* myidx = lds + P8_IDX + (wave * 64 + lane) * 32;
    const int gw = vcu * NWAVES + wave, NGW = G * NWAVES;
    for (int item = gw; item < (T / 32) * 8; item += NGW) {
        const int tg = item >> 3, h = item & 7;
        const int tok = tg * 32 + r32;
        unsigned tops[2][16];
#pragma unroll
        for (int L = 0; L < 2; ++L) {
            bf16x8 qf[8];
            const bf16_t* qrow = qp + (size_t)tok * 2048 + h * 256 + L * 128 + hi * 8;
#pragma unroll
            for (int s8 = 0; s8 < 8; ++s8) qf[s8] = *(const bf16x8*)(qrow + s8 * 16);
            unsigned top[16];
#pragma unroll
            for (int kb = 0; kb < 4; ++kb) {
                f32x16 acc = {0.f, 0.f, 0.f, 0.f, 0.f, 0.f, 0.f, 0.f, 0.f, 0.f, 0.f, 0.f, 0.f, 0.f, 0.f, 0.f};
                const int row = kb * 32 + r32;
#pragma unroll
                for (int s8 = 0; s8 < 8; ++s8) {
                    const bf16x8 kf = *(const LDSP bf16x8*)(lds + P8_KOFF + L * 32768 + row * 256 + (((2 * s8 + hi) ^ (row & 15)) << 4));
                    acc = __builtin_amdgcn_mfma_f32_32x32x16_bf16(kf, qf[s8], acc, 0, 0, 0);
                }
                unsigned blk[16];
#pragma unroll
                for (int r = 0; r < 16; ++r) {
                    const int key = kb * 32 + (r & 3) + 8 * (r >> 2) + 4 * hi;
                    blk[r] = (f2ord(acc[r]) & ~0x7Fu) | (unsigned)(127 - key);
                }
                sort16_desc(blk);
                if (kb == 0) {
#pragma unroll
                    for (int j = 0; j < 16; ++j) top[j] = blk[j];
                } else merge_top16(top, blk);
            }
            unsigned oth[16];
#pragma unroll
            for (int j = 0; j < 16; ++j) oth[j] = (unsigned)__shfl_xor((int)top[j], 32);
            merge_top16(top, oth);
#pragma unroll
            for (int j = 0; j < 16; ++j) tops[L][j] = top[j];
        }
        float v1[16], v2[16];
#pragma unroll
        for (int j = 0; j < 16; j += 4) {
            unsigned w1 = 0, w2 = 0;
#pragma unroll
            for (int q = 0; q < 4; ++q) { w1 |= (127u - (tops[0][j + q] & 127u)) << (8 * q); w2 |= (127u - (tops[1][j + q] & 127u)) << (8 * q); }
            *(LDSP unsigned*)(myidx + j) = w1; *(LDSP unsigned*)(myidx + 16 + j) = w2;
        }
#pragma unroll
        for (int j = 0; j < 16; ++j) { v1[j] = ord2f(tops[0][j] & ~0x7Fu); v2[j] = ord2f(tops[1][j] & ~0x7Fu); }
        unsigned ct[16];
        {
            unsigned cand[64];
#pragma unroll
            for (int n = 0; n < 64; ++n) cand[n] = 0u;
#pragma unroll
            for (int i = 0; i < 16; ++i)
#pragma unroll
                for (int j = 0; j < 16; ++j)
                    if ((i + 1) * (j + 1) <= 16) cand[cand_prefix(i) + j] = (f2ord(v1[i] + v2[j]) & ~0xFFu) | (unsigned)(255 - (i * 16 + j));
#pragma unroll
            for (int bk = 0; bk < 4; ++bk) {
                unsigned blk[16];
#pragma unroll
                for (int r = 0; r < 16; ++r) blk[r] = cand[bk * 16 + r];
                sort16_desc(blk);
                if (bk == 0) {
#pragma unroll
                    for (int j = 0; j < 16; ++j) ct[j] = blk[j];
                } else merge_top16(ct, blk);
            }
        }
        float vals[16], ssum = 0.f;
        const float vmax = ord2f(ct[0] & ~0xFFu);
#pragma unroll
        for (int k = 0; k < 16; ++k) { vals[k] = __expf(ord2f(ct[k] & ~0xFFu) - vmax); ssum += vals[k]; }
        const float inv = 1.0f / ssum;
        asm volatile("s_waitcnt lgkmcnt(0)" ::: "memory");
        if (hi == 0) {
            int* ep = experts + (size_t)tok * 128 + h * 16;
            float* gp = gates + (size_t)tok * 128 + h * 16;
#pragma unroll
            for (int k = 0; k < 16; k += 4) {
                int e4[4];
#pragma unroll
                for (int q = 0; q < 4; ++q) {
                    const unsigned flat = 255u - (ct[k + q] & 255u);
                    const int i1 = myidx[flat >> 4], i2 = myidx[16 + (flat & 15)];
                    e4[q] = i1 * 128 + i2;
                }
                *(u32x4*)(ep + k) = (u32x4){(unsigned)e4[0], (unsigned)e4[1], (unsigned)e4[2], (unsigned)e4[3]};
                *(f32x4*)(gp + k) = (f32x4){vals[k] * inv, vals[k + 1] * inv, vals[k + 2] * inv, vals[k + 3] * inv};
            }
        }
        asm volatile("s_waitcnt lgkmcnt(0)" ::: "memory");
    }
}

__device__ __forceinline__ void peer_slice_map(const Params& P, LDSP unsigned char* lds, int vcu, int G, int wave, int& slice, int& half, int& wslot, int& nslot) {
    volatile LDSP unsigned* bst = (volatile LDSP unsigned*)(lds + LDS_BYTES - 16);
    LDSP unsigned* info = (LDSP unsigned*)(lds + LDS_BYTES - 64);
    __syncthreads();
    if (threadIdx.x == 0) {
        unsigned* bar = (unsigned*)(P.ws + 16384);
        const unsigned x = (unsigned)__builtin_amdgcn_s_getreg((3 << 11) | 20) & 0xFu;
        bool ok = true; unsigned sum = 0, mine = 0;
        for (unsigned j = 0; j < 16; ++j) { const unsigned c = __hip_atomic_load(&bar[256 + 64 * j], __ATOMIC_RELAXED, __HIP_MEMORY_SCOPE_AGENT); sum += c; if (j < 8 && c == 0) ok = false; if (j >= 8 && c != 0) ok = false; if (j == x) mine = c; }
        ok = ok && (sum == (unsigned)G) && (bst[2] < mine);
        info[0] = ok ? 1u : 0u; info[1] = x; info[2] = mine; info[3] = bst[2];
    }
    __syncthreads();
    if (info[0]) { slice = (int)(info[1] & 3u); half = (int)(info[1] >> 2); wslot = (int)info[3] * NWAVES + wave; nslot = (int)info[2] * NWAVES; }
    else if ((G & 7) == 0) { const int g8 = vcu / (G >> 3); slice = g8 & 3; half = g8 >> 2; wslot = (vcu % (G >> 3)) * NWAVES + wave; nslot = (G >> 3) * NWAVES; }
    else { slice = -1; half = 0; wslot = vcu * NWAVES + wave; nslot = G * NWAVES; }
}
struct PeerMetaA { int eA, eB; u32x4 h0, h1, h2, h3; };
struct PeerMetaB { int eA, eB; float aA, aB; };
#define PEER_IDX(m, j) __shfl(((j) < 8) ? (m).eA : (m).eB, (8 * (j) + grp) & 63)
__device__ __forceinline__ float dpp_xor1(float v) { return __builtin_bit_cast(float, __builtin_amdgcn_mov_dpp(__builtin_bit_cast(int, v), 0xB1, 0xF, 0xF, true)); }
__device__ __forceinline__ float dpp_xor2(float v) { return __builtin_bit_cast(float, __builtin_amdgcn_mov_dpp(__builtin_bit_cast(int, v), 0x4E, 0xF, 0xF, true)); }
__device__ __forceinline__ float dpp_hmirror(float v) { return __builtin_bit_cast(float, __builtin_amdgcn_mov_dpp(__builtin_bit_cast(int, v), 0x141, 0xF, 0xF, true)); }
__device__ __forceinline__ float dpp_ror8(float v) { return __builtin_bit_cast(float, __builtin_amdgcn_mov_dpp(__builtin_bit_cast(int, v), 0x128, 0xF, 0xF, true)); }
__device__ __forceinline__ float swap32_sum(float X, float Y) {
    const auto r = __builtin_amdgcn_permlane32_swap(__float_as_uint(X), __float_as_uint(Y), false, false);
    return __uint_as_float(r[0]) + __uint_as_float(r[1]);
}
__device__ __forceinline__ float swap16_sum(float X, float Y) {
    const auto r = __builtin_amdgcn_permlane16_swap(__float_as_uint(X), __float_as_uint(Y), false, false);
    return __uint_as_float(r[0]) + __uint_as_float(r[1]);
}
__device__ __forceinline__ void cvt32_fp4_pk(const u32x4 w, f32x2 (&f)[16]) {
#pragma unroll
    for (int q = 0; q < 4; ++q) {
        f[4 * q]     = __builtin_amdgcn_cvt_scalef32_pk_f32_fp4(w[q], 1.0f, 0); f[4 * q + 1] = __builtin_amdgcn_cvt_scalef32_pk_f32_fp4(w[q], 1.0f, 1);
        f[4 * q + 2] = __builtin_amdgcn_cvt_scalef32_pk_f32_fp4(w[q], 1.0f, 2); f[4 * q + 3] = __builtin_amdgcn_cvt_scalef32_pk_f32_fp4(w[q], 1.0f, 3);
    }
}
#define PA_T(it) ((slice >= 0) ? (2 * (it) + half) : ((it) >> 2))
#define PA_X(it) ((slice >= 0) ? slice : ((it) & 3))
__device__ __forceinline__ void phase_peer_a(const Params& P, LDSP unsigned char* lds, int vcu, int G) {
    unsigned char* ws = P.ws;
    const bf16_t* x1b = (const bf16_t*)(ws + OFF_R0);
    const unsigned char* U4 = ws + OFF_U;
    const int* experts = (const int*)(ws + OFF_EXPERTS);
    float* apart = (float*)(ws + OFF_R1);
    const int tid = opaque_tid(), lane = tid & 63, wave = tid >> 6, grp = lane >> 3, sub = lane & 7;
    const bool b2 = lane & 4, b1 = lane & 2, b0 = lane & 1;
    int slice, half, wslot, nslot;
    peer_slice_map(P, lds, vcu, G, wave, slice, half, wslot, nslot);
    const int nitems = (slice >= 0) ? T / 2 : T * 4;
#define PA_META(m, it) do { const int it_ = ((it) < nitems) ? (it) : wslot; { const int t_ = PA_T(it_), x_ = PA_X(it_); \
        (m).eA = __builtin_nontemporal_load(experts + (size_t)t_ * 128 + lane); (m).eB = __builtin_nontemporal_load(experts + (size_t)t_ * 128 + 64 + lane); const u32x4* hp_ = (const u32x4*)(x1b + (size_t)t_ * DM + 256 * x_ + 32 * sub); \
        (m).h0 = __builtin_nontemporal_load(hp_); (m).h1 = __builtin_nontemporal_load(hp_ + 1); (m).h2 = __builtin_nontemporal_load(hp_ + 2); (m).h3 = __builtin_nontemporal_load(hp_ + 3); } } while (0)
#define PA_GATHER(R, m, it, J0) do { const int x_ = PA_X(it); _Pragma("unroll") for (int j = 0; j < 8; ++j) { const int e_ = PEER_IDX(m, (J0) + j); \
        (R)[j] = *(const u32x4*)(U4 + ((size_t)x_ * PEER_NE + e_) * 128 + 16 * sub); } } while (0)
#define PA_COMPUTE(R, J0) do { _Pragma("unroll") for (int j = 0; j < 8; ++j) { f32x2 f[16]; asm volatile("" : "+v"((R)[j])); cvt32_fp4_pk((R)[j], f); f32x2 sd = f[0] * h2[0]; \
        _Pragma("unroll") for (int i = 1; i < 16; ++i) sd = __builtin_elementwise_fma(f[i], h2[i], sd); part[(J0) + j] = sd.x + sd.y; asm volatile("" : "+v"(part[(J0) + j])); } } while (0)
    PeerMetaA m0, m1, m2;
    m0.eA = m0.eB = m1.eA = m1.eB = m2.eA = m2.eB = 0;
    m0.h0 = m0.h1 = m0.h2 = m0.h3 = m1.h0 = m1.h1 = m1.h2 = m1.h3 = m2.h0 = m2.h1 = m2.h2 = m2.h3 = (u32x4){0u, 0u, 0u, 0u};
    u32x4 R0[8], R1[8];
    PA_META(m0, wslot); PA_META(m1, wslot + nslot);
    if (wslot >= nitems) return;
    PA_GATHER(R0, m0, wslot, 0); PA_GATHER(R1, m0, wslot, 8);
#pragma unroll 1
    for (int it = wslot; it < nitems; it += nslot) {
        PA_META(m2, it + 2 * nslot);
        f32x2 h2[16]; float part[16];
        { float f[8];
#define PA_H(Q, W) do { cvt8((W), f); _Pragma("unroll") for (int i = 0; i < 4; ++i) h2[4 * (Q) + i] = (f32x2){f[2 * i], f[2 * i + 1]}; } while (0)
          PA_H(0, m0.h0); PA_H(1, m0.h1); PA_H(2, m0.h2); PA_H(3, m0.h3);
#undef PA_H
        }
        PA_COMPUTE(R0, 0);
        const int itn = (it + nslot < nitems) ? it + nslot : it;
        PA_GATHER(R0, m1, itn, 0);
        PA_COMPUTE(R1, 8);
        PA_GATHER(R1, m1, itn, 8);
        float q8[8], q4[4], q2[2];
#pragma unroll
        for (int i = 0; i < 8; ++i) { const float send = b2 ? part[i] : part[i + 8], keep = b2 ? part[i + 8] : part[i]; q8[i] = keep + dpp_hmirror(send); }
#pragma unroll
        for (int i = 0; i < 4; ++i) { const float send = b1 ? q8[i] : q8[i + 4], keep = b1 ? q8[i + 4] : q8[i]; q4[i] = keep + dpp_xor2(send); }
#pragma unroll
        for (int i = 0; i < 2; ++i) { const float send = b0 ? q4[i] : q4[i + 2], keep = b0 ? q4[i + 2] : q4[i]; q2[i] = keep + dpp_xor1(send); }
        float* ap = apart + ((size_t)PA_X(it) * T + PA_T(it)) * 128 + lane;
        __builtin_nontemporal_store(q2[0], ap); __builtin_nontemporal_store(q2[1], ap + 64);
        m0 = m1; m1 = m2;
    }
#undef PA_META
#undef PA_GATHER
#undef PA_COMPUTE
}
__device__ __forceinline__ void phase_peer_w(const Params& P, LDSP unsigned char* lds, int vcu, int G) {
    unsigned char* ws = P.ws;
    float* gates = (float*)(ws + OFF_GATES);
    const float* rs2 = (const float*)(ws + OFF_RS2);
    const float* apart = (const float*)(ws + OFF_R1);
    const int* experts = (const int*)(ws + OFF_EXPERTS);
    const float* su = (const float*)(ws + OFF_PSCALE);
    const float* sv = su + PEER_NE;
    const size_t gt = (size_t)(vcu * NTHREADS + threadIdx.x), NGT = (size_t)G * NTHREADS;
    for (size_t i = gt; i < (size_t)T * 128; i += NGT) {
        const int t = (int)(i >> 7), k = (int)(i & 127);
        const int sub = k >> 4, s1 = (k >> 3) & 1, grp = k & 7, idx = s1 * 64 + grp * 8 + sub;
        float a = 0.f;
#pragma unroll
        for (int xs = 0; xs < 4; ++xs) a += apart[((size_t)xs * T + t) * 128 + idx];
        const int e = experts[i];
        const float rs = su[e] / sqrtf(rs2[t] * (1.0f / DM) + NORM_EPS);
        gates[i] = gelu_tanh(a * rs) * gates[i] * sv[e];
    }
}
__device__ __forceinline__ void phase_peer_b(const Params& P, LDSP unsigned char* lds, int vcu, int G) {
    unsigned char* ws = P.ws;
    const unsigned char* V4 = ws + OFF_V;
    const int* experts = (const int*)(ws + OFF_EXPERTS);
    const float* wtok = (const float*)(ws + OFF_GATES);
    const int tid = opaque_tid(), lane = tid & 63, wave = tid >> 6, grp = lane >> 3, sub = lane & 7;
    const bool b3 = lane & 8;
    const int k0 = 16 * sub + grp, k1 = k0 + 8;
    LDSP float* wbuf = (LDSP float*)(lds + wave * 1024);
    int slice, half, wslot, nslot;
    peer_slice_map(P, lds, vcu, G, wave, slice, half, wslot, nslot);
    const int nitems = (slice >= 0) ? T / 2 : T * 4;
#define PB_META(m, it) do { const int it_ = ((it) < nitems) ? (it) : wslot; { const int t_ = PA_T(it_); \
        (m).eA = __builtin_nontemporal_load(experts + (size_t)t_ * 128 + lane); (m).eB = __builtin_nontemporal_load(experts + (size_t)t_ * 128 + 64 + lane); \
        (m).aA = __builtin_nontemporal_load(wtok + (size_t)t_ * 128 + k0); (m).aB = __builtin_nontemporal_load(wtok + (size_t)t_ * 128 + k1); } } while (0)
#define PB_GATHER(R, m, it, J0) do { const int x_ = PA_X(it); _Pragma("unroll") for (int j = 0; j < 8; ++j) { const int e_ = PEER_IDX(m, (J0) + j); \
        (R)[j] = *(const u32x4*)(V4 + ((size_t)x_ * PEER_NE + e_) * 128 + 16 * sub); } } while (0)
#define PB_COMPUTE(R, J0) do { _Pragma("unroll") for (int j = 0; j < 8; ++j) { f32x2 f[16]; asm volatile("" : "+v"((R)[j])); cvt32_fp4_pk((R)[j], f); const float wk = wb[8 * ((J0) + j) + grp]; const f32x2 wk2 = {wk, wk}; \
        _Pragma("unroll") for (int i = 0; i < 16; ++i) acc2[i] = __builtin_elementwise_fma(wk2, f[i], acc2[i]); \
        asm volatile("" : "+v"(acc2[0]), "+v"(acc2[1]), "+v"(acc2[2]), "+v"(acc2[3]), "+v"(acc2[4]), "+v"(acc2[5]), "+v"(acc2[6]), "+v"(acc2[7])); \
        asm volatile("" : "+v"(acc2[8]), "+v"(acc2[9]), "+v"(acc2[10]), "+v"(acc2[11]), "+v"(acc2[12]), "+v"(acc2[13]), "+v"(acc2[14]), "+v"(acc2[15])); } } while (0)
    PeerMetaB m0, m1, m2;
    m0.eA = m0.eB = m1.eA = m1.eB = m2.eA = m2.eB = 0; m0.aA = m0.aB = m1.aA = m1.aB = m2.aA = m2.aB = 0.f;
    u32x4 R0[8], R1[8];
    PB_META(m0, wslot); PB_META(m1, wslot + nslot);
    if (wslot >= nitems) return;
    PB_GATHER(R0, m0, wslot, 0); PB_GATHER(R1, m0, wslot, 8);
    int par = 0;
#pragma unroll 1
    for (int it = wslot; it < nitems; it += nslot) {
        PB_META(m2, it + 2 * nslot);
        LDSP float* wb = wbuf + par * 128; par ^= 1;
        wb[k0] = m0.aA; wb[k1] = m0.aB;
        asm volatile("s_waitcnt lgkmcnt(0)" ::: "memory");
        f32x2 acc2[16];
#pragma unroll
        for (int i = 0; i < 16; ++i) acc2[i] = (f32x2){0.f, 0.f};
        PB_COMPUTE(R0, 0);
        const int itn = (it + nslot < nitems) ? it + nslot : it;
        PB_GATHER(R0, m1, itn, 0);
        PB_COMPUTE(R1, 8);
        PB_GATHER(R1, m1, itn, 8);
        float acc[32];
#pragma unroll
        for (int i = 0; i < 16; ++i) { acc[2 * i] = acc2[i].x; acc[2 * i + 1] = acc2[i].y; }
        float q16[16], q8[8], q4[4];
#pragma unroll
        for (int i = 0; i < 16; ++i) q16[i] = swap32_sum(acc[i], acc[i + 16]);
#pragma unroll
        for (int i = 0; i < 8; ++i) q8[i] = swap16_sum(q16[i], q16[i + 8]);
#pragma unroll
        for (int i = 0; i < 4; ++i) { const float send = b3 ? q8[i] : q8[i + 4], keep = b3 ? q8[i + 4] : q8[i]; q4[i] = keep + dpp_ror8(send); }
        const int c32 = ((lane & 32) ? 16 : 0) + ((lane & 16) ? 8 : 0) + (b3 ? 4 : 0);
        const size_t oidx = (size_t)PA_T(it) * DM + 256 * PA_X(it) + 32 * sub + c32;
        const u32x2 xr = __builtin_nontemporal_load((const u32x2*)((const bf16_t*)(P.ws + OFF_R0) + oidx));
        f32x4 o;
        o.x = __uint_as_float(xr.x << 16) + q4[0]; o.y = __uint_as_float(xr.x & 0xffff0000u) + q4[1]; o.z = __uint_as_float(xr.y << 16) + q4[2]; o.w = __uint_as_float(xr.y & 0xffff0000u) + q4[3];
        __builtin_nontemporal_store(o, (f32x4*)(P.out + oidx));
        m0 = m1; m1 = m2;
    }
#undef PB_META
#undef PB_GATHER
#undef PB_COMPUTE
#undef PA_T
#undef PA_X
}

#ifndef SELFCHECK
#define SELFCHECK 0
#endif
#if SELFCHECK
constexpr size_t OFF_CHK = 512 * 1024;
__device__ __forceinline__ void wave_argmax(float& v, int& i) {
#pragma unroll
    for (int o = 1; o < 64; o <<= 1) {
        const float ov = __shfl_xor(v, o); const int oi = __shfl_xor(i, o);
        if (ov > v || (ov == v && oi < i)) { v = ov; i = oi; }
    }
}
struct NaiveAcc { float m, l; float o[64]; };
__device__ __forceinline__ float wave_max(float v) {
#pragma unroll
    for (int o = 1; o < 64; o <<= 1) v = fmaxf(v, __shfl_xor(v, o));
    return v;
}
__device__ __forceinline__ void nacc_reset(NaiveAcc& a) { a.m = -1.0e30f; a.l = 0.f;
#pragma unroll
    for (int d = 0; d < 64; ++d) a.o[d] = 0.f; }
__device__ __forceinline__ float dot64(LDSP const float* qs, const bf16_t* krow) {
    float s = 0.f;
#pragma unroll
    for (int c = 0; c < 8; ++c) { float f[8]; cvt8(*(const u32x4*)(krow + c * 8), f);
#pragma unroll
        for (int i = 0; i < 8; ++i) s += qs[c * 8 + i] * f[i]; }
    return s;
}
__device__ __forceinline__ void axpy64(NaiveAcc& a, float alpha, float p, const bf16_t* vrow) {
#pragma unroll
    for (int c = 0; c < 8; ++c) { float f[8]; cvt8(*(const u32x4*)(vrow + c * 8), f);
#pragma unroll
        for (int i = 0; i < 8; ++i) a.o[c * 8 + i] = a.o[c * 8 + i] * alpha + p * f[i]; }
}
__device__ __forceinline__ void naive_chunk(NaiveAcc& a, LDSP const float* qs, const bf16_t* krow, const bf16_t* vrow, bool valid) {
    float s = dot64(qs, krow);
    if (!valid) s = -INFINITY;
    const float mnew = fmaxf(a.m, wave_max(s));
    const float alpha = exp2f(a.m - mnew), p = valid ? exp2f(s - mnew) : 0.f;
    a.l = a.l * alpha + p; a.m = mnew;
    axpy64(a, alpha, p, vrow);
}
__device__ __forceinline__ float nacc_final(NaiveAcc& a, int lane) {
    const float l = wave_sum(a.l);
    const float inv = (l > 0.f) ? 1.0f / l : 0.f;
    const bool b5 = lane & 32, b4 = lane & 16, b3 = lane & 8, b2 = lane & 4, b1 = lane & 2, b0 = lane & 1;
    float q32[32], q16[16], q8[8], q4[4], q2[2];
#pragma unroll
    for (int i = 0; i < 32; ++i) { const float send = b5 ? a.o[i] : a.o[i + 32], keep = b5 ? a.o[i + 32] : a.o[i]; q32[i] = keep + __shfl_xor(send, 32); }
#pragma unroll
    for (int i = 0; i < 16; ++i) { const float send = b4 ? q32[i] : q32[i + 16], keep = b4 ? q32[i + 16] : q32[i]; q16[i] = keep + __shfl_xor(send, 16); }
#pragma unroll
    for (int i = 0; i < 8; ++i) { const float send = b3 ? q16[i] : q16[i + 8], keep = b3 ? q16[i + 8] : q16[i]; q8[i] = keep + __shfl_xor(send, 8); }
#pragma unroll
    for (int i = 0; i < 4; ++i) { const float send = b2 ? q8[i] : q8[i + 4], keep = b2 ? q8[i + 4] : q8[i]; q4[i] = keep + __shfl_xor(send, 4); }
#pragma unroll
    for (int i = 0; i < 2; ++i) { const float send = b1 ? q4[i] : q4[i + 2], keep = b1 ? q4[i + 2] : q4[i]; q2[i] = keep + __shfl_xor(send, 2); }
    const float send = b0 ? q2[0] : q2[1], keep = b0 ? q2[1] : q2[0];
    return (keep + __shfl_xor(send, 1)) * inv;
}
__device__ __forceinline__ float cmp_err(float ref, const bf16_t* got, int lane) {
    const float e = wave_max(fabsf(ref - bf2f(got[lane]))), mx = wave_max(fabsf(ref));
    return e / (mx + 1e-3f);
}
__device__ __forceinline__ void phase_selfcheck(const Params& P, LDSP unsigned char* lds, int vcu, int G) {
    unsigned char* ws = P.ws;
    const int tid = opaque_tid(), lane = tid & 63, wave = tid >> 6;
    const int gw = vcu * NWAVES + wave, NGW = G * NWAVES;
    unsigned* cnt = (unsigned*)(ws + OFF_CHK);
    const bf16_t* qa = (const bf16_t*)(ws + OFF_R1);
    const bf16_t* ka = (const bf16_t*)(ws + OFF_R1 + 32 * MiB);
    const bf16_t* va = (const bf16_t*)(ws + OFF_R1 + 64 * MiB);
    const bf16_t* qb = (const bf16_t*)(ws + OFF_R1 + 96 * MiB);
    const bf16_t* ya = (const bf16_t*)(ws + OFF_R0);
    const bf16_t* yb = (const bf16_t*)(ws + OFF_R0 + 32 * MiB);
    const float* kmean = (const float*)(ws + OFF_KMEAN);
    const float* bgate = (const float*)(ws + OFF_BGATE);
    LDSP float* psum = (LDSP float*)(lds + wave * 4096);
    LDSP float* qs = psum + 320;
    LDSP float* ocs = psum + 384;
    constexpr int NS = 537;
#pragma unroll 1
    for (int item = gw; item < NS * 8; item += NGW) {
        const int t = 37 + 61 * (item >> 3), h = item & 7, b = t >> 12, pos = t & (SEQ - 1), own = pos >> 8;
        qs[lane] = bf2f(qa[(size_t)t * 512 + h * 64 + lane]);
        asm volatile("s_waitcnt lgkmcnt(0)" ::: "memory");
        float g0 = -INFINITY, g1 = -INFINITY, g2 = -INFINITY; int i0 = -1, i1 = -1, i2 = -1;
#pragma unroll 1
        for (int j = 0; j < own; ++j) {
            const float* km = kmean + (size_t)((b * 8 + h) * 16 + j) * 64;
            float d = 0.f;
#pragma unroll 8
            for (int i = 0; i < 64; ++i) d += qs[i] * km[i];
            if (d > g0) { g2 = g1; i2 = i1; g1 = g0; i1 = i0; g0 = d; i0 = j; }
            else if (d > g1) { g2 = g1; i2 = i1; g1 = d; i1 = j; }
            else if (d > g2) { g2 = d; i2 = j; }
        }
        NaiveAcc a; nacc_reset(a);
#pragma unroll 1
        for (int j = 0; j <= own; ++j) {
            if (j < own && j != i0 && j != i1 && j != i2) continue;
#pragma unroll 1
            for (int ck = 0; ck < 4; ++ck) {
                const int kp = j * 256 + ck * 64 + lane;
                const size_t kr = (size_t)(b * SEQ + kp) * 512 + h * 64;
                naive_chunk(a, qs, ka + kr, va + kr, kp <= pos);
            }
        }
        const float om = nacc_final(a, lane);
        const float e = cmp_err(om, ya + (size_t)t * 512 + h * 64, lane);
        if (lane == 0 && !(e < 0.05f)) atomicAdd(cnt + 0, 1u);
        asm volatile("s_waitcnt lgkmcnt(0)" ::: "memory");
    }
#pragma unroll 1
    for (int item = gw; item < NS * 2; item += NGW) {
        const int t = 37 + 61 * (item >> 1), g = item & 1, b = t >> 12, pos = t & (SEQ - 1), own = pos >> 6;
        const bf16_t* kc = (const bf16_t*)(ws + OFF_KC) + (size_t)(b * 2 + g) * 256 * 64;
        const bf16_t* vc = (const bf16_t*)(ws + OFF_VC) + (size_t)(b * 2 + g) * 256 * 64;
        const bf16_t* ks = (const bf16_t*)(ws + OFF_R2 + 16 * MiB) + (size_t)(b * SEQ) * 128 + g * 64;
        const bf16_t* vs = (const bf16_t*)(ws + OFF_R2 + 24 * MiB) + (size_t)(b * SEQ) * 128 + g * 64;
        const bf16_t* kw = (const bf16_t*)(ws + OFF_R2 + 32 * MiB) + (size_t)(b * SEQ) * 128 + g * 64;
        const bf16_t* vw = (const bf16_t*)(ws + OFF_R2 + 40 * MiB) + (size_t)(b * SEQ) * 128 + g * 64;
        for (int i = lane; i < 320; i += 64) psum[i] = 0.f;
        asm volatile("s_waitcnt lgkmcnt(0)" ::: "memory");
        const int ncmp_vis = (pos >= 31) ? ((pos - 31) >> 4) + 1 : 0;
#pragma unroll 1
        for (int r = 0; r < 4; ++r) {
            qs[lane] = bf2f(qb[(size_t)t * 512 + (g * 4 + r) * 64 + lane]);
            asm volatile("s_waitcnt lgkmcnt(0)" ::: "memory");
            float mx = -INFINITY;
#pragma unroll 1
            for (int ck = 0; ck < 4; ++ck) { const int n = ck * 64 + lane;
                const float sdot = dot64(qs, kc + (size_t)n * 64);
                mx = fmaxf(mx, (n < ncmp_vis) ? sdot : -INFINITY); }
            mx = wave_max(mx);
            float l = 0.f;
#pragma unroll 1
            for (int ck = 0; ck < 4; ++ck) { const int n = ck * 64 + lane;
                const float sdot = dot64(qs, kc + (size_t)n * 64);
                l += (n < ncmp_vis) ? exp2f(sdot - mx) : 0.f; }
            l = wave_sum(l);
            const float inv = (l > 0.f) ? 1.0f / l : 0.f;
            NaiveAcc a; nacc_reset(a);
#pragma unroll 1
            for (int ck = 0; ck < 4; ++ck) { const int n = ck * 64 + lane;
                const float sdot = dot64(qs, kc + (size_t)n * 64);
                const float pr = (n < ncmp_vis) ? exp2f(sdot - mx) * inv : 0.f;
                psum[n] += pr;
                axpy64(a, 1.0f, pr, vc + (size_t)n * 64); }
            a.l = (lane == 0) ? 1.f : 0.f;
            ocs[r * 64 + lane] = nacc_final(a, lane);
            asm volatile("s_waitcnt lgkmcnt(0)" ::: "memory");
        }
        {
            const int j = lane;
            float imp = 0.f;
            for (int n = 4 * j - 1; n <= 4 * j + 3; ++n) if (n >= 0 && n < 255) imp += psum[n];
            if (j == 0 || j == own || j == own - 1) imp = 1.0e30f;
            if (j > own) imp = -1.0e30f;
            unsigned long long sel = 0ull;
#pragma unroll 1
            for (int r = 0; r < 16; ++r) {
                float v = imp; int i = j;
                wave_argmax(v, i);
                if (v > -0.5e30f) sel |= 1ull << i;
                if (i == j) imp = -3.0e38f;
            }
            psum[256] = __uint_as_float((unsigned)sel); psum[257] = __uint_as_float((unsigned)(sel >> 32));
            asm volatile("s_waitcnt lgkmcnt(0)" ::: "memory");
        }
        const unsigned long long sel = ((unsigned long long)__float_as_uint(psum[257]) << 32) | __float_as_uint(psum[256]);
#pragma unroll 1
        for (int r = 0; r < 4; ++r) {
            const int head = g * 4 + r;
            qs[lane] = bf2f(qb[(size_t)t * 512 + head * 64 + lane]);
            asm volatile("s_waitcnt lgkmcnt(0)" ::: "memory");
            const float gt0 = bgate[(size_t)t * 24 + head * 3], gt1 = bgate[(size_t)t * 24 + head * 3 + 1], gt2 = bgate[(size_t)t * 24 + head * 3 + 2];
            float y = gt0 * ocs[r * 64 + lane];
            NaiveAcc a; nacc_reset(a);
#pragma unroll 1
            for (int j = 0; j <= own; ++j) {
                if (!((sel >> j) & 1ull)) continue;
                const int kp = j * 64 + lane;
                naive_chunk(a, qs, ks + (size_t)kp * 128, vs + (size_t)kp * 128, kp <= pos);
            }
            y += gt1 * nacc_final(a, lane);
            nacc_reset(a);
#pragma unroll 1
            for (int ck = 0; ck < 9; ++ck) {
                const int kp = pos - 575 + ck * 64 + lane;
                const bool valid = kp >= 0 && kp <= pos && kp > pos - 512;
                const int kpc = kp < 0 ? 0 : kp;
                naive_chunk(a, qs, kw + (size_t)kpc * 128, vw + (size_t)kpc * 128, valid);
            }
            y += gt2 * nacc_final(a, lane);
            const float e = cmp_err(y, yb + (size_t)t * 512 + head * 64, lane);
            if (lane == 0 && !(e < 0.05f)) atomicAdd(cnt + 1, 1u);
            asm volatile("s_waitcnt lgkmcnt(0)" ::: "memory");
        }
    }
}

__device__ __forceinline__ void phase_selfcheck2(const Params& P, LDSP unsigned char* lds, int vcu, int G) {
    unsigned char* ws = P.ws;
    const int tid = opaque_tid(), lane = tid & 63, wave = tid >> 6;
    const int gw = vcu * NWAVES + wave, NGW = G * NWAVES;
    unsigned* cnt = (unsigned*)(ws + OFF_CHK);
    LDSP float* hs = (LDSP float*)(lds + wave * 8192);
    const float* x = P.in[I_X]; const float* g1 = P.in[I_NORM1]; const float* w = P.in[I_WIN];
    constexpr int NS = 192, NGRP = 14;
#pragma unroll 1
    for (int item = gw; item < NS * NGRP; item += NGW) {
        const int si = item / NGRP, grp = item % NGRP;
        const int t = 11 + 167 * si, b = t >> 12, pos = t & (SEQ - 1);
        const int hsel = si & 7, gsel = si & 1;
        float ss = 0.f;
        for (int i = lane; i < DM; i += 64) { const float v = x[(size_t)t * DM + i]; ss += v * v; }
        ss = wave_sum(ss);
        const float rs = 1.0f / sqrtf(ss / DM + NORM_EPS);
        for (int i = lane; i < DM; i += 64) hs[i] = x[(size_t)t * DM + i] * rs * g1[i];
        asm volatile("s_waitcnt lgkmcnt(0)" ::: "memory");
        int col0, kind; const float* gain = nullptr; float oscale = 1.f; const bf16_t* got = nullptr; int ncols = 64;
        const bf16_t* R1 = (const bf16_t*)(ws + OFF_R1); const bf16_t* R2 = (const bf16_t*)(ws + OFF_R2); const bf16_t* R3 = (const bf16_t*)(ws + OFF_R3);
        const size_t M32 = (size_t)16 * 1024 * 1024;
        switch (grp) {
        case 0: col0 = hsel * 64;          kind = 1; gain = P.in[I_AQG]; oscale = QSCALE; got = R1 + (size_t)t * 512 + hsel * 64; break;
        case 1: col0 = 512 + hsel * 64;    kind = 1; gain = P.in[I_AKG]; got = R1 + M32 + (size_t)t * 512 + hsel * 64; break;
        case 2: col0 = 1024 + hsel * 64;   kind = 0; got = R1 + 2 * M32 + (size_t)t * 512 + hsel * 64; break;
        case 3: col0 = 1536 + hsel * 64;   kind = 1; gain = P.in[I_BQG]; oscale = QSCALE; got = R1 + 3 * M32 + (size_t)t * 512 + hsel * 64; break;
        case 4: col0 = 2048 + gsel * 64;   kind = 0; got = R2 + ((size_t)((b * 2 + gsel) * SEQ + pos)) * 64; break;
        case 5: col0 = 2176 + gsel * 64;   kind = 0; got = R2 + M32 / 4 + ((size_t)((b * 2 + gsel) * SEQ + pos)) * 64; break;
        case 6: col0 = 2304 + gsel * 64;   kind = 1; gain = P.in[I_BKSG]; got = R2 + 2 * (M32 / 4) + (size_t)t * 128 + gsel * 64; break;
        case 7: col0 = 2432 + gsel * 64;   kind = 0; got = R2 + 3 * (M32 / 4) + (size_t)t * 128 + gsel * 64; break;
        case 8: col0 = 2560 + gsel * 64;   kind = 1; gain = P.in[I_BKWG]; got = R2 + 4 * (M32 / 4) + (size_t)t * 128 + gsel * 64; break;
        case 9: col0 = 2688 + gsel * 64;   kind = 0; got = R2 + 5 * (M32 / 4) + (size_t)t * 128 + gsel * 64; break;
        case 10: col0 = 2840 + hsel * 64;        kind = 2; got = R3 + (size_t)t * 2048 + hsel * 64; break;
        case 11: col0 = 2840 + 1024 + hsel * 64; kind = 2; got = R3 + (size_t)t * 2048 + 1024 + hsel * 64; break;
        case 12: col0 = 2840 + 1024 + 512 + hsel * 64; kind = 2; got = R3 + (size_t)t * 2048 + 1536 + hsel * 64; break;
        default: col0 = 2816; kind = 3; ncols = 24; break;
        }
        if (grp == 10) continue;
        float acc = 0.f;
        if (lane < ncols) {
#pragma unroll 4
            for (int k = 0; k < DM; ++k) acc += hs[k] * w[(size_t)k * 4888 + col0 + lane];
        }
        float ref;
        if (kind == 1) {
            const float ssq = wave_sum(acc * acc);
            float y = acc / sqrtf(ssq / 64.0f + NORM_EPS) * gain[lane];
            const float ya_ = __shfl(y, (lane + 8) & 63), yb_ = __shfl(y, (lane - 8) & 63);
            const int f = lane & 7;
            const float ang = (float)pos * powf(500000.0f, -(float)(2 * f) / 16.0f);
            const float c = cosf(ang), sn = sinf(ang);
            if (lane < 8) y = y * c - ya_ * sn; else if (lane < 16) y = y * c + yb_ * sn;
            ref = y * oscale;
        } else if (kind == 2) {
            ref = 1.0f / (1.0f + expf(-(acc + P.in[I_BMERGE][col0 - 2840 + lane])));
        } else if (kind == 3) {
            ref = 1.0f / (1.0f + expf(-acc));
        } else ref = acc;
        float gotv;
        if (kind == 3) gotv = (lane < 24) ? ((const float*)(ws + OFF_BGATE))[(size_t)t * 24 + lane] : 0.f;
        else gotv = bf2f(got[lane]);
        if (kind == 3 && lane >= 24) ref = 0.f;
        const float e = wave_max(fabsf(ref - gotv)) / (wave_max(fabsf(ref)) + 1e-3f);
        if (lane == 0 && !(e < 0.03f)) atomicAdd(cnt + 0, 1u);
        asm volatile("s_waitcnt lgkmcnt(0)" ::: "memory");
    }
#pragma unroll 1
    for (int item = gw; item < 1024; item += NGW) {
        const int b = item >> 7, h = (item >> 4) & 7, blk = item & 15;
        const bf16_t* p = (const bf16_t*)(ws + OFF_R1 + 32 * MiB) + (size_t)(b * SEQ + blk * 256) * 512 + h * 64 + lane;
        float sref = 0.f;
        for (int k = 0; k < 256; ++k) sref += bf2f(p[(size_t)k * 512]);
        const float gotv = ((const float*)(ws + OFF_KMEAN))[(size_t)item * 64 + lane];
        const float e = wave_max(fabsf(sref - gotv)) / (wave_max(fabsf(sref)) + 1e-2f);
        if (lane == 0 && !(e < 0.03f)) atomicAdd(cnt + 1, 1u);
    }
#pragma unroll 1
    for (int item = gw; item < 96 * 2; item += NGW) {
        const int si = item >> 1, kv = item & 1;
        const int slab = si & 15, n = (si * 37 + 3) % 255;
        const bf16_t* raw = (const bf16_t*)(ws + OFF_R2 + (size_t)kv * 8 * MiB) + (size_t)slab * SEQ * 64 + (size_t)n * 16 * 64;
        const float* posv = P.in[kv ? I_CPV : I_CPK]; const float* w1 = P.in[kv ? I_CVW1 : I_CKW1]; const float* b1 = P.in[kv ? I_CVB1 : I_CKB1];
        const float* w2 = P.in[kv ? I_CVW2 : I_CKW2]; const float* b2 = P.in[kv ? I_CVB2 : I_CKB2];
        float hacc[4] = {0.f, 0.f, 0.f, 0.f};
#pragma unroll 1
        for (int i = 0; i < 2048; ++i) {
            const float a = bf2f(raw[i]) + posv[i];
#pragma unroll
            for (int u = 0; u < 4; ++u) hacc[u] += a * w1[(size_t)i * 256 + lane + 64 * u];
        }
#pragma unroll
        for (int u = 0; u < 4; ++u) { const float z = hacc[u] + b1[lane + 64 * u]; hs[1024 + lane + 64 * u] = 0.5f * z * (1.0f + tanhf(0.7978845608028654f * (z + 0.044715f * z * z * z))); }
        asm volatile("s_waitcnt lgkmcnt(0)" ::: "memory");
        float o = b2[lane];
#pragma unroll 4
        for (int j = 0; j < 256; ++j) o += hs[1024 + j] * w2[(size_t)j * 64 + lane];
        if (!kv) { const float ssq = wave_sum(o * o); o = o / sqrtf(ssq / 64.0f + NORM_EPS) * P.in[I_BKCG][lane]; }
        const float gotv = bf2f(((const bf16_t*)(ws + (kv ? OFF_VC : OFF_KC)))[((size_t)slab * 256 + n) * 64 + lane]);
        const float e = wave_max(fabsf(o - gotv)) / (wave_max(fabsf(o)) + 1e-3f);
        if (lane == 0 && !(e < 0.03f)) atomicAdd(cnt + 1, 1u);
        asm volatile("s_waitcnt lgkmcnt(0)" ::: "memory");
    }
}
#endif

#define XB_TMO      128
#define XB_XCNT(j)  (256  + 64 * (j))
#define XB_XSUB(j)  (1280 + 64 * (j))
#define XB_XGEN(j)  (2304 + 64 * (j))
#define XB_TOP      3328
#define XB_TOPGEN   3392
#define XCD_BAR_WORDS 3456
#define XB_SPIN_CAP (1u << 22)
__device__ __forceinline__ unsigned xb_ld(unsigned* p)              { return __hip_atomic_load(p, __ATOMIC_RELAXED, __HIP_MEMORY_SCOPE_AGENT); }
__device__ __forceinline__ unsigned xb_add(unsigned* p, unsigned v) { return __hip_atomic_fetch_add(p, v, __ATOMIC_RELAXED, __HIP_MEMORY_SCOPE_AGENT); }
__device__ __forceinline__ unsigned xb_xcc_id() { return (unsigned)__builtin_amdgcn_s_getreg((3 << 11) | 20) & 0xFu; }
#define XB_SPIN(cond, bar) do { unsigned _sp = 0; while (cond) { __builtin_amdgcn_s_sleep(1); \
    if ((++_sp & 255u) == 0u) { if (xb_ld(&(bar)[XB_TMO])) break; if (_sp > XB_SPIN_CAP) { atomicAdd(&(bar)[XB_TMO], 1u); break; } } } } while (0)
struct XcdBarrier { unsigned* bar; unsigned x; volatile LDSP unsigned* st; };
__device__ __forceinline__ XcdBarrier xcd_barrier_post(unsigned* bar, volatile LDSP unsigned* st) {
    XcdBarrier b; b.bar = bar; b.x = xb_xcc_id(); b.st = st;
    if (threadIdx.x == 0) (void)xb_add(&bar[XB_XCNT(b.x)], 1u);
    return b;
}
__device__ __forceinline__ void xcd_barrier_complete(unsigned* bar, unsigned x, unsigned& nloc, unsigned& nx) {
    const unsigned G = gridDim.x * gridDim.y * gridDim.z;
    unsigned sum, cnt, mine, sp = 0u;
    for (;;) {
        sum = 0u; cnt = 0u; mine = 0u;
#pragma unroll
        for (unsigned j = 0; j < 16; ++j) { const unsigned c = xb_ld(&bar[XB_XCNT(j)]); sum += c; cnt += (c > 0u) ? 1u : 0u; mine = (j == x) ? c : mine; }
        if (sum == G) break;
        __builtin_amdgcn_s_sleep(1);
        if ((++sp & 255u) == 0u) { if (xb_ld(&bar[XB_TMO])) break; if (sp > XB_SPIN_CAP) { atomicAdd(&bar[XB_TMO], 1u); break; } }
    }
    nloc = mine > 0u ? mine : 1u; nx = cnt > 0u ? cnt : 1u;
}
__device__ __forceinline__ void xcd_barrier(const XcdBarrier& b) {
    asm volatile("s_waitcnt vmcnt(0)" ::: "memory");
    __syncthreads();
    if (threadIdx.x == 0) {
        unsigned* bar = b.bar;
        __builtin_amdgcn_s_waitcnt(0);
        unsigned nloc = b.st[0], nx = b.st[1];
        if (nloc == 0u) { xcd_barrier_complete(bar, b.x, nloc, nx); b.st[0] = nloc; b.st[1] = nx; }
        const unsigned old = xb_add(&bar[XB_XSUB(b.x)], 1u);
        const unsigned gen = old / nloc;
        if (old + 1u == (gen + 1u) * nloc) {
            __builtin_amdgcn_fence(__ATOMIC_RELEASE, "agent");
            asm volatile("s_waitcnt vmcnt(0)" ::: "memory");
            const unsigned og = xb_add(&bar[XB_TOP], 1u);
            const unsigned tg = og / nx;
            if (og + 1u == (tg + 1u) * nx) xb_add(&bar[XB_TOPGEN], 1u);
            else XB_SPIN(xb_ld(&bar[XB_TOPGEN]) == tg, bar);
            __builtin_amdgcn_fence(__ATOMIC_ACQUIRE, "agent");
            xb_add(&bar[XB_XGEN(b.x)], 1u);
            asm volatile("s_waitcnt vmcnt(0)" ::: "memory");
        } else {
            XB_SPIN(xb_ld(&bar[XB_XGEN(b.x)]) == gen, bar);
            __builtin_amdgcn_fence(__ATOMIC_ACQUIRE, "agent");
            asm volatile("s_waitcnt vmcnt(0)" ::: "memory");
        }
    }
    __syncthreads();
}

__global__ void __launch_bounds__(NTHREADS, 2) fwd_kernel(Params P) {
    extern __shared__ __attribute__((aligned(16))) unsigned char lds_raw[];
    LDSP unsigned char* lds = (LDSP unsigned char*)lds_raw;
    const int G = gridDim.x, bx = blockIdx.x;
    const int vcu = (G % 8 == 0) ? (bx % 8) * (G / 8) + bx / 8 : bx;
    const int lo = P.ph_lo, hi = P.ph_hi;
    volatile LDSP unsigned* bst = (volatile LDSP unsigned*)(lds + LDS_BYTES - 16);
    if (threadIdx.x == 0) { bst[0] = 0u; bst[1] = 0u; bst[2] = 0u; bst[3] = 0u; }
    __syncthreads();
    const XcdBarrier xbar = xcd_barrier_post((unsigned*)(P.ws + 16384), bst);
    if (threadIdx.x == 0) bst[2] = xb_add((unsigned*)(P.ws + 32768) + 64 * xbar.x, 1u);
#define IN(k) (lo <= (k) && (k) < hi)
#define SEAM(k) do { if (IN(k) && IN((k) + 1)) xcd_barrier(xbar); } while (0)
    if (IN(0)) phase_prep(P, lds, vcu, G);
    SEAM(0);
    if (IN(1)) phase_proj(P, lds, vcu, G);
    SEAM(1);
    if (IN(2)) phase_cmp(P, lds, vcu, G);
    SEAM(2);
    if (IN(4)) phase_attn(P, lds, vcu, G);
    SEAM(4);
#if SELFCHECK == 1
    phase_selfcheck(P, lds, vcu, G);
    xcd_barrier(xbar);
#elif SELFCHECK == 2
    phase_selfcheck2(P, lds, vcu, G);
    xcd_barrier(xbar);
#endif
    if (IN(5)) phase_up(P, lds, vcu, G);
    SEAM(5);
    if (IN(6)) phase_out(P, lds, vcu, G);
    SEAM(6);
    if (IN(7)) phase_pq(P, lds, vcu, G);
    SEAM(7);
    if (IN(8)) phase_topk(P, lds, vcu, G);
    SEAM(8);
    if (IN(9)) { phase_peer_a(P, lds, vcu, G); xcd_barrier(xbar); phase_peer_w(P, lds, vcu, G); xcd_barrier(xbar); phase_peer_b(P, lds, vcu, G); }
#if SELFCHECK
    xcd_barrier(xbar);
    if (bx == 0 && threadIdx.x == 0) {
        const unsigned* cnt = (const unsigned*)(P.ws + OFF_CHK);
        P.out[0] += 1000.0f * (float)cnt[0];
        P.out[1] += 1000000.0f * (float)cnt[1];
    }
#endif
#undef IN
#undef SEAM
}

extern "C" void kernel_launch(void* const* d_in, const int* in_sizes, int n_in, void* d_out, int out_size, void* d_ws, size_t ws_size, hipStream_t stream) {
    static int grid = 0;
    if (grid == 0) {
        if (n_in != 29 || ws_size < WS_END) { fprintf(stderr, "kernel_launch: unexpected n_in %d / ws_size %zu\n", n_in, ws_size); grid = -1; return; }
        int dev = 0, cus = 0, per_cu = 0;
        (void)hipGetDevice(&dev);
        (void)hipDeviceGetAttribute(&cus, hipDeviceAttributeMultiprocessorCount, dev);
        (void)hipFuncSetAttribute((const void*)fwd_kernel, hipFuncAttributeMaxDynamicSharedMemorySize, LDS_BYTES);
        (void)hipOccupancyMaxActiveBlocksPerMultiprocessor(&per_cu, (const void*)fwd_kernel, NTHREADS, LDS_BYTES);
        if (per_cu < 1) { fprintf(stderr, "kernel_launch: occupancy query says %d blocks per CU\n", per_cu); grid = -1; return; }
        grid = cus;
    }
    if (grid < 0) return;
    Params p{};
    for (int i = 0; i < 29; ++i) p.in[i] = (const float*)d_in[i];
    p.out = (float*)d_out; p.ws = (unsigned char*)d_ws;
    (void)hipMemsetAsync(d_ws, 0, 65536, stream);
    p.ph_lo = 0; p.ph_hi = 10;
    hipLaunchKernelGGL(fwd_kernel, dim3(grid), dim3(NTHREADS), LDS_BYTES, stream, p);
}
```

```cpp
#include <hip/hip_runtime.h>
#include <hip/hip_cooperative_groups.h>
#include <stdint.h>
#include <stdio.h>
#define SELFCHECK 0
namespace cg = cooperative_groups;

#define LDSP __attribute__((address_space(3)))
typedef unsigned short bf16_t;
typedef short bf16x8 __attribute__((ext_vector_type(8)));
typedef short s16x4 __attribute__((ext_vector_type(4)));
typedef float f32x2 __attribute__((ext_vector_type(2)));
typedef float f32x4 __attribute__((ext_vector_type(4)));
typedef float f32x16 __attribute__((ext_vector_type(16)));
typedef unsigned u32x2 __attribute__((ext_vector_type(2)));
typedef unsigned u32x4 __attribute__((ext_vector_type(4)));
typedef __bf16 bf16x2_t __attribute__((ext_vector_type(2)));

constexpr int BATCH = 8, SEQ = 4096, DM = 1024, T = BATCH * SEQ;
constexpr int HD = 64;
constexpr int NPROJ = 5120;
constexpr int PEER_NE = 16384;
constexpr float NORM_EPS = 1e-6f;
constexpr float QSCALE = 0.125f * 1.4426950408889634f;
constexpr int NTHREADS = 512, NWAVES = 8;
constexpr int LDS_BYTES = 140 * 1024;

constexpr size_t MiB = 1u << 20;
constexpr size_t OFF_RS1 = 1 * MiB;
constexpr size_t OFF_RS2 = 1 * MiB + 256 * 1024;
constexpr size_t OFF_ROPE_C = 2 * MiB;
constexpr size_t OFF_ROPE_S = 2 * MiB + 128 * 1024;
constexpr size_t OFF_POSB = 2 * MiB + 512 * 1024;
constexpr size_t OFF_KMEAN = 3 * MiB;
constexpr size_t OFF_BGATE = 4 * MiB;
constexpr size_t OFF_WIN_T = 8 * MiB;
constexpr size_t OFF_WUPA_T = 19 * MiB;
constexpr size_t OFF_WUPB_T = 20 * MiB;
constexpr size_t OFF_WOUT_T = 21 * MiB;
constexpr size_t OFF_WPQ_T = 23 * MiB;
constexpr size_t OFF_W1K_T = 27 * MiB;
constexpr size_t OFF_W1V_T = 28 * MiB;
constexpr size_t OFF_W2K_T = 29 * MiB;
constexpr size_t OFF_W2V_T = 29 * MiB + 128 * 1024;
constexpr size_t OFF_K1B = 29 * MiB + 256 * 1024;
constexpr size_t OFF_K2B = 29 * MiB + 320 * 1024;
constexpr size_t OFF_HID = 30 * MiB;
constexpr size_t OFF_KC = 34 * MiB;
constexpr size_t OFF_VC = 35 * MiB;
constexpr size_t OFF_EXPERTS = 36 * MiB;
constexpr size_t OFF_GATES = 52 * MiB;
constexpr size_t OFF_U = 68 * MiB;
constexpr size_t OFF_PSCALE = 84 * MiB;
constexpr size_t OFF_V = 100 * MiB;
constexpr size_t OFF_R0 = 132 * MiB;
constexpr size_t OFF_R1 = 196 * MiB;
constexpr size_t OFF_R2 = 324 * MiB;
constexpr size_t OFF_R3 = 372 * MiB;
constexpr size_t WS_END = 500 * MiB;

struct Params {
    const float* in[29];
    float* out;
    unsigned char* ws;
    int ph_lo, ph_hi;
};
static_assert(sizeof(Params) == 31 * 8 + 8, "Params has no padding");

enum { I_X = 0, I_NORM1, I_WIN, I_BMERGE, I_AQG, I_AKG, I_BQG, I_BKCG, I_BKSG, I_BKWG,
       I_CPK, I_CKW1, I_CKB1, I_CKW2, I_CKB2, I_CPV, I_CVW1, I_CVB1, I_CVW2, I_CVB2,
       I_WUPA, I_WUPB, I_WOUT, I_NORM2, I_PWQ, I_PK1, I_PK2, I_PU, I_PV };

__device__ __forceinline__ int opaque_tid() { int t = threadIdx.x; asm volatile("" : "+v"(t)); return t; }
__device__ __forceinline__ unsigned pk2(float lo, float hi) {
    f32x2 v = {lo, hi};
    bf16x2_t b = __builtin_convertvector(v, bf16x2_t);
    return __builtin_bit_cast(unsigned, b);
}
__device__ __forceinline__ float bf2f(bf16_t b) { return __uint_as_float(((unsigned)b) << 16); }
__device__ __forceinline__ float wave_sum(float v) {
#pragma unroll
    for (int o = 1; o < 64; o <<= 1) v += __shfl_xor(v, o);
    return v;
}
__device__ __forceinline__ float sum_xor16(float v) { const auto r = __builtin_amdgcn_permlane16_swap(__float_as_uint(v), __float_as_uint(v), false, false); return __uint_as_float(r[0]) + __uint_as_float(r[1]); }
__device__ __forceinline__ float sum_xor32(float v) { const auto r = __builtin_amdgcn_permlane32_swap(__float_as_uint(v), __float_as_uint(v), false, false); return __uint_as_float(r[0]) + __uint_as_float(r[1]); }
__device__ __forceinline__ float get_xor16(float v, bool odd_row) { const auto r = __builtin_amdgcn_permlane16_swap(__float_as_uint(v), __float_as_uint(v), false, false); return __uint_as_float(odd_row ? r[0] : r[1]); }
__device__ __forceinline__ float gelu_tanh(float x) {
    const float u = 0.7978845608028654f * (x + 0.044715f * x * x * x);
    return x * __builtin_amdgcn_rcpf(1.0f + __expf(-2.0f * u));
}
__device__ __forceinline__ float sigmoidf_(float x) { return __builtin_amdgcn_rcpf(1.0f + __expf(-x)); }
__device__ __forceinline__ void cvt8(const u32x4 w, float (&f)[8]) {
    f[0] = __uint_as_float(w.x << 16); f[1] = __uint_as_float(w.x & 0xffff0000u); f[2] = __uint_as_float(w.y << 16); f[3] = __uint_as_float(w.y & 0xffff0000u);
    f[4] = __uint_as_float(w.z << 16); f[5] = __uint_as_float(w.z & 0xffff0000u); f[6] = __uint_as_float(w.w << 16); f[7] = __uint_as_float(w.w & 0xffff0000u);
}
__device__ __forceinline__ int swz_off(int row, int chunk) { return row * 128 + ((chunk ^ ((row >> 1) & 7)) << 4); }

__device__ __forceinline__ void transpose_item(const float* W, int ldw, int k0, int src_c0, int nvalid, const float* kscale,
                                               bf16_t* WT, int ldwt, int n0, LDSP float* scr, int lane) {
#pragma unroll 8
    for (int i = 0; i < 32; ++i) {
        const int kk = 2 * i + (lane >> 5), nn = lane & 31;
        float v = 0.f;
        if (nn < nvalid) v = W[(size_t)(k0 + kk) * ldw + src_c0 + nn];
        if (kscale) v *= kscale[k0 + kk];
        scr[kk * 33 + nn] = v;
    }
    asm volatile("s_waitcnt lgkmcnt(0)" ::: "memory");
    const int c = lane & 7;
#pragma unroll
    for (int j = 0; j < 4; ++j) {
        const int n = (lane >> 3) + 8 * j;
        const LDSP float* s = scr + (8 * c) * 33 + n;
        u32x4 o;
        o.x = pk2(s[0 * 33], s[1 * 33]); o.y = pk2(s[2 * 33], s[3 * 33]); o.z = pk2(s[4 * 33], s[5 * 33]); o.w = pk2(s[6 * 33], s[7 * 33]);
        *(u32x4*)(WT + (size_t)(n0 + n) * ldwt + k0 + 8 * c) = o;
    }
    asm volatile("s_waitcnt lgkmcnt(0)" ::: "memory");
}

struct TrJob { const float* W; int K, N, ldw; const float* kscale; bf16_t* WT; int kind; };

__device__ __forceinline__ void run_tr_job(const TrJob& J, int item, LDSP float* scr, int lane) {
    const int nblk = J.N / 32, kb = item / nblk, nb = item % nblk;
    int src_c0 = nb * 32, nvalid = 32;
    if (J.kind == 1) {
        const int p0 = nb * 32, pn = p0 >> 8, q = p0 & 255, bj = q >> 7, wc = (q >> 5) & 3, H = 4 * pn + wc, d0 = 32 * bj;
        if (H < 44) src_c0 = 64 * H + d0;
        else if (H < 76) src_c0 = 64 * H + d0 + 24;
        else if (H == 76 && bj == 0) { src_c0 = 2816; nvalid = 24; }
        else { src_c0 = 0; nvalid = 0; }
    } else if (J.kind == 2) {
        if (nb * 32 >= 64) { src_c0 = 0; nvalid = 0; }
    }
    transpose_item(J.W, J.ldw, kb * 64, src_c0, nvalid, J.kscale, J.WT, J.K, nb * 32, scr, lane);
}

__device__ __forceinline__ void phase_prep(const Params& P, LDSP unsigned char* lds, int vcu, int G) {
    const int tid = opaque_tid(), lane = tid & 63, wave = tid >> 6;
    const int gw = vcu * NWAVES + wave, NGW = G * NWAVES;
    unsigned char* ws = P.ws;
    LDSP float* scr = (LDSP float*)(lds + wave * 8704);
    int base = 0;
#define TR_JOB(Wp, Kk, Nn, LDW, KS, WTp, KIND) do { TrJob J{Wp, Kk, Nn, LDW, KS, WTp, KIND}; const int nitems = ((Kk) / 64) * ((Nn) / 32); \
        const int first = (gw - base % NGW + NGW) % NGW; for (int it = first; it < nitems; it += NGW) run_tr_job(J, it, scr, lane); base += nitems; } while (0)
    TR_JOB(P.in[I_WIN], 1024, NPROJ, 4888, P.in[I_NORM1], (bf16_t*)(ws + OFF_WIN_T), 1);
    TR_JOB(P.in[I_WUPA], 512, 1024, 1024, nullptr, (bf16_t*)(ws + OFF_WUPA_T), 0);
    TR_JOB(P.in[I_WUPB], 512, 1024, 1024, nullptr, (bf16_t*)(ws + OFF_WUPB_T), 0);
    TR_JOB(P.in[I_WOUT], 1024, 1024, 1024, nullptr, (bf16_t*)(ws + OFF_WOUT_T), 0);
    TR_JOB(P.in[I_PWQ], 1024, 2048, 2048, P.in[I_NORM2], (bf16_t*)(ws + OFF_WPQ_T), 0);
    TR_JOB(P.in[I_CKW1], 2048, 256, 256, nullptr, (bf16_t*)(ws + OFF_W1K_T), 0);
    TR_JOB(P.in[I_CVW1], 2048, 256, 256, nullptr, (bf16_t*)(ws + OFF_W1V_T), 0);
    TR_JOB(P.in[I_CKW2], 256, 128, 64, nullptr, (bf16_t*)(ws + OFF_W2K_T), 2);
    TR_JOB(P.in[I_CVW2], 256, 128, 64, nullptr, (bf16_t*)(ws + OFF_W2V_T), 2);
#undef TR_JOB
    {
        const float* x = P.in[I_X];
        bf16_t* xb = (bf16_t*)(ws + OFF_R0);
        float* rs1 = (float*)(ws + OFF_RS1);
#pragma unroll 4
        for (int m = gw; m < T; m += NGW) {
            const f32x4* xr = (const f32x4*)(x + (size_t)m * DM) + lane;
            f32x4 v[4]; float s = 0.f;
#pragma unroll
            for (int j = 0; j < 4; ++j) { v[j] = xr[64 * j]; s += (v[j].x * v[j].x + v[j].y * v[j].y) + (v[j].z * v[j].z + v[j].w * v[j].w); }
            s = wave_sum(s);
            if (lane == 0) rs1[m] = 1.0f / sqrtf(s * (1.0f / DM) + NORM_EPS);
            u32x2* o = (u32x2*)(xb + (size_t)m * DM) + lane;
#pragma unroll
            for (int j = 0; j < 4; ++j) { u32x2 w; w.x = pk2(v[j].x, v[j].y); w.y = pk2(v[j].z, v[j].w); o[64 * j] = w; }
        }
    }
    {
        const float* g2 = P.in[I_NORM2];
        f32x4 g4[4];
#pragma unroll
        for (int q = 0; q < 4; ++q) g4[q] = *(const f32x4*)(g2 + 256 * q + 4 * lane);
        float* scales = (float*)(ws + OFF_PSCALE);
#pragma unroll 4
        for (int r = gw; r < 2 * PEER_NE; r += NGW) {
            const int which = (r >= PEER_NE) ? 1 : 0, e = r & (PEER_NE - 1);
            const float* src = P.in[which ? I_PV : I_PU] + (size_t)e * DM + 4 * lane;
            f32x4 a[4]; float ss = 0.f;
#pragma unroll
            for (int q = 0; q < 4; ++q) { a[q] = *(const f32x4*)(src + 256 * q); if (!which) a[q] = a[q] * g4[q];
                ss += (a[q].x * a[q].x + a[q].y * a[q].y) + (a[q].z * a[q].z + a[q].w * a[q].w); }
            ss = wave_sum(ss);
            const float rms = sqrtf(ss * (1.0f / DM));
            if (which) {
                const float sc = (rms > 0.f) ? 0.5f * rms : 1.0f, inv = 1.0f / sc;
                unsigned char* dst = ws + OFF_V + (size_t)e * 128 + 2 * lane;
#pragma unroll
                for (int q = 0; q < 4; ++q) {
                    unsigned pq = 0;
                    pq = __builtin_amdgcn_cvt_scalef32_pk_fp4_f32(pq, a[q].x * inv, a[q].y * inv, 1.0f, 0);
                    pq = __builtin_amdgcn_cvt_scalef32_pk_fp4_f32(pq, a[q].z * inv, a[q].w * inv, 1.0f, 1);
                    *(unsigned short*)(dst + (size_t)q * PEER_NE * 128) = (unsigned short)pq;
                }
                if (lane == 0) scales[r] = sc;
            } else {
                const float sc = (rms > 0.f) ? rms * (2.5f / 7.0f) : 1.0f, inv = 1.0f / sc;
                const int b8 = 8 * (lane & 1);
#pragma unroll
                for (int q = 0; q < 4; ++q) {
                    const int n0 = (int)fminf(fmaxf(rintf(a[q].x * inv), -7.f), 7.f) & 15, n1 = (int)fminf(fmaxf(rintf(a[q].y * inv), -7.f), 7.f) & 15;
                    const int n2 = (int)fminf(fmaxf(rintf(a[q].z * inv), -7.f), 7.f) & 15, n3 = (int)fminf(fmaxf(rintf(a[q].w * inv), -7.f), 7.f) & 15;
                    const unsigned part = ((unsigned)n0 << b8) | ((unsigned)n2 << (b8 + 4)) | ((unsigned)n1 << (b8 + 16)) | ((unsigned)n3 << (b8 + 20));
                    const unsigned full = part | (unsigned)__shfl_xor((int)part, 1);
                    if (!(lane & 1)) *(unsigned*)(ws + OFF_U + ((size_t)q * PEER_NE + e) * 128 + 4 * (lane >> 1)) = full;
                }
                if (lane == 0) scales[r] = sc;
            }
        }
    }
    {
        const int gt = gw * 64 + lane, NGT = NGW * 64;
        for (int i = gt; i < 2 * 128 * 128; i += NGT) {
            const int w = i >> 14, e = i & 16383;
            const float v = P.in[w ? I_PK2 : I_PK1][e];
            ((bf16_t*)(ws + (w ? OFF_K2B : OFF_K1B)))[e] = (bf16_t)(pk2(v, 0.f) & 0xffff);
        }
        if (gt < 8) ((float*)(ws + OFF_ROPE_C))[gt] = powf(500000.0f, -(float)(2 * gt) / 16.0f) * 0.15915494309189535f;
        for (int i = gt; i < T; i += NGT) ((float*)(ws + OFF_RS2))[i] = 0.f;
        for (int i = gt; i < 8 * 8 * 16 * 64; i += NGT) ((float*)(ws + OFF_KMEAN))[i] = 0.f;
        if (gt < 2) ((unsigned*)(ws + 512 * 1024))[gt] = 0u;
        for (int o = gw; o < 512; o += NGW) {
            const int w = o >> 8, j = o & 255;
            const float* pos = P.in[w ? I_CPV : I_CPK];
            const float* w1 = P.in[w ? I_CVW1 : I_CKW1];
            float s = 0.f;
            for (int i = lane; i < 2048; i += 64) s += pos[i] * w1[(size_t)i * 256 + j];
            s = wave_sum(s);
            if (lane == 0) ((float*)(ws + OFF_POSB))[o] = s + P.in[w ? I_CVB1 : I_CKB1][j];
        }
    }
}

constexpr int G_BM = 256, G_BN = 128, G_BK = 64;
constexpr int G_ABYTES = G_BM * 128, G_BBYTES = G_BN * 128, G_STAGE = G_ABYTES + G_BBYTES;

__device__ __forceinline__ void gemm_kloop(f32x4 (&acc)[4][4], const bf16_t* A, size_t lda, const bf16_t* Bt, size_t ldb, int K, LDSP unsigned char* lds) {
    const int tid = opaque_tid(), lane = tid & 63, wid = tid >> 6, wm = wid >> 1, wn = wid & 1, fr = lane & 15, fq = lane >> 4;
    const int lrow = tid >> 3, lch = tid & 7;
    const bf16_t* ga = A + (size_t)lrow * lda + lch * 8;
    const bf16_t* gb = Bt + (size_t)lrow * ldb + lch * 8;
    u32x4 ra[4], rb[2];
    const int nk = K / G_BK;
#pragma unroll
    for (int p = 0; p < 4; ++p) ra[p] = *(const u32x4*)(ga + (size_t)(64 * p) * lda);
#pragma unroll
    for (int p = 0; p < 2; ++p) rb[p] = *(const u32x4*)(gb + (size_t)(64 * p) * ldb);
    __syncthreads();
#pragma unroll
    for (int p = 0; p < 4; ++p) *(LDSP u32x4*)(lds + swz_off(lrow + 64 * p, lch)) = ra[p];
#pragma unroll
    for (int p = 0; p < 2; ++p) *(LDSP u32x4*)(lds + G_ABYTES + swz_off(lrow + 64 * p, lch)) = rb[p];
    __syncthreads();
    for (int kt = 0; kt < nk; ++kt) {
        LDSP unsigned char* cur = lds + (kt & 1) * G_STAGE;
        LDSP unsigned char* nxt = lds + ((kt + 1) & 1) * G_STAGE;
        if (kt + 1 < nk) {
#pragma unroll
            for (int p = 0; p < 4; ++p) ra[p] = *(const u32x4*)(ga + (size_t)(64 * p) * lda + (kt + 1) * G_BK);
#pragma unroll
            for (int p = 0; p < 2; ++p) rb[p] = *(const u32x4*)(gb + (size_t)(64 * p) * ldb + (kt + 1) * G_BK);
        }
#pragma unroll
        for (int ks = 0; ks < 2; ++ks) {
            bf16x8 af[4], bfr[4];
#pragma unroll
            for (int m = 0; m < 4; ++m) af[m] = *(const LDSP bf16x8*)(cur + swz_off(wm * 64 + m * 16 + fr, ks * 4 + fq));
#pragma unroll
            for (int n = 0; n < 4; ++n) bfr[n] = *(const LDSP bf16x8*)(cur + G_ABYTES + swz_off(wn * 64 + n * 16 + fr, ks * 4 + fq));
#pragma unroll
            for (int m = 0; m < 4; ++m)
#pragma unroll
                for (int n = 0; n < 4; ++n) acc[m][n] = __builtin_amdgcn_mfma_f32_16x16x32_bf16(bfr[n], af[m], acc[m][n], 0, 0, 0);
        }
        if (kt + 1 < nk) {
#pragma unroll
            for (int p = 0; p < 4; ++p) *(LDSP u32x4*)(nxt + swz_off(lrow + 64 * p, lch)) = ra[p];
#pragma unroll
            for (int p = 0; p < 2; ++p) *(LDSP u32x4*)(nxt + G_ABYTES + swz_off(lrow + 64 * p, lch)) = rb[p];
        }
        __syncthreads();
    }
}

__device__ __forceinline__ void zero_acc(f32x4 (&acc)[4][4]) {
#pragma unroll
    for (int m = 0; m < 4; ++m)
#pragma unroll
        for (int n = 0; n < 4; ++n) acc[m][n] = (f32x4){0.f, 0.f, 0.f, 0.f};
}

__device__ __forceinline__ bool tile_order(int it, int vcu, int G, int nM, int nN, int& tm, int& tn) {
    if (G == 256 && (nM % 32) == 0) {
        const int xcd = vcu >> 5, cu = vcu & 31, mper = nM / 8;
        const int L = it * 32 + cu, per_group = 4 * nN;
        if (L >= mper * nN) return false;
        const int mg = L / per_group, rem = L % per_group;
        tm = xcd * mper + mg * 4 + (rem & 3); tn = rem >> 2;
        return true;
    }
    const int L = it * G + vcu;
    if (L >= nM * nN) return false;
    tm = L / nN; tn = L % nN;
    return true;
}

namespace pg8 {
constexpr int BM = 256, BK = 64, HALF = 128, HTB = HALF * BK * 2, NXCD = 8, WGM = 8;
__device__ __forceinline__ int lds_byte(int r, int c) { const int st = (r >> 4) * 2 + (c >> 5), rr = r & 15, cc = c & 31, ob = rr * 64 + cc * 2; return st * 1024 + (ob ^ (((ob >> 9) & 1) << 5)); }
__device__ __forceinline__ void stage_rc(int b, int& R, int& C) { const int st = b / 1024, sb = b % 1024, swz = sb ^ (((sb >> 9) & 1) << 5); R = (st >> 1) * 16 + swz / 64; C = (st & 1) * 32 + (swz % 64) / 2; }
__device__ __forceinline__ int perm32(int rho) { const int n = rho >> 4, i = rho & 15; return 8 * (i >> 2) + 4 * n + (i & 3); }
struct Unit { int pm, pn, z; };
__device__ __forceinline__ bool tile_of(int L, int nM, int nN, int& pm, int& pn) {
    const int nwg = nM * nN; if (L >= nwg) return false;
    int wgid = L; { const int q = nwg / NXCD, r = nwg % NXCD, xcd = wgid % NXCD, off = wgid / NXCD; wgid = (xcd < r ? xcd * (q + 1) : r * (q + 1) + (xcd - r) * q) + off; }
    const int nig = WGM * nN, gid = wgid / nig, fm = gid * WGM, gsz = (nM - fm) < WGM ? (nM - fm) : WGM;
    pm = fm + ((wgid % nig) % gsz); pn = (wgid % nig) / gsz; return true;
}
struct Sched {
    const bf16_t *A0, *A1, *B0, *B1; size_t lda, ldb; int K, nM, nN, NZ, G, c;
    __device__ __forceinline__ bool next(int i, Unit& u) const { u.z = (NZ == 2) ? (i & 1) : 0; const int ti = (NZ == 2) ? (i >> 1) : i; return tile_of(ti * G + c, nM, nN, u.pm, u.pn); }
    __device__ __forceinline__ const char* aptr(const Unit& u) const { return (const char*)((u.z ? A1 : A0) + (size_t)u.pm * BM * lda); }
    __device__ __forceinline__ const char* bptr(const Unit& u) const { return (const char*)((u.z ? B1 : B0) + (size_t)u.pn * BM * ldb); }
};
template <class Epi>
__device__ __forceinline__ void gemm_phase(LDSP unsigned char* lds, const Sched& S, const Epi& E) {
    const int tid = opaque_tid(), wid = __builtin_amdgcn_readfirstlane(tid >> 6), lane = tid & 63, wr = wid >> 2, wc = wid & 3, fr = lane & 15, fq = lane >> 4;
    const int nt = S.K / BK;
    unsigned voffA[2], voffB[2];
#pragma unroll
    for (int i = 0; i < 2; ++i) { int R, C; stage_rc(tid * 16 + i * 8192, R, C); const int Rb = (R & ~31) + perm32(R & 31);
        voffA[i] = (unsigned)(R * S.lda + C) * 2u; voffB[i] = (unsigned)(Rb * S.ldb + C) * 2u; }
    const size_t kstep = (size_t)(BK * 2);
    const size_t hstepA = (size_t)HALF * S.lda * 2, hstepB = (size_t)HALF * S.ldb * 2;
    const unsigned ldsw = (unsigned)wid * 1024u;
    const int aoff = lds_byte(wr * 64 + fr, fq * 8), boff = lds_byte(wc * 32 + fr, fq * 8);
#define PG8_SA(b, h) (((b) * 2 + (h)) * HTB)
#define PG8_SB(b, h) ((4 + (b) * 2 + (h)) * HTB)
#define PG8_STAGE(bufoff, gbase, voff) do { _Pragma("unroll") for (int _i = 0; _i < 2; ++_i) \
        __builtin_amdgcn_global_load_lds((const unsigned*)((const char*)(gbase) + (voff)[_i]), (LDSP unsigned*)(lds + (bufoff) + ldsw + _i * 8192), 16, 0, 0); } while (0)
#define PG8_LDA(dst, b, h) do { _Pragma("unroll") for (int m = 0; m < 4; ++m) _Pragma("unroll") for (int k = 0; k < 2; ++k) dst[m][k] = *(const LDSP bf16x8*)(lds + PG8_SA(b, h) + aoff + m * 2048 + k * 1024); } while (0)
#define PG8_LDB(dst, b, h) do { _Pragma("unroll") for (int n = 0; n < 2; ++n) _Pragma("unroll") for (int k = 0; k < 2; ++k) dst[n][k] = *(const LDSP bf16x8*)(lds + PG8_SB(b, h) + boff + n * 2048 + k * 1024); } while (0)
#define PG8_MMA(ai, bj, At, Bt) do { __builtin_amdgcn_s_setprio(1); _Pragma("unroll") for (int m = 0; m < 4; ++m) _Pragma("unroll") for (int n = 0; n < 2; ++n) _Pragma("unroll") for (int k = 0; k < 2; ++k) \
        acc[ai][bj][m][n] = __builtin_amdgcn_mfma_f32_16x16x32_bf16(Bt[n][k], At[m][k], acc[ai][bj][m][n], 0, 0, 0); __builtin_amdgcn_s_setprio(0); } while (0)
#define PG8_WAIT_V(n) asm volatile("s_waitcnt vmcnt(" #n ")" ::: "memory")
#define PG8_WAIT_L(n) asm volatile("s_waitcnt lgkmcnt(" #n ")" ::: "memory")
#define PG8_BAR __builtin_amdgcn_s_barrier()
#define PG8_SCHED __builtin_amdgcn_sched_barrier(0)
    Unit cur, nxt; int ui = 0;
    if (!S.next(0, cur)) return;
    f32x4 acc[2][2][4][2];
#pragma unroll
    for (int a = 0; a < 2; ++a)
#pragma unroll
        for (int b = 0; b < 2; ++b)
#pragma unroll
            for (int m = 0; m < 4; ++m)
#pragma unroll
                for (int n = 0; n < 2; ++n) acc[a][b][m][n] = (f32x4){0.f, 0.f, 0.f, 0.f};
    bf16x8 At[4][2], B0[2][2], B1[2][2];
    const char* cA = S.aptr(cur); const char* cB = S.bptr(cur);
    PG8_STAGE(PG8_SB(0, 0), cB, voffB); PG8_STAGE(PG8_SB(0, 1), cB + hstepB, voffB); PG8_STAGE(PG8_SA(0, 0), cA, voffA); PG8_STAGE(PG8_SA(0, 1), cA + hstepA, voffA);
    if (wr == 1) PG8_BAR;
    PG8_WAIT_V(2); PG8_BAR;
    PG8_STAGE(PG8_SB(1, 0), cB + kstep, voffB); PG8_STAGE(PG8_SA(1, 0), cA + kstep, voffA); PG8_STAGE(PG8_SB(1, 1), cB + hstepB + kstep, voffB);
    PG8_WAIT_V(6); PG8_BAR;
    for (;;) {
        const bool has_next = S.next(ui + 1, nxt);
        const char* nA = has_next ? S.aptr(nxt) : cA; const char* nB = has_next ? S.bptr(nxt) : cB;
        for (int t = 0; t < nt; t += 2) {
            const bool last = (t == nt - 2);
            const char* a1 = cA + (size_t)(t + 1) * kstep;
            const char* a2 = last ? nA : cA + (size_t)(t + 2) * kstep; const char* b2 = last ? nB : cB + (size_t)(t + 2) * kstep;
            const char* a3 = a2 + kstep; const char* b3 = b2 + kstep;
            PG8_LDB(B0, 0, 0); PG8_LDB(B1, 0, 1); PG8_SCHED; PG8_LDA(At, 0, 0); PG8_STAGE(PG8_SA(1, 1), a1 + hstepA, voffA);
            PG8_WAIT_V(8); PG8_WAIT_L(0); PG8_BAR; PG8_MMA(0, 0, At, B0); PG8_MMA(0, 1, At, B1); PG8_BAR; PG8_SCHED;
            PG8_LDA(At, 0, 1); PG8_STAGE(PG8_SB(0, 0), b2, voffB); PG8_STAGE(PG8_SB(0, 1), b2 + hstepB, voffB); PG8_STAGE(PG8_SA(0, 0), a2, voffA);
            PG8_WAIT_V(8); PG8_WAIT_L(0); PG8_BAR; PG8_MMA(1, 0, At, B0); PG8_MMA(1, 1, At, B1); PG8_BAR; PG8_SCHED;
            PG8_LDB(B0, 1, 0); PG8_LDB(B1, 1, 1); PG8_SCHED; PG8_LDA(At, 1, 0); PG8_STAGE(PG8_SA(0, 1), a2 + hstepA, voffA);
            PG8_WAIT_V(8); PG8_WAIT_L(0); PG8_BAR; PG8_MMA(0, 0, At, B0); PG8_MMA(0, 1, At, B1); PG8_BAR; PG8_SCHED;
            PG8_LDA(At, 1, 1); PG8_STAGE(PG8_SB(1, 0), b3, voffB); PG8_STAGE(PG8_SB(1, 1), b3 + hstepB, voffB); PG8_STAGE(PG8_SA(1, 0), a3, voffA);
            PG8_WAIT_V(8); PG8_WAIT_L(0); PG8_BAR; PG8_MMA(1, 0, At, B0); PG8_MMA(1, 1, At, B1); PG8_BAR; PG8_SCHED;
        }
        if (wr == 0) PG8_BAR;
        E(acc, cur, wr, wc, fr, fq);
        if (!has_next) break;
#pragma unroll
        for (int a = 0; a < 2; ++a)
#pragma unroll
            for (int b = 0; b < 2; ++b)
#pragma unroll
                for (int m = 0; m < 4; ++m)
#pragma unroll
                    for (int n = 0; n < 2; ++n) acc[a][b][m][n] = (f32x4){0.f, 0.f, 0.f, 0.f};
        cur = nxt; cA = nA; cB = nB; ++ui;
        if (wr == 1) PG8_BAR;
    }
    PG8_WAIT_V(0);
    PG8_BAR;
#undef PG8_SA
#undef PG8_SB
#undef PG8_STAGE
#undef PG8_LDA
#undef PG8_LDB
#undef PG8_MMA
#undef PG8_WAIT_V
#undef PG8_WAIT_L
#undef PG8_BAR
#undef PG8_SCHED
}
}

struct EpiProj {
    const Params* P;
    __device__ __forceinline__ void operator()(f32x4 (&acc)[2][2][4][2], const pg8::Unit& u, int wr, int wc, int fr, int fq) const {
        unsigned char* ws = P->ws;
        const int H = 4 * u.pn + wc;
        if (H > 76) return;
        const float* rs1 = (const float*)(ws + OFF_RS1);
        int kind; bf16_t* dst = nullptr; int pitch = 0, cb = 0; const float* gain = nullptr; float oscale = 1.f; bool slab = false; int sg = 0;
        if (H < 8)        { kind = 1; dst = (bf16_t*)(ws + OFF_R1);            pitch = 512; cb = H * 64;        gain = P->in[I_AQG]; oscale = QSCALE; }
        else if (H < 16)  { kind = 1; dst = (bf16_t*)(ws + OFF_R1 + 32 * MiB); pitch = 512; cb = (H - 8) * 64;  gain = P->in[I_AKG]; }
        else if (H < 24)  { kind = 0; dst = (bf16_t*)(ws + OFF_R1 + 64 * MiB); pitch = 512; cb = (H - 16) * 64; }
        else if (H < 32)  { kind = 1; dst = (bf16_t*)(ws + OFF_R1 + 96 * MiB); pitch = 512; cb = (H - 24) * 64; gain = P->in[I_BQG]; oscale = QSCALE; }
        else if (H < 34)  { kind = 0; dst = (bf16_t*)(ws + OFF_R2);            slab = true; sg = H - 32; }
        else if (H < 36)  { kind = 0; dst = (bf16_t*)(ws + OFF_R2 + 8 * MiB);  slab = true; sg = H - 34; }
        else if (H < 38)  { kind = 1; dst = (bf16_t*)(ws + OFF_R2 + 16 * MiB); pitch = 128; cb = (H - 36) * 64; gain = P->in[I_BKSG]; }
        else if (H < 40)  { kind = 0; dst = (bf16_t*)(ws + OFF_R2 + 24 * MiB); pitch = 128; cb = (H - 38) * 64; }
        else if (H < 42)  { kind = 1; dst = (bf16_t*)(ws + OFF_R2 + 32 * MiB); pitch = 128; cb = (H - 40) * 64; gain = P->in[I_BKWG]; }
        else if (H < 44)  { kind = 0; dst = (bf16_t*)(ws + OFF_R2 + 40 * MiB); pitch = 128; cb = (H - 42) * 64; }
        else if (H < 76)  { kind = 2; dst = (bf16_t*)(ws + OFF_R3);            pitch = 2048; cb = (H - 44) * 64; }
        else              { kind = 3; }
        f32x4 invrev[2] = {{0.f, 0.f, 0.f, 0.f}, {0.f, 0.f, 0.f, 0.f}};
        if (kind == 1) { invrev[0] = *(const f32x4*)((const float*)(ws + OFF_ROPE_C)); invrev[1] = *(const f32x4*)((const float*)(ws + OFF_ROPE_C) + 4); }
        float rsr[2][4];
#pragma unroll
        for (int ai = 0; ai < 2; ++ai)
#pragma unroll
            for (int m = 0; m < 4; ++m) rsr[ai][m] = rs1[u.pm * 256 + ai * 128 + wr * 64 + m * 16 + fr];
        f32x4 gv[2][2];
        if (kind == 1 || kind == 2) {
            const float* gp = (kind == 1) ? gain : P->in[I_BMERGE] + cb;
#pragma unroll
            for (int bj = 0; bj < 2; ++bj)
#pragma unroll
                for (int n = 0; n < 2; ++n) gv[bj][n] = *(const f32x4*)(gp + 32 * bj + 8 * fq + 4 * n);
        }
        const bool ksum = (H >= 8 && H < 16);
        f32x4 cs[2][2];
#pragma unroll
        for (int bj = 0; bj < 2; ++bj)
#pragma unroll
            for (int n = 0; n < 2; ++n) cs[bj][n] = (f32x4){0.f, 0.f, 0.f, 0.f};
#pragma unroll
        for (int ai = 0; ai < 2; ++ai)
#pragma unroll
            for (int m = 0; m < 4; ++m) {
                const int row = u.pm * 256 + ai * 128 + wr * 64 + m * 16 + fr;
                const float rs = rsr[ai][m];
                f32x4 v[2][2];
#pragma unroll
                for (int bj = 0; bj < 2; ++bj)
#pragma unroll
                    for (int n = 0; n < 2; ++n) v[bj][n] = acc[ai][bj][m][n] * rs;
                if (kind == 1) {
                    float ss = 0.f;
#pragma unroll
                    for (int bj = 0; bj < 2; ++bj)
#pragma unroll
                        for (int n = 0; n < 2; ++n) ss += (v[bj][n][0] * v[bj][n][0] + v[bj][n][1] * v[bj][n][1]) + (v[bj][n][2] * v[bj][n][2] + v[bj][n][3] * v[bj][n][3]);
                    ss = sum_xor16(ss); ss = sum_xor32(ss);
                    const float r = oscale * __builtin_amdgcn_rsqf(ss * (1.0f / 64.0f) + NORM_EPS);
#pragma unroll
                    for (int bj = 0; bj < 2; ++bj)
#pragma unroll
                        for (int n = 0; n < 2; ++n) v[bj][n] = v[bj][n] * gv[bj][n] * r;
                    const float posf = (float)(row & (SEQ - 1));
                    const float sgn = (fq == 0) ? -1.f : 1.f;
#pragma unroll
                    for (int n = 0; n < 2; ++n) {
                        const f32x4 me = v[0][n]; f32x4 ot, ro;
#pragma unroll
                        for (int i = 0; i < 4; ++i) ot[i] = get_xor16(me[i], fq & 1);
#pragma unroll
                        for (int i = 0; i < 4; ++i) { const float rev = __builtin_amdgcn_fractf(posf * invrev[n][i]); ro[i] = me[i] * __builtin_amdgcn_cosf(rev) + sgn * ot[i] * __builtin_amdgcn_sinf(rev); }
                        if (fq < 2) v[0][n] = ro;
                    }
                    if (ksum) {
#pragma unroll
                        for (int bj = 0; bj < 2; ++bj)
#pragma unroll
                            for (int n = 0; n < 2; ++n) cs[bj][n] += v[bj][n];
                    }
                } else if (kind == 2) {
#pragma unroll
                    for (int bj = 0; bj < 2; ++bj)
#pragma unroll
                        for (int n = 0; n < 2; ++n)
#pragma unroll
                            for (int i = 0; i < 4; ++i) v[bj][n][i] = sigmoidf_(v[bj][n][i] + gv[bj][n][i]);
                }
                if (kind == 3) {
                    float* bg = (float*)(ws + OFF_BGATE) + (size_t)row * 24;
                    if (fq < 3) {
#pragma unroll
                        for (int n = 0; n < 2; ++n) { f32x4 o; o.x = sigmoidf_(v[0][n][0]); o.y = sigmoidf_(v[0][n][1]); o.z = sigmoidf_(v[0][n][2]); o.w = sigmoidf_(v[0][n][3]); *(f32x4*)(bg + 8 * fq + 4 * n) = o; }
                    }
                } else {
                    bf16_t* rp;
                    if (slab) { const int b = row >> 12, s = row & (SEQ - 1); rp = dst + ((size_t)((b * 2 + sg) * SEQ + s)) * 64 + 8 * fq; }
                    else rp = dst + (size_t)row * pitch + cb + 8 * fq;
#pragma unroll
                    for (int bj = 0; bj < 2; ++bj) {
                        u32x4 w; w.x = pk2(v[bj][0][0], v[bj][0][1]); w.y = pk2(v[bj][0][2], v[bj][0][3]); w.z = pk2(v[bj][1][0], v[bj][1][1]); w.w = pk2(v[bj][1][2], v[bj][1][3]);
                        *(u32x4*)(rp + 32 * bj) = w;
                    }
                }
            }
        if (ksum) {
            float* km = (float*)(ws + OFF_KMEAN) + (size_t)(((u.pm >> 4) * 8 + (H - 8)) * 16 + (u.pm & 15)) * 64;
#pragma unroll
            for (int bj = 0; bj < 2; ++bj)
#pragma unroll
                for (int n = 0; n < 2; ++n)
#pragma unroll
                    for (int i = 0; i < 4; ++i) {
                        float t = cs[bj][n][i];
                        t += __shfl_xor(t, 1); t += __shfl_xor(t, 2); t += __shfl_xor(t, 4); t += __shfl_xor(t, 8);
                        if (fr == 0) atomicAdd(km + 32 * bj + 8 * fq + 4 * n + i, t);
                    }
        }
    }
};
__device__ __forceinline__ void phase_proj(const Params& P, LDSP unsigned char* lds, int vcu, int G) {
    pg8::Sched S; S.A0 = S.A1 = (const bf16_t*)(P.ws + OFF_R0); S.B0 = S.B1 = (const bf16_t*)(P.ws + OFF_WIN_T);
    S.lda = DM; S.ldb = DM; S.K = DM; S.nM = T / 256; S.nN = NPROJ / 256; S.NZ = 1; S.G = G; S.c = blockIdx.x;
    EpiProj E{&P};
    pg8::gemm_phase(lds, S, E);
}

constexpr size_t OFF_CPART = OFF_EXPERTS;
constexpr size_t CPART_STRIDE = (size_t)2 * 4096 * 256;
__device__ __forceinline__ void phase_cmp1(const Params& P, LDSP unsigned char* lds, int vcu, int G) {
    unsigned char* ws = P.ws;
    const int tid = opaque_tid(), lane = tid & 63, wid = tid >> 6, wm = wid >> 1, wn = wid & 1, fr = lane & 15, fq = lane >> 4;
    for (int item = vcu; item < 256; item += G) {
        const int kc = item & 3, tn = (item >> 2) & 1, tm = (item >> 3) & 15, kv = item >> 7;
        const bf16_t* A = (const bf16_t*)(ws + OFF_R2 + (size_t)kv * 8 * MiB) + (size_t)tm * SEQ * 64 + kc * 512;
        const bf16_t* Bt = (const bf16_t*)(ws + (kv ? OFF_W1V_T : OFF_W1K_T)) + (size_t)tn * G_BN * 2048 + kc * 512;
        float* part = (float*)(ws + OFF_CPART) + (size_t)kc * CPART_STRIDE + (size_t)kv * 4096 * 256;
        f32x4 acc[4][4];
        zero_acc(acc);
        gemm_kloop(acc, A, 1024, Bt, 2048, 512, lds);
        const int row0 = tm * 256 + wm * 64 + fr, col0 = tn * 128 + wn * 64 + 4 * fq;
#pragma unroll
        for (int m = 0; m < 4; ++m)
#pragma unroll
            for (int n = 0; n < 4; ++n) *(f32x4*)(part + (size_t)(row0 + m * 16) * 256 + col0 + n * 16) = acc[m][n];
    }
}

__device__ __forceinline__ u32x4 load_hid8(const float* part, const float* posb, size_t rowoff, int k) {
    f32x4 a = *(const f32x4*)(posb + k), b = *(const f32x4*)(posb + k + 4);
#pragma unroll
    for (int c = 0; c < 4; ++c) { a += *(const f32x4*)(part + c * CPART_STRIDE + rowoff + k); b += *(const f32x4*)(part + c * CPART_STRIDE + rowoff + k + 4); }
    u32x4 o; o.x = pk2(gelu_tanh(a.x), gelu_tanh(a.y)); o.y = pk2(gelu_tanh(a.z), gelu_tanh(a.w)); o.z = pk2(gelu_tanh(b.x), gelu_tanh(b.y)); o.w = pk2(gelu_tanh(b.z), gelu_tanh(b.w));
    return o;
}
__device__ __forceinline__ void phase_cmp2(const Params& P, LDSP unsigned char* lds, int vcu, int G) {
    unsigned char* ws = P.ws;
    const int tid = opaque_tid(), lane = tid & 63, wid = tid >> 6, wm = wid >> 1, wn = wid & 1, fr = lane & 15, fq = lane >> 4;
    const int lrow = tid >> 3, lch = tid & 7;
    for (int item = vcu; item < 32; item += G) {
        const int kv = item >> 4, tm = item & 15;
        const float* part = (const float*)(ws + OFF_CPART) + (size_t)kv * 4096 * 256 + (size_t)tm * 256 * 256;
        const float* posb = (const float*)(ws + OFF_POSB) + kv * 256;
        const bf16_t* Bt = (const bf16_t*)(ws + (kv ? OFF_W2V_T : OFF_W2K_T));
        const float* b2 = P.in[kv ? I_CVB2 : I_CKB2];
        bf16_t* dst = (bf16_t*)(ws + (kv ? OFF_VC : OFF_KC)) + (size_t)tm * 256 * 64;
        f32x4 acc[4][4];
        zero_acc(acc);
        {
            const bf16_t* gb = Bt + (size_t)lrow * 256 + lch * 8;
            u32x4 ra[4], rb[2];
#pragma unroll
            for (int p = 0; p < 4; ++p) ra[p] = load_hid8(part, posb, (size_t)(lrow + 64 * p) * 256, lch * 8);
#pragma unroll
            for (int p = 0; p < 2; ++p) rb[p] = *(const u32x4*)(gb + (size_t)(64 * p) * 256);
            __syncthreads();
#pragma unroll
            for (int p = 0; p < 4; ++p) *(LDSP u32x4*)(lds + swz_off(lrow + 64 * p, lch)) = ra[p];
#pragma unroll
            for (int p = 0; p < 2; ++p) *(LDSP u32x4*)(lds + G_ABYTES + swz_off(lrow + 64 * p, lch)) = rb[p];
            __syncthreads();
#pragma unroll 1
            for (int kt = 0; kt < 4; ++kt) {
                LDSP unsigned char* cur = lds + (kt & 1) * G_STAGE;
                LDSP unsigned char* nxt = lds + ((kt + 1) & 1) * G_STAGE;
                if (kt + 1 < 4) {
#pragma unroll
                    for (int p = 0; p < 4; ++p) ra[p] = load_hid8(part, posb, (size_t)(lrow + 64 * p) * 256, (kt + 1) * G_BK + lch * 8);
#pragma unroll
                    for (int p = 0; p < 2; ++p) rb[p] = *(const u32x4*)(gb + (size_t)(64 * p) * 256 + (kt + 1) * G_BK);
                }
#pragma unroll
                for (int ks = 0; ks < 2; ++ks) {
                    bf16x8 af[4], bfr[4];
#pragma unroll
                    for (int m = 0; m < 4; ++m) af[m] = *(const LDSP bf16x8*)(cur + swz_off(wm * 64 + m * 16 + fr, ks * 4 + fq));
#pragma unroll
                    for (int n = 0; n < 4; ++n) bfr[n] = *(const LDSP bf16x8*)(cur + G_ABYTES + swz_off(wn * 64 + n * 16 + fr, ks * 4 + fq));
#pragma unroll
                    for (int m = 0; m < 4; ++m)
#pragma unroll
                        for (int n = 0; n < 4; ++n) acc[m][n] = __builtin_amdgcn_mfma_f32_16x16x32_bf16(bfr[n], af[m], acc[m][n], 0, 0, 0);
                }
                if (kt + 1 < 4) {
#pragma unroll
                    for (int p = 0; p < 4; ++p) *(LDSP u32x4*)(nxt + swz_off(lrow + 64 * p, lch)) = ra[p];
#pragma unroll
                    for (int p = 0; p < 2; ++p) *(LDSP u32x4*)(nxt + G_ABYTES + swz_off(lrow + 64 * p, lch)) = rb[p];
                }
                __syncthreads();
            }
        }
        if (wn == 0) {
            float gv[4][4];
#pragma unroll
            for (int n = 0; n < 4; ++n) {
                const f32x4 bb = *(const f32x4*)(b2 + n * 16 + 4 * fq);
                const f32x4 g4 = kv ? (f32x4){1.f, 1.f, 1.f, 1.f} : *(const f32x4*)(P.in[I_BKCG] + n * 16 + 4 * fq);
                gv[n][0] = g4.x; gv[n][1] = g4.y; gv[n][2] = g4.z; gv[n][3] = g4.w;
#pragma unroll
                for (int m = 0; m < 4; ++m) acc[m][n] += bb;
            }
#pragma unroll
            for (int m = 0; m < 4; ++m) {
                float r = 1.f;
                if (kv == 0) {
                    float ss = 0.f;
#pragma unroll
                    for (int n = 0; n < 4; ++n) ss += (acc[m][n][0] * acc[m][n][0] + acc[m][n][1] * acc[m][n][1]) + (acc[m][n][2] * acc[m][n][2] + acc[m][n][3] * acc[m][n][3]);
                    ss += __shfl_xor(ss, 16); ss += __shfl_xor(ss, 32);
                    r = 1.0f / sqrtf(ss * (1.0f / 64.0f) + NORM_EPS);
                }
                const int row = wm * 64 + m * 16 + fr;
                if (row == 255) r = 0.f;
#pragma unroll
                for (int n = 0; n < 4; ++n) {
                    f32x4 o = acc[m][n];
                    if (row == 255) o = (f32x4){0.f, 0.f, 0.f, 0.f};
                    u32x2 w; w.x = pk2(o[0] * r * gv[n][0], o[1] * r * gv[n][1]); w.y = pk2(o[2] * r * gv[n][2], o[3] * r * gv[n][3]);
                    *(u32x2*)(dst + (size_t)row * 64 + n * 16 + 4 * fq) = w;
                }
            }
        }
    }
}

__device__ __forceinline__ void phase_cmp(const Params& P, LDSP unsigned char* lds, int vcu, int G) {
    unsigned char* ws = P.ws;
    const int tid = opaque_tid(), lane = tid & 63, r32 = lane & 31, hi = lane >> 5;
    const int wu = __builtin_amdgcn_readfirstlane(tid >> 6);
    for (int item = vcu; item < 256; item += G) {
        const int kv = item >> 7, bg = (item >> 3) & 15, rb = item & 7;
        const bf16_t* A = (const bf16_t*)(ws + OFF_R2 + (size_t)kv * 8 * MiB) + ((size_t)bg * SEQ + 512 * rb) * 64;
        const bf16_t* W1 = (const bf16_t*)(ws + (kv ? OFF_W1V_T : OFF_W1K_T)) + (size_t)(32 * wu + r32) * 2048 + 32 * hi;
        __syncthreads();
        for (int pc = wu; pc < 66; pc += 8) {
            const int g16 = pc >> 1, h8 = pc & 1, tau = 16 * g16 + 8 * h8 + (lane >> 3), c = (lane & 7) ^ ((g16 >> 1) & 7);
            __builtin_amdgcn_global_load_lds((const unsigned*)(A + (size_t)tau * 64 + c * 8), (LDSP unsigned*)(lds + (17 * g16 + 8 * h8) * 128), 16, 0, 0);
        }
        u32x4 Bq[8][4];
#pragma unroll
        for (int j = 0; j < 8; ++j)
#pragma unroll
            for (int i = 0; i < 4; ++i) Bq[j][i] = *(const u32x4*)(W1 + 64 * j + 8 * i);
        const int abase = 17 * r32 * 128;
        int aoff[2][4];
#pragma unroll
        for (int jh = 0; jh < 2; ++jh)
#pragma unroll
            for (int i = 0; i < 4; ++i) aoff[jh][i] = abase + ((((4 * hi + i) ^ (((r32 + jh) >> 1) & 7))) << 4);
        f32x16 acc;
#pragma unroll
        for (int r = 0; r < 16; ++r) acc[r] = 0.f;
        asm volatile("s_waitcnt vmcnt(32)" ::: "memory");
        __syncthreads();
#pragma unroll
        for (int j = 0; j < 32; ++j) {
#pragma unroll
            for (int i = 0; i < 4; ++i) {
                const bf16x8 xf = *(const LDSP bf16x8*)(lds + aoff[j >> 4][i] + (j + (j >> 4)) * 128);
                acc = __builtin_amdgcn_mfma_f32_32x32x16_bf16(__builtin_bit_cast(bf16x8, Bq[j & 7][i]), xf, acc, 0, 0, 0);
            }
            if (j + 8 < 32) {
#pragma unroll
                for (int i = 0; i < 4; ++i) Bq[j & 7][i] = *(const u32x4*)(W1 + 64 * (j + 8) + 8 * i);
            }
            __builtin_amdgcn_sched_barrier(0);
        }
        const float* posb = (const float*)(ws + OFF_POSB) + kv * 256 + 32 * wu + 4 * hi;
        u32x4 pw[2];
#pragma unroll
        for (int q = 0; q < 4; ++q) {
            const f32x4 pb = *(const f32x4*)(posb + 8 * q);
            const float h0 = gelu_tanh(acc[4 * q] + pb.x), h1 = gelu_tanh(acc[4 * q + 1] + pb.y), h2 = gelu_tanh(acc[4 * q + 2] + pb.z), h3 = gelu_tanh(acc[4 * q + 3] + pb.w);
            pw[q >> 1][(q & 1) * 2] = pk2(h0, h1); pw[q >> 1][(q & 1) * 2 + 1] = pk2(h2, h3);
        }
        const bf16_t* W2 = (const bf16_t*)(ws + (kv ? OFF_W2V_T : OFF_W2K_T)) + (size_t)r32 * 256 + 32 * wu + 4 * hi;
        f32x16 o2[2];
#pragma unroll
        for (int mb = 0; mb < 2; ++mb) {
#pragma unroll
            for (int r = 0; r < 16; ++r) o2[mb][r] = 0.f;
#pragma unroll
            for (int s2 = 0; s2 < 2; ++s2) {
                const u32x2 lo = *(const u32x2*)(W2 + (size_t)mb * 32 * 256 + 16 * s2), hh = *(const u32x2*)(W2 + (size_t)mb * 32 * 256 + 16 * s2 + 8);
                const u32x4 a2 = {lo.x, lo.y, hh.x, hh.y};
                o2[mb] = __builtin_amdgcn_mfma_f32_32x32x16_bf16(__builtin_bit_cast(bf16x8, a2), __builtin_bit_cast(bf16x8, pw[s2]), o2[mb], 0, 0, 0);
            }
        }
        __syncthreads();
        {
            LDSP float* part = (LDSP float*)lds + (size_t)(wu * 32 + r32) * 68 + 4 * hi;
#pragma unroll
            for (int mb = 0; mb < 2; ++mb)
#pragma unroll
                for (int q = 0; q < 4; ++q) *(LDSP f32x4*)(part + 32 * mb + 8 * q) = (f32x4){o2[mb][4 * q], o2[mb][4 * q + 1], o2[mb][4 * q + 2], o2[mb][4 * q + 3]};
        }
        __syncthreads();
        {
            const int row = tid >> 4, dq = tid & 15;
            f32x4 v = *(const f32x4*)(P.in[kv ? I_CVB2 : I_CKB2] + 4 * dq);
#pragma unroll
            for (int w = 0; w < 8; ++w) v += *(const LDSP f32x4*)((LDSP float*)lds + (size_t)(w * 32 + row) * 68 + 4 * dq);
            float rr = 1.f; f32x4 g4 = {1.f, 1.f, 1.f, 1.f};
            if (kv == 0) {
                float ss = (v.x * v.x + v.y * v.y) + (v.z * v.z + v.w * v.w);
                ss += __shfl_xor(ss, 1); ss += __shfl_xor(ss, 2); ss += __shfl_xor(ss, 4); ss += __shfl_xor(ss, 8);
                rr = 1.0f / sqrtf(ss * (1.0f / 64.0f) + NORM_EPS);
                g4 = *(const f32x4*)(P.in[I_BKCG] + 4 * dq);
            }
            const int grow = 32 * rb + row;
            u32x2 w2; w2.x = pk2(v.x * rr * g4.x, v.y * rr * g4.y); w2.y = pk2(v.z * rr * g4.z, v.w * rr * g4.w);
            if (grow == 255) w2 = (u32x2){0u, 0u};
            *(u32x2*)((bf16_t*)(ws + (kv ? OFF_VC : OFF_KC)) + ((size_t)bg * 256 + grow) * 64 + 4 * dq) = w2;
        }
    }
    __syncthreads();
}

constexpr int A_GS = 65536, A_ES = 81920, A_Y = 65536, A_MISC = 131072;
typedef short v4i16_t __attribute__((ext_vector_type(4)));
struct ASt { f32x16 o0, o1; float m, l; };
struct KVStage { u32x4 k, v; };
__device__ __forceinline__ void kv_load(KVStage& s, const bf16_t* Kg, const bf16_t* Vg, size_t pitch, int tid) {
    const int key = tid >> 3, ch = tid & 7;
    s.k = *(const u32x4*)(Kg + (size_t)key * pitch + ch * 8);
    s.v = *(const u32x4*)(Vg + (size_t)key * pitch + ch * 8);
}
__device__ __forceinline__ void kv_store(const KVStage& s, LDSP unsigned char* buf, int tid) {
    const int key = tid >> 3, ch = tid & 7;
    *(LDSP u32x4*)(buf + swz_off(key, ch)) = s.k;
    *(LDSP u32x4*)(buf + 8192 + ((ch >> 2) * 4 + (key >> 4)) * 1024 + (key & 15) * 64 + (ch & 3) * 16) = s.v;
}
__device__ __forceinline__ void kv_dma(const bf16_t* Kg, const bf16_t* Vg, size_t pitch, LDSP unsigned char* buf, int wid, int lane) {
    const int row = wid * 8 + (lane >> 3), chunk = (lane & 7) ^ ((row >> 1) & 7);
    __builtin_amdgcn_global_load_lds((const unsigned*)(Kg + (size_t)row * pitch + chunk * 8), (LDSP unsigned*)(buf + wid * 1024), 16, 0, 0);
    const int vrow = (wid & 3) * 16 + (lane >> 2), vcol = (wid >> 2) * 32 + (lane & 3) * 8;
    __builtin_amdgcn_global_load_lds((const unsigned*)(Vg + (size_t)vrow * pitch + vcol), (LDSP unsigned*)(buf + 8192 + wid * 1024), 16, 0, 0);
}
__device__ __forceinline__ float swap32f(float v) { return __shfl_xor(v, 32); }
__device__ __forceinline__ void ast_reset(ASt& st) {
#pragma unroll
    for (int r = 0; r < 16; ++r) { st.o0[r] = 0.f; st.o1[r] = 0.f; }
    st.m = 0.f; st.l = 0.f;
}
constexpr float ATT_THR = 8.0f;
template <int MODE>
__device__ __forceinline__ void attn_tile(ASt& st, const bf16x8 (&qf)[4], LDSP const unsigned char* kt, int lane, bool rowoff, int kl, int kh, bool need_mask,
                                          float linv, LDSP float* gs, LDSP float* es, int jbase, int ql) {
    const int r32 = lane & 31, hi = lane >> 5;
    const float cin = rowoff ? -INFINITY : -st.m;
    f32x16 p0, p1;
#pragma unroll
    for (int r = 0; r < 16; ++r) { p0[r] = cin; p1[r] = cin; }
#pragma unroll
    for (int d0 = 0; d0 < 4; ++d0) {
        const bf16x8 k0f = *(const LDSP bf16x8*)(kt + swz_off(r32, 2 * d0 + hi));
        const bf16x8 k1f = *(const LDSP bf16x8*)(kt + swz_off(r32 + 32, 2 * d0 + hi));
        p0 = __builtin_amdgcn_mfma_f32_32x32x16_bf16(k0f, qf[d0], p0, 0, 0, 0);
        p1 = __builtin_amdgcn_mfma_f32_32x32x16_bf16(k1f, qf[d0], p1, 0, 0, 0);
    }
    if (need_mask) {
        const int kl2 = kl - 4 * hi, kh2 = kh - 4 * hi;
#pragma unroll
        for (int r = 0; r < 16; ++r) {
            const int c = (r & 3) + 8 * (r >> 2);
            const bool v0 = c >= kl2 && c <= kh2, v1 = (c + 32) >= kl2 && (c + 32) <= kh2;
            p0[r] = v0 ? p0[r] : -INFINITY; p1[r] = v1 ? p1[r] : -INFINITY;
        }
    }
    if (MODE != 2) {
        float mx = fmaxf(fmaxf(p0[0], p1[0]), fmaxf(p0[1], p1[1]));
#pragma unroll
        for (int r = 2; r < 16; r += 2) mx = fmaxf(fmaxf(mx, fmaxf(p0[r], p1[r])), fmaxf(p0[r + 1], p1[r + 1]));
        mx = fmaxf(mx, swap32f(mx));
        if (__any(mx > ATT_THR)) {
            const float dl = (mx > ATT_THR) ? mx : 0.f;
            const float alpha = __builtin_amdgcn_exp2f(-dl);
            st.m += dl; st.l *= alpha;
#pragma unroll
            for (int r = 0; r < 16; ++r) { p0[r] -= dl; p1[r] -= dl; }
            if (MODE == 0) {
#pragma unroll
                for (int r = 0; r < 16; ++r) { st.o0[r] *= alpha; st.o1[r] *= alpha; }
            }
        }
    }
#pragma unroll
    for (int r = 0; r < 16; ++r) { p0[r] = __builtin_amdgcn_exp2f(p0[r]); p1[r] = __builtin_amdgcn_exp2f(p1[r]); }
    if (MODE != 2) {
        const f32x16 t = p0 + p1;
        st.l += ((t[0] + t[1]) + (t[2] + t[3])) + ((t[4] + t[5]) + (t[6] + t[7])) + (((t[8] + t[9]) + (t[10] + t[11])) + ((t[12] + t[13]) + (t[14] + t[15])));
    } else {
#pragma unroll
        for (int r = 0; r < 16; ++r) { p0[r] *= linv; p1[r] *= linv; }
#pragma unroll
        for (int qd = 0; qd < 4; ++qd) {
            float g0 = (p0[4 * qd] + p0[4 * qd + 1]) + (p0[4 * qd + 2] + p0[4 * qd + 3]), e0 = p0[4 * qd + 3];
            float g1 = (p1[4 * qd] + p1[4 * qd + 1]) + (p1[4 * qd + 2] + p1[4 * qd + 3]), e1 = p1[4 * qd + 3];
            g0 += __shfl_xor(g0, 1); g0 += __shfl_xor(g0, 2); e0 += __shfl_xor(e0, 1); e0 += __shfl_xor(e0, 2);
            g1 += __shfl_xor(g1, 1); g1 += __shfl_xor(g1, 2); e1 += __shfl_xor(e1, 1); e1 += __shfl_xor(e1, 2);
            if ((r32 & 3) == 0) {
                const int j = jbase + 2 * qd + hi;
                gs[ql * 64 + j] = g0; es[ql * 64 + j] = e0; gs[ql * 64 + j + 8] = g1; es[ql * 64 + j + 8] = e1;
            }
        }
    }
    if (MODE != 1) {
        u32x4 pw[4];
        pw[0] = (u32x4){pk2(p0[0], p0[1]), pk2(p0[2], p0[3]), pk2(p0[4], p0[5]), pk2(p0[6], p0[7])};
        pw[1] = (u32x4){pk2(p0[8], p0[9]), pk2(p0[10], p0[11]), pk2(p0[12], p0[13]), pk2(p0[14], p0[15])};
        pw[2] = (u32x4){pk2(p1[0], p1[1]), pk2(p1[2], p1[3]), pk2(p1[4], p1[5]), pk2(p1[6], p1[7])};
        pw[3] = (u32x4){pk2(p1[8], p1[9]), pk2(p1[10], p1[11]), pk2(p1[12], p1[13]), pk2(p1[14], p1[15])};
        LDSP const unsigned char* vb = kt + 8192 + ((lane >> 4) & 1) * 32 + (lane & 3) * 8 + (4 * hi + ((lane & 15) >> 2)) * 64;
#pragma unroll
        for (int ks = 0; ks < 4; ++ks) {
            const bf16x8 pf = __builtin_bit_cast(bf16x8, pw[ks]);
#pragma unroll
            for (int d0 = 0; d0 < 2; ++d0) {
                const v4i16_t lo = __builtin_amdgcn_ds_read_tr16_b64_v4i16((LDSP v4i16_t*)(vb + (d0 * 4 + ks) * 1024));
                const v4i16_t hh = __builtin_amdgcn_ds_read_tr16_b64_v4i16((LDSP v4i16_t*)(vb + (d0 * 4 + ks) * 1024 + 512));
                const bf16x8 vf = (bf16x8){lo[0], lo[1], lo[2], lo[3], hh[0], hh[1], hh[2], hh[3]};
                if (d0 == 0) st.o0 = __builtin_amdgcn_mfma_f32_32x32x16_bf16(vf, pf, st.o0, 0, 0, 0);
                else         st.o1 = __builtin_amdgcn_mfma_f32_32x32x16_bf16(vf, pf, st.o1, 0, 0, 0);
            }
            if (ks & 1) __builtin_amdgcn_sched_barrier(0);
        }
    }
}

#define KV_LOOP(NT, KPTR, VPTR, PITCH, ...) do { const int nt_ = (NT), np_ = (nt_ + 1) >> 1; KVStage sa_, sb_; __syncthreads(); \
    { const int i = 0; kv_load(sa_, (KPTR), (VPTR), (PITCH), tid); } { const int i = (nt_ > 1) ? 1 : 0; kv_load(sb_, (KPTR), (VPTR), (PITCH), tid); } \
    kv_store(sa_, lds, tid); kv_store(sb_, lds + 16384, tid); __syncthreads(); \
    _Pragma("unroll 1") for (int ip_ = 0; ip_ < np_; ++ip_) { LDSP unsigned char* cur0_ = lds + (ip_ & 1) * 32768; \
        if (ip_ + 1 < np_) { { const int i = 2 * ip_ + 2; kv_load(sa_, (KPTR), (VPTR), (PITCH), tid); } \
                             { const int i = (2 * ip_ + 3 < nt_) ? 2 * ip_ + 3 : 2 * ip_ + 2; kv_load(sb_, (KPTR), (VPTR), (PITCH), tid); } } \
        { const int i = 2 * ip_; LDSP unsigned char* cur = cur0_; __VA_ARGS__ } \
        if (2 * ip_ + 1 < nt_) { const int i = 2 * ip_ + 1; LDSP unsigned char* cur = cur0_ + 16384; __VA_ARGS__ } \
        if (ip_ + 1 < np_) { kv_store(sa_, lds + ((ip_ + 1) & 1) * 32768, tid); kv_store(sb_, lds + ((ip_ + 1) & 1) * 32768 + 16384, tid); } \
        __syncthreads(); } } while (0)

struct TP { bool rowoff, nm; int kl, kh; };
__device__ __forceinline__ void pair_kload(bf16x8 (&kf)[8], LDSP const unsigned char* kt, int r32, int hi) {
#pragma unroll
    for (int d0 = 0; d0 < 4; ++d0) {
        kf[2 * d0]     = *(const LDSP bf16x8*)(kt + swz_off(r32, 2 * d0 + hi));
        kf[2 * d0 + 1] = *(const LDSP bf16x8*)(kt + swz_off(r32 + 32, 2 * d0 + hi));
    }
}
__device__ __forceinline__ void pair_vload(bf16x8 (&vf)[8], LDSP const unsigned char* kt, int lane, int hi) {
    LDSP const unsigned char* vb = kt + 8192 + ((lane >> 4) & 1) * 32 + (lane & 3) * 8 + (4 * hi + ((lane & 15) >> 2)) * 64;
#pragma unroll
    for (int ks = 0; ks < 4; ++ks)
#pragma unroll
        for (int d0 = 0; d0 < 2; ++d0) {
            const v4i16_t lo = __builtin_amdgcn_ds_read_tr16_b64_v4i16((LDSP v4i16_t*)(vb + (d0 * 4 + ks) * 1024));
            const v4i16_t hh = __builtin_amdgcn_ds_read_tr16_b64_v4i16((LDSP v4i16_t*)(vb + (d0 * 4 + ks) * 1024 + 512));
            vf[2 * ks + d0] = (bf16x8){lo[0], lo[1], lo[2], lo[3], hh[0], hh[1], hh[2], hh[3]};
        }
}
#define PAIR_LDS_WAIT() do { asm volatile("s_waitcnt lgkmcnt(0)" ::: "memory"); __builtin_amdgcn_sched_barrier(0); } while (0)
__device__ __forceinline__ void pair_qk(f32x16& p0, f32x16& p1, float cin, const bf16x8 (&qf)[4], const bf16x8 (&kf)[8]) {
    f32x16 c16;
#pragma unroll
    for (int r = 0; r < 16; ++r) c16[r] = cin;
#pragma unroll
    for (int d0 = 0; d0 < 4; ++d0) {
        p0 = __builtin_amdgcn_mfma_f32_32x32x16_bf16(kf[2 * d0], qf[d0], d0 == 0 ? c16 : p0, 0, 0, 0);
        p1 = __builtin_amdgcn_mfma_f32_32x32x16_bf16(kf[2 * d0 + 1], qf[d0], d0 == 0 ? c16 : p1, 0, 0, 0);
    }
}
__device__ __forceinline__ void pair_sm(ASt& st, f32x16& p0, f32x16& p1, u32x4 (&pw)[4], const TP& t, float pend, int hi) {
    if (t.nm) {
        const int kl2 = t.kl - 4 * hi, kh2 = t.kh - 4 * hi;
#pragma unroll
        for (int r = 0; r < 16; ++r) {
            const int c = (r & 3) + 8 * (r >> 2);
            const bool v0 = c >= kl2 && c <= kh2, v1 = (c + 32) >= kl2 && (c + 32) <= kh2;
            p0[r] = v0 ? p0[r] : -INFINITY; p1[r] = v1 ? p1[r] : -INFINITY;
        }
    }
    float mx = fmaxf(fmaxf(p0[0], p1[0]), fmaxf(p0[1], p1[1]));
#pragma unroll
    for (int r = 2; r < 16; r += 2) mx = fmaxf(fmaxf(mx, fmaxf(p0[r], p1[r])), fmaxf(p0[r + 1], p1[r + 1]));
    { const auto rr = __builtin_amdgcn_permlane32_swap(__float_as_uint(mx), __float_as_uint(mx), false, false); mx = fmaxf(__uint_as_float(rr[0]), __uint_as_float(rr[1])); }
    mx -= pend;
    if (__any(mx > ATT_THR || pend != 0.f)) {
        const float dl = (mx > ATT_THR) ? mx : 0.f;
        const float alpha = __builtin_amdgcn_exp2f(-dl), sub = dl + pend;
        st.m += dl; st.l *= alpha;
#pragma unroll
        for (int r = 0; r < 16; ++r) { p0[r] -= sub; p1[r] -= sub; st.o0[r] *= alpha; st.o1[r] *= alpha; }
    }
#pragma unroll
    for (int r = 0; r < 16; ++r) { p0[r] = __builtin_amdgcn_exp2f(p0[r]); p1[r] = __builtin_amdgcn_exp2f(p1[r]); }
    const f32x16 tt = p0 + p1;
    st.l += ((tt[0] + tt[1]) + (tt[2] + tt[3])) + ((tt[4] + tt[5]) + (tt[6] + tt[7])) + (((tt[8] + tt[9]) + (tt[10] + tt[11])) + ((tt[12] + tt[13]) + (tt[14] + tt[15])));
    pw[0] = (u32x4){pk2(p0[0], p0[1]), pk2(p0[2], p0[3]), pk2(p0[4], p0[5]), pk2(p0[6], p0[7])};
    pw[1] = (u32x4){pk2(p0[8], p0[9]), pk2(p0[10], p0[11]), pk2(p0[12], p0[13]), pk2(p0[14], p0[15])};
    pw[2] = (u32x4){pk2(p1[0], p1[1]), pk2(p1[2], p1[3]), pk2(p1[4], p1[5]), pk2(p1[6], p1[7])};
    pw[3] = (u32x4){pk2(p1[8], p1[9]), pk2(p1[10], p1[11]), pk2(p1[12], p1[13]), pk2(p1[14], p1[15])};
}
__device__ __forceinline__ void pair_pv(ASt& st, const u32x4 (&pw)[4], const bf16x8 (&vf)[8]) {
#pragma unroll
    for (int ks = 0; ks < 4; ++ks) {
        const bf16x8 pf = __builtin_bit_cast(bf16x8, pw[ks]);
        st.o0 = __builtin_amdgcn_mfma_f32_32x32x16_bf16(vf[2 * ks], pf, st.o0, 0, 0, 0);
        st.o1 = __builtin_amdgcn_mfma_f32_32x32x16_bf16(vf[2 * ks + 1], pf, st.o1, 0, 0, 0);
    }
}
__device__ __forceinline__ void attn_pair(ASt& st, const bf16x8 (&qf)[4], LDSP const unsigned char* ka, LDSP const unsigned char* kb, int lane, const TP& ta, const TP& tb) {
    const int r32 = lane & 31, hi = lane >> 5;
    const float m0 = st.m;
    f32x16 a0, a1, b0, b1; u32x4 pwa[4], pwb[4];
    bf16x8 kfa[8], kfb[8], vf[8];
    pair_kload(kfa, ka, r32, hi); pair_kload(kfb, kb, r32, hi);
    PAIR_LDS_WAIT();
    pair_qk(a0, a1, ta.rowoff ? -INFINITY : -m0, qf, kfa);
    pair_qk(b0, b1, tb.rowoff ? -INFINITY : -m0, qf, kfb);
    pair_vload(vf, ka, lane, hi);
    __builtin_amdgcn_sched_barrier(0);
    pair_sm(st, a0, a1, pwa, ta, 0.f, hi);
    PAIR_LDS_WAIT();
    pair_pv(st, pwa, vf);
    __builtin_amdgcn_sched_barrier(0);
    pair_vload(vf, kb, lane, hi);
    __builtin_amdgcn_sched_barrier(0);
    pair_sm(st, b0, b1, pwb, tb, st.m - m0, hi);
    PAIR_LDS_WAIT();
    pair_pv(st, pwb, vf);
}
template <int I, bool MASK>
__device__ __forceinline__ void pair_exp_chunk(const f32x16& p0, const f32x16& p1, u32x4 (&pw)[4], float& sacc, int kl2, int kh2) {
    const f32x16& src = (I < 4) ? p0 : p1; constexpr int b = 4 * (I & 3);
    float x0 = src[b], x1 = src[b + 1], x2 = src[b + 2], x3 = src[b + 3];
    if (MASK) {
        constexpr int c0 = 8 * (b >> 2) + ((I < 4) ? 0 : 32);
        x0 = (c0 >= kl2 && c0 <= kh2) ? x0 : -INFINITY; x1 = (c0 + 1 >= kl2 && c0 + 1 <= kh2) ? x1 : -INFINITY;
        x2 = (c0 + 2 >= kl2 && c0 + 2 <= kh2) ? x2 : -INFINITY; x3 = (c0 + 3 >= kl2 && c0 + 3 <= kh2) ? x3 : -INFINITY;
    }
    const float e0 = __builtin_amdgcn_exp2f(x0), e1 = __builtin_amdgcn_exp2f(x1), e2 = __builtin_amdgcn_exp2f(x2), e3 = __builtin_amdgcn_exp2f(x3);
    sacc += (e0 + e1) + (e2 + e3);
    pw[I >> 1][(I & 1) * 2] = pk2(e0, e1); pw[I >> 1][(I & 1) * 2 + 1] = pk2(e2, e3);
}
#define PAIR_SB() __builtin_amdgcn_sched_barrier(0)
__device__ __forceinline__ bf16x8 vfrag_load(LDSP const unsigned char* vb, int idx) {
    const int off = ((idx & 1) * 4 + (idx >> 1)) * 1024;
    const v4i16_t lo = __builtin_amdgcn_ds_read_tr16_b64_v4i16((LDSP v4i16_t*)(vb + off));
    const v4i16_t hh = __builtin_amdgcn_ds_read_tr16_b64_v4i16((LDSP v4i16_t*)(vb + off + 512));
    return (bf16x8){lo[0], lo[1], lo[2], lo[3], hh[0], hh[1], hh[2], hh[3]};
}
template <bool MASK>
__device__ __forceinline__ void attn_pair_fast(ASt& st, const bf16x8 (&qf)[4], LDSP const unsigned char* ka, LDSP const unsigned char* kb, int lane, const TP& ta, const TP& tb) {
    const int r32 = lane & 31, hi = lane >> 5; const bool offa = ta.rowoff, offb = tb.rowoff;
    const int kla = ta.kl - 4 * hi, kha = ta.kh - 4 * hi, klb = tb.kl - 4 * hi, khb = tb.kh - 4 * hi;
    LDSP const unsigned char* vba = ka + 8192 + ((lane >> 4) & 1) * 32 + (lane & 3) * 8 + (4 * hi + ((lane & 15) >> 2)) * 64;
    LDSP const unsigned char* vbb = vba + (kb - ka);
    f32x16 a0, a1, b0, b1; u32x4 pwa[4], pwb[4];
    bf16x8 kfa[8], kfb[8], vfa[8], vfb[8];
    pair_kload(kfa, ka, r32, hi);
    { f32x16 c16; const float cina = offa ? -INFINITY : -st.m;
#pragma unroll
      for (int r = 0; r < 16; ++r) c16[r] = cina;
      asm volatile("s_waitcnt lgkmcnt(0)" ::: "memory"); PAIR_SB();
#define QKA_STEP(I) do { if ((I) & 1) a1 = __builtin_amdgcn_mfma_f32_32x32x16_bf16(kfa[I], qf[(I) >> 1], (I) == 1 ? c16 : a1, 0, 0, 0); \
                         else         a0 = __builtin_amdgcn_mfma_f32_32x32x16_bf16(kfa[I], qf[(I) >> 1], (I) == 0 ? c16 : a0, 0, 0, 0); \
                         kfb[I] = *(const LDSP bf16x8*)(kb + swz_off(r32 + 32 * ((I) & 1), 2 * ((I) >> 1) + hi)); PAIR_SB(); } while (0)
      QKA_STEP(0); QKA_STEP(1); QKA_STEP(2); QKA_STEP(3); QKA_STEP(4); QKA_STEP(5); QKA_STEP(6); QKA_STEP(7);
#undef QKA_STEP
    }
    float sa = 0.f, sbm = 0.f;
    { f32x16 c16; const float cinb = offb ? -INFINITY : -st.m;
#pragma unroll
      for (int r = 0; r < 16; ++r) c16[r] = cinb;
      asm volatile("s_waitcnt lgkmcnt(0)" ::: "memory"); PAIR_SB();
#define QKB_STEP(I) do { if ((I) & 1) b1 = __builtin_amdgcn_mfma_f32_32x32x16_bf16(kfb[I], qf[(I) >> 1], (I) == 1 ? c16 : b1, 0, 0, 0); \
                         else         b0 = __builtin_amdgcn_mfma_f32_32x32x16_bf16(kfb[I], qf[(I) >> 1], (I) == 0 ? c16 : b0, 0, 0, 0); \
                         if ((I) >= 4) vfa[(I) - 4] = vfrag_load(vba, (I) - 4); \
                         pair_exp_chunk<I, MASK>(a0, a1, pwa, sa, kla, kha); PAIR_SB(); } while (0)
      QKB_STEP(0); QKB_STEP(1); QKB_STEP(2); QKB_STEP(3); QKB_STEP(4); QKB_STEP(5); QKB_STEP(6); QKB_STEP(7);
#undef QKB_STEP
    }
    asm volatile("s_waitcnt lgkmcnt(0)" ::: "memory"); PAIR_SB();
#define PVA_STEP(I) do { if ((I) & 1) st.o1 = __builtin_amdgcn_mfma_f32_32x32x16_bf16(vfa[I], __builtin_bit_cast(bf16x8, pwa[(I) >> 1]), st.o1, 0, 0, 0); \
                         else         st.o0 = __builtin_amdgcn_mfma_f32_32x32x16_bf16(vfa[I], __builtin_bit_cast(bf16x8, pwa[(I) >> 1]), st.o0, 0, 0, 0); \
                         if ((I) < 4) vfa[(I) + 4] = vfrag_load(vba, (I) + 4); else vfb[(I) - 4] = vfrag_load(vbb, (I) - 4); \
                         pair_exp_chunk<I, MASK>(b0, b1, pwb, sbm, klb, khb); PAIR_SB(); \
                         if ((I) == 3) { asm volatile("s_waitcnt lgkmcnt(0)" ::: "memory"); PAIR_SB(); } } while (0)
    PVA_STEP(0); PVA_STEP(1); PVA_STEP(2); PVA_STEP(3); PVA_STEP(4); PVA_STEP(5); PVA_STEP(6); PVA_STEP(7);
#undef PVA_STEP
    st.l += sa + sbm;
    asm volatile("s_waitcnt lgkmcnt(0)" ::: "memory"); PAIR_SB();
#define PVB_STEP(I) do { if ((I) & 1) st.o1 = __builtin_amdgcn_mfma_f32_32x32x16_bf16(vfb[I], __builtin_bit_cast(bf16x8, pwb[(I) >> 1]), st.o1, 0, 0, 0); \
                         else         st.o0 = __builtin_amdgcn_mfma_f32_32x32x16_bf16(vfb[I], __builtin_bit_cast(bf16x8, pwb[(I) >> 1]), st.o0, 0, 0, 0); \
                         if ((I) < 4) vfb[(I) + 4] = vfrag_load(vbb, (I) + 4); PAIR_SB(); \
                         if ((I) == 3) { asm volatile("s_waitcnt lgkmcnt(0)" ::: "memory"); PAIR_SB(); } } while (0)
    PVB_STEP(0); PVB_STEP(1); PVB_STEP(2); PVB_STEP(3); PVB_STEP(4); PVB_STEP(5); PVB_STEP(6); PVB_STEP(7);
#undef PVB_STEP
    const float lpair = fmaxf(st.l, swap32f(st.l));
    if (__any(lpair > 1.0e18f)) {
        const float dl = (lpair > 1.0e18f) ? 64.f : 0.f, alpha = __builtin_amdgcn_exp2f(-dl);
        st.m += dl; st.l *= alpha;
#pragma unroll
        for (int r = 0; r < 16; ++r) { st.o0[r] *= alpha; st.o1[r] *= alpha; }
    }
}

#define KV_LOOP_PAIR(NT, KPTR, VDELTA, PITCH, TPF) do { const int nt_ = (NT), np_ = (nt_ + 1) >> 1; const int wu_ = __builtin_amdgcn_readfirstlane(wid); __syncthreads(); \
    { const int i = 0; kv_dma((KPTR), (KPTR) + (VDELTA), (PITCH), lds, wu_, lane); } { const int i = (nt_ > 1) ? 1 : 0; kv_dma((KPTR), (KPTR) + (VDELTA), (PITCH), lds + 16384, wu_, lane); } \
    asm volatile("s_waitcnt vmcnt(0)" ::: "memory"); __syncthreads(); \
    _Pragma("unroll 1") for (int ip_ = 0; ip_ < np_; ++ip_) { LDSP unsigned char* cur0_ = lds + (ip_ & 1) * 32768; LDSP unsigned char* nxt0_ = lds + ((ip_ + 1) & 1) * 32768; \
        if (ip_ + 1 < np_) { { const int i = 2 * ip_ + 2; kv_dma((KPTR), (KPTR) + (VDELTA), (PITCH), nxt0_, wu_, lane); } \
                             { const int i = (2 * ip_ + 3 < nt_) ? 2 * ip_ + 3 : 2 * ip_ + 2; kv_dma((KPTR), (KPTR) + (VDELTA), (PITCH), nxt0_ + 16384, wu_, lane); } } \
        if (2 * ip_ + 1 < nt_) { const TP ta_ = TPF(2 * ip_), tb_ = TPF(2 * ip_ + 1); \
            if (ta_.nm || tb_.nm) attn_pair_fast<true>(st, qf, cur0_, cur0_ + 16384, lane, ta_, tb_); else attn_pair_fast<false>(st, qf, cur0_, cur0_ + 16384, lane, ta_, tb_); } \
        else { const TP ta_ = TPF(2 * ip_); attn_tile<0>(st, qf, cur0_, lane, ta_.rowoff, ta_.kl, ta_.kh, ta_.nm, 0.f, nullptr, nullptr, 0, 0); } \
        asm volatile("s_waitcnt vmcnt(0)" ::: "memory"); \
        __syncthreads(); } } while (0)

__device__ __forceinline__ void store_ot(bf16_t* dst, const f32x16& o0, const f32x16& o1, int hi) {
#pragma unroll
    for (int qd = 0; qd < 4; ++qd) {
        u32x2 w0, w1;
        w0.x = pk2(o0[4 * qd], o0[4 * qd + 1]); w0.y = pk2(o0[4 * qd + 2], o0[4 * qd + 3]);
        w1.x = pk2(o1[4 * qd], o1[4 * qd + 1]); w1.y = pk2(o1[4 * qd + 2], o1[4 * qd + 3]);
        *(u32x2*)(dst + 8 * qd + 4 * hi) = w0; *(u32x2*)(dst + 32 + 8 * qd + 4 * hi) = w1;
    }
}

__device__ __forceinline__ void moba_unit(const Params& P, LDSP unsigned char* lds, int b, int h, int blk) {
    unsigned char* ws = P.ws;
    const int tid = opaque_tid(), lane = tid & 63, wid = tid >> 6, r32 = lane & 31, hi = lane >> 5;
    const bf16_t* qa = (const bf16_t*)(ws + OFF_R1);
    const bf16_t* ka = (const bf16_t*)(ws + OFF_R1 + 32 * MiB);
    const bf16_t* va = (const bf16_t*)(ws + OFF_R1 + 64 * MiB);
    bf16_t* ya = (bf16_t*)(ws + OFF_R0);
    const float* kmean = (const float*)(ws + OFF_KMEAN) + (size_t)((b * 8 + h) * 16) * 64;
    LDSP float* km = (LDSP float*)(lds + A_MISC);
    LDSP unsigned short* sel16 = (LDSP unsigned short*)(lds + A_MISC + 4096);
    __syncthreads();
    for (int i = tid; i < blk * 64; i += NTHREADS) km[i] = kmean[i];
    __syncthreads();
    {
        const int qi = tid >> 1, hf = tid & 1;
        const bf16_t* qrow = qa + (size_t)(b * SEQ + blk * 256 + qi) * 512 + h * 64 + hf * 32;
        float q[32];
#pragma unroll
        for (int c = 0; c < 4; ++c) { float f[8]; cvt8(*(const u32x4*)(qrow + c * 8), f);
#pragma unroll
            for (int i = 0; i < 8; ++i) q[c * 8 + i] = f[i]; }
        float g0 = -INFINITY, g1 = -INFINITY, g2 = -INFINITY; int i0 = -1, i1 = -1, i2 = -1;
        for (int j = 0; j < blk; ++j) {
            float d = 0.f;
#pragma unroll
            for (int i = 0; i < 32; ++i) d += q[i] * km[j * 64 + hf * 32 + i];
            d += __shfl_xor(d, 1);
            if (d > g0) { g2 = g1; i2 = i1; g1 = g0; i1 = i0; g0 = d; i0 = j; }
            else if (d > g1) { g2 = g1; i2 = i1; g1 = d; i1 = j; }
            else if (d > g2) { g2 = d; i2 = j; }
        }
        unsigned mask = 0;
        if (i0 >= 0) mask |= 1u << i0;
        if (i1 >= 0) mask |= 1u << i1;
        if (i2 >= 0) mask |= 1u << i2;
        if (hf == 0) sel16[qi] = (unsigned short)mask;
    }
    __syncthreads();
    const int qloc = wid * 32 + r32;
    const size_t qrow_g = (size_t)(b * SEQ + blk * 256 + qloc);
    bf16x8 qf[4];
#pragma unroll
    for (int d0 = 0; d0 < 4; ++d0) qf[d0] = *(const bf16x8*)(qa + qrow_g * 512 + h * 64 + d0 * 16 + hi * 8);
    const unsigned selbits = sel16[qloc];
    ASt st; ast_reset(st);
    const bf16_t* kbase = ka + (size_t)(b * SEQ) * 512 + h * 64;
    const bf16_t* vbase = va + (size_t)(b * SEQ) * 512 + h * 64;
    auto moba_tp = [=](int ti) -> TP { const int jb = ti >> 2, t4 = ti & 3; const bool past = jb < blk;
        int l_ = lane; asm volatile("" : "+v"(l_)); const int w_ = __builtin_amdgcn_readfirstlane(wid), ql_ = w_ * 32 + (l_ & 31);
        TP t; t.rowoff = past ? !((selbits >> jb) & 1u) : (64 * t4 > ql_); t.nm = !past && (64 * t4 + 63 > w_ * 32); t.kl = 0; t.kh = past ? 63 : ql_ - 64 * t4; return t; };
    KV_LOOP_PAIR(4 * (blk + 1), kbase + (size_t)i * 64 * 512, (size_t)16 * 1024 * 1024, 512, moba_tp);
    const float lt = st.l + swap32f(st.l);
    const float inv = 1.0f / lt;
#pragma unroll
    for (int r = 0; r < 16; ++r) { st.o0[r] *= inv; st.o1[r] *= inv; }
    { const int t2 = opaque_tid(), l2 = t2 & 63;
      const size_t row2 = (size_t)(b * SEQ + blk * 256 + (t2 >> 6) * 32 + (l2 & 31));
      store_ot((bf16_t*)(P.ws + OFF_R0) + row2 * 512 + h * 64, st.o0, st.o1, l2 >> 5); }
}

__device__ __forceinline__ void nsa_unit(const Params& P, LDSP unsigned char* lds, int b, int g, int c) {
    unsigned char* ws = P.ws;
    const int tid = opaque_tid(), lane = tid & 63, wid = tid >> 6, r32 = lane & 31, hi = lane >> 5;
    const bf16_t* qb = (const bf16_t*)(ws + OFF_R1 + 96 * MiB);
    const bf16_t* kc = (const bf16_t*)(ws + OFF_KC) + (size_t)(b * 2 + g) * 256 * 64;
    const bf16_t* vc = (const bf16_t*)(ws + OFF_VC) + (size_t)(b * 2 + g) * 256 * 64;
    const bf16_t* ks = (const bf16_t*)(ws + OFF_R2 + 16 * MiB) + (size_t)(b * SEQ) * 128 + g * 64;
    const bf16_t* vs = (const bf16_t*)(ws + OFF_R2 + 24 * MiB) + (size_t)(b * SEQ) * 128 + g * 64;
    const bf16_t* kw = (const bf16_t*)(ws + OFF_R2 + 32 * MiB) + (size_t)(b * SEQ) * 128 + g * 64;
    const bf16_t* vw = (const bf16_t*)(ws + OFF_R2 + 40 * MiB) + (size_t)(b * SEQ) * 128 + g * 64;
    const float* bgate = (const float*)(ws + OFF_BGATE);
    bf16_t* yb = (bf16_t*)(ws + OFF_R0 + 32 * MiB);
    LDSP float* gs = (LDSP float*)(lds + A_GS);
    LDSP float* es = (LDSP float*)(lds + A_ES);
    LDSP unsigned long long* selm = (LDSP unsigned long long*)(lds + A_MISC);
    const int ql = wid * 8 + (r32 >> 2), hr = r32 & 3, head = g * 4 + hr, pos = c * 64 + ql;
    const size_t trow = (size_t)(b * SEQ + pos);
    bf16x8 qf[4];
#pragma unroll
    for (int d0 = 0; d0 < 4; ++d0) qf[d0] = *(const bf16x8*)(qb + trow * 512 + head * 64 + d0 * 16 + hi * 8);
    const int nmax = (pos >= 31) ? ((pos - 31) >> 4) : -1;
    const int ntc = ((4 * c + 2) >> 6) + 1;
    ASt st; ast_reset(st);
    __syncthreads();
    {
        const int wu_ = __builtin_amdgcn_readfirstlane(wid);
#pragma unroll 1
        for (int i = 0; i < ntc; ++i) kv_dma(kc + (size_t)i * 64 * 64, vc + (size_t)i * 64 * 64, 64, lds + i * 16384, wu_, lane);
        asm volatile("s_waitcnt vmcnt(0)" ::: "memory");
        __syncthreads();
    }
#pragma unroll 1
    for (int i = 0; i < ntc; ++i) attn_tile<1>(st, qf, lds + i * 16384, lane, nmax < 0, 0, nmax - 64 * i, true, 0.f, nullptr, nullptr, 0, 0);
    {
        const float lt = st.l + swap32f(st.l);
        const float linv = (lt > 0.f) ? 1.0f / lt : 0.f;
#pragma unroll 1
        for (int i = 0; i < ntc; ++i) attn_tile<2>(st, qf, lds + i * 16384, lane, nmax < 0, 0, nmax - 64 * i, true, linv, gs, es, 16 * i, ql);
    }
    LDSP float* yl = (LDSP float*)(lds + A_Y) + wid * 2048 + lane;
    __syncthreads();
    for (int qq = 0; qq < 8; ++qq) {
        const int q = wid * 8 + qq, j = lane;
        unsigned long long m;
        if (c < 16) m = (2ull << c) - 1ull;
        else {
            const bool cand = (j >= 1 && j <= c - 2);
            float imp = 0.f;
            if (cand) imp = gs[q * 64 + j] + es[q * 64 + j - 1];
            int rank = 0;
            for (int jp = 1; jp <= c - 2; ++jp) {
                const float o = __uint_as_float(__builtin_amdgcn_readlane(__float_as_uint(imp), jp));
                rank += (o > imp || (o == imp && jp < j)) ? 1 : 0;
            }
            const bool sel = (j == 0) || (j == c) || (j == c - 1) || (cand && rank < 13);
            m = __ballot(sel);
        }
        if (lane == 0) selm[q] = m;
    }
    __syncthreads();
    { const int t2 = opaque_tid(), l2 = t2 & 63; const size_t trow2 = (size_t)(b * SEQ + c * 64 + (t2 >> 6) * 8 + ((l2 & 31) >> 2)); const int head2 = g * 4 + (l2 & 3);
      const float gt0 = ((const float*)(P.ws + OFF_BGATE))[trow2 * 24 + head2 * 3 + 0];
#pragma unroll
    for (int r = 0; r < 16; ++r) { yl[r * 64] = gt0 * st.o0[r]; yl[(16 + r) * 64] = gt0 * st.o1[r]; } }
    const unsigned long long selmask = selm[ql];
    ast_reset(st);
    auto slc_tp = [=](int ti) -> TP { int l_ = lane; asm volatile("" : "+v"(l_)); const int ql_ = __builtin_amdgcn_readfirstlane(wid) * 8 + ((l_ & 31) >> 2);
        TP t; t.rowoff = !((selmask >> ti) & 1ull); t.nm = (ti == c); t.kl = 0; t.kh = (ti == c) ? ql_ : 63; return t; };
    KV_LOOP_PAIR(c + 1, ks + (size_t)i * 64 * 128, (size_t)4 * 1024 * 1024, 128, slc_tp);
    {
        const float lt = st.l + swap32f(st.l);
        const int t2 = opaque_tid(), l2 = t2 & 63; const size_t trow2 = (size_t)(b * SEQ + c * 64 + (t2 >> 6) * 8 + ((l2 & 31) >> 2)); const int head2 = g * 4 + (l2 & 3);
        LDSP float* yl = (LDSP float*)(lds + A_Y) + (t2 >> 6) * 2048 + l2;
        const float sc = ((const float*)(P.ws + OFF_BGATE))[trow2 * 24 + head2 * 3 + 1] / lt;
#pragma unroll
        for (int r = 0; r < 16; ++r) { yl[r * 64] += sc * st.o0[r]; yl[(16 + r) * 64] += sc * st.o1[r]; }
    }
    ast_reset(st);
    const int j0 = (c >= 8) ? c - 8 : 0;
    auto win_tp = [=](int ti) -> TP { const int j = j0 + ti; const bool first = (j == c - 8), own = (j == c);
        int l_ = lane; asm volatile("" : "+v"(l_)); const int ql_ = __builtin_amdgcn_readfirstlane(wid) * 8 + ((l_ & 31) >> 2);
        TP t; t.rowoff = false; t.nm = first || own; t.kl = first ? ql_ + 1 : 0; t.kh = own ? ql_ : 63; return t; };
    KV_LOOP_PAIR(c - j0 + 1, kw + (size_t)(j0 + i) * 64 * 128, (size_t)4 * 1024 * 1024, 128, win_tp);
    {
        const float lt = st.l + swap32f(st.l);
        const int t2 = opaque_tid(), l2 = t2 & 63; const size_t trow2 = (size_t)(b * SEQ + c * 64 + (t2 >> 6) * 8 + ((l2 & 31) >> 2)); const int head2 = g * 4 + (l2 & 3);
        LDSP float* yl = (LDSP float*)(lds + A_Y) + (t2 >> 6) * 2048 + l2;
        const float sc = ((const float*)(P.ws + OFF_BGATE))[trow2 * 24 + head2 * 3 + 2] / lt;
        f32x16 y0, y1;
#pragma unroll
        for (int r = 0; r < 16; ++r) { y0[r] = yl[r * 64] + sc * st.o0[r]; y1[r] = yl[(16 + r) * 64] + sc * st.o1[r]; }
        store_ot((bf16_t*)(P.ws + OFF_R0 + 32 * MiB) + trow2 * 512 + head2 * 64, y0, y1, l2 >> 5);
    }
}

__device__ __forceinline__ void phase_attn(const Params& P, LDSP unsigned char* lds, int vcu, int G) {
    const int nloc = (G == 256) ? 8 : (2048 - vcu + G - 1) / G;
    for (int k = 0; k < nloc; ++k) {
        int u;
        if (G == 256) {
            const int kk = k >> 1;
            if (!(k & 1)) { const int bh = vcu >> 2, jm = vcu & 3; const int blk = (kk == 0) ? 15 - jm : (kk == 1) ? 8 + jm : (kk == 2) ? 7 - jm : jm; u = bh * 16 + blk; }
            else { const int bg = vcu >> 4, jn = vcu & 15; const int c = (kk == 0) ? 63 - jn : (kk == 1) ? 32 + jn : (kk == 2) ? 31 - jn : jn; u = 1024 + bg * 64 + c; }
        } else u = vcu + k * G;
        if (u < 1024) moba_unit(P, lds, u >> 7, (u >> 4) & 7, u & 15);
        else { const int v = u - 1024; nsa_unit(P, lds, v >> 7, (v >> 6) & 1, v & 63); }
    }
}

struct EpiUp {
    const Params* P;
    __device__ __forceinline__ void operator()(f32x4 (&acc)[2][2][4][2], const pg8::Unit& u, int wr, int wc, int fr, int fq) const {
        bf16_t* g = (bf16_t*)(P->ws + OFF_R3);
#pragma unroll
        for (int ai = 0; ai < 2; ++ai)
#pragma unroll
            for (int m = 0; m < 4; ++m) {
                const int row = u.pm * 256 + ai * 128 + wr * 64 + m * 16 + fr;
#pragma unroll
                for (int bj = 0; bj < 2; ++bj) {
                    bf16_t* rp = g + (size_t)row * 2048 + u.pn * 256 + bj * 128 + wc * 32 + 8 * fq;
                    const u32x4 gg = *(const u32x4*)(rp + (u.z ? 1024 : 0));
                    float gf[8]; cvt8(gg, gf);
                    float o[8];
#pragma unroll
                    for (int n = 0; n < 2; ++n)
#pragma unroll
                        for (int i = 0; i < 4; ++i) o[4 * n + i] = gf[4 * n + i] * acc[ai][bj][m][n][i];
                    if (u.z) { float pf[8]; cvt8(*(const u32x4*)rp, pf);
#pragma unroll
                        for (int i = 0; i < 8; ++i) o[i] += pf[i]; }
                    u32x4 w; w.x = pk2(o[0], o[1]); w.y = pk2(o[2], o[3]); w.z = pk2(o[4], o[5]); w.w = pk2(o[6], o[7]);
                    *(u32x4*)rp = w;
                }
            }
    }
};
__device__ __forceinline__ void phase_up(const Params& P, LDSP unsigned char* lds, int vcu, int G) {
    pg8::Sched S; S.A0 = (const bf16_t*)(P.ws + OFF_R0); S.A1 = (const bf16_t*)(P.ws + OFF_R0 + 32 * MiB);
    S.B0 = (const bf16_t*)(P.ws + OFF_WUPA_T); S.B1 = (const bf16_t*)(P.ws + OFF_WUPB_T);
    S.lda = 512; S.ldb = 512; S.K = 512; S.nM = T / 256; S.nN = DM / 256; S.NZ = 2; S.G = G; S.c = blockIdx.x;
    EpiUp E{&P};
    pg8::gemm_phase(lds, S, E);
}

struct EpiOut {
    const Params* P;
    __device__ __forceinline__ void operator()(f32x4 (&acc)[2][2][4][2], const pg8::Unit& u, int wr, int wc, int fr, int fq) const {
        bf16_t* x1b = (bf16_t*)(P->ws + OFF_R0);
        float* rs2 = (float*)(P->ws + OFF_RS2);
        const float* x = P->in[I_X];
#pragma unroll
        for (int ai = 0; ai < 2; ++ai)
#pragma unroll
            for (int m = 0; m < 4; ++m) {
                const int row = u.pm * 256 + ai * 128 + wr * 64 + m * 16 + fr;
                float ss = 0.f;
                f32x4 xv[2][2];
#pragma unroll
                for (int bj = 0; bj < 2; ++bj)
#pragma unroll
                    for (int n = 0; n < 2; ++n) xv[bj][n] = *(const f32x4*)(x + (size_t)row * DM + u.pn * 256 + bj * 128 + wc * 32 + 8 * fq + 4 * n);
#pragma unroll
                for (int bj = 0; bj < 2; ++bj) {
                    const size_t off = (size_t)row * DM + u.pn * 256 + bj * 128 + wc * 32 + 8 * fq;
                    const f32x4 o0 = xv[bj][0] + acc[ai][bj][m][0], o1 = xv[bj][1] + acc[ai][bj][m][1];
                    u32x4 w; w.x = pk2(o0.x, o0.y); w.y = pk2(o0.z, o0.w); w.z = pk2(o1.x, o1.y); w.w = pk2(o1.z, o1.w);
                    *(u32x4*)(x1b + off) = w;
                    ss += ((o0.x * o0.x + o0.y * o0.y) + (o0.z * o0.z + o0.w * o0.w)) + ((o1.x * o1.x + o1.y * o1.y) + (o1.z * o1.z + o1.w * o1.w));
                }
                ss = sum_xor16(ss); ss = sum_xor32(ss);
                if (fq == 0) atomicAdd(rs2 + row, ss);
            }
    }
};
__device__ __forceinline__ void phase_out(const Params& P, LDSP unsigned char* lds, int vcu, int G) {
    pg8::Sched S; S.A0 = S.A1 = (const bf16_t*)(P.ws + OFF_R3); S.B0 = S.B1 = (const bf16_t*)(P.ws + OFF_WOUT_T);
    S.lda = 2048; S.ldb = DM; S.K = DM; S.nM = T / 256; S.nN = DM / 256; S.NZ = 1; S.G = G; S.c = blockIdx.x;
    EpiOut E{&P};
    pg8::gemm_phase(lds, S, E);
}

struct EpiPq {
    const Params* P;
    __device__ __forceinline__ void operator()(f32x4 (&acc)[2][2][4][2], const pg8::Unit& u, int wr, int wc, int fr, int fq) const {
        bf16_t* qp = (bf16_t*)(P->ws + OFF_R1);
        const float* rs2 = (const float*)(P->ws + OFF_RS2);
        float rr[2][4];
#pragma unroll
        for (int ai = 0; ai < 2; ++ai)
#pragma unroll
            for (int m = 0; m < 4; ++m) rr[ai][m] = __builtin_amdgcn_rsqf(rs2[u.pm * 256 + ai * 128 + wr * 64 + m * 16 + fr] * (1.0f / DM) + NORM_EPS);
#pragma unroll
        for (int ai = 0; ai < 2; ++ai)
#pragma unroll
            for (int m = 0; m < 4; ++m) {
                const int row = u.pm * 256 + ai * 128 + wr * 64 + m * 16 + fr;
                const float r = rr[ai][m];
#pragma unroll
                for (int bj = 0; bj < 2; ++bj) {
                    const f32x4 a0 = acc[ai][bj][m][0], a1 = acc[ai][bj][m][1];
                    u32x4 w; w.x = pk2(a0[0] * r, a0[1] * r); w.y = pk2(a0[2] * r, a0[3] * r); w.z = pk2(a1[0] * r, a1[1] * r); w.w = pk2(a1[2] * r, a1[3] * r);
                    *(u32x4*)(qp + (size_t)row * 2048 + u.pn * 256 + bj * 128 + wc * 32 + 8 * fq) = w;
                }
            }
    }
};
__device__ __forceinline__ void phase_pq(const Params& P, LDSP unsigned char* lds, int vcu, int G) {
    pg8::Sched S; S.A0 = S.A1 = (const bf16_t*)(P.ws + OFF_R0); S.B0 = S.B1 = (const bf16_t*)(P.ws + OFF_WPQ_T);
    S.lda = DM; S.ldb = DM; S.K = DM; S.nM = T / 256; S.nN = 2048 / 256; S.NZ = 1; S.G = G; S.c = blockIdx.x;
    EpiPq E{&P};
    pg8::gemm_phase(lds, S, E);
}

__device__ __forceinline__ unsigned f2ord(float f) { const unsigned u = __float_as_uint(f); return u ^ ((unsigned)((int)u >> 31) | 0x80000000u); }
__device__ __forceinline__ float ord2f(unsigned o) { const unsigned u = (o & 0x80000000u) ? (o ^ 0x80000000u) : ~o; return __uint_as_float(u); }
__device__ __forceinline__ void ins16(unsigned (&top)[16], unsigned x) {
#pragma unroll
    for (int j = 0; j < 16; ++j) { const unsigned t = max(x, top[j]); x = min(x, top[j]); top[j] = t; }
}
__device__ __forceinline__ int crow(int r, int hi) { return (r & 3) + 8 * (r >> 2) + 4 * hi; }
__device__ __forceinline__ void ce_desc(unsigned& a, unsigned& b) { const unsigned hi_ = max(a, b), lo_ = min(a, b); a = hi_; b = lo_; }
__device__ __forceinline__ void bitonic_merge16_desc(unsigned (&a)[16]) {
#pragma unroll
    for (int j = 8; j > 0; j >>= 1)
#pragma unroll
        for (int i = 0; i < 16; ++i) { const int l = i ^ j; if (l > i) ce_desc(a[i], a[l]); }
}
__device__ __forceinline__ void sort16_desc(unsigned (&a)[16]) {
#pragma unroll
    for (int k = 2; k <= 16; k <<= 1)
#pragma unroll
        for (int j = k >> 1; j > 0; j >>= 1)
#pragma unroll
            for (int i = 0; i < 16; ++i) { const int l = i ^ j; if (l > i) { if ((i & k) == 0) ce_desc(a[i], a[l]); else ce_desc(a[l], a[i]); } }
}
__device__ __forceinline__ void merge_top16(unsigned (&top)[16], const unsigned (&blk)[16]) {
#pragma unroll
    for (int i = 0; i < 16; ++i) top[i] = max(top[i], blk[15 - i]);
    bitonic_merge16_desc(top);
}
constexpr int cand_prefix(int i) { int n = 0; for (int a = 0; a < i; ++a) n += 16 / (a + 1); return n; }

constexpr int P8_KOFF = 0, P8_IDX = 65536;
__device__ __forceinline__ void phase_topk(const Params& P, LDSP unsigned char* lds, int vcu, int G) {
    unsigned char* ws = P.ws;
    const bf16_t* qp = (const bf16_t*)(ws + OFF_R1);
    int* experts = (int*)(ws + OFF_EXPERTS);
    float* gates = (float*)(ws + OFF_GATES);
    const int tid = opaque_tid(), lane = tid & 63, wave = tid >> 6, r32 = lane & 31, hi = lane >> 5;
    __syncthreads();
    for (int i = tid; i < 2 * 128 * 16; i += NTHREADS) {
        const int w = i >> 11, row = (i >> 4) & 127, ch = i & 15;
        const u32x4 v = *(const u32x4*)((const bf16_t*)(ws + (w ? OFF_K2B : OFF_K1B)) + row * 128 + ch * 8);
        *(LDSP u32x4*)(lds + P8_KOFF + w * 32768 + row * 256 + ((ch ^ (row & 15)) << 4)) = v;
    }
    __syncthreads();
    LDSP unsigned char* myidx = lds + P8_IDX + (wave * 64 + lane) * 32;
    const int gw = vcu * NWAVES + wave, NGW = G * NWAVES;
    for (int item = gw; item < (T / 32) * 8; item += NGW) {
        const int tg = item >> 3, h = item & 7;
        const int tok = tg * 32 + r32;
        unsigned tops[2][16];
#pragma unroll
        for (int L = 0; L < 2; ++L) {
            bf16x8 qf[8];
            const bf16_t* qrow = qp + (size_t)tok * 2048 + h * 256 + L * 128 + hi * 8;
#pragma unroll
            for (int s8 = 0; s8 < 8; ++s8) qf[s8] = *(const bf16x8*)(qrow + s8 * 16);
            unsigned top[16];
#pragma unroll
            for (int kb = 0; kb < 4; ++kb) {
                f32x16 acc = {0.f, 0.f, 0.f, 0.f, 0.f, 0.f, 0.f, 0.f, 0.f, 0.f, 0.f, 0.f, 0.f, 0.f, 0.f, 0.f};
                const int row = kb * 32 + r32;
#pragma unroll
                for (int s8 = 0; s8 < 8; ++s8) {
                    const bf16x8 kf = *(const LDSP bf16x8*)(lds + P8_KOFF + L * 32768 + row * 256 + (((2 * s8 + hi) ^ (row & 15)) << 4));
                    acc = __builtin_amdgcn_mfma_f32_32x32x16_bf16(kf, qf[s8], acc, 0, 0, 0);
                }
                unsigned blk[16];
#pragma unroll
                for (int r = 0; r < 16; ++r) {
                    const int key = kb * 32 + (r & 3) + 8 * (r >> 2) + 4 * hi;
                    blk[r] = (f2ord(acc[r]) & ~0x7Fu) | (unsigned)(127 - key);
                }
                sort16_desc(blk);
                if (kb == 0) {
#pragma unroll
                    for (int j = 0; j < 16; ++j) top[j] = blk[j];
                } else merge_top16(top, blk);
            }
            unsigned oth[16];
#pragma unroll
            for (int j = 0; j < 16; ++j) oth[j] = (unsigned)__shfl_xor((int)top[j], 32);
            merge_top16(top, oth);
#pragma unroll
            for (int j = 0; j < 16; ++j) tops[L][j] = top[j];
        }
        float v1[16], v2[16];
#pragma unroll
        for (int j = 0; j < 16; j += 4) {
            unsigned w1 = 0, w2 = 0;
#pragma unroll
            for (int q = 0; q < 4; ++q) { w1 |= (127u - (tops[0][j + q] & 127u)) << (8 * q); w2 |= (127u - (tops[1][j + q] & 127u)) << (8 * q); }
            *(LDSP unsigned*)(myidx + j) = w1; *(LDSP unsigned*)(myidx + 16 + j) = w2;
        }
#pragma unroll
        for (int j = 0; j < 16; ++j) { v1[j] = ord2f(tops[0][j] & ~0x7Fu); v2[j] = ord2f(tops[1][j] & ~0x7Fu); }
        unsigned ct[16];
        {
            unsigned cand[64];
#pragma unroll
            for (int n = 0; n < 64; ++n) cand[n] = 0u;
#pragma unroll
            for (int i = 0; i < 16; ++i)
#pragma unroll
                for (int j = 0; j < 16; ++j)
                    if ((i + 1) * (j + 1) <= 16) cand[cand_prefix(i) + j] = (f2ord(v1[i] + v2[j]) & ~0xFFu) | (unsigned)(255 - (i * 16 + j));
#pragma unroll
            for (int bk = 0; bk < 4; ++bk) {
                unsigned blk[16];
#pragma unroll
                for (int r = 0; r < 16; ++r) blk[r] = cand[bk * 16 + r];
                sort16_desc(blk);
                if (bk == 0) {
#pragma unroll
                    for (int j = 0; j < 16; ++j) ct[j] = blk[j];
                } else merge_top16(ct, blk);
            }
        }
        float vals[16], ssum = 0.f;
        const float vmax = ord2f(ct[0] & ~0xFFu);
#pragma unroll
        for (int k = 0; k < 16; ++k) { vals[k] = __expf(ord2f(ct[k] & ~0xFFu) - vmax); ssum += vals[k]; }
        const float inv = 1.0f / ssum;
        asm volatile("s_waitcnt lgkmcnt(0)" ::: "memory");
        if (hi == 0) {
            int* ep = experts + (size_t)tok * 128 + h * 16;
            float* gp = gates + (size_t)tok * 128 + h * 16;
#pragma unroll
            for (int k = 0; k < 16; k += 4) {
                int e4[4];
#pragma unroll
                for (int q = 0; q < 4; ++q) {
                    const unsigned flat = 255u - (ct[k + q] & 255u);
                    const int i1 = myidx[flat >> 4], i2 = myidx[16 + (flat & 15)];
                    e4[q] = i1 * 128 + i2;
                }
                *(u32x4*)(ep + k) = (u32x4){(unsigned)e4[0], (unsigned)e4[1], (unsigned)e4[2], (unsigned)e4[3]};
                *(f32x4*)(gp + k) = (f32x4){vals[k] * inv, vals[k + 1] * inv, vals[k + 2] * inv, vals[k + 3] * inv};
            }
        }
        asm volatile("s_waitcnt lgkmcnt(0)" ::: "memory");
    }
}

__device__ __forceinline__ void peer_slice_map(const Params& P, LDSP unsigned char* lds, int vcu, int G, int wave, int& slice, int& half, int& wslot, int& nslot) {
    volatile LDSP unsigned* bst = (volatile LDSP unsigned*)(lds + LDS_BYTES - 16);
    LDSP unsigned* info = (LDSP unsigned*)(lds + LDS_BYTES - 64);
    __syncthreads();
    if (threadIdx.x == 0) {
        unsigned* bar = (unsigned*)(P.ws + 16384);
        const unsigned x = (unsigned)__builtin_amdgcn_s_getreg((3 << 11) | 20) & 0xFu;
        bool ok = true; unsigned sum = 0, mine = 0;
        for (unsigned j = 0; j < 16; ++j) { const unsigned c = __hip_atomic_load(&bar[256 + 64 * j], __ATOMIC_RELAXED, __HIP_MEMORY_SCOPE_AGENT); sum += c; if (j < 8 && c == 0) ok = false; if (j >= 8 && c != 0) ok = false; if (j == x) mine = c; }
        ok = ok && (sum == (unsigned)G) && (bst[2] < mine);
        info[0] = ok ? 1u : 0u; info[1] = x; info[2] = mine; info[3] = bst[2];
    }
    __syncthreads();
    if (info[0]) { slice = (int)(info[1] & 3u); half = (int)(info[1] >> 2); wslot = (int)info[3] * NWAVES + wave; nslot = (int)info[2] * NWAVES; }
    else if ((G & 7) == 0) { const int g8 = vcu / (G >> 3); slice = g8 & 3; half = g8 >> 2; wslot = (vcu % (G >> 3)) * NWAVES + wave; nslot = (G >> 3) * NWAVES; }
    else { slice = -1; half = 0; wslot = vcu * NWAVES + wave; nslot = G * NWAVES; }
}
struct PeerMetaA { int eA, eB; u32x4 h0, h1, h2, h3; float ss; };
struct PeerMetaB { int eA, eB; float aA, aB; };
#define PEER_IDX(m, j) __shfl(((j) < 8) ? (m).eA : (m).eB, (8 * (j) + grp) & 63)
__device__ __forceinline__ float dpp_xor1(float v) { return __builtin_bit_cast(float, __builtin_amdgcn_mov_dpp(__builtin_bit_cast(int, v), 0xB1, 0xF, 0xF, true)); }
__device__ __forceinline__ float dpp_xor2(float v) { return __builtin_bit_cast(float, __builtin_amdgcn_mov_dpp(__builtin_bit_cast(int, v), 0x4E, 0xF, 0xF, true)); }
__device__ __forceinline__ float dpp_hmirror(float v) { return __builtin_bit_cast(float, __builtin_amdgcn_mov_dpp(__builtin_bit_cast(int, v), 0x141, 0xF, 0xF, true)); }
__device__ __forceinline__ float dpp_ror8(float v) { return __builtin_bit_cast(float, __builtin_amdgcn_mov_dpp(__builtin_bit_cast(int, v), 0x128, 0xF, 0xF, true)); }
__device__ __forceinline__ float swap32_sum(float X, float Y) {
    const auto r = __builtin_amdgcn_permlane32_swap(__float_as_uint(X), __float_as_uint(Y), false, false);
    return __uint_as_float(r[0]) + __uint_as_float(r[1]);
}
__device__ __forceinline__ float swap16_sum(float X, float Y) {
    const auto r = __builtin_amdgcn_permlane16_swap(__float_as_uint(X), __float_as_uint(Y), false, false);
    return __uint_as_float(r[0]) + __uint_as_float(r[1]);
}
__device__ __forceinline__ void cvt32_fp4_pk(const u32x4 w, f32x2 (&f)[16]) {
#pragma unroll
    for (int q = 0; q < 4; ++q) {
        f[4 * q]     = __builtin_amdgcn_cvt_scalef32_pk_f32_fp4(w[q], 1.0f, 0); f[4 * q + 1] = __builtin_amdgcn_cvt_scalef32_pk_f32_fp4(w[q], 1.0f, 1);
        f[4 * q + 2] = __builtin_amdgcn_cvt_scalef32_pk_f32_fp4(w[q], 1.0f, 2); f[4 * q + 3] = __builtin_amdgcn_cvt_scalef32_pk_f32_fp4(w[q], 1.0f, 3);
    }
}
#define PA_T(it) ((slice >= 0) ? (2 * (it) + half) : ((it) >> 2))
#define PA_X(it) ((slice >= 0) ? slice : ((it) & 3))
__device__ __forceinline__ void phase_peer_a(const Params& P, LDSP unsigned char* lds, int vcu, int G) {
    unsigned char* ws = P.ws;
    const bf16_t* x1b = (const bf16_t*)(ws + OFF_R0);
    const float* rs2 = (const float*)(ws + OFF_RS2);
    const unsigned char* U4 = ws + OFF_U;
    const int* experts = (const int*)(ws + OFF_EXPERTS);
    float* apart = (float*)(ws + OFF_R1);
    const int tid = opaque_tid(), lane = tid & 63, wave = tid >> 6, grp = lane >> 3, sub = lane & 7;
    const bool b2 = lane & 4, b1 = lane & 2, b0 = lane & 1;
    int slice, half, wslot, nslot;
    peer_slice_map(P, lds, vcu, G, wave, slice, half, wslot, nslot);
    const int nitems = (slice >= 0) ? T / 2 : T * 4;
#define PA_META(m, it) do { const int it_ = ((it) < nitems) ? (it) : wslot; { const int t_ = PA_T(it_), x_ = PA_X(it_); \
        (m).eA = __builtin_nontemporal_load(experts + (size_t)t_ * 128 + lane); (m).eB = __builtin_nontemporal_load(experts + (size_t)t_ * 128 + 64 + lane); const u32x4* hp_ = (const u32x4*)(x1b + (size_t)t_ * DM + 256 * x_ + 32 * sub); \
        (m).h0 = __builtin_nontemporal_load(hp_); (m).h1 = __builtin_nontemporal_load(hp_ + 1); (m).h2 = __builtin_nontemporal_load(hp_ + 2); (m).h3 = __builtin_nontemporal_load(hp_ + 3); (m).ss = rs2[t_]; } } while (0)
#define PA_GATHER(R, m, it, J0) do { const int x_ = PA_X(it); _Pragma("unroll") for (int j = 0; j < 8; ++j) { const int e_ = PEER_IDX(m, (J0) + j); \
        (R)[j] = *(const u32x4*)(U4 + (((unsigned)x_ * (unsigned)PEER_NE + (unsigned)e_) * 128u + 16u * (unsigned)sub)); } } while (0)
#define PA_COMPUTE(R, J0) do { _Pragma("unroll") for (int j = 0; j < 8; ++j) { asm volatile("" : "+v"((R)[j])); int ah = 0, al = 0; \
        _Pragma("unroll") for (int q = 0; q < 4; ++q) { ah = __builtin_amdgcn_sdot8((int)(R)[j][q], (int)HQ[q], ah, false); al = __builtin_amdgcn_sdot8((int)(R)[j][q], (int)LQ[q], al, false); } \
        part[(J0) + j] = (float)(ah * 16 + al); asm volatile("" : "+v"(part[(J0) + j])); } } while (0)
    PeerMetaA m0, m1, m2;
    m0.eA = m0.eB = m1.eA = m1.eB = m2.eA = m2.eB = 0; m0.ss = m1.ss = m2.ss = 1.f;
    m0.h0 = m0.h1 = m0.h2 = m0.h3 = m1.h0 = m1.h1 = m1.h2 = m1.h3 = m2.h0 = m2.h1 = m2.h2 = m2.h3 = (u32x4){0u, 0u, 0u, 0u};
    u32x4 R0[8], R1[8];
    PA_META(m0, wslot); PA_META(m1, wslot + nslot);
    if (wslot >= nitems) return;
    PA_GATHER(R0, m0, wslot, 0); PA_GATHER(R1, m0, wslot, 8);
#pragma unroll 1
    for (int it = wslot; it < nitems; it += nslot) {
        PA_META(m2, it + 2 * nslot);
        unsigned HQ[4], LQ[4]; float part[16];
        { const float inv = (119.0f / 8.0f) * __builtin_amdgcn_rsqf(m0.ss * (1.0f / DM) + NORM_EPS); const f32x2 inv2 = {inv, inv}, magic2 = {12582920.0f, 12582920.0f};
          typedef short s16x2 __attribute__((ext_vector_type(2)));
          const s16x2 lo2 = {(short)-112, (short)-112}, hi2 = {(short)127, (short)127};
          constexpr unsigned M = 0x000F000Fu;
#define PA_H(Q, W) do { unsigned p_[4]; _Pragma("unroll") for (int w = 0; w < 4; ++w) { const unsigned wd = (W)[w]; const f32x2 f = {__uint_as_float(wd << 16), __uint_as_float(wd & 0xffff0000u)}; \
              const f32x2 t = __builtin_elementwise_fma(f, inv2, magic2);                                     \
              const unsigned pk_ = __builtin_amdgcn_perm(__float_as_uint(t.y), __float_as_uint(t.x), 0x05040100u); \
              p_[w] = __builtin_bit_cast(unsigned, __builtin_elementwise_min(__builtin_elementwise_max(__builtin_bit_cast(s16x2, pk_), lo2), hi2)); } \
          HQ[Q] = ((p_[0] >> 4) & M) | (p_[1] & (M << 4)) | ((p_[2] << 4) & (M << 8)) | ((p_[3] << 8) & (M << 12)); \
          LQ[Q] = ((p_[0] & M) | ((p_[1] << 4) & (M << 4)) | ((p_[2] << 8) & (M << 8)) | ((p_[3] << 12) & (M << 12))) ^ 0x88888888u; } while (0)
          PA_H(0, m0.h0); PA_H(1, m0.h1); PA_H(2, m0.h2); PA_H(3, m0.h3);
#undef PA_H
        }
        PA_COMPUTE(R0, 0);
        const int itn = (it + nslot < nitems) ? it + nslot : it;
        PA_GATHER(R0, m1, itn, 0);
        PA_COMPUTE(R1, 8);
        PA_GATHER(R1, m1, itn, 8);
        float q8[8], q4[4], q2[2];
#pragma unroll
        for (int i = 0; i < 8; ++i) { const float send = b2 ? part[i] : part[i + 8], keep = b2 ? part[i + 8] : part[i]; q8[i] = keep + dpp_hmirror(send); }
#pragma unroll
        for (int i = 0; i < 4; ++i) { const float send = b1 ? q8[i] : q8[i + 4], keep = b1 ? q8[i + 4] : q8[i]; q4[i] = keep + dpp_xor2(send); }
#pragma unroll
        for (int i = 0; i < 2; ++i) { const float send = b0 ? q4[i] : q4[i + 2], keep = b0 ? q4[i + 2] : q4[i]; q2[i] = keep + dpp_xor1(send); }
        float* ap = apart + ((size_t)PA_X(it) * T + PA_T(it)) * 128 + lane;
        __builtin_nontemporal_store(q2[0], ap); __builtin_nontemporal_store(q2[1], ap + 64);
        m0 = m1; m1 = m2;
    }
#undef PA_META
#undef PA_GATHER
#undef PA_COMPUTE
}
__device__ __forceinline__ void phase_peer_w(const Params& P, LDSP unsigned char* lds, int vcu, int G) {
    unsigned char* ws = P.ws;
    float* gates = (float*)(ws + OFF_GATES);
    const float* apart = (const float*)(ws + OFF_R1);
    const int* experts = (const int*)(ws + OFF_EXPERTS);
    const float* su = (const float*)(ws + OFF_PSCALE);
    const float* sv = su + PEER_NE;
    const size_t gt = (size_t)(vcu * NTHREADS + threadIdx.x), NGT = (size_t)G * NTHREADS;
    for (size_t i = gt; i < (size_t)T * 128; i += NGT) {
        const int t = (int)(i >> 7), k = (int)(i & 127);
        const int sub = k >> 4, s1 = (k >> 3) & 1, grp = k & 7, idx = s1 * 64 + grp * 8 + sub;
        float a = 0.f;
#pragma unroll
        for (int xs = 0; xs < 4; ++xs) a += apart[((size_t)xs * T + t) * 128 + idx];
        const int e = experts[i];
        gates[i] = gelu_tanh(a * su[e] * (8.0f / 119.0f)) * gates[i] * sv[e];
    }
}
__device__ __forceinline__ void phase_peer_b(const Params& P, LDSP unsigned char* lds, int vcu, int G) {
    unsigned char* ws = P.ws;
    const unsigned char* V4 = ws + OFF_V;
    const int* experts = (const int*)(ws + OFF_EXPERTS);
    const float* wtok = (const float*)(ws + OFF_GATES);
    const int tid = opaque_tid(), lane = tid & 63, wave = tid >> 6, grp = lane >> 3, sub = lane & 7;
    const bool b3 = lane & 8;
    const int k0 = 16 * sub + grp, k1 = k0 + 8;
    LDSP float* wbuf = (LDSP float*)(lds + wave * 1024);
    int slice, half, wslot, nslot;
    peer_slice_map(P, lds, vcu, G, wave, slice, half, wslot, nslot);
    const int nitems = (slice >= 0) ? T / 2 : T * 4;
#define PB_META(m, it) do { const int it_ = ((it) < nitems) ? (it) : wslot; { const int t_ = PA_T(it_); \
        (m).eA = __builtin_nontemporal_load(experts + (size_t)t_ * 128 + lane); (m).eB = __builtin_nontemporal_load(experts + (size_t)t_ * 128 + 64 + lane); \
        (m).aA = __builtin_nontemporal_load(wtok + (size_t)t_ * 128 + k0); (m).aB = __builtin_nontemporal_load(wtok + (size_t)t_ * 128 + k1); } } while (0)
#define PB_GATHER(R, m, it, J0) do { const int x_ = PA_X(it); _Pragma("unroll") for (int j = 0; j < 8; ++j) { const int e_ = PEER_IDX(m, (J0) + j); \
        (R)[j] = *(const u32x4*)(V4 + (((unsigned)x_ * (unsigned)PEER_NE + (unsigned)e_) * 128u + 16u * (unsigned)sub)); } } while (0)
#define PB_COMPUTE(R, J0) do { _Pragma("unroll") for (int j = 0; j < 8; ++j) { f32x2 f[16]; asm volatile("" : "+v"((R)[j])); cvt32_fp4_pk((R)[j], f); const float wk = wb[8 * ((J0) + j) + grp]; const f32x2 wk2 = {wk, wk}; \
        _Pragma("unroll") for (int i = 0; i < 16; ++i) acc2[i] = __builtin_elementwise_fma(wk2, f[i], acc2[i]); \
        asm volatile("" : "+v"(acc2[0]), "+v"(acc2[1]), "+v"(acc2[2]), "+v"(acc2[3]), "+v"(acc2[4]), "+v"(acc2[5]), "+v"(acc2[6]), "+v"(acc2[7])); \
        asm volatile("" : "+v"(acc2[8]), "+v"(acc2[9]), "+v"(acc2[10]), "+v"(acc2[11]), "+v"(acc2[12]), "+v"(acc2[13]), "+v"(acc2[14]), "+v"(acc2[15])); } } while (0)
    PeerMetaB m0, m1, m2;
    m0.eA = m0.eB = m1.eA = m1.eB = m2.eA = m2.eB = 0; m0.aA = m0.aB = m1.aA = m1.aB = m2.aA = m2.aB = 0.f;
    u32x4 R0[8], R1[8];
    PB_META(m0, wslot); PB_META(m1, wslot + nslot);
    if (wslot >= nitems) return;
    PB_GATHER(R0, m0, wslot, 0); PB_GATHER(R1, m0, wslot, 8);
    int par = 0;
#pragma unroll 1
    for (int it = wslot; it < nitems; it += nslot) {
        PB_META(m2, it + 2 * nslot);
        LDSP float* wb = wbuf + par * 128; par ^= 1;
        wb[k0] = m0.aA; wb[k1] = m0.aB;
        asm volatile("s_waitcnt lgkmcnt(0)" ::: "memory");
        f32x2 acc2[16];
#pragma unroll
        for (int i = 0; i < 16; ++i) acc2[i] = (f32x2){0.f, 0.f};
        PB_COMPUTE(R0, 0);
        const int itn = (it + nslot < nitems) ? it + nslot : it;
        PB_GATHER(R0, m1, itn, 0);
        PB_COMPUTE(R1, 8);
        PB_GATHER(R1, m1, itn, 8);
        float acc[32];
#pragma unroll
        for (int i = 0; i < 16; ++i) { acc[2 * i] = acc2[i].x; acc[2 * i + 1] = acc2[i].y; }
        float q16[16], q8[8], q4[4];
#pragma unroll
        for (int i = 0; i < 16; ++i) q16[i] = swap32_sum(acc[i], acc[i + 16]);
#pragma unroll
        for (int i = 0; i < 8; ++i) q8[i] = swap16_sum(q16[i], q16[i + 8]);
#pragma unroll
        for (int i = 0; i < 4; ++i) { const float send = b3 ? q8[i] : q8[i + 4], keep = b3 ? q8[i + 4] : q8[i]; q4[i] = keep + dpp_ror8(send); }
        const int c32 = ((lane & 32) ? 16 : 0) + ((lane & 16) ? 8 : 0) + (b3 ? 4 : 0);
        const size_t oidx = (size_t)PA_T(it) * DM + 256 * PA_X(it) + 32 * sub + c32;
        const u32x2 xr = __builtin_nontemporal_load((const u32x2*)((const bf16_t*)(P.ws + OFF_R0) + oidx));
        f32x4 o;
        o.x = __uint_as_float(xr.x << 16) + q4[0]; o.y = __uint_as_float(xr.x & 0xffff0000u) + q4[1]; o.z = __uint_as_float(xr.y << 16) + q4[2]; o.w = __uint_as_float(xr.y & 0xffff0000u) + q4[3];
        __builtin_nontemporal_store(o, (f32x4*)(P.out + oidx));
        m0 = m1; m1 = m2;
    }
#undef PB_META
#undef PB_GATHER
#undef PB_COMPUTE
#undef PA_T
#undef PA_X
}

#ifndef SELFCHECK
#define SELFCHECK 0
#endif
#if SELFCHECK
constexpr size_t OFF_CHK = 512 * 1024;
__device__ __forceinline__ void wave_argmax(float& v, int& i) {
#pragma unroll
    for (int o = 1; o < 64; o <<= 1) {
        const float ov = __shfl_xor(v, o); const int oi = __shfl_xor(i, o);
        if (ov > v || (ov == v && oi < i)) { v = ov; i = oi; }
    }
}
struct NaiveAcc { float m, l; float o[64]; };
__device__ __forceinline__ float wave_max(float v) {
#pragma unroll
    for (int o = 1; o < 64; o <<= 1) v = fmaxf(v, __shfl_xor(v, o));
    return v;
}
__device__ __forceinline__ void nacc_reset(NaiveAcc& a) { a.m = -1.0e30f; a.l = 0.f;
#pragma unroll
    for (int d = 0; d < 64; ++d) a.o[d] = 0.f; }
__device__ __forceinline__ float dot64(LDSP const float* qs, const bf16_t* krow) {
    float s = 0.f;
#pragma unroll
    for (int c = 0; c < 8; ++c) { float f[8]; cvt8(*(const u32x4*)(krow + c * 8), f);
#pragma unroll
        for (int i = 0; i < 8; ++i) s += qs[c * 8 + i] * f[i]; }
    return s;
}
__device__ __forceinline__ void axpy64(NaiveAcc& a, float alpha, float p, const bf16_t* vrow) {
#pragma unroll
    for (int c = 0; c < 8; ++c) { float f[8]; cvt8(*(const u32x4*)(vrow + c * 8), f);
#pragma unroll
        for (int i = 0; i < 8; ++i) a.o[c * 8 + i] = a.o[c * 8 + i] * alpha + p * f[i]; }
}
__device__ __forceinline__ void naive_chunk(NaiveAcc& a, LDSP const float* qs, const bf16_t* krow, const bf16_t* vrow, bool valid) {
    float s = dot64(qs, krow);
    if (!valid) s = -INFINITY;
    const float mnew = fmaxf(a.m, wave_max(s));
    const float alpha = exp2f(a.m - mnew), p = valid ? exp2f(s - mnew) : 0.f;
    a.l = a.l * alpha + p; a.m = mnew;
    axpy64(a, alpha, p, vrow);
}
__device__ __forceinline__ float nacc_final(NaiveAcc& a, int lane) {
    const float l = wave_sum(a.l);
    const float inv = (l > 0.f) ? 1.0f / l : 0.f;
    const bool b5 = lane & 32, b4 = lane & 16, b3 = lane & 8, b2 = lane & 4, b1 = lane & 2, b0 = lane & 1;
    float q32[32], q16[16], q8[8], q4[4], q2[2];
#pragma unroll
    for (int i = 0; i < 32; ++i) { const float send = b5 ? a.o[i] : a.o[i + 32], keep = b5 ? a.o[i + 32] : a.o[i]; q32[i] = keep + __shfl_xor(send, 32); }
#pragma unroll
    for (int i = 0; i < 16; ++i) { const float send = b4 ? q32[i] : q32[i + 16], keep = b4 ? q32[i + 16] : q32[i]; q16[i] = keep + __shfl_xor(send, 16); }
#pragma unroll
    for (int i = 0; i < 8; ++i) { const float send = b3 ? q16[i] : q16[i + 8], keep = b3 ? q16[i + 8] : q16[i]; q8[i] = keep + __shfl_xor(send, 8); }
#pragma unroll
    for (int i = 0; i < 4; ++i) { const float send = b2 ? q8[i] : q8[i + 4], keep = b2 ? q8[i + 4] : q8[i]; q4[i] = keep + __shfl_xor(send, 4); }
#pragma unroll
    for (int i = 0; i < 2; ++i) { const float send = b1 ? q4[i] : q4[i + 2], keep = b1 ? q4[i + 2] : q4[i]; q2[i] = keep + __shfl_xor(send, 2); }
    const float send = b0 ? q2[0] : q2[1], keep = b0 ? q2[1] : q2[0];
    return (keep + __shfl_xor(send, 1)) * inv;
}
__device__ __forceinline__ float cmp_err(float ref, const bf16_t* got, int lane) {
    const float e = wave_max(fabsf(ref - bf2f(got[lane]))), mx = wave_max(fabsf(ref));
    return e / (mx + 1e-3f);
}
__device__ __forceinline__ void phase_selfcheck(const Params& P, LDSP unsigned char* lds, int vcu, int G) {
    unsigned char* ws = P.ws;
    const int tid = opaque_tid(), lane = tid & 63, wave = tid >> 6;
    const int gw = vcu * NWAVES + wave, NGW = G * NWAVES;
    unsigned* cnt = (unsigned*)(ws + OFF_CHK);
    const bf16_t* qa = (const bf16_t*)(ws + OFF_R1);
    const bf16_t* ka = (const bf16_t*)(ws + OFF_R1 + 32 * MiB);
    const bf16_t* va = (const bf16_t*)(ws + OFF_R1 + 64 * MiB);
    const bf16_t* qb = (const bf16_t*)(ws + OFF_R1 + 96 * MiB);
    const bf16_t* ya = (const bf16_t*)(ws + OFF_R0);
    const bf16_t* yb = (const bf16_t*)(ws + OFF_R0 + 32 * MiB);
    const float* kmean = (const float*)(ws + OFF_KMEAN);
    const float* bgate = (const float*)(ws + OFF_BGATE);
    LDSP float* psum = (LDSP float*)(lds + wave * 4096);
    LDSP float* qs = psum + 320;
    LDSP float* ocs = psum + 384;
    constexpr int NS = 537;
#pragma unroll 1
    for (int item = gw; item < NS * 8; item += NGW) {
        const int t = 37 + 61 * (item >> 3), h = item & 7, b = t >> 12, pos = t & (SEQ - 1), own = pos >> 8;
        qs[lane] = bf2f(qa[(size_t)t * 512 + h * 64 + lane]);
        asm volatile("s_waitcnt lgkmcnt(0)" ::: "memory");
        float g0 = -INFINITY, g1 = -INFINITY, g2 = -INFINITY; int i0 = -1, i1 = -1, i2 = -1;
#pragma unroll 1
        for (int j = 0; j < own; ++j) {
            const float* km = kmean + (size_t)((b * 8 + h) * 16 + j) * 64;
            float d = 0.f;
#pragma unroll 8
            for (int i = 0; i < 64; ++i) d += qs[i] * km[i];
            if (d > g0) { g2 = g1; i2 = i1; g1 = g0; i1 = i0; g0 = d; i0 = j; }
            else if (d > g1) { g2 = g1; i2 = i1; g1 = d; i1 = j; }
            else if (d > g2) { g2 = d; i2 = j; }
        }
        NaiveAcc a; nacc_reset(a);
#pragma unroll 1
        for (int j = 0; j <= own; ++j) {
            if (j < own && j != i0 && j != i1 && j != i2) continue;
#pragma unroll 1
            for (int ck = 0; ck < 4; ++ck) {
                const int kp = j * 256 + ck * 64 + lane;
                const size_t kr = (size_t)(b * SEQ + kp) * 512 + h * 64;
                naive_chunk(a, qs, ka + kr, va + kr, kp <= pos);
            }
        }
        const float om = nacc_final(a, lane);
        const float e = cmp_err(om, ya + (size_t)t * 512 + h * 64, lane);
        if (lane == 0 && !(e < 0.05f)) atomicAdd(cnt + 0, 1u);
        asm volatile("s_waitcnt lgkmcnt(0)" ::: "memory");
    }
#pragma unroll 1
    for (int item = gw; item < NS * 2; item += NGW) {
        const int t = 37 + 61 * (item >> 1), g = item & 1, b = t >> 12, pos = t & (SEQ - 1), own = pos >> 6;
        const bf16_t* kc = (const bf16_t*)(ws + OFF_KC) + (size_t)(b * 2 + g) * 256 * 64;
        const bf16_t* vc = (const bf16_t*)(ws + OFF_VC) + (size_t)(b * 2 + g) * 256 * 64;
        const bf16_t* ks = (const bf16_t*)(ws + OFF_R2 + 16 * MiB) + (size_t)(b * SEQ) * 128 + g * 64;
        const bf16_t* vs = (const bf16_t*)(ws + OFF_R2 + 24 * MiB) + (size_t)(b * SEQ) * 128 + g * 64;
        const bf16_t* kw = (const bf16_t*)(ws + OFF_R2 + 32 * MiB) + (size_t)(b * SEQ) * 128 + g * 64;
        const bf16_t* vw = (const bf16_t*)(ws + OFF_R2 + 40 * MiB) + (size_t)(b * SEQ) * 128 + g * 64;
        for (int i = lane; i < 320; i += 64) psum[i] = 0.f;
        asm volatile("s_waitcnt lgkmcnt(0)" ::: "memory");
        const int ncmp_vis = (pos >= 31) ? ((pos - 31) >> 4) + 1 : 0;
#pragma unroll 1
        for (int r = 0; r < 4; ++r) {
            qs[lane] = bf2f(qb[(size_t)t * 512 + (g * 4 + r) * 64 + lane]);
            asm volatile("s_waitcnt lgkmcnt(0)" ::: "memory");
            float mx = -INFINITY;
#pragma unroll 1
            for (int ck = 0; ck < 4; ++ck) { const int n = ck * 64 + lane;
                const float sdot = dot64(qs, kc + (size_t)n * 64);
                mx = fmaxf(mx, (n < ncmp_vis) ? sdot : -INFINITY); }
            mx = wave_max(mx);
            float l = 0.f;
#pragma unroll 1
            for (int ck = 0; ck < 4; ++ck) { const int n = ck * 64 + lane;
                const float sdot = dot64(qs, kc + (size_t)n * 64);
                l += (n < ncmp_vis) ? exp2f(sdot - mx) : 0.f; }
            l = wave_sum(l);
            const float inv = (l > 0.f) ? 1.0f / l : 0.f;
            NaiveAcc a; nacc_reset(a);
#pragma unroll 1
            for (int ck = 0; ck < 4; ++ck) { const int n = ck * 64 + lane;
                const float sdot = dot64(qs, kc + (size_t)n * 64);
                const float pr = (n < ncmp_vis) ? exp2f(sdot - mx) * inv : 0.f;
                psum[n] += pr;
                axpy64(a, 1.0f, pr, vc + (size_t)n * 64); }
            a.l = (lane == 0) ? 1.f : 0.f;
            ocs[r * 64 + lane] = nacc_final(a, lane);
            asm volatile("s_waitcnt lgkmcnt(0)" ::: "memory");
        }
        {
            const int j = lane;
            float imp = 0.f;
            for (int n = 4 * j - 1; n <= 4 * j + 3; ++n) if (n >= 0 && n < 255) imp += psum[n];
            if (j == 0 || j == own || j == own - 1) imp = 1.0e30f;
            if (j > own) imp = -1.0e30f;
            unsigned long long sel = 0ull;
#pragma unroll 1
            for (int r = 0; r < 16; ++r) {
                float v = imp; int i = j;
                wave_argmax(v, i);
                if (v > -0.5e30f) sel |= 1ull << i;
                if (i == j) imp = -3.0e38f;
            }
            psum[256] = __uint_as_float((unsigned)sel); psum[257] = __uint_as_float((unsigned)(sel >> 32));
            asm volatile("s_waitcnt lgkmcnt(0)" ::: "memory");
        }
        const unsigned long long sel = ((unsigned long long)__float_as_uint(psum[257]) << 32) | __float_as_uint(psum[256]);
#pragma unroll 1
        for (int r = 0; r < 4; ++r) {
            const int head = g * 4 + r;
            qs[lane] = bf2f(qb[(size_t)t * 512 + head * 64 + lane]);
            asm volatile("s_waitcnt lgkmcnt(0)" ::: "memory");
            const float gt0 = bgate[(size_t)t * 24 + head * 3], gt1 = bgate[(size_t)t * 24 + head * 3 + 1], gt2 = bgate[(size_t)t * 24 + head * 3 + 2];
            float y = gt0 * ocs[r * 64 + lane];
            NaiveAcc a; nacc_reset(a);
#pragma unroll 1
            for (int j = 0; j <= own; ++j) {
                if (!((sel >> j) & 1ull)) continue;
                const int kp = j * 64 + lane;
                naive_chunk(a, qs, ks + (size_t)kp * 128, vs + (size_t)kp * 128, kp <= pos);
            }
            y += gt1 * nacc_final(a, lane);
            nacc_reset(a);
#pragma unroll 1
            for (int ck = 0; ck < 9; ++ck) {
                const int kp = pos - 575 + ck * 64 + lane;
                const bool valid = kp >= 0 && kp <= pos && kp > pos - 512;
                const int kpc = kp < 0 ? 0 : kp;
                naive_chunk(a, qs, kw + (size_t)kpc * 128, vw + (size_t)kpc * 128, valid);
            }
            y += gt2 * nacc_final(a, lane);
            const float e = cmp_err(y, yb + (size_t)t * 512 + head * 64, lane);
            if (lane == 0 && !(e < 0.05f)) atomicAdd(cnt + 1, 1u);
            asm volatile("s_waitcnt lgkmcnt(0)" ::: "memory");
        }
    }
}

__device__ __forceinline__ void phase_selfcheck2(const Params& P, LDSP unsigned char* lds, int vcu, int G) {
    unsigned char* ws = P.ws;
    const int tid = opaque_tid(), lane = tid & 63, wave = tid >> 6;
    const int gw = vcu * NWAVES + wave, NGW = G * NWAVES;
    unsigned* cnt = (unsigned*)(ws + OFF_CHK);
    LDSP float* hs = (LDSP float*)(lds + wave * 8192);
    const float* x = P.in[I_X]; const float* g1 = P.in[I_NORM1]; const float* w = P.in[I_WIN];
    constexpr int NS = 192, NGRP = 14;
#pragma unroll 1
    for (int item = gw; item < NS * NGRP; item += NGW) {
        const int si = item / NGRP, grp = item % NGRP;
        const int t = 11 + 167 * si, b = t >> 12, pos = t & (SEQ - 1);
        const int hsel = si & 7, gsel = si & 1;
        float ss = 0.f;
        for (int i = lane; i < DM; i += 64) { const float v = x[(size_t)t * DM + i]; ss += v * v; }
        ss = wave_sum(ss);
        const float rs = 1.0f / sqrtf(ss / DM + NORM_EPS);
        for (int i = lane; i < DM; i += 64) hs[i] = x[(size_t)t * DM + i] * rs * g1[i];
        asm volatile("s_waitcnt lgkmcnt(0)" ::: "memory");
        int col0, kind; const float* gain = nullptr; float oscale = 1.f; const bf16_t* got = nullptr; int ncols = 64;
        const bf16_t* R1 = (const bf16_t*)(ws + OFF_R1); const bf16_t* R2 = (const bf16_t*)(ws + OFF_R2); const bf16_t* R3 = (const bf16_t*)(ws + OFF_R3);
        const size_t M32 = (size_t)16 * 1024 * 1024;
        switch (grp) {
        case 0: col0 = hsel * 64;          kind = 1; gain = P.in[I_AQG]; oscale = QSCALE; got = R1 + (size_t)t * 512 + hsel * 64; break;
        case 1: col0 = 512 + hsel * 64;    kind = 1; gain = P.in[I_AKG]; got = R1 + M32 + (size_t)t * 512 + hsel * 64; break;
        case 2: col0 = 1024 + hsel * 64;   kind = 0; got = R1 + 2 * M32 + (size_t)t * 512 + hsel * 64; break;
        case 3: col0 = 1536 + hsel * 64;   kind = 1; gain = P.in[I_BQG]; oscale = QSCALE; got = R1 + 3 * M32 + (size_t)t * 512 + hsel * 64; break;
        case 4: col0 = 2048 + gsel * 64;   kind = 0; got = R2 + ((size_t)((b * 2 + gsel) * SEQ + pos)) * 64; break;
        case 5: col0 = 2176 + gsel * 64;   kind = 0; got = R2 + M32 / 4 + ((size_t)((b * 2 + gsel) * SEQ + pos)) * 64; break;
        case 6: col0 = 2304 + gsel * 64;   kind = 1; gain = P.in[I_BKSG]; got = R2 + 2 * (M32 / 4) + (size_t)t * 128 + gsel * 64; break;
        case 7: col0 = 2432 + gsel * 64;   kind = 0; got = R2 + 3 * (M32 / 4) + (size_t)t * 128 + gsel * 64; break;
        case 8: col0 = 2560 + gsel * 64;   kind = 1; gain = P.in[I_BKWG]; got = R2 + 4 * (M32 / 4) + (size_t)t * 128 + gsel * 64; break;
        case 9: col0 = 2688 + gsel * 64;   kind = 0; got = R2 + 5 * (M32 / 4) + (size_t)t * 128 + gsel * 64; break;
        case 10: col0 = 2840 + hsel * 64;        kind = 2; got = R3 + (size_t)t * 2048 + hsel * 64; break;
        case 11: col0 = 2840 + 1024 + hsel * 64; kind = 2; got = R3 + (size_t)t * 2048 + 1024 + hsel * 64; break;
        case 12: col0 = 2840 + 1024 + 512 + hsel * 64; kind = 2; got = R3 + (size_t)t * 2048 + 1536 + hsel * 64; break;
        default: col0 = 2816; kind = 3; ncols = 24; break;
        }
        if (grp == 10) continue;
        float acc = 0.f;
        if (lane < ncols) {
#pragma unroll 4
            for (int k = 0; k < DM; ++k) acc += hs[k] * w[(size_t)k * 4888 + col0 + lane];
        }
        float ref;
        if (kind == 1) {
            const float ssq = wave_sum(acc * acc);
            float y = acc / sqrtf(ssq / 64.0f + NORM_EPS) * gain[lane];
            const float ya_ = __shfl(y, (lane + 8) & 63), yb_ = __shfl(y, (lane - 8) & 63);
            const int f = lane & 7;
            const float ang = (float)pos * powf(500000.0f, -(float)(2 * f) / 16.0f);
            const float c = cosf(ang), sn = sinf(ang);
            if (lane < 8) y = y * c - ya_ * sn; else if (lane < 16) y = y * c + yb_ * sn;
            ref = y * oscale;
        } else if (kind == 2) {
            ref = 1.0f / (1.0f + expf(-(acc + P.in[I_BMERGE][col0 - 2840 + lane])));
        } else if (kind == 3) {
            ref = 1.0f / (1.0f + expf(-acc));
        } else ref = acc;
        float gotv;
        if (kind == 3) gotv = (lane < 24) ? ((const float*)(ws + OFF_BGATE))[(size_t)t * 24 + lane] : 0.f;
        else gotv = bf2f(got[lane]);
        if (kind == 3 && lane >= 24) ref = 0.f;
        const float e = wave_max(fabsf(ref - gotv)) / (wave_max(fabsf(ref)) + 1e-3f);
        if (lane == 0 && !(e < 0.03f)) atomicAdd(cnt + 0, 1u);
        asm volatile("s_waitcnt lgkmcnt(0)" ::: "memory");
    }
#pragma unroll 1
    for (int item = gw; item < 1024; item += NGW) {
        const int b = item >> 7, h = (item >> 4) & 7, blk = item & 15;
        const bf16_t* p = (const bf16_t*)(ws + OFF_R1 + 32 * MiB) + (size_t)(b * SEQ + blk * 256) * 512 + h * 64 + lane;
        float sref = 0.f;
        for (int k = 0; k < 256; ++k) sref += bf2f(p[(size_t)k * 512]);
        const float gotv = ((const float*)(ws + OFF_KMEAN))[(size_t)item * 64 + lane];
        const float e = wave_max(fabsf(sref - gotv)) / (wave_max(fabsf(sref)) + 1e-2f);
        if (lane == 0 && !(e < 0.03f)) atomicAdd(cnt + 1, 1u);
    }
#pragma unroll 1
    for (int item = gw; item < 96 * 2; item += NGW) {
        const int si = item >> 1, kv = item & 1;
        const int slab = si & 15, n = (si * 37 + 3) % 255;
        const bf16_t* raw = (const bf16_t*)(ws + OFF_R2 + (size_t)kv * 8 * MiB) + (size_t)slab * SEQ * 64 + (size_t)n * 16 * 64;
        const float* posv = P.in[kv ? I_CPV : I_CPK]; const float* w1 = P.in[kv ? I_CVW1 : I_CKW1]; const float* b1 = P.in[kv ? I_CVB1 : I_CKB1];
        const float* w2 = P.in[kv ? I_CVW2 : I_CKW2]; const float* b2 = P.in[kv ? I_CVB2 : I_CKB2];
        float hacc[4] = {0.f, 0.f, 0.f, 0.f};
#pragma unroll 1
        for (int i = 0; i < 2048; ++i) {
            const float a = bf2f(raw[i]) + posv[i];
#pragma unroll
            for (int u = 0; u < 4; ++u) hacc[u] += a * w1[(size_t)i * 256 + lane + 64 * u];
        }
#pragma unroll
        for (int u = 0; u < 4; ++u) { const float z = hacc[u] + b1[lane + 64 * u]; hs[1024 + lane + 64 * u] = 0.5f * z * (1.0f + tanhf(0.7978845608028654f * (z + 0.044715f * z * z * z))); }
        asm volatile("s_waitcnt lgkmcnt(0)" ::: "memory");
        float o = b2[lane];
#pragma unroll 4
        for (int j = 0; j < 256; ++j) o += hs[1024 + j] * w2[(size_t)j * 64 + lane];
        if (!kv) { const float ssq = wave_sum(o * o); o = o / sqrtf(ssq / 64.0f + NORM_EPS) * P.in[I_BKCG][lane]; }
        const float gotv = bf2f(((const bf16_t*)(ws + (kv ? OFF_VC : OFF_KC)))[((size_t)slab * 256 + n) * 64 + lane]);
        const float e = wave_max(fabsf(o - gotv)) / (wave_max(fabsf(o)) + 1e-3f);
        if (lane == 0 && !(e < 0.03f)) atomicAdd(cnt + 1, 1u);
        asm volatile("s_waitcnt lgkmcnt(0)" ::: "memory");
    }
}
#endif

#define XB_TMO      128
#define XB_XCNT(j)  (256  + 64 * (j))
#define XB_XSUB(j)  (1280 + 64 * (j))
#define XB_XGEN(j)  (2304 + 64 * (j))
#define XB_TOP      3328
#define XB_TOPGEN   3392
#define XCD_BAR_WORDS 3456
#define XB_SPIN_CAP (1u << 22)
__device__ __forceinline__ unsigned xb_ld(unsigned* p)              { return __hip_atomic_load(p, __ATOMIC_RELAXED, __HIP_MEMORY_SCOPE_AGENT); }
__device__ __forceinline__ unsigned xb_add(unsigned* p, unsigned v) { return __hip_atomic_fetch_add(p, v, __ATOMIC_RELAXED, __HIP_MEMORY_SCOPE_AGENT); }
__device__ __forceinline__ unsigned xb_xcc_id() { return (unsigned)__builtin_amdgcn_s_getreg((3 << 11) | 20) & 0xFu; }
#define XB_SPIN(cond, bar) do { unsigned _sp = 0; while (cond) { __builtin_amdgcn_s_sleep(1); \
    if ((++_sp & 255u) == 0u) { if (xb_ld(&(bar)[XB_TMO])) break; if (_sp > XB_SPIN_CAP) { atomicAdd(&(bar)[XB_TMO], 1u); break; } } } } while (0)
struct XcdBarrier { unsigned* bar; unsigned x; volatile LDSP unsigned* st; };
__device__ __forceinline__ XcdBarrier xcd_barrier_post(unsigned* bar, volatile LDSP unsigned* st) {
    XcdBarrier b; b.bar = bar; b.x = xb_xcc_id(); b.st = st;
    if (threadIdx.x == 0) (void)xb_add(&bar[XB_XCNT(b.x)], 1u);
    return b;
}
__device__ __forceinline__ void xcd_barrier_complete(unsigned* bar, unsigned x, unsigned& nloc, unsigned& nx) {
    const unsigned G = gridDim.x * gridDim.y * gridDim.z;
    unsigned sum, cnt, mine, sp = 0u;
    for (;;) {
        sum = 0u; cnt = 0u; mine = 0u;
#pragma unroll
        for (unsigned j = 0; j < 16; ++j) { const unsigned c = xb_ld(&bar[XB_XCNT(j)]); sum += c; cnt += (c > 0u) ? 1u : 0u; mine = (j == x) ? c : mine; }
        if (sum == G) break;
        __builtin_amdgcn_s_sleep(1);
        if ((++sp & 255u) == 0u) { if (xb_ld(&bar[XB_TMO])) break; if (sp > XB_SPIN_CAP) { atomicAdd(&bar[XB_TMO], 1u); break; } }
    }
    nloc = mine > 0u ? mine : 1u; nx = cnt > 0u ? cnt : 1u;
}
__device__ __forceinline__ void xcd_barrier(const XcdBarrier& b) {
    asm volatile("s_waitcnt vmcnt(0)" ::: "memory");
    __syncthreads();
    if (threadIdx.x == 0) {
        unsigned* bar = b.bar;
        __builtin_amdgcn_s_waitcnt(0);
        unsigned nloc = b.st[0], nx = b.st[1];
        if (nloc == 0u) { xcd_barrier_complete(bar, b.x, nloc, nx); b.st[0] = nloc; b.st[1] = nx; }
        const unsigned old = xb_add(&bar[XB_XSUB(b.x)], 1u);
        const unsigned gen = old / nloc;
        if (old + 1u == (gen + 1u) * nloc) {
            __builtin_amdgcn_fence(__ATOMIC_RELEASE, "agent");
            asm volatile("s_waitcnt vmcnt(0)" ::: "memory");
            const unsigned og = xb_add(&bar[XB_TOP], 1u);
            const unsigned tg = og / nx;
            if (og + 1u == (tg + 1u) * nx) xb_add(&bar[XB_TOPGEN], 1u);
            else XB_SPIN(xb_ld(&bar[XB_TOPGEN]) == tg, bar);
            __builtin_amdgcn_fence(__ATOMIC_ACQUIRE, "agent");
            xb_add(&bar[XB_XGEN(b.x)], 1u);
            asm volatile("s_waitcnt vmcnt(0)" ::: "memory");
        } else {
            XB_SPIN(xb_ld(&bar[XB_XGEN(b.x)]) == gen, bar);
            __builtin_amdgcn_fence(__ATOMIC_ACQUIRE, "agent");
            asm volatile("s_waitcnt vmcnt(0)" ::: "memory");
        }
    }
    __syncthreads();
}

__global__ void __launch_bounds__(NTHREADS, 2) fwd_kernel(Params P) {
    extern __shared__ __attribute__((aligned(16))) unsigned char lds_raw[];
    LDSP unsigned char* lds = (LDSP unsigned char*)lds_raw;
    const int G = gridDim.x, bx = blockIdx.x;
    const int vcu = (G % 8 == 0) ? (bx % 8) * (G / 8) + bx / 8 : bx;
    const int lo = P.ph_lo, hi = P.ph_hi;
    volatile LDSP unsigned* bst = (volatile LDSP unsigned*)(lds + LDS_BYTES - 16);
    if (threadIdx.x == 0) { bst[0] = 0u; bst[1] = 0u; bst[2] = 0u; bst[3] = 0u; }
    __syncthreads();
    const XcdBarrier xbar = xcd_barrier_post((unsigned*)(P.ws + 16384), bst);
    if (threadIdx.x == 0) bst[2] = xb_add((unsigned*)(P.ws + 32768) + 64 * xbar.x, 1u);
#define IN(k) (lo <= (k) && (k) < hi)
#define SEAM(k) do { if (IN(k) && IN((k) + 1)) xcd_barrier(xbar); } while (0)
    if (IN(0)) phase_prep(P, lds, vcu, G);
    SEAM(0);
    if (IN(1)) phase_proj(P, lds, vcu, G);
    SEAM(1);
    if (IN(2)) phase_cmp(P, lds, vcu, G);
    SEAM(2);
    if (IN(4)) phase_attn(P, lds, vcu, G);
    SEAM(4);
#if SELFCHECK == 1
    phase_selfcheck(P, lds, vcu, G);
    xcd_barrier(xbar);
#elif SELFCHECK == 2
    phase_selfcheck2(P, lds, vcu, G);
    xcd_barrier(xbar);
#endif
    if (IN(5)) phase_up(P, lds, vcu, G);
    SEAM(5);
    if (IN(6)) phase_out(P, lds, vcu, G);
    SEAM(6);
    if (IN(7)) phase_pq(P, lds, vcu, G);
    SEAM(7);
    if (IN(8)) phase_topk(P, lds, vcu, G);
    SEAM(8);
    if (IN(9)) { phase_peer_a(P, lds, vcu, G); xcd_barrier(xbar); phase_peer_w(P, lds, vcu, G); xcd_barrier(xbar); phase_peer_b(P, lds, vcu, G); }
#if SELFCHECK
    xcd_barrier(xbar);
    if (bx == 0 && threadIdx.x == 0) {
        const unsigned* cnt = (const unsigned*)(P.ws + OFF_CHK);
        P.out[0] += 1000.0f * (float)cnt[0];
        P.out[1] += 1000000.0f * (float)cnt[1];
    }
#endif
#undef IN
#undef SEAM
}

extern "C" void kernel_launch(void* const* d_in, const int* in_sizes, int n_in, void* d_out, int out_size, void* d_ws, size_t ws_size, hipStream_t stream) {
    static int grid = 0;
    if (grid == 0) {
        if (n_in != 29 || ws_size < WS_END) { fprintf(stderr, "kernel_launch: unexpected n_in %d / ws_size %zu\n", n_in, ws_size); grid = -1; return; }
        int dev = 0, cus = 0, per_cu = 0;
        (void)hipGetDevice(&dev);
        (void)hipDeviceGetAttribute(&cus, hipDeviceAttributeMultiprocessorCount, dev);
        (void)hipFuncSetAttribute((const void*)fwd_kernel, hipFuncAttributeMaxDynamicSharedMemorySize, LDS_BYTES);
        (void)hipOccupancyMaxActiveBlocksPerMultiprocessor(&per_cu, (const void*)fwd_kernel, NTHREADS, LDS_BYTES);
        if (per_cu < 1) { fprintf(stderr, "kernel_launch: occupancy query says %d blocks per CU\n", per_cu); grid = -1; return; }
        grid = cus;
    }
    if (grid < 0) return;
    Params p{};
    for (int i = 0; i < 29; ++i) p.in[i] = (const float*)d_in[i];
    p.out = (float*)d_out; p.ws = (unsigned char*)d_ws;
    (void)hipMemsetAsync(d_ws, 0, 65536, stream);
    p.ph_lo = 0; p.ph_hi = 10;
    hipLaunchKernelGGL(fwd_kernel, dim3(grid), dim3(NTHREADS), LDS_BYTES, stream, p);
}
```

```cpp
#include <hip/hip_runtime.h>
#include <hip/hip_cooperative_groups.h>
#include <stdint.h>
#include <stdio.h>
#define SELFCHECK 0
namespace cg = cooperative_groups;

#define LDSP __attribute__((address_space(3)))
typedef unsigned short bf16_t;
typedef short bf16x8 __attribute__((ext_vector_type(8)));
typedef short s16x4 __attribute__((ext_vector_type(4)));
typedef float f32x2 __attribute__((ext_vector_type(2)));
typedef float f32x4 __attribute__((ext_vector_type(4)));
typedef float f32x16 __attribute__((ext_vector_type(16)));
typedef unsigned u32x2 __attribute__((ext_vector_type(2)));
typedef unsigned u32x4 __attribute__((ext_vector_type(4)));
typedef __bf16 bf16x2_t __attribute__((ext_vector_type(2)));

constexpr int BATCH = 8, SEQ = 4096, DM = 1024, T = BATCH * SEQ;
constexpr int HD = 64;
constexpr int NPROJ = 5120;
constexpr int PEER_NE = 16384;
constexpr float NORM_EPS = 1e-6f;
constexpr float QSCALE = 0.125f * 1.4426950408889634f;
constexpr int NTHREADS = 512, NWAVES = 8;
constexpr int LDS_BYTES = 140 * 1024;

constexpr size_t MiB = 1u << 20;
constexpr size_t OFF_RS1 = 1 * MiB;
constexpr size_t OFF_RS2 = 1 * MiB + 256 * 1024;
constexpr size_t OFF_ROPE_C = 2 * MiB;
constexpr size_t OFF_ROPE_S = 2 * MiB + 128 * 1024;
constexpr size_t OFF_POSB = 2 * MiB + 512 * 1024;
constexpr size_t OFF_KMEAN = 3 * MiB;
constexpr size_t OFF_BGATE = 4 * MiB;
constexpr size_t OFF_WIN_T = 8 * MiB;
constexpr size_t OFF_WUPA_T = 19 * MiB;
constexpr size_t OFF_WUPB_T = 20 * MiB;
constexpr size_t OFF_WOUT_T = 21 * MiB;
constexpr size_t OFF_WPQ_T = 23 * MiB;
constexpr size_t OFF_W1K_T = 27 * MiB;
constexpr size_t OFF_W1V_T = 28 * MiB;
constexpr size_t OFF_W2K_T = 29 * MiB;
constexpr size_t OFF_W2V_T = 29 * MiB + 128 * 1024;
constexpr size_t OFF_K1B = 29 * MiB + 256 * 1024;
constexpr size_t OFF_K2B = 29 * MiB + 320 * 1024;
constexpr size_t OFF_HID = 30 * MiB;
constexpr size_t OFF_KC = 34 * MiB;
constexpr size_t OFF_VC = 35 * MiB;
constexpr size_t OFF_EXPERTS = 36 * MiB;
constexpr size_t OFF_GATES = 52 * MiB;
constexpr size_t OFF_U = 68 * MiB;
constexpr size_t OFF_PSCALE = 84 * MiB;
constexpr size_t OFF_V = 100 * MiB;
constexpr size_t OFF_R0 = 132 * MiB;
constexpr size_t OFF_R1 = 196 * MiB;
constexpr size_t OFF_R2 = 324 * MiB;
constexpr size_t OFF_R3 = 372 * MiB;
constexpr size_t WS_END = 500 * MiB;

struct Params {
    const float* in[29];
    float* out;
    unsigned char* ws;
    int ph_lo, ph_hi;
};
static_assert(sizeof(Params) == 31 * 8 + 8, "Params has no padding");

enum { I_X = 0, I_NORM1, I_WIN, I_BMERGE, I_AQG, I_AKG, I_BQG, I_BKCG, I_BKSG, I_BKWG,
       I_CPK, I_CKW1, I_CKB1, I_CKW2, I_CKB2, I_CPV, I_CVW1, I_CVB1, I_CVW2, I_CVB2,
       I_WUPA, I_WUPB, I_WOUT, I_NORM2, I_PWQ, I_PK1, I_PK2, I_PU, I_PV };

__device__ __forceinline__ int opaque_tid() { int t = threadIdx.x; asm volatile("" : "+v"(t)); return t; }
__device__ __forceinline__ unsigned pk2(float lo, float hi) {
    f32x2 v = {lo, hi};
    bf16x2_t b = __builtin_convertvector(v, bf16x2_t);
    return __builtin_bit_cast(unsigned, b);
}
__device__ __forceinline__ float bf2f(bf16_t b) { return __uint_as_float(((unsigned)b) << 16); }
__device__ __forceinline__ float wave_sum(float v) {
#pragma unroll
    for (int o = 1; o < 64; o <<= 1) v += __shfl_xor(v, o);
    return v;
}
__device__ __forceinline__ float sum_xor16(float v) { const auto r = __builtin_amdgcn_permlane16_swap(__float_as_uint(v), __float_as_uint(v), false, false); return __uint_as_float(r[0]) + __uint_as_float(r[1]); }
__device__ __forceinline__ float sum_xor32(float v) { const auto r = __builtin_amdgcn_permlane32_swap(__float_as_uint(v), __float_as_uint(v), false, false); return __uint_as_float(r[0]) + __uint_as_float(r[1]); }
__device__ __forceinline__ float get_xor16(float v, bool odd_row) { const auto r = __builtin_amdgcn_permlane16_swap(__float_as_uint(v), __float_as_uint(v), false, false); return __uint_as_float(odd_row ? r[0] : r[1]); }
__device__ __forceinline__ float gelu_tanh(float x) {
    const float u = 0.7978845608028654f * (x + 0.044715f * x * x * x);
    return x * __builtin_amdgcn_rcpf(1.0f + __expf(-2.0f * u));
}
__device__ __forceinline__ float sigmoidf_(float x) { return __builtin_amdgcn_rcpf(1.0f + __expf(-x)); }
__device__ __forceinline__ void cvt8(const u32x4 w, float (&f)[8]) {
    f[0] = __uint_as_float(w.x << 16); f[1] = __uint_as_float(w.x & 0xffff0000u); f[2] = __uint_as_float(w.y << 16); f[3] = __uint_as_float(w.y & 0xffff0000u);
    f[4] = __uint_as_float(w.z << 16); f[5] = __uint_as_float(w.z & 0xffff0000u); f[6] = __uint_as_float(w.w << 16); f[7] = __uint_as_float(w.w & 0xffff0000u);
}
__device__ __forceinline__ int swz_off(int row, int chunk) { return row * 128 + ((chunk ^ ((row >> 1) & 7)) << 4); }

__device__ __forceinline__ void transpose_item(const float* W, int ldw, int k0, int src_c0, int nvalid, const float* kscale,
                                               bf16_t* WT, int ldwt, int n0, LDSP float* scr, int lane) {
    const int ch = lane & 7, r0 = lane >> 3;
    f32x4 v[8]; float ks[8];
#pragma unroll
    for (int i = 0; i < 8; ++i) {
        const int kk = r0 + 8 * i;
        v[i] = (f32x4){0.f, 0.f, 0.f, 0.f};
        if (4 * ch < nvalid) v[i] = *(const f32x4*)(W + (size_t)(k0 + kk) * ldw + src_c0 + 4 * ch);
        ks[i] = kscale ? kscale[k0 + kk] : 1.0f;
    }
#pragma unroll
    for (int i = 0; i < 8; ++i) {
        LDSP float* d = scr + (r0 + 8 * i) * 33 + 4 * ch;
        d[0] = v[i].x * ks[i]; d[1] = v[i].y * ks[i]; d[2] = v[i].z * ks[i]; d[3] = v[i].w * ks[i];
    }
    asm volatile("s_waitcnt lgkmcnt(0)" ::: "memory");
    const int c = lane & 7;
#pragma unroll
    for (int j = 0; j < 4; ++j) {
        const int n = (lane >> 3) + 8 * j;
        const LDSP float* s = scr + (8 * c) * 33 + n;
        u32x4 o;
        o.x = pk2(s[0 * 33], s[1 * 33]); o.y = pk2(s[2 * 33], s[3 * 33]); o.z = pk2(s[4 * 33], s[5 * 33]); o.w = pk2(s[6 * 33], s[7 * 33]);
        *(u32x4*)(WT + (size_t)(n0 + n) * ldwt + k0 + 8 * c) = o;
    }
    asm volatile("s_waitcnt lgkmcnt(0)" ::: "memory");
}

struct TrJob { const float* W; int K, N, ldw; const float* kscale; bf16_t* WT; int kind; };

__device__ __forceinline__ void run_tr_job(const TrJob& J, int item, LDSP float* scr, int lane) {
    const int nblk = J.N / 32, kb = item / nblk, nb = item % nblk;
    int src_c0 = nb * 32, nvalid = 32;
    if (J.kind == 1) {
        const int p0 = nb * 32, pn = p0 >> 8, q = p0 & 255, bj = q >> 7, wc = (q >> 5) & 3, H = 4 * pn + wc, d0 = 32 * bj;
        if (H < 44) src_c0 = 64 * H + d0;
        else if (H < 76) src_c0 = 64 * H + d0 + 24;
        else if (H == 76 && bj == 0) { src_c0 = 2816; nvalid = 24; }
        else { src_c0 = 0; nvalid = 0; }
    } else if (J.kind == 2) {
        if (nb * 32 >= 64) { src_c0 = 0; nvalid = 0; }
    }
    transpose_item(J.W, J.ldw, kb * 64, src_c0, nvalid, J.kscale, J.WT, J.K, nb * 32, scr, lane);
}

__device__ __forceinline__ void phase_prep(const Params& P, LDSP unsigned char* lds, int vcu, int G) {
    const int tid = opaque_tid(), lane = tid & 63, wave = tid >> 6;
    const int gw = vcu * NWAVES + wave, NGW = G * NWAVES;
    unsigned char* ws = P.ws;
    LDSP float* scr = (LDSP float*)(lds + wave * 8704);
    int base = 0;
#define TR_JOB(Wp, Kk, Nn, LDW, KS, WTp, KIND) do { TrJob J{Wp, Kk, Nn, LDW, KS, WTp, KIND}; const int nitems = ((Kk) / 64) * ((Nn) / 32); \
        const int first = (gw - base % NGW + NGW) % NGW; for (int it = first; it < nitems; it += NGW) run_tr_job(J, it, scr, lane); base += nitems; } while (0)
    TR_JOB(P.in[I_WIN], 1024, NPROJ, 4888, P.in[I_NORM1], (bf16_t*)(ws + OFF_WIN_T), 1);
    TR_JOB(P.in[I_WUPA], 512, 1024, 1024, nullptr, (bf16_t*)(ws + OFF_WUPA_T), 0);
    TR_JOB(P.in[I_WUPB], 512, 1024, 1024, nullptr, (bf16_t*)(ws + OFF_WUPB_T), 0);
    TR_JOB(P.in[I_WOUT], 1024, 1024, 1024, nullptr, (bf16_t*)(ws + OFF_WOUT_T), 0);
    TR_JOB(P.in[I_PWQ], 1024, 2048, 2048, P.in[I_NORM2], (bf16_t*)(ws + OFF_WPQ_T), 0);
    TR_JOB(P.in[I_CKW1], 2048, 256, 256, nullptr, (bf16_t*)(ws + OFF_W1K_T), 0);
    TR_JOB(P.in[I_CVW1], 2048, 256, 256, nullptr, (bf16_t*)(ws + OFF_W1V_T), 0);
    TR_JOB(P.in[I_CKW2], 256, 128, 64, nullptr, (bf16_t*)(ws + OFF_W2K_T), 2);
    TR_JOB(P.in[I_CVW2], 256, 128, 64, nullptr, (bf16_t*)(ws + OFF_W2V_T), 2);
#undef TR_JOB
    {
        const float* x = P.in[I_X];
        bf16_t* xb = (bf16_t*)(ws + OFF_R0);
        float* rs1 = (float*)(ws + OFF_RS1);
#pragma unroll 4
        for (int m = gw; m < T; m += NGW) {
            const f32x4* xr = (const f32x4*)(x + (size_t)m * DM) + lane;
            f32x4 v[4]; float s = 0.f;
#pragma unroll
            for (int j = 0; j < 4; ++j) { v[j] = xr[64 * j]; s += (v[j].x * v[j].x + v[j].y * v[j].y) + (v[j].z * v[j].z + v[j].w * v[j].w); }
            s = wave_sum(s);
            if (lane == 0) rs1[m] = 1.0f / sqrtf(s * (1.0f / DM) + NORM_EPS);
            u32x2* o = (u32x2*)(xb + (size_t)m * DM) + lane;
#pragma unroll
            for (int j = 0; j < 4; ++j) { u32x2 w; w.x = pk2(v[j].x, v[j].y); w.y = pk2(v[j].z, v[j].w); o[64 * j] = w; }
        }
    }
    {
        const float* g2 = P.in[I_NORM2];
        f32x4 g4[4];
#pragma unroll
        for (int q = 0; q < 4; ++q) g4[q] = *(const f32x4*)(g2 + 256 * q + 4 * lane);
        float* scales = (float*)(ws + OFF_PSCALE);
#pragma unroll 4
        for (int r = gw; r < 2 * PEER_NE; r += NGW) {
            const int which = (r >= PEER_NE) ? 1 : 0, e = r & (PEER_NE - 1);
            const float* src = P.in[which ? I_PV : I_PU] + (size_t)e * DM + 4 * lane;
            f32x4 a[4]; float ss = 0.f;
#pragma unroll
            for (int q = 0; q < 4; ++q) { a[q] = *(const f32x4*)(src + 256 * q); if (!which) a[q] = a[q] * g4[q];
                ss += (a[q].x * a[q].x + a[q].y * a[q].y) + (a[q].z * a[q].z + a[q].w * a[q].w); }
            ss = wave_sum(ss);
            const float rms = sqrtf(ss * (1.0f / DM));
            if (which) {
                const float sc = (rms > 0.f) ? 0.5f * rms : 1.0f, inv = 1.0f / sc;
                unsigned char* dst = ws + OFF_V + (size_t)e * 128 + 2 * lane;
#pragma unroll
                for (int q = 0; q < 4; ++q) {
                    unsigned pq = 0;
                    pq = __builtin_amdgcn_cvt_scalef32_pk_fp4_f32(pq, a[q].x * inv, a[q].y * inv, 1.0f, 0);
                    pq = __builtin_amdgcn_cvt_scalef32_pk_fp4_f32(pq, a[q].z * inv, a[q].w * inv, 1.0f, 1);
                    *(unsigned short*)(dst + (size_t)q * PEER_NE * 128) = (unsigned short)pq;
                }
                if (lane == 0) scales[r] = sc;
            } else {
                const float sc = (rms > 0.f) ? rms * (2.5f / 7.0f) : 1.0f, inv = 1.0f / sc;
                const int b8 = 8 * (lane & 1);
#pragma unroll
                for (int q = 0; q < 4; ++q) {
                    const int n0 = (int)fminf(fmaxf(rintf(a[q].x * inv), -7.f), 7.f) & 15, n1 = (int)fminf(fmaxf(rintf(a[q].y * inv), -7.f), 7.f) & 15;
                    const int n2 = (int)fminf(fmaxf(rintf(a[q].z * inv), -7.f), 7.f) & 15, n3 = (int)fminf(fmaxf(rintf(a[q].w * inv), -7.f), 7.f) & 15;
                    const unsigned part = ((unsigned)n0 << b8) | ((unsigned)n2 << (b8 + 4)) | ((unsigned)n1 << (b8 + 16)) | ((unsigned)n3 << (b8 + 20));
                    const unsigned full = part | (unsigned)__shfl_xor((int)part, 1);
                    if (!(lane & 1)) *(unsigned*)(ws + OFF_U + ((size_t)q * PEER_NE + e) * 128 + 4 * (lane >> 1)) = full;
                }
                if (lane == 0) scales[r] = sc;
            }
        }
    }
    {
        const int gt = gw * 64 + lane, NGT = NGW * 64;
        for (int i = gt; i < 2 * 128 * 128; i += NGT) {
            const int w = i >> 14, e = i & 16383;
            const float v = P.in[w ? I_PK2 : I_PK1][e];
            ((bf16_t*)(ws + (w ? OFF_K2B : OFF_K1B)))[e] = (bf16_t)(pk2(v, 0.f) & 0xffff);
        }
        if (gt < 8) ((float*)(ws + OFF_ROPE_C))[gt] = powf(500000.0f, -(float)(2 * gt) / 16.0f) * 0.15915494309189535f;
        for (int i = gt; i < T; i += NGT) ((float*)(ws + OFF_RS2))[i] = 0.f;
        for (int i = gt; i < 8 * 8 * 16 * 64; i += NGT) ((float*)(ws + OFF_KMEAN))[i] = 0.f;
        if (gt < 2) ((unsigned*)(ws + 512 * 1024))[gt] = 0u;
        for (int it = 0; it < 128; ++it) {
            if ((it * 16 + 5) % NGW != gw) continue;
            const int w = it >> 6, j4 = (it & 63) * 4;
            const float* pos = P.in[w ? I_CPV : I_CPK] + lane;
            const float* w1 = P.in[w ? I_CVW1 : I_CKW1] + (size_t)lane * 256 + j4;
            f32x4 rowv[32]; float pv[32];
#pragma unroll
            for (int k = 0; k < 32; ++k) { rowv[k] = *(const f32x4*)(w1 + (size_t)k * 64 * 256); pv[k] = pos[64 * k]; }
            f32x4 s4 = {0.f, 0.f, 0.f, 0.f};
#pragma unroll
            for (int k = 0; k < 32; ++k) s4 += rowv[k] * pv[k];
            s4.x = wave_sum(s4.x); s4.y = wave_sum(s4.y); s4.z = wave_sum(s4.z); s4.w = wave_sum(s4.w);
            if (lane == 0) *(f32x4*)((float*)(ws + OFF_POSB) + w * 256 + j4) = s4 + *(const f32x4*)(P.in[w ? I_CVB1 : I_CKB1] + j4);
        }
    }
}

constexpr int G_BM = 256, G_BN = 128, G_BK = 64;
constexpr int G_ABYTES = G_BM * 128, G_BBYTES = G_BN * 128, G_STAGE = G_ABYTES + G_BBYTES;

__device__ __forceinline__ void gemm_kloop(f32x4 (&acc)[4][4], const bf16_t* A, size_t lda, const bf16_t* Bt, size_t ldb, int K, LDSP unsigned char* lds) {
    const int tid = opaque_tid(), lane = tid & 63, wid = tid >> 6, wm = wid >> 1, wn = wid & 1, fr = lane & 15, fq = lane >> 4;
    const int lrow = tid >> 3, lch = tid & 7;
    const bf16_t* ga = A + (size_t)lrow * lda + lch * 8;
    const bf16_t* gb = Bt + (size_t)lrow * ldb + lch * 8;
    u32x4 ra[4], rb[2];
    const int nk = K / G_BK;
#pragma unroll
    for (int p = 0; p < 4; ++p) ra[p] = *(const u32x4*)(ga + (size_t)(64 * p) * lda);
#pragma unroll
    for (int p = 0; p < 2; ++p) rb[p] = *(const u32x4*)(gb + (size_t)(64 * p) * ldb);
    __syncthreads();
#pragma unroll
    for (int p = 0; p < 4; ++p) *(LDSP u32x4*)(lds + swz_off(lrow + 64 * p, lch)) = ra[p];
#pragma unroll
    for (int p = 0; p < 2; ++p) *(LDSP u32x4*)(lds + G_ABYTES + swz_off(lrow + 64 * p, lch)) = rb[p];
    __syncthreads();
    for (int kt = 0; kt < nk; ++kt) {
        LDSP unsigned char* cur = lds + (kt & 1) * G_STAGE;
        LDSP unsigned char* nxt = lds + ((kt + 1) & 1) * G_STAGE;
        if (kt + 1 < nk) {
#pragma unroll
            for (int p = 0; p < 4; ++p) ra[p] = *(const u32x4*)(ga + (size_t)(64 * p) * lda + (kt + 1) * G_BK);
#pragma unroll
            for (int p = 0; p < 2; ++p) rb[p] = *(const u32x4*)(gb + (size_t)(64 * p) * ldb + (kt + 1) * G_BK);
        }
#pragma unroll
        for (int ks = 0; ks < 2; ++ks) {
            bf16x8 af[4], bfr[4];
#pragma unroll
            for (int m = 0; m < 4; ++m) af[m] = *(const LDSP bf16x8*)(cur + swz_off(wm * 64 + m * 16 + fr, ks * 4 + fq));
#pragma unroll
            for (int n = 0; n < 4; ++n) bfr[n] = *(const LDSP bf16x8*)(cur + G_ABYTES + swz_off(wn * 64 + n * 16 + fr, ks * 4 + fq));
#pragma unroll
            for (int m = 0; m < 4; ++m)
#pragma unroll
                for (int n = 0; n < 4; ++n) acc[m][n] = __builtin_amdgcn_mfma_f32_16x16x32_bf16(bfr[n], af[m], acc[m][n], 0, 0, 0);
        }
        if (kt + 1 < nk) {
#pragma unroll
            for (int p = 0; p < 4; ++p) *(LDSP u32x4*)(nxt + swz_off(lrow + 64 * p, lch)) = ra[p];
#pragma unroll
            for (int p = 0; p < 2; ++p) *(LDSP u32x4*)(nxt + G_ABYTES + swz_off(lrow + 64 * p, lch)) = rb[p];
        }
        __syncthreads();
    }
}

__device__ __forceinline__ void zero_acc(f32x4 (&acc)[4][4]) {
#pragma unroll
    for (int m = 0; m < 4; ++m)
#pragma unroll
        for (int n = 0; n < 4; ++n) acc[m][n] = (f32x4){0.f, 0.f, 0.f, 0.f};
}

__device__ __forceinline__ bool tile_order(int it, int vcu, int G, int nM, int nN, int& tm, int& tn) {
    if (G == 256 && (nM % 32) == 0) {
        const int xcd = vcu >> 5, cu = vcu & 31, mper = nM / 8;
        const int L = it * 32 + cu, per_group = 4 * nN;
        if (L >= mper * nN) return false;
        const int mg = L / per_group, rem = L % per_group;
        tm = xcd * mper + mg * 4 + (rem & 3); tn = rem >> 2;
        return true;
    }
    const int L = it * G + vcu;
    if (L >= nM * nN) return false;
    tm = L / nN; tn = L % nN;
    return true;
}

namespace pg8 {
constexpr int BM = 256, BK = 64, HALF = 128, HTB = HALF * BK * 2, NXCD = 8, WGM = 8;
__device__ __forceinline__ int lds_byte(int r, int c) { const int st = (r >> 4) * 2 + (c >> 5), rr = r & 15, cc = c & 31, ob = rr * 64 + cc * 2; return st * 1024 + (ob ^ (((ob >> 9) & 1) << 5)); }
__device__ __forceinline__ void stage_rc(int b, int& R, int& C) { const int st = b / 1024, sb = b % 1024, swz = sb ^ (((sb >> 9) & 1) << 5); R = (st >> 1) * 16 + swz / 64; C = (st & 1) * 32 + (swz % 64) / 2; }
__device__ __forceinline__ int perm32(int rho) { const int n = rho >> 4, i = rho & 15; return 8 * (i >> 2) + 4 * n + (i & 3); }
struct Unit { int pm, pn, z; };
__device__ __forceinline__ bool tile_of(int L, int nM, int nN, int& pm, int& pn) {
    const int nwg = nM * nN; if (L >= nwg) return false;
    int wgid = L; { const int q = nwg / NXCD, r = nwg % NXCD, xcd = wgid % NXCD, off = wgid / NXCD; wgid = (xcd < r ? xcd * (q + 1) : r * (q + 1) + (xcd - r) * q) + off; }
    const int nig = WGM * nN, gid = wgid / nig, fm = gid * WGM, gsz = (nM - fm) < WGM ? (nM - fm) : WGM;
    pm = fm + ((wgid % nig) % gsz); pn = (wgid % nig) / gsz; return true;
}
struct Sched {
    const bf16_t *A0, *A1, *B0, *B1; size_t lda, ldb; int K, nM, nN, NZ, G, c;
    __device__ __forceinline__ bool next(int i, Unit& u) const { u.z = (NZ == 2) ? (i & 1) : 0; const int ti = (NZ == 2) ? (i >> 1) : i; return tile_of(ti * G + c, nM, nN, u.pm, u.pn); }
    __device__ __forceinline__ const char* aptr(const Unit& u) const { return (const char*)((u.z ? A1 : A0) + (size_t)u.pm * BM * lda); }
    __device__ __forceinline__ const char* bptr(const Unit& u) const { return (const char*)((u.z ? B1 : B0) + (size_t)u.pn * BM * ldb); }
};
template <class Epi>
__device__ __forceinline__ void gemm_phase(LDSP unsigned char* lds, const Sched& S, const Epi& E) {
    const int tid = opaque_tid(), wid = __builtin_amdgcn_readfirstlane(tid >> 6), lane = tid & 63, wr = wid >> 2, wc = wid & 3, fr = lane & 15, fq = lane >> 4;
    const int nt = S.K / BK;
    unsigned voffA[2], voffB[2];
#pragma unroll
    for (int i = 0; i < 2; ++i) { int R, C; stage_rc(tid * 16 + i * 8192, R, C); const int Rb = (R & ~31) + perm32(R & 31);
        voffA[i] = (unsigned)(R * S.lda + C) * 2u; voffB[i] = (unsigned)(Rb * S.ldb + C) * 2u; }
    const size_t kstep = (size_t)(BK * 2);
    const size_t hstepA = (size_t)HALF * S.lda * 2, hstepB = (size_t)HALF * S.ldb * 2;
    const unsigned ldsw = (unsigned)wid * 1024u;
    const int aoff = lds_byte(wr * 64 + fr, fq * 8), boff = lds_byte(wc * 32 + fr, fq * 8);
#define PG8_SA(b, h) (((b) * 2 + (h)) * HTB)
#define PG8_SB(b, h) ((4 + (b) * 2 + (h)) * HTB)
#define PG8_STAGE(bufoff, gbase, voff) do { _Pragma("unroll") for (int _i = 0; _i < 2; ++_i) \
        __builtin_amdgcn_global_load_lds((const unsigned*)((const char*)(gbase) + (voff)[_i]), (LDSP unsigned*)(lds + (bufoff) + ldsw + _i * 8192), 16, 0, 0); } while (0)
#define PG8_LDA(dst, b, h) do { _Pragma("unroll") for (int m = 0; m < 4; ++m) _Pragma("unroll") for (int k = 0; k < 2; ++k) dst[m][k] = *(const LDSP bf16x8*)(lds + PG8_SA(b, h) + aoff + m * 2048 + k * 1024); } while (0)
#define PG8_LDB(dst, b, h) do { _Pragma("unroll") for (int n = 0; n < 2; ++n) _Pragma("unroll") for (int k = 0; k < 2; ++k) dst[n][k] = *(const LDSP bf16x8*)(lds + PG8_SB(b, h) + boff + n * 2048 + k * 1024); } while (0)
#define PG8_MMA(ai, bj, At, Bt) do { __builtin_amdgcn_s_setprio(1); _Pragma("unroll") for (int m = 0; m < 4; ++m) _Pragma("unroll") for (int n = 0; n < 2; ++n) _Pragma("unroll") for (int k = 0; k < 2; ++k) \
        acc[ai][bj][m][n] = __builtin_amdgcn_mfma_f32_16x16x32_bf16(Bt[n][k], At[m][k], acc[ai][bj][m][n], 0, 0, 0); __builtin_amdgcn_s_setprio(0); } while (0)
#define PG8_WAIT_V(n) asm volatile("s_waitcnt vmcnt(" #n ")" ::: "memory")
#define PG8_WAIT_L(n) asm volatile("s_waitcnt lgkmcnt(" #n ")" ::: "memory")
#define PG8_BAR __builtin_amdgcn_s_barrier()
#define PG8_SCHED __builtin_amdgcn_sched_barrier(0)
    Unit cur, nxt; int ui = 0;
    if (!S.next(0, cur)) return;
    f32x4 acc[2][2][4][2];
#pragma unroll
    for (int a = 0; a < 2; ++a)
#pragma unroll
        for (int b = 0; b < 2; ++b)
#pragma unroll
            for (int m = 0; m < 4; ++m)
#pragma unroll
                for (int n = 0; n < 2; ++n) acc[a][b][m][n] = (f32x4){0.f, 0.f, 0.f, 0.f};
    bf16x8 At[4][2], B0[2][2], B1[2][2];
    const char* cA = S.aptr(cur); const char* cB = S.bptr(cur);
    PG8_STAGE(PG8_SB(0, 0), cB, voffB); PG8_STAGE(PG8_SB(0, 1), cB + hstepB, voffB); PG8_STAGE(PG8_SA(0, 0), cA, voffA); PG8_STAGE(PG8_SA(0, 1), cA + hstepA, voffA);
    if (wr == 1) PG8_BAR;
    PG8_WAIT_V(2); PG8_BAR;
    PG8_STAGE(PG8_SB(1, 0), cB + kstep, voffB); PG8_STAGE(PG8_SA(1, 0), cA + kstep, voffA); PG8_STAGE(PG8_SB(1, 1), cB + hstepB + kstep, voffB);
    PG8_WAIT_V(6); PG8_BAR;
    for (;;) {
        const bool has_next = S.next(ui + 1, nxt);
        const char* nA = has_next ? S.aptr(nxt) : cA; const char* nB = has_next ? S.bptr(nxt) : cB;
        for (int t = 0; t < nt; t += 2) {
            const bool last = (t == nt - 2);
            const char* a1 = cA + (size_t)(t + 1) * kstep;
            const char* a2 = last ? nA : cA + (size_t)(t + 2) * kstep; const char* b2 = last ? nB : cB + (size_t)(t + 2) * kstep;
            const char* a3 = a2 + kstep; const char* b3 = b2 + kstep;
            PG8_LDB(B0, 0, 0); PG8_LDB(B1, 0, 1); PG8_SCHED; PG8_LDA(At, 0, 0); PG8_STAGE(PG8_SA(1, 1), a1 + hstepA, voffA);
            PG8_WAIT_V(8); PG8_WAIT_L(0); PG8_BAR; PG8_MMA(0, 0, At, B0); PG8_MMA(0, 1, At, B1); PG8_BAR; PG8_SCHED;
            PG8_LDA(At, 0, 1); PG8_STAGE(PG8_SB(0, 0), b2, voffB); PG8_STAGE(PG8_SB(0, 1), b2 + hstepB, voffB); PG8_STAGE(PG8_SA(0, 0), a2, voffA);
            PG8_WAIT_V(8); PG8_WAIT_L(0); PG8_BAR; PG8_MMA(1, 0, At, B0); PG8_MMA(1, 1, At, B1); PG8_BAR; PG8_SCHED;
            PG8_LDB(B0, 1, 0); PG8_LDB(B1, 1, 1); PG8_SCHED; PG8_LDA(At, 1, 0); PG8_STAGE(PG8_SA(0, 1), a2 + hstepA, voffA);
            PG8_WAIT_V(8); PG8_WAIT_L(0); PG8_BAR; PG8_MMA(0, 0, At, B0); PG8_MMA(0, 1, At, B1); PG8_BAR; PG8_SCHED;
            PG8_LDA(At, 1, 1); PG8_STAGE(PG8_SB(1, 0), b3, voffB); PG8_STAGE(PG8_SB(1, 1), b3 + hstepB, voffB); PG8_STAGE(PG8_SA(1, 0), a3, voffA);
            PG8_WAIT_V(8); PG8_WAIT_L(0); PG8_BAR; PG8_MMA(1, 0, At, B0); PG8_MMA(1, 1, At, B1); PG8_BAR; PG8_SCHED;
        }
        if (wr == 0) PG8_BAR;
        E(acc, cur, wr, wc, fr, fq);
        if (!has_next) break;
#pragma unroll
        for (int a = 0; a < 2; ++a)
#pragma unroll
            for (int b = 0; b < 2; ++b)
#pragma unroll
                for (int m = 0; m < 4; ++m)
#pragma unroll
                    for (int n = 0; n < 2; ++n) acc[a][b][m][n] = (f32x4){0.f, 0.f, 0.f, 0.f};
        cur = nxt; cA = nA; cB = nB; ++ui;
        if (wr == 1) PG8_BAR;
    }
    PG8_WAIT_V(0);
    PG8_BAR;
#undef PG8_SA
#undef PG8_SB
#undef PG8_STAGE
#undef PG8_LDA
#undef PG8_LDB
#undef PG8_MMA
#undef PG8_WAIT_V
#undef PG8_WAIT_L
#undef PG8_BAR
#undef PG8_SCHED
}
}

struct EpiProj {
    const Params* P;
    __device__ __forceinline__ void operator()(f32x4 (&acc)[2][2][4][2], const pg8::Unit& u, int wr, int wc, int fr, int fq) const {
        unsigned char* ws = P->ws;
        const int H = 4 * u.pn + wc;
        if (H > 76) return;
        const float* rs1 = (const float*)(ws + OFF_RS1);
        int kind; bf16_t* dst = nullptr; int pitch = 0, cb = 0; const float* gain = nullptr; float oscale = 1.f; bool slab = false; int sg = 0;
        if (H < 8)        { kind = 1; dst = (bf16_t*)(ws + OFF_R1);            pitch = 512; cb = H * 64;        gain = P->in[I_AQG]; oscale = QSCALE; }
        else if (H < 16)  { kind = 1; dst = (bf16_t*)(ws + OFF_R1 + 32 * MiB); pitch = 512; cb = (H - 8) * 64;  gain = P->in[I_AKG]; }
        else if (H < 24)  { kind = 0; dst = (bf16_t*)(ws + OFF_R1 + 64 * MiB); pitch = 512; cb = (H - 16) * 64; }
        else if (H < 32)  { kind = 1; dst = (bf16_t*)(ws + OFF_R1 + 96 * MiB); pitch = 512; cb = (H - 24) * 64; gain = P->in[I_BQG]; oscale = QSCALE; }
        else if (H < 34)  { kind = 0; dst = (bf16_t*)(ws + OFF_R2);            slab = true; sg = H - 32; }
        else if (H < 36)  { kind = 0; dst = (bf16_t*)(ws + OFF_R2 + 8 * MiB);  slab = true; sg = H - 34; }
        else if (H < 38)  { kind = 1; dst = (bf16_t*)(ws + OFF_R2 + 16 * MiB); pitch = 128; cb = (H - 36) * 64; gain = P->in[I_BKSG]; }
        else if (H < 40)  { kind = 0; dst = (bf16_t*)(ws + OFF_R2 + 24 * MiB); pitch = 128; cb = (H - 38) * 64; }
        else if (H < 42)  { kind = 1; dst = (bf16_t*)(ws + OFF_R2 + 32 * MiB); pitch = 128; cb = (H - 40) * 64; gain = P->in[I_BKWG]; }
        else if (H < 44)  { kind = 0; dst = (bf16_t*)(ws + OFF_R2 + 40 * MiB); pitch = 128; cb = (H - 42) * 64; }
        else if (H < 76)  { kind = 2; dst = (bf16_t*)(ws + OFF_R3);            pitch = 2048; cb = (H - 44) * 64; }
        else              { kind = 3; }
        f32x4 invrev[2] = {{0.f, 0.f, 0.f, 0.f}, {0.f, 0.f, 0.f, 0.f}};
        if (kind == 1) { invrev[0] = *(const f32x4*)((const float*)(ws + OFF_ROPE_C)); invrev[1] = *(const f32x4*)((const float*)(ws + OFF_ROPE_C) + 4); }
        float rsr[2][4];
#pragma unroll
        for (int ai = 0; ai < 2; ++ai)
#pragma unroll
            for (int m = 0; m < 4; ++m) rsr[ai][m] = rs1[u.pm * 256 + ai * 128 + wr * 64 + m * 16 + fr];
        f32x4 gv[2][2];
        if (kind == 1 || kind == 2) {
            const float* gp = (kind == 1) ? gain : P->in[I_BMERGE] + cb;
#pragma unroll
            for (int bj = 0; bj < 2; ++bj)
#pragma unroll
                for (int n = 0; n < 2; ++n) gv[bj][n] = *(const f32x4*)(gp + 32 * bj + 8 * fq + 4 * n);
        }
        const bool ksum = (H >= 8 && H < 16);
        f32x4 cs[2][2];
#pragma unroll
        for (int bj = 0; bj < 2; ++bj)
#pragma unroll
            for (int n = 0; n < 2; ++n) cs[bj][n] = (f32x4){0.f, 0.f, 0.f, 0.f};
#pragma unroll
        for (int ai = 0; ai < 2; ++ai)
#pragma unroll
            for (int m = 0; m < 4; ++m) {
                const int row = u.pm * 256 + ai * 128 + wr * 64 + m * 16 + fr;
                const float rs = rsr[ai][m];
                f32x4 v[2][2];
#pragma unroll
                for (int bj = 0; bj < 2; ++bj)
#pragma unroll
                    for (int n = 0; n < 2; ++n) v[bj][n] = acc[ai][bj][m][n] * rs;
                if (kind == 1) {
                    float ss = 0.f;
#pragma unroll
                    for (int bj = 0; bj < 2; ++bj)
#pragma unroll
                        for (int n = 0; n < 2; ++n) ss += (v[bj][n][0] * v[bj][n][0] + v[bj][n][1] * v[bj][n][1]) + (v[bj][n][2] * v[bj][n][2] + v[bj][n][3] * v[bj][n][3]);
                    ss = sum_xor16(ss); ss = sum_xor32(ss);
                    const float r = oscale * __builtin_amdgcn_rsqf(ss * (1.0f / 64.0f) + NORM_EPS);
#pragma unroll
                    for (int bj = 0; bj < 2; ++bj)
#pragma unroll
                        for (int n = 0; n < 2; ++n) v[bj][n] = v[bj][n] * gv[bj][n] * r;
                    const float posf = (float)(row & (SEQ - 1));
                    const float sgn = (fq == 0) ? -1.f : 1.f;
#pragma unroll
                    for (int n = 0; n < 2; ++n) {
                        const f32x4 me = v[0][n]; f32x4 ot, ro;
#pragma unroll
                        for (int i = 0; i < 4; ++i) ot[i] = get_xor16(me[i], fq & 1);
#pragma unroll
                        for (int i = 0; i < 4; ++i) { const float rev = __builtin_amdgcn_fractf(posf * invrev[n][i]); ro[i] = me[i] * __builtin_amdgcn_cosf(rev) + sgn * ot[i] * __builtin_amdgcn_sinf(rev); }
                        if (fq < 2) v[0][n] = ro;
                    }
                    if (ksum) {
#pragma unroll
                        for (int bj = 0; bj < 2; ++bj)
#pragma unroll
                            for (int n = 0; n < 2; ++n) cs[bj][n] += v[bj][n];
                    }
                } else if (kind == 2) {
#pragma unroll
                    for (int bj = 0; bj < 2; ++bj)
#pragma unroll
                        for (int n = 0; n < 2; ++n)
#pragma unroll
                            for (int i = 0; i < 4; ++i) v[bj][n][i] = sigmoidf_(v[bj][n][i] + gv[bj][n][i]);
                }
                if (kind == 3) {
                    float* bg = (float*)(ws + OFF_BGATE) + (size_t)row * 24;
                    if (fq < 3) {
#pragma unroll
                        for (int n = 0; n < 2; ++n) { f32x4 o; o.x = sigmoidf_(v[0][n][0]); o.y = sigmoidf_(v[0][n][1]); o.z = sigmoidf_(v[0][n][2]); o.w = sigmoidf_(v[0][n][3]); *(f32x4*)(bg + 8 * fq + 4 * n) = o; }
                    }
                } else {
                    bf16_t* rp;
                    if (slab) { const int b = row >> 12, s = row & (SEQ - 1); rp = dst + ((size_t)((b * 2 + sg) * SEQ + s)) * 64 + 8 * fq; }
                    else rp = dst + (size_t)row * pitch + cb + 8 * fq;
#pragma unroll
                    for (int bj = 0; bj < 2; ++bj) {
                        u32x4 w; w.x = pk2(v[bj][0][0], v[bj][0][1]); w.y = pk2(v[bj][0][2], v[bj][0][3]); w.z = pk2(v[bj][1][0], v[bj][1][1]); w.w = pk2(v[bj][1][2], v[bj][1][3]);
                        *(u32x4*)(rp + 32 * bj) = w;
                    }
                }
            }
        if (ksum) {
            float* km = (float*)(ws + OFF_KMEAN) + (size_t)(((u.pm >> 4) * 8 + (H - 8)) * 16 + (u.pm & 15)) * 64;
#pragma unroll
            for (int bj = 0; bj < 2; ++bj)
#pragma unroll
                for (int n = 0; n < 2; ++n)
#pragma unroll
                    for (int i = 0; i < 4; ++i) {
                        float t = cs[bj][n][i];
                        t += __shfl_xor(t, 1); t += __shfl_xor(t, 2); t += __shfl_xor(t, 4); t += __shfl_xor(t, 8);
                        if (fr == 0) atomicAdd(km + 32 * bj + 8 * fq + 4 * n + i, t);
                    }
        }
    }
};
__device__ __forceinline__ void phase_proj(const Params& P, LDSP unsigned char* lds, int vcu, int G) {
    pg8::Sched S; S.A0 = S.A1 = (const bf16_t*)(P.ws + OFF_R0); S.B0 = S.B1 = (const bf16_t*)(P.ws + OFF_WIN_T);
    S.lda = DM; S.ldb = DM; S.K = DM; S.nM = T / 256; S.nN = NPROJ / 256; S.NZ = 1; S.G = G; S.c = blockIdx.x;
    EpiProj E{&P};
    pg8::gemm_phase(lds, S, E);
}

constexpr size_t OFF_CPART = OFF_EXPERTS;
constexpr size_t CPART_STRIDE = (size_t)2 * 4096 * 256;
__device__ __forceinline__ void phase_cmp1(const Params& P, LDSP unsigned char* lds, int vcu, int G) {
    unsigned char* ws = P.ws;
    const int tid = opaque_tid(), lane = tid & 63, wid = tid >> 6, wm = wid >> 1, wn = wid & 1, fr = lane & 15, fq = lane >> 4;
    for (int item = vcu; item < 256; item += G) {
        const int kc = item & 3, tn = (item >> 2) & 1, tm = (item >> 3) & 15, kv = item >> 7;
        const bf16_t* A = (const bf16_t*)(ws + OFF_R2 + (size_t)kv * 8 * MiB) + (size_t)tm * SEQ * 64 + kc * 512;
        const bf16_t* Bt = (const bf16_t*)(ws + (kv ? OFF_W1V_T : OFF_W1K_T)) + (size_t)tn * G_BN * 2048 + kc * 512;
        float* part = (float*)(ws + OFF_CPART) + (size_t)kc * CPART_STRIDE + (size_t)kv * 4096 * 256;
        f32x4 acc[4][4];
        zero_acc(acc);
        gemm_kloop(acc, A, 1024, Bt, 2048, 512, lds);
        const int row0 = tm * 256 + wm * 64 + fr, col0 = tn * 128 + wn * 64 + 4 * fq;
#pragma unroll
        for (int m = 0; m < 4; ++m)
#pragma unroll
            for (int n = 0; n < 4; ++n) *(f32x4*)(part + (size_t)(row0 + m * 16) * 256 + col0 + n * 16) = acc[m][n];
    }
}

__device__ __forceinline__ u32x4 load_hid8(const float* part, const float* posb, size_t rowoff, int k) {
    f32x4 a = *(const f32x4*)(posb + k), b = *(const f32x4*)(posb + k + 4);
#pragma unroll
    for (int c = 0; c < 4; ++c) { a += *(const f32x4*)(part + c * CPART_STRIDE + rowoff + k); b += *(const f32x4*)(part + c * CPART_STRIDE + rowoff + k + 4); }
    u32x4 o; o.x = pk2(gelu_tanh(a.x), gelu_tanh(a.y)); o.y = pk2(gelu_tanh(a.z), gelu_tanh(a.w)); o.z = pk2(gelu_tanh(b.x), gelu_tanh(b.y)); o.w = pk2(gelu_tanh(b.z), gelu_tanh(b.w));
    return o;
}
__device__ __forceinline__ void phase_cmp2(const Params& P, LDSP unsigned char* lds, int vcu, int G) {
    unsigned char* ws = P.ws;
    const int tid = opaque_tid(), lane = tid & 63, wid = tid >> 6, wm = wid >> 1, wn = wid & 1, fr = lane & 15, fq = lane >> 4;
    const int lrow = tid >> 3, lch = tid & 7;
    for (int item = vcu; item < 32; item += G) {
        const int kv = item >> 4, tm = item & 15;
        const float* part = (const float*)(ws + OFF_CPART) + (size_t)kv * 4096 * 256 + (size_t)tm * 256 * 256;
        const float* posb = (const float*)(ws + OFF_POSB) + kv * 256;
        const bf16_t* Bt = (const bf16_t*)(ws + (kv ? OFF_W2V_T : OFF_W2K_T));
        const float* b2 = P.in[kv ? I_CVB2 : I_CKB2];
        bf16_t* dst = (bf16_t*)(ws + (kv ? OFF_VC : OFF_KC)) + (size_t)tm * 256 * 64;
        f32x4 acc[4][4];
        zero_acc(acc);
        {
            const bf16_t* gb = Bt + (size_t)lrow * 256 + lch * 8;
            u32x4 ra[4], rb[2];
#pragma unroll
            for (int p = 0; p < 4; ++p) ra[p] = load_hid8(part, posb, (size_t)(lrow + 64 * p) * 256, lch * 8);
#pragma unroll
            for (int p = 0; p < 2; ++p) rb[p] = *(const u32x4*)(gb + (size_t)(64 * p) * 256);
            __syncthreads();
#pragma unroll
            for (int p = 0; p < 4; ++p) *(LDSP u32x4*)(lds + swz_off(lrow + 64 * p, lch)) = ra[p];
#pragma unroll
            for (int p = 0; p < 2; ++p) *(LDSP u32x4*)(lds + G_ABYTES + swz_off(lrow + 64 * p, lch)) = rb[p];
            __syncthreads();
#pragma unroll 1
            for (int kt = 0; kt < 4; ++kt) {
                LDSP unsigned char* cur = lds + (kt & 1) * G_STAGE;
                LDSP unsigned char* nxt = lds + ((kt + 1) & 1) * G_STAGE;
                if (kt + 1 < 4) {
#pragma unroll
                    for (int p = 0; p < 4; ++p) ra[p] = load_hid8(part, posb, (size_t)(lrow + 64 * p) * 256, (kt + 1) * G_BK + lch * 8);
#pragma unroll
                    for (int p = 0; p < 2; ++p) rb[p] = *(const u32x4*)(gb + (size_t)(64 * p) * 256 + (kt + 1) * G_BK);
                }
#pragma unroll
                for (int ks = 0; ks < 2; ++ks) {
                    bf16x8 af[4], bfr[4];
#pragma unroll
                    for (int m = 0; m < 4; ++m) af[m] = *(const LDSP bf16x8*)(cur + swz_off(wm * 64 + m * 16 + fr, ks * 4 + fq));
#pragma unroll
                    for (int n = 0; n < 4; ++n) bfr[n] = *(const LDSP bf16x8*)(cur + G_ABYTES + swz_off(wn * 64 + n * 16 + fr, ks * 4 + fq));
#pragma unroll
                    for (int m = 0; m < 4; ++m)
#pragma unroll
                        for (int n = 0; n < 4; ++n) acc[m][n] = __builtin_amdgcn_mfma_f32_16x16x32_bf16(bfr[n], af[m], acc[m][n], 0, 0, 0);
                }
                if (kt + 1 < 4) {
#pragma unroll
                    for (int p = 0; p < 4; ++p) *(LDSP u32x4*)(nxt + swz_off(lrow + 64 * p, lch)) = ra[p];
#pragma unroll
                    for (int p = 0; p < 2; ++p) *(LDSP u32x4*)(nxt + G_ABYTES + swz_off(lrow + 64 * p, lch)) = rb[p];
                }
                __syncthreads();
            }
        }
        if (wn == 0) {
            float gv[4][4];
#pragma unroll
            for (int n = 0; n < 4; ++n) {
                const f32x4 bb = *(const f32x4*)(b2 + n * 16 + 4 * fq);
                const f32x4 g4 = kv ? (f32x4){1.f, 1.f, 1.f, 1.f} : *(const f32x4*)(P.in[I_BKCG] + n * 16 + 4 * fq);
                gv[n][0] = g4.x; gv[n][1] = g4.y; gv[n][2] = g4.z; gv[n][3] = g4.w;
#pragma unroll
                for (int m = 0; m < 4; ++m) acc[m][n] += bb;
            }
#pragma unroll
            for (int m = 0; m < 4; ++m) {
                float r = 1.f;
                if (kv == 0) {
                    float ss = 0.f;
#pragma unroll
                    for (int n = 0; n < 4; ++n) ss += (acc[m][n][0] * acc[m][n][0] + acc[m][n][1] * acc[m][n][1]) + (acc[m][n][2] * acc[m][n][2] + acc[m][n][3] * acc[m][n][3]);
                    ss += __shfl_xor(ss, 16); ss += __shfl_xor(ss, 32);
                    r = 1.0f / sqrtf(ss * (1.0f / 64.0f) + NORM_EPS);
                }
                const int row = wm * 64 + m * 16 + fr;
                if (row == 255) r = 0.f;
#pragma unroll
                for (int n = 0; n < 4; ++n) {
                    f32x4 o = acc[m][n];
                    if (row == 255) o = (f32x4){0.f, 0.f, 0.f, 0.f};
                    u32x2 w; w.x = pk2(o[0] * r * gv[n][0], o[1] * r * gv[n][1]); w.y = pk2(o[2] * r * gv[n][2], o[3] * r * gv[n][3]);
                    *(u32x2*)(dst + (size_t)row * 64 + n * 16 + 4 * fq) = w;
                }
            }
        }
    }
}

__device__ __forceinline__ void phase_cmp(const Params& P, LDSP unsigned char* lds, int vcu, int G) {
    unsigned char* ws = P.ws;
    const int tid = opaque_tid(), lane = tid & 63, r32 = lane & 31, hi = lane >> 5;
    const int wu = __builtin_amdgcn_readfirstlane(tid >> 6);
    for (int item = vcu; item < 256; item += G) {
        const int kv = item >> 7, bg = (item >> 3) & 15, rb = item & 7;
        const bf16_t* A = (const bf16_t*)(ws + OFF_R2 + (size_t)kv * 8 * MiB) + ((size_t)bg * SEQ + 512 * rb) * 64;
        const bf16_t* W1 = (const bf16_t*)(ws + (kv ? OFF_W1V_T : OFF_W1K_T)) + (size_t)(32 * wu + r32) * 2048 + 32 * hi;
        __syncthreads();
        for (int pc = wu; pc < 66; pc += 8) {
            const int g16 = pc >> 1, h8 = pc & 1, tau = 16 * g16 + 8 * h8 + (lane >> 3), c = (lane & 7) ^ ((g16 >> 1) & 7);
            __builtin_amdgcn_global_load_lds((const unsigned*)(A + (size_t)tau * 64 + c * 8), (LDSP unsigned*)(lds + (17 * g16 + 8 * h8) * 128), 16, 0, 0);
        }
        u32x4 Bq[8][4];
#pragma unroll
        for (int j = 0; j < 8; ++j)
#pragma unroll
            for (int i = 0; i < 4; ++i) Bq[j][i] = *(const u32x4*)(W1 + 64 * j + 8 * i);
        const int abase = 17 * r32 * 128;
        int aoff[2][4];
#pragma unroll
        for (int jh = 0; jh < 2; ++jh)
#pragma unroll
            for (int i = 0; i < 4; ++i) aoff[jh][i] = abase + ((((4 * hi + i) ^ (((r32 + jh) >> 1) & 7))) << 4);
        f32x16 acc;
#pragma unroll
        for (int r = 0; r < 16; ++r) acc[r] = 0.f;
        asm volatile("s_waitcnt vmcnt(32)" ::: "memory");
        __syncthreads();
#pragma unroll
        for (int j = 0; j < 32; ++j) {
#pragma unroll
            for (int i = 0; i < 4; ++i) {
                const bf16x8 xf = *(const LDSP bf16x8*)(lds + aoff[j >> 4][i] + (j + (j >> 4)) * 128);
                acc = __builtin_amdgcn_mfma_f32_32x32x16_bf16(__builtin_bit_cast(bf16x8, Bq[j & 7][i]), xf, acc, 0, 0, 0);
            }
            if (j + 8 < 32) {
#pragma unroll
                for (int i = 0; i < 4; ++i) Bq[j & 7][i] = *(const u32x4*)(W1 + 64 * (j + 8) + 8 * i);
            }
            __builtin_amdgcn_sched_barrier(0);
        }
        const float* posb = (const float*)(ws + OFF_POSB) + kv * 256 + 32 * wu + 4 * hi;
        u32x4 pw[2];
#pragma unroll
        for (int q = 0; q < 4; ++q) {
            const f32x4 pb = *(const f32x4*)(posb + 8 * q);
            const float h0 = gelu_tanh(acc[4 * q] + pb.x), h1 = gelu_tanh(acc[4 * q + 1] + pb.y), h2 = gelu_tanh(acc[4 * q + 2] + pb.z), h3 = gelu_tanh(acc[4 * q + 3] + pb.w);
            pw[q >> 1][(q & 1) * 2] = pk2(h0, h1); pw[q >> 1][(q & 1) * 2 + 1] = pk2(h2, h3);
        }
        const bf16_t* W2 = (const bf16_t*)(ws + (kv ? OFF_W2V_T : OFF_W2K_T)) + (size_t)r32 * 256 + 32 * wu + 4 * hi;
        f32x16 o2[2];
#pragma unroll
        for (int mb = 0; mb < 2; ++mb) {
#pragma unroll
            for (int r = 0; r < 16; ++r) o2[mb][r] = 0.f;
#pragma unroll
            for (int s2 = 0; s2 < 2; ++s2) {
                const u32x2 lo = *(const u32x2*)(W2 + (size_t)mb * 32 * 256 + 16 * s2), hh = *(const u32x2*)(W2 + (size_t)mb * 32 * 256 + 16 * s2 + 8);
                const u32x4 a2 = {lo.x, lo.y, hh.x, hh.y};
                o2[mb] = __builtin_amdgcn_mfma_f32_32x32x16_bf16(__builtin_bit_cast(bf16x8, a2), __builtin_bit_cast(bf16x8, pw[s2]), o2[mb], 0, 0, 0);
            }
        }
        __syncthreads();
        {
            LDSP float* part = (LDSP float*)lds + (size_t)(wu * 32 + r32) * 68 + 4 * hi;
#pragma unroll
            for (int mb = 0; mb < 2; ++mb)
#pragma unroll
                for (int q = 0; q < 4; ++q) *(LDSP f32x4*)(part + 32 * mb + 8 * q) = (f32x4){o2[mb][4 * q], o2[mb][4 * q + 1], o2[mb][4 * q + 2], o2[mb][4 * q + 3]};
        }
        __syncthreads();
        {
            const int row = tid >> 4, dq = tid & 15;
            f32x4 v = *(const f32x4*)(P.in[kv ? I_CVB2 : I_CKB2] + 4 * dq);
#pragma unroll
            for (int w = 0; w < 8; ++w) v += *(const LDSP f32x4*)((LDSP float*)lds + (size_t)(w * 32 + row) * 68 + 4 * dq);
            float rr = 1.f; f32x4 g4 = {1.f, 1.f, 1.f, 1.f};
            if (kv == 0) {
                float ss = (v.x * v.x + v.y * v.y) + (v.z * v.z + v.w * v.w);
                ss += __shfl_xor(ss, 1); ss += __shfl_xor(ss, 2); ss += __shfl_xor(ss, 4); ss += __shfl_xor(ss, 8);
                rr = 1.0f / sqrtf(ss * (1.0f / 64.0f) + NORM_EPS);
                g4 = *(const f32x4*)(P.in[I_BKCG] + 4 * dq);
            }
            const int grow = 32 * rb + row;
            u32x2 w2; w2.x = pk2(v.x * rr * g4.x, v.y * rr * g4.y); w2.y = pk2(v.z * rr * g4.z, v.w * rr * g4.w);
            if (grow == 255) w2 = (u32x2){0u, 0u};
            *(u32x2*)((bf16_t*)(ws + (kv ? OFF_VC : OFF_KC)) + ((size_t)bg * 256 + grow) * 64 + 4 * dq) = w2;
        }
    }
    __syncthreads();
}

constexpr int A_GS = 65536, A_ES = 81920, A_Y = 65536, A_MISC = 131072;
typedef short v4i16_t __attribute__((ext_vector_type(4)));
struct ASt { f32x16 o0, o1; float m, l; };
struct KVStage { u32x4 k, v; };
__device__ __forceinline__ void kv_load(KVStage& s, const bf16_t* Kg, const bf16_t* Vg, size_t pitch, int tid) {
    const int key = tid >> 3, ch = tid & 7;
    s.k = *(const u32x4*)(Kg + (size_t)key * pitch + ch * 8);
    s.v = *(const u32x4*)(Vg + (size_t)key * pitch + ch * 8);
}
__device__ __forceinline__ void kv_store(const KVStage& s, LDSP unsigned char* buf, int tid) {
    const int key = tid >> 3, ch = tid & 7;
    *(LDSP u32x4*)(buf + swz_off(key, ch)) = s.k;
    *(LDSP u32x4*)(buf + 8192 + ((ch >> 2) * 4 + (key >> 4)) * 1024 + (key & 15) * 64 + (ch & 3) * 16) = s.v;
}
__device__ __forceinline__ void kv_dma(const bf16_t* Kg, const bf16_t* Vg, size_t pitch, LDSP unsigned char* buf, int wid, int lane) {
    const int row = wid * 8 + (lane >> 3), chunk = (lane & 7) ^ ((row >> 1) & 7);
    __builtin_amdgcn_global_load_lds((const unsigned*)(Kg + (size_t)row * pitch + chunk * 8), (LDSP unsigned*)(buf + wid * 1024), 16, 0, 0);
    const int vrow = (wid & 3) * 16 + (lane >> 2), vcol = (wid >> 2) * 32 + (lane & 3) * 8;
    __builtin_amdgcn_global_load_lds((const unsigned*)(Vg + (size_t)vrow * pitch + vcol), (LDSP unsigned*)(buf + 8192 + wid * 1024), 16, 0, 0);
}
__device__ __forceinline__ float swap32f(float v) { return __shfl_xor(v, 32); }
__device__ __forceinline__ void ast_reset(ASt& st) {
#pragma unroll
    for (int r = 0; r < 16; ++r) { st.o0[r] = 0.f; st.o1[r] = 0.f; }
    st.m = 0.f; st.l = 0.f;
}
constexpr float ATT_THR = 8.0f;
template <int MODE>
__device__ __forceinline__ void attn_tile(ASt& st, const bf16x8 (&qf)[4], LDSP const unsigned char* kt, int lane, bool rowoff, int kl, int kh, bool need_mask,
                                          float linv, LDSP float* gs, LDSP float* es, int jbase, int ql) {
    const int r32 = lane & 31, hi = lane >> 5;
    const float cin = rowoff ? -INFINITY : -st.m;
    f32x16 p0, p1;
#pragma unroll
    for (int r = 0; r < 16; ++r) { p0[r] = cin; p1[r] = cin; }
#pragma unroll
    for (int d0 = 0; d0 < 4; ++d0) {
        const bf16x8 k0f = *(const LDSP bf16x8*)(kt + swz_off(r32, 2 * d0 + hi));
        const bf16x8 k1f = *(const LDSP bf16x8*)(kt + swz_off(r32 + 32, 2 * d0 + hi));
        p0 = __builtin_amdgcn_mfma_f32_32x32x16_bf16(k0f, qf[d0], p0, 0, 0, 0);
        p1 = __builtin_amdgcn_mfma_f32_32x32x16_bf16(k1f, qf[d0], p1, 0, 0, 0);
    }
    if (need_mask) {
        const int kl2 = kl - 4 * hi, kh2 = kh - 4 * hi;
#pragma unroll
        for (int r = 0; r < 16; ++r) {
            const int c = (r & 3) + 8 * (r >> 2);
            const bool v0 = c >= kl2 && c <= kh2, v1 = (c + 32) >= kl2 && (c + 32) <= kh2;
            p0[r] = v0 ? p0[r] : -INFINITY; p1[r] = v1 ? p1[r] : -INFINITY;
        }
    }
    if (MODE != 2) {
        float mx = fmaxf(fmaxf(p0[0], p1[0]), fmaxf(p0[1], p1[1]));
#pragma unroll
        for (int r = 2; r < 16; r += 2) mx = fmaxf(fmaxf(mx, fmaxf(p0[r], p1[r])), fmaxf(p0[r + 1], p1[r + 1]));
        mx = fmaxf(mx, swap32f(mx));
        if (__any(mx > ATT_THR)) {
            const float dl = (mx > ATT_THR) ? mx : 0.f;
            const float alpha = __builtin_amdgcn_exp2f(-dl);
            st.m += dl; st.l *= alpha;
#pragma unroll
            for (int r = 0; r < 16; ++r) { p0[r] -= dl; p1[r] -= dl; }
            if (MODE == 0) {
#pragma unroll
                for (int r = 0; r < 16; ++r) { st.o0[r] *= alpha; st.o1[r] *= alpha; }
            }
        }
    }
#pragma unroll
    for (int r = 0; r < 16; ++r) { p0[r] = __builtin_amdgcn_exp2f(p0[r]); p1[r] = __builtin_amdgcn_exp2f(p1[r]); }
    if (MODE != 2) {
        const f32x16 t = p0 + p1;
        st.l += ((t[0] + t[1]) + (t[2] + t[3])) + ((t[4] + t[5]) + (t[6] + t[7])) + (((t[8] + t[9]) + (t[10] + t[11])) + ((t[12] + t[13]) + (t[14] + t[15])));
    } else {
#pragma unroll
        for (int r = 0; r < 16; ++r) { p0[r] *= linv; p1[r] *= linv; }
#pragma unroll
        for (int qd = 0; qd < 4; ++qd) {
            float g0 = (p0[4 * qd] + p0[4 * qd + 1]) + (p0[4 * qd + 2] + p0[4 * qd + 3]), e0 = p0[4 * qd + 3];
            float g1 = (p1[4 * qd] + p1[4 * qd + 1]) + (p1[4 * qd + 2] + p1[4 * qd + 3]), e1 = p1[4 * qd + 3];
            g0 += __shfl_xor(g0, 1); g0 += __shfl_xor(g0, 2); e0 += __shfl_xor(e0, 1); e0 += __shfl_xor(e0, 2);
            g1 += __shfl_xor(g1, 1); g1 += __shfl_xor(g1, 2); e1 += __shfl_xor(e1, 1); e1 += __shfl_xor(e1, 2);
            if ((r32 & 3) == 0) {
                const int j = jbase + 2 * qd + hi;
                gs[ql * 64 + j] = g0; es[ql * 64 + j] = e0; gs[ql * 64 + j + 8] = g1; es[ql * 64 + j + 8] = e1;
            }
        }
    }
    if (MODE != 1) {
        u32x4 pw[4];
        pw[0] = (u32x4){pk2(p0[0], p0[1]), pk2(p0[2], p0[3]), pk2(p0[4], p0[5]), pk2(p0[6], p0[7])};
        pw[1] = (u32x4){pk2(p0[8], p0[9]), pk2(p0[10], p0[11]), pk2(p0[12], p0[13]), pk2(p0[14], p0[15])};
        pw[2] = (u32x4){pk2(p1[0], p1[1]), pk2(p1[2], p1[3]), pk2(p1[4], p1[5]), pk2(p1[6], p1[7])};
        pw[3] = (u32x4){pk2(p1[8], p1[9]), pk2(p1[10], p1[11]), pk2(p1[12], p1[13]), pk2(p1[14], p1[15])};
        LDSP const unsigned char* vb = kt + 8192 + ((lane >> 4) & 1) * 32 + (lane & 3) * 8 + (4 * hi + ((lane & 15) >> 2)) * 64;
#pragma unroll
        for (int ks = 0; ks < 4; ++ks) {
            const bf16x8 pf = __builtin_bit_cast(bf16x8, pw[ks]);
#pragma unroll
            for (int d0 = 0; d0 < 2; ++d0) {
                const v4i16_t lo = __builtin_amdgcn_ds_read_tr16_b64_v4i16((LDSP v4i16_t*)(vb + (d0 * 4 + ks) * 1024));
                const v4i16_t hh = __builtin_amdgcn_ds_read_tr16_b64_v4i16((LDSP v4i16_t*)(vb + (d0 * 4 + ks) * 1024 + 512));
                const bf16x8 vf = (bf16x8){lo[0], lo[1], lo[2], lo[3], hh[0], hh[1], hh[2], hh[3]};
                if (d0 == 0) st.o0 = __builtin_amdgcn_mfma_f32_32x32x16_bf16(vf, pf, st.o0, 0, 0, 0);
                else         st.o1 = __builtin_amdgcn_mfma_f32_32x32x16_bf16(vf, pf, st.o1, 0, 0, 0);
            }
            if (ks & 1) __builtin_amdgcn_sched_barrier(0);
        }
    }
}

#define KV_LOOP(NT, KPTR, VPTR, PITCH, ...) do { const int nt_ = (NT), np_ = (nt_ + 1) >> 1; KVStage sa_, sb_; __syncthreads(); \
    { const int i = 0; kv_load(sa_, (KPTR), (VPTR), (PITCH), tid); } { const int i = (nt_ > 1) ? 1 : 0; kv_load(sb_, (KPTR), (VPTR), (PITCH), tid); } \
    kv_store(sa_, lds, tid); kv_store(sb_, lds + 16384, tid); __syncthreads(); \
    _Pragma("unroll 1") for (int ip_ = 0; ip_ < np_; ++ip_) { LDSP unsigned char* cur0_ = lds + (ip_ & 1) * 32768; \
        if (ip_ + 1 < np_) { { const int i = 2 * ip_ + 2; kv_load(sa_, (KPTR), (VPTR), (PITCH), tid); } \
                             { const int i = (2 * ip_ + 3 < nt_) ? 2 * ip_ + 3 : 2 * ip_ + 2; kv_load(sb_, (KPTR), (VPTR), (PITCH), tid); } } \
        { const int i = 2 * ip_; LDSP unsigned char* cur = cur0_; __VA_ARGS__ } \
        if (2 * ip_ + 1 < nt_) { const int i = 2 * ip_ + 1; LDSP unsigned char* cur = cur0_ + 16384; __VA_ARGS__ } \
        if (ip_ + 1 < np_) { kv_store(sa_, lds + ((ip_ + 1) & 1) * 32768, tid); kv_store(sb_, lds + ((ip_ + 1) & 1) * 32768 + 16384, tid); } \
        __syncthreads(); } } while (0)

struct TP { bool rowoff, nm; int kl, kh; };
__device__ __forceinline__ void pair_kload(bf16x8 (&kf)[8], LDSP const unsigned char* kt, int r32, int hi) {
#pragma unroll
    for (int d0 = 0; d0 < 4; ++d0) {
        kf[2 * d0]     = *(const LDSP bf16x8*)(kt + swz_off(r32, 2 * d0 + hi));
        kf[2 * d0 + 1] = *(const LDSP bf16x8*)(kt + swz_off(r32 + 32, 2 * d0 + hi));
    }
}
__device__ __forceinline__ void pair_vload(bf16x8 (&vf)[8], LDSP const unsigned char* kt, int lane, int hi) {
    LDSP const unsigned char* vb = kt + 8192 + ((lane >> 4) & 1) * 32 + (lane & 3) * 8 + (4 * hi + ((lane & 15) >> 2)) * 64;
#pragma unroll
    for (int ks = 0; ks < 4; ++ks)
#pragma unroll
        for (int d0 = 0; d0 < 2; ++d0) {
            const v4i16_t lo = __builtin_amdgcn_ds_read_tr16_b64_v4i16((LDSP v4i16_t*)(vb + (d0 * 4 + ks) * 1024));
            const v4i16_t hh = __builtin_amdgcn_ds_read_tr16_b64_v4i16((LDSP v4i16_t*)(vb + (d0 * 4 + ks) * 1024 + 512));
            vf[2 * ks + d0] = (bf16x8){lo[0], lo[1], lo[2], lo[3], hh[0], hh[1], hh[2], hh[3]};
        }
}
#define PAIR_LDS_WAIT() do { asm volatile("s_waitcnt lgkmcnt(0)" ::: "memory"); __builtin_amdgcn_sched_barrier(0); } while (0)
__device__ __forceinline__ void pair_qk(f32x16& p0, f32x16& p1, float cin, const bf16x8 (&qf)[4], const bf16x8 (&kf)[8]) {
    f32x16 c16;
#pragma unroll
    for (int r = 0; r < 16; ++r) c16[r] = cin;
#pragma unroll
    for (int d0 = 0; d0 < 4; ++d0) {
        p0 = __builtin_amdgcn_mfma_f32_32x32x16_bf16(kf[2 * d0], qf[d0], d0 == 0 ? c16 : p0, 0, 0, 0);
        p1 = __builtin_amdgcn_mfma_f32_32x32x16_bf16(kf[2 * d0 + 1], qf[d0], d0 == 0 ? c16 : p1, 0, 0, 0);
    }
}
__device__ __forceinline__ void pair_sm(ASt& st, f32x16& p0, f32x16& p1, u32x4 (&pw)[4], const TP& t, float pend, int hi) {
    if (t.nm) {
        const int kl2 = t.kl - 4 * hi, kh2 = t.kh - 4 * hi;
#pragma unroll
        for (int r = 0; r < 16; ++r) {
            const int c = (r & 3) + 8 * (r >> 2);
            const bool v0 = c >= kl2 && c <= kh2, v1 = (c + 32) >= kl2 && (c + 32) <= kh2;
            p0[r] = v0 ? p0[r] : -INFINITY; p1[r] = v1 ? p1[r] : -INFINITY;
        }
    }
    float mx = fmaxf(fmaxf(p0[0], p1[0]), fmaxf(p0[1], p1[1]));
#pragma unroll
    for (int r = 2; r < 16; r += 2) mx = fmaxf(fmaxf(mx, fmaxf(p0[r], p1[r])), fmaxf(p0[r + 1], p1[r + 1]));
    { const auto rr = __builtin_amdgcn_permlane32_swap(__float_as_uint(mx), __float_as_uint(mx), false, false); mx = fmaxf(__uint_as_float(rr[0]), __uint_as_float(rr[1])); }
    mx -= pend;
    if (__any(mx > ATT_THR || pend != 0.f)) {
        const float dl = (mx > ATT_THR) ? mx : 0.f;
        const float alpha = __builtin_amdgcn_exp2f(-dl), sub = dl + pend;
        st.m += dl; st.l *= alpha;
#pragma unroll
        for (int r = 0; r < 16; ++r) { p0[r] -= sub; p1[r] -= sub; st.o0[r] *= alpha; st.o1[r] *= alpha; }
    }
#pragma unroll
    for (int r = 0; r < 16; ++r) { p0[r] = __builtin_amdgcn_exp2f(p0[r]); p1[r] = __builtin_amdgcn_exp2f(p1[r]); }
    const f32x16 tt = p0 + p1;
    st.l += ((tt[0] + tt[1]) + (tt[2] + tt[3])) + ((tt[4] + tt[5]) + (tt[6] + tt[7])) + (((tt[8] + tt[9]) + (tt[10] + tt[11])) + ((tt[12] + tt[13]) + (tt[14] + tt[15])));
    pw[0] = (u32x4){pk2(p0[0], p0[1]), pk2(p0[2], p0[3]), pk2(p0[4], p0[5]), pk2(p0[6], p0[7])};
    pw[1] = (u32x4){pk2(p0[8], p0[9]), pk2(p0[10], p0[11]), pk2(p0[12], p0[13]), pk2(p0[14], p0[15])};
    pw[2] = (u32x4){pk2(p1[0], p1[1]), pk2(p1[2], p1[3]), pk2(p1[4], p1[5]), pk2(p1[6], p1[7])};
    pw[3] = (u32x4){pk2(p1[8], p1[9]), pk2(p1[10], p1[11]), pk2(p1[12], p1[13]), pk2(p1[14], p1[15])};
}
__device__ __forceinline__ void pair_pv(ASt& st, const u32x4 (&pw)[4], const bf16x8 (&vf)[8]) {
#pragma unroll
    for (int ks = 0; ks < 4; ++ks) {
        const bf16x8 pf = __builtin_bit_cast(bf16x8, pw[ks]);
        st.o0 = __builtin_amdgcn_mfma_f32_32x32x16_bf16(vf[2 * ks], pf, st.o0, 0, 0, 0);
        st.o1 = __builtin_amdgcn_mfma_f32_32x32x16_bf16(vf[2 * ks + 1], pf, st.o1, 0, 0, 0);
    }
}
__device__ __forceinline__ void attn_pair(ASt& st, const bf16x8 (&qf)[4], LDSP const unsigned char* ka, LDSP const unsigned char* kb, int lane, const TP& ta, const TP& tb) {
    const int r32 = lane & 31, hi = lane >> 5;
    const float m0 = st.m;
    f32x16 a0, a1, b0, b1; u32x4 pwa[4], pwb[4];
    bf16x8 kfa[8], kfb[8], vf[8];
    pair_kload(kfa, ka, r32, hi); pair_kload(kfb, kb, r32, hi);
    PAIR_LDS_WAIT();
    pair_qk(a0, a1, ta.rowoff ? -INFINITY : -m0, qf, kfa);
    pair_qk(b0, b1, tb.rowoff ? -INFINITY : -m0, qf, kfb);
    pair_vload(vf, ka, lane, hi);
    __builtin_amdgcn_sched_barrier(0);
    pair_sm(st, a0, a1, pwa, ta, 0.f, hi);
    PAIR_LDS_WAIT();
    pair_pv(st, pwa, vf);
    __builtin_amdgcn_sched_barrier(0);
    pair_vload(vf, kb, lane, hi);
    __builtin_amdgcn_sched_barrier(0);
    pair_sm(st, b0, b1, pwb, tb, st.m - m0, hi);
    PAIR_LDS_WAIT();
    pair_pv(st, pwb, vf);
}
template <int I, bool MASK>
__device__ __forceinline__ void pair_exp_chunk(const f32x16& p0, const f32x16& p1, u32x4 (&pw)[4], float& sacc, int kl2, int kh2) {
    const f32x16& src = (I < 4) ? p0 : p1; constexpr int b = 4 * (I & 3);
    float x0 = src[b], x1 = src[b + 1], x2 = src[b + 2], x3 = src[b + 3];
    if (MASK) {
        constexpr int c0 = 8 * (b >> 2) + ((I < 4) ? 0 : 32);
        x0 = (c0 >= kl2 && c0 <= kh2) ? x0 : -INFINITY; x1 = (c0 + 1 >= kl2 && c0 + 1 <= kh2) ? x1 : -INFINITY;
        x2 = (c0 + 2 >= kl2 && c0 + 2 <= kh2) ? x2 : -INFINITY; x3 = (c0 + 3 >= kl2 && c0 + 3 <= kh2) ? x3 : -INFINITY;
    }
    const float e0 = __builtin_amdgcn_exp2f(x0), e1 = __builtin_amdgcn_exp2f(x1), e2 = __builtin_amdgcn_exp2f(x2), e3 = __builtin_amdgcn_exp2f(x3);
    sacc += (e0 + e1) + (e2 + e3);
    pw[I >> 1][(I & 1) * 2] = pk2(e0, e1); pw[I >> 1][(I & 1) * 2 + 1] = pk2(e2, e3);
}
#define PAIR_SB() __builtin_amdgcn_sched_barrier(0)
__device__ __forceinline__ bf16x8 vfrag_load(LDSP const unsigned char* vb, int idx) {
    const int off = ((idx & 1) * 4 + (idx >> 1)) * 1024;
    const v4i16_t lo = __builtin_amdgcn_ds_read_tr16_b64_v4i16((LDSP v4i16_t*)(vb + off));
    const v4i16_t hh = __builtin_amdgcn_ds_read_tr16_b64_v4i16((LDSP v4i16_t*)(vb + off + 512));
    return (bf16x8){lo[0], lo[1], lo[2], lo[3], hh[0], hh[1], hh[2], hh[3]};
}
template <bool MASK>
__device__ __forceinline__ void attn_pair_fast(ASt& st, const bf16x8 (&qf)[4], LDSP const unsigned char* ka, LDSP const unsigned char* kb, int lane, const TP& ta, const TP& tb) {
    const int r32 = lane & 31, hi = lane >> 5; const bool offa = ta.rowoff, offb = tb.rowoff;
    const int kla = ta.kl - 4 * hi, kha = ta.kh - 4 * hi, klb = tb.kl - 4 * hi, khb = tb.kh - 4 * hi;
    LDSP const unsigned char* vba = ka + 8192 + ((lane >> 4) & 1) * 32 + (lane & 3) * 8 + (4 * hi + ((lane & 15) >> 2)) * 64;
    LDSP const unsigned char* vbb = vba + (kb - ka);
    f32x16 a0, a1, b0, b1; u32x4 pwa[4], pwb[4];
    bf16x8 kfa[8], kfb[8], vfa[8], vfb[8];
    pair_kload(kfa, ka, r32, hi);
    { f32x16 c16; const float cina = offa ? -INFINITY : -st.m;
#pragma unroll
      for (int r = 0; r < 16; ++r) c16[r] = cina;
      asm volatile("s_waitcnt lgkmcnt(0)" ::: "memory"); PAIR_SB();
#define QKA_STEP(I) do { if ((I) & 1) a1 = __builtin_amdgcn_mfma_f32_32x32x16_bf16(kfa[I], qf[(I) >> 1], (I) == 1 ? c16 : a1, 0, 0, 0); \
                         else         a0 = __builtin_amdgcn_mfma_f32_32x32x16_bf16(kfa[I], qf[(I) >> 1], (I) == 0 ? c16 : a0, 0, 0, 0); \
                         kfb[I] = *(const LDSP bf16x8*)(kb + swz_off(r32 + 32 * ((I) & 1), 2 * ((I) >> 1) + hi)); PAIR_SB(); } while (0)
      QKA_STEP(0); QKA_STEP(1); QKA_STEP(2); QKA_STEP(3); QKA_STEP(4); QKA_STEP(5); QKA_STEP(6); QKA_STEP(7);
#undef QKA_STEP
    }
    float sa = 0.f, sbm = 0.f;
    { f32x16 c16; const float cinb = offb ? -INFINITY : -st.m;
#pragma unroll
      for (int r = 0; r < 16; ++r) c16[r] = cinb;
      asm volatile("s_waitcnt lgkmcnt(0)" ::: "memory"); PAIR_SB();
#define QKB_STEP(I) do { if ((I) & 1) b1 = __builtin_amdgcn_mfma_f32_32x32x16_bf16(kfb[I], qf[(I) >> 1], (I) == 1 ? c16 : b1, 0, 0, 0); \
                         else         b0 = __builtin_amdgcn_mfma_f32_32x32x16_bf16(kfb[I], qf[(I) >> 1], (I) == 0 ? c16 : b0, 0, 0, 0); \
                         if ((I) >= 4) vfa[(I) - 4] = vfrag_load(vba, (I) - 4); \
                         pair_exp_chunk<I, MASK>(a0, a1, pwa, sa, kla, kha); PAIR_SB(); } while (0)
      QKB_STEP(0); QKB_STEP(1); QKB_STEP(2); QKB_STEP(3); QKB_STEP(4); QKB_STEP(5); QKB_STEP(6); QKB_STEP(7);
#undef QKB_STEP
    }
    asm volatile("s_waitcnt lgkmcnt(0)" ::: "memory"); PAIR_SB();
#define PVA_STEP(I) do { if ((I) & 1) st.o1 = __builtin_amdgcn_mfma_f32_32x32x16_bf16(vfa[I], __builtin_bit_cast(bf16x8, pwa[(I) >> 1]), st.o1, 0, 0, 0); \
                         else         st.o0 = __builtin_amdgcn_mfma_f32_32x32x16_bf16(vfa[I], __builtin_bit_cast(bf16x8, pwa[(I) >> 1]), st.o0, 0, 0, 0); \
                         if ((I) < 4) vfa[(I) + 4] = vfrag_load(vba, (I) + 4); else vfb[(I) - 4] = vfrag_load(vbb, (I) - 4); \
                         pair_exp_chunk<I, MASK>(b0, b1, pwb, sbm, klb, khb); PAIR_SB(); \
                         if ((I) == 3) { asm volatile("s_waitcnt lgkmcnt(0)" ::: "memory"); PAIR_SB(); } } while (0)
    PVA_STEP(0); PVA_STEP(1); PVA_STEP(2); PVA_STEP(3); PVA_STEP(4); PVA_STEP(5); PVA_STEP(6); PVA_STEP(7);
#undef PVA_STEP
    st.l += sa + sbm;
    asm volatile("s_waitcnt lgkmcnt(0)" ::: "memory"); PAIR_SB();
#define PVB_STEP(I) do { if ((I) & 1) st.o1 = __builtin_amdgcn_mfma_f32_32x32x16_bf16(vfb[I], __builtin_bit_cast(bf16x8, pwb[(I) >> 1]), st.o1, 0, 0, 0); \
                         else         st.o0 = __builtin_amdgcn_mfma_f32_32x32x16_bf16(vfb[I], __builtin_bit_cast(bf16x8, pwb[(I) >> 1]), st.o0, 0, 0, 0); \
                         if ((I) < 4) vfb[(I) + 4] = vfrag_load(vbb, (I) + 4); PAIR_SB(); \
                         if ((I) == 3) { asm volatile("s_waitcnt lgkmcnt(0)" ::: "memory"); PAIR_SB(); } } while (0)
    PVB_STEP(0); PVB_STEP(1); PVB_STEP(2); PVB_STEP(3); PVB_STEP(4); PVB_STEP(5); PVB_STEP(6); PVB_STEP(7);
#undef PVB_STEP
    const float lpair = fmaxf(st.l, swap32f(st.l));
    if (__any(lpair > 1.0e18f)) {
        const float dl = (lpair > 1.0e18f) ? 64.f : 0.f, alpha = __builtin_amdgcn_exp2f(-dl);
        st.m += dl; st.l *= alpha;
#pragma unroll
        for (int r = 0; r < 16; ++r) { st.o0[r] *= alpha; st.o1[r] *= alpha; }
    }
}

#define KV_LOOP_PAIR(NT, KPTR, VDELTA, PITCH, TPF) do { const int nt_ = (NT), np_ = (nt_ + 1) >> 1; const int wu_ = __builtin_amdgcn_readfirstlane(wid); __syncthreads(); \
    { const int i = 0; kv_dma((KPTR), (KPTR) + (VDELTA), (PITCH), lds, wu_, lane); } { const int i = (nt_ > 1) ? 1 : 0; kv_dma((KPTR), (KPTR) + (VDELTA), (PITCH), lds + 16384, wu_, lane); } \
    asm volatile("s_waitcnt vmcnt(0)" ::: "memory"); __syncthreads(); \
    _Pragma("unroll 1") for (int ip_ = 0; ip_ < np_; ++ip_) { LDSP unsigned char* cur0_ = lds + (ip_ & 1) * 32768; LDSP unsigned char* nxt0_ = lds + ((ip_ + 1) & 1) * 32768; \
        if (ip_ + 1 < np_) { { const int i = 2 * ip_ + 2; kv_dma((KPTR), (KPTR) + (VDELTA), (PITCH), nxt0_, wu_, lane); } \
                             { const int i = (2 * ip_ + 3 < nt_) ? 2 * ip_ + 3 : 2 * ip_ + 2; kv_dma((KPTR), (KPTR) + (VDELTA), (PITCH), nxt0_ + 16384, wu_, lane); } } \
        if (2 * ip_ + 1 < nt_) { const TP ta_ = TPF(2 * ip_), tb_ = TPF(2 * ip_ + 1); \
            if (ta_.nm || tb_.nm) attn_pair_fast<true>(st, qf, cur0_, cur0_ + 16384, lane, ta_, tb_); else attn_pair_fast<false>(st, qf, cur0_, cur0_ + 16384, lane, ta_, tb_); } \
        else { const TP ta_ = TPF(2 * ip_); attn_tile<0>(st, qf, cur0_, lane, ta_.rowoff, ta_.kl, ta_.kh, ta_.nm, 0.f, nullptr, nullptr, 0, 0); } \
        asm volatile("s_waitcnt vmcnt(0)" ::: "memory"); \
        __syncthreads(); } } while (0)

__device__ __forceinline__ void store_ot(bf16_t* dst, const f32x16& o0, const f32x16& o1, int hi) {
#pragma unroll
    for (int qd = 0; qd < 4; ++qd) {
        u32x2 w0, w1;
        w0.x = pk2(o0[4 * qd], o0[4 * qd + 1]); w0.y = pk2(o0[4 * qd + 2], o0[4 * qd + 3]);
        w1.x = pk2(o1[4 * qd], o1[4 * qd + 1]); w1.y = pk2(o1[4 * qd + 2], o1[4 * qd + 3]);
        *(u32x2*)(dst + 8 * qd + 4 * hi) = w0; *(u32x2*)(dst + 32 + 8 * qd + 4 * hi) = w1;
    }
}

__device__ __forceinline__ void moba_unit(const Params& P, LDSP unsigned char* lds, int b, int h, int blk) {
    unsigned char* ws = P.ws;
    const int tid = opaque_tid(), lane = tid & 63, wid = tid >> 6, r32 = lane & 31, hi = lane >> 5;
    const bf16_t* qa = (const bf16_t*)(ws + OFF_R1);
    const bf16_t* ka = (const bf16_t*)(ws + OFF_R1 + 32 * MiB);
    const bf16_t* va = (const bf16_t*)(ws + OFF_R1 + 64 * MiB);
    bf16_t* ya = (bf16_t*)(ws + OFF_R0);
    const float* kmean = (const float*)(ws + OFF_KMEAN) + (size_t)((b * 8 + h) * 16) * 64;
    LDSP float* km = (LDSP float*)(lds + A_MISC);
    LDSP unsigned short* sel16 = (LDSP unsigned short*)(lds + A_MISC + 4096);
    __syncthreads();
    for (int i = tid; i < blk * 64; i += NTHREADS) km[i] = kmean[i];
    __syncthreads();
    {
        const int qi = tid >> 1, hf = tid & 1;
        const bf16_t* qrow = qa + (size_t)(b * SEQ + blk * 256 + qi) * 512 + h * 64 + hf * 32;
        float q[32];
#pragma unroll
        for (int c = 0; c < 4; ++c) { float f[8]; cvt8(*(const u32x4*)(qrow + c * 8), f);
#pragma unroll
            for (int i = 0; i < 8; ++i) q[c * 8 + i] = f[i]; }
        float g0 = -INFINITY, g1 = -INFINITY, g2 = -INFINITY; int i0 = -1, i1 = -1, i2 = -1;
        for (int j = 0; j < blk; ++j) {
            float d = 0.f;
#pragma unroll
            for (int i = 0; i < 32; ++i) d += q[i] * km[j * 64 + hf * 32 + i];
            d += __shfl_xor(d, 1);
            if (d > g0) { g2 = g1; i2 = i1; g1 = g0; i1 = i0; g0 = d; i0 = j; }
            else if (d > g1) { g2 = g1; i2 = i1; g1 = d; i1 = j; }
            else if (d > g2) { g2 = d; i2 = j; }
        }
        unsigned mask = 0;
        if (i0 >= 0) mask |= 1u << i0;
        if (i1 >= 0) mask |= 1u << i1;
        if (i2 >= 0) mask |= 1u << i2;
        if (hf == 0) sel16[qi] = (unsigned short)mask;
    }
    __syncthreads();
    const int qloc = wid * 32 + r32;
    const size_t qrow_g = (size_t)(b * SEQ + blk * 256 + qloc);
    bf16x8 qf[4];
#pragma unroll
    for (int d0 = 0; d0 < 4; ++d0) qf[d0] = *(const bf16x8*)(qa + qrow_g * 512 + h * 64 + d0 * 16 + hi * 8);
    const unsigned selbits = sel16[qloc];
    ASt st; ast_reset(st);
    const bf16_t* kbase = ka + (size_t)(b * SEQ) * 512 + h * 64;
    const bf16_t* vbase = va + (size_t)(b * SEQ) * 512 + h * 64;
    auto moba_tp = [=](int ti) -> TP { const int jb = ti >> 2, t4 = ti & 3; const bool past = jb < blk;
        int l_ = lane; asm volatile("" : "+v"(l_)); const int w_ = __builtin_amdgcn_readfirstlane(wid), ql_ = w_ * 32 + (l_ & 31);
        TP t; t.rowoff = past ? !((selbits >> jb) & 1u) : (64 * t4 > ql_); t.nm = !past && (64 * t4 + 63 > w_ * 32); t.kl = 0; t.kh = past ? 63 : ql_ - 64 * t4; return t; };
    KV_LOOP_PAIR(4 * (blk + 1), kbase + (size_t)i * 64 * 512, (size_t)16 * 1024 * 1024, 512, moba_tp);
    const float lt = st.l + swap32f(st.l);
    const float inv = 1.0f / lt;
#pragma unroll
    for (int r = 0; r < 16; ++r) { st.o0[r] *= inv; st.o1[r] *= inv; }
    { const int t2 = opaque_tid(), l2 = t2 & 63;
      const size_t row2 = (size_t)(b * SEQ + blk * 256 + (t2 >> 6) * 32 + (l2 & 31));
      store_ot((bf16_t*)(P.ws + OFF_R0) + row2 * 512 + h * 64, st.o0, st.o1, l2 >> 5); }
}

__device__ __forceinline__ void nsa_unit(const Params& P, LDSP unsigned char* lds, int b, int g, int c) {
    unsigned char* ws = P.ws;
    const int tid = opaque_tid(), lane = tid & 63, wid = tid >> 6, r32 = lane & 31, hi = lane >> 5;
    const bf16_t* qb = (const bf16_t*)(ws + OFF_R1 + 96 * MiB);
    const bf16_t* kc = (const bf16_t*)(ws + OFF_KC) + (size_t)(b * 2 + g) * 256 * 64;
    const bf16_t* vc = (const bf16_t*)(ws + OFF_VC) + (size_t)(b * 2 + g) * 256 * 64;
    const bf16_t* ks = (const bf16_t*)(ws + OFF_R2 + 16 * MiB) + (size_t)(b * SEQ) * 128 + g * 64;
    const bf16_t* vs = (const bf16_t*)(ws + OFF_R2 + 24 * MiB) + (size_t)(b * SEQ) * 128 + g * 64;
    const bf16_t* kw = (const bf16_t*)(ws + OFF_R2 + 32 * MiB) + (size_t)(b * SEQ) * 128 + g * 64;
    const bf16_t* vw = (const bf16_t*)(ws + OFF_R2 + 40 * MiB) + (size_t)(b * SEQ) * 128 + g * 64;
    const float* bgate = (const float*)(ws + OFF_BGATE);
    bf16_t* yb = (bf16_t*)(ws + OFF_R0 + 32 * MiB);
    LDSP float* gs = (LDSP float*)(lds + A_GS);
    LDSP float* es = (LDSP float*)(lds + A_ES);
    LDSP unsigned long long* selm = (LDSP unsigned long long*)(lds + A_MISC);
    const int ql = wid * 8 + (r32 >> 2), hr = r32 & 3, head = g * 4 + hr, pos = c * 64 + ql;
    const size_t trow = (size_t)(b * SEQ + pos);
    bf16x8 qf[4];
#pragma unroll
    for (int d0 = 0; d0 < 4; ++d0) qf[d0] = *(const bf16x8*)(qb + trow * 512 + head * 64 + d0 * 16 + hi * 8);
    const int nmax = (pos >= 31) ? ((pos - 31) >> 4) : -1;
    const int ntc = ((4 * c + 2) >> 6) + 1;
    ASt st; ast_reset(st);
    __syncthreads();
    {
        const int wu_ = __builtin_amdgcn_readfirstlane(wid);
#pragma unroll 1
        for (int i = 0; i < ntc; ++i) kv_dma(kc + (size_t)i * 64 * 64, vc + (size_t)i * 64 * 64, 64, lds + i * 16384, wu_, lane);
        asm volatile("s_waitcnt vmcnt(0)" ::: "memory");
        __syncthreads();
    }
#pragma unroll 1
    for (int i = 0; i < ntc; ++i) attn_tile<1>(st, qf, lds + i * 16384, lane, nmax < 0, 0, nmax - 64 * i, true, 0.f, nullptr, nullptr, 0, 0);
    {
        const float lt = st.l + swap32f(st.l);
        const float linv = (lt > 0.f) ? 1.0f / lt : 0.f;
#pragma unroll 1
        for (int i = 0; i < ntc; ++i) attn_tile<2>(st, qf, lds + i * 16384, lane, nmax < 0, 0, nmax - 64 * i, true, linv, gs, es, 16 * i, ql);
    }
    LDSP float* yl = (LDSP float*)(lds + A_Y) + wid * 2048 + lane;
    __syncthreads();
    for (int qq = 0; qq < 8; ++qq) {
        const int q = wid * 8 + qq, j = lane;
        unsigned long long m;
        if (c < 16) m = (2ull << c) - 1ull;
        else {
            const bool cand = (j >= 1 && j <= c - 2);
            float imp = 0.f;
            if (cand) imp = gs[q * 64 + j] + es[q * 64 + j - 1];
            int rank = 0;
            for (int jp = 1; jp <= c - 2; ++jp) {
                const float o = __uint_as_float(__builtin_amdgcn_readlane(__float_as_uint(imp), jp));
                rank += (o > imp || (o == imp && jp < j)) ? 1 : 0;
            }
            const bool sel = (j == 0) || (j == c) || (j == c - 1) || (cand && rank < 13);
            m = __ballot(sel);
        }
        if (lane == 0) selm[q] = m;
    }
    __syncthreads();
    { const int t2 = opaque_tid(), l2 = t2 & 63; const size_t trow2 = (size_t)(b * SEQ + c * 64 + (t2 >> 6) * 8 + ((l2 & 31) >> 2)); const int head2 = g * 4 + (l2 & 3);
      const float gt0 = ((const float*)(P.ws + OFF_BGATE))[trow2 * 24 + head2 * 3 + 0];
#pragma unroll
    for (int r = 0; r < 16; ++r) { yl[r * 64] = gt0 * st.o0[r]; yl[(16 + r) * 64] = gt0 * st.o1[r]; } }
    const unsigned long long selmask = selm[ql];
    ast_reset(st);
    auto slc_tp = [=](int ti) -> TP { int l_ = lane; asm volatile("" : "+v"(l_)); const int ql_ = __builtin_amdgcn_readfirstlane(wid) * 8 + ((l_ & 31) >> 2);
        TP t; t.rowoff = !((selmask >> ti) & 1ull); t.nm = (ti == c); t.kl = 0; t.kh = (ti == c) ? ql_ : 63; return t; };
    KV_LOOP_PAIR(c + 1, ks + (size_t)i * 64 * 128, (size_t)4 * 1024 * 1024, 128, slc_tp);
    {
        const float lt = st.l + swap32f(st.l);
        const int t2 = opaque_tid(), l2 = t2 & 63; const size_t trow2 = (size_t)(b * SEQ + c * 64 + (t2 >> 6) * 8 + ((l2 & 31) >> 2)); const int head2 = g * 4 + (l2 & 3);
        LDSP float* yl = (LDSP float*)(lds + A_Y) + (t2 >> 6) * 2048 + l2;
        const float sc = ((const float*)(P.ws + OFF_BGATE))[trow2 * 24 + head2 * 3 + 1] / lt;
#pragma unroll
        for (int r = 0; r < 16; ++r) { yl[r * 64] += sc * st.o0[r]; yl[(16 + r) * 64] += sc * st.o1[r]; }
    }
    ast_reset(st);
    const int j0 = (c >= 8) ? c - 8 : 0;
    auto win_tp = [=](int ti) -> TP { const int j = j0 + ti; const bool first = (j == c - 8), own = (j == c);
        int l_ = lane; asm volatile("" : "+v"(l_)); const int ql_ = __builtin_amdgcn_readfirstlane(wid) * 8 + ((l_ & 31) >> 2);
        TP t; t.rowoff = false; t.nm = first || own; t.kl = first ? ql_ + 1 : 0; t.kh = own ? ql_ : 63; return t; };
    KV_LOOP_PAIR(c - j0 + 1, kw + (size_t)(j0 + i) * 64 * 128, (size_t)4 * 1024 * 1024, 128, win_tp);
    {
        const float lt = st.l + swap32f(st.l);
        const int t2 = opaque_tid(), l2 = t2 & 63; const size_t trow2 = (size_t)(b * SEQ + c * 64 + (t2 >> 6) * 8 + ((l2 & 31) >> 2)); const int head2 = g * 4 + (l2 & 3);
        LDSP float* yl = (LDSP float*)(lds + A_Y) + (t2 >> 6) * 2048 + l2;
        const float sc = ((const float*)(P.ws + OFF_BGATE))[trow2 * 24 + head2 * 3 + 2] / lt;
        f32x16 y0, y1;
#pragma unroll
        for (int r = 0; r < 16; ++r) { y0[r] = yl[r * 64] + sc * st.o0[r]; y1[r] = yl[(16 + r) * 64] + sc * st.o1[r]; }
        store_ot((bf16_t*)(P.ws + OFF_R0 + 32 * MiB) + trow2 * 512 + head2 * 64, y0, y1, l2 >> 5);
    }
}

__device__ __forceinline__ void phase_attn(const Params& P, LDSP unsigned char* lds, int vcu, int G) {
    const int nloc = (G == 256) ? 8 : (2048 - vcu + G - 1) / G;
    for (int k = 0; k < nloc; ++k) {
        int u;
        if (G == 256) {
            const int kk = k >> 1;
            if (!(k & 1)) { const int bh = vcu >> 2, jm = vcu & 3; const int blk = (kk == 0) ? 15 - jm : (kk == 1) ? 8 + jm : (kk == 2) ? 7 - jm : jm; u = bh * 16 + blk; }
            else { const int bg = vcu >> 4, jn = vcu & 15; const int c = (kk == 0) ? 63 - jn : (kk == 1) ? 32 + jn : (kk == 2) ? 31 - jn : jn; u = 1024 + bg * 64 + c; }
        } else u = vcu + k * G;
        if (u < 1024) moba_unit(P, lds, u >> 7, (u >> 4) & 7, u & 15);
        else { const int v = u - 1024; nsa_unit(P, lds, v >> 7, (v >> 6) & 1, v & 63); }
    }
}

struct EpiUp {
    const Params* P;
    __device__ __forceinline__ void operator()(f32x4 (&acc)[2][2][4][2], const pg8::Unit& u, int wr, int wc, int fr, int fq) const {
        bf16_t* g = (bf16_t*)(P->ws + OFF_R3);
#pragma unroll
        for (int ai = 0; ai < 2; ++ai)
#pragma unroll
            for (int m = 0; m < 4; ++m) {
                const int row = u.pm * 256 + ai * 128 + wr * 64 + m * 16 + fr;
#pragma unroll
                for (int bj = 0; bj < 2; ++bj) {
                    bf16_t* rp = g + (size_t)row * 2048 + u.pn * 256 + bj * 128 + wc * 32 + 8 * fq;
                    const u32x4 gg = *(const u32x4*)(rp + (u.z ? 1024 : 0));
                    float gf[8]; cvt8(gg, gf);
                    float o[8];
#pragma unroll
                    for (int n = 0; n < 2; ++n)
#pragma unroll
                        for (int i = 0; i < 4; ++i) o[4 * n + i] = gf[4 * n + i] * acc[ai][bj][m][n][i];
                    if (u.z) { float pf[8]; cvt8(*(const u32x4*)rp, pf);
#pragma unroll
                        for (int i = 0; i < 8; ++i) o[i] += pf[i]; }
                    u32x4 w; w.x = pk2(o[0], o[1]); w.y = pk2(o[2], o[3]); w.z = pk2(o[4], o[5]); w.w = pk2(o[6], o[7]);
                    *(u32x4*)rp = w;
                }
            }
    }
};
__device__ __forceinline__ void phase_up(const Params& P, LDSP unsigned char* lds, int vcu, int G) {
    pg8::Sched S; S.A0 = (const bf16_t*)(P.ws + OFF_R0); S.A1 = (const bf16_t*)(P.ws + OFF_R0 + 32 * MiB);
    S.B0 = (const bf16_t*)(P.ws + OFF_WUPA_T); S.B1 = (const bf16_t*)(P.ws + OFF_WUPB_T);
    S.lda = 512; S.ldb = 512; S.K = 512; S.nM = T / 256; S.nN = DM / 256; S.NZ = 2; S.G = G; S.c = blockIdx.x;
    EpiUp E{&P};
    pg8::gemm_phase(lds, S, E);
}

struct EpiOut {
    const Params* P;
    __device__ __forceinline__ void operator()(f32x4 (&acc)[2][2][4][2], const pg8::Unit& u, int wr, int wc, int fr, int fq) const {
        bf16_t* x1b = (bf16_t*)(P->ws + OFF_R0);
        float* rs2 = (float*)(P->ws + OFF_RS2);
        const float* x = P->in[I_X];
#pragma unroll
        for (int ai = 0; ai < 2; ++ai)
#pragma unroll
            for (int m = 0; m < 4; ++m) {
                const int row = u.pm * 256 + ai * 128 + wr * 64 + m * 16 + fr;
                float ss = 0.f;
                f32x4 xv[2][2];
#pragma unroll
                for (int bj = 0; bj < 2; ++bj)
#pragma unroll
                    for (int n = 0; n < 2; ++n) xv[bj][n] = *(const f32x4*)(x + (size_t)row * DM + u.pn * 256 + bj * 128 + wc * 32 + 8 * fq + 4 * n);
#pragma unroll
                for (int bj = 0; bj < 2; ++bj) {
                    const size_t off = (size_t)row * DM + u.pn * 256 + bj * 128 + wc * 32 + 8 * fq;
                    const f32x4 o0 = xv[bj][0] + acc[ai][bj][m][0], o1 = xv[bj][1] + acc[ai][bj][m][1];
                    u32x4 w; w.x = pk2(o0.x, o0.y); w.y = pk2(o0.z, o0.w); w.z = pk2(o1.x, o1.y); w.w = pk2(o1.z, o1.w);
                    *(u32x4*)(x1b + off) = w;
                    ss += ((o0.x * o0.x + o0.y * o0.y) + (o0.z * o0.z + o0.w * o0.w)) + ((o1.x * o1.x + o1.y * o1.y) + (o1.z * o1.z + o1.w * o1.w));
                }
                ss = sum_xor16(ss); ss = sum_xor32(ss);
                if (fq == 0) atomicAdd(rs2 + row, ss);
            }
    }
};
__device__ __forceinline__ void phase_out(const Params& P, LDSP unsigned char* lds, int vcu, int G) {
    pg8::Sched S; S.A0 = S.A1 = (const bf16_t*)(P.ws + OFF_R3); S.B0 = S.B1 = (const bf16_t*)(P.ws + OFF_WOUT_T);
    S.lda = 2048; S.ldb = DM; S.K = DM; S.nM = T / 256; S.nN = DM / 256; S.NZ = 1; S.G = G; S.c = blockIdx.x;
    EpiOut E{&P};
    pg8::gemm_phase(lds, S, E);
}

struct EpiPq {
    const Params* P;
    __device__ __forceinline__ void operator()(f32x4 (&acc)[2][2][4][2], const pg8::Unit& u, int wr, int wc, int fr, int fq) const {
        bf16_t* qp = (bf16_t*)(P->ws + OFF_R1);
        const float* rs2 = (const float*)(P->ws + OFF_RS2);
        float rr[2][4];
#pragma unroll
        for (int ai = 0; ai < 2; ++ai)
#pragma unroll
            for (int m = 0; m < 4; ++m) rr[ai][m] = __builtin_amdgcn_rsqf(rs2[u.pm * 256 + ai * 128 + wr * 64 + m * 16 + fr] * (1.0f / DM) + NORM_EPS);
#pragma unroll
        for (int ai = 0; ai < 2; ++ai)
#pragma unroll
            for (int m = 0; m < 4; ++m) {
                const int row = u.pm * 256 + ai * 128 + wr * 64 + m * 16 + fr;
                const float r = rr[ai][m];
#pragma unroll
                for (int bj = 0; bj < 2; ++bj) {
                    const f32x4 a0 = acc[ai][bj][m][0], a1 = acc[ai][bj][m][1];
                    u32x4 w; w.x = pk2(a0[0] * r, a0[1] * r); w.y = pk2(a0[2] * r, a0[3] * r); w.z = pk2(a1[0] * r, a1[1] * r); w.w = pk2(a1[2] * r, a1[3] * r);
                    *(u32x4*)(qp + (size_t)row * 2048 + u.pn * 256 + bj * 128 + wc * 32 + 8 * fq) = w;
                }
            }
    }
};
__device__ __forceinline__ void phase_pq(const Params& P, LDSP unsigned char* lds, int vcu, int G) {
    pg8::Sched S; S.A0 = S.A1 = (const bf16_t*)(P.ws + OFF_R0); S.B0 = S.B1 = (const bf16_t*)(P.ws + OFF_WPQ_T);
    S.lda = DM; S.ldb = DM; S.K = DM; S.nM = T / 256; S.nN = 2048 / 256; S.NZ = 1; S.G = G; S.c = blockIdx.x;
    EpiPq E{&P};
    pg8::gemm_phase(lds, S, E);
}

__device__ __forceinline__ unsigned f2ord(float f) { const unsigned u = __float_as_uint(f); return u ^ ((unsigned)((int)u >> 31) | 0x80000000u); }
__device__ __forceinline__ float ord2f(unsigned o) { const unsigned u = (o & 0x80000000u) ? (o ^ 0x80000000u) : ~o; return __uint_as_float(u); }
__device__ __forceinline__ void ins16(unsigned (&top)[16], unsigned x) {
#pragma unroll
    for (int j = 0; j < 16; ++j) { const unsigned t = max(x, top[j]); x = min(x, top[j]); top[j] = t; }
}
__device__ __forceinline__ int crow(int r, int hi) { return (r & 3) + 8 * (r >> 2) + 4 * hi; }
__device__ __forceinline__ void ce_desc(unsigned& a, unsigned& b) { const unsigned hi_ = max(a, b), lo_ = min(a, b); a = hi_; b = lo_; }
__device__ __forceinline__ void bitonic_merge16_desc(unsigned (&a)[16]) {
#pragma unroll
    for (int j = 8; j > 0; j >>= 1)
#pragma unroll
        for (int i = 0; i < 16; ++i) { const int l = i ^ j; if (l > i) ce_desc(a[i], a[l]); }
}
__device__ __forceinline__ void sort16_desc(unsigned (&a)[16]) {
#pragma unroll
    for (int k = 2; k <= 16; k <<= 1)
#pragma unroll
        for (int j = k >> 1; j > 0; j >>= 1)
#pragma unroll
            for (int i = 0; i < 16; ++i) { const int l = i ^ j; if (l > i) { if ((i & k) == 0) ce_desc(a[i], a[l]); else ce_desc(a[l], a[i]); } }
}
__device__ __forceinline__ void merge_top16(unsigned (&top)[16], const unsigned (&blk)[16]) {
#pragma unroll
    for (int i = 0; i < 16; ++i) top[i] = max(top[i], blk[15 - i]);
    bitonic_merge16_desc(top);
}
constexpr int cand_prefix(int i) { int n = 0; for (int a = 0; a < i; ++a) n += 16 / (a + 1); return n; }

constexpr int P8_KOFF = 0, P8_IDX = 65536;
__device__ __forceinline__ void phase_topk(const Params& P, LDSP unsigned char* lds, int vcu, int G) {
    unsigned char* ws = P.ws;
    const bf16_t* qp = (const bf16_t*)(ws + OFF_R1);
    int* experts = (int*)(ws + OFF_EXPERTS);
    float* gates = (float*)(ws + OFF_GATES);
    const int tid = opaque_tid(), lane = tid & 63, wave = tid >> 6, r32 = lane & 31, hi = lane >> 5;
    __syncthreads();
    for (int i = tid; i < 2 * 128 * 16; i += NTHREADS) {
        const int w = i >> 11, row = (i >> 4) & 127, ch = i & 15;
        const u32x4 v = *(const u32x4*)((const bf16_t*)(ws + (w ? OFF_K2B : OFF_K1B)) + row * 128 + ch * 8);
        *(LDSP u32x4*)(lds + P8_KOFF + w * 32768 + row * 256 + ((ch ^ (row & 15)) << 4)) = v;
    }
    __syncthreads();
    LDSP unsigned char* myidx = lds + P8_IDX + (wave * 64 + lane) * 32;
    const int gw = vcu * NWAVES + wave, NGW = G * NWAVES;
    for (int item = gw; item < (T / 32) * 8; item += NGW) {
        const int tg = item >> 3, h = item & 7;
        const int tok = tg * 32 + r32;
        unsigned tops[2][16];
#pragma unroll
        for (int L = 0; L < 2; ++L) {
            bf16x8 qf[8];
            const bf16_t* qrow = qp + (size_t)tok * 2048 + h * 256 + L * 128 + hi * 8;
#pragma unroll
            for (int s8 = 0; s8 < 8; ++s8) qf[s8] = *(const bf16x8*)(qrow + s8 * 16);
            unsigned top[16];
#pragma unroll
            for (int kb = 0; kb < 4; ++kb) {
                f32x16 acc = {0.f, 0.f, 0.f, 0.f, 0.f, 0.f, 0.f, 0.f, 0.f, 0.f, 0.f, 0.f, 0.f, 0.f, 0.f, 0.f};
                const int row = kb * 32 + r32;
#pragma unroll
                for (int s8 = 0; s8 < 8; ++s8) {
                    const bf16x8 kf = *(const LDSP bf16x8*)(lds + P8_KOFF + L * 32768 + row * 256 + (((2 * s8 + hi) ^ (row & 15)) << 4));
                    acc = __builtin_amdgcn_mfma_f32_32x32x16_bf16(kf, qf[s8], acc, 0, 0, 0);
                }
                unsigned blk[16];
#pragma unroll
                for (int r = 0; r < 16; ++r) {
                    const int key = kb * 32 + (r & 3) + 8 * (r >> 2) + 4 * hi;
                    blk[r] = (f2ord(acc[r]) & ~0x7Fu) | (unsigned)(127 - key);
                }
                sort16_desc(blk);
                if (kb == 0) {
#pragma unroll
                    for (int j = 0; j < 16; ++j) top[j] = blk[j];
                } else merge_top16(top, blk);
            }
            unsigned oth[16];
#pragma unroll
            for (int j = 0; j < 16; ++j) oth[j] = (unsigned)__shfl_xor((int)top[j], 32);
            merge_top16(top, oth);
#pragma unroll
            for (int j = 0; j < 16; ++j) tops[L][j] = top[j];
        }
        float v1[16], v2[16];
#pragma unroll
        for (int j = 0; j < 16; j += 4) {
            unsigned w1 = 0, w2 = 0;
#pragma unroll
            for (int q = 0; q < 4; ++q) { w1 |= (127u - (tops[0][j + q] & 127u)) << (8 * q); w2 |= (127u - (tops[1][j + q] & 127u)) << (8 * q); }
            *(LDSP unsigned*)(myidx + j) = w1; *(LDSP unsigned*)(myidx + 16 + j) = w2;
        }
#pragma unroll
        for (int j = 0; j < 16; ++j) { v1[j] = ord2f(tops[0][j] & ~0x7Fu); v2[j] = ord2f(tops[1][j] & ~0x7Fu); }
        unsigned ct[16];
        {
            unsigned cand[64];
#pragma unroll
            for (int n = 0; n < 64; ++n) cand[n] = 0u;
#pragma unroll
            for (int i = 0; i < 16; ++i)
#pragma unroll
                for (int j = 0; j < 16; ++j)
                    if ((i + 1) * (j + 1) <= 16) cand[cand_prefix(i) + j] = (f2ord(v1[i] + v2[j]) & ~0xFFu) | (unsigned)(255 - (i * 16 + j));
#pragma unroll
            for (int bk = 0; bk < 4; ++bk) {
                unsigned blk[16];
#pragma unroll
                for (int r = 0; r < 16; ++r) blk[r] = cand[bk * 16 + r];
                sort16_desc(blk);
                if (bk == 0) {
#pragma unroll
                    for (int j = 0; j < 16; ++j) ct[j] = blk[j];
                } else merge_top16(ct, blk);
            }
        }
        float vals[16], ssum = 0.f;
        const float vmax = ord2f(ct[0] & ~0xFFu);
#pragma unroll
        for (int k = 0; k < 16; ++k) { vals[k] = __expf(ord2f(ct[k] & ~0xFFu) - vmax); ssum += vals[k]; }
        const float inv = 1.0f / ssum;
        asm volatile("s_waitcnt lgkmcnt(0)" ::: "memory");
        if (hi == 0) {
            int* ep = experts + (size_t)tok * 128 + h * 16;
            float* gp = gates + (size_t)tok * 128 + h * 16;
#pragma unroll
            for (int k = 0; k < 16; k += 4) {
                int e4[4];
#pragma unroll
                for (int q = 0; q < 4; ++q) {
                    const unsigned flat = 255u - (ct[k + q] & 255u);
                    const int i1 = myidx[flat >> 4], i2 = myidx[16 + (flat & 15)];
                    e4[q] = i1 * 128 + i2;
                }
                *(u32x4*)(ep + k) = (u32x4){(unsigned)e4[0], (unsigned)e4[1], (unsigned)e4[2], (unsigned)e4[3]};
                *(f32x4*)(gp + k) = (f32x4){vals[k] * inv, vals[k + 1] * inv, vals[k + 2] * inv, vals[k + 3] * inv};
            }
        }
        asm volatile("s_waitcnt lgkmcnt(0)" ::: "memory");
    }
}

__device__ __forceinline__ void peer_slice_map(const Params& P, LDSP unsigned char* lds, int vcu, int G, int wave, int& slice, int& half, int& wslot, int& nslot) {
    volatile LDSP unsigned* bst = (volatile LDSP unsigned*)(lds + LDS_BYTES - 16);
    LDSP unsigned* info = (LDSP unsigned*)(lds + LDS_BYTES - 64);
    __syncthreads();
    if (threadIdx.x == 0) {
        unsigned* bar = (unsigned*)(P.ws + 16384);
        const unsigned x = (unsigned)__builtin_amdgcn_s_getreg((3 << 11) | 20) & 0xFu;
        bool ok = true; unsigned sum = 0, mine = 0;
        for (unsigned j = 0; j < 16; ++j) { const unsigned c = __hip_atomic_load(&bar[256 + 64 * j], __ATOMIC_RELAXED, __HIP_MEMORY_SCOPE_AGENT); sum += c; if (j < 8 && c == 0) ok = false; if (j >= 8 && c != 0) ok = false; if (j == x) mine = c; }
        ok = ok && (sum == (unsigned)G) && (bst[2] < mine);
        info[0] = ok ? 1u : 0u; info[1] = x; info[2] = mine; info[3] = bst[2];
    }
    __syncthreads();
    if (info[0]) { slice = (int)(info[1] & 3u); half = (int)(info[1] >> 2); wslot = (int)info[3] * NWAVES + wave; nslot = (int)info[2] * NWAVES; }
    else if ((G & 7) == 0) { const int g8 = vcu / (G >> 3); slice = g8 & 3; half = g8 >> 2; wslot = (vcu % (G >> 3)) * NWAVES + wave; nslot = (G >> 3) * NWAVES; }
    else { slice = -1; half = 0; wslot = vcu * NWAVES + wave; nslot = G * NWAVES; }
}
struct PeerMetaA { int eA, eB; u32x4 h0, h1, h2, h3; float ss; };
struct PeerMetaB { int eA, eB; float aA, aB; };
#define PEER_IDX(m, j) __shfl(((j) < 8) ? (m).eA : (m).eB, (8 * (j) + grp) & 63)
__device__ __forceinline__ float dpp_xor1(float v) { return __builtin_bit_cast(float, __builtin_amdgcn_mov_dpp(__builtin_bit_cast(int, v), 0xB1, 0xF, 0xF, true)); }
__device__ __forceinline__ float dpp_xor2(float v) { return __builtin_bit_cast(float, __builtin_amdgcn_mov_dpp(__builtin_bit_cast(int, v), 0x4E, 0xF, 0xF, true)); }
__device__ __forceinline__ float dpp_hmirror(float v) { return __builtin_bit_cast(float, __builtin_amdgcn_mov_dpp(__builtin_bit_cast(int, v), 0x141, 0xF, 0xF, true)); }
__device__ __forceinline__ float dpp_ror8(float v) { return __builtin_bit_cast(float, __builtin_amdgcn_mov_dpp(__builtin_bit_cast(int, v), 0x128, 0xF, 0xF, true)); }
__device__ __forceinline__ float swap32_sum(float X, float Y) {
    const auto r = __builtin_amdgcn_permlane32_swap(__float_as_uint(X), __float_as_uint(Y), false, false);
    return __uint_as_float(r[0]) + __uint_as_float(r[1]);
}
__device__ __forceinline__ float swap16_sum(float X, float Y) {
    const auto r = __builtin_amdgcn_permlane16_swap(__float_as_uint(X), __float_as_uint(Y), false, false);
    return __uint_as_float(r[0]) + __uint_as_float(r[1]);
}
__device__ __forceinline__ void cvt32_fp4_pk(const u32x4 w, f32x2 (&f)[16]) {
#pragma unroll
    for (int q = 0; q < 4; ++q) {
        f[4 * q]     = __builtin_amdgcn_cvt_scalef32_pk_f32_fp4(w[q], 1.0f, 0); f[4 * q + 1] = __builtin_amdgcn_cvt_scalef32_pk_f32_fp4(w[q], 1.0f, 1);
        f[4 * q + 2] = __builtin_amdgcn_cvt_scalef32_pk_f32_fp4(w[q], 1.0f, 2); f[4 * q + 3] = __builtin_amdgcn_cvt_scalef32_pk_f32_fp4(w[q], 1.0f, 3);
    }
}
#define PA_T(it) ((slice >= 0) ? (2 * (it) + half) : ((it) >> 2))
#define PA_X(it) ((slice >= 0) ? slice : ((it) & 3))
__device__ __forceinline__ void phase_peer_a(const Params& P, LDSP unsigned char* lds, int vcu, int G) {
    unsigned char* ws = P.ws;
    const bf16_t* x1b = (const bf16_t*)(ws + OFF_R0);
    const float* rs2 = (const float*)(ws + OFF_RS2);
    const unsigned char* U4 = ws + OFF_U;
    const int* experts = (const int*)(ws + OFF_EXPERTS);
    float* apart = (float*)(ws + OFF_R1);
    const int tid = opaque_tid(), lane = tid & 63, wave = tid >> 6, grp = lane >> 3, sub = lane & 7;
    const bool b2 = lane & 4, b1 = lane & 2, b0 = lane & 1;
    int slice, half, wslot, nslot;
    peer_slice_map(P, lds, vcu, G, wave, slice, half, wslot, nslot);
    const int nitems = (slice >= 0) ? T / 2 : T * 4;
#define PA_META(m, it) do { const int it_ = ((it) < nitems) ? (it) : wslot; { const int t_ = PA_T(it_), x_ = PA_X(it_); \
        (m).eA = __builtin_nontemporal_load(experts + (size_t)t_ * 128 + lane); (m).eB = __builtin_nontemporal_load(experts + (size_t)t_ * 128 + 64 + lane); const u32x4* hp_ = (const u32x4*)(x1b + (size_t)t_ * DM + 256 * x_ + 32 * sub); \
        (m).h0 = __builtin_nontemporal_load(hp_); (m).h1 = __builtin_nontemporal_load(hp_ + 1); (m).h2 = __builtin_nontemporal_load(hp_ + 2); (m).h3 = __builtin_nontemporal_load(hp_ + 3); (m).ss = rs2[t_]; } } while (0)
#define PA_GATHER(R, m, it, J0) do { const int x_ = PA_X(it); _Pragma("unroll") for (int j = 0; j < 8; ++j) { const int e_ = PEER_IDX(m, (J0) + j); \
        (R)[j] = *(const u32x4*)(U4 + (((unsigned)x_ * (unsigned)PEER_NE + (unsigned)e_) * 128u + 16u * (unsigned)sub)); } } while (0)
#define PA_COMPUTE(R, J0) do { _Pragma("unroll") for (int j = 0; j < 8; ++j) { asm volatile("" : "+v"((R)[j])); int ah = 0, al = 0; \
        _Pragma("unroll") for (int q = 0; q < 4; ++q) { ah = __builtin_amdgcn_sdot8((int)(R)[j][q], (int)HQ[q], ah, false); al = __builtin_amdgcn_sdot8((int)(R)[j][q], (int)LQ[q], al, false); } \
        part[(J0) + j] = (float)(ah * 16 + al); asm volatile("" : "+v"(part[(J0) + j])); } } while (0)
    PeerMetaA m0, m1, m2;
    m0.eA = m0.eB = m1.eA = m1.eB = m2.eA = m2.eB = 0; m0.ss = m1.ss = m2.ss = 1.f;
    m0.h0 = m0.h1 = m0.h2 = m0.h3 = m1.h0 = m1.h1 = m1.h2 = m1.h3 = m2.h0 = m2.h1 = m2.h2 = m2.h3 = (u32x4){0u, 0u, 0u, 0u};
    u32x4 R0[8], R1[8];
    PA_META(m0, wslot); PA_META(m1, wslot + nslot);
    if (wslot >= nitems) return;
    PA_GATHER(R0, m0, wslot, 0); PA_GATHER(R1, m0, wslot, 8);
#pragma unroll 1
    for (int it = wslot; it < nitems; it += nslot) {
        PA_META(m2, it + 2 * nslot);
        unsigned HQ[4], LQ[4]; float part[16];
        { const float inv = (119.0f / 8.0f) * __builtin_amdgcn_rsqf(m0.ss * (1.0f / DM) + NORM_EPS); const f32x2 inv2 = {inv, inv}, magic2 = {12582920.0f, 12582920.0f};
          typedef short s16x2 __attribute__((ext_vector_type(2)));
          const s16x2 lo2 = {(short)-112, (short)-112}, hi2 = {(short)127, (short)127};
          constexpr unsigned M = 0x000F000Fu;
#define PA_H(Q, W) do { unsigned p_[4]; _Pragma("unroll") for (int w = 0; w < 4; ++w) { const unsigned wd = (W)[w]; const f32x2 f = {__uint_as_float(wd << 16), __uint_as_float(wd & 0xffff0000u)}; \
              const f32x2 t = __builtin_elementwise_fma(f, inv2, magic2);                                     \
              const unsigned pk_ = __builtin_amdgcn_perm(__float_as_uint(t.y), __float_as_uint(t.x), 0x05040100u); \
              p_[w] = __builtin_bit_cast(unsigned, __builtin_elementwise_min(__builtin_elementwise_max(__builtin_bit_cast(s16x2, pk_), lo2), hi2)); } \
          HQ[Q] = ((p_[0] >> 4) & M) | (p_[1] & (M << 4)) | ((p_[2] << 4) & (M << 8)) | ((p_[3] << 8) & (M << 12)); \
          LQ[Q] = ((p_[0] & M) | ((p_[1] << 4) & (M << 4)) | ((p_[2] << 8) & (M << 8)) | ((p_[3] << 12) & (M << 12))) ^ 0x88888888u; } while (0)
          PA_H(0, m0.h0); PA_H(1, m0.h1); PA_H(2, m0.h2); PA_H(3, m0.h3);
#undef PA_H
        }
        PA_COMPUTE(R0, 0);
        const int itn = (it + nslot < nitems) ? it + nslot : it;
        PA_GATHER(R0, m1, itn, 0);
        PA_COMPUTE(R1, 8);
        PA_GATHER(R1, m1, itn, 8);
        float q8[8], q4[4], q2[2];
#pragma unroll
        for (int i = 0; i < 8; ++i) { const float send = b2 ? part[i] : part[i + 8], keep = b2 ? part[i + 8] : part[i]; q8[i] = keep + dpp_hmirror(send); }
#pragma unroll
        for (int i = 0; i < 4; ++i) { const float send = b1 ? q8[i] : q8[i + 4], keep = b1 ? q8[i + 4] : q8[i]; q4[i] = keep + dpp_xor2(send); }
#pragma unroll
        for (int i = 0; i < 2; ++i) { const float send = b0 ? q4[i] : q4[i + 2], keep = b0 ? q4[i + 2] : q4[i]; q2[i] = keep + dpp_xor1(send); }
        float* ap = apart + ((size_t)PA_X(it) * T + PA_T(it)) * 128 + lane;
        __builtin_nontemporal_store(q2[0], ap); __builtin_nontemporal_store(q2[1], ap + 64);
        m0 = m1; m1 = m2;
    }
#undef PA_META
#undef PA_GATHER
#undef PA_COMPUTE
}
__device__ __forceinline__ void phase_peer_w(const Params& P, LDSP unsigned char* lds, int vcu, int G) {
    unsigned char* ws = P.ws;
    float* gates = (float*)(ws + OFF_GATES);
    const float* apart = (const float*)(ws + OFF_R1);
    const int* experts = (const int*)(ws + OFF_EXPERTS);
    const float* su = (const float*)(ws + OFF_PSCALE);
    const float* sv = su + PEER_NE;
    const size_t gt = (size_t)(vcu * NTHREADS + threadIdx.x), NGT = (size_t)G * NTHREADS;
    for (size_t i = gt; i < (size_t)T * 128; i += NGT) {
        const int t = (int)(i >> 7), k = (int)(i & 127);
        const int sub = k >> 4, s1 = (k >> 3) & 1, grp = k & 7, idx = s1 * 64 + grp * 8 + sub;
        float a = 0.f;
#pragma unroll
        for (int xs = 0; xs < 4; ++xs) a += apart[((size_t)xs * T + t) * 128 + idx];
        const int e = experts[i];
        gates[i] = gelu_tanh(a * su[e] * (8.0f / 119.0f)) * gates[i] * sv[e];
    }
}
__device__ __forceinline__ void phase_peer_b(const Params& P, LDSP unsigned char* lds, int vcu, int G) {
    unsigned char* ws = P.ws;
    const unsigned char* V4 = ws + OFF_V;
    const int* experts = (const int*)(ws + OFF_EXPERTS);
    const float* wtok = (const float*)(ws + OFF_GATES);
    const int tid = opaque_tid(), lane = tid & 63, wave = tid >> 6, grp = lane >> 3, sub = lane & 7;
    const bool b3 = lane & 8;
    const int k0 = 16 * sub + grp, k1 = k0 + 8;
    LDSP float* wbuf = (LDSP float*)(lds + wave * 1024);
    int slice, half, wslot, nslot;
    peer_slice_map(P, lds, vcu, G, wave, slice, half, wslot, nslot);
    const int nitems = (slice >= 0) ? T / 2 : T * 4;
#define PB_META(m, it) do { const int it_ = ((it) < nitems) ? (it) : wslot; { const int t_ = PA_T(it_); \
        (m).eA = __builtin_nontemporal_load(experts + (size_t)t_ * 128 + lane); (m).eB = __builtin_nontemporal_load(experts + (size_t)t_ * 128 + 64 + lane); \
        (m).aA = __builtin_nontemporal_load(wtok + (size_t)t_ * 128 + k0); (m).aB = __builtin_nontemporal_load(wtok + (size_t)t_ * 128 + k1); } } while (0)
#define PB_GATHER(R, m, it, J0) do { const int x_ = PA_X(it); _Pragma("unroll") for (int j = 0; j < 8; ++j) { const int e_ = PEER_IDX(m, (J0) + j); \
        (R)[j] = *(const u32x4*)(V4 + (((unsigned)x_ * (unsigned)PEER_NE + (unsigned)e_) * 128u + 16u * (unsigned)sub)); } } while (0)
#define PB_COMPUTE(R, J0) do { _Pragma("unroll") for (int j = 0; j < 8; ++j) { f32x2 f[16]; asm volatile("" : "+v"((R)[j])); cvt32_fp4_pk((R)[j], f); const float wk = wb[8 * ((J0) + j) + grp]; const f32x2 wk2 = {wk, wk}; \
        _Pragma("unroll") for (int i = 0; i < 16; ++i) acc2[i] = __builtin_elementwise_fma(wk2, f[i], acc2[i]); \
        asm volatile("" : "+v"(acc2[0]), "+v"(acc2[1]), "+v"(acc2[2]), "+v"(acc2[3]), "+v"(acc2[4]), "+v"(acc2[5]), "+v"(acc2[6]), "+v"(acc2[7])); \
        asm volatile("" : "+v"(acc2[8]), "+v"(acc2[9]), "+v"(acc2[10]), "+v"(acc2[11]), "+v"(acc2[12]), "+v"(acc2[13]), "+v"(acc2[14]), "+v"(acc2[15])); } } while (0)
    PeerMetaB m0, m1, m2;
    m0.eA = m0.eB = m1.eA = m1.eB = m2.eA = m2.eB = 0; m0.aA = m0.aB = m1.aA = m1.aB = m2.aA = m2.aB = 0.f;
    u32x4 R0[8], R1[8];
    PB_META(m0, wslot); PB_META(m1, wslot + nslot);
    if (wslot >= nitems) return;
    PB_GATHER(R0, m0, wslot, 0); PB_GATHER(R1, m0, wslot, 8);
    int par = 0;
#pragma unroll 1
    for (int it = wslot; it < nitems; it += nslot) {
        PB_META(m2, it + 2 * nslot);
        LDSP float* wb = wbuf + par * 128; par ^= 1;
        wb[k0] = m0.aA; wb[k1] = m0.aB;
        asm volatile("s_waitcnt lgkmcnt(0)" ::: "memory");
        f32x2 acc2[16];
#pragma unroll
        for (int i = 0; i < 16; ++i) acc2[i] = (f32x2){0.f, 0.f};
        PB_COMPUTE(R0, 0);
        const int itn = (it + nslot < nitems) ? it + nslot : it;
        PB_GATHER(R0, m1, itn, 0);
        PB_COMPUTE(R1, 8);
        PB_GATHER(R1, m1, itn, 8);
        float acc[32];
#pragma unroll
        for (int i = 0; i < 16; ++i) { acc[2 * i] = acc2[i].x; acc[2 * i + 1] = acc2[i].y; }
        float q16[16], q8[8], q4[4];
#pragma unroll
        for (int i = 0; i < 16; ++i) q16[i] = swap32_sum(acc[i], acc[i + 16]);
#pragma unroll
        for (int i = 0; i < 8; ++i) q8[i] = swap16_sum(q16[i], q16[i + 8]);
#pragma unroll
        for (int i = 0; i < 4; ++i) { const float send = b3 ? q8[i] : q8[i + 4], keep = b3 ? q8[i + 4] : q8[i]; q4[i] = keep + dpp_ror8(send); }
        const int c32 = ((lane & 32) ? 16 : 0) + ((lane & 16) ? 8 : 0) + (b3 ? 4 : 0);
        const size_t oidx = (size_t)PA_T(it) * DM + 256 * PA_X(it) + 32 * sub + c32;
        const u32x2 xr = __builtin_nontemporal_load((const u32x2*)((const bf16_t*)(P.ws + OFF_R0) + oidx));
        f32x4 o;
        o.x = __uint_as_float(xr.x << 16) + q4[0]; o.y = __uint_as_float(xr.x & 0xffff0000u) + q4[1]; o.z = __uint_as_float(xr.y << 16) + q4[2]; o.w = __uint_as_float(xr.y & 0xffff0000u) + q4[3];
        __builtin_nontemporal_store(o, (f32x4*)(P.out + oidx));
        m0 = m1; m1 = m2;
    }
#undef PB_META
#undef PB_GATHER
#undef PB_COMPUTE
#undef PA_T
#undef PA_X
}

#ifndef SELFCHECK
#define SELFCHECK 0
#endif
#if SELFCHECK
constexpr size_t OFF_CHK = 512 * 1024;
__device__ __forceinline__ void wave_argmax(float& v, int& i) {
#pragma unroll
    for (int o = 1; o < 64; o <<= 1) {
        const float ov = __shfl_xor(v, o); const int oi = __shfl_xor(i, o);
        if (ov > v || (ov == v && oi < i)) { v = ov; i = oi; }
    }
}
struct NaiveAcc { float m, l; float o[64]; };
__device__ __forceinline__ float wave_max(float v) {
#pragma unroll
    for (int o = 1; o < 64; o <<= 1) v = fmaxf(v, __shfl_xor(v, o));
    return v;
}
__device__ __forceinline__ void nacc_reset(NaiveAcc& a) { a.m = -1.0e30f; a.l = 0.f;
#pragma unroll
    for (int d = 0; d < 64; ++d) a.o[d] = 0.f; }
__device__ __forceinline__ float dot64(LDSP const float* qs, const bf16_t* krow) {
    float s = 0.f;
#pragma unroll
    for (int c = 0; c < 8; ++c) { float f[8]; cvt8(*(const u32x4*)(krow + c * 8), f);
#pragma unroll
        for (int i = 0; i < 8; ++i) s += qs[c * 8 + i] * f[i]; }
    return s;
}
__device__ __forceinline__ void axpy64(NaiveAcc& a, float alpha, float p, const bf16_t* vrow) {
#pragma unroll
    for (int c = 0; c < 8; ++c) { float f[8]; cvt8(*(const u32x4*)(vrow + c * 8), f);
#pragma unroll
        for (int i = 0; i < 8; ++i) a.o[c * 8 + i] = a.o[c * 8 + i] * alpha + p * f[i]; }
}
__device__ __forceinline__ void naive_chunk(NaiveAcc& a, LDSP const float* qs, const bf16_t* krow, const bf16_t* vrow, bool valid) {
    float s = dot64(qs, krow);
    if (!valid) s = -INFINITY;
    const float mnew = fmaxf(a.m, wave_max(s));
    const float alpha = exp2f(a.m - mnew), p = valid ? exp2f(s - mnew) : 0.f;
    a.l = a.l * alpha + p; a.m = mnew;
    axpy64(a, alpha, p, vrow);
}
__device__ __forceinline__ float nacc_final(NaiveAcc& a, int lane) {
    const float l = wave_sum(a.l);
    const float inv = (l > 0.f) ? 1.0f / l : 0.f;
    const bool b5 = lane & 32, b4 = lane & 16, b3 = lane & 8, b2 = lane & 4, b1 = lane & 2, b0 = lane & 1;
    float q32[32], q16[16], q8[8], q4[4], q2[2];
#pragma unroll
    for (int i = 0; i < 32; ++i) { const float send = b5 ? a.o[i] : a.o[i + 32], keep = b5 ? a.o[i + 32] : a.o[i]; q32[i] = keep + __shfl_xor(send, 32); }
#pragma unroll
    for (int i = 0; i < 16; ++i) { const float send = b4 ? q32[i] : q32[i + 16], keep = b4 ? q32[i + 16] : q32[i]; q16[i] = keep + __shfl_xor(send, 16); }
#pragma unroll
    for (int i = 0; i < 8; ++i) { const float send = b3 ? q16[i] : q16[i + 8], keep = b3 ? q16[i + 8] : q16[i]; q8[i] = keep + __shfl_xor(send, 8); }
#pragma unroll
    for (int i = 0; i < 4; ++i) { const float send = b2 ? q8[i] : q8[i + 4], keep = b2 ? q8[i + 4] : q8[i]; q4[i] = keep + __shfl_xor(send, 4); }
#pragma unroll
    for (int i = 0; i < 2; ++i) { const float send = b1 ? q4[i] : q4[i + 2], keep = b1 ? q4[i + 2] : q4[i]; q2[i] = keep + __shfl_xor(send, 2); }
    const float send = b0 ? q2[0] : q2[1], keep = b0 ? q2[1] : q2[0];
    return (keep + __shfl_xor(send, 1)) * inv;
}
__device__ __forceinline__ float cmp_err(float ref, const bf16_t* got, int lane) {
    const float e = wave_max(fabsf(ref - bf2f(got[lane]))), mx = wave_max(fabsf(ref));
    return e / (mx + 1e-3f);
}
__device__ __forceinline__ void phase_selfcheck(const Params& P, LDSP unsigned char* lds, int vcu, int G) {
    unsigned char* ws = P.ws;
    const int tid = opaque_tid(), lane = tid & 63, wave = tid >> 6;
    const int gw = vcu * NWAVES + wave, NGW = G * NWAVES;
    unsigned* cnt = (unsigned*)(ws + OFF_CHK);
    const bf16_t* qa = (const bf16_t*)(ws + OFF_R1);
    const bf16_t* ka = (const bf16_t*)(ws + OFF_R1 + 32 * MiB);
    const bf16_t* va = (const bf16_t*)(ws + OFF_R1 + 64 * MiB);
    const bf16_t* qb = (const bf16_t*)(ws + OFF_R1 + 96 * MiB);
    const bf16_t* ya = (const bf16_t*)(ws + OFF_R0);
    const bf16_t* yb = (const bf16_t*)(ws + OFF_R0 + 32 * MiB);
    const float* kmean = (const float*)(ws + OFF_KMEAN);
    const float* bgate = (const float*)(ws + OFF_BGATE);
    LDSP float* psum = (LDSP float*)(lds + wave * 4096);
    LDSP float* qs = psum + 320;
    LDSP float* ocs = psum + 384;
    constexpr int NS = 537;
#pragma unroll 1
    for (int item = gw; item < NS * 8; item += NGW) {
        const int t = 37 + 61 * (item >> 3), h = item & 7, b = t >> 12, pos = t & (SEQ - 1), own = pos >> 8;
        qs[lane] = bf2f(qa[(size_t)t * 512 + h * 64 + lane]);
        asm volatile("s_waitcnt lgkmcnt(0)" ::: "memory");
        float g0 = -INFINITY, g1 = -INFINITY, g2 = -INFINITY; int i0 = -1, i1 = -1, i2 = -1;
#pragma unroll 1
        for (int j = 0; j < own; ++j) {
            const float* km = kmean + (size_t)((b * 8 + h) * 16 + j) * 64;
            float d = 0.f;
#pragma unroll 8
            for (int i = 0; i < 64; ++i) d += qs[i] * km[i];
            if (d > g0) { g2 = g1; i2 = i1; g1 = g0; i1 = i0; g0 = d; i0 = j; }
            else if (d > g1) { g2 = g1; i2 = i1; g1 = d; i1 = j; }
            else if (d > g2) { g2 = d; i2 = j; }
        }
        NaiveAcc a; nacc_reset(a);
#pragma unroll 1
        for (int j = 0; j <= own; ++j) {
            if (j < own && j != i0 && j != i1 && j != i2) continue;
#pragma unroll 1
            for (int ck = 0; ck < 4; ++ck) {
                const int kp = j * 256 + ck * 64 + lane;
                const size_t kr = (size_t)(b * SEQ + kp) * 512 + h * 64;
                naive_chunk(a, qs, ka + kr, va + kr, kp <= pos);
            }
        }
        const float om = nacc_final(a, lane);
        const float e = cmp_err(om, ya + (size_t)t * 512 + h * 64, lane);
        if (lane == 0 && !(e < 0.05f)) atomicAdd(cnt + 0, 1u);
        asm volatile("s_waitcnt lgkmcnt(0)" ::: "memory");
    }
#pragma unroll 1
    for (int item = gw; item < NS * 2; item += NGW) {
        const int t = 37 + 61 * (item >> 1), g = item & 1, b = t >> 12, pos = t & (SEQ - 1), own = pos >> 6;
        const bf16_t* kc = (const bf16_t*)(ws + OFF_KC) + (size_t)(b * 2 + g) * 256 * 64;
        const bf16_t* vc = (const bf16_t*)(ws + OFF_VC) + (size_t)(b * 2 + g) * 256 * 64;
        const bf16_t* ks = (const bf16_t*)(ws + OFF_R2 + 16 * MiB) + (size_t)(b * SEQ) * 128 + g * 64;
        const bf16_t* vs = (const bf16_t*)(ws + OFF_R2 + 24 * MiB) + (size_t)(b * SEQ) * 128 + g * 64;
        const bf16_t* kw = (const bf16_t*)(ws + OFF_R2 + 32 * MiB) + (size_t)(b * SEQ) * 128 + g * 64;
        const bf16_t* vw = (const bf16_t*)(ws + OFF_R2 + 40 * MiB) + (size_t)(b * SEQ) * 128 + g * 64;
        for (int i = lane; i < 320; i += 64) psum[i] = 0.f;
        asm volatile("s_waitcnt lgkmcnt(0)" ::: "memory");
        const int ncmp_vis = (pos >= 31) ? ((pos - 31) >> 4) + 1 : 0;
#pragma unroll 1
        for (int r = 0; r < 4; ++r) {
            qs[lane] = bf2f(qb[(size_t)t * 512 + (g * 4 + r) * 64 + lane]);
            asm volatile("s_waitcnt lgkmcnt(0)" ::: "memory");
            float mx = -INFINITY;
#pragma unroll 1
            for (int ck = 0; ck < 4; ++ck) { const int n = ck * 64 + lane;
                const float sdot = dot64(qs, kc + (size_t)n * 64);
                mx = fmaxf(mx, (n < ncmp_vis) ? sdot : -INFINITY); }
            mx = wave_max(mx);
            float l = 0.f;
#pragma unroll 1
            for (int ck = 0; ck < 4; ++ck) { const int n = ck * 64 + lane;
                const float sdot = dot64(qs, kc + (size_t)n * 64);
                l += (n < ncmp_vis) ? exp2f(sdot - mx) : 0.f; }
            l = wave_sum(l);
            const float inv = (l > 0.f) ? 1.0f / l : 0.f;
            NaiveAcc a; nacc_reset(a);
#pragma unroll 1
            for (int ck = 0; ck < 4; ++ck) { const int n = ck * 64 + lane;
                const float sdot = dot64(qs, kc + (size_t)n * 64);
                const float pr = (n < ncmp_vis) ? exp2f(sdot - mx) * inv : 0.f;
                psum[n] += pr;
                axpy64(a, 1.0f, pr, vc + (size_t)n * 64); }
            a.l = (lane == 0) ? 1.f : 0.f;
            ocs[r * 64 + lane] = nacc_final(a, lane);
            asm volatile("s_waitcnt lgkmcnt(0)" ::: "memory");
        }
        {
            const int j = lane;
            float imp = 0.f;
            for (int n = 4 * j - 1; n <= 4 * j + 3; ++n) if (n >= 0 && n < 255) imp += psum[n];
            if (j == 0 || j == own || j == own - 1) imp = 1.0e30f;
            if (j > own) imp = -1.0e30f;
            unsigned long long sel = 0ull;
#pragma unroll 1
            for (int r = 0; r < 16; ++r) {
                float v = imp; int i = j;
                wave_argmax(v, i);
                if (v > -0.5e30f) sel |= 1ull << i;
                if (i == j) imp = -3.0e38f;
            }
            psum[256] = __uint_as_float((unsigned)sel); psum[257] = __uint_as_float((unsigned)(sel >> 32));
            asm volatile("s_waitcnt lgkmcnt(0)" ::: "memory");
        }
        const unsigned long long sel = ((unsigned long long)__float_as_uint(psum[257]) << 32) | __float_as_uint(psum[256]);
#pragma unroll 1
        for (int r = 0; r < 4; ++r) {
            const int head = g * 4 + r;
            qs[lane] = bf2f(qb[(size_t)t * 512 + head * 64 + lane]);
            asm volatile("s_waitcnt lgkmcnt(0)" ::: "memory");
            const float gt0 = bgate[(size_t)t * 24 + head * 3], gt1 = bgate[(size_t)t * 24 + head * 3 + 1], gt2 = bgate[(size_t)t * 24 + head * 3 + 2];
            float y = gt0 * ocs[r * 64 + lane];
            NaiveAcc a; nacc_reset(a);
#pragma unroll 1
            for (int j = 0; j <= own; ++j) {
                if (!((sel >> j) & 1ull)) continue;
                const int kp = j * 64 + lane;
                naive_chunk(a, qs, ks + (size_t)kp * 128, vs + (size_t)kp * 128, kp <= pos);
            }
            y += gt1 * nacc_final(a, lane);
            nacc_reset(a);
#pragma unroll 1
            for (int ck = 0; ck < 9; ++ck) {
                const int kp = pos - 575 + ck * 64 + lane;
                const bool valid = kp >= 0 && kp <= pos && kp > pos - 512;
                const int kpc = kp < 0 ? 0 : kp;
                naive_chunk(a, qs, kw + (size_t)kpc * 128, vw + (size_t)kpc * 128, valid);
            }
            y += gt2 * nacc_final(a, lane);
            const float e = cmp_err(y, yb + (size_t)t * 512 + head * 64, lane);
            if (lane == 0 && !(e < 0.05f)) atomicAdd(cnt + 1, 1u);
            asm volatile("s_waitcnt lgkmcnt(0)" ::: "memory");
        }
    }
}

__device__ __forceinline__ void phase_selfcheck2(const Params& P, LDSP unsigned char* lds, int vcu, int G) {
    unsigned char* ws = P.ws;
    const int tid = opaque_tid(), lane = tid & 63, wave = tid >> 6;
    const int gw = vcu * NWAVES + wave, NGW = G * NWAVES;
    unsigned* cnt = (unsigned*)(ws + OFF_CHK);
    LDSP float* hs = (LDSP float*)(lds + wave * 8192);
    const float* x = P.in[I_X]; const float* g1 = P.in[I_NORM1]; const float* w = P.in[I_WIN];
    constexpr int NS = 192, NGRP = 14;
#pragma unroll 1
    for (int item = gw; item < NS * NGRP; item += NGW) {
        const int si = item / NGRP, grp = item % NGRP;
        const int t = 11 + 167 * si, b = t >> 12, pos = t & (SEQ - 1);
        const int hsel = si & 7, gsel = si & 1;
        float ss = 0.f;
        for (int i = lane; i < DM; i += 64) { const float v = x[(size_t)t * DM + i]; ss += v * v; }
        ss = wave_sum(ss);
        const float rs = 1.0f / sqrtf(ss / DM + NORM_EPS);
        for (int i = lane; i < DM; i += 64) hs[i] = x[(size_t)t * DM + i] * rs * g1[i];
        asm volatile("s_waitcnt lgkmcnt(0)" ::: "memory");
        int col0, kind; const float* gain = nullptr; float oscale = 1.f; const bf16_t* got = nullptr; int ncols = 64;
        const bf16_t* R1 = (const bf16_t*)(ws + OFF_R1); const bf16_t* R2 = (const bf16_t*)(ws + OFF_R2); const bf16_t* R3 = (const bf16_t*)(ws + OFF_R3);
        const size_t M32 = (size_t)16 * 1024 * 1024;
        switch (grp) {
        case 0: col0 = hsel * 64;          kind = 1; gain = P.in[I_AQG]; oscale = QSCALE; got = R1 + (size_t)t * 512 + hsel * 64; break;
        case 1: col0 = 512 + hsel * 64;    kind = 1; gain = P.in[I_AKG]; got = R1 + M32 + (size_t)t * 512 + hsel * 64; break;
        case 2: col0 = 1024 + hsel * 64;   kind = 0; got = R1 + 2 * M32 + (size_t)t * 512 + hsel * 64; break;
        case 3: col0 = 1536 + hsel * 64;   kind = 1; gain = P.in[I_BQG]; oscale = QSCALE; got = R1 + 3 * M32 + (size_t)t * 512 + hsel * 64; break;
        case 4: col0 = 2048 + gsel * 64;   kind = 0; got = R2 + ((size_t)((b * 2 + gsel) * SEQ + pos)) * 64; break;
        case 5: col0 = 2176 + gsel * 64;   kind = 0; got = R2 + M32 / 4 + ((size_t)((b * 2 + gsel) * SEQ + pos)) * 64; break;
        case 6: col0 = 2304 + gsel * 64;   kind = 1; gain = P.in[I_BKSG]; got = R2 + 2 * (M32 / 4) + (size_t)t * 128 + gsel * 64; break;
        case 7: col0 = 2432 + gsel * 64;   kind = 0; got = R2 + 3 * (M32 / 4) + (size_t)t * 128 + gsel * 64; break;
        case 8: col0 = 2560 + gsel * 64;   kind = 1; gain = P.in[I_BKWG]; got = R2 + 4 * (M32 / 4) + (size_t)t * 128 + gsel * 64; break;
        case 9: col0 = 2688 + gsel * 64;   kind = 0; got = R2 + 5 * (M32 / 4) + (size_t)t * 128 + gsel * 64; break;
        case 10: col0 = 2840 + hsel * 64;        kind = 2; got = R3 + (size_t)t * 2048 + hsel * 64; break;
        case 11: col0 = 2840 + 1024 + hsel * 64; kind = 2; got = R3 + (size_t)t * 2048 + 1024 + hsel * 64; break;
        case 12: col0 = 2840 + 1024 + 512 + hsel * 64; kind = 2; got = R3 + (size_t)t * 2048 + 1536 + hsel * 64; break;
        default: col0 = 2816; kind = 3; ncols = 24; break;
        }
        if (grp == 10) continue;
        float acc = 0.f;
        if (lane < ncols) {
#pragma unroll 4
            for (int k = 0; k < DM; ++k) acc += hs[k] * w[(size_t)k * 4888 + col0 + lane];
        }
        float ref;
        if (kind == 1) {
            const float ssq = wave_sum(acc * acc);
            float y = acc / sqrtf(ssq / 64.0f + NORM_EPS) * gain[lane];
            const float ya_ = __shfl(y, (lane + 8) & 63), yb_ = __shfl(y, (lane - 8) & 63);
            const int f = lane & 7;
            const float ang = (float)pos * powf(500000.0f, -(float)(2 * f) / 16.0f);
            const float c = cosf(ang), sn = sinf(ang);
            if (lane < 8) y = y * c - ya_ * sn; else if (lane < 16) y = y * c + yb_ * sn;
            ref = y * oscale;
        } else if (kind == 2) {
            ref = 1.0f / (1.0f + expf(-(acc + P.in[I_BMERGE][col0 - 2840 + lane])));
        } else if (kind == 3) {
            ref = 1.0f / (1.0f + expf(-acc));
        } else ref = acc;
        float gotv;
        if (kind == 3) gotv = (lane < 24) ? ((const float*)(ws + OFF_BGATE))[(size_t)t * 24 + lane] : 0.f;
        else gotv = bf2f(got[lane]);
        if (kind == 3 && lane >= 24) ref = 0.f;
        const float e = wave_max(fabsf(ref - gotv)) / (wave_max(fabsf(ref)) + 1e-3f);
        if (lane == 0 && !(e < 0.03f)) atomicAdd(cnt + 0, 1u);
        asm volatile("s_waitcnt lgkmcnt(0)" ::: "memory");
    }
#pragma unroll 1
    for (int item = gw; item < 1024; item += NGW) {
        const int b = item >> 7, h = (item >> 4) & 7, blk = item & 15;
        const bf16_t* p = (const bf16_t*)(ws + OFF_R1 + 32 * MiB) + (size_t)(b * SEQ + blk * 256) * 512 + h * 64 + lane;
        float sref = 0.f;
        for (int k = 0; k < 256; ++k) sref += bf2f(p[(size_t)k * 512]);
        const float gotv = ((const float*)(ws + OFF_KMEAN))[(size_t)item * 64 + lane];
        const float e = wave_max(fabsf(sref - gotv)) / (wave_max(fabsf(sref)) + 1e-2f);
        if (lane == 0 && !(e < 0.03f)) atomicAdd(cnt + 1, 1u);
    }
#pragma unroll 1
    for (int item = gw; item < 96 * 2; item += NGW) {
        const int si = item >> 1, kv = item & 1;
        const int slab = si & 15, n = (si * 37 + 3) % 255;
        const bf16_t* raw = (const bf16_t*)(ws + OFF_R2 + (size_t)kv * 8 * MiB) + (size_t)slab * SEQ * 64 + (size_t)n * 16 * 64;
        const float* posv = P.in[kv ? I_CPV : I_CPK]; const float* w1 = P.in[kv ? I_CVW1 : I_CKW1]; const float* b1 = P.in[kv ? I_CVB1 : I_CKB1];
        const float* w2 = P.in[kv ? I_CVW2 : I_CKW2]; const float* b2 = P.in[kv ? I_CVB2 : I_CKB2];
        float hacc[4] = {0.f, 0.f, 0.f, 0.f};
#pragma unroll 1
        for (int i = 0; i < 2048; ++i) {
            const float a = bf2f(raw[i]) + posv[i];
#pragma unroll
            for (int u = 0; u < 4; ++u) hacc[u] += a * w1[(size_t)i * 256 + lane + 64 * u];
        }
#pragma unroll
        for (int u = 0; u < 4; ++u) { const float z = hacc[u] + b1[lane + 64 * u]; hs[1024 + lane + 64 * u] = 0.5f * z * (1.0f + tanhf(0.7978845608028654f * (z + 0.044715f * z * z * z))); }
        asm volatile("s_waitcnt lgkmcnt(0)" ::: "memory");
        float o = b2[lane];
#pragma unroll 4
        for (int j = 0; j < 256; ++j) o += hs[1024 + j] * w2[(size_t)j * 64 + lane];
        if (!kv) { const float ssq = wave_sum(o * o); o = o / sqrtf(ssq / 64.0f + NORM_EPS) * P.in[I_BKCG][lane]; }
        const float gotv = bf2f(((const bf16_t*)(ws + (kv ? OFF_VC : OFF_KC)))[((size_t)slab * 256 + n) * 64 + lane]);
        const float e = wave_max(fabsf(o - gotv)) / (wave_max(fabsf(o)) + 1e-3f);
        if (lane == 0 && !(e < 0.03f)) atomicAdd(cnt + 1, 1u);
        asm volatile("s_waitcnt lgkmcnt(0)" ::: "memory");
    }
}
#endif

#define XB_TMO      128
#define XB_XCNT(j)  (256  + 64 * (j))
#define XB_XSUB(j)  (1280 + 64 * (j))
#define XB_XGEN(j)  (2304 + 64 * (j))
#define XB_TOP      3328
#define XB_TOPGEN   3392
#define XCD_BAR_WORDS 3456
#define XB_SPIN_CAP (1u << 22)
__device__ __forceinline__ unsigned xb_ld(unsigned* p)              { return __hip_atomic_load(p, __ATOMIC_RELAXED, __HIP_MEMORY_SCOPE_AGENT); }
__device__ __forceinline__ unsigned xb_add(unsigned* p, unsigned v) { return __hip_atomic_fetch_add(p, v, __ATOMIC_RELAXED, __HIP_MEMORY_SCOPE_AGENT); }
__device__ __forceinline__ unsigned xb_xcc_id() { return (unsigned)__builtin_amdgcn_s_getreg((3 << 11) | 20) & 0xFu; }
#define XB_SPIN(cond, bar) do { unsigned _sp = 0; while (cond) { __builtin_amdgcn_s_sleep(1); \
    if ((++_sp & 255u) == 0u) { if (xb_ld(&(bar)[XB_TMO])) break; if (_sp > XB_SPIN_CAP) { atomicAdd(&(bar)[XB_TMO], 1u); break; } } } } while (0)
struct XcdBarrier { unsigned* bar; unsigned x; volatile LDSP unsigned* st; };
__device__ __forceinline__ XcdBarrier xcd_barrier_post(unsigned* bar, volatile LDSP unsigned* st) {
    XcdBarrier b; b.bar = bar; b.x = xb_xcc_id(); b.st = st;
    if (threadIdx.x == 0) (void)xb_add(&bar[XB_XCNT(b.x)], 1u);
    return b;
}
__device__ __forceinline__ void xcd_barrier_complete(unsigned* bar, unsigned x, unsigned& nloc, unsigned& nx) {
    const unsigned G = gridDim.x * gridDim.y * gridDim.z;
    unsigned sum, cnt, mine, sp = 0u;
    for (;;) {
        sum = 0u; cnt = 0u; mine = 0u;
#pragma unroll
        for (unsigned j = 0; j < 16; ++j) { const unsigned c = xb_ld(&bar[XB_XCNT(j)]); sum += c; cnt += (c > 0u) ? 1u : 0u; mine = (j == x) ? c : mine; }
        if (sum == G) break;
        __builtin_amdgcn_s_sleep(1);
        if ((++sp & 255u) == 0u) { if (xb_ld(&bar[XB_TMO])) break; if (sp > XB_SPIN_CAP) { atomicAdd(&bar[XB_TMO], 1u); break; } }
    }
    nloc = mine > 0u ? mine : 1u; nx = cnt > 0u ? cnt : 1u;
}
__device__ __forceinline__ void xcd_barrier(const XcdBarrier& b) {
    asm volatile("s_waitcnt vmcnt(0)" ::: "memory");
    __syncthreads();
    if (threadIdx.x == 0) {
        unsigned* bar = b.bar;
        __builtin_amdgcn_s_waitcnt(0);
        unsigned nloc = b.st[0], nx = b.st[1];
        if (nloc == 0u) { xcd_barrier_complete(bar, b.x, nloc, nx); b.st[0] = nloc; b.st[1] = nx; }
        const unsigned old = xb_add(&bar[XB_XSUB(b.x)], 1u);
        const unsigned gen = old / nloc;
        if (old + 1u == (gen + 1u) * nloc) {
            __builtin_amdgcn_fence(__ATOMIC_RELEASE, "agent");
            asm volatile("s_waitcnt vmcnt(0)" ::: "memory");
            const unsigned og = xb_add(&bar[XB_TOP], 1u);
            const unsigned tg = og / nx;
            if (og + 1u == (tg + 1u) * nx) xb_add(&bar[XB_TOPGEN], 1u);
            else XB_SPIN(xb_ld(&bar[XB_TOPGEN]) == tg, bar);
            __builtin_amdgcn_fence(__ATOMIC_ACQUIRE, "agent");
            xb_add(&bar[XB_XGEN(b.x)], 1u);
            asm volatile("s_waitcnt vmcnt(0)" ::: "memory");
        } else {
            XB_SPIN(xb_ld(&bar[XB_XGEN(b.x)]) == gen, bar);
            __builtin_amdgcn_fence(__ATOMIC_ACQUIRE, "agent");
            asm volatile("s_waitcnt vmcnt(0)" ::: "memory");
        }
    }
    __syncthreads();
}

__global__ void __launch_bounds__(NTHREADS, 2) fwd_kernel(Params P) {
    extern __shared__ __attribute__((aligned(16))) unsigned char lds_raw[];
    LDSP unsigned char* lds = (LDSP unsigned char*)lds_raw;
    const int G = gridDim.x, bx = blockIdx.x;
    const int vcu = (G % 8 == 0) ? (bx % 8) * (G / 8) + bx / 8 : bx;
    const int lo = P.ph_lo, hi = P.ph_hi;
    volatile LDSP unsigned* bst = (volatile LDSP unsigned*)(lds + LDS_BYTES - 16);
    if (threadIdx.x == 0) { bst[0] = 0u; bst[1] = 0u; bst[2] = 0u; bst[3] = 0u; }
    __syncthreads();
    const XcdBarrier xbar = xcd_barrier_post((unsigned*)(P.ws + 16384), bst);
    if (threadIdx.x == 0) bst[2] = xb_add((unsigned*)(P.ws + 32768) + 64 * xbar.x, 1u);
#define IN(k) (lo <= (k) && (k) < hi)
#define SEAM(k) do { if (IN(k) && IN((k) + 1)) xcd_barrier(xbar); } while (0)
    if (IN(0)) phase_prep(P, lds, vcu, G);
    SEAM(0);
    if (IN(1)) phase_proj(P, lds, vcu, G);
    SEAM(1);
    if (IN(2)) phase_cmp(P, lds, vcu, G);
    SEAM(2);
    if (IN(4)) phase_attn(P, lds, vcu, G);
    SEAM(4);
#if SELFCHECK == 1
    phase_selfcheck(P, lds, vcu, G);
    xcd_barrier(xbar);
#elif SELFCHECK == 2
    phase_selfcheck2(P, lds, vcu, G);
    xcd_barrier(xbar);
#endif
    if (IN(5)) phase_up(P, lds, vcu, G);
    SEAM(5);
    if (IN(6)) phase_out(P, lds, vcu, G);
    SEAM(6);
    if (IN(7)) phase_pq(P, lds, vcu, G);
    SEAM(7);
    if (IN(8)) phase_topk(P, lds, vcu, G);
    SEAM(8);
    if (IN(9)) { phase_peer_a(P, lds, vcu, G); xcd_barrier(xbar); phase_peer_w(P, lds, vcu, G); xcd_barrier(xbar); phase_peer_b(P, lds, vcu, G); }
#if SELFCHECK
    xcd_barrier(xbar);
    if (bx == 0 && threadIdx.x == 0) {
        const unsigned* cnt = (const unsigned*)(P.ws + OFF_CHK);
        P.out[0] += 1000.0f * (float)cnt[0];
        P.out[1] += 1000000.0f * (float)cnt[1];
    }
#endif
#undef IN
#undef SEAM
}

extern "C" void kernel_launch(void* const* d_in, const int* in_sizes, int n_in, void* d_out, int out_size, void* d_ws, size_t ws_size, hipStream_t stream) {
    static int grid = 0;
    if (grid == 0) {
        if (n_in != 29 || ws_size < WS_END) { fprintf(stderr, "kernel_launch: unexpected n_in %d / ws_size %zu\n", n_in, ws_size); grid = -1; return; }
        int dev = 0, cus = 0, per_cu = 0;
        (void)hipGetDevice(&dev);
        (void)hipDeviceGetAttribute(&cus, hipDeviceAttributeMultiprocessorCount, dev);
        (void)hipFuncSetAttribute((const void*)fwd_kernel, hipFuncAttributeMaxDynamicSharedMemorySize, LDS_BYTES);
        (void)hipOccupancyMaxActiveBlocksPerMultiprocessor(&per_cu, (const void*)fwd_kernel, NTHREADS, LDS_BYTES);
        if (per_cu < 1) { fprintf(stderr, "kernel_launch: occupancy query says %d blocks per CU\n", per_cu); grid = -1; return; }
        grid = cus;
    }
    if (grid < 0) return;
    Params p{};
    for (int i = 0; i < 29; ++i) p.in[i] = (const float*)d_in[i];
    p.out = (float*)d_out; p.ws = (unsigned char*)d_ws;
    (void)hipMemsetAsync(d_ws, 0, 65536, stream);
    p.ph_lo = 0; p.ph_hi = 10;
    hipLaunchKernelGGL(fwd_kernel, dim3(grid), dim3(NTHREADS), LDS_BYTES, stream, p);
}
```

```cpp
#include <hip/hip_runtime.h>
#include <hip/hip_cooperative_groups.h>
#include <stdint.h>
#include <stdio.h>
#define SELFCHECK 0
namespace cg = cooperative_groups;

#define LDSP __attribute__((address_space(3)))
typedef unsigned short bf16_t;
typedef short bf16x8 __attribute__((ext_vector_type(8)));
typedef short s16x4 __attribute__((ext_vector_type(4)));
typedef float f32x2 __attribute__((ext_vector_type(2)));
typedef float f32x4 __attribute__((ext_vector_type(4)));
typedef float f32x16 __attribute__((ext_vector_type(16)));
typedef unsigned u32x2 __attribute__((ext_vector_type(2)));
typedef unsigned u32x4 __attribute__((ext_vector_type(4)));
typedef __bf16 bf16x2_t __attribute__((ext_vector_type(2)));

constexpr int BATCH = 8, SEQ = 4096, DM = 1024, T = BATCH * SEQ;
constexpr int HD = 64;
constexpr int NPROJ = 5120;
constexpr int PEER_NE = 16384;
constexpr float NORM_EPS = 1e-6f;
constexpr float QSCALE = 0.125f * 1.4426950408889634f;
constexpr int NTHREADS = 512, NWAVES = 8;
constexpr int LDS_BYTES = 140 * 1024;

constexpr size_t MiB = 1u << 20;
constexpr size_t OFF_RS1 = 1 * MiB;
constexpr size_t OFF_RS2 = 1 * MiB + 256 * 1024;
constexpr size_t OFF_ROPE_C = 2 * MiB;
constexpr size_t OFF_ROPE_S = 2 * MiB + 128 * 1024;
constexpr size_t OFF_POSB = 2 * MiB + 512 * 1024;
constexpr size_t OFF_KMEAN = 3 * MiB;
constexpr size_t OFF_BGATE = 4 * MiB;
constexpr size_t OFF_WIN_T = 8 * MiB;
constexpr size_t OFF_WUPA_T = 19 * MiB;
constexpr size_t OFF_WUPB_T = 20 * MiB;
constexpr size_t OFF_WOUT_T = 21 * MiB;
constexpr size_t OFF_WPQ_T = 23 * MiB;
constexpr size_t OFF_W1K_T = 27 * MiB;
constexpr size_t OFF_W1V_T = 28 * MiB;
constexpr size_t OFF_W2K_T = 29 * MiB;
constexpr size_t OFF_W2V_T = 29 * MiB + 128 * 1024;
constexpr size_t OFF_K1B = 29 * MiB + 256 * 1024;
constexpr size_t OFF_K2B = 29 * MiB + 320 * 1024;
constexpr size_t OFF_HID = 30 * MiB;
constexpr size_t OFF_KC = 34 * MiB;
constexpr size_t OFF_VC = 35 * MiB;
constexpr size_t OFF_EXPERTS = 36 * MiB;
constexpr size_t OFF_GATES = 52 * MiB;
constexpr size_t OFF_U = 68 * MiB;
constexpr size_t OFF_PSCALE = 84 * MiB;
constexpr size_t OFF_V = 100 * MiB;
constexpr size_t OFF_R0 = 132 * MiB;
constexpr size_t OFF_R1 = 196 * MiB;
constexpr size_t OFF_R2 = 324 * MiB;
constexpr size_t OFF_R3 = 372 * MiB;
constexpr size_t WS_END = 500 * MiB;

struct Params {
    const float* in[29];
    float* out;
    unsigned char* ws;
    int ph_lo, ph_hi;
};
static_assert(sizeof(Params) == 31 * 8 + 8, "Params has no padding");

enum { I_X = 0, I_NORM1, I_WIN, I_BMERGE, I_AQG, I_AKG, I_BQG, I_BKCG, I_BKSG, I_BKWG,
       I_CPK, I_CKW1, I_CKB1, I_CKW2, I_CKB2, I_CPV, I_CVW1, I_CVB1, I_CVW2, I_CVB2,
       I_WUPA, I_WUPB, I_WOUT, I_NORM2, I_PWQ, I_PK1, I_PK2, I_PU, I_PV };

__device__ __forceinline__ int opaque_tid() { int t = threadIdx.x; asm volatile("" : "+v"(t)); return t; }
__device__ __forceinline__ unsigned pk2(float lo, float hi) {
    f32x2 v = {lo, hi};
    bf16x2_t b = __builtin_convertvector(v, bf16x2_t);
    return __builtin_bit_cast(unsigned, b);
}
__device__ __forceinline__ float bf2f(bf16_t b) { return __uint_as_float(((unsigned)b) << 16); }
__device__ __forceinline__ float wave_sum(float v) {
#pragma unroll
    for (int o = 1; o < 64; o <<= 1) v += __shfl_xor(v, o);
    return v;
}
__device__ __forceinline__ float sum_xor16(float v) { const auto r = __builtin_amdgcn_permlane16_swap(__float_as_uint(v), __float_as_uint(v), false, false); return __uint_as_float(r[0]) + __uint_as_float(r[1]); }
__device__ __forceinline__ float sum_xor32(float v) { const auto r = __builtin_amdgcn_permlane32_swap(__float_as_uint(v), __float_as_uint(v), false, false); return __uint_as_float(r[0]) + __uint_as_float(r[1]); }
__device__ __forceinline__ float get_xor16(float v, bool odd_row) { const auto r = __builtin_amdgcn_permlane16_swap(__float_as_uint(v), __float_as_uint(v), false, false); return __uint_as_float(odd_row ? r[0] : r[1]); }
__device__ __forceinline__ float gelu_tanh(float x) {
    const float u = 0.7978845608028654f * (x + 0.044715f * x * x * x);
    return x * __builtin_amdgcn_rcpf(1.0f + __expf(-2.0f * u));
}
__device__ __forceinline__ float sigmoidf_(float x) { return __builtin_amdgcn_rcpf(1.0f + __expf(-x)); }
__device__ __forceinline__ void cvt8(const u32x4 w, float (&f)[8]) {
    f[0] = __uint_as_float(w.x << 16); f[1] = __uint_as_float(w.x & 0xffff0000u); f[2] = __uint_as_float(w.y << 16); f[3] = __uint_as_float(w.y & 0xffff0000u);
    f[4] = __uint_as_float(w.z << 16); f[5] = __uint_as_float(w.z & 0xffff0000u); f[6] = __uint_as_float(w.w << 16); f[7] = __uint_as_float(w.w & 0xffff0000u);
}
__device__ __forceinline__ int swz_off(int row, int chunk) { return row * 128 + ((chunk ^ ((row >> 1) & 7)) << 4); }

__device__ __forceinline__ void transpose_item(const float* W, int ldw, int k0, int src_c0, int nvalid, const float* kscale,
                                               bf16_t* WT, int ldwt, int n0, LDSP float* scr, int lane) {
    const int ch = lane & 7, r0 = lane >> 3;
    f32x4 v[8]; float ks[8];
#pragma unroll
    for (int i = 0; i < 8; ++i) {
        const int kk = r0 + 8 * i;
        v[i] = (f32x4){0.f, 0.f, 0.f, 0.f};
        if (4 * ch < nvalid) v[i] = *(const f32x4*)(W + (size_t)(k0 + kk) * ldw + src_c0 + 4 * ch);
        ks[i] = kscale ? kscale[k0 + kk] : 1.0f;
    }
#pragma unroll
    for (int i = 0; i < 8; ++i) {
        LDSP float* d = scr + (r0 + 8 * i) * 33 + 4 * ch;
        d[0] = v[i].x * ks[i]; d[1] = v[i].y * ks[i]; d[2] = v[i].z * ks[i]; d[3] = v[i].w * ks[i];
    }
    asm volatile("s_waitcnt lgkmcnt(0)" ::: "memory");
    const int c = lane & 7;
#pragma unroll
    for (int j = 0; j < 4; ++j) {
        const int n = (lane >> 3) + 8 * j;
        const LDSP float* s = scr + (8 * c) * 33 + n;
        u32x4 o;
        o.x = pk2(s[0 * 33], s[1 * 33]); o.y = pk2(s[2 * 33], s[3 * 33]); o.z = pk2(s[4 * 33], s[5 * 33]); o.w = pk2(s[6 * 33], s[7 * 33]);
        *(u32x4*)(WT + (size_t)(n0 + n) * ldwt + k0 + 8 * c) = o;
    }
    asm volatile("s_waitcnt lgkmcnt(0)" ::: "memory");
}

struct TrJob { const float* W; int K, N, ldw; const float* kscale; bf16_t* WT; int kind; };

__device__ __forceinline__ void run_tr_job(const TrJob& J, int item, LDSP float* scr, int lane) {
    const int nblk = J.N / 32, kb = item / nblk, nb = item % nblk;
    int src_c0 = nb * 32, nvalid = 32;
    if (J.kind == 1) {
        const int p0 = nb * 32, pn = p0 >> 8, q = p0 & 255, bj = q >> 7, wc = (q >> 5) & 3, H = 4 * pn + wc, d0 = 32 * bj;
        if (H < 44) src_c0 = 64 * H + d0;
        else if (H < 76) src_c0 = 64 * H + d0 + 24;
        else if (H == 76 && bj == 0) { src_c0 = 2816; nvalid = 24; }
        else { src_c0 = 0; nvalid = 0; }
    } else if (J.kind == 2) {
        if (nb * 32 >= 64) { src_c0 = 0; nvalid = 0; }
    }
    transpose_item(J.W, J.ldw, kb * 64, src_c0, nvalid, J.kscale, J.WT, J.K, nb * 32, scr, lane);
}

__device__ __forceinline__ void phase_prep(const Params& P, LDSP unsigned char* lds, int vcu, int G) {
    const int tid = opaque_tid(), lane = tid & 63, wave = tid >> 6;
    const int gw = vcu * NWAVES + wave, NGW = G * NWAVES;
    unsigned char* ws = P.ws;
    LDSP float* scr = (LDSP float*)(lds + wave * 8704);
    int base = 0;
#define TR_JOB(Wp, Kk, Nn, LDW, KS, WTp, KIND) do { TrJob J{Wp, Kk, Nn, LDW, KS, WTp, KIND}; const int nitems = ((Kk) / 64) * ((Nn) / 32); \
        const int first = (gw - base % NGW + NGW) % NGW; for (int it = first; it < nitems; it += NGW) run_tr_job(J, it, scr, lane); base += nitems; } while (0)
    TR_JOB(P.in[I_WIN], 1024, NPROJ, 4888, P.in[I_NORM1], (bf16_t*)(ws + OFF_WIN_T), 1);
    TR_JOB(P.in[I_WUPA], 512, 1024, 1024, nullptr, (bf16_t*)(ws + OFF_WUPA_T), 0);
    TR_JOB(P.in[I_WUPB], 512, 1024, 1024, nullptr, (bf16_t*)(ws + OFF_WUPB_T), 0);
    TR_JOB(P.in[I_WOUT], 1024, 1024, 1024, nullptr, (bf16_t*)(ws + OFF_WOUT_T), 0);
    TR_JOB(P.in[I_PWQ], 1024, 2048, 2048, P.in[I_NORM2], (bf16_t*)(ws + OFF_WPQ_T), 0);
    TR_JOB(P.in[I_CKW1], 2048, 256, 256, nullptr, (bf16_t*)(ws + OFF_W1K_T), 0);
    TR_JOB(P.in[I_CVW1], 2048, 256, 256, nullptr, (bf16_t*)(ws + OFF_W1V_T), 0);
    TR_JOB(P.in[I_CKW2], 256, 128, 64, nullptr, (bf16_t*)(ws + OFF_W2K_T), 2);
    TR_JOB(P.in[I_CVW2], 256, 128, 64, nullptr, (bf16_t*)(ws + OFF_W2V_T), 2);
#undef TR_JOB
    {
        const float* x = P.in[I_X];
        bf16_t* xb = (bf16_t*)(ws + OFF_R0);
        float* rs1 = (float*)(ws + OFF_RS1);
#pragma unroll 4
        for (int m = gw; m < T; m += NGW) {
            const f32x4* xr = (const f32x4*)(x + (size_t)m * DM) + lane;
            f32x4 v[4]; float s = 0.f;
#pragma unroll
            for (int j = 0; j < 4; ++j) { v[j] = xr[64 * j]; s += (v[j].x * v[j].x + v[j].y * v[j].y) + (v[j].z * v[j].z + v[j].w * v[j].w); }
            s = wave_sum(s);
            if (lane == 0) rs1[m] = 1.0f / sqrtf(s * (1.0f / DM) + NORM_EPS);
            u32x2* o = (u32x2*)(xb + (size_t)m * DM) + lane;
#pragma unroll
            for (int j = 0; j < 4; ++j) { u32x2 w; w.x = pk2(v[j].x, v[j].y); w.y = pk2(v[j].z, v[j].w); o[64 * j] = w; }
        }
    }
    {
        const float* g2 = P.in[I_NORM2];
        f32x4 g4[4];
#pragma unroll
        for (int q = 0; q < 4; ++q) g4[q] = *(const f32x4*)(g2 + 256 * q + 4 * lane);
        float* scales = (float*)(ws + OFF_PSCALE);
#pragma unroll 4
        for (int r = gw; r < 2 * PEER_NE; r += NGW) {
            const int which = (r >= PEER_NE) ? 1 : 0, e = r & (PEER_NE - 1);
            const float* src = P.in[which ? I_PV : I_PU] + (size_t)e * DM + 4 * lane;
            f32x4 a[4]; float ss = 0.f;
#pragma unroll
            for (int q = 0; q < 4; ++q) { a[q] = *(const f32x4*)(src + 256 * q); if (!which) a[q] = a[q] * g4[q];
                ss += (a[q].x * a[q].x + a[q].y * a[q].y) + (a[q].z * a[q].z + a[q].w * a[q].w); }
            ss = wave_sum(ss);
            const float rms = sqrtf(ss * (1.0f / DM));
            if (which) {
                const float sc = (rms > 0.f) ? 0.5f * rms : 1.0f, inv = 1.0f / sc;
                unsigned char* dst = ws + OFF_V + (size_t)e * 128 + 2 * lane;
#pragma unroll
                for (int q = 0; q < 4; ++q) {
                    unsigned pq = 0;
                    pq = __builtin_amdgcn_cvt_scalef32_pk_fp4_f32(pq, a[q].x * inv, a[q].y * inv, 1.0f, 0);
                    pq = __builtin_amdgcn_cvt_scalef32_pk_fp4_f32(pq, a[q].z * inv, a[q].w * inv, 1.0f, 1);
                    *(unsigned short*)(dst + (size_t)q * PEER_NE * 128) = (unsigned short)pq;
                }
                if (lane == 0) scales[2 * e + which] = sc;
            } else {
                const float sc = (rms > 0.f) ? rms * (2.5f / 7.0f) : 1.0f, inv = 1.0f / sc;
                const int b8 = 8 * (lane & 1);
#pragma unroll
                for (int q = 0; q < 4; ++q) {
                    const int n0 = (int)fminf(fmaxf(rintf(a[q].x * inv), -7.f), 7.f) & 15, n1 = (int)fminf(fmaxf(rintf(a[q].y * inv), -7.f), 7.f) & 15;
                    const int n2 = (int)fminf(fmaxf(rintf(a[q].z * inv), -7.f), 7.f) & 15, n3 = (int)fminf(fmaxf(rintf(a[q].w * inv), -7.f), 7.f) & 15;
                    const unsigned part = ((unsigned)n0 << b8) | ((unsigned)n2 << (b8 + 4)) | ((unsigned)n1 << (b8 + 16)) | ((unsigned)n3 << (b8 + 20));
                    const unsigned full = part | (unsigned)__shfl_xor((int)part, 1);
                    if (!(lane & 1)) *(unsigned*)(ws + OFF_U + ((size_t)q * PEER_NE + e) * 128 + 4 * (lane >> 1)) = full;
                }
                if (lane == 0) scales[2 * e + which] = sc;
            }
        }
    }
    {
        const int gt = gw * 64 + lane, NGT = NGW * 64;
        for (int i = gt; i < 2 * 128 * 128; i += NGT) {
            const int w = i >> 14, e = i & 16383;
            const float v = P.in[w ? I_PK2 : I_PK1][e];
            ((bf16_t*)(ws + (w ? OFF_K2B : OFF_K1B)))[e] = (bf16_t)(pk2(v, 0.f) & 0xffff);
        }
        if (gt < 8) ((float*)(ws + OFF_ROPE_C))[gt] = powf(500000.0f, -(float)(2 * gt) / 16.0f) * 0.15915494309189535f;
        for (int i = gt; i < T; i += NGT) ((float*)(ws + OFF_RS2))[i] = 0.f;
        for (int i = gt; i < 8 * 8 * 16 * 64; i += NGT) ((float*)(ws + OFF_KMEAN))[i] = 0.f;
        if (gt < 2) ((unsigned*)(ws + 512 * 1024))[gt] = 0u;
        for (int it = 0; it < 128; ++it) {
            if ((it * 16 + 5) % NGW != gw) continue;
            const int w = it >> 6, j4 = (it & 63) * 4;
            const float* pos = P.in[w ? I_CPV : I_CPK] + lane;
            const float* w1 = P.in[w ? I_CVW1 : I_CKW1] + (size_t)lane * 256 + j4;
            f32x4 rowv[32]; float pv[32];
#pragma unroll
            for (int k = 0; k < 32; ++k) { rowv[k] = *(const f32x4*)(w1 + (size_t)k * 64 * 256); pv[k] = pos[64 * k]; }
            f32x4 s4 = {0.f, 0.f, 0.f, 0.f};
#pragma unroll
            for (int k = 0; k < 32; ++k) s4 += rowv[k] * pv[k];
            s4.x = wave_sum(s4.x); s4.y = wave_sum(s4.y); s4.z = wave_sum(s4.z); s4.w = wave_sum(s4.w);
            if (lane == 0) *(f32x4*)((float*)(ws + OFF_POSB) + w * 256 + j4) = s4 + *(const f32x4*)(P.in[w ? I_CVB1 : I_CKB1] + j4);
        }
    }
}

constexpr int G_BM = 256, G_BN = 128, G_BK = 64;
constexpr int G_ABYTES = G_BM * 128, G_BBYTES = G_BN * 128, G_STAGE = G_ABYTES + G_BBYTES;

__device__ __forceinline__ void gemm_kloop(f32x4 (&acc)[4][4], const bf16_t* A, size_t lda, const bf16_t* Bt, size_t ldb, int K, LDSP unsigned char* lds) {
    const int tid = opaque_tid(), lane = tid & 63, wid = tid >> 6, wm = wid >> 1, wn = wid & 1, fr = lane & 15, fq = lane >> 4;
    const int lrow = tid >> 3, lch = tid & 7;
    const bf16_t* ga = A + (size_t)lrow * lda + lch * 8;
    const bf16_t* gb = Bt + (size_t)lrow * ldb + lch * 8;
    u32x4 ra[4], rb[2];
    const int nk = K / G_BK;
#pragma unroll
    for (int p = 0; p < 4; ++p) ra[p] = *(const u32x4*)(ga + (size_t)(64 * p) * lda);
#pragma unroll
    for (int p = 0; p < 2; ++p) rb[p] = *(const u32x4*)(gb + (size_t)(64 * p) * ldb);
    __syncthreads();
#pragma unroll
    for (int p = 0; p < 4; ++p) *(LDSP u32x4*)(lds + swz_off(lrow + 64 * p, lch)) = ra[p];
#pragma unroll
    for (int p = 0; p < 2; ++p) *(LDSP u32x4*)(lds + G_ABYTES + swz_off(lrow + 64 * p, lch)) = rb[p];
    __syncthreads();
    for (int kt = 0; kt < nk; ++kt) {
        LDSP unsigned char* cur = lds + (kt & 1) * G_STAGE;
        LDSP unsigned char* nxt = lds + ((kt + 1) & 1) * G_STAGE;
        if (kt + 1 < nk) {
#pragma unroll
            for (int p = 0; p < 4; ++p) ra[p] = *(const u32x4*)(ga + (size_t)(64 * p) * lda + (kt + 1) * G_BK);
#pragma unroll
            for (int p = 0; p < 2; ++p) rb[p] = *(const u32x4*)(gb + (size_t)(64 * p) * ldb + (kt + 1) * G_BK);
        }
#pragma unroll
        for (int ks = 0; ks < 2; ++ks) {
            bf16x8 af[4], bfr[4];
#pragma unroll
            for (int m = 0; m < 4; ++m) af[m] = *(const LDSP bf16x8*)(cur + swz_off(wm * 64 + m * 16 + fr, ks * 4 + fq));
#pragma unroll
            for (int n = 0; n < 4; ++n) bfr[n] = *(const LDSP bf16x8*)(cur + G_ABYTES + swz_off(wn * 64 + n * 16 + fr, ks * 4 + fq));
#pragma unroll
            for (int m = 0; m < 4; ++m)
#pragma unroll
                for (int n = 0; n < 4; ++n) acc[m][n] = __builtin_amdgcn_mfma_f32_16x16x32_bf16(bfr[n], af[m], acc[m][n], 0, 0, 0);
        }
        if (kt + 1 < nk) {
#pragma unroll
            for (int p = 0; p < 4; ++p) *(LDSP u32x4*)(nxt + swz_off(lrow + 64 * p, lch)) = ra[p];
#pragma unroll
            for (int p = 0; p < 2; ++p) *(LDSP u32x4*)(nxt + G_ABYTES + swz_off(lrow + 64 * p, lch)) = rb[p];
        }
        __syncthreads();
    }
}

__device__ __forceinline__ void zero_acc(f32x4 (&acc)[4][4]) {
#pragma unroll
    for (int m = 0; m < 4; ++m)
#pragma unroll
        for (int n = 0; n < 4; ++n) acc[m][n] = (f32x4){0.f, 0.f, 0.f, 0.f};
}

__device__ __forceinline__ bool tile_order(int it, int vcu, int G, int nM, int nN, int& tm, int& tn) {
    if (G == 256 && (nM % 32) == 0) {
        const int xcd = vcu >> 5, cu = vcu & 31, mper = nM / 8;
        const int L = it * 32 + cu, per_group = 4 * nN;
        if (L >= mper * nN) return false;
        const int mg = L / per_group, rem = L % per_group;
        tm = xcd * mper + mg * 4 + (rem & 3); tn = rem >> 2;
        return true;
    }
    const int L = it * G + vcu;
    if (L >= nM * nN) return false;
    tm = L / nN; tn = L % nN;
    return true;
}

namespace pg8 {
constexpr int BM = 256, BK = 64, HALF = 128, HTB = HALF * BK * 2, NXCD = 8, WGM = 8;
__device__ __forceinline__ int lds_byte(int r, int c) { const int st = (r >> 4) * 2 + (c >> 5), rr = r & 15, cc = c & 31, ob = rr * 64 + cc * 2; return st * 1024 + (ob ^ (((ob >> 9) & 1) << 5)); }
__device__ __forceinline__ void stage_rc(int b, int& R, int& C) { const int st = b / 1024, sb = b % 1024, swz = sb ^ (((sb >> 9) & 1) << 5); R = (st >> 1) * 16 + swz / 64; C = (st & 1) * 32 + (swz % 64) / 2; }
__device__ __forceinline__ int perm32(int rho) { const int n = rho >> 4, i = rho & 15; return 8 * (i >> 2) + 4 * n + (i & 3); }
struct Unit { int pm, pn, z; };
__device__ __forceinline__ bool tile_of(int L, int nM, int nN, int& pm, int& pn) {
    const int nwg = nM * nN; if (L >= nwg) return false;
    int wgid = L; { const int q = nwg / NXCD, r = nwg % NXCD, xcd = wgid % NXCD, off = wgid / NXCD; wgid = (xcd < r ? xcd * (q + 1) : r * (q + 1) + (xcd - r) * q) + off; }
    const int nig = WGM * nN, gid = wgid / nig, fm = gid * WGM, gsz = (nM - fm) < WGM ? (nM - fm) : WGM;
    pm = fm + ((wgid % nig) % gsz); pn = (wgid % nig) / gsz; return true;
}
struct Sched {
    const bf16_t *A0, *A1, *B0, *B1; size_t lda, ldb; int K, nM, nN, NZ, G, c;
    __device__ __forceinline__ bool next(int i, Unit& u) const { u.z = (NZ == 2) ? (i & 1) : 0; const int ti = (NZ == 2) ? (i >> 1) : i; return tile_of(ti * G + c, nM, nN, u.pm, u.pn); }
    __device__ __forceinline__ const char* aptr(const Unit& u) const { return (const char*)((u.z ? A1 : A0) + (size_t)u.pm * BM * lda); }
    __device__ __forceinline__ const char* bptr(const Unit& u) const { return (const char*)((u.z ? B1 : B0) + (size_t)u.pn * BM * ldb); }
};
template <class Epi>
__device__ __forceinline__ void gemm_phase(LDSP unsigned char* lds, const Sched& S, const Epi& E) {
    const int tid = opaque_tid(), wid = __builtin_amdgcn_readfirstlane(tid >> 6), lane = tid & 63, wr = wid >> 2, wc = wid & 3, fr = lane & 15, fq = lane >> 4;
    const int nt = S.K / BK;
    unsigned voffA[2], voffB[2];
#pragma unroll
    for (int i = 0; i < 2; ++i) { int R, C; stage_rc(tid * 16 + i * 8192, R, C); const int Rb = (R & ~31) + perm32(R & 31);
        voffA[i] = (unsigned)(R * S.lda + C) * 2u; voffB[i] = (unsigned)(Rb * S.ldb + C) * 2u; }
    const size_t kstep = (size_t)(BK * 2);
    const size_t hstepA = (size_t)HALF * S.lda * 2, hstepB = (size_t)HALF * S.ldb * 2;
    const unsigned ldsw = (unsigned)wid * 1024u;
    const int aoff = lds_byte(wr * 64 + fr, fq * 8), boff = lds_byte(wc * 32 + fr, fq * 8);
#define PG8_SA(b, h) (((b) * 2 + (h)) * HTB)
#define PG8_SB(b, h) ((4 + (b) * 2 + (h)) * HTB)
#define PG8_STAGE(bufoff, gbase, voff) do { _Pragma("unroll") for (int _i = 0; _i < 2; ++_i) \
        __builtin_amdgcn_global_load_lds((const unsigned*)((const char*)(gbase) + (voff)[_i]), (LDSP unsigned*)(lds + (bufoff) + ldsw + _i * 8192), 16, 0, 0); } while (0)
#define PG8_LDA(dst, b, h) do { _Pragma("unroll") for (int m = 0; m < 4; ++m) _Pragma("unroll") for (int k = 0; k < 2; ++k) dst[m][k] = *(const LDSP bf16x8*)(lds + PG8_SA(b, h) + aoff + m * 2048 + k * 1024); } while (0)
#define PG8_LDB(dst, b, h) do { _Pragma("unroll") for (int n = 0; n < 2; ++n) _Pragma("unroll") for (int k = 0; k < 2; ++k) dst[n][k] = *(const LDSP bf16x8*)(lds + PG8_SB(b, h) + boff + n * 2048 + k * 1024); } while (0)
#define PG8_MMA(ai, bj, At, Bt) do { __builtin_amdgcn_s_setprio(1); _Pragma("unroll") for (int m = 0; m < 4; ++m) _Pragma("unroll") for (int n = 0; n < 2; ++n) _Pragma("unroll") for (int k = 0; k < 2; ++k) \
        acc[ai][bj][m][n] = __builtin_amdgcn_mfma_f32_16x16x32_bf16(Bt[n][k], At[m][k], acc[ai][bj][m][n], 0, 0, 0); __builtin_amdgcn_s_setprio(0); } while (0)
#define PG8_WAIT_V(n) asm volatile("s_waitcnt vmcnt(" #n ")" ::: "memory")
#define PG8_WAIT_L(n) asm volatile("s_waitcnt lgkmcnt(" #n ")" ::: "memory")
#define PG8_BAR __builtin_amdgcn_s_barrier()
#define PG8_SCHED __builtin_amdgcn_sched_barrier(0)
    Unit cur, nxt; int ui = 0;
    if (!S.next(0, cur)) return;
    f32x4 acc[2][2][4][2];
#pragma unroll
    for (int a = 0; a < 2; ++a)
#pragma unroll
        for (int b = 0; b < 2; ++b)
#pragma unroll
            for (int m = 0; m < 4; ++m)
#pragma unroll
                for (int n = 0; n < 2; ++n) acc[a][b][m][n] = (f32x4){0.f, 0.f, 0.f, 0.f};
    bf16x8 At[4][2], B0[2][2], B1[2][2];
    const char* cA = S.aptr(cur); const char* cB = S.bptr(cur);
    PG8_STAGE(PG8_SB(0, 0), cB, voffB); PG8_STAGE(PG8_SB(0, 1), cB + hstepB, voffB); PG8_STAGE(PG8_SA(0, 0), cA, voffA); PG8_STAGE(PG8_SA(0, 1), cA + hstepA, voffA);
    if (wr == 1) PG8_BAR;
    PG8_WAIT_V(2); PG8_BAR;
    PG8_STAGE(PG8_SB(1, 0), cB + kstep, voffB); PG8_STAGE(PG8_SA(1, 0), cA + kstep, voffA); PG8_STAGE(PG8_SB(1, 1), cB + hstepB + kstep, voffB);
    PG8_WAIT_V(6); PG8_BAR;
    for (;;) {
        const bool has_next = S.next(ui + 1, nxt);
        const char* nA = has_next ? S.aptr(nxt) : cA; const char* nB = has_next ? S.bptr(nxt) : cB;
        for (int t = 0; t < nt; t += 2) {
            const bool last = (t == nt - 2);
            const char* a1 = cA + (size_t)(t + 1) * kstep;
            const char* a2 = last ? nA : cA + (size_t)(t + 2) * kstep; const char* b2 = last ? nB : cB + (size_t)(t + 2) * kstep;
            const char* a3 = a2 + kstep; const char* b3 = b2 + kstep;
            PG8_LDB(B0, 0, 0); PG8_LDB(B1, 0, 1); PG8_SCHED; PG8_LDA(At, 0, 0); PG8_STAGE(PG8_SA(1, 1), a1 + hstepA, voffA);
            PG8_WAIT_V(8); PG8_WAIT_L(0); PG8_BAR; PG8_MMA(0, 0, At, B0); PG8_MMA(0, 1, At, B1); PG8_BAR; PG8_SCHED;
            PG8_LDA(At, 0, 1); PG8_STAGE(PG8_SB(0, 0), b2, voffB); PG8_STAGE(PG8_SB(0, 1), b2 + hstepB, voffB); PG8_STAGE(PG8_SA(0, 0), a2, voffA);
            PG8_WAIT_V(8); PG8_WAIT_L(0); PG8_BAR; PG8_MMA(1, 0, At, B0); PG8_MMA(1, 1, At, B1); PG8_BAR; PG8_SCHED;
            PG8_LDB(B0, 1, 0); PG8_LDB(B1, 1, 1); PG8_SCHED; PG8_LDA(At, 1, 0); PG8_STAGE(PG8_SA(0, 1), a2 + hstepA, voffA);
            PG8_WAIT_V(8); PG8_WAIT_L(0); PG8_BAR; PG8_MMA(0, 0, At, B0); PG8_MMA(0, 1, At, B1); PG8_BAR; PG8_SCHED;
            PG8_LDA(At, 1, 1); PG8_STAGE(PG8_SB(1, 0), b3, voffB); PG8_STAGE(PG8_SB(1, 1), b3 + hstepB, voffB); PG8_STAGE(PG8_SA(1, 0), a3, voffA);
            PG8_WAIT_V(8); PG8_WAIT_L(0); PG8_BAR; PG8_MMA(1, 0, At, B0); PG8_MMA(1, 1, At, B1); PG8_BAR; PG8_SCHED;
        }
        if (wr == 0) PG8_BAR;
        E(acc, cur, wr, wc, fr, fq);
        if (!has_next) break;
#pragma unroll
        for (int a = 0; a < 2; ++a)
#pragma unroll
            for (int b = 0; b < 2; ++b)
#pragma unroll
                for (int m = 0; m < 4; ++m)
#pragma unroll
                    for (int n = 0; n < 2; ++n) acc[a][b][m][n] = (f32x4){0.f, 0.f, 0.f, 0.f};
        cur = nxt; cA = nA; cB = nB; ++ui;
        if (wr == 1) PG8_BAR;
    }
    PG8_WAIT_V(0);
    PG8_BAR;
#undef PG8_SA
#undef PG8_SB
#undef PG8_STAGE
#undef PG8_LDA
#undef PG8_LDB
#undef PG8_MMA
#undef PG8_WAIT_V
#undef PG8_WAIT_L
#undef PG8_BAR
#undef PG8_SCHED
}
}

struct EpiProj {
    const Params* P;
    __device__ __forceinline__ void operator()(f32x4 (&acc)[2][2][4][2], const pg8::Unit& u, int wr, int wc, int fr, int fq) const {
        unsigned char* ws = P->ws;
        const int H = 4 * u.pn + wc;
        if (H > 76) return;
        const float* rs1 = (const float*)(ws + OFF_RS1);
        int kind; bf16_t* dst = nullptr; int pitch = 0, cb = 0; const float* gain = nullptr; float oscale = 1.f; bool slab = false; int sg = 0;
        if (H < 8)        { kind = 1; dst = (bf16_t*)(ws + OFF_R1);            pitch = 512; cb = H * 64;        gain = P->in[I_AQG]; oscale = QSCALE; }
        else if (H < 16)  { kind = 1; dst = (bf16_t*)(ws + OFF_R1 + 32 * MiB); pitch = 512; cb = (H - 8) * 64;  gain = P->in[I_AKG]; }
        else if (H < 24)  { kind = 0; dst = (bf16_t*)(ws + OFF_R1 + 64 * MiB); pitch = 512; cb = (H - 16) * 64; }
        else if (H < 32)  { kind = 1; dst = (bf16_t*)(ws + OFF_R1 + 96 * MiB); pitch = 512; cb = (H - 24) * 64; gain = P->in[I_BQG]; oscale = QSCALE; }
        else if (H < 34)  { kind = 0; dst = (bf16_t*)(ws + OFF_R2);            slab = true; sg = H - 32; }
        else if (H < 36)  { kind = 0; dst = (bf16_t*)(ws + OFF_R2 + 8 * MiB);  slab = true; sg = H - 34; }
        else if (H < 38)  { kind = 1; dst = (bf16_t*)(ws + OFF_R2 + 16 * MiB); pitch = 128; cb = (H - 36) * 64; gain = P->in[I_BKSG]; }
        else if (H < 40)  { kind = 0; dst = (bf16_t*)(ws + OFF_R2 + 24 * MiB); pitch = 128; cb = (H - 38) * 64; }
        else if (H < 42)  { kind = 1; dst = (bf16_t*)(ws + OFF_R2 + 32 * MiB); pitch = 128; cb = (H - 40) * 64; gain = P->in[I_BKWG]; }
        else if (H < 44)  { kind = 0; dst = (bf16_t*)(ws + OFF_R2 + 40 * MiB); pitch = 128; cb = (H - 42) * 64; }
        else if (H < 76)  { kind = 2; dst = (bf16_t*)(ws + OFF_R3);            pitch = 2048; cb = (H - 44) * 64; }
        else              { kind = 3; }
        f32x4 invrev[2] = {{0.f, 0.f, 0.f, 0.f}, {0.f, 0.f, 0.f, 0.f}};
        if (kind == 1) { invrev[0] = *(const f32x4*)((const float*)(ws + OFF_ROPE_C)); invrev[1] = *(const f32x4*)((const float*)(ws + OFF_ROPE_C) + 4); }
        float rsr[2][4];
#pragma unroll
        for (int ai = 0; ai < 2; ++ai)
#pragma unroll
            for (int m = 0; m < 4; ++m) rsr[ai][m] = rs1[u.pm * 256 + ai * 128 + wr * 64 + m * 16 + fr];
        f32x4 gv[2][2];
        if (kind == 1 || kind == 2) {
            const float* gp = (kind == 1) ? gain : P->in[I_BMERGE] + cb;
#pragma unroll
            for (int bj = 0; bj < 2; ++bj)
#pragma unroll
                for (int n = 0; n < 2; ++n) gv[bj][n] = *(const f32x4*)(gp + 32 * bj + 8 * fq + 4 * n);
        }
        const bool ksum = (H >= 8 && H < 16);
        f32x4 cs[2][2];
#pragma unroll
        for (int bj = 0; bj < 2; ++bj)
#pragma unroll
            for (int n = 0; n < 2; ++n) cs[bj][n] = (f32x4){0.f, 0.f, 0.f, 0.f};
#pragma unroll
        for (int ai = 0; ai < 2; ++ai)
#pragma unroll
            for (int m = 0; m < 4; ++m) {
                const int row = u.pm * 256 + ai * 128 + wr * 64 + m * 16 + fr;
                const float rs = rsr[ai][m];
                f32x4 v[2][2];
#pragma unroll
                for (int bj = 0; bj < 2; ++bj)
#pragma unroll
                    for (int n = 0; n < 2; ++n) v[bj][n] = acc[ai][bj][m][n] * rs;
                if (kind == 1) {
                    float ss = 0.f;
#pragma unroll
                    for (int bj = 0; bj < 2; ++bj)
#pragma unroll
                        for (int n = 0; n < 2; ++n) ss += (v[bj][n][0] * v[bj][n][0] + v[bj][n][1] * v[bj][n][1]) + (v[bj][n][2] * v[bj][n][2] + v[bj][n][3] * v[bj][n][3]);
                    ss = sum_xor16(ss); ss = sum_xor32(ss);
                    const float r = oscale * __builtin_amdgcn_rsqf(ss * (1.0f / 64.0f) + NORM_EPS);
#pragma unroll
                    for (int bj = 0; bj < 2; ++bj)
#pragma unroll
                        for (int n = 0; n < 2; ++n) v[bj][n] = v[bj][n] * gv[bj][n] * r;
                    const float posf = (float)(row & (SEQ - 1));
                    const float sgn = (fq == 0) ? -1.f : 1.f;
#pragma unroll
                    for (int n = 0; n < 2; ++n) {
                        const f32x4 me = v[0][n]; f32x4 ot, ro;
#pragma unroll
                        for (int i = 0; i < 4; ++i) ot[i] = get_xor16(me[i], fq & 1);
#pragma unroll
                        for (int i = 0; i < 4; ++i) { const float rev = __builtin_amdgcn_fractf(posf * invrev[n][i]); ro[i] = me[i] * __builtin_amdgcn_cosf(rev) + sgn * ot[i] * __builtin_amdgcn_sinf(rev); }
                        if (fq < 2) v[0][n] = ro;
                    }
                    if (ksum) {
#pragma unroll
                        for (int bj = 0; bj < 2; ++bj)
#pragma unroll
                            for (int n = 0; n < 2; ++n) cs[bj][n] += v[bj][n];
                    }
                } else if (kind == 2) {
#pragma unroll
                    for (int bj = 0; bj < 2; ++bj)
#pragma unroll
                        for (int n = 0; n < 2; ++n)
#pragma unroll
                            for (int i = 0; i < 4; ++i) v[bj][n][i] = sigmoidf_(v[bj][n][i] + gv[bj][n][i]);
                }
                if (kind == 3) {
                    float* bg = (float*)(ws + OFF_BGATE) + (size_t)row * 24;
                    if (fq < 3) {
#pragma unroll
                        for (int n = 0; n < 2; ++n) { f32x4 o; o.x = sigmoidf_(v[0][n][0]); o.y = sigmoidf_(v[0][n][1]); o.z = sigmoidf_(v[0][n][2]); o.w = sigmoidf_(v[0][n][3]); *(f32x4*)(bg + 8 * fq + 4 * n) = o; }
                    }
                } else {
                    bf16_t* rp;
                    if (slab) { const int b = row >> 12, s = row & (SEQ - 1); rp = dst + ((size_t)((b * 2 + sg) * SEQ + s)) * 64 + 8 * fq; }
                    else rp = dst + (size_t)row * pitch + cb + 8 * fq;
#pragma unroll
                    for (int bj = 0; bj < 2; ++bj) {
                        u32x4 w; w.x = pk2(v[bj][0][0], v[bj][0][1]); w.y = pk2(v[bj][0][2], v[bj][0][3]); w.z = pk2(v[bj][1][0], v[bj][1][1]); w.w = pk2(v[bj][1][2], v[bj][1][3]);
                        *(u32x4*)(rp + 32 * bj) = w;
                    }
                }
            }
        if (ksum) {
            float* km = (float*)(ws + OFF_KMEAN) + (size_t)(((u.pm >> 4) * 8 + (H - 8)) * 16 + (u.pm & 15)) * 64;
#pragma unroll
            for (int bj = 0; bj < 2; ++bj)
#pragma unroll
                for (int n = 0; n < 2; ++n)
#pragma unroll
                    for (int i = 0; i < 4; ++i) {
                        float t = cs[bj][n][i];
                        t += __shfl_xor(t, 1); t += __shfl_xor(t, 2); t += __shfl_xor(t, 4); t += __shfl_xor(t, 8);
                        if (fr == 0) atomicAdd(km + 32 * bj + 8 * fq + 4 * n + i, t);
                    }
        }
    }
};
__device__ __forceinline__ void phase_proj(const Params& P, LDSP unsigned char* lds, int vcu, int G) {
    pg8::Sched S; S.A0 = S.A1 = (const bf16_t*)(P.ws + OFF_R0); S.B0 = S.B1 = (const bf16_t*)(P.ws + OFF_WIN_T);
    S.lda = DM; S.ldb = DM; S.K = DM; S.nM = T / 256; S.nN = NPROJ / 256; S.NZ = 1; S.G = G; S.c = blockIdx.x;
    EpiProj E{&P};
    pg8::gemm_phase(lds, S, E);
}

constexpr size_t OFF_CPART = OFF_EXPERTS;
constexpr size_t CPART_STRIDE = (size_t)2 * 4096 * 256;
__device__ __forceinline__ void phase_cmp1(const Params& P, LDSP unsigned char* lds, int vcu, int G) {
    unsigned char* ws = P.ws;
    const int tid = opaque_tid(), lane = tid & 63, wid = tid >> 6, wm = wid >> 1, wn = wid & 1, fr = lane & 15, fq = lane >> 4;
    for (int item = vcu; item < 256; item += G) {
        const int kc = item & 3, tn = (item >> 2) & 1, tm = (item >> 3) & 15, kv = item >> 7;
        const bf16_t* A = (const bf16_t*)(ws + OFF_R2 + (size_t)kv * 8 * MiB) + (size_t)tm * SEQ * 64 + kc * 512;
        const bf16_t* Bt = (const bf16_t*)(ws + (kv ? OFF_W1V_T : OFF_W1K_T)) + (size_t)tn * G_BN * 2048 + kc * 512;
        float* part = (float*)(ws + OFF_CPART) + (size_t)kc * CPART_STRIDE + (size_t)kv * 4096 * 256;
        f32x4 acc[4][4];
        zero_acc(acc);
        gemm_kloop(acc, A, 1024, Bt, 2048, 512, lds);
        const int row0 = tm * 256 + wm * 64 + fr, col0 = tn * 128 + wn * 64 + 4 * fq;
#pragma unroll
        for (int m = 0; m < 4; ++m)
#pragma unroll
            for (int n = 0; n < 4; ++n) *(f32x4*)(part + (size_t)(row0 + m * 16) * 256 + col0 + n * 16) = acc[m][n];
    }
}

__device__ __forceinline__ u32x4 load_hid8(const float* part, const float* posb, size_t rowoff, int k) {
    f32x4 a = *(const f32x4*)(posb + k), b = *(const f32x4*)(posb + k + 4);
#pragma unroll
    for (int c = 0; c < 4; ++c) { a += *(const f32x4*)(part + c * CPART_STRIDE + rowoff + k); b += *(const f32x4*)(part + c * CPART_STRIDE + rowoff + k + 4); }
    u32x4 o; o.x = pk2(gelu_tanh(a.x), gelu_tanh(a.y)); o.y = pk2(gelu_tanh(a.z), gelu_tanh(a.w)); o.z = pk2(gelu_tanh(b.x), gelu_tanh(b.y)); o.w = pk2(gelu_tanh(b.z), gelu_tanh(b.w));
    return o;
}
__device__ __forceinline__ void phase_cmp2(const Params& P, LDSP unsigned char* lds, int vcu, int G) {
    unsigned char* ws = P.ws;
    const int tid = opaque_tid(), lane = tid & 63, wid = tid >> 6, wm = wid >> 1, wn = wid & 1, fr = lane & 15, fq = lane >> 4;
    const int lrow = tid >> 3, lch = tid & 7;
    for (int item = vcu; item < 32; item += G) {
        const int kv = item >> 4, tm = item & 15;
        const float* part = (const float*)(ws + OFF_CPART) + (size_t)kv * 4096 * 256 + (size_t)tm * 256 * 256;
        const float* posb = (const float*)(ws + OFF_POSB) + kv * 256;
        const bf16_t* Bt = (const bf16_t*)(ws + (kv ? OFF_W2V_T : OFF_W2K_T));
        const float* b2 = P.in[kv ? I_CVB2 : I_CKB2];
        bf16_t* dst = (bf16_t*)(ws + (kv ? OFF_VC : OFF_KC)) + (size_t)tm * 256 * 64;
        f32x4 acc[4][4];
        zero_acc(acc);
        {
            const bf16_t* gb = Bt + (size_t)lrow * 256 + lch * 8;
            u32x4 ra[4], rb[2];
#pragma unroll
            for (int p = 0; p < 4; ++p) ra[p] = load_hid8(part, posb, (size_t)(lrow + 64 * p) * 256, lch * 8);
#pragma unroll
            for (int p = 0; p < 2; ++p) rb[p] = *(const u32x4*)(gb + (size_t)(64 * p) * 256);
            __syncthreads();
#pragma unroll
            for (int p = 0; p < 4; ++p) *(LDSP u32x4*)(lds + swz_off(lrow + 64 * p, lch)) = ra[p];
#pragma unroll
            for (int p = 0; p < 2; ++p) *(LDSP u32x4*)(lds + G_ABYTES + swz_off(lrow + 64 * p, lch)) = rb[p];
            __syncthreads();
#pragma unroll 1
            for (int kt = 0; kt < 4; ++kt) {
                LDSP unsigned char* cur = lds + (kt & 1) * G_STAGE;
                LDSP unsigned char* nxt = lds + ((kt + 1) & 1) * G_STAGE;
                if (kt + 1 < 4) {
#pragma unroll
                    for (int p = 0; p < 4; ++p) ra[p] = load_hid8(part, posb, (size_t)(lrow + 64 * p) * 256, (kt + 1) * G_BK + lch * 8);
#pragma unroll
                    for (int p = 0; p < 2; ++p) rb[p] = *(const u32x4*)(gb + (size_t)(64 * p) * 256 + (kt + 1) * G_BK);
                }
#pragma unroll
                for (int ks = 0; ks < 2; ++ks) {
                    bf16x8 af[4], bfr[4];
#pragma unroll
                    for (int m = 0; m < 4; ++m) af[m] = *(const LDSP bf16x8*)(cur + swz_off(wm * 64 + m * 16 + fr, ks * 4 + fq));
#pragma unroll
                    for (int n = 0; n < 4; ++n) bfr[n] = *(const LDSP bf16x8*)(cur + G_ABYTES + swz_off(wn * 64 + n * 16 + fr, ks * 4 + fq));
#pragma unroll
                    for (int m = 0; m < 4; ++m)
#pragma unroll
                        for (int n = 0; n < 4; ++n) acc[m][n] = __builtin_amdgcn_mfma_f32_16x16x32_bf16(bfr[n], af[m], acc[m][n], 0, 0, 0);
                }
                if (kt + 1 < 4) {
#pragma unroll
                    for (int p = 0; p < 4; ++p) *(LDSP u32x4*)(nxt + swz_off(lrow + 64 * p, lch)) = ra[p];
#pragma unroll
                    for (int p = 0; p < 2; ++p) *(LDSP u32x4*)(nxt + G_ABYTES + swz_off(lrow + 64 * p, lch)) = rb[p];
                }
                __syncthreads();
            }
        }
        if (wn == 0) {
            float gv[4][4];
#pragma unroll
            for (int n = 0; n < 4; ++n) {
                const f32x4 bb = *(const f32x4*)(b2 + n * 16 + 4 * fq);
                const f32x4 g4 = kv ? (f32x4){1.f, 1.f, 1.f, 1.f} : *(const f32x4*)(P.in[I_BKCG] + n * 16 + 4 * fq);
                gv[n][0] = g4.x; gv[n][1] = g4.y; gv[n][2] = g4.z; gv[n][3] = g4.w;
#pragma unroll
                for (int m = 0; m < 4; ++m) acc[m][n] += bb;
            }
#pragma unroll
            for (int m = 0; m < 4; ++m) {
                float r = 1.f;
                if (kv == 0) {
                    float ss = 0.f;
#pragma unroll
                    for (int n = 0; n < 4; ++n) ss += (acc[m][n][0] * acc[m][n][0] + acc[m][n][1] * acc[m][n][1]) + (acc[m][n][2] * acc[m][n][2] + acc[m][n][3] * acc[m][n][3]);
                    ss += __shfl_xor(ss, 16); ss += __shfl_xor(ss, 32);
                    r = 1.0f / sqrtf(ss * (1.0f / 64.0f) + NORM_EPS);
                }
                const int row = wm * 64 + m * 16 + fr;
                if (row == 255) r = 0.f;
#pragma unroll
                for (int n = 0; n < 4; ++n) {
                    f32x4 o = acc[m][n];
                    if (row == 255) o = (f32x4){0.f, 0.f, 0.f, 0.f};
                    u32x2 w; w.x = pk2(o[0] * r * gv[n][0], o[1] * r * gv[n][1]); w.y = pk2(o[2] * r * gv[n][2], o[3] * r * gv[n][3]);
                    *(u32x2*)(dst + (size_t)row * 64 + n * 16 + 4 * fq) = w;
                }
            }
        }
    }
}

__device__ __forceinline__ void phase_cmp(const Params& P, LDSP unsigned char* lds, int vcu, int G) {
    unsigned char* ws = P.ws;
    const int tid = opaque_tid(), lane = tid & 63, r32 = lane & 31, hi = lane >> 5;
    const int wu = __builtin_amdgcn_readfirstlane(tid >> 6);
    for (int item = vcu; item < 256; item += G) {
        const int kv = item >> 7, bg = (item >> 3) & 15, rb = item & 7;
        const bf16_t* A = (const bf16_t*)(ws + OFF_R2 + (size_t)kv * 8 * MiB) + ((size_t)bg * SEQ + 512 * rb) * 64;
        const bf16_t* W1 = (const bf16_t*)(ws + (kv ? OFF_W1V_T : OFF_W1K_T)) + (size_t)(32 * wu + r32) * 2048 + 32 * hi;
        __syncthreads();
        for (int pc = wu; pc < 66; pc += 8) {
            const int g16 = pc >> 1, h8 = pc & 1, tau = 16 * g16 + 8 * h8 + (lane >> 3), c = (lane & 7) ^ ((g16 >> 1) & 7);
            __builtin_amdgcn_global_load_lds((const unsigned*)(A + (size_t)tau * 64 + c * 8), (LDSP unsigned*)(lds + (17 * g16 + 8 * h8) * 128), 16, 0, 0);
        }
        u32x4 Bq[8][4];
#pragma unroll
        for (int j = 0; j < 8; ++j)
#pragma unroll
            for (int i = 0; i < 4; ++i) Bq[j][i] = *(const u32x4*)(W1 + 64 * j + 8 * i);
        const int abase = 17 * r32 * 128;
        int aoff[2][4];
#pragma unroll
        for (int jh = 0; jh < 2; ++jh)
#pragma unroll
            for (int i = 0; i < 4; ++i) aoff[jh][i] = abase + ((((4 * hi + i) ^ (((r32 + jh) >> 1) & 7))) << 4);
        f32x16 acc;
#pragma unroll
        for (int r = 0; r < 16; ++r) acc[r] = 0.f;
        asm volatile("s_waitcnt vmcnt(32)" ::: "memory");
        __syncthreads();
#pragma unroll
        for (int j = 0; j < 32; ++j) {
#pragma unroll
            for (int i = 0; i < 4; ++i) {
                const bf16x8 xf = *(const LDSP bf16x8*)(lds + aoff[j >> 4][i] + (j + (j >> 4)) * 128);
                acc = __builtin_amdgcn_mfma_f32_32x32x16_bf16(__builtin_bit_cast(bf16x8, Bq[j & 7][i]), xf, acc, 0, 0, 0);
            }
            if (j + 8 < 32) {
#pragma unroll
                for (int i = 0; i < 4; ++i) Bq[j & 7][i] = *(const u32x4*)(W1 + 64 * (j + 8) + 8 * i);
            }
            __builtin_amdgcn_sched_barrier(0);
        }
        const float* posb = (const float*)(ws + OFF_POSB) + kv * 256 + 32 * wu + 4 * hi;
        u32x4 pw[2];
#pragma unroll
        for (int q = 0; q < 4; ++q) {
            const f32x4 pb = *(const f32x4*)(posb + 8 * q);
            const float h0 = gelu_tanh(acc[4 * q] + pb.x), h1 = gelu_tanh(acc[4 * q + 1] + pb.y), h2 = gelu_tanh(acc[4 * q + 2] + pb.z), h3 = gelu_tanh(acc[4 * q + 3] + pb.w);
            pw[q >> 1][(q & 1) * 2] = pk2(h0, h1); pw[q >> 1][(q & 1) * 2 + 1] = pk2(h2, h3);
        }
        const bf16_t* W2 = (const bf16_t*)(ws + (kv ? OFF_W2V_T : OFF_W2K_T)) + (size_t)r32 * 256 + 32 * wu + 4 * hi;
        f32x16 o2[2];
#pragma unroll
        for (int mb = 0; mb < 2; ++mb) {
#pragma unroll
            for (int r = 0; r < 16; ++r) o2[mb][r] = 0.f;
#pragma unroll
            for (int s2 = 0; s2 < 2; ++s2) {
                const u32x2 lo = *(const u32x2*)(W2 + (size_t)mb * 32 * 256 + 16 * s2), hh = *(const u32x2*)(W2 + (size_t)mb * 32 * 256 + 16 * s2 + 8);
                const u32x4 a2 = {lo.x, lo.y, hh.x, hh.y};
                o2[mb] = __builtin_amdgcn_mfma_f32_32x32x16_bf16(__builtin_bit_cast(bf16x8, a2), __builtin_bit_cast(bf16x8, pw[s2]), o2[mb], 0, 0, 0);
            }
        }
        __syncthreads();
        {
            LDSP float* part = (LDSP float*)lds + (size_t)(wu * 32 + r32) * 68 + 4 * hi;
#pragma unroll
            for (int mb = 0; mb < 2; ++mb)
#pragma unroll
                for (int q = 0; q < 4; ++q) *(LDSP f32x4*)(part + 32 * mb + 8 * q) = (f32x4){o2[mb][4 * q], o2[mb][4 * q + 1], o2[mb][4 * q + 2], o2[mb][4 * q + 3]};
        }
        __syncthreads();
        {
            const int row = tid >> 4, dq = tid & 15;
            f32x4 v = *(const f32x4*)(P.in[kv ? I_CVB2 : I_CKB2] + 4 * dq);
#pragma unroll
            for (int w = 0; w < 8; ++w) v += *(const LDSP f32x4*)((LDSP float*)lds + (size_t)(w * 32 + row) * 68 + 4 * dq);
            float rr = 1.f; f32x4 g4 = {1.f, 1.f, 1.f, 1.f};
            if (kv == 0) {
                float ss = (v.x * v.x + v.y * v.y) + (v.z * v.z + v.w * v.w);
                ss += __shfl_xor(ss, 1); ss += __shfl_xor(ss, 2); ss += __shfl_xor(ss, 4); ss += __shfl_xor(ss, 8);
                rr = 1.0f / sqrtf(ss * (1.0f / 64.0f) + NORM_EPS);
                g4 = *(const f32x4*)(P.in[I_BKCG] + 4 * dq);
            }
            const int grow = 32 * rb + row;
            u32x2 w2; w2.x = pk2(v.x * rr * g4.x, v.y * rr * g4.y); w2.y = pk2(v.z * rr * g4.z, v.w * rr * g4.w);
            if (grow == 255) w2 = (u32x2){0u, 0u};
            *(u32x2*)((bf16_t*)(ws + (kv ? OFF_VC : OFF_KC)) + ((size_t)bg * 256 + grow) * 64 + 4 * dq) = w2;
        }
    }
    __syncthreads();
}

constexpr int A_GS = 65536, A_ES = 81920, A_Y = 65536, A_MISC = 131072;
typedef short v4i16_t __attribute__((ext_vector_type(4)));
struct ASt { f32x16 o0, o1; float m, l; };
struct KVStage { u32x4 k, v; };
__device__ __forceinline__ void kv_load(KVStage& s, const bf16_t* Kg, const bf16_t* Vg, size_t pitch, int tid) {
    const int key = tid >> 3, ch = tid & 7;
    s.k = *(const u32x4*)(Kg + (size_t)key * pitch + ch * 8);
    s.v = *(const u32x4*)(Vg + (size_t)key * pitch + ch * 8);
}
__device__ __forceinline__ void kv_store(const KVStage& s, LDSP unsigned char* buf, int tid) {
    const int key = tid >> 3, ch = tid & 7;
    *(LDSP u32x4*)(buf + swz_off(key, ch)) = s.k;
    *(LDSP u32x4*)(buf + 8192 + ((ch >> 2) * 4 + (key >> 4)) * 1024 + (key & 15) * 64 + (ch & 3) * 16) = s.v;
}
__device__ __forceinline__ void kv_dma(const bf16_t* Kg, const bf16_t* Vg, size_t pitch, LDSP unsigned char* buf, int wid, int lane) {
    const int row = wid * 8 + (lane >> 3), chunk = (lane & 7) ^ ((row >> 1) & 7);
    __builtin_amdgcn_global_load_lds((const unsigned*)(Kg + (size_t)row * pitch + chunk * 8), (LDSP unsigned*)(buf + wid * 1024), 16, 0, 0);
    const int vrow = (wid & 3) * 16 + (lane >> 2), vcol = (wid >> 2) * 32 + (lane & 3) * 8;
    __builtin_amdgcn_global_load_lds((const unsigned*)(Vg + (size_t)vrow * pitch + vcol), (LDSP unsigned*)(buf + 8192 + wid * 1024), 16, 0, 0);
}
__device__ __forceinline__ float swap32f(float v) { return __shfl_xor(v, 32); }
__device__ __forceinline__ void ast_reset(ASt& st) {
#pragma unroll
    for (int r = 0; r < 16; ++r) { st.o0[r] = 0.f; st.o1[r] = 0.f; }
    st.m = 0.f; st.l = 0.f;
}
constexpr float ATT_THR = 8.0f;
template <int MODE>
__device__ __forceinline__ void attn_tile(ASt& st, const bf16x8 (&qf)[4], LDSP const unsigned char* kt, int lane, bool rowoff, int kl, int kh, bool need_mask,
                                          float linv, LDSP float* gs, LDSP float* es, int jbase, int ql) {
    const int r32 = lane & 31, hi = lane >> 5;
    const float cin = rowoff ? -INFINITY : -st.m;
    f32x16 p0, p1;
#pragma unroll
    for (int r = 0; r < 16; ++r) { p0[r] = cin; p1[r] = cin; }
#pragma unroll
    for (int d0 = 0; d0 < 4; ++d0) {
        const bf16x8 k0f = *(const LDSP bf16x8*)(kt + swz_off(r32, 2 * d0 + hi));
        const bf16x8 k1f = *(const LDSP bf16x8*)(kt + swz_off(r32 + 32, 2 * d0 + hi));
        p0 = __builtin_amdgcn_mfma_f32_32x32x16_bf16(k0f, qf[d0], p0, 0, 0, 0);
        p1 = __builtin_amdgcn_mfma_f32_32x32x16_bf16(k1f, qf[d0], p1, 0, 0, 0);
    }
    if (need_mask) {
        const int kl2 = kl - 4 * hi, kh2 = kh - 4 * hi;
#pragma unroll
        for (int r = 0; r < 16; ++r) {
            const int c = (r & 3) + 8 * (r >> 2);
            const bool v0 = c >= kl2 && c <= kh2, v1 = (c + 32) >= kl2 && (c + 32) <= kh2;
            p0[r] = v0 ? p0[r] : -INFINITY; p1[r] = v1 ? p1[r] : -INFINITY;
        }
    }
    if (MODE != 2) {
        float mx = fmaxf(fmaxf(p0[0], p1[0]), fmaxf(p0[1], p1[1]));
#pragma unroll
        for (int r = 2; r < 16; r += 2) mx = fmaxf(fmaxf(mx, fmaxf(p0[r], p1[r])), fmaxf(p0[r + 1], p1[r + 1]));
        mx = fmaxf(mx, swap32f(mx));
        if (__any(mx > ATT_THR)) {
            const float dl = (mx > ATT_THR) ? mx : 0.f;
            const float alpha = __builtin_amdgcn_exp2f(-dl);
            st.m += dl; st.l *= alpha;
#pragma unroll
            for (int r = 0; r < 16; ++r) { p0[r] -= dl; p1[r] -= dl; }
            if (MODE == 0) {
#pragma unroll
                for (int r = 0; r < 16; ++r) { st.o0[r] *= alpha; st.o1[r] *= alpha; }
            }
        }
    }
#pragma unroll
    for (int r = 0; r < 16; ++r) { p0[r] = __builtin_amdgcn_exp2f(p0[r]); p1[r] = __builtin_amdgcn_exp2f(p1[r]); }
    if (MODE != 2) {
        const f32x16 t = p0 + p1;
        st.l += ((t[0] + t[1]) + (t[2] + t[3])) + ((t[4] + t[5]) + (t[6] + t[7])) + (((t[8] + t[9]) + (t[10] + t[11])) + ((t[12] + t[13]) + (t[14] + t[15])));
    } else {
#pragma unroll
        for (int r = 0; r < 16; ++r) { p0[r] *= linv; p1[r] *= linv; }
#pragma unroll
        for (int qd = 0; qd < 4; ++qd) {
            float g0 = (p0[4 * qd] + p0[4 * qd + 1]) + (p0[4 * qd + 2] + p0[4 * qd + 3]), e0 = p0[4 * qd + 3];
            float g1 = (p1[4 * qd] + p1[4 * qd + 1]) + (p1[4 * qd + 2] + p1[4 * qd + 3]), e1 = p1[4 * qd + 3];
            g0 += __shfl_xor(g0, 1); g0 += __shfl_xor(g0, 2); e0 += __shfl_xor(e0, 1); e0 += __shfl_xor(e0, 2);
            g1 += __shfl_xor(g1, 1); g1 += __shfl_xor(g1, 2); e1 += __shfl_xor(e1, 1); e1 += __shfl_xor(e1, 2);
            if ((r32 & 3) == 0) {
                const int j = jbase + 2 * qd + hi;
                gs[ql * 64 + j] = g0; es[ql * 64 + j] = e0; gs[ql * 64 + j + 8] = g1; es[ql * 64 + j + 8] = e1;
            }
        }
    }
    if (MODE != 1) {
        u32x4 pw[4];
        pw[0] = (u32x4){pk2(p0[0], p0[1]), pk2(p0[2], p0[3]), pk2(p0[4], p0[5]), pk2(p0[6], p0[7])};
        pw[1] = (u32x4){pk2(p0[8], p0[9]), pk2(p0[10], p0[11]), pk2(p0[12], p0[13]), pk2(p0[14], p0[15])};
        pw[2] = (u32x4){pk2(p1[0], p1[1]), pk2(p1[2], p1[3]), pk2(p1[4], p1[5]), pk2(p1[6], p1[7])};
        pw[3] = (u32x4){pk2(p1[8], p1[9]), pk2(p1[10], p1[11]), pk2(p1[12], p1[13]), pk2(p1[14], p1[15])};
        LDSP const unsigned char* vb = kt + 8192 + ((lane >> 4) & 1) * 32 + (lane & 3) * 8 + (4 * hi + ((lane & 15) >> 2)) * 64;
#pragma unroll
        for (int ks = 0; ks < 4; ++ks) {
            const bf16x8 pf = __builtin_bit_cast(bf16x8, pw[ks]);
#pragma unroll
            for (int d0 = 0; d0 < 2; ++d0) {
                const v4i16_t lo = __builtin_amdgcn_ds_read_tr16_b64_v4i16((LDSP v4i16_t*)(vb + (d0 * 4 + ks) * 1024));
                const v4i16_t hh = __builtin_amdgcn_ds_read_tr16_b64_v4i16((LDSP v4i16_t*)(vb + (d0 * 4 + ks) * 1024 + 512));
                const bf16x8 vf = (bf16x8){lo[0], lo[1], lo[2], lo[3], hh[0], hh[1], hh[2], hh[3]};
                if (d0 == 0) st.o0 = __builtin_amdgcn_mfma_f32_32x32x16_bf16(vf, pf, st.o0, 0, 0, 0);
                else         st.o1 = __builtin_amdgcn_mfma_f32_32x32x16_bf16(vf, pf, st.o1, 0, 0, 0);
            }
            if (ks & 1) __builtin_amdgcn_sched_barrier(0);
        }
    }
}

#define KV_LOOP(NT, KPTR, VPTR, PITCH, ...) do { const int nt_ = (NT), np_ = (nt_ + 1) >> 1; KVStage sa_, sb_; __syncthreads(); \
    { const int i = 0; kv_load(sa_, (KPTR), (VPTR), (PITCH), tid); } { const int i = (nt_ > 1) ? 1 : 0; kv_load(sb_, (KPTR), (VPTR), (PITCH), tid); } \
    kv_store(sa_, lds, tid); kv_store(sb_, lds + 16384, tid); __syncthreads(); \
    _Pragma("unroll 1") for (int ip_ = 0; ip_ < np_; ++ip_) { LDSP unsigned char* cur0_ = lds + (ip_ & 1) * 32768; \
        if (ip_ + 1 < np_) { { const int i = 2 * ip_ + 2; kv_load(sa_, (KPTR), (VPTR), (PITCH), tid); } \
                             { const int i = (2 * ip_ + 3 < nt_) ? 2 * ip_ + 3 : 2 * ip_ + 2; kv_load(sb_, (KPTR), (VPTR), (PITCH), tid); } } \
        { const int i = 2 * ip_; LDSP unsigned char* cur = cur0_; __VA_ARGS__ } \
        if (2 * ip_ + 1 < nt_) { const int i = 2 * ip_ + 1; LDSP unsigned char* cur = cur0_ + 16384; __VA_ARGS__ } \
        if (ip_ + 1 < np_) { kv_store(sa_, lds + ((ip_ + 1) & 1) * 32768, tid); kv_store(sb_, lds + ((ip_ + 1) & 1) * 32768 + 16384, tid); } \
        __syncthreads(); } } while (0)

struct TP { bool rowoff, nm; int kl, kh; };
__device__ __forceinline__ void pair_kload(bf16x8 (&kf)[8], LDSP const unsigned char* kt, int r32, int hi) {
#pragma unroll
    for (int d0 = 0; d0 < 4; ++d0) {
        kf[2 * d0]     = *(const LDSP bf16x8*)(kt + swz_off(r32, 2 * d0 + hi));
        kf[2 * d0 + 1] = *(const LDSP bf16x8*)(kt + swz_off(r32 + 32, 2 * d0 + hi));
    }
}
__device__ __forceinline__ void pair_vload(bf16x8 (&vf)[8], LDSP const unsigned char* kt, int lane, int hi) {
    LDSP const unsigned char* vb = kt + 8192 + ((lane >> 4) & 1) * 32 + (lane & 3) * 8 + (4 * hi + ((lane & 15) >> 2)) * 64;
#pragma unroll
    for (int ks = 0; ks < 4; ++ks)
#pragma unroll
        for (int d0 = 0; d0 < 2; ++d0) {
            const v4i16_t lo = __builtin_amdgcn_ds_read_tr16_b64_v4i16((LDSP v4i16_t*)(vb + (d0 * 4 + ks) * 1024));
            const v4i16_t hh = __builtin_amdgcn_ds_read_tr16_b64_v4i16((LDSP v4i16_t*)(vb + (d0 * 4 + ks) * 1024 + 512));
            vf[2 * ks + d0] = (bf16x8){lo[0], lo[1], lo[2], lo[3], hh[0], hh[1], hh[2], hh[3]};
        }
}
#define PAIR_LDS_WAIT() do { asm volatile("s_waitcnt lgkmcnt(0)" ::: "memory"); __builtin_amdgcn_sched_barrier(0); } while (0)
__device__ __forceinline__ void pair_qk(f32x16& p0, f32x16& p1, float cin, const bf16x8 (&qf)[4], const bf16x8 (&kf)[8]) {
    f32x16 c16;
#pragma unroll
    for (int r = 0; r < 16; ++r) c16[r] = cin;
#pragma unroll
    for (int d0 = 0; d0 < 4; ++d0) {
        p0 = __builtin_amdgcn_mfma_f32_32x32x16_bf16(kf[2 * d0], qf[d0], d0 == 0 ? c16 : p0, 0, 0, 0);
        p1 = __builtin_amdgcn_mfma_f32_32x32x16_bf16(kf[2 * d0 + 1], qf[d0], d0 == 0 ? c16 : p1, 0, 0, 0);
    }
}
__device__ __forceinline__ void pair_sm(ASt& st, f32x16& p0, f32x16& p1, u32x4 (&pw)[4], const TP& t, float pend, int hi) {
    if (t.nm) {
        const int kl2 = t.kl - 4 * hi, kh2 = t.kh - 4 * hi;
#pragma unroll
        for (int r = 0; r < 16; ++r) {
            const int c = (r & 3) + 8 * (r >> 2);
            const bool v0 = c >= kl2 && c <= kh2, v1 = (c + 32) >= kl2 && (c + 32) <= kh2;
            p0[r] = v0 ? p0[r] : -INFINITY; p1[r] = v1 ? p1[r] : -INFINITY;
        }
    }
    float mx = fmaxf(fmaxf(p0[0], p1[0]), fmaxf(p0[1], p1[1]));
#pragma unroll
    for (int r = 2; r < 16; r += 2) mx = fmaxf(fmaxf(mx, fmaxf(p0[r], p1[r])), fmaxf(p0[r + 1], p1[r + 1]));
    { const auto rr = __builtin_amdgcn_permlane32_swap(__float_as_uint(mx), __float_as_uint(mx), false, false); mx = fmaxf(__uint_as_float(rr[0]), __uint_as_float(rr[1])); }
    mx -= pend;
    if (__any(mx > ATT_THR || pend != 0.f)) {
        const float dl = (mx > ATT_THR) ? mx : 0.f;
        const float alpha = __builtin_amdgcn_exp2f(-dl), sub = dl + pend;
        st.m += dl; st.l *= alpha;
#pragma unroll
        for (int r = 0; r < 16; ++r) { p0[r] -= sub; p1[r] -= sub; st.o0[r] *= alpha; st.o1[r] *= alpha; }
    }
#pragma unroll
    for (int r = 0; r < 16; ++r) { p0[r] = __builtin_amdgcn_exp2f(p0[r]); p1[r] = __builtin_amdgcn_exp2f(p1[r]); }
    const f32x16 tt = p0 + p1;
    st.l += ((tt[0] + tt[1]) + (tt[2] + tt[3])) + ((tt[4] + tt[5]) + (tt[6] + tt[7])) + (((tt[8] + tt[9]) + (tt[10] + tt[11])) + ((tt[12] + tt[13]) + (tt[14] + tt[15])));
    pw[0] = (u32x4){pk2(p0[0], p0[1]), pk2(p0[2], p0[3]), pk2(p0[4], p0[5]), pk2(p0[6], p0[7])};
    pw[1] = (u32x4){pk2(p0[8], p0[9]), pk2(p0[10], p0[11]), pk2(p0[12], p0[13]), pk2(p0[14], p0[15])};
    pw[2] = (u32x4){pk2(p1[0], p1[1]), pk2(p1[2], p1[3]), pk2(p1[4], p1[5]), pk2(p1[6], p1[7])};
    pw[3] = (u32x4){pk2(p1[8], p1[9]), pk2(p1[10], p1[11]), pk2(p1[12], p1[13]), pk2(p1[14], p1[15])};
}
__device__ __forceinline__ void pair_pv(ASt& st, const u32x4 (&pw)[4], const bf16x8 (&vf)[8]) {
#pragma unroll
    for (int ks = 0; ks < 4; ++ks) {
        const bf16x8 pf = __builtin_bit_cast(bf16x8, pw[ks]);
        st.o0 = __builtin_amdgcn_mfma_f32_32x32x16_bf16(vf[2 * ks], pf, st.o0, 0, 0, 0);
        st.o1 = __builtin_amdgcn_mfma_f32_32x32x16_bf16(vf[2 * ks + 1], pf, st.o1, 0, 0, 0);
    }
}
__device__ __forceinline__ void attn_pair(ASt& st, const bf16x8 (&qf)[4], LDSP const unsigned char* ka, LDSP const unsigned char* kb, int lane, const TP& ta, const TP& tb) {
    const int r32 = lane & 31, hi = lane >> 5;
    const float m0 = st.m;
    f32x16 a0, a1, b0, b1; u32x4 pwa[4], pwb[4];
    bf16x8 kfa[8], kfb[8], vf[8];
    pair_kload(kfa, ka, r32, hi); pair_kload(kfb, kb, r32, hi);
    PAIR_LDS_WAIT();
    pair_qk(a0, a1, ta.rowoff ? -INFINITY : -m0, qf, kfa);
    pair_qk(b0, b1, tb.rowoff ? -INFINITY : -m0, qf, kfb);
    pair_vload(vf, ka, lane, hi);
    __builtin_amdgcn_sched_barrier(0);
    pair_sm(st, a0, a1, pwa, ta, 0.f, hi);
    PAIR_LDS_WAIT();
    pair_pv(st, pwa, vf);
    __builtin_amdgcn_sched_barrier(0);
    pair_vload(vf, kb, lane, hi);
    __builtin_amdgcn_sched_barrier(0);
    pair_sm(st, b0, b1, pwb, tb, st.m - m0, hi);
    PAIR_LDS_WAIT();
    pair_pv(st, pwb, vf);
}
template <int I, bool MASK>
__device__ __forceinline__ void pair_exp_chunk(const f32x16& p0, const f32x16& p1, u32x4 (&pw)[4], float& sacc, int kl2, int kh2) {
    const f32x16& src = (I < 4) ? p0 : p1; constexpr int b = 4 * (I & 3);
    float x0 = src[b], x1 = src[b + 1], x2 = src[b + 2], x3 = src[b + 3];
    if (MASK) {
        constexpr int c0 = 8 * (b >> 2) + ((I < 4) ? 0 : 32);
        x0 = (c0 >= kl2 && c0 <= kh2) ? x0 : -INFINITY; x1 = (c0 + 1 >= kl2 && c0 + 1 <= kh2) ? x1 : -INFINITY;
        x2 = (c0 + 2 >= kl2 && c0 + 2 <= kh2) ? x2 : -INFINITY; x3 = (c0 + 3 >= kl2 && c0 + 3 <= kh2) ? x3 : -INFINITY;
    }
    const float e0 = __builtin_amdgcn_exp2f(x0), e1 = __builtin_amdgcn_exp2f(x1), e2 = __builtin_amdgcn_exp2f(x2), e3 = __builtin_amdgcn_exp2f(x3);
    sacc += (e0 + e1) + (e2 + e3);
    pw[I >> 1][(I & 1) * 2] = pk2(e0, e1); pw[I >> 1][(I & 1) * 2 + 1] = pk2(e2, e3);
}
#define PAIR_SB() __builtin_amdgcn_sched_barrier(0)
__device__ __forceinline__ bf16x8 vfrag_load(LDSP const unsigned char* vb, int idx) {
    const int off = ((idx & 1) * 4 + (idx >> 1)) * 1024;
    const v4i16_t lo = __builtin_amdgcn_ds_read_tr16_b64_v4i16((LDSP v4i16_t*)(vb + off));
    const v4i16_t hh = __builtin_amdgcn_ds_read_tr16_b64_v4i16((LDSP v4i16_t*)(vb + off + 512));
    return (bf16x8){lo[0], lo[1], lo[2], lo[3], hh[0], hh[1], hh[2], hh[3]};
}
template <bool MASK>
__device__ __forceinline__ void attn_pair_fast(ASt& st, const bf16x8 (&qf)[4], LDSP const unsigned char* ka, LDSP const unsigned char* kb, int lane, const TP& ta, const TP& tb) {
    const int r32 = lane & 31, hi = lane >> 5; const bool offa = ta.rowoff, offb = tb.rowoff;
    const int kla = ta.kl - 4 * hi, kha = ta.kh - 4 * hi, klb = tb.kl - 4 * hi, khb = tb.kh - 4 * hi;
    LDSP const unsigned char* vba = ka + 8192 + ((lane >> 4) & 1) * 32 + (lane & 3) * 8 + (4 * hi + ((lane & 15) >> 2)) * 64;
    LDSP const unsigned char* vbb = vba + (kb - ka);
    f32x16 a0, a1, b0, b1; u32x4 pwa[4], pwb[4];
    bf16x8 kfa[8], kfb[8], vfa[8], vfb[8];
    pair_kload(kfa, ka, r32, hi);
    { f32x16 c16; const float cina = offa ? -INFINITY : -st.m;
#pragma unroll
      for (int r = 0; r < 16; ++r) c16[r] = cina;
      asm volatile("s_waitcnt lgkmcnt(0)" ::: "memory"); PAIR_SB();
#define QKA_STEP(I) do { if ((I) & 1) a1 = __builtin_amdgcn_mfma_f32_32x32x16_bf16(kfa[I], qf[(I) >> 1], (I) == 1 ? c16 : a1, 0, 0, 0); \
                         else         a0 = __builtin_amdgcn_mfma_f32_32x32x16_bf16(kfa[I], qf[(I) >> 1], (I) == 0 ? c16 : a0, 0, 0, 0); \
                         kfb[I] = *(const LDSP bf16x8*)(kb + swz_off(r32 + 32 * ((I) & 1), 2 * ((I) >> 1) + hi)); PAIR_SB(); } while (0)
      QKA_STEP(0); QKA_STEP(1); QKA_STEP(2); QKA_STEP(3); QKA_STEP(4); QKA_STEP(5); QKA_STEP(6); QKA_STEP(7);
#undef QKA_STEP
    }
    float sa = 0.f, sbm = 0.f;
    { f32x16 c16; const float cinb = offb ? -INFINITY : -st.m;
#pragma unroll
      for (int r = 0; r < 16; ++r) c16[r] = cinb;
      asm volatile("s_waitcnt lgkmcnt(0)" ::: "memory"); PAIR_SB();
#define QKB_STEP(I) do { if ((I) & 1) b1 = __builtin_amdgcn_mfma_f32_32x32x16_bf16(kfb[I], qf[(I) >> 1], (I) == 1 ? c16 : b1, 0, 0, 0); \
                         else         b0 = __builtin_amdgcn_mfma_f32_32x32x16_bf16(kfb[I], qf[(I) >> 1], (I) == 0 ? c16 : b0, 0, 0, 0); \
                         if ((I) >= 4) vfa[(I) - 4] = vfrag_load(vba, (I) - 4); \
                         pair_exp_chunk<I, MASK>(a0, a1, pwa, sa, kla, kha); PAIR_SB(); } while (0)
      QKB_STEP(0); QKB_STEP(1); QKB_STEP(2); QKB_STEP(3); QKB_STEP(4); QKB_STEP(5); QKB_STEP(6); QKB_STEP(7);
#undef QKB_STEP
    }
    asm volatile("s_waitcnt lgkmcnt(0)" ::: "memory"); PAIR_SB();
#define PVA_STEP(I) do { if ((I) & 1) st.o1 = __builtin_amdgcn_mfma_f32_32x32x16_bf16(vfa[I], __builtin_bit_cast(bf16x8, pwa[(I) >> 1]), st.o1, 0, 0, 0); \
                         else         st.o0 = __builtin_amdgcn_mfma_f32_32x32x16_bf16(vfa[I], __builtin_bit_cast(bf16x8, pwa[(I) >> 1]), st.o0, 0, 0, 0); \
                         if ((I) < 4) vfa[(I) + 4] = vfrag_load(vba, (I) + 4); else vfb[(I) - 4] = vfrag_load(vbb, (I) - 4); \
                         pair_exp_chunk<I, MASK>(b0, b1, pwb, sbm, klb, khb); PAIR_SB(); \
                         if ((I) == 3) { asm volatile("s_waitcnt lgkmcnt(0)" ::: "memory"); PAIR_SB(); } } while (0)
    PVA_STEP(0); PVA_STEP(1); PVA_STEP(2); PVA_STEP(3); PVA_STEP(4); PVA_STEP(5); PVA_STEP(6); PVA_STEP(7);
#undef PVA_STEP
    st.l += sa + sbm;
    asm volatile("s_waitcnt lgkmcnt(0)" ::: "memory"); PAIR_SB();
#define PVB_STEP(I) do { if ((I) & 1) st.o1 = __builtin_amdgcn_mfma_f32_32x32x16_bf16(vfb[I], __builtin_bit_cast(bf16x8, pwb[(I) >> 1]), st.o1, 0, 0, 0); \
                         else         st.o0 = __builtin_amdgcn_mfma_f32_32x32x16_bf16(vfb[I], __builtin_bit_cast(bf16x8, pwb[(I) >> 1]), st.o0, 0, 0, 0); \
                         if ((I) < 4) vfb[(I) + 4] = vfrag_load(vbb, (I) + 4); PAIR_SB(); \
                         if ((I) == 3) { asm volatile("s_waitcnt lgkmcnt(0)" ::: "memory"); PAIR_SB(); } } while (0)
    PVB_STEP(0); PVB_STEP(1); PVB_STEP(2); PVB_STEP(3); PVB_STEP(4); PVB_STEP(5); PVB_STEP(6); PVB_STEP(7);
#undef PVB_STEP
    const float lpair = fmaxf(st.l, swap32f(st.l));
    if (__any(lpair > 1.0e18f)) {
        const float dl = (lpair > 1.0e18f) ? 64.f : 0.f, alpha = __builtin_amdgcn_exp2f(-dl);
        st.m += dl; st.l *= alpha;
#pragma unroll
        for (int r = 0; r < 16; ++r) { st.o0[r] *= alpha; st.o1[r] *= alpha; }
    }
}

#define KV_LOOP_PAIR(NT, KPTR, VDELTA, PITCH, TPF) do { const int nt_ = (NT), np_ = (nt_ + 1) >> 1; const int wu_ = __builtin_amdgcn_readfirstlane(wid); __syncthreads(); \
    { const int i = 0; kv_dma((KPTR), (KPTR) + (VDELTA), (PITCH), lds, wu_, lane); } { const int i = (nt_ > 1) ? 1 : 0; kv_dma((KPTR), (KPTR) + (VDELTA), (PITCH), lds + 16384, wu_, lane); } \
    asm volatile("s_waitcnt vmcnt(0)" ::: "memory"); __syncthreads(); \
    _Pragma("unroll 1") for (int ip_ = 0; ip_ < np_; ++ip_) { LDSP unsigned char* cur0_ = lds + (ip_ & 1) * 32768; LDSP unsigned char* nxt0_ = lds + ((ip_ + 1) & 1) * 32768; \
        if (ip_ + 1 < np_) { { const int i = 2 * ip_ + 2; kv_dma((KPTR), (KPTR) + (VDELTA), (PITCH), nxt0_, wu_, lane); } \
                             { const int i = (2 * ip_ + 3 < nt_) ? 2 * ip_ + 3 : 2 * ip_ + 2; kv_dma((KPTR), (KPTR) + (VDELTA), (PITCH), nxt0_ + 16384, wu_, lane); } } \
        if (2 * ip_ + 1 < nt_) { const TP ta_ = TPF(2 * ip_), tb_ = TPF(2 * ip_ + 1); \
            if (ta_.nm || tb_.nm) attn_pair_fast<true>(st, qf, cur0_, cur0_ + 16384, lane, ta_, tb_); else attn_pair_fast<false>(st, qf, cur0_, cur0_ + 16384, lane, ta_, tb_); } \
        else { const TP ta_ = TPF(2 * ip_); attn_tile<0>(st, qf, cur0_, lane, ta_.rowoff, ta_.kl, ta_.kh, ta_.nm, 0.f, nullptr, nullptr, 0, 0); } \
        asm volatile("s_waitcnt vmcnt(0)" ::: "memory"); \
        __syncthreads(); } } while (0)

__device__ __forceinline__ void store_ot(bf16_t* dst, const f32x16& o0, const f32x16& o1, int hi) {
#pragma unroll
    for (int qd = 0; qd < 4; ++qd) {
        u32x2 w0, w1;
        w0.x = pk2(o0[4 * qd], o0[4 * qd + 1]); w0.y = pk2(o0[4 * qd + 2], o0[4 * qd + 3]);
        w1.x = pk2(o1[4 * qd], o1[4 * qd + 1]); w1.y = pk2(o1[4 * qd + 2], o1[4 * qd + 3]);
        *(u32x2*)(dst + 8 * qd + 4 * hi) = w0; *(u32x2*)(dst + 32 + 8 * qd + 4 * hi) = w1;
    }
}

__device__ __forceinline__ void moba_unit(const Params& P, LDSP unsigned char* lds, int b, int h, int blk) {
    unsigned char* ws = P.ws;
    const int tid = opaque_tid(), lane = tid & 63, wid = tid >> 6, r32 = lane & 31, hi = lane >> 5;
    const bf16_t* qa = (const bf16_t*)(ws + OFF_R1);
    const bf16_t* ka = (const bf16_t*)(ws + OFF_R1 + 32 * MiB);
    const bf16_t* va = (const bf16_t*)(ws + OFF_R1 + 64 * MiB);
    bf16_t* ya = (bf16_t*)(ws + OFF_R0);
    const float* kmean = (const float*)(ws + OFF_KMEAN) + (size_t)((b * 8 + h) * 16) * 64;
    LDSP float* km = (LDSP float*)(lds + A_MISC);
    LDSP unsigned short* sel16 = (LDSP unsigned short*)(lds + A_MISC + 4096);
    __syncthreads();
    for (int i = tid; i < blk * 64; i += NTHREADS) km[i] = kmean[i];
    __syncthreads();
    {
        const int qi = tid >> 1, hf = tid & 1;
        const bf16_t* qrow = qa + (size_t)(b * SEQ + blk * 256 + qi) * 512 + h * 64 + hf * 32;
        float q[32];
#pragma unroll
        for (int c = 0; c < 4; ++c) { float f[8]; cvt8(*(const u32x4*)(qrow + c * 8), f);
#pragma unroll
            for (int i = 0; i < 8; ++i) q[c * 8 + i] = f[i]; }
        float g0 = -INFINITY, g1 = -INFINITY, g2 = -INFINITY; int i0 = -1, i1 = -1, i2 = -1;
        for (int j = 0; j < blk; ++j) {
            float d = 0.f;
#pragma unroll
            for (int i = 0; i < 32; ++i) d += q[i] * km[j * 64 + hf * 32 + i];
            d += __shfl_xor(d, 1);
            if (d > g0) { g2 = g1; i2 = i1; g1 = g0; i1 = i0; g0 = d; i0 = j; }
            else if (d > g1) { g2 = g1; i2 = i1; g1 = d; i1 = j; }
            else if (d > g2) { g2 = d; i2 = j; }
        }
        unsigned mask = 0;
        if (i0 >= 0) mask |= 1u << i0;
        if (i1 >= 0) mask |= 1u << i1;
        if (i2 >= 0) mask |= 1u << i2;
        if (hf == 0) sel16[qi] = (unsigned short)mask;
    }
    __syncthreads();
    const int qloc = wid * 32 + r32;
    const size_t qrow_g = (size_t)(b * SEQ + blk * 256 + qloc);
    bf16x8 qf[4];
#pragma unroll
    for (int d0 = 0; d0 < 4; ++d0) qf[d0] = *(const bf16x8*)(qa + qrow_g * 512 + h * 64 + d0 * 16 + hi * 8);
    const unsigned selbits = sel16[qloc];
    ASt st; ast_reset(st);
    const bf16_t* kbase = ka + (size_t)(b * SEQ) * 512 + h * 64;
    const bf16_t* vbase = va + (size_t)(b * SEQ) * 512 + h * 64;
    auto moba_tp = [=](int ti) -> TP { const int jb = ti >> 2, t4 = ti & 3; const bool past = jb < blk;
        int l_ = lane; asm volatile("" : "+v"(l_)); const int w_ = __builtin_amdgcn_readfirstlane(wid), ql_ = w_ * 32 + (l_ & 31);
        TP t; t.rowoff = past ? !((selbits >> jb) & 1u) : (64 * t4 > ql_); t.nm = !past && (64 * t4 + 63 > w_ * 32); t.kl = 0; t.kh = past ? 63 : ql_ - 64 * t4; return t; };
    KV_LOOP_PAIR(4 * (blk + 1), kbase + (size_t)i * 64 * 512, (size_t)16 * 1024 * 1024, 512, moba_tp);
    const float lt = st.l + swap32f(st.l);
    const float inv = 1.0f / lt;
#pragma unroll
    for (int r = 0; r < 16; ++r) { st.o0[r] *= inv; st.o1[r] *= inv; }
    { const int t2 = opaque_tid(), l2 = t2 & 63;
      const size_t row2 = (size_t)(b * SEQ + blk * 256 + (t2 >> 6) * 32 + (l2 & 31));
      store_ot((bf16_t*)(P.ws + OFF_R0) + row2 * 512 + h * 64, st.o0, st.o1, l2 >> 5); }
}

__device__ __forceinline__ void nsa_unit(const Params& P, LDSP unsigned char* lds, int b, int g, int c) {
    unsigned char* ws = P.ws;
    const int tid = opaque_tid(), lane = tid & 63, wid = tid >> 6, r32 = lane & 31, hi = lane >> 5;
    const bf16_t* qb = (const bf16_t*)(ws + OFF_R1 + 96 * MiB);
    const bf16_t* kc = (const bf16_t*)(ws + OFF_KC) + (size_t)(b * 2 + g) * 256 * 64;
    const bf16_t* vc = (const bf16_t*)(ws + OFF_VC) + (size_t)(b * 2 + g) * 256 * 64;
    const bf16_t* ks = (const bf16_t*)(ws + OFF_R2 + 16 * MiB) + (size_t)(b * SEQ) * 128 + g * 64;
    const bf16_t* vs = (const bf16_t*)(ws + OFF_R2 + 24 * MiB) + (size_t)(b * SEQ) * 128 + g * 64;
    const bf16_t* kw = (const bf16_t*)(ws + OFF_R2 + 32 * MiB) + (size_t)(b * SEQ) * 128 + g * 64;
    const bf16_t* vw = (const bf16_t*)(ws + OFF_R2 + 40 * MiB) + (size_t)(b * SEQ) * 128 + g * 64;
    const float* bgate = (const float*)(ws + OFF_BGATE);
    bf16_t* yb = (bf16_t*)(ws + OFF_R0 + 32 * MiB);
    LDSP float* gs = (LDSP float*)(lds + A_GS);
    LDSP float* es = (LDSP float*)(lds + A_ES);
    LDSP unsigned long long* selm = (LDSP unsigned long long*)(lds + A_MISC);
    const int ql = wid * 8 + (r32 >> 2), hr = r32 & 3, head = g * 4 + hr, pos = c * 64 + ql;
    const size_t trow = (size_t)(b * SEQ + pos);
    bf16x8 qf[4];
#pragma unroll
    for (int d0 = 0; d0 < 4; ++d0) qf[d0] = *(const bf16x8*)(qb + trow * 512 + head * 64 + d0 * 16 + hi * 8);
    const int nmax = (pos >= 31) ? ((pos - 31) >> 4) : -1;
    const int ntc = ((4 * c + 2) >> 6) + 1;
    ASt st; ast_reset(st);
    __syncthreads();
    {
        const int wu_ = __builtin_amdgcn_readfirstlane(wid);
#pragma unroll 1
        for (int i = 0; i < ntc; ++i) kv_dma(kc + (size_t)i * 64 * 64, vc + (size_t)i * 64 * 64, 64, lds + i * 16384, wu_, lane);
        asm volatile("s_waitcnt vmcnt(0)" ::: "memory");
        __syncthreads();
    }
#pragma unroll 1
    for (int i = 0; i < ntc; ++i) attn_tile<1>(st, qf, lds + i * 16384, lane, nmax < 0, 0, nmax - 64 * i, true, 0.f, nullptr, nullptr, 0, 0);
    {
        const float lt = st.l + swap32f(st.l);
        const float linv = (lt > 0.f) ? 1.0f / lt : 0.f;
#pragma unroll 1
        for (int i = 0; i < ntc; ++i) attn_tile<2>(st, qf, lds + i * 16384, lane, nmax < 0, 0, nmax - 64 * i, true, linv, gs, es, 16 * i, ql);
    }
    LDSP float* yl = (LDSP float*)(lds + A_Y) + wid * 2048 + lane;
    __syncthreads();
    for (int qq = 0; qq < 8; ++qq) {
        const int q = wid * 8 + qq, j = lane;
        unsigned long long m;
        if (c < 16) m = (2ull << c) - 1ull;
        else {
            const bool cand = (j >= 1 && j <= c - 2);
            float imp = 0.f;
            if (cand) imp = gs[q * 64 + j] + es[q * 64 + j - 1];
            int rank = 0;
            for (int jp = 1; jp <= c - 2; ++jp) {
                const float o = __uint_as_float(__builtin_amdgcn_readlane(__float_as_uint(imp), jp));
                rank += (o > imp || (o == imp && jp < j)) ? 1 : 0;
            }
            const bool sel = (j == 0) || (j == c) || (j == c - 1) || (cand && rank < 13);
            m = __ballot(sel);
        }
        if (lane == 0) selm[q] = m;
    }
    __syncthreads();
    { const int t2 = opaque_tid(), l2 = t2 & 63; const size_t trow2 = (size_t)(b * SEQ + c * 64 + (t2 >> 6) * 8 + ((l2 & 31) >> 2)); const int head2 = g * 4 + (l2 & 3);
      const float gt0 = ((const float*)(P.ws + OFF_BGATE))[trow2 * 24 + head2 * 3 + 0];
#pragma unroll
    for (int r = 0; r < 16; ++r) { yl[r * 64] = gt0 * st.o0[r]; yl[(16 + r) * 64] = gt0 * st.o1[r]; } }
    const unsigned long long selmask = selm[ql];
    ast_reset(st);
    auto slc_tp = [=](int ti) -> TP { int l_ = lane; asm volatile("" : "+v"(l_)); const int ql_ = __builtin_amdgcn_readfirstlane(wid) * 8 + ((l_ & 31) >> 2);
        TP t; t.rowoff = !((selmask >> ti) & 1ull); t.nm = (ti == c); t.kl = 0; t.kh = (ti == c) ? ql_ : 63; return t; };
    KV_LOOP_PAIR(c + 1, ks + (size_t)i * 64 * 128, (size_t)4 * 1024 * 1024, 128, slc_tp);
    {
        const float lt = st.l + swap32f(st.l);
        const int t2 = opaque_tid(), l2 = t2 & 63; const size_t trow2 = (size_t)(b * SEQ + c * 64 + (t2 >> 6) * 8 + ((l2 & 31) >> 2)); const int head2 = g * 4 + (l2 & 3);
        LDSP float* yl = (LDSP float*)(lds + A_Y) + (t2 >> 6) * 2048 + l2;
        const float sc = ((const float*)(P.ws + OFF_BGATE))[trow2 * 24 + head2 * 3 + 1] / lt;
#pragma unroll
        for (int r = 0; r < 16; ++r) { yl[r * 64] += sc * st.o0[r]; yl[(16 + r) * 64] += sc * st.o1[r]; }
    }
    ast_reset(st);
    const int j0 = (c >= 8) ? c - 8 : 0;
    auto win_tp = [=](int ti) -> TP { const int j = j0 + ti; const bool first = (j == c - 8), own = (j == c);
        int l_ = lane; asm volatile("" : "+v"(l_)); const int ql_ = __builtin_amdgcn_readfirstlane(wid) * 8 + ((l_ & 31) >> 2);
        TP t; t.rowoff = false; t.nm = first || own; t.kl = first ? ql_ + 1 : 0; t.kh = own ? ql_ : 63; return t; };
    KV_LOOP_PAIR(c - j0 + 1, kw + (size_t)(j0 + i) * 64 * 128, (size_t)4 * 1024 * 1024, 128, win_tp);
    {
        const float lt = st.l + swap32f(st.l);
        const int t2 = opaque_tid(), l2 = t2 & 63; const size_t trow2 = (size_t)(b * SEQ + c * 64 + (t2 >> 6) * 8 + ((l2 & 31) >> 2)); const int head2 = g * 4 + (l2 & 3);
        LDSP float* yl = (LDSP float*)(lds + A_Y) + (t2 >> 6) * 2048 + l2;
        const float sc = ((const float*)(P.ws + OFF_BGATE))[trow2 * 24 + head2 * 3 + 2] / lt;
        f32x16 y0, y1;
#pragma unroll
        for (int r = 0; r < 16; ++r) { y0[r] = yl[r * 64] + sc * st.o0[r]; y1[r] = yl[(16 + r) * 64] + sc * st.o1[r]; }
        store_ot((bf16_t*)(P.ws + OFF_R0 + 32 * MiB) + trow2 * 512 + head2 * 64, y0, y1, l2 >> 5);
    }
}

__device__ __forceinline__ void phase_attn(const Params& P, LDSP unsigned char* lds, int vcu, int G) {
    const int nloc = (G == 256) ? 8 : (2048 - vcu + G - 1) / G;
    for (int k = 0; k < nloc; ++k) {
        int u;
        if (G == 256) {
            const int kk = k >> 1;
            if (!(k & 1)) { const int bh = vcu >> 2, jm = vcu & 3; const int blk = (kk == 0) ? 15 - jm : (kk == 1) ? 8 + jm : (kk == 2) ? 7 - jm : jm; u = bh * 16 + blk; }
            else { const int bg = vcu >> 4, jn = vcu & 15; const int c = (kk == 0) ? 63 - jn : (kk == 1) ? 32 + jn : (kk == 2) ? 31 - jn : jn; u = 1024 + bg * 64 + c; }
        } else u = vcu + k * G;
        if (u < 1024) moba_unit(P, lds, u >> 7, (u >> 4) & 7, u & 15);
        else { const int v = u - 1024; nsa_unit(P, lds, v >> 7, (v >> 6) & 1, v & 63); }
    }
}

struct EpiUp {
    const Params* P;
    __device__ __forceinline__ void operator()(f32x4 (&acc)[2][2][4][2], const pg8::Unit& u, int wr, int wc, int fr, int fq) const {
        bf16_t* g = (bf16_t*)(P->ws + OFF_R3);
#pragma unroll
        for (int ai = 0; ai < 2; ++ai)
#pragma unroll
            for (int m = 0; m < 4; ++m) {
                const int row = u.pm * 256 + ai * 128 + wr * 64 + m * 16 + fr;
#pragma unroll
                for (int bj = 0; bj < 2; ++bj) {
                    bf16_t* rp = g + (size_t)row * 2048 + u.pn * 256 + bj * 128 + wc * 32 + 8 * fq;
                    const u32x4 gg = *(const u32x4*)(rp + (u.z ? 1024 : 0));
                    float gf[8]; cvt8(gg, gf);
                    float o[8];
#pragma unroll
                    for (int n = 0; n < 2; ++n)
#pragma unroll
                        for (int i = 0; i < 4; ++i) o[4 * n + i] = gf[4 * n + i] * acc[ai][bj][m][n][i];
                    if (u.z) { float pf[8]; cvt8(*(const u32x4*)rp, pf);
#pragma unroll
                        for (int i = 0; i < 8; ++i) o[i] += pf[i]; }
                    u32x4 w; w.x = pk2(o[0], o[1]); w.y = pk2(o[2], o[3]); w.z = pk2(o[4], o[5]); w.w = pk2(o[6], o[7]);
                    *(u32x4*)rp = w;
                }
            }
    }
};
__device__ __forceinline__ void phase_up(const Params& P, LDSP unsigned char* lds, int vcu, int G) {
    pg8::Sched S; S.A0 = (const bf16_t*)(P.ws + OFF_R0); S.A1 = (const bf16_t*)(P.ws + OFF_R0 + 32 * MiB);
    S.B0 = (const bf16_t*)(P.ws + OFF_WUPA_T); S.B1 = (const bf16_t*)(P.ws + OFF_WUPB_T);
    S.lda = 512; S.ldb = 512; S.K = 512; S.nM = T / 256; S.nN = DM / 256; S.NZ = 2; S.G = G; S.c = blockIdx.x;
    EpiUp E{&P};
    pg8::gemm_phase(lds, S, E);
}

struct EpiOut {
    const Params* P;
    __device__ __forceinline__ void operator()(f32x4 (&acc)[2][2][4][2], const pg8::Unit& u, int wr, int wc, int fr, int fq) const {
        bf16_t* x1b = (bf16_t*)(P->ws + OFF_R0);
        float* rs2 = (float*)(P->ws + OFF_RS2);
        const float* x = P->in[I_X];
#pragma unroll
        for (int ai = 0; ai < 2; ++ai)
#pragma unroll
            for (int m = 0; m < 4; ++m) {
                const int row = u.pm * 256 + ai * 128 + wr * 64 + m * 16 + fr;
                float ss = 0.f;
                f32x4 xv[2][2];
#pragma unroll
                for (int bj = 0; bj < 2; ++bj)
#pragma unroll
                    for (int n = 0; n < 2; ++n) xv[bj][n] = *(const f32x4*)(x + (size_t)row * DM + u.pn * 256 + bj * 128 + wc * 32 + 8 * fq + 4 * n);
#pragma unroll
                for (int bj = 0; bj < 2; ++bj) {
                    const size_t off = (size_t)row * DM + u.pn * 256 + bj * 128 + wc * 32 + 8 * fq;
                    const f32x4 o0 = xv[bj][0] + acc[ai][bj][m][0], o1 = xv[bj][1] + acc[ai][bj][m][1];
                    u32x4 w; w.x = pk2(o0.x, o0.y); w.y = pk2(o0.z, o0.w); w.z = pk2(o1.x, o1.y); w.w = pk2(o1.z, o1.w);
                    *(u32x4*)(x1b + off) = w;
                    ss += ((o0.x * o0.x + o0.y * o0.y) + (o0.z * o0.z + o0.w * o0.w)) + ((o1.x * o1.x + o1.y * o1.y) + (o1.z * o1.z + o1.w * o1.w));
                }
                ss = sum_xor16(ss); ss = sum_xor32(ss);
                if (fq == 0) atomicAdd(rs2 + row, ss);
            }
    }
};
__device__ __forceinline__ void phase_out(const Params& P, LDSP unsigned char* lds, int vcu, int G) {
    pg8::Sched S; S.A0 = S.A1 = (const bf16_t*)(P.ws + OFF_R3); S.B0 = S.B1 = (const bf16_t*)(P.ws + OFF_WOUT_T);
    S.lda = 2048; S.ldb = DM; S.K = DM; S.nM = T / 256; S.nN = DM / 256; S.NZ = 1; S.G = G; S.c = blockIdx.x;
    EpiOut E{&P};
    pg8::gemm_phase(lds, S, E);
}

struct EpiPq {
    const Params* P;
    __device__ __forceinline__ void operator()(f32x4 (&acc)[2][2][4][2], const pg8::Unit& u, int wr, int wc, int fr, int fq) const {
        bf16_t* qp = (bf16_t*)(P->ws + OFF_R1);
        const float* rs2 = (const float*)(P->ws + OFF_RS2);
        float rr[2][4];
#pragma unroll
        for (int ai = 0; ai < 2; ++ai)
#pragma unroll
            for (int m = 0; m < 4; ++m) rr[ai][m] = __builtin_amdgcn_rsqf(rs2[u.pm * 256 + ai * 128 + wr * 64 + m * 16 + fr] * (1.0f / DM) + NORM_EPS);
#pragma unroll
        for (int ai = 0; ai < 2; ++ai)
#pragma unroll
            for (int m = 0; m < 4; ++m) {
                const int row = u.pm * 256 + ai * 128 + wr * 64 + m * 16 + fr;
                const float r = rr[ai][m];
#pragma unroll
                for (int bj = 0; bj < 2; ++bj) {
                    const f32x4 a0 = acc[ai][bj][m][0], a1 = acc[ai][bj][m][1];
                    u32x4 w; w.x = pk2(a0[0] * r, a0[1] * r); w.y = pk2(a0[2] * r, a0[3] * r); w.z = pk2(a1[0] * r, a1[1] * r); w.w = pk2(a1[2] * r, a1[3] * r);
                    *(u32x4*)(qp + (size_t)row * 2048 + u.pn * 256 + bj * 128 + wc * 32 + 8 * fq) = w;
                }
            }
    }
};
__device__ __forceinline__ void phase_pq(const Params& P, LDSP unsigned char* lds, int vcu, int G) {
    pg8::Sched S; S.A0 = S.A1 = (const bf16_t*)(P.ws + OFF_R0); S.B0 = S.B1 = (const bf16_t*)(P.ws + OFF_WPQ_T);
    S.lda = DM; S.ldb = DM; S.K = DM; S.nM = T / 256; S.nN = 2048 / 256; S.NZ = 1; S.G = G; S.c = blockIdx.x;
    EpiPq E{&P};
    pg8::gemm_phase(lds, S, E);
}

__device__ __forceinline__ unsigned f2ord(float f) { const unsigned u = __float_as_uint(f); return u ^ ((unsigned)((int)u >> 31) | 0x80000000u); }
__device__ __forceinline__ float ord2f(unsigned o) { const unsigned u = (o & 0x80000000u) ? (o ^ 0x80000000u) : ~o; return __uint_as_float(u); }
__device__ __forceinline__ void ins16(unsigned (&top)[16], unsigned x) {
#pragma unroll
    for (int j = 0; j < 16; ++j) { const unsigned t = max(x, top[j]); x = min(x, top[j]); top[j] = t; }
}
__device__ __forceinline__ int crow(int r, int hi) { return (r & 3) + 8 * (r >> 2) + 4 * hi; }
__device__ __forceinline__ void ce_desc(unsigned& a, unsigned& b) { const unsigned hi_ = max(a, b), lo_ = min(a, b); a = hi_; b = lo_; }
__device__ __forceinline__ void bitonic_merge16_desc(unsigned (&a)[16]) {
#pragma unroll
    for (int j = 8; j > 0; j >>= 1)
#pragma unroll
        for (int i = 0; i < 16; ++i) { const int l = i ^ j; if (l > i) ce_desc(a[i], a[l]); }
}
__device__ __forceinline__ void sort16_desc(unsigned (&a)[16]) {
#pragma unroll
    for (int k = 2; k <= 16; k <<= 1)
#pragma unroll
        for (int j = k >> 1; j > 0; j >>= 1)
#pragma unroll
            for (int i = 0; i < 16; ++i) { const int l = i ^ j; if (l > i) { if ((i & k) == 0) ce_desc(a[i], a[l]); else ce_desc(a[l], a[i]); } }
}
__device__ __forceinline__ void merge_top16(unsigned (&top)[16], const unsigned (&blk)[16]) {
#pragma unroll
    for (int i = 0; i < 16; ++i) top[i] = max(top[i], blk[15 - i]);
    bitonic_merge16_desc(top);
}
constexpr int cand_prefix(int i) { int n = 0; for (int a = 0; a < i; ++a) n += 16 / (a + 1); return n; }

constexpr int P8_KOFF = 0, P8_IDX = 65536;
__device__ __forceinline__ void phase_topk(const Params& P, LDSP unsigned char* lds, int vcu, int G) {
    unsigned char* ws = P.ws;
    const bf16_t* qp = (const bf16_t*)(ws + OFF_R1);
    int* experts = (int*)(ws + OFF_EXPERTS);
    float* gates = (float*)(ws + OFF_GATES);
    const int tid = opaque_tid(), lane = tid & 63, wave = tid >> 6, r32 = lane & 31, hi = lane >> 5;
    __syncthreads();
    for (int i = tid; i < 2 * 128 * 16; i += NTHREADS) {
        const int w = i >> 11, row = (i >> 4) & 127, ch = i & 15;
        const u32x4 v = *(const u32x4*)((const bf16_t*)(ws + (w ? OFF_K2B : OFF_K1B)) + row * 128 + ch * 8);
        *(LDSP u32x4*)(lds + P8_KOFF + w * 32768 + row * 256 + ((ch ^ (row & 15)) << 4)) = v;
    }
    __syncthreads();
    LDSP unsigned char* myidx = lds + P8_IDX + (wave * 64 + lane) * 32;
    const int gw = vcu * NWAVES + wave, NGW = G * NWAVES;
    for (int item = gw; item < (T / 32) * 8; item += NGW) {
        const int tg = item >> 3, h = item & 7;
        const int tok = tg * 32 + r32;
        unsigned tops[2][16];
#pragma unroll
        for (int L = 0; L < 2; ++L) {
            bf16x8 qf[8];
            const bf16_t* qrow = qp + (size_t)tok * 2048 + h * 256 + L * 128 + hi * 8;
#pragma unroll
            for (int s8 = 0; s8 < 8; ++s8) qf[s8] = *(const bf16x8*)(qrow + s8 * 16);
            unsigned top[16];
#pragma unroll
            for (int kb = 0; kb < 4; ++kb) {
                f32x16 acc = {0.f, 0.f, 0.f, 0.f, 0.f, 0.f, 0.f, 0.f, 0.f, 0.f, 0.f, 0.f, 0.f, 0.f, 0.f, 0.f};
                const int row = kb * 32 + r32;
#pragma unroll
                for (int s8 = 0; s8 < 8; ++s8) {
                    const bf16x8 kf = *(const LDSP bf16x8*)(lds + P8_KOFF + L * 32768 + row * 256 + (((2 * s8 + hi) ^ (row & 15)) << 4));
                    acc = __builtin_amdgcn_mfma_f32_32x32x16_bf16(kf, qf[s8], acc, 0, 0, 0);
                }
                unsigned blk[16];
#pragma unroll
                for (int r = 0; r < 16; ++r) {
                    const int key = kb * 32 + (r & 3) + 8 * (r >> 2) + 4 * hi;
                    blk[r] = (f2ord(acc[r]) & ~0x7Fu) | (unsigned)(127 - key);
                }
                sort16_desc(blk);
                if (kb == 0) {
#pragma unroll
                    for (int j = 0; j < 16; ++j) top[j] = blk[j];
                } else merge_top16(top, blk);
            }
            unsigned oth[16];
#pragma unroll
            for (int j = 0; j < 16; ++j) oth[j] = (unsigned)__shfl_xor((int)top[j], 32);
            merge_top16(top, oth);
#pragma unroll
            for (int j = 0; j < 16; ++j) tops[L][j] = top[j];
        }
        float v1[16], v2[16];
#pragma unroll
        for (int j = 0; j < 16; j += 4) {
            unsigned w1 = 0, w2 = 0;
#pragma unroll
            for (int q = 0; q < 4; ++q) { w1 |= (127u - (tops[0][j + q] & 127u)) << (8 * q); w2 |= (127u - (tops[1][j + q] & 127u)) << (8 * q); }
            *(LDSP unsigned*)(myidx + j) = w1; *(LDSP unsigned*)(myidx + 16 + j) = w2;
        }
#pragma unroll
        for (int j = 0; j < 16; ++j) { v1[j] = ord2f(tops[0][j] & ~0x7Fu); v2[j] = ord2f(tops[1][j] & ~0x7Fu); }
        unsigned ct[16];
        {
            unsigned blk0[16], blk1[16];
            { const float a_ = hi ? v1[0] : v1[0], b_ = hi ? v2[1] : v2[0]; blk0[0] = (f2ord(a_ + b_) & ~0xFFu) | (unsigned)(hi ? 254 : 255); }
            { const float a_ = hi ? v1[0] : v1[0], b_ = hi ? v2[3] : v2[2]; blk0[1] = (f2ord(a_ + b_) & ~0xFFu) | (unsigned)(hi ? 252 : 253); }
            { const float a_ = hi ? v1[0] : v1[0], b_ = hi ? v2[5] : v2[4]; blk0[2] = (f2ord(a_ + b_) & ~0xFFu) | (unsigned)(hi ? 250 : 251); }
            { const float a_ = hi ? v1[0] : v1[0], b_ = hi ? v2[7] : v2[6]; blk0[3] = (f2ord(a_ + b_) & ~0xFFu) | (unsigned)(hi ? 248 : 249); }
            { const float a_ = hi ? v1[0] : v1[0], b_ = hi ? v2[9] : v2[8]; blk0[4] = (f2ord(a_ + b_) & ~0xFFu) | (unsigned)(hi ? 246 : 247); }
            { const float a_ = hi ? v1[0] : v1[0], b_ = hi ? v2[11] : v2[10]; blk0[5] = (f2ord(a_ + b_) & ~0xFFu) | (unsigned)(hi ? 244 : 245); }
            { const float a_ = hi ? v1[0] : v1[0], b_ = hi ? v2[13] : v2[12]; blk0[6] = (f2ord(a_ + b_) & ~0xFFu) | (unsigned)(hi ? 242 : 243); }
            { const float a_ = hi ? v1[0] : v1[0], b_ = hi ? v2[15] : v2[14]; blk0[7] = (f2ord(a_ + b_) & ~0xFFu) | (unsigned)(hi ? 240 : 241); }
            { const float a_ = hi ? v1[1] : v1[1], b_ = hi ? v2[1] : v2[0]; blk0[8] = (f2ord(a_ + b_) & ~0xFFu) | (unsigned)(hi ? 238 : 239); }
            { const float a_ = hi ? v1[1] : v1[1], b_ = hi ? v2[3] : v2[2]; blk0[9] = (f2ord(a_ + b_) & ~0xFFu) | (unsigned)(hi ? 236 : 237); }
            { const float a_ = hi ? v1[1] : v1[1], b_ = hi ? v2[5] : v2[4]; blk0[10] = (f2ord(a_ + b_) & ~0xFFu) | (unsigned)(hi ? 234 : 235); }
            { const float a_ = hi ? v1[1] : v1[1], b_ = hi ? v2[7] : v2[6]; blk0[11] = (f2ord(a_ + b_) & ~0xFFu) | (unsigned)(hi ? 232 : 233); }
            { const float a_ = hi ? v1[2] : v1[2], b_ = hi ? v2[1] : v2[0]; blk0[12] = (f2ord(a_ + b_) & ~0xFFu) | (unsigned)(hi ? 222 : 223); }
            { const float a_ = hi ? v1[2] : v1[2], b_ = hi ? v2[3] : v2[2]; blk0[13] = (f2ord(a_ + b_) & ~0xFFu) | (unsigned)(hi ? 220 : 221); }
            { const float a_ = hi ? v1[3] : v1[2], b_ = hi ? v2[0] : v2[4]; blk0[14] = (f2ord(a_ + b_) & ~0xFFu) | (unsigned)(hi ? 207 : 219); }
            { const float a_ = hi ? v1[3] : v1[3], b_ = hi ? v2[2] : v2[1]; blk0[15] = (f2ord(a_ + b_) & ~0xFFu) | (unsigned)(hi ? 205 : 206); }
            { const float a_ = hi ? v1[4] : v1[3], b_ = hi ? v2[0] : v2[3]; blk1[0] = (f2ord(a_ + b_) & ~0xFFu) | (unsigned)(hi ? 191 : 204); }
            { const float a_ = hi ? v1[4] : v1[4], b_ = hi ? v2[2] : v2[1]; blk1[1] = (f2ord(a_ + b_) & ~0xFFu) | (unsigned)(hi ? 189 : 190); }
            { const float a_ = hi ? v1[5] : v1[5], b_ = hi ? v2[1] : v2[0]; blk1[2] = (f2ord(a_ + b_) & ~0xFFu) | (unsigned)(hi ? 174 : 175); }
            { const float a_ = hi ? v1[6] : v1[6], b_ = hi ? v2[1] : v2[0]; blk1[3] = (f2ord(a_ + b_) & ~0xFFu) | (unsigned)(hi ? 158 : 159); }
            { const float a_ = hi ? v1[7] : v1[7], b_ = hi ? v2[1] : v2[0]; blk1[4] = (f2ord(a_ + b_) & ~0xFFu) | (unsigned)(hi ? 142 : 143); }
            { const float a_ = hi ? v1[9] : v1[8], b_ = hi ? v2[0] : v2[0]; blk1[5] = (f2ord(a_ + b_) & ~0xFFu) | (unsigned)(hi ? 111 : 127); }
            { const float a_ = hi ? v1[11] : v1[10], b_ = hi ? v2[0] : v2[0]; blk1[6] = (f2ord(a_ + b_) & ~0xFFu) | (unsigned)(hi ? 79 : 95); }
            { const float a_ = hi ? v1[13] : v1[12], b_ = hi ? v2[0] : v2[0]; blk1[7] = (f2ord(a_ + b_) & ~0xFFu) | (unsigned)(hi ? 47 : 63); }
            { const float a_ = hi ? v1[15] : v1[14], b_ = hi ? v2[0] : v2[0]; blk1[8] = (f2ord(a_ + b_) & ~0xFFu) | (unsigned)(hi ? 15 : 31); }
            blk1[9] = 0u;
            blk1[10] = 0u;
            blk1[11] = 0u;
            blk1[12] = 0u;
            blk1[13] = 0u;
            blk1[14] = 0u;
            blk1[15] = 0u;
            sort16_desc(blk0); sort16_desc(blk1);
#pragma unroll
            for (int j = 0; j < 16; ++j) ct[j] = blk0[j];
            merge_top16(ct, blk1);
            unsigned oth[16];
#pragma unroll
            for (int j = 0; j < 16; ++j) oth[j] = (unsigned)__shfl_xor((int)ct[j], 32);
            merge_top16(ct, oth);
        }
        float vals[16], ssum = 0.f;
        const float vmax = ord2f(ct[0] & ~0xFFu);
#pragma unroll
        for (int k = 0; k < 16; ++k) { vals[k] = __expf(ord2f(ct[k] & ~0xFFu) - vmax); ssum += vals[k]; }
        const float inv = 1.0f / ssum;
        asm volatile("s_waitcnt lgkmcnt(0)" ::: "memory");
        if (hi == 0) {
            int* ep = experts + (size_t)tok * 128 + h * 16;
            float* gp = gates + (size_t)tok * 128 + h * 16;
#pragma unroll
            for (int k = 0; k < 16; k += 4) {
                int e4[4];
#pragma unroll
                for (int q = 0; q < 4; ++q) {
                    const unsigned flat = 255u - (ct[k + q] & 255u);
                    const int i1 = myidx[flat >> 4], i2 = myidx[16 + (flat & 15)];
                    e4[q] = i1 * 128 + i2;
                }
                *(u32x4*)(ep + k) = (u32x4){(unsigned)e4[0], (unsigned)e4[1], (unsigned)e4[2], (unsigned)e4[3]};
                *(f32x4*)(gp + k) = (f32x4){vals[k] * inv, vals[k + 1] * inv, vals[k + 2] * inv, vals[k + 3] * inv};
            }
        }
        asm volatile("s_waitcnt lgkmcnt(0)" ::: "memory");
    }
}

__device__ __forceinline__ void peer_slice_map(const Params& P, LDSP unsigned char* lds, int vcu, int G, int wave, int& slice, int& half, int& wslot, int& nslot) {
    volatile LDSP unsigned* bst = (volatile LDSP unsigned*)(lds + LDS_BYTES - 16);
    LDSP unsigned* info = (LDSP unsigned*)(lds + LDS_BYTES - 64);
    __syncthreads();
    if (threadIdx.x == 0) {
        unsigned* bar = (unsigned*)(P.ws + 16384);
        const unsigned x = (unsigned)__builtin_amdgcn_s_getreg((3 << 11) | 20) & 0xFu;
        bool ok = true; unsigned sum = 0, mine = 0;
        for (unsigned j = 0; j < 16; ++j) { const unsigned c = __hip_atomic_load(&bar[256 + 64 * j], __ATOMIC_RELAXED, __HIP_MEMORY_SCOPE_AGENT); sum += c; if (j < 8 && c == 0) ok = false; if (j >= 8 && c != 0) ok = false; if (j == x) mine = c; }
        ok = ok && (sum == (unsigned)G) && (bst[2] < mine);
        info[0] = ok ? 1u : 0u; info[1] = x; info[2] = mine; info[3] = bst[2];
    }
    __syncthreads();
    if (info[0]) { slice = (int)(info[1] & 3u); half = (int)(info[1] >> 2); wslot = (int)info[3] * NWAVES + wave; nslot = (int)info[2] * NWAVES; }
    else if ((G & 7) == 0) { const int g8 = vcu / (G >> 3); slice = g8 & 3; half = g8 >> 2; wslot = (vcu % (G >> 3)) * NWAVES + wave; nslot = (G >> 3) * NWAVES; }
    else { slice = -1; half = 0; wslot = vcu * NWAVES + wave; nslot = G * NWAVES; }
}
struct PeerMetaA { int eA, eB; u32x4 h0, h1, h2, h3; float ss; };
struct PeerMetaB { int eA, eB; float aA, aB; };
#define PEER_IDX(m, j) __shfl(((j) < 8) ? (m).eA : (m).eB, (8 * (j) + grp) & 63)
__device__ __forceinline__ float dpp_xor1(float v) { return __builtin_bit_cast(float, __builtin_amdgcn_mov_dpp(__builtin_bit_cast(int, v), 0xB1, 0xF, 0xF, true)); }
__device__ __forceinline__ float dpp_xor2(float v) { return __builtin_bit_cast(float, __builtin_amdgcn_mov_dpp(__builtin_bit_cast(int, v), 0x4E, 0xF, 0xF, true)); }
__device__ __forceinline__ float dpp_hmirror(float v) { return __builtin_bit_cast(float, __builtin_amdgcn_mov_dpp(__builtin_bit_cast(int, v), 0x141, 0xF, 0xF, true)); }
__device__ __forceinline__ float dpp_ror8(float v) { return __builtin_bit_cast(float, __builtin_amdgcn_mov_dpp(__builtin_bit_cast(int, v), 0x128, 0xF, 0xF, true)); }
__device__ __forceinline__ float swap32_sum(float X, float Y) {
    const auto r = __builtin_amdgcn_permlane32_swap(__float_as_uint(X), __float_as_uint(Y), false, false);
    return __uint_as_float(r[0]) + __uint_as_float(r[1]);
}
__device__ __forceinline__ float swap16_sum(float X, float Y) {
    const auto r = __builtin_amdgcn_permlane16_swap(__float_as_uint(X), __float_as_uint(Y), false, false);
    return __uint_as_float(r[0]) + __uint_as_float(r[1]);
}
__device__ __forceinline__ void cvt32_fp4_pk(const u32x4 w, f32x2 (&f)[16]) {
#pragma unroll
    for (int q = 0; q < 4; ++q) {
        f[4 * q]     = __builtin_amdgcn_cvt_scalef32_pk_f32_fp4(w[q], 1.0f, 0); f[4 * q + 1] = __builtin_amdgcn_cvt_scalef32_pk_f32_fp4(w[q], 1.0f, 1);
        f[4 * q + 2] = __builtin_amdgcn_cvt_scalef32_pk_f32_fp4(w[q], 1.0f, 2); f[4 * q + 3] = __builtin_amdgcn_cvt_scalef32_pk_f32_fp4(w[q], 1.0f, 3);
    }
}
#define PA_T(it) ((slice >= 0) ? (2 * (it) + half) : ((it) >> 2))
#define PA_X(it) ((slice >= 0) ? slice : ((it) & 3))
__device__ __forceinline__ void phase_peer_a(const Params& P, LDSP unsigned char* lds, int vcu, int G) {
    unsigned char* ws = P.ws;
    const bf16_t* x1b = (const bf16_t*)(ws + OFF_R0);
    const float* rs2 = (const float*)(ws + OFF_RS2);
    const unsigned char* U4 = ws + OFF_U;
    const int* experts = (const int*)(ws + OFF_EXPERTS);
    float* apart = (float*)(ws + OFF_R1);
    const int tid = opaque_tid(), lane = tid & 63, wave = tid >> 6, grp = lane >> 3, sub = lane & 7;
    const bool b2 = lane & 4, b1 = lane & 2, b0 = lane & 1;
    int slice, half, wslot, nslot;
    peer_slice_map(P, lds, vcu, G, wave, slice, half, wslot, nslot);
    const int nitems = (slice >= 0) ? T / 2 : T * 4;
#define PA_META(m, it) do { const int it_ = ((it) < nitems) ? (it) : wslot; { const int t_ = PA_T(it_), x_ = PA_X(it_); \
        (m).eA = __builtin_nontemporal_load(experts + (size_t)t_ * 128 + lane); (m).eB = __builtin_nontemporal_load(experts + (size_t)t_ * 128 + 64 + lane); const u32x4* hp_ = (const u32x4*)(x1b + (size_t)t_ * DM + 256 * x_ + 32 * sub); \
        (m).h0 = __builtin_nontemporal_load(hp_); (m).h1 = __builtin_nontemporal_load(hp_ + 1); (m).h2 = __builtin_nontemporal_load(hp_ + 2); (m).h3 = __builtin_nontemporal_load(hp_ + 3); (m).ss = rs2[t_]; } } while (0)
#define PA_GATHER(R, m, it, J0) do { const int x_ = PA_X(it); _Pragma("unroll") for (int j = 0; j < 8; ++j) { const int e_ = PEER_IDX(m, (J0) + j); \
        (R)[j] = *(const u32x4*)(U4 + (((unsigned)x_ * (unsigned)PEER_NE + (unsigned)e_) * 128u + 16u * (unsigned)sub)); } } while (0)
#define PA_COMPUTE(R, J0) do { _Pragma("unroll") for (int j = 0; j < 8; ++j) { asm volatile("" : "+v"((R)[j])); int ah = 0, al = 0; \
        _Pragma("unroll") for (int q = 0; q < 4; ++q) { ah = __builtin_amdgcn_sdot8((int)(R)[j][q], (int)HQ[q], ah, false); al = __builtin_amdgcn_sdot8((int)(R)[j][q], (int)LQ[q], al, false); } \
        part[(J0) + j] = (float)(ah * 16 + al); asm volatile("" : "+v"(part[(J0) + j])); } } while (0)
    PeerMetaA m0, m1, m2;
    m0.eA = m0.eB = m1.eA = m1.eB = m2.eA = m2.eB = 0; m0.ss = m1.ss = m2.ss = 1.f;
    m0.h0 = m0.h1 = m0.h2 = m0.h3 = m1.h0 = m1.h1 = m1.h2 = m1.h3 = m2.h0 = m2.h1 = m2.h2 = m2.h3 = (u32x4){0u, 0u, 0u, 0u};
    u32x4 R0[8], R1[8];
    PA_META(m0, wslot); PA_META(m1, wslot + nslot);
    if (wslot >= nitems) return;
    PA_GATHER(R0, m0, wslot, 0); PA_GATHER(R1, m0, wslot, 8);
#pragma unroll 1
    for (int it = wslot; it < nitems; it += nslot) {
        PA_META(m2, it + 2 * nslot);
        unsigned HQ[4], LQ[4]; float part[16];
        { const float inv = (119.0f / 8.0f) * __builtin_amdgcn_rsqf(m0.ss * (1.0f / DM) + NORM_EPS); const f32x2 inv2 = {inv, inv}, magic2 = {12582920.0f, 12582920.0f};
          typedef short s16x2 __attribute__((ext_vector_type(2)));
          const s16x2 lo2 = {(short)-112, (short)-112}, hi2 = {(short)127, (short)127};
          constexpr unsigned M = 0x000F000Fu;
#define PA_H(Q, W) do { unsigned p_[4]; _Pragma("unroll") for (int w = 0; w < 4; ++w) { const unsigned wd = (W)[w]; const f32x2 f = {__uint_as_float(wd << 16), __uint_as_float(wd & 0xffff0000u)}; \
              const f32x2 t = __builtin_elementwise_fma(f, inv2, magic2);                                     \
              const unsigned pk_ = __builtin_amdgcn_perm(__float_as_uint(t.y), __float_as_uint(t.x), 0x05040100u); \
              p_[w] = __builtin_bit_cast(unsigned, __builtin_elementwise_min(__builtin_elementwise_max(__builtin_bit_cast(s16x2, pk_), lo2), hi2)); } \
          HQ[Q] = ((p_[0] >> 4) & M) | (p_[1] & (M << 4)) | ((p_[2] << 4) & (M << 8)) | ((p_[3] << 8) & (M << 12)); \
          LQ[Q] = ((p_[0] & M) | ((p_[1] << 4) & (M << 4)) | ((p_[2] << 8) & (M << 8)) | ((p_[3] << 12) & (M << 12))) ^ 0x88888888u; } while (0)
          PA_H(0, m0.h0); PA_H(1, m0.h1); PA_H(2, m0.h2); PA_H(3, m0.h3);
#undef PA_H
        }
        PA_COMPUTE(R0, 0);
        const int itn = (it + nslot < nitems) ? it + nslot : it;
        PA_GATHER(R0, m1, itn, 0);
        PA_COMPUTE(R1, 8);
        PA_GATHER(R1, m1, itn, 8);
        float q8[8], q4[4], q2[2];
#pragma unroll
        for (int i = 0; i < 8; ++i) { const float send = b2 ? part[i] : part[i + 8], keep = b2 ? part[i + 8] : part[i]; q8[i] = keep + dpp_hmirror(send); }
#pragma unroll
        for (int i = 0; i < 4; ++i) { const float send = b1 ? q8[i] : q8[i + 4], keep = b1 ? q8[i + 4] : q8[i]; q4[i] = keep + dpp_xor2(send); }
#pragma unroll
        for (int i = 0; i < 2; ++i) { const float send = b0 ? q4[i] : q4[i + 2], keep = b0 ? q4[i + 2] : q4[i]; q2[i] = keep + dpp_xor1(send); }
        float* ap = apart + ((size_t)PA_X(it) * T + PA_T(it)) * 128 + lane;
        __builtin_nontemporal_store(q2[0], ap); __builtin_nontemporal_store(q2[1], ap + 64);
        m0 = m1; m1 = m2;
    }
#undef PA_META
#undef PA_GATHER
#undef PA_COMPUTE
}
__device__ __forceinline__ void phase_peer_w(const Params& P, LDSP unsigned char* lds, int vcu, int G) {
    unsigned char* ws = P.ws;
    float* gates = (float*)(ws + OFF_GATES);
    const float* apart = (const float*)(ws + OFF_R1);
    const int* experts = (const int*)(ws + OFF_EXPERTS);
    const f32x2* suv = (const f32x2*)(ws + OFF_PSCALE);
    const size_t gt = (size_t)(vcu * NTHREADS + threadIdx.x), NGT = (size_t)G * NTHREADS;
    for (size_t i = gt; i < (size_t)T * 128; i += NGT) {
        const int t = (int)(i >> 7), k = (int)(i & 127);
        const int sub = k >> 4, s1 = (k >> 3) & 1, grp = k & 7, idx = s1 * 64 + grp * 8 + sub;
        float a = 0.f;
#pragma unroll
        for (int xs = 0; xs < 4; ++xs) a += apart[((size_t)xs * T + t) * 128 + idx];
        const int e = experts[i];
        const f32x2 sc2 = suv[e];
        gates[i] = gelu_tanh(a * sc2.x * (8.0f / 119.0f)) * gates[i] * sc2.y;
    }
}
__device__ __forceinline__ void phase_peer_b(const Params& P, LDSP unsigned char* lds, int vcu, int G) {
    unsigned char* ws = P.ws;
    const unsigned char* V4 = ws + OFF_V;
    const int* experts = (const int*)(ws + OFF_EXPERTS);
    const float* wtok = (const float*)(ws + OFF_GATES);
    const int tid = opaque_tid(), lane = tid & 63, wave = tid >> 6, grp = lane >> 3, sub = lane & 7;
    const bool b3 = lane & 8;
    const int k0 = 16 * sub + grp, k1 = k0 + 8;
    LDSP float* wbuf = (LDSP float*)(lds + wave * 1024);
    int slice, half, wslot, nslot;
    peer_slice_map(P, lds, vcu, G, wave, slice, half, wslot, nslot);
    const int nitems = (slice >= 0) ? T / 2 : T * 4;
#define PB_META(m, it) do { const int it_ = ((it) < nitems) ? (it) : wslot; { const int t_ = PA_T(it_); \
        (m).eA = __builtin_nontemporal_load(experts + (size_t)t_ * 128 + lane); (m).eB = __builtin_nontemporal_load(experts + (size_t)t_ * 128 + 64 + lane); \
        (m).aA = __builtin_nontemporal_load(wtok + (size_t)t_ * 128 + k0); (m).aB = __builtin_nontemporal_load(wtok + (size_t)t_ * 128 + k1); } } while (0)
#define PB_GATHER(R, m, it, J0) do { const int x_ = PA_X(it); _Pragma("unroll") for (int j = 0; j < 8; ++j) { const int e_ = PEER_IDX(m, (J0) + j); \
        (R)[j] = *(const u32x4*)(V4 + (((unsigned)x_ * (unsigned)PEER_NE + (unsigned)e_) * 128u + 16u * (unsigned)sub)); } } while (0)
#define PB_COMPUTE(R, J0) do { _Pragma("unroll") for (int j = 0; j < 8; ++j) { f32x2 f[16]; asm volatile("" : "+v"((R)[j])); cvt32_fp4_pk((R)[j], f); const float wk = wb[8 * ((J0) + j) + grp]; const f32x2 wk2 = {wk, wk}; \
        _Pragma("unroll") for (int i = 0; i < 16; ++i) acc2[i] = __builtin_elementwise_fma(wk2, f[i], acc2[i]); \
        asm volatile("" : "+v"(acc2[0]), "+v"(acc2[1]), "+v"(acc2[2]), "+v"(acc2[3]), "+v"(acc2[4]), "+v"(acc2[5]), "+v"(acc2[6]), "+v"(acc2[7])); \
        asm volatile("" : "+v"(acc2[8]), "+v"(acc2[9]), "+v"(acc2[10]), "+v"(acc2[11]), "+v"(acc2[12]), "+v"(acc2[13]), "+v"(acc2[14]), "+v"(acc2[15])); } } while (0)
    PeerMetaB m0, m1, m2;
    m0.eA = m0.eB = m1.eA = m1.eB = m2.eA = m2.eB = 0; m0.aA = m0.aB = m1.aA = m1.aB = m2.aA = m2.aB = 0.f;
    u32x4 R0[8], R1[8];
    PB_META(m0, wslot); PB_META(m1, wslot + nslot);
    if (wslot >= nitems) return;
    PB_GATHER(R0, m0, wslot, 0); PB_GATHER(R1, m0, wslot, 8);
    int par = 0;
#pragma unroll 1
    for (int it = wslot; it < nitems; it += nslot) {
        PB_META(m2, it + 2 * nslot);
        LDSP float* wb = wbuf + par * 128; par ^= 1;
        wb[k0] = m0.aA; wb[k1] = m0.aB;
        asm volatile("s_waitcnt lgkmcnt(0)" ::: "memory");
        f32x2 acc2[16];
#pragma unroll
        for (int i = 0; i < 16; ++i) acc2[i] = (f32x2){0.f, 0.f};
        PB_COMPUTE(R0, 0);
        const int itn = (it + nslot < nitems) ? it + nslot : it;
        PB_GATHER(R0, m1, itn, 0);
        PB_COMPUTE(R1, 8);
        PB_GATHER(R1, m1, itn, 8);
        float acc[32];
#pragma unroll
        for (int i = 0; i < 16; ++i) { acc[2 * i] = acc2[i].x; acc[2 * i + 1] = acc2[i].y; }
        float q16[16], q8[8], q4[4];
#pragma unroll
        for (int i = 0; i < 16; ++i) q16[i] = swap32_sum(acc[i], acc[i + 16]);
#pragma unroll
        for (int i = 0; i < 8; ++i) q8[i] = swap16_sum(q16[i], q16[i + 8]);
#pragma unroll
        for (int i = 0; i < 4; ++i) { const float send = b3 ? q8[i] : q8[i + 4], keep = b3 ? q8[i + 4] : q8[i]; q4[i] = keep + dpp_ror8(send); }
        const int c32 = ((lane & 32) ? 16 : 0) + ((lane & 16) ? 8 : 0) + (b3 ? 4 : 0);
        const size_t oidx = (size_t)PA_T(it) * DM + 256 * PA_X(it) + 32 * sub + c32;
        const u32x2 xr = __builtin_nontemporal_load((const u32x2*)((const bf16_t*)(P.ws + OFF_R0) + oidx));
        f32x4 o;
        o.x = __uint_as_float(xr.x << 16) + q4[0]; o.y = __uint_as_float(xr.x & 0xffff0000u) + q4[1]; o.z = __uint_as_float(xr.y << 16) + q4[2]; o.w = __uint_as_float(xr.y & 0xffff0000u) + q4[3];
        __builtin_nontemporal_store(o, (f32x4*)(P.out + oidx));
        m0 = m1; m1 = m2;
    }
#undef PB_META
#undef PB_GATHER
#undef PB_COMPUTE
#undef PA_T
#undef PA_X
}

#ifndef SELFCHECK
#define SELFCHECK 0
#endif
#if SELFCHECK
constexpr size_t OFF_CHK = 512 * 1024;
__device__ __forceinline__ void wave_argmax(float& v, int& i) {
#pragma unroll
    for (int o = 1; o < 64; o <<= 1) {
        const float ov = __shfl_xor(v, o); const int oi = __shfl_xor(i, o);
        if (ov > v || (ov == v && oi < i)) { v = ov; i = oi; }
    }
}
struct NaiveAcc { float m, l; float o[64]; };
__device__ __forceinline__ float wave_max(float v) {
#pragma unroll
    for (int o = 1; o < 64; o <<= 1) v = fmaxf(v, __shfl_xor(v, o));
    return v;
}
__device__ __forceinline__ void nacc_reset(NaiveAcc& a) { a.m = -1.0e30f; a.l = 0.f;
#pragma unroll
    for (int d = 0; d < 64; ++d) a.o[d] = 0.f; }
__device__ __forceinline__ float dot64(LDSP const float* qs, const bf16_t* krow) {
    float s = 0.f;
#pragma unroll
    for (int c = 0; c < 8; ++c) { float f[8]; cvt8(*(const u32x4*)(krow + c * 8), f);
#pragma unroll
        for (int i = 0; i < 8; ++i) s += qs[c * 8 + i] * f[i]; }
    return s;
}
__device__ __forceinline__ void axpy64(NaiveAcc& a, float alpha, float p, const bf16_t* vrow) {
#pragma unroll
    for (int c = 0; c < 8; ++c) { float f[8]; cvt8(*(const u32x4*)(vrow + c * 8), f);
#pragma unroll
        for (int i = 0; i < 8; ++i) a.o[c * 8 + i] = a.o[c * 8 + i] * alpha + p * f[i]; }
}
__device__ __forceinline__ void naive_chunk(NaiveAcc& a, LDSP const float* qs, const bf16_t* krow, const bf16_t* vrow, bool valid) {
    float s = dot64(qs, krow);
    if (!valid) s = -INFINITY;
    const float mnew = fmaxf(a.m, wave_max(s));
    const float alpha = exp2f(a.m - mnew), p = valid ? exp2f(s - mnew) : 0.f;
    a.l = a.l * alpha + p; a.m = mnew;
    axpy64(a, alpha, p, vrow);
}
__device__ __forceinline__ float nacc_final(NaiveAcc& a, int lane) {
    const float l = wave_sum(a.l);
    const float inv = (l > 0.f) ? 1.0f / l : 0.f;
    const bool b5 = lane & 32, b4 = lane & 16, b3 = lane & 8, b2 = lane & 4, b1 = lane & 2, b0 = lane & 1;
    float q32[32], q16[16], q8[8], q4[4], q2[2];
#pragma unroll
    for (int i = 0; i < 32; ++i) { const float send = b5 ? a.o[i] : a.o[i + 32], keep = b5 ? a.o[i + 32] : a.o[i]; q32[i] = keep + __shfl_xor(send, 32); }
#pragma unroll
    for (int i = 0; i < 16; ++i) { const float send = b4 ? q32[i] : q32[i + 16], keep = b4 ? q32[i + 16] : q32[i]; q16[i] = keep + __shfl_xor(send, 16); }
#pragma unroll
    for (int i = 0; i < 8; ++i) { const float send = b3 ? q16[i] : q16[i + 8], keep = b3 ? q16[i + 8] : q16[i]; q8[i] = keep + __shfl_xor(send, 8); }
#pragma unroll
    for (int i = 0; i < 4; ++i) { const float send = b2 ? q8[i] : q8[i + 4], keep = b2 ? q8[i + 4] : q8[i]; q4[i] = keep + __shfl_xor(send, 4); }
#pragma unroll
    for (int i = 0; i < 2; ++i) { const float send = b1 ? q4[i] : q4[i + 2], keep = b1 ? q4[i + 2] : q4[i]; q2[i] = keep + __shfl_xor(send, 2); }
    const float send = b0 ? q2[0] : q2[1], keep = b0 ? q2[1] : q2[0];
    return (keep + __shfl_xor(send, 1)) * inv;
}
__device__ __forceinline__ float cmp_err(float ref, const bf16_t* got, int lane) {
    const float e = wave_max(fabsf(ref - bf2f(got[lane]))), mx = wave_max(fabsf(ref));
    return e / (mx + 1e-3f);
}
__device__ __forceinline__ void phase_selfcheck(const Params& P, LDSP unsigned char* lds, int vcu, int G) {
    unsigned char* ws = P.ws;
    const int tid = opaque_tid(), lane = tid & 63, wave = tid >> 6;
    const int gw = vcu * NWAVES + wave, NGW = G * NWAVES;
    unsigned* cnt = (unsigned*)(ws + OFF_CHK);
    const bf16_t* qa = (const bf16_t*)(ws + OFF_R1);
    const bf16_t* ka = (const bf16_t*)(ws + OFF_R1 + 32 * MiB);
    const bf16_t* va = (const bf16_t*)(ws + OFF_R1 + 64 * MiB);
    const bf16_t* qb = (const bf16_t*)(ws + OFF_R1 + 96 * MiB);
    const bf16_t* ya = (const bf16_t*)(ws + OFF_R0);
    const bf16_t* yb = (const bf16_t*)(ws + OFF_R0 + 32 * MiB);
    const float* kmean = (const float*)(ws + OFF_KMEAN);
    const float* bgate = (const float*)(ws + OFF_BGATE);
    LDSP float* psum = (LDSP float*)(lds + wave * 4096);
    LDSP float* qs = psum + 320;
    LDSP float* ocs = psum + 384;
    constexpr int NS = 537;
#pragma unroll 1
    for (int item = gw; item < NS * 8; item += NGW) {
        const int t = 37 + 61 * (item >> 3), h = item & 7, b = t >> 12, pos = t & (SEQ - 1), own = pos >> 8;
        qs[lane] = bf2f(qa[(size_t)t * 512 + h * 64 + lane]);
        asm volatile("s_waitcnt lgkmcnt(0)" ::: "memory");
        float g0 = -INFINITY, g1 = -INFINITY, g2 = -INFINITY; int i0 = -1, i1 = -1, i2 = -1;
#pragma unroll 1
        for (int j = 0; j < own; ++j) {
            const float* km = kmean + (size_t)((b * 8 + h) * 16 + j) * 64;
            float d = 0.f;
#pragma unroll 8
            for (int i = 0; i < 64; ++i) d += qs[i] * km[i];
            if (d > g0) { g2 = g1; i2 = i1; g1 = g0; i1 = i0; g0 = d; i0 = j; }
            else if (d > g1) { g2 = g1; i2 = i1; g1 = d; i1 = j; }
            else if (d > g2) { g2 = d; i2 = j; }
        }
        NaiveAcc a; nacc_reset(a);
#pragma unroll 1
        for (int j = 0; j <= own; ++j) {
            if (j < own && j != i0 && j != i1 && j != i2) continue;
#pragma unroll 1
            for (int ck = 0; ck < 4; ++ck) {
                const int kp = j * 256 + ck * 64 + lane;
                const size_t kr = (size_t)(b * SEQ + kp) * 512 + h * 64;
                naive_chunk(a, qs, ka + kr, va + kr, kp <= pos);
            }
        }
        const float om = nacc_final(a, lane);
        const float e = cmp_err(om, ya + (size_t)t * 512 + h * 64, lane);
        if (lane == 0 && !(e < 0.05f)) atomicAdd(cnt + 0, 1u);
        asm volatile("s_waitcnt lgkmcnt(0)" ::: "memory");
    }
#pragma unroll 1
    for (int item = gw; item < NS * 2; item += NGW) {
        const int t = 37 + 61 * (item >> 1), g = item & 1, b = t >> 12, pos = t & (SEQ - 1), own = pos >> 6;
        const bf16_t* kc = (const bf16_t*)(ws + OFF_KC) + (size_t)(b * 2 + g) * 256 * 64;
        const bf16_t* vc = (const bf16_t*)(ws + OFF_VC) + (size_t)(b * 2 + g) * 256 * 64;
        const bf16_t* ks = (const bf16_t*)(ws + OFF_R2 + 16 * MiB) + (size_t)(b * SEQ) * 128 + g * 64;
        const bf16_t* vs = (const bf16_t*)(ws + OFF_R2 + 24 * MiB) + (size_t)(b * SEQ) * 128 + g * 64;
        const bf16_t* kw = (const bf16_t*)(ws + OFF_R2 + 32 * MiB) + (size_t)(b * SEQ) * 128 + g * 64;
        const bf16_t* vw = (const bf16_t*)(ws + OFF_R2 + 40 * MiB) + (size_t)(b * SEQ) * 128 + g * 64;
        for (int i = lane; i < 320; i += 64) psum[i] = 0.f;
        asm volatile("s_waitcnt lgkmcnt(0)" ::: "memory");
        const int ncmp_vis = (pos >= 31) ? ((pos - 31) >> 4) + 1 : 0;
#pragma unroll 1
        for (int r = 0; r < 4; ++r) {
            qs[lane] = bf2f(qb[(size_t)t * 512 + (g * 4 + r) * 64 + lane]);
            asm volatile("s_waitcnt lgkmcnt(0)" ::: "memory");
            float mx = -INFINITY;
#pragma unroll 1
            for (int ck = 0; ck < 4; ++ck) { const int n = ck * 64 + lane;
                const float sdot = dot64(qs, kc + (size_t)n * 64);
                mx = fmaxf(mx, (n < ncmp_vis) ? sdot : -INFINITY); }
            mx = wave_max(mx);
            float l = 0.f;
#pragma unroll 1
            for (int ck = 0; ck < 4; ++ck) { const int n = ck * 64 + lane;
                const float sdot = dot64(qs, kc + (size_t)n * 64);
                l += (n < ncmp_vis) ? exp2f(sdot - mx) : 0.f; }
            l = wave_sum(l);
            const float inv = (l > 0.f) ? 1.0f / l : 0.f;
            NaiveAcc a; nacc_reset(a);
#pragma unroll 1
            for (int ck = 0; ck < 4; ++ck) { const int n = ck * 64 + lane;
                const float sdot = dot64(qs, kc + (size_t)n * 64);
                const float pr = (n < ncmp_vis) ? exp2f(sdot - mx) * inv : 0.f;
                psum[n] += pr;
                axpy64(a, 1.0f, pr, vc + (size_t)n * 64); }
            a.l = (lane == 0) ? 1.f : 0.f;
            ocs[r * 64 + lane] = nacc_final(a, lane);
            asm volatile("s_waitcnt lgkmcnt(0)" ::: "memory");
        }
        {
            const int j = lane;
            float imp = 0.f;
            for (int n = 4 * j - 1; n <= 4 * j + 3; ++n) if (n >= 0 && n < 255) imp += psum[n];
            if (j == 0 || j == own || j == own - 1) imp = 1.0e30f;
            if (j > own) imp = -1.0e30f;
            unsigned long long sel = 0ull;
#pragma unroll 1
            for (int r = 0; r < 16; ++r) {
                float v = imp; int i = j;
                wave_argmax(v, i);
                if (v > -0.5e30f) sel |= 1ull << i;
                if (i == j) imp = -3.0e38f;
            }
            psum[256] = __uint_as_float((unsigned)sel); psum[257] = __uint_as_float((unsigned)(sel >> 32));
            asm volatile("s_waitcnt lgkmcnt(0)" ::: "memory");
        }
        const unsigned long long sel = ((unsigned long long)__float_as_uint(psum[257]) << 32) | __float_as_uint(psum[256]);
#pragma unroll 1
        for (int r = 0; r < 4; ++r) {
            const int head = g * 4 + r;
            qs[lane] = bf2f(qb[(size_t)t * 512 + head * 64 + lane]);
            asm volatile("s_waitcnt lgkmcnt(0)" ::: "memory");
            const float gt0 = bgate[(size_t)t * 24 + head * 3], gt1 = bgate[(size_t)t * 24 + head * 3 + 1], gt2 = bgate[(size_t)t * 24 + head * 3 + 2];
            float y = gt0 * ocs[r * 64 + lane];
            NaiveAcc a; nacc_reset(a);
#pragma unroll 1
            for (int j = 0; j <= own; ++j) {
                if (!((sel >> j) & 1ull)) continue;
                const int kp = j * 64 + lane;
                naive_chunk(a, qs, ks + (size_t)kp * 128, vs + (size_t)kp * 128, kp <= pos);
            }
            y += gt1 * nacc_final(a, lane);
            nacc_reset(a);
#pragma unroll 1
            for (int ck = 0; ck < 9; ++ck) {
                const int kp = pos - 575 + ck * 64 + lane;
                const bool valid = kp >= 0 && kp <= pos && kp > pos - 512;
                const int kpc = kp < 0 ? 0 : kp;
                naive_chunk(a, qs, kw + (size_t)kpc * 128, vw + (size_t)kpc * 128, valid);
            }
            y += gt2 * nacc_final(a, lane);
            const float e = cmp_err(y, yb + (size_t)t * 512 + head * 64, lane);
            if (lane == 0 && !(e < 0.05f)) atomicAdd(cnt + 1, 1u);
            asm volatile("s_waitcnt lgkmcnt(0)" ::: "memory");
        }
    }
}

__device__ __forceinline__ void phase_selfcheck2(const Params& P, LDSP unsigned char* lds, int vcu, int G) {
    unsigned char* ws = P.ws;
    const int tid = opaque_tid(), lane = tid & 63, wave = tid >> 6;
    const int gw = vcu * NWAVES + wave, NGW = G * NWAVES;
    unsigned* cnt = (unsigned*)(ws + OFF_CHK);
    LDSP float* hs = (LDSP float*)(lds + wave * 8192);
    const float* x = P.in[I_X]; const float* g1 = P.in[I_NORM1]; const float* w = P.in[I_WIN];
    constexpr int NS = 192, NGRP = 14;
#pragma unroll 1
    for (int item = gw; item < NS * NGRP; item += NGW) {
        const int si = item / NGRP, grp = item % NGRP;
        const int t = 11 + 167 * si, b = t >> 12, pos = t & (SEQ - 1);
        const int hsel = si & 7, gsel = si & 1;
        float ss = 0.f;
        for (int i = lane; i < DM; i += 64) { const float v = x[(size_t)t * DM + i]; ss += v * v; }
        ss = wave_sum(ss);
        const float rs = 1.0f / sqrtf(ss / DM + NORM_EPS);
        for (int i = lane; i < DM; i += 64) hs[i] = x[(size_t)t * DM + i] * rs * g1[i];
        asm volatile("s_waitcnt lgkmcnt(0)" ::: "memory");
        int col0, kind; const float* gain = nullptr; float oscale = 1.f; const bf16_t* got = nullptr; int ncols = 64;
        const bf16_t* R1 = (const bf16_t*)(ws + OFF_R1); const bf16_t* R2 = (const bf16_t*)(ws + OFF_R2); const bf16_t* R3 = (const bf16_t*)(ws + OFF_R3);
        const size_t M32 = (size_t)16 * 1024 * 1024;
        switch (grp) {
        case 0: col0 = hsel * 64;          kind = 1; gain = P.in[I_AQG]; oscale = QSCALE; got = R1 + (size_t)t * 512 + hsel * 64; break;
        case 1: col0 = 512 + hsel * 64;    kind = 1; gain = P.in[I_AKG]; got = R1 + M32 + (size_t)t * 512 + hsel * 64; break;
        case 2: col0 = 1024 + hsel * 64;   kind = 0; got = R1 + 2 * M32 + (size_t)t * 512 + hsel * 64; break;
        case 3: col0 = 1536 + hsel * 64;   kind = 1; gain = P.in[I_BQG]; oscale = QSCALE; got = R1 + 3 * M32 + (size_t)t * 512 + hsel * 64; break;
        case 4: col0 = 2048 + gsel * 64;   kind = 0; got = R2 + ((size_t)((b * 2 + gsel) * SEQ + pos)) * 64; break;
        case 5: col0 = 2176 + gsel * 64;   kind = 0; got = R2 + M32 / 4 + ((size_t)((b * 2 + gsel) * SEQ + pos)) * 64; break;
        case 6: col0 = 2304 + gsel * 64;   kind = 1; gain = P.in[I_BKSG]; got = R2 + 2 * (M32 / 4) + (size_t)t * 128 + gsel * 64; break;
        case 7: col0 = 2432 + gsel * 64;   kind = 0; got = R2 + 3 * (M32 / 4) + (size_t)t * 128 + gsel * 64; break;
        case 8: col0 = 2560 + gsel * 64;   kind = 1; gain = P.in[I_BKWG]; got = R2 + 4 * (M32 / 4) + (size_t)t * 128 + gsel * 64; break;
        case 9: col0 = 2688 + gsel * 64;   kind = 0; got = R2 + 5 * (M32 / 4) + (size_t)t * 128 + gsel * 64; break;
        case 10: col0 = 2840 + hsel * 64;        kind = 2; got = R3 + (size_t)t * 2048 + hsel * 64; break;
        case 11: col0 = 2840 + 1024 + hsel * 64; kind = 2; got = R3 + (size_t)t * 2048 + 1024 + hsel * 64; break;
        case 12: col0 = 2840 + 1024 + 512 + hsel * 64; kind = 2; got = R3 + (size_t)t * 2048 + 1536 + hsel * 64; break;
        default: col0 = 2816; kind = 3; ncols = 24; break;
        }
        if (grp == 10) continue;
        float acc = 0.f;
        if (lane < ncols) {
#pragma unroll 4
            for (int k = 0; k < DM; ++k) acc += hs[k] * w[(size_t)k * 4888 + col0 + lane];
        }
        float ref;
        if (kind == 1) {
            const float ssq = wave_sum(acc * acc);
            float y = acc / sqrtf(ssq / 64.0f + NORM_EPS) * gain[lane];
            const float ya_ = __shfl(y, (lane + 8) & 63), yb_ = __shfl(y, (lane - 8) & 63);
            const int f = lane & 7;
            const float ang = (float)pos * powf(500000.0f, -(float)(2 * f) / 16.0f);
            const float c = cosf(ang), sn = sinf(ang);
            if (lane < 8) y = y * c - ya_ * sn; else if (lane < 16) y = y * c + yb_ * sn;
            ref = y * oscale;
        } else if (kind == 2) {
            ref = 1.0f / (1.0f + expf(-(acc + P.in[I_BMERGE][col0 - 2840 + lane])));
        } else if (kind == 3) {
            ref = 1.0f / (1.0f + expf(-acc));
        } else ref = acc;
        float gotv;
        if (kind == 3) gotv = (lane < 24) ? ((const float*)(ws + OFF_BGATE))[(size_t)t * 24 + lane] : 0.f;
        else gotv = bf2f(got[lane]);
        if (kind == 3 && lane >= 24) ref = 0.f;
        const float e = wave_max(fabsf(ref - gotv)) / (wave_max(fabsf(ref)) + 1e-3f);
        if (lane == 0 && !(e < 0.03f)) atomicAdd(cnt + 0, 1u);
        asm volatile("s_waitcnt lgkmcnt(0)" ::: "memory");
    }
#pragma unroll 1
    for (int item = gw; item < 1024; item += NGW) {
        const int b = item >> 7, h = (item >> 4) & 7, blk = item & 15;
        const bf16_t* p = (const bf16_t*)(ws + OFF_R1 + 32 * MiB) + (size_t)(b * SEQ + blk * 256) * 512 + h * 64 + lane;
        float sref = 0.f;
        for (int k = 0; k < 256; ++k) sref += bf2f(p[(size_t)k * 512]);
        const float gotv = ((const float*)(ws + OFF_KMEAN))[(size_t)item * 64 + lane];
        const float e = wave_max(fabsf(sref - gotv)) / (wave_max(fabsf(sref)) + 1e-2f);
        if (lane == 0 && !(e < 0.03f)) atomicAdd(cnt + 1, 1u);
    }
#pragma unroll 1
    for (int item = gw; item < 96 * 2; item += NGW) {
        const int si = item >> 1, kv = item & 1;
        const int slab = si & 15, n = (si * 37 + 3) % 255;
        const bf16_t* raw = (const bf16_t*)(ws + OFF_R2 + (size_t)kv * 8 * MiB) + (size_t)slab * SEQ * 64 + (size_t)n * 16 * 64;
        const float* posv = P.in[kv ? I_CPV : I_CPK]; const float* w1 = P.in[kv ? I_CVW1 : I_CKW1]; const float* b1 = P.in[kv ? I_CVB1 : I_CKB1];
        const float* w2 = P.in[kv ? I_CVW2 : I_CKW2]; const float* b2 = P.in[kv ? I_CVB2 : I_CKB2];
        float hacc[4] = {0.f, 0.f, 0.f, 0.f};
#pragma unroll 1
        for (int i = 0; i < 2048; ++i) {
            const float a = bf2f(raw[i]) + posv[i];
#pragma unroll
            for (int u = 0; u < 4; ++u) hacc[u] += a * w1[(size_t)i * 256 + lane + 64 * u];
        }
#pragma unroll
        for (int u = 0; u < 4; ++u) { const float z = hacc[u] + b1[lane + 64 * u]; hs[1024 + lane + 64 * u] = 0.5f * z * (1.0f + tanhf(0.7978845608028654f * (z + 0.044715f * z * z * z))); }
        asm volatile("s_waitcnt lgkmcnt(0)" ::: "memory");
        float o = b2[lane];
#pragma unroll 4
        for (int j = 0; j < 256; ++j) o += hs[1024 + j] * w2[(size_t)j * 64 + lane];
        if (!kv) { const float ssq = wave_sum(o * o); o = o / sqrtf(ssq / 64.0f + NORM_EPS) * P.in[I_BKCG][lane]; }
        const float gotv = bf2f(((const bf16_t*)(ws + (kv ? OFF_VC : OFF_KC)))[((size_t)slab * 256 + n) * 64 + lane]);
        const float e = wave_max(fabsf(o - gotv)) / (wave_max(fabsf(o)) + 1e-3f);
        if (lane == 0 && !(e < 0.03f)) atomicAdd(cnt + 1, 1u);
        asm volatile("s_waitcnt lgkmcnt(0)" ::: "memory");
    }
}
#endif

#define XB_TMO      128
#define XB_XCNT(j)  (256  + 64 * (j))
#define XB_XSUB(j)  (1280 + 64 * (j))
#define XB_XGEN(j)  (2304 + 64 * (j))
#define XB_TOP      3328
#define XB_TOPGEN   3392
#define XCD_BAR_WORDS 3456
#define XB_SPIN_CAP (1u << 22)
__device__ __forceinline__ unsigned xb_ld(unsigned* p)              { return __hip_atomic_load(p, __ATOMIC_RELAXED, __HIP_MEMORY_SCOPE_AGENT); }
__device__ __forceinline__ unsigned xb_add(unsigned* p, unsigned v) { return __hip_atomic_fetch_add(p, v, __ATOMIC_RELAXED, __HIP_MEMORY_SCOPE_AGENT); }
__device__ __forceinline__ unsigned xb_xcc_id() { return (unsigned)__builtin_amdgcn_s_getreg((3 << 11) | 20) & 0xFu; }
#define XB_SPIN(cond, bar) do { unsigned _sp = 0; while (cond) { __builtin_amdgcn_s_sleep(1); \
    if ((++_sp & 255u) == 0u) { if (xb_ld(&(bar)[XB_TMO])) break; if (_sp > XB_SPIN_CAP) { atomicAdd(&(bar)[XB_TMO], 1u); break; } } } } while (0)
struct XcdBarrier { unsigned* bar; unsigned x; volatile LDSP unsigned* st; };
__device__ __forceinline__ XcdBarrier xcd_barrier_post(unsigned* bar, volatile LDSP unsigned* st) {
    XcdBarrier b; b.bar = bar; b.x = xb_xcc_id(); b.st = st;
    if (threadIdx.x == 0) (void)xb_add(&bar[XB_XCNT(b.x)], 1u);
    return b;
}
__device__ __forceinline__ void xcd_barrier_complete(unsigned* bar, unsigned x, unsigned& nloc, unsigned& nx) {
    const unsigned G = gridDim.x * gridDim.y * gridDim.z;
    unsigned sum, cnt, mine, sp = 0u;
    for (;;) {
        sum = 0u; cnt = 0u; mine = 0u;
#pragma unroll
        for (unsigned j = 0; j < 16; ++j) { const unsigned c = xb_ld(&bar[XB_XCNT(j)]); sum += c; cnt += (c > 0u) ? 1u : 0u; mine = (j == x) ? c : mine; }
        if (sum == G) break;
        __builtin_amdgcn_s_sleep(1);
        if ((++sp & 255u) == 0u) { if (xb_ld(&bar[XB_TMO])) break; if (sp > XB_SPIN_CAP) { atomicAdd(&bar[XB_TMO], 1u); break; } }
    }
    nloc = mine > 0u ? mine : 1u; nx = cnt > 0u ? cnt : 1u;
}
__device__ __forceinline__ void xcd_barrier(const XcdBarrier& b) {
    asm volatile("s_waitcnt vmcnt(0)" ::: "memory");
    __syncthreads();
    if (threadIdx.x == 0) {
        unsigned* bar = b.bar;
        __builtin_amdgcn_s_waitcnt(0);
        unsigned nloc = b.st[0], nx = b.st[1];
        if (nloc == 0u) { xcd_barrier_complete(bar, b.x, nloc, nx); b.st[0] = nloc; b.st[1] = nx; }
        const unsigned old = xb_add(&bar[XB_XSUB(b.x)], 1u);
        const unsigned gen = old / nloc;
        if (old + 1u == (gen + 1u) * nloc) {
            __builtin_amdgcn_fence(__ATOMIC_RELEASE, "agent");
            asm volatile("s_waitcnt vmcnt(0)" ::: "memory");
            const unsigned og = xb_add(&bar[XB_TOP], 1u);
            const unsigned tg = og / nx;
            if (og + 1u == (tg + 1u) * nx) xb_add(&bar[XB_TOPGEN], 1u);
            else XB_SPIN(xb_ld(&bar[XB_TOPGEN]) == tg, bar);
            __builtin_amdgcn_fence(__ATOMIC_ACQUIRE, "agent");
            xb_add(&bar[XB_XGEN(b.x)], 1u);
            asm volatile("s_waitcnt vmcnt(0)" ::: "memory");
        } else {
            XB_SPIN(xb_ld(&bar[XB_XGEN(b.x)]) == gen, bar);
            __builtin_amdgcn_fence(__ATOMIC_ACQUIRE, "agent");
            asm volatile("s_waitcnt vmcnt(0)" ::: "memory");
        }
    }
    __syncthreads();
}

__global__ void __launch_bounds__(NTHREADS, 2) fwd_kernel(Params P) {
    extern __shared__ __attribute__((aligned(16))) unsigned char lds_raw[];
    LDSP unsigned char* lds = (LDSP unsigned char*)lds_raw;
    const int G = gridDim.x, bx = blockIdx.x;
    const int vcu = (G % 8 == 0) ? (bx % 8) * (G / 8) + bx / 8 : bx;
    const int lo = P.ph_lo, hi = P.ph_hi;
    volatile LDSP unsigned* bst = (volatile LDSP unsigned*)(lds + LDS_BYTES - 16);
    if (threadIdx.x == 0) { bst[0] = 0u; bst[1] = 0u; bst[2] = 0u; bst[3] = 0u; }
    __syncthreads();
    const XcdBarrier xbar = xcd_barrier_post((unsigned*)(P.ws + 16384), bst);
    if (threadIdx.x == 0) bst[2] = xb_add((unsigned*)(P.ws + 32768) + 64 * xbar.x, 1u);
#define IN(k) (lo <= (k) && (k) < hi)
#define SEAM(k) do { if (IN(k) && IN((k) + 1)) xcd_barrier(xbar); } while (0)
    if (IN(0)) phase_prep(P, lds, vcu, G);
    SEAM(0);
    if (IN(1)) phase_proj(P, lds, vcu, G);
    SEAM(1);
    if (IN(2)) phase_cmp(P, lds, vcu, G);
    SEAM(2);
    if (IN(4)) phase_attn(P, lds, vcu, G);
    SEAM(4);
#if SELFCHECK == 1
    phase_selfcheck(P, lds, vcu, G);
    xcd_barrier(xbar);
#elif SELFCHECK == 2
    phase_selfcheck2(P, lds, vcu, G);
    xcd_barrier(xbar);
#endif
    if (IN(5)) phase_up(P, lds, vcu, G);
    SEAM(5);
    if (IN(6)) phase_out(P, lds, vcu, G);
    SEAM(6);
    if (IN(7)) phase_pq(P, lds, vcu, G);
    SEAM(7);
    if (IN(8)) phase_topk(P, lds, vcu, G);
    SEAM(8);
    if (IN(9)) { phase_peer_a(P, lds, vcu, G); xcd_barrier(xbar); phase_peer_w(P, lds, vcu, G); xcd_barrier(xbar); phase_peer_b(P, lds, vcu, G); }
#if SELFCHECK
    xcd_barrier(xbar);
    if (bx == 0 && threadIdx.x == 0) {
        const unsigned* cnt = (const unsigned*)(P.ws + OFF_CHK);
        P.out[0] += 1000.0f * (float)cnt[0];
        P.out[1] += 1000000.0f * (float)cnt[1];
    }
#endif
#undef IN
#undef SEAM
}

extern "C" void kernel_launch(void* const* d_in, const int* in_sizes, int n_in, void* d_out, int out_size, void* d_ws, size_t ws_size, hipStream_t stream) {
    static int grid = 0;
    if (grid == 0) {
        if (n_in != 29 || ws_size < WS_END) { fprintf(stderr, "kernel_launch: unexpected n_in %d / ws_size %zu\n", n_in, ws_size); grid = -1; return; }
        int dev = 0, cus = 0, per_cu = 0;
        (void)hipGetDevice(&dev);
        (void)hipDeviceGetAttribute(&cus, hipDeviceAttributeMultiprocessorCount, dev);
        (void)hipFuncSetAttribute((const void*)fwd_kernel, hipFuncAttributeMaxDynamicSharedMemorySize, LDS_BYTES);
        (void)hipOccupancyMaxActiveBlocksPerMultiprocessor(&per_cu, (const void*)fwd_kernel, NTHREADS, LDS_BYTES);
        if (per_cu < 1) { fprintf(stderr, "kernel_launch: occupancy query says %d blocks per CU\n", per_cu); grid = -1; return; }
        grid = cus;
    }
    if (grid < 0) return;
    Params p{};
    for (int i = 0; i < 29; ++i) p.in[i] = (const float*)d_in[i];
    p.out = (float*)d_out; p.ws = (unsigned char*)d_ws;
    (void)hipMemsetAsync(d_ws, 0, 65536, stream);
    p.ph_lo = 0; p.ph_hi = 10;
    hipLaunchKernelGGL(fwd_kernel, dim3(grid), dim3(NTHREADS), LDS_BYTES, stream, p);
}
```

```cpp
#include <hip/hip_runtime.h>
#include <hip/hip_cooperative_groups.h>
#include <stdint.h>
#include <stdio.h>
#define SELFCHECK 0
namespace cg = cooperative_groups;

#define LDSP __attribute__((address_space(3)))
typedef unsigned short bf16_t;
typedef short bf16x8 __attribute__((ext_vector_type(8)));
typedef short s16x4 __attribute__((ext_vector_type(4)));
typedef float f32x2 __attribute__((ext_vector_type(2)));
typedef float f32x4 __attribute__((ext_vector_type(4)));
typedef float f32x16 __attribute__((ext_vector_type(16)));
typedef unsigned u32x2 __attribute__((ext_vector_type(2)));
typedef unsigned u32x4 __attribute__((ext_vector_type(4)));
typedef __bf16 bf16x2_t __attribute__((ext_vector_type(2)));

constexpr int BATCH = 8, SEQ = 4096, DM = 1024, T = BATCH * SEQ;
constexpr int HD = 64;
constexpr int NPROJ = 5120;
constexpr int PEER_NE = 16384;
constexpr float NORM_EPS = 1e-6f;
constexpr float QSCALE = 0.125f * 1.4426950408889634f;
constexpr int NTHREADS = 512, NWAVES = 8;
constexpr int LDS_BYTES = 140 * 1024;

constexpr size_t MiB = 1u << 20;
constexpr size_t OFF_RS1 = 1 * MiB;
constexpr size_t OFF_RS2 = 1 * MiB + 256 * 1024;
constexpr size_t OFF_ROPE_C = 2 * MiB;
constexpr size_t OFF_ROPE_S = 2 * MiB + 128 * 1024;
constexpr size_t OFF_POSB = 2 * MiB + 512 * 1024;
constexpr size_t OFF_KMEAN = 3 * MiB;
constexpr size_t OFF_BGATE = 4 * MiB;
constexpr size_t OFF_WIN_T = 8 * MiB;
constexpr size_t OFF_WUPA_T = 19 * MiB;
constexpr size_t OFF_WUPB_T = 20 * MiB;
constexpr size_t OFF_WOUT_T = 21 * MiB;
constexpr size_t OFF_WPQ_T = 23 * MiB;
constexpr size_t OFF_W1K_T = 27 * MiB;
constexpr size_t OFF_W1V_T = 28 * MiB;
constexpr size_t OFF_W2K_T = 29 * MiB;
constexpr size_t OFF_W2V_T = 29 * MiB + 128 * 1024;
constexpr size_t OFF_K1B = 29 * MiB + 256 * 1024;
constexpr size_t OFF_K2B = 29 * MiB + 320 * 1024;
constexpr size_t OFF_KC = 34 * MiB;
constexpr size_t OFF_VC = 35 * MiB;
constexpr size_t OFF_EXPERTS = 36 * MiB;
constexpr size_t OFF_GATES = 52 * MiB;
constexpr size_t OFF_U = 68 * MiB;
constexpr size_t OFF_PSCALE = 30 * MiB;
constexpr size_t OFF_V = 108 * MiB;
constexpr size_t OFF_YA = 36 * MiB;
constexpr size_t OFF_YB = 76 * MiB;
constexpr size_t OFF_R0 = 132 * MiB;
constexpr size_t OFF_R1 = 196 * MiB;
constexpr size_t OFF_R2 = 324 * MiB;
constexpr size_t OFF_WT = OFF_R2;
constexpr size_t OFF_ET = OFF_R2 + 16 * MiB;
constexpr size_t OFF_R3 = 372 * MiB;
constexpr size_t OFF_MERGED = 436 * MiB;
constexpr size_t WS_END = 500 * MiB;

struct Params {
    const float* in[29];
    float* out;
    unsigned char* ws;
    int ph_lo, ph_hi;
};
static_assert(sizeof(Params) == 31 * 8 + 8, "Params has no padding");

enum { I_X = 0, I_NORM1, I_WIN, I_BMERGE, I_AQG, I_AKG, I_BQG, I_BKCG, I_BKSG, I_BKWG,
       I_CPK, I_CKW1, I_CKB1, I_CKW2, I_CKB2, I_CPV, I_CVW1, I_CVB1, I_CVW2, I_CVB2,
       I_WUPA, I_WUPB, I_WOUT, I_NORM2, I_PWQ, I_PK1, I_PK2, I_PU, I_PV };

__device__ __forceinline__ int opaque_tid() { int t = threadIdx.x; asm volatile("" : "+v"(t)); return t; }
__device__ __forceinline__ unsigned pk2(float lo, float hi) {
    f32x2 v = {lo, hi};
    bf16x2_t b = __builtin_convertvector(v, bf16x2_t);
    return __builtin_bit_cast(unsigned, b);
}
__device__ __forceinline__ float bf2f(bf16_t b) { return __uint_as_float(((unsigned)b) << 16); }
__device__ __forceinline__ float bf_lo(unsigned w) { return __uint_as_float(w << 16); }
__device__ __forceinline__ float bf_hi(unsigned w) { return __uint_as_float(w & 0xffff0000u); }
__device__ __forceinline__ float wave_sum(float v) {
#pragma unroll
    for (int o = 1; o < 64; o <<= 1) v += __shfl_xor(v, o);
    return v;
}
__device__ __forceinline__ float sum_xor16(float v) { const auto r = __builtin_amdgcn_permlane16_swap(__float_as_uint(v), __float_as_uint(v), false, false); return __uint_as_float(r[0]) + __uint_as_float(r[1]); }
__device__ __forceinline__ float sum_xor32(float v) { const auto r = __builtin_amdgcn_permlane32_swap(__float_as_uint(v), __float_as_uint(v), false, false); return __uint_as_float(r[0]) + __uint_as_float(r[1]); }
__device__ __forceinline__ float get_xor16(float v, bool odd_row) { const auto r = __builtin_amdgcn_permlane16_swap(__float_as_uint(v), __float_as_uint(v), false, false); return __uint_as_float(odd_row ? r[0] : r[1]); }
__device__ __forceinline__ float gelu_tanh(float x) {
    const float u = 0.7978845608028654f * (x + 0.044715f * x * x * x);
    return x * __builtin_amdgcn_rcpf(1.0f + __expf(-2.0f * u));
}
__device__ __forceinline__ float sigmoidf_(float x) { return __builtin_amdgcn_rcpf(1.0f + __expf(-x)); }
__device__ __forceinline__ void cvt8(const u32x4 w, float (&f)[8]) {
    f[0] = __uint_as_float(w.x << 16); f[1] = __uint_as_float(w.x & 0xffff0000u); f[2] = __uint_as_float(w.y << 16); f[3] = __uint_as_float(w.y & 0xffff0000u);
    f[4] = __uint_as_float(w.z << 16); f[5] = __uint_as_float(w.z & 0xffff0000u); f[6] = __uint_as_float(w.w << 16); f[7] = __uint_as_float(w.w & 0xffff0000u);
}
__device__ __forceinline__ int swz_off(int row, int chunk) { return row * 128 + ((chunk ^ ((row >> 1) & 7)) << 4); }

__device__ __forceinline__ void transpose_item(const float* W, int ldw, int k0, int src_c0, int nvalid, const float* kscale,
                                               bf16_t* WT, int ldwt, int n0, LDSP float* scr, int lane) {
    const int ch = lane & 7, r0 = lane >> 3;
    f32x4 v[8]; float ks[8];
    const bool ok = 4 * ch < nvalid;
    const int coff = ok ? src_c0 + 4 * ch : 0;
#pragma unroll
    for (int i = 0; i < 8; ++i) v[i] = __builtin_nontemporal_load((const f32x4*)(W + (size_t)(k0 + r0 + 8 * i) * ldw + coff));
#pragma unroll
    for (int i = 0; i < 8; ++i) ks[i] = kscale ? kscale[k0 + r0 + 8 * i] : 1.0f;
#pragma unroll
    for (int i = 0; i < 8; ++i) {
        LDSP float* d = scr + (r0 + 8 * i) * 33 + 4 * ch;
        const float kz = ok ? ks[i] : 0.f;
        d[0] = v[i].x * kz; d[1] = v[i].y * kz; d[2] = v[i].z * kz; d[3] = v[i].w * kz;
    }
    asm volatile("s_waitcnt lgkmcnt(0)" ::: "memory");
    const int c = lane & 7;
#pragma unroll
    for (int j = 0; j < 4; ++j) {
        const int n = (lane >> 3) + 8 * j;
        const LDSP float* s = scr + (8 * c) * 33 + n;
        u32x4 o;
        o.x = pk2(s[0 * 33], s[1 * 33]); o.y = pk2(s[2 * 33], s[3 * 33]); o.z = pk2(s[4 * 33], s[5 * 33]); o.w = pk2(s[6 * 33], s[7 * 33]);
        *(u32x4*)(WT + (size_t)(n0 + n) * ldwt + k0 + 8 * c) = o;
    }
    asm volatile("s_waitcnt lgkmcnt(0)" ::: "memory");
}

struct TrJob { const float* W; int K, N, ldw; const float* kscale; bf16_t* WT; int kind; };

__device__ __forceinline__ void run_tr_job(const TrJob& J, int item, LDSP float* scr, int lane) {
    const int nblk = J.N / 32, kb = item / nblk, nb = item % nblk;
    int src_c0 = nb * 32, nvalid = 32;
    if (J.kind == 1) {
        const int p0 = nb * 32, pn = p0 >> 8, q = p0 & 255, bj = q >> 7, wc = (q >> 5) & 3, H = 4 * pn + wc, d0 = 32 * bj;
        if (H < 44) src_c0 = 64 * H + d0;
        else if (H < 76) src_c0 = 64 * H + d0 + 24;
        else if (H == 76 && bj == 0) { src_c0 = 2816; nvalid = 24; }
        else { src_c0 = 0; nvalid = 0; }
    } else if (J.kind == 2) {
        if (nb * 32 >= 64) { src_c0 = 0; nvalid = 0; }
    }
    transpose_item(J.W, J.ldw, kb * 64, src_c0, nvalid, J.kscale, J.WT, J.K, nb * 32, scr, lane);
}

__device__ __forceinline__ void phase_prep(const Params& P, LDSP unsigned char* lds, int vcu, int G) {
    const int tid = opaque_tid(), lane = tid & 63, wave = tid >> 6;
    const int gw = vcu * NWAVES + wave, NGW = G * NWAVES;
    unsigned char* ws = P.ws;
    LDSP float* scr = (LDSP float*)(lds + wave * 8704);
    int base = 0;
    const int gd = wave * G + vcu;
#define TR_JOB(Wp, Kk, Nn, LDW, KS, WTp, KIND) do { TrJob J{Wp, Kk, Nn, LDW, KS, WTp, KIND}; const int nitems = ((Kk) / 64) * ((Nn) / 32); \
        const int first = (gd - base % NGW + NGW) % NGW; for (int it = first; it < nitems; it += NGW) run_tr_job(J, it, scr, lane); base += nitems; } while (0)
    TR_JOB(P.in[I_WIN], 1024, NPROJ, 4888, P.in[I_NORM1], (bf16_t*)(ws + OFF_WIN_T), 1);
    TR_JOB(P.in[I_WUPA], 512, 1024, 1024, nullptr, (bf16_t*)(ws + OFF_WUPA_T), 0);
    TR_JOB(P.in[I_WUPB], 512, 1024, 1024, nullptr, (bf16_t*)(ws + OFF_WUPB_T), 0);
    TR_JOB(P.in[I_WOUT], 1024, 1024, 1024, nullptr, (bf16_t*)(ws + OFF_WOUT_T), 0);
    TR_JOB(P.in[I_PWQ], 1024, 2048, 2048, P.in[I_NORM2], (bf16_t*)(ws + OFF_WPQ_T), 0);
    TR_JOB(P.in[I_CKW1], 2048, 256, 256, nullptr, (bf16_t*)(ws + OFF_W1K_T), 0);
    TR_JOB(P.in[I_CVW1], 2048, 256, 256, nullptr, (bf16_t*)(ws + OFF_W1V_T), 0);
    TR_JOB(P.in[I_CKW2], 256, 128, 64, nullptr, (bf16_t*)(ws + OFF_W2K_T), 2);
    TR_JOB(P.in[I_CVW2], 256, 128, 64, nullptr, (bf16_t*)(ws + OFF_W2V_T), 2);
#undef TR_JOB
    {
        const float* x = P.in[I_X];
        bf16_t* xb = (bf16_t*)(ws + OFF_R0);
        float* rs1 = (float*)(ws + OFF_RS1);
#pragma unroll 4
        for (int m = gw; m < T; m += NGW) {
            const f32x4* xr = (const f32x4*)(x + (size_t)m * DM) + lane;
            f32x4 v[4]; float s = 0.f;
#pragma unroll
            for (int j = 0; j < 4; ++j) { v[j] = __builtin_nontemporal_load(xr + 64 * j); s += (v[j].x * v[j].x + v[j].y * v[j].y) + (v[j].z * v[j].z + v[j].w * v[j].w); }
            s = wave_sum(s);
            if (lane == 0) rs1[m] = 1.0f / sqrtf(s * (1.0f / DM) + NORM_EPS);
            u32x2* o = (u32x2*)(xb + (size_t)m * DM) + lane;
#pragma unroll
            for (int j = 0; j < 4; ++j) { u32x2 w; w.x = pk2(v[j].x, v[j].y); w.y = pk2(v[j].z, v[j].w); o[64 * j] = w; }
        }
    }
    {
        const float* g2 = P.in[I_NORM2];
        f32x4 g4[4];
#pragma unroll
        for (int q = 0; q < 4; ++q) g4[q] = *(const f32x4*)(g2 + 256 * q + 4 * lane);
        float* scales = (float*)(ws + OFF_PSCALE);
#pragma unroll 4
        for (int r = gw; r < 2 * PEER_NE; r += NGW) {
            const int which = (r >= PEER_NE) ? 1 : 0, e = r & (PEER_NE - 1);
            const float* src = P.in[which ? I_PV : I_PU] + (size_t)e * DM + 4 * lane;
            f32x4 a[4]; float ss = 0.f;
#pragma unroll
            for (int q = 0; q < 4; ++q) { a[q] = __builtin_nontemporal_load((const f32x4*)(src + 256 * q)); if (!which) a[q] = a[q] * g4[q];
                ss += (a[q].x * a[q].x + a[q].y * a[q].y) + (a[q].z * a[q].z + a[q].w * a[q].w); }
            ss = wave_sum(ss);
            const float rms = sqrtf(ss * (1.0f / DM));
            if (which) {
                const float sc = (rms > 0.f) ? 0.5f * rms : 1.0f, inv = 1.0f / sc;
                unsigned char* dst = ws + OFF_V + (size_t)e * 128 + 2 * lane;
#pragma unroll
                for (int q = 0; q < 4; ++q) {
                    unsigned pq = 0;
                    pq = __builtin_amdgcn_cvt_scalef32_pk_fp4_f32(pq, a[q].x * inv, a[q].y * inv, 1.0f, 0);
                    pq = __builtin_amdgcn_cvt_scalef32_pk_fp4_f32(pq, a[q].z * inv, a[q].w * inv, 1.0f, 1);
                    *(unsigned short*)(dst + (size_t)q * PEER_NE * 128) = (unsigned short)pq;
                }
                if (lane == 0) scales[2 * e + which] = sc;
            } else {
                const float sc = (rms > 0.f) ? rms * (2.5f / 7.0f) : 1.0f, inv = 1.0f / sc;
                const int b8 = 8 * (lane & 1);
#pragma unroll
                for (int q = 0; q < 4; ++q) {
                    const int n0 = (int)fminf(fmaxf(rintf(a[q].x * inv), -7.f), 7.f) & 15, n1 = (int)fminf(fmaxf(rintf(a[q].y * inv), -7.f), 7.f) & 15;
                    const int n2 = (int)fminf(fmaxf(rintf(a[q].z * inv), -7.f), 7.f) & 15, n3 = (int)fminf(fmaxf(rintf(a[q].w * inv), -7.f), 7.f) & 15;
                    const unsigned part = ((unsigned)n0 << b8) | ((unsigned)n2 << (b8 + 4)) | ((unsigned)n1 << (b8 + 16)) | ((unsigned)n3 << (b8 + 20));
                    const unsigned full = part | (unsigned)__shfl_xor((int)part, 1);
                    if (!(lane & 1)) *(unsigned*)(ws + OFF_U + ((size_t)q * PEER_NE + e) * 128 + 4 * (lane >> 1)) = full;
                }
                if (lane == 0) scales[2 * e + which] = sc;
            }
        }
    }
    {
        const int gt = gw * 64 + lane, NGT = NGW * 64;
        for (int i = gt; i < 2 * 128 * 128; i += NGT) {
            const int w = i >> 14, e = i & 16383;
            const float v = P.in[w ? I_PK2 : I_PK1][e];
            ((bf16_t*)(ws + (w ? OFF_K2B : OFF_K1B)))[e] = (bf16_t)(pk2(v, 0.f) & 0xffff);
        }
        if (gt < 8) ((float*)(ws + OFF_ROPE_C))[gt] = powf(500000.0f, -(float)(2 * gt) / 16.0f) * 0.15915494309189535f;
        for (int i = gt; i < T; i += NGT) ((float*)(ws + OFF_RS2))[i] = 0.f;
        for (int i = gt; i < 8 * 8 * 16 * 64; i += NGT) ((float*)(ws + OFF_KMEAN))[i] = 0.f;
        if (gt < 2) ((unsigned*)(ws + 512 * 1024))[gt] = 0u;
        for (int it = 0; it < 128; ++it) {
            if ((NGW == 2048 ? 1056 + 7 * it : (it * 16 + 5) % NGW) != gd) continue;
            const int w = it >> 6, j4 = (it & 63) * 4;
            const float* pos = P.in[w ? I_CPV : I_CPK] + lane;
            const float* w1 = P.in[w ? I_CVW1 : I_CKW1] + (size_t)lane * 256 + j4;
            f32x4 rowv[32]; float pv[32];
#pragma unroll
            for (int k = 0; k < 32; ++k) { rowv[k] = *(const f32x4*)(w1 + (size_t)k * 64 * 256); pv[k] = pos[64 * k]; }
            f32x4 s4 = {0.f, 0.f, 0.f, 0.f};
#pragma unroll
            for (int k = 0; k < 32; ++k) s4 += rowv[k] * pv[k];
            s4.x = wave_sum(s4.x); s4.y = wave_sum(s4.y); s4.z = wave_sum(s4.z); s4.w = wave_sum(s4.w);
            if (lane == 0) *(f32x4*)((float*)(ws + OFF_POSB) + w * 256 + j4) = s4 + *(const f32x4*)(P.in[w ? I_CVB1 : I_CKB1] + j4);
        }
    }
}

constexpr int G_BM = 256, G_BN = 128, G_BK = 64;
constexpr int G_ABYTES = G_BM * 128, G_BBYTES = G_BN * 128, G_STAGE = G_ABYTES + G_BBYTES;

__device__ __forceinline__ void gemm_kloop(f32x4 (&acc)[4][4], const bf16_t* A, size_t lda, const bf16_t* Bt, size_t ldb, int K, LDSP unsigned char* lds) {
    const int tid = opaque_tid(), lane = tid & 63, wid = tid >> 6, wm = wid >> 1, wn = wid & 1, fr = lane & 15, fq = lane >> 4;
    const int lrow = tid >> 3, lch = tid & 7;
    const bf16_t* ga = A + (size_t)lrow * lda + lch * 8;
    const bf16_t* gb = Bt + (size_t)lrow * ldb + lch * 8;
    u32x4 ra[4], rb[2];
    const int nk = K / G_BK;
#pragma unroll
    for (int p = 0; p < 4; ++p) ra[p] = *(const u32x4*)(ga + (size_t)(64 * p) * lda);
#pragma unroll
    for (int p = 0; p < 2; ++p) rb[p] = *(const u32x4*)(gb + (size_t)(64 * p) * ldb);
    __syncthreads();
#pragma unroll
    for (int p = 0; p < 4; ++p) *(LDSP u32x4*)(lds + swz_off(lrow + 64 * p, lch)) = ra[p];
#pragma unroll
    for (int p = 0; p < 2; ++p) *(LDSP u32x4*)(lds + G_ABYTES + swz_off(lrow + 64 * p, lch)) = rb[p];
    __syncthreads();
    for (int kt = 0; kt < nk; ++kt) {
        LDSP unsigned char* cur = lds + (kt & 1) * G_STAGE;
        LDSP unsigned char* nxt = lds + ((kt + 1) & 1) * G_STAGE;
        if (kt + 1 < nk) {
#pragma unroll
            for (int p = 0; p < 4; ++p) ra[p] = *(const u32x4*)(ga + (size_t)(64 * p) * lda + (kt + 1) * G_BK);
#pragma unroll
            for (int p = 0; p < 2; ++p) rb[p] = *(const u32x4*)(gb + (size_t)(64 * p) * ldb + (kt + 1) * G_BK);
        }
#pragma unroll
        for (int ks = 0; ks < 2; ++ks) {
            bf16x8 af[4], bfr[4];
#pragma unroll
            for (int m = 0; m < 4; ++m) af[m] = *(const LDSP bf16x8*)(cur + swz_off(wm * 64 + m * 16 + fr, ks * 4 + fq));
#pragma unroll
            for (int n = 0; n < 4; ++n) bfr[n] = *(const LDSP bf16x8*)(cur + G_ABYTES + swz_off(wn * 64 + n * 16 + fr, ks * 4 + fq));
#pragma unroll
            for (int m = 0; m < 4; ++m)
#pragma unroll
                for (int n = 0; n < 4; ++n) acc[m][n] = __builtin_amdgcn_mfma_f32_16x16x32_bf16(bfr[n], af[m], acc[m][n], 0, 0, 0);
        }
        if (kt + 1 < nk) {
#pragma unroll
            for (int p = 0; p < 4; ++p) *(LDSP u32x4*)(nxt + swz_off(lrow + 64 * p, lch)) = ra[p];
#pragma unroll
            for (int p = 0; p < 2; ++p) *(LDSP u32x4*)(nxt + G_ABYTES + swz_off(lrow + 64 * p, lch)) = rb[p];
        }
        __syncthreads();
    }
}

__device__ __forceinline__ void zero_acc(f32x4 (&acc)[4][4]) {
#pragma unroll
    for (int m = 0; m < 4; ++m)
#pragma unroll
        for (int n = 0; n < 4; ++n) acc[m][n] = (f32x4){0.f, 0.f, 0.f, 0.f};
}

__device__ __forceinline__ bool tile_order(int it, int vcu, int G, int nM, int nN, int& tm, int& tn) {
    if (G == 256 && (nM % 32) == 0) {
        const int xcd = vcu >> 5, cu = vcu & 31, mper = nM / 8;
        const int L = it * 32 + cu, per_group = 4 * nN;
        if (L >= mper * nN) return false;
        const int mg = L / per_group, rem = L % per_group;
        tm = xcd * mper + mg * 4 + (rem & 3); tn = rem >> 2;
        return true;
    }
    const int L = it * G + vcu;
    if (L >= nM * nN) return false;
    tm = L / nN; tn = L % nN;
    return true;
}

namespace pg8 {
constexpr int BM = 256, BK = 64, HALF = 128, HTB = HALF * BK * 2, NXCD = 8, WGM = 8;
__device__ __forceinline__ int lds_byte(int r, int c) { const int st = (r >> 4) * 2 + (c >> 5), rr = r & 15, cc = c & 31, ob = rr * 64 + cc * 2; return st * 1024 + (ob ^ (((ob >> 9) & 1) << 5)); }
__device__ __forceinline__ void stage_rc(int b, int& R, int& C) { const int st = b / 1024, sb = b % 1024, swz = sb ^ (((sb >> 9) & 1) << 5); R = (st >> 1) * 16 + swz / 64; C = (st & 1) * 32 + (swz % 64) / 2; }
__device__ __forceinline__ int perm32(int rho) { const int n = rho >> 4, i = rho & 15; return 8 * (i >> 2) + 4 * n + (i & 3); }
struct Unit { int pm, pn, z; };
__device__ __forceinline__ bool tile_of(int L, int nM, int nN, int& pm, int& pn) {
    const int nwg = nM * nN; if (L >= nwg) return false;
    int wgid = L; { const int q = nwg / NXCD, r = nwg % NXCD, xcd = wgid % NXCD, off = wgid / NXCD; wgid = (xcd < r ? xcd * (q + 1) : r * (q + 1) + (xcd - r) * q) + off; }
    const int nig = WGM * nN, gid = wgid / nig, fm = gid * WGM, gsz = (nM - fm) < WGM ? (nM - fm) : WGM;
    pm = fm + ((wgid % nig) % gsz); pn = (wgid % nig) / gsz; return true;
}
struct Sched {
    const bf16_t *A0, *A1, *B0, *B1; size_t lda, ldb; int K, nM, nN, NZ, G, c;
    __device__ __forceinline__ bool next(int i, Unit& u) const { u.z = (NZ == 2) ? (i & 1) : 0; const int ti = (NZ == 2) ? (i >> 1) : i; return tile_of(ti * G + c, nM, nN, u.pm, u.pn); }
    __device__ __forceinline__ const char* aptr(const Unit& u) const { return (const char*)((u.z ? A1 : A0) + (size_t)u.pm * BM * lda); }
    __device__ __forceinline__ const char* bptr(const Unit& u) const { return (const char*)((u.z ? B1 : B0) + (size_t)u.pn * BM * ldb); }
};
template <class Epi>
__device__ __forceinline__ void gemm_phase(LDSP unsigned char* lds, const Sched& S, const Epi& E) {
    const int tid = opaque_tid(), wid = __builtin_amdgcn_readfirstlane(tid >> 6), lane = tid & 63, wr = wid >> 2, wc = wid & 3, fr = lane & 15, fq = lane >> 4;
    const int nt = S.K / BK;
    unsigned voffA[2], voffB[2];
#pragma unroll
    for (int i = 0; i < 2; ++i) { int R, C; stage_rc(tid * 16 + i * 8192, R, C); const int Rb = (R & ~31) + perm32(R & 31);
        voffA[i] = (unsigned)(R * S.lda + C) * 2u; voffB[i] = (unsigned)(Rb * S.ldb + C) * 2u; }
    const size_t kstep = (size_t)(BK * 2);
    const size_t hstepA = (size_t)HALF * S.lda * 2, hstepB = (size_t)HALF * S.ldb * 2;
    const unsigned ldsw = (unsigned)wid * 1024u;
    const int aoff = lds_byte(wr * 64 + fr, fq * 8), boff = lds_byte(wc * 32 + fr, fq * 8);
#define PG8_SA(b, h) (((b) * 2 + (h)) * HTB)
#define PG8_SB(b, h) ((4 + (b) * 2 + (h)) * HTB)
#define PG8_STAGE(bufoff, gbase, voff) do { _Pragma("unroll") for (int _i = 0; _i < 2; ++_i) \
        __builtin_amdgcn_global_load_lds((const unsigned*)((const char*)(gbase) + (voff)[_i]), (LDSP unsigned*)(lds + (bufoff) + ldsw + _i * 8192), 16, 0, 0); } while (0)
#define PG8_LDA(dst, b, h) do { _Pragma("unroll") for (int m = 0; m < 4; ++m) _Pragma("unroll") for (int k = 0; k < 2; ++k) dst[m][k] = *(const LDSP bf16x8*)(lds + PG8_SA(b, h) + aoff + m * 2048 + k * 1024); } while (0)
#define PG8_LDB(dst, b, h) do { _Pragma("unroll") for (int n = 0; n < 2; ++n) _Pragma("unroll") for (int k = 0; k < 2; ++k) dst[n][k] = *(const LDSP bf16x8*)(lds + PG8_SB(b, h) + boff + n * 2048 + k * 1024); } while (0)
#define PG8_MMA(ai, bj, At, Bt) do { __builtin_amdgcn_s_setprio(1); _Pragma("unroll") for (int m = 0; m < 4; ++m) _Pragma("unroll") for (int n = 0; n < 2; ++n) _Pragma("unroll") for (int k = 0; k < 2; ++k) \
        acc[ai][bj][m][n] = __builtin_amdgcn_mfma_f32_16x16x32_bf16(Bt[n][k], At[m][k], acc[ai][bj][m][n], 0, 0, 0); __builtin_amdgcn_s_setprio(0); } while (0)
#define PG8_WAIT_V(n) asm volatile("s_waitcnt vmcnt(" #n ")" ::: "memory")
#define PG8_WAIT_L(n) asm volatile("s_waitcnt lgkmcnt(" #n ")" ::: "memory")
#define PG8_BAR __builtin_amdgcn_s_barrier()
#define PG8_SCHED __builtin_amdgcn_sched_barrier(0)
    Unit cur, nxt; int ui = 0;
    if (!S.next(0, cur)) return;
    f32x4 acc[2][2][4][2];
#pragma unroll
    for (int a = 0; a < 2; ++a)
#pragma unroll
        for (int b = 0; b < 2; ++b)
#pragma unroll
            for (int m = 0; m < 4; ++m)
#pragma unroll
                for (int n = 0; n < 2; ++n) acc[a][b][m][n] = (f32x4){0.f, 0.f, 0.f, 0.f};
    bf16x8 At[4][2], B0[2][2], B1[2][2];
    const char* cA = S.aptr(cur); const char* cB = S.bptr(cur);
    PG8_STAGE(PG8_SB(0, 0), cB, voffB); PG8_STAGE(PG8_SB(0, 1), cB + hstepB, voffB); PG8_STAGE(PG8_SA(0, 0), cA, voffA); PG8_STAGE(PG8_SA(0, 1), cA + hstepA, voffA);
    if (wr == 1) PG8_BAR;
    PG8_WAIT_V(2); PG8_BAR;
    PG8_STAGE(PG8_SB(1, 0), cB + kstep, voffB); PG8_STAGE(PG8_SA(1, 0), cA + kstep, voffA); PG8_STAGE(PG8_SB(1, 1), cB + hstepB + kstep, voffB);
    PG8_WAIT_V(6); PG8_BAR;
    for (;;) {
        const bool has_next = S.next(ui + 1, nxt);
        const char* nA = has_next ? S.aptr(nxt) : cA; const char* nB = has_next ? S.bptr(nxt) : cB;
        for (int t = 0; t < nt; t += 2) {
            const bool last = (t == nt - 2);
            const char* a1 = cA + (size_t)(t + 1) * kstep;
            const char* a2 = last ? nA : cA + (size_t)(t + 2) * kstep; const char* b2 = last ? nB : cB + (size_t)(t + 2) * kstep;
            const char* a3 = a2 + kstep; const char* b3 = b2 + kstep;
            PG8_LDB(B0, 0, 0); PG8_LDB(B1, 0, 1); PG8_SCHED; PG8_LDA(At, 0, 0); PG8_STAGE(PG8_SA(1, 1), a1 + hstepA, voffA);
            PG8_WAIT_V(8); PG8_WAIT_L(0); PG8_BAR; PG8_MMA(0, 0, At, B0); PG8_MMA(0, 1, At, B1); PG8_BAR; PG8_SCHED;
            PG8_LDA(At, 0, 1); PG8_STAGE(PG8_SB(0, 0), b2, voffB); PG8_STAGE(PG8_SB(0, 1), b2 + hstepB, voffB); PG8_STAGE(PG8_SA(0, 0), a2, voffA);
            PG8_WAIT_V(8); PG8_WAIT_L(0); PG8_BAR; PG8_MMA(1, 0, At, B0); PG8_MMA(1, 1, At, B1); PG8_BAR; PG8_SCHED;
            PG8_LDB(B0, 1, 0); PG8_LDB(B1, 1, 1); PG8_SCHED; PG8_LDA(At, 1, 0); PG8_STAGE(PG8_SA(0, 1), a2 + hstepA, voffA);
            PG8_WAIT_V(8); PG8_WAIT_L(0); PG8_BAR; PG8_MMA(0, 0, At, B0); PG8_MMA(0, 1, At, B1); PG8_BAR; PG8_SCHED;
            PG8_LDA(At, 1, 1); PG8_STAGE(PG8_SB(1, 0), b3, voffB); PG8_STAGE(PG8_SB(1, 1), b3 + hstepB, voffB); PG8_STAGE(PG8_SA(1, 0), a3, voffA);
            PG8_WAIT_V(8); PG8_WAIT_L(0); PG8_BAR; PG8_MMA(1, 0, At, B0); PG8_MMA(1, 1, At, B1); PG8_BAR; PG8_SCHED;
        }
        if (wr == 0) PG8_BAR;
        E(acc, cur, wr, wc, fr, fq);
        if (!has_next) break;
#pragma unroll
        for (int a = 0; a < 2; ++a)
#pragma unroll
            for (int b = 0; b < 2; ++b)
#pragma unroll
                for (int m = 0; m < 4; ++m)
#pragma unroll
                    for (int n = 0; n < 2; ++n) acc[a][b][m][n] = (f32x4){0.f, 0.f, 0.f, 0.f};
        cur = nxt; cA = nA; cB = nB; ++ui;
        if (wr == 1) PG8_BAR;
    }
    PG8_WAIT_V(0);
    PG8_BAR;
#undef PG8_SA
#undef PG8_SB
#undef PG8_STAGE
#undef PG8_LDA
#undef PG8_LDB
#undef PG8_MMA
#undef PG8_WAIT_V
#undef PG8_WAIT_L
#undef PG8_BAR
#undef PG8_SCHED
}
}

struct EpiProj {
    const Params* P;
    __device__ __forceinline__ void operator()(f32x4 (&acc)[2][2][4][2], const pg8::Unit& u, int wr, int wc, int fr, int fq) const {
        unsigned char* ws = P->ws;
        const int H = 4 * u.pn + wc;
        if (H > 76) return;
        const float* rs1 = (const float*)(ws + OFF_RS1);
        int kind; bf16_t* dst = nullptr; int pitch = 0, cb = 0; const float* gain = nullptr; float oscale = 1.f; bool slab = false; int sg = 0;
        if (H < 8)        { kind = 1; dst = (bf16_t*)(ws + OFF_R1);            pitch = 512; cb = H * 64;        gain = P->in[I_AQG]; oscale = QSCALE; }
        else if (H < 16)  { kind = 1; dst = (bf16_t*)(ws + OFF_R1 + 32 * MiB); pitch = 512; cb = (H - 8) * 64;  gain = P->in[I_AKG]; }
        else if (H < 24)  { kind = 0; dst = (bf16_t*)(ws + OFF_R1 + 64 * MiB); pitch = 512; cb = (H - 16) * 64; }
        else if (H < 32)  { kind = 1; dst = (bf16_t*)(ws + OFF_R1 + 96 * MiB); pitch = 512; cb = (H - 24) * 64; gain = P->in[I_BQG]; oscale = QSCALE; }
        else if (H < 34)  { kind = 0; dst = (bf16_t*)(ws + OFF_R2);            slab = true; sg = H - 32; }
        else if (H < 36)  { kind = 0; dst = (bf16_t*)(ws + OFF_R2 + 8 * MiB);  slab = true; sg = H - 34; }
        else if (H < 38)  { kind = 1; dst = (bf16_t*)(ws + OFF_R2 + 16 * MiB); pitch = 128; cb = (H - 36) * 64; gain = P->in[I_BKSG]; }
        else if (H < 40)  { kind = 0; dst = (bf16_t*)(ws + OFF_R2 + 24 * MiB); pitch = 128; cb = (H - 38) * 64; }
        else if (H < 42)  { kind = 1; dst = (bf16_t*)(ws + OFF_R2 + 32 * MiB); pitch = 128; cb = (H - 40) * 64; gain = P->in[I_BKWG]; }
        else if (H < 44)  { kind = 0; dst = (bf16_t*)(ws + OFF_R2 + 40 * MiB); pitch = 128; cb = (H - 42) * 64; }
        else if (H < 76)  { kind = 2; dst = (bf16_t*)(ws + OFF_R3);            pitch = 2048; cb = (H - 44) * 64; }
        else              { kind = 3; }
        f32x4 invrev[2] = {{0.f, 0.f, 0.f, 0.f}, {0.f, 0.f, 0.f, 0.f}};
        if (kind == 1) { invrev[0] = *(const f32x4*)((const float*)(ws + OFF_ROPE_C)); invrev[1] = *(const f32x4*)((const float*)(ws + OFF_ROPE_C) + 4); }
        float rsr[2][4];
#pragma unroll
        for (int ai = 0; ai < 2; ++ai)
#pragma unroll
            for (int m = 0; m < 4; ++m) rsr[ai][m] = rs1[u.pm * 256 + ai * 128 + wr * 64 + m * 16 + fr];
        f32x4 gv[2][2];
        if (kind == 1 || kind == 2) {
            const float* gp = (kind == 1) ? gain : P->in[I_BMERGE] + cb;
#pragma unroll
            for (int bj = 0; bj < 2; ++bj)
#pragma unroll
                for (int n = 0; n < 2; ++n) gv[bj][n] = *(const f32x4*)(gp + 32 * bj + 8 * fq + 4 * n);
            if (kind == 2) {
#pragma unroll
                for (int bj = 0; bj < 2; ++bj)
#pragma unroll
                    for (int n = 0; n < 2; ++n) gv[bj][n] = gv[bj][n] * (-1.4426950408889634f);
            }
        }
        const bool ksum = (H >= 8 && H < 16);
        f32x4 cs[2][2];
#pragma unroll
        for (int bj = 0; bj < 2; ++bj)
#pragma unroll
            for (int n = 0; n < 2; ++n) cs[bj][n] = (f32x4){0.f, 0.f, 0.f, 0.f};
#pragma unroll
        for (int ai = 0; ai < 2; ++ai)
#pragma unroll
            for (int m = 0; m < 4; ++m) {
                const int row = u.pm * 256 + ai * 128 + wr * 64 + m * 16 + fr;
                const float rs = rsr[ai][m];
                f32x4 v[2][2];
                if (kind == 1) {
                    float ss = 0.f;
#pragma unroll
                    for (int bj = 0; bj < 2; ++bj)
#pragma unroll
                        for (int n = 0; n < 2; ++n) { const f32x4 a_ = acc[ai][bj][m][n]; ss += (a_[0] * a_[0] + a_[1] * a_[1]) + (a_[2] * a_[2] + a_[3] * a_[3]); }
                    ss = sum_xor16(ss); ss = sum_xor32(ss);
                    const float r = rs * oscale * __builtin_amdgcn_rsqf(ss * (rs * rs * (1.0f / 64.0f)) + NORM_EPS);
#pragma unroll
                    for (int bj = 0; bj < 2; ++bj)
#pragma unroll
                        for (int n = 0; n < 2; ++n) v[bj][n] = (acc[ai][bj][m][n] * r) * gv[bj][n];
                    const float posf = (fq == 0) ? -(float)(row & (SEQ - 1)) : (float)(row & (SEQ - 1));
#pragma unroll
                    for (int n = 0; n < 2; ++n) {
                        const f32x4 me = v[0][n]; f32x4 ot, ro;
#pragma unroll
                        for (int i = 0; i < 4; ++i) ot[i] = get_xor16(me[i], fq & 1);
#pragma unroll
                        for (int i = 0; i < 4; ++i) { const float rev = __builtin_amdgcn_fractf(posf * invrev[n][i]); ro[i] = me[i] * __builtin_amdgcn_cosf(rev) + ot[i] * __builtin_amdgcn_sinf(rev); }
                        if (fq < 2) v[0][n] = ro;
                    }
                    if (ksum) {
#pragma unroll
                        for (int bj = 0; bj < 2; ++bj)
#pragma unroll
                            for (int n = 0; n < 2; ++n) cs[bj][n] += v[bj][n];
                    }
                } else if (kind == 2) {
                    const float rsn = rs * (-1.4426950408889634f);
#pragma unroll
                    for (int bj = 0; bj < 2; ++bj)
#pragma unroll
                        for (int n = 0; n < 2; ++n)
#pragma unroll
                            for (int i = 0; i < 4; ++i) v[bj][n][i] = __builtin_amdgcn_rcpf(__builtin_fmaf(__builtin_amdgcn_exp2f(__builtin_fmaf(acc[ai][bj][m][n][i], rsn, gv[bj][n][i])), 1.0f / 255.0f, 1.0f / 255.0f));
                } else {
#pragma unroll
                    for (int bj = 0; bj < 2; ++bj)
#pragma unroll
                        for (int n = 0; n < 2; ++n) v[bj][n] = acc[ai][bj][m][n] * rs;
                }
                if (kind == 3) {
                    float* bg = (float*)(ws + OFF_BGATE) + (size_t)row * 24;
                    if (fq < 3) {
#pragma unroll
                        for (int n = 0; n < 2; ++n) { f32x4 o; o.x = sigmoidf_(v[0][n][0]); o.y = sigmoidf_(v[0][n][1]); o.z = sigmoidf_(v[0][n][2]); o.w = sigmoidf_(v[0][n][3]); *(f32x4*)(bg + 8 * fq + 4 * n) = o; }
                    }
                } else if (kind == 2) {
                    unsigned char* rp8 = ws + OFF_R3 + (size_t)row * 2048 + cb + 8 * fq;
#pragma unroll
                    for (int bj = 0; bj < 2; ++bj) {
                        u32x2 w;
#pragma unroll
                        for (int n = 0; n < 2; ++n) {
                            const unsigned b0 = __float_as_uint(v[bj][n][0] + 8388608.0f), b1 = __float_as_uint(v[bj][n][1] + 8388608.0f);
                            const unsigned b2 = __float_as_uint(v[bj][n][2] + 8388608.0f), b3 = __float_as_uint(v[bj][n][3] + 8388608.0f);
                            const unsigned p01 = __builtin_amdgcn_perm(b1, b0, 0x0c0c0400u), p23 = __builtin_amdgcn_perm(b3, b2, 0x0c0c0400u);
                            w[n] = __builtin_amdgcn_perm(p23, p01, 0x05040100u);
                        }
                        __builtin_nontemporal_store(w, (u32x2*)(rp8 + 32 * bj));
                    }
                } else {
                    bf16_t* rp;
                    if (slab) { const int b = row >> 12, s = row & (SEQ - 1); rp = dst + ((size_t)((b * 2 + sg) * SEQ + s)) * 64 + 8 * fq; }
                    else rp = dst + (size_t)row * pitch + cb + 8 * fq;
#pragma unroll
                    for (int bj = 0; bj < 2; ++bj) {
                        u32x4 w; w.x = pk2(v[bj][0][0], v[bj][0][1]); w.y = pk2(v[bj][0][2], v[bj][0][3]); w.z = pk2(v[bj][1][0], v[bj][1][1]); w.w = pk2(v[bj][1][2], v[bj][1][3]);
                        *(u32x4*)(rp + 32 * bj) = w;
                    }
                }
            }
        if (ksum) {
            float* km = (float*)(ws + OFF_KMEAN) + (size_t)(((u.pm >> 4) * 8 + (H - 8)) * 16 + (u.pm & 15)) * 64;
#pragma unroll
            for (int bj = 0; bj < 2; ++bj)
#pragma unroll
                for (int n = 0; n < 2; ++n)
#pragma unroll
                    for (int i = 0; i < 4; ++i) {
                        float t = cs[bj][n][i];
                        t += __shfl_xor(t, 1); t += __shfl_xor(t, 2); t += __shfl_xor(t, 4); t += __shfl_xor(t, 8);
                        if (fr == 0) atomicAdd(km + 32 * bj + 8 * fq + 4 * n + i, t);
                    }
        }
    }
};
__device__ __forceinline__ void phase_proj(const Params& P, LDSP unsigned char* lds, int vcu, int G) {
    pg8::Sched S; S.A0 = S.A1 = (const bf16_t*)(P.ws + OFF_R0); S.B0 = S.B1 = (const bf16_t*)(P.ws + OFF_WIN_T);
    S.lda = DM; S.ldb = DM; S.K = DM; S.nM = T / 256; S.nN = NPROJ / 256; S.NZ = 1; S.G = G; S.c = blockIdx.x;
    EpiProj E{&P};
    pg8::gemm_phase(lds, S, E);
}

constexpr size_t OFF_CPART = OFF_EXPERTS;
constexpr size_t CPART_STRIDE = (size_t)2 * 4096 * 256;
__device__ __forceinline__ void phase_cmp1(const Params& P, LDSP unsigned char* lds, int vcu, int G) {
    unsigned char* ws = P.ws;
    const int tid = opaque_tid(), lane = tid & 63, wid = tid >> 6, wm = wid >> 1, wn = wid & 1, fr = lane & 15, fq = lane >> 4;
    for (int item = vcu; item < 256; item += G) {
        const int kc = item & 3, tn = (item >> 2) & 1, tm = (item >> 3) & 15, kv = item >> 7;
        const bf16_t* A = (const bf16_t*)(ws + OFF_R2 + (size_t)kv * 8 * MiB) + (size_t)tm * SEQ * 64 + kc * 512;
        const bf16_t* Bt = (const bf16_t*)(ws + (kv ? OFF_W1V_T : OFF_W1K_T)) + (size_t)tn * G_BN * 2048 + kc * 512;
        float* part = (float*)(ws + OFF_CPART) + (size_t)kc * CPART_STRIDE + (size_t)kv * 4096 * 256;
        f32x4 acc[4][4];
        zero_acc(acc);
        gemm_kloop(acc, A, 1024, Bt, 2048, 512, lds);
        const int row0 = tm * 256 + wm * 64 + fr, col0 = tn * 128 + wn * 64 + 4 * fq;
#pragma unroll
        for (int m = 0; m < 4; ++m)
#pragma unroll
            for (int n = 0; n < 4; ++n) *(f32x4*)(part + (size_t)(row0 + m * 16) * 256 + col0 + n * 16) = acc[m][n];
    }
}

__device__ __forceinline__ u32x4 load_hid8(const float* part, const float* posb, size_t rowoff, int k) {
    f32x4 a = *(const f32x4*)(posb + k), b = *(const f32x4*)(posb + k + 4);
#pragma unroll
    for (int c = 0; c < 4; ++c) { a += *(const f32x4*)(part + c * CPART_STRIDE + rowoff + k); b += *(const f32x4*)(part + c * CPART_STRIDE + rowoff + k + 4); }
    u32x4 o; o.x = pk2(gelu_tanh(a.x), gelu_tanh(a.y)); o.y = pk2(gelu_tanh(a.z), gelu_tanh(a.w)); o.z = pk2(gelu_tanh(b.x), gelu_tanh(b.y)); o.w = pk2(gelu_tanh(b.z), gelu_tanh(b.w));
    return o;
}
__device__ __forceinline__ void phase_cmp2(const Params& P, LDSP unsigned char* lds, int vcu, int G) {
    unsigned char* ws = P.ws;
    const int tid = opaque_tid(), lane = tid & 63, wid = tid >> 6, wm = wid >> 1, wn = wid & 1, fr = lane & 15, fq = lane >> 4;
    const int lrow = tid >> 3, lch = tid & 7;
    for (int item = vcu; item < 32; item += G) {
        const int kv = item >> 4, tm = item & 15;
        const float* part = (const float*)(ws + OFF_CPART) + (size_t)kv * 4096 * 256 + (size_t)tm * 256 * 256;
        const float* posb = (const float*)(ws + OFF_POSB) + kv * 256;
        const bf16_t* Bt = (const bf16_t*)(ws + (kv ? OFF_W2V_T : OFF_W2K_T));
        const float* b2 = P.in[kv ? I_CVB2 : I_CKB2];
        bf16_t* dst = (bf16_t*)(ws + (kv ? OFF_VC : OFF_KC)) + (size_t)tm * 256 * 64;
        f32x4 acc[4][4];
        zero_acc(acc);
        {
            const bf16_t* gb = Bt + (size_t)lrow * 256 + lch * 8;
            u32x4 ra[4], rb[2];
#pragma unroll
            for (int p = 0; p < 4; ++p) ra[p] = load_hid8(part, posb, (size_t)(lrow + 64 * p) * 256, lch * 8);
#pragma unroll
            for (int p = 0; p < 2; ++p) rb[p] = *(const u32x4*)(gb + (size_t)(64 * p) * 256);
            __syncthreads();
#pragma unroll
            for (int p = 0; p < 4; ++p) *(LDSP u32x4*)(lds + swz_off(lrow + 64 * p, lch)) = ra[p];
#pragma unroll
            for (int p = 0; p < 2; ++p) *(LDSP u32x4*)(lds + G_ABYTES + swz_off(lrow + 64 * p, lch)) = rb[p];
            __syncthreads();
#pragma unroll 1
            for (int kt = 0; kt < 4; ++kt) {
                LDSP unsigned char* cur = lds + (kt & 1) * G_STAGE;
                LDSP unsigned char* nxt = lds + ((kt + 1) & 1) * G_STAGE;
                if (kt + 1 < 4) {
#pragma unroll
                    for (int p = 0; p < 4; ++p) ra[p] = load_hid8(part, posb, (size_t)(lrow + 64 * p) * 256, (kt + 1) * G_BK + lch * 8);
#pragma unroll
                    for (int p = 0; p < 2; ++p) rb[p] = *(const u32x4*)(gb + (size_t)(64 * p) * 256 + (kt + 1) * G_BK);
                }
#pragma unroll
                for (int ks = 0; ks < 2; ++ks) {
                    bf16x8 af[4], bfr[4];
#pragma unroll
                    for (int m = 0; m < 4; ++m) af[m] = *(const LDSP bf16x8*)(cur + swz_off(wm * 64 + m * 16 + fr, ks * 4 + fq));
#pragma unroll
                    for (int n = 0; n < 4; ++n) bfr[n] = *(const LDSP bf16x8*)(cur + G_ABYTES + swz_off(wn * 64 + n * 16 + fr, ks * 4 + fq));
#pragma unroll
                    for (int m = 0; m < 4; ++m)
#pragma unroll
                        for (int n = 0; n < 4; ++n) acc[m][n] = __builtin_amdgcn_mfma_f32_16x16x32_bf16(bfr[n], af[m], acc[m][n], 0, 0, 0);
                }
                if (kt + 1 < 4) {
#pragma unroll
                    for (int p = 0; p < 4; ++p) *(LDSP u32x4*)(nxt + swz_off(lrow + 64 * p, lch)) = ra[p];
#pragma unroll
                    for (int p = 0; p < 2; ++p) *(LDSP u32x4*)(nxt + G_ABYTES + swz_off(lrow + 64 * p, lch)) = rb[p];
                }
                __syncthreads();
            }
        }
        if (wn == 0) {
            float gv[4][4];
#pragma unroll
            for (int n = 0; n < 4; ++n) {
                const f32x4 bb = *(const f32x4*)(b2 + n * 16 + 4 * fq);
                const f32x4 g4 = kv ? (f32x4){1.f, 1.f, 1.f, 1.f} : *(const f32x4*)(P.in[I_BKCG] + n * 16 + 4 * fq);
                gv[n][0] = g4.x; gv[n][1] = g4.y; gv[n][2] = g4.z; gv[n][3] = g4.w;
#pragma unroll
                for (int m = 0; m < 4; ++m) acc[m][n] += bb;
            }
#pragma unroll
            for (int m = 0; m < 4; ++m) {
                float r = 1.f;
                if (kv == 0) {
                    float ss = 0.f;
#pragma unroll
                    for (int n = 0; n < 4; ++n) ss += (acc[m][n][0] * acc[m][n][0] + acc[m][n][1] * acc[m][n][1]) + (acc[m][n][2] * acc[m][n][2] + acc[m][n][3] * acc[m][n][3]);
                    ss += __shfl_xor(ss, 16); ss += __shfl_xor(ss, 32);
                    r = 1.0f / sqrtf(ss * (1.0f / 64.0f) + NORM_EPS);
                }
                const int row = wm * 64 + m * 16 + fr;
                if (row == 255) r = 0.f;
#pragma unroll
                for (int n = 0; n < 4; ++n) {
                    f32x4 o = acc[m][n];
                    if (row == 255) o = (f32x4){0.f, 0.f, 0.f, 0.f};
                    u32x2 w; w.x = pk2(o[0] * r * gv[n][0], o[1] * r * gv[n][1]); w.y = pk2(o[2] * r * gv[n][2], o[3] * r * gv[n][3]);
                    *(u32x2*)(dst + (size_t)row * 64 + n * 16 + 4 * fq) = w;
                }
            }
        }
    }
}

__device__ __forceinline__ void phase_cmp(const Params& P, LDSP unsigned char* lds, int vcu, int G) {
    unsigned char* ws = P.ws;
    const int tid = opaque_tid(), lane = tid & 63, r32 = lane & 31, hi = lane >> 5;
    const int wu = __builtin_amdgcn_readfirstlane(tid >> 6);
    for (int item = vcu; item < 256; item += G) {
        const int kv = item >> 7, bg = (item >> 3) & 15, rb = item & 7;
        const bf16_t* A = (const bf16_t*)(ws + OFF_R2 + (size_t)kv * 8 * MiB) + ((size_t)bg * SEQ + 512 * rb) * 64;
        const bf16_t* W1 = (const bf16_t*)(ws + (kv ? OFF_W1V_T : OFF_W1K_T)) + (size_t)(32 * wu + (lane >> 3)) * 2048 + 8 * (lane & 7);
        LDSP unsigned char* wt = lds + 73728 + wu * 4096;
        __syncthreads();
        for (int pc = wu; pc < 66; pc += 8) {
            const int g16 = pc >> 1, h8 = pc & 1, tau = 16 * g16 + 8 * h8 + (lane >> 3), c = (lane & 7) ^ ((g16 >> 1) & 7);
            __builtin_amdgcn_global_load_lds((const unsigned*)(A + (size_t)tau * 64 + c * 8), (LDSP unsigned*)(lds + (17 * g16 + 8 * h8) * 128), 16, 0, 0);
        }
        u32x4 Bq[8][4];
#pragma unroll
        for (int j = 0; j < 8; ++j)
#pragma unroll
            for (int i = 0; i < 4; ++i) Bq[j][i] = *(const u32x4*)(W1 + (size_t)(8 * i) * 2048 + 64 * j);
        int wwr[4], wrd[4];
#pragma unroll
        for (int i = 0; i < 4; ++i) { wwr[i] = swz_off(8 * i + (lane >> 3), lane & 7); wrd[i] = swz_off(r32, 4 * hi + i); }
        const int abase = 17 * r32 * 128;
        int aoff[2][4];
#pragma unroll
        for (int jh = 0; jh < 2; ++jh)
#pragma unroll
            for (int i = 0; i < 4; ++i) aoff[jh][i] = abase + ((((4 * hi + i) ^ (((r32 + jh) >> 1) & 7))) << 4);
        f32x16 acc;
#pragma unroll
        for (int r = 0; r < 16; ++r) acc[r] = 0.f;
        asm volatile("s_waitcnt vmcnt(32)" ::: "memory");
        __syncthreads();
#pragma unroll
        for (int j = 0; j < 32; ++j) {
#pragma unroll
            for (int i = 0; i < 4; ++i) *(LDSP u32x4*)(wt + wwr[i]) = Bq[j & 7][i];
            if (j + 8 < 32) {
#pragma unroll
                for (int i = 0; i < 4; ++i) Bq[j & 7][i] = *(const u32x4*)(W1 + (size_t)(8 * i) * 2048 + 64 * (j + 8));
            }
#pragma unroll
            for (int i = 0; i < 4; ++i) {
                const bf16x8 wf = *(const LDSP bf16x8*)(wt + wrd[i]);
                const bf16x8 xf = *(const LDSP bf16x8*)(lds + aoff[j >> 4][i] + (j + (j >> 4)) * 128);
                acc = __builtin_amdgcn_mfma_f32_32x32x16_bf16(wf, xf, acc, 0, 0, 0);
            }
            __builtin_amdgcn_sched_barrier(0);
        }
        const float* posb = (const float*)(ws + OFF_POSB) + kv * 256 + 32 * wu + 4 * hi;
        u32x4 pw[2];
#pragma unroll
        for (int q = 0; q < 4; ++q) {
            const f32x4 pb = *(const f32x4*)(posb + 8 * q);
            const float h0 = gelu_tanh(acc[4 * q] + pb.x), h1 = gelu_tanh(acc[4 * q + 1] + pb.y), h2 = gelu_tanh(acc[4 * q + 2] + pb.z), h3 = gelu_tanh(acc[4 * q + 3] + pb.w);
            pw[q >> 1][(q & 1) * 2] = pk2(h0, h1); pw[q >> 1][(q & 1) * 2 + 1] = pk2(h2, h3);
        }
        const bf16_t* W2 = (const bf16_t*)(ws + (kv ? OFF_W2V_T : OFF_W2K_T)) + (size_t)r32 * 256 + 32 * wu + 4 * hi;
        f32x16 o2[2];
#pragma unroll
        for (int mb = 0; mb < 2; ++mb) {
#pragma unroll
            for (int r = 0; r < 16; ++r) o2[mb][r] = 0.f;
#pragma unroll
            for (int s2 = 0; s2 < 2; ++s2) {
                const u32x2 lo = *(const u32x2*)(W2 + (size_t)mb * 32 * 256 + 16 * s2), hh = *(const u32x2*)(W2 + (size_t)mb * 32 * 256 + 16 * s2 + 8);
                const u32x4 a2 = {lo.x, lo.y, hh.x, hh.y};
                o2[mb] = __builtin_amdgcn_mfma_f32_32x32x16_bf16(__builtin_bit_cast(bf16x8, a2), __builtin_bit_cast(bf16x8, pw[s2]), o2[mb], 0, 0, 0);
            }
        }
        __syncthreads();
        {
            LDSP float* part = (LDSP float*)lds + (size_t)(wu * 32 + r32) * 68 + 4 * hi;
#pragma unroll
            for (int mb = 0; mb < 2; ++mb)
#pragma unroll
                for (int q = 0; q < 4; ++q) *(LDSP f32x4*)(part + 32 * mb + 8 * q) = (f32x4){o2[mb][4 * q], o2[mb][4 * q + 1], o2[mb][4 * q + 2], o2[mb][4 * q + 3]};
        }
        __syncthreads();
        {
            const int row = tid >> 4, dq = tid & 15;
            f32x4 v = *(const f32x4*)(P.in[kv ? I_CVB2 : I_CKB2] + 4 * dq);
#pragma unroll
            for (int w = 0; w < 8; ++w) v += *(const LDSP f32x4*)((LDSP float*)lds + (size_t)(w * 32 + row) * 68 + 4 * dq);
            float rr = 1.f; f32x4 g4 = {1.f, 1.f, 1.f, 1.f};
            if (kv == 0) {
                float ss = (v.x * v.x + v.y * v.y) + (v.z * v.z + v.w * v.w);
                ss += __shfl_xor(ss, 1); ss += __shfl_xor(ss, 2); ss += __shfl_xor(ss, 4); ss += __shfl_xor(ss, 8);
                rr = 1.0f / sqrtf(ss * (1.0f / 64.0f) + NORM_EPS);
                g4 = *(const f32x4*)(P.in[I_BKCG] + 4 * dq);
            }
            const int grow = 32 * rb + row;
            u32x2 w2; w2.x = pk2(v.x * rr * g4.x, v.y * rr * g4.y); w2.y = pk2(v.z * rr * g4.z, v.w * rr * g4.w);
            if (grow == 255) w2 = (u32x2){0u, 0u};
            *(u32x2*)((bf16_t*)(ws + (kv ? OFF_VC : OFF_KC)) + ((size_t)bg * 256 + grow) * 64 + 4 * dq) = w2;
        }
    }
    __syncthreads();
}

constexpr int A_GS = 65536, A_ES = 81920, A_Y = 65536, A_MISC = 131072;
typedef short v4i16_t __attribute__((ext_vector_type(4)));
struct ASt { f32x16 o0, o1; float m, l; };
struct KVStage { u32x4 k, v; };
__device__ __forceinline__ void kv_load(KVStage& s, const bf16_t* Kg, const bf16_t* Vg, size_t pitch, int tid) {
    const int key = tid >> 3, ch = tid & 7;
    s.k = *(const u32x4*)(Kg + (size_t)key * pitch + ch * 8);
    s.v = *(const u32x4*)(Vg + (size_t)key * pitch + ch * 8);
}
__device__ __forceinline__ void kv_store(const KVStage& s, LDSP unsigned char* buf, int tid) {
    const int key = tid >> 3, ch = tid & 7;
    *(LDSP u32x4*)(buf + swz_off(key, ch)) = s.k;
    *(LDSP u32x4*)(buf + 8192 + ((ch >> 2) * 4 + (key >> 4)) * 1024 + (key & 15) * 64 + (ch & 3) * 16) = s.v;
}
__device__ __forceinline__ void kv_dma(const bf16_t* Kg, const bf16_t* Vg, size_t pitch, LDSP unsigned char* buf, int wid, int lane) {
    const int row = wid * 8 + (lane >> 3), chunk = (lane & 7) ^ ((row >> 1) & 7);
    __builtin_amdgcn_global_load_lds((const unsigned*)(Kg + (size_t)row * pitch + chunk * 8), (LDSP unsigned*)(buf + wid * 1024), 16, 0, 0);
    const int vrow = (wid & 3) * 16 + (lane >> 2), vcol = (wid >> 2) * 32 + (lane & 3) * 8;
    __builtin_amdgcn_global_load_lds((const unsigned*)(Vg + (size_t)vrow * pitch + vcol), (LDSP unsigned*)(buf + 8192 + wid * 1024), 16, 0, 0);
}
__device__ __forceinline__ float swap32f(float v) { return __shfl_xor(v, 32); }
__device__ __forceinline__ void ast_reset(ASt& st) {
#pragma unroll
    for (int r = 0; r < 16; ++r) { st.o0[r] = 0.f; st.o1[r] = 0.f; }
    st.m = 0.f; st.l = 0.f;
}
constexpr float ATT_THR = 8.0f;
template <int MODE>
__device__ __forceinline__ void attn_tile(ASt& st, const bf16x8 (&qf)[4], LDSP const unsigned char* kt, int lane, bool rowoff, int kl, int kh, bool need_mask,
                                          float linv, LDSP float* gs, LDSP float* es, int jbase, int ql) {
    const int r32 = lane & 31, hi = lane >> 5;
    const float cin = rowoff ? -INFINITY : -st.m;
    f32x16 p0, p1;
#pragma unroll
    for (int r = 0; r < 16; ++r) { p0[r] = cin; p1[r] = cin; }
#pragma unroll
    for (int d0 = 0; d0 < 4; ++d0) {
        const bf16x8 k0f = *(const LDSP bf16x8*)(kt + swz_off(r32, 2 * d0 + hi));
        const bf16x8 k1f = *(const LDSP bf16x8*)(kt + swz_off(r32 + 32, 2 * d0 + hi));
        p0 = __builtin_amdgcn_mfma_f32_32x32x16_bf16(k0f, qf[d0], p0, 0, 0, 0);
        p1 = __builtin_amdgcn_mfma_f32_32x32x16_bf16(k1f, qf[d0], p1, 0, 0, 0);
    }
    if (need_mask) {
        const int kl2 = kl - 4 * hi, kh2 = kh - 4 * hi;
#pragma unroll
        for (int r = 0; r < 16; ++r) {
            const int c = (r & 3) + 8 * (r >> 2);
            const bool v0 = c >= kl2 && c <= kh2, v1 = (c + 32) >= kl2 && (c + 32) <= kh2;
            p0[r] = v0 ? p0[r] : -INFINITY; p1[r] = v1 ? p1[r] : -INFINITY;
        }
    }
    if (MODE != 2) {
        float mx = fmaxf(fmaxf(p0[0], p1[0]), fmaxf(p0[1], p1[1]));
#pragma unroll
        for (int r = 2; r < 16; r += 2) mx = fmaxf(fmaxf(mx, fmaxf(p0[r], p1[r])), fmaxf(p0[r + 1], p1[r + 1]));
        mx = fmaxf(mx, swap32f(mx));
        if (__any(mx > ATT_THR)) {
            const float dl = (mx > ATT_THR) ? mx : 0.f;
            const float alpha = __builtin_amdgcn_exp2f(-dl);
            st.m += dl; st.l *= alpha;
#pragma unroll
            for (int r = 0; r < 16; ++r) { p0[r] -= dl; p1[r] -= dl; }
            if (MODE == 0) {
#pragma unroll
                for (int r = 0; r < 16; ++r) { st.o0[r] *= alpha; st.o1[r] *= alpha; }
            }
        }
    }
#pragma unroll
    for (int r = 0; r < 16; ++r) { p0[r] = __builtin_amdgcn_exp2f(p0[r]); p1[r] = __builtin_amdgcn_exp2f(p1[r]); }
    if (MODE != 2) {
        const f32x16 t = p0 + p1;
        st.l += ((t[0] + t[1]) + (t[2] + t[3])) + ((t[4] + t[5]) + (t[6] + t[7])) + (((t[8] + t[9]) + (t[10] + t[11])) + ((t[12] + t[13]) + (t[14] + t[15])));
    } else {
#pragma unroll
        for (int r = 0; r < 16; ++r) { p0[r] *= linv; p1[r] *= linv; }
#pragma unroll
        for (int qd = 0; qd < 4; ++qd) {
            float g0 = (p0[4 * qd] + p0[4 * qd + 1]) + (p0[4 * qd + 2] + p0[4 * qd + 3]), e0 = p0[4 * qd + 3];
            float g1 = (p1[4 * qd] + p1[4 * qd + 1]) + (p1[4 * qd + 2] + p1[4 * qd + 3]), e1 = p1[4 * qd + 3];
            g0 += __shfl_xor(g0, 1); g0 += __shfl_xor(g0, 2); e0 += __shfl_xor(e0, 1); e0 += __shfl_xor(e0, 2);
            g1 += __shfl_xor(g1, 1); g1 += __shfl_xor(g1, 2); e1 += __shfl_xor(e1, 1); e1 += __shfl_xor(e1, 2);
            if ((r32 & 3) == 0) {
                const int j = jbase + 2 * qd + hi;
                gs[ql * 64 + j] = g0; es[ql * 64 + j] = e0; gs[ql * 64 + j + 8] = g1; es[ql * 64 + j + 8] = e1;
            }
        }
    }
    if (MODE != 1) {
        u32x4 pw[4];
        pw[0] = (u32x4){pk2(p0[0], p0[1]), pk2(p0[2], p0[3]), pk2(p0[4], p0[5]), pk2(p0[6], p0[7])};
        pw[1] = (u32x4){pk2(p0[8], p0[9]), pk2(p0[10], p0[11]), pk2(p0[12], p0[13]), pk2(p0[14], p0[15])};
        pw[2] = (u32x4){pk2(p1[0], p1[1]), pk2(p1[2], p1[3]), pk2(p1[4], p1[5]), pk2(p1[6], p1[7])};
        pw[3] = (u32x4){pk2(p1[8], p1[9]), pk2(p1[10], p1[11]), pk2(p1[12], p1[13]), pk2(p1[14], p1[15])};
        LDSP const unsigned char* vb = kt + 8192 + ((lane >> 4) & 1) * 32 + (lane & 3) * 8 + (4 * hi + ((lane & 15) >> 2)) * 64;
#pragma unroll
        for (int ks = 0; ks < 4; ++ks) {
            const bf16x8 pf = __builtin_bit_cast(bf16x8, pw[ks]);
#pragma unroll
            for (int d0 = 0; d0 < 2; ++d0) {
                const v4i16_t lo = __builtin_amdgcn_ds_read_tr16_b64_v4i16((LDSP v4i16_t*)(vb + (d0 * 4 + ks) * 1024));
                const v4i16_t hh = __builtin_amdgcn_ds_read_tr16_b64_v4i16((LDSP v4i16_t*)(vb + (d0 * 4 + ks) * 1024 + 512));
                const bf16x8 vf = (bf16x8){lo[0], lo[1], lo[2], lo[3], hh[0], hh[1], hh[2], hh[3]};
                if (d0 == 0) st.o0 = __builtin_amdgcn_mfma_f32_32x32x16_bf16(vf, pf, st.o0, 0, 0, 0);
                else         st.o1 = __builtin_amdgcn_mfma_f32_32x32x16_bf16(vf, pf, st.o1, 0, 0, 0);
            }
            if (ks & 1) __builtin_amdgcn_sched_barrier(0);
        }
    }
}

#define KV_LOOP(NT, KPTR, VPTR, PITCH, ...) do { const int nt_ = (NT), np_ = (nt_ + 1) >> 1; KVStage sa_, sb_; __syncthreads(); \
    { const int i = 0; kv_load(sa_, (KPTR), (VPTR), (PITCH), tid); } { const int i = (nt_ > 1) ? 1 : 0; kv_load(sb_, (KPTR), (VPTR), (PITCH), tid); } \
    kv_store(sa_, lds, tid); kv_store(sb_, lds + 16384, tid); __syncthreads(); \
    _Pragma("unroll 1") for (int ip_ = 0; ip_ < np_; ++ip_) { LDSP unsigned char* cur0_ = lds + (ip_ & 1) * 32768; \
        if (ip_ + 1 < np_) { { const int i = 2 * ip_ + 2; kv_load(sa_, (KPTR), (VPTR), (PITCH), tid); } \
                             { const int i = (2 * ip_ + 3 < nt_) ? 2 * ip_ + 3 : 2 * ip_ + 2; kv_load(sb_, (KPTR), (VPTR), (PITCH), tid); } } \
        { const int i = 2 * ip_; LDSP unsigned char* cur = cur0_; __VA_ARGS__ } \
        if (2 * ip_ + 1 < nt_) { const int i = 2 * ip_ + 1; LDSP unsigned char* cur = cur0_ + 16384; __VA_ARGS__ } \
        if (ip_ + 1 < np_) { kv_store(sa_, lds + ((ip_ + 1) & 1) * 32768, tid); kv_store(sb_, lds + ((ip_ + 1) & 1) * 32768 + 16384, tid); } \
        __syncthreads(); } } while (0)

struct TP { bool rowoff, nm; int kl, kh; };
__device__ __forceinline__ void pair_kload(bf16x8 (&kf)[8], LDSP const unsigned char* kt, int r32, int hi) {
#pragma unroll
    for (int d0 = 0; d0 < 4; ++d0) {
        kf[2 * d0]     = *(const LDSP bf16x8*)(kt + swz_off(r32, 2 * d0 + hi));
        kf[2 * d0 + 1] = *(const LDSP bf16x8*)(kt + swz_off(r32 + 32, 2 * d0 + hi));
    }
}
__device__ __forceinline__ void pair_vload(bf16x8 (&vf)[8], LDSP const unsigned char* kt, int lane, int hi) {
    LDSP const unsigned char* vb = kt + 8192 + ((lane >> 4) & 1) * 32 + (lane & 3) * 8 + (4 * hi + ((lane & 15) >> 2)) * 64;
#pragma unroll
    for (int ks = 0; ks < 4; ++ks)
#pragma unroll
        for (int d0 = 0; d0 < 2; ++d0) {
            const v4i16_t lo = __builtin_amdgcn_ds_read_tr16_b64_v4i16((LDSP v4i16_t*)(vb + (d0 * 4 + ks) * 1024));
            const v4i16_t hh = __builtin_amdgcn_ds_read_tr16_b64_v4i16((LDSP v4i16_t*)(vb + (d0 * 4 + ks) * 1024 + 512));
            vf[2 * ks + d0] = (bf16x8){lo[0], lo[1], lo[2], lo[3], hh[0], hh[1], hh[2], hh[3]};
        }
}
#define PAIR_LDS_WAIT() do { asm volatile("s_waitcnt lgkmcnt(0)" ::: "memory"); __builtin_amdgcn_sched_barrier(0); } while (0)
__device__ __forceinline__ void pair_qk(f32x16& p0, f32x16& p1, float cin, const bf16x8 (&qf)[4], const bf16x8 (&kf)[8]) {
    f32x16 c16;
#pragma unroll
    for (int r = 0; r < 16; ++r) c16[r] = cin;
#pragma unroll
    for (int d0 = 0; d0 < 4; ++d0) {
        p0 = __builtin_amdgcn_mfma_f32_32x32x16_bf16(kf[2 * d0], qf[d0], d0 == 0 ? c16 : p0, 0, 0, 0);
        p1 = __builtin_amdgcn_mfma_f32_32x32x16_bf16(kf[2 * d0 + 1], qf[d0], d0 == 0 ? c16 : p1, 0, 0, 0);
    }
}
__device__ __forceinline__ void pair_sm(ASt& st, f32x16& p0, f32x16& p1, u32x4 (&pw)[4], const TP& t, float pend, int hi) {
    if (t.nm) {
        const int kl2 = t.kl - 4 * hi, kh2 = t.kh - 4 * hi;
#pragma unroll
        for (int r = 0; r < 16; ++r) {
            const int c = (r & 3) + 8 * (r >> 2);
            const bool v0 = c >= kl2 && c <= kh2, v1 = (c + 32) >= kl2 && (c + 32) <= kh2;
            p0[r] = v0 ? p0[r] : -INFINITY; p1[r] = v1 ? p1[r] : -INFINITY;
        }
    }
    float mx = fmaxf(fmaxf(p0[0], p1[0]), fmaxf(p0[1], p1[1]));
#pragma unroll
    for (int r = 2; r < 16; r += 2) mx = fmaxf(fmaxf(mx, fmaxf(p0[r], p1[r])), fmaxf(p0[r + 1], p1[r + 1]));
    { const auto rr = __builtin_amdgcn_permlane32_swap(__float_as_uint(mx), __float_as_uint(mx), false, false); mx = fmaxf(__uint_as_float(rr[0]), __uint_as_float(rr[1])); }
    mx -= pend;
    if (__any(mx > ATT_THR || pend != 0.f)) {
        const float dl = (mx > ATT_THR) ? mx : 0.f;
        const float alpha = __builtin_amdgcn_exp2f(-dl), sub = dl + pend;
        st.m += dl; st.l *= alpha;
#pragma unroll
        for (int r = 0; r < 16; ++r) { p0[r] -= sub; p1[r] -= sub; st.o0[r] *= alpha; st.o1[r] *= alpha; }
    }
#pragma unroll
    for (int r = 0; r < 16; ++r) { p0[r] = __builtin_amdgcn_exp2f(p0[r]); p1[r] = __builtin_amdgcn_exp2f(p1[r]); }
    const f32x16 tt = p0 + p1;
    st.l += ((tt[0] + tt[1]) + (tt[2] + tt[3])) + ((tt[4] + tt[5]) + (tt[6] + tt[7])) + (((tt[8] + tt[9]) + (tt[10] + tt[11])) + ((tt[12] + tt[13]) + (tt[14] + tt[15])));
    pw[0] = (u32x4){pk2(p0[0], p0[1]), pk2(p0[2], p0[3]), pk2(p0[4], p0[5]), pk2(p0[6], p0[7])};
    pw[1] = (u32x4){pk2(p0[8], p0[9]), pk2(p0[10], p0[11]), pk2(p0[12], p0[13]), pk2(p0[14], p0[15])};
    pw[2] = (u32x4){pk2(p1[0], p1[1]), pk2(p1[2], p1[3]), pk2(p1[4], p1[5]), pk2(p1[6], p1[7])};
    pw[3] = (u32x4){pk2(p1[8], p1[9]), pk2(p1[10], p1[11]), pk2(p1[12], p1[13]), pk2(p1[14], p1[15])};
}
__device__ __forceinline__ void pair_pv(ASt& st, const u32x4 (&pw)[4], const bf16x8 (&vf)[8]) {
#pragma unroll
    for (int ks = 0; ks < 4; ++ks) {
        const bf16x8 pf = __builtin_bit_cast(bf16x8, pw[ks]);
        st.o0 = __builtin_amdgcn_mfma_f32_32x32x16_bf16(vf[2 * ks], pf, st.o0, 0, 0, 0);
        st.o1 = __builtin_amdgcn_mfma_f32_32x32x16_bf16(vf[2 * ks + 1], pf, st.o1, 0, 0, 0);
    }
}
__device__ __forceinline__ void attn_pair(ASt& st, const bf16x8 (&qf)[4], LDSP const unsigned char* ka, LDSP const unsigned char* kb, int lane, const TP& ta, const TP& tb) {
    const int r32 = lane & 31, hi = lane >> 5;
    const float m0 = st.m;
    f32x16 a0, a1, b0, b1; u32x4 pwa[4], pwb[4];
    bf16x8 kfa[8], kfb[8], vf[8];
    pair_kload(kfa, ka, r32, hi); pair_kload(kfb, kb, r32, hi);
    PAIR_LDS_WAIT();
    pair_qk(a0, a1, ta.rowoff ? -INFINITY : -m0, qf, kfa);
    pair_qk(b0, b1, tb.rowoff ? -INFINITY : -m0, qf, kfb);
    pair_vload(vf, ka, lane, hi);
    __builtin_amdgcn_sched_barrier(0);
    pair_sm(st, a0, a1, pwa, ta, 0.f, hi);
    PAIR_LDS_WAIT();
    pair_pv(st, pwa, vf);
    __builtin_amdgcn_sched_barrier(0);
    pair_vload(vf, kb, lane, hi);
    __builtin_amdgcn_sched_barrier(0);
    pair_sm(st, b0, b1, pwb, tb, st.m - m0, hi);
    PAIR_LDS_WAIT();
    pair_pv(st, pwb, vf);
}
template <int I, bool MASK>
__device__ __forceinline__ void pair_exp_chunk(const f32x16& p0, const f32x16& p1, u32x4 (&pw)[4], float& sacc, int kl2, int kh2) {
    const f32x16& src = (I < 4) ? p0 : p1; constexpr int b = 4 * (I & 3);
    float x0 = src[b], x1 = src[b + 1], x2 = src[b + 2], x3 = src[b + 3];
    if (MASK) {
        constexpr int c0 = 8 * (b >> 2) + ((I < 4) ? 0 : 32);
        x0 = (c0 >= kl2 && c0 <= kh2) ? x0 : -INFINITY; x1 = (c0 + 1 >= kl2 && c0 + 1 <= kh2) ? x1 : -INFINITY;
        x2 = (c0 + 2 >= kl2 && c0 + 2 <= kh2) ? x2 : -INFINITY; x3 = (c0 + 3 >= kl2 && c0 + 3 <= kh2) ? x3 : -INFINITY;
    }
    const float e0 = __builtin_amdgcn_exp2f(x0), e1 = __builtin_amdgcn_exp2f(x1), e2 = __builtin_amdgcn_exp2f(x2), e3 = __builtin_amdgcn_exp2f(x3);
    sacc += (e0 + e1) + (e2 + e3);
    pw[I >> 1][(I & 1) * 2] = pk2(e0, e1); pw[I >> 1][(I & 1) * 2 + 1] = pk2(e2, e3);
}
#define PAIR_SB() __builtin_amdgcn_sched_barrier(0)
__device__ __forceinline__ bf16x8 vfrag_load(LDSP const unsigned char* vb, int idx) {
    const int off = ((idx & 1) * 4 + (idx >> 1)) * 1024;
    const v4i16_t lo = __builtin_amdgcn_ds_read_tr16_b64_v4i16((LDSP v4i16_t*)(vb + off));
    const v4i16_t hh = __builtin_amdgcn_ds_read_tr16_b64_v4i16((LDSP v4i16_t*)(vb + off + 512));
    return (bf16x8){lo[0], lo[1], lo[2], lo[3], hh[0], hh[1], hh[2], hh[3]};
}
template <bool MASK>
__device__ __forceinline__ void attn_pair_fast(ASt& st, const bf16x8 (&qf)[4], LDSP const unsigned char* ka, LDSP const unsigned char* kb, int lane, const TP& ta, const TP& tb) {
    const int r32 = lane & 31, hi = lane >> 5; const bool offa = ta.rowoff, offb = tb.rowoff;
    const int kla = ta.kl - 4 * hi, kha = ta.kh - 4 * hi, klb = tb.kl - 4 * hi, khb = tb.kh - 4 * hi;
    LDSP const unsigned char* vba = ka + 8192 + ((lane >> 4) & 1) * 32 + (lane & 3) * 8 + (4 * hi + ((lane & 15) >> 2)) * 64;
    LDSP const unsigned char* vbb = vba + (kb - ka);
    f32x16 a0, a1, b0, b1; u32x4 pwa[4], pwb[4];
    bf16x8 kfa[8], kfb[8], vfa[8], vfb[8];
    pair_kload(kfa, ka, r32, hi);
    { f32x16 c16; const float cina = offa ? -INFINITY : -st.m;
#pragma unroll
      for (int r = 0; r < 16; ++r) c16[r] = cina;
      asm volatile("s_waitcnt lgkmcnt(0)" ::: "memory"); PAIR_SB();
#define QKA_STEP(I) do { if ((I) & 1) a1 = __builtin_amdgcn_mfma_f32_32x32x16_bf16(kfa[I], qf[(I) >> 1], (I) == 1 ? c16 : a1, 0, 0, 0); \
                         else         a0 = __builtin_amdgcn_mfma_f32_32x32x16_bf16(kfa[I], qf[(I) >> 1], (I) == 0 ? c16 : a0, 0, 0, 0); \
                         kfb[I] = *(const LDSP bf16x8*)(kb + swz_off(r32 + 32 * ((I) & 1), 2 * ((I) >> 1) + hi)); PAIR_SB(); } while (0)
      QKA_STEP(0); QKA_STEP(1); QKA_STEP(2); QKA_STEP(3); QKA_STEP(4); QKA_STEP(5); QKA_STEP(6); QKA_STEP(7);
#undef QKA_STEP
    }
    float sa = 0.f, sbm = 0.f;
    { f32x16 c16; const float cinb = offb ? -INFINITY : -st.m;
#pragma unroll
      for (int r = 0; r < 16; ++r) c16[r] = cinb;
      asm volatile("s_waitcnt lgkmcnt(0)" ::: "memory"); PAIR_SB();
#define QKB_STEP(I) do { if ((I) & 1) b1 = __builtin_amdgcn_mfma_f32_32x32x16_bf16(kfb[I], qf[(I) >> 1], (I) == 1 ? c16 : b1, 0, 0, 0); \
                         else         b0 = __builtin_amdgcn_mfma_f32_32x32x16_bf16(kfb[I], qf[(I) >> 1], (I) == 0 ? c16 : b0, 0, 0, 0); \
                         if ((I) >= 4) vfa[(I) - 4] = vfrag_load(vba, (I) - 4); \
                         pair_exp_chunk<I, MASK>(a0, a1, pwa, sa, kla, kha); PAIR_SB(); } while (0)
      QKB_STEP(0); QKB_STEP(1); QKB_STEP(2); QKB_STEP(3); QKB_STEP(4); QKB_STEP(5); QKB_STEP(6); QKB_STEP(7);
#undef QKB_STEP
    }
    asm volatile("s_waitcnt lgkmcnt(0)" ::: "memory"); PAIR_SB();
#define PVA_STEP(I) do { if ((I) & 1) st.o1 = __builtin_amdgcn_mfma_f32_32x32x16_bf16(vfa[I], __builtin_bit_cast(bf16x8, pwa[(I) >> 1]), st.o1, 0, 0, 0); \
                         else         st.o0 = __builtin_amdgcn_mfma_f32_32x32x16_bf16(vfa[I], __builtin_bit_cast(bf16x8, pwa[(I) >> 1]), st.o0, 0, 0, 0); \
                         if ((I) < 4) vfa[(I) + 4] = vfrag_load(vba, (I) + 4); else vfb[(I) - 4] = vfrag_load(vbb, (I) - 4); \
                         pair_exp_chunk<I, MASK>(b0, b1, pwb, sbm, klb, khb); PAIR_SB(); \
                         if ((I) == 3) { asm volatile("s_waitcnt lgkmcnt(0)" ::: "memory"); PAIR_SB(); } } while (0)
    PVA_STEP(0); PVA_STEP(1); PVA_STEP(2); PVA_STEP(3); PVA_STEP(4); PVA_STEP(5); PVA_STEP(6); PVA_STEP(7);
#undef PVA_STEP
    st.l += sa + sbm;
    asm volatile("s_waitcnt lgkmcnt(0)" ::: "memory"); PAIR_SB();
#define PVB_STEP(I) do { if ((I) & 1) st.o1 = __builtin_amdgcn_mfma_f32_32x32x16_bf16(vfb[I], __builtin_bit_cast(bf16x8, pwb[(I) >> 1]), st.o1, 0, 0, 0); \
                         else         st.o0 = __builtin_amdgcn_mfma_f32_32x32x16_bf16(vfb[I], __builtin_bit_cast(bf16x8, pwb[(I) >> 1]), st.o0, 0, 0, 0); \
                         if ((I) < 4) vfb[(I) + 4] = vfrag_load(vbb, (I) + 4); PAIR_SB(); \
                         if ((I) == 3) { asm volatile("s_waitcnt lgkmcnt(0)" ::: "memory"); PAIR_SB(); } } while (0)
    PVB_STEP(0); PVB_STEP(1); PVB_STEP(2); PVB_STEP(3); PVB_STEP(4); PVB_STEP(5); PVB_STEP(6); PVB_STEP(7);
#undef PVB_STEP
    const float lpair = fmaxf(st.l, swap32f(st.l));
    if (__any(lpair > 1.0e18f)) {
        const float dl = (lpair > 1.0e18f) ? 64.f : 0.f, alpha = __builtin_amdgcn_exp2f(-dl);
        st.m += dl; st.l *= alpha;
#pragma unroll
        for (int r = 0; r < 16; ++r) { st.o0[r] *= alpha; st.o1[r] *= alpha; }
    }
}

#define KV_LOOP_PAIR(NT, KPTR, VDELTA, PITCH, TPF) do { const int nt_ = (NT), np_ = (nt_ + 1) >> 1; const int wu_ = __builtin_amdgcn_readfirstlane(wid); __syncthreads(); \
    { const int i = 0; kv_dma((KPTR), (KPTR) + (VDELTA), (PITCH), lds, wu_, lane); } { const int i = (nt_ > 1) ? 1 : 0; kv_dma((KPTR), (KPTR) + (VDELTA), (PITCH), lds + 16384, wu_, lane); } \
    asm volatile("s_waitcnt vmcnt(0)" ::: "memory"); __syncthreads(); \
    _Pragma("unroll 1") for (int ip_ = 0; ip_ < np_; ++ip_) { LDSP unsigned char* cur0_ = lds + (ip_ & 1) * 32768; LDSP unsigned char* nxt0_ = lds + ((ip_ + 1) & 1) * 32768; \
        if (ip_ + 1 < np_) { { const int i = 2 * ip_ + 2; kv_dma((KPTR), (KPTR) + (VDELTA), (PITCH), nxt0_, wu_, lane); } \
                             { const int i = (2 * ip_ + 3 < nt_) ? 2 * ip_ + 3 : 2 * ip_ + 2; kv_dma((KPTR), (KPTR) + (VDELTA), (PITCH), nxt0_ + 16384, wu_, lane); } } \
        if (2 * ip_ + 1 < nt_) { const TP ta_ = TPF(2 * ip_), tb_ = TPF(2 * ip_ + 1); \
            if (ta_.nm || tb_.nm) attn_pair_fast<true>(st, qf, cur0_, cur0_ + 16384, lane, ta_, tb_); else attn_pair_fast<false>(st, qf, cur0_, cur0_ + 16384, lane, ta_, tb_); } \
        else { const TP ta_ = TPF(2 * ip_); attn_tile<0>(st, qf, cur0_, lane, ta_.rowoff, ta_.kl, ta_.kh, ta_.nm, 0.f, nullptr, nullptr, 0, 0); } \
        asm volatile("s_waitcnt vmcnt(0)" ::: "memory"); \
        __syncthreads(); } } while (0)

__device__ __forceinline__ void store_ot(bf16_t* dst, const f32x16& o0, const f32x16& o1, int hi) {
#pragma unroll
    for (int qd = 0; qd < 4; ++qd) {
        u32x2 w0, w1;
        w0.x = pk2(o0[4 * qd], o0[4 * qd + 1]); w0.y = pk2(o0[4 * qd + 2], o0[4 * qd + 3]);
        w1.x = pk2(o1[4 * qd], o1[4 * qd + 1]); w1.y = pk2(o1[4 * qd + 2], o1[4 * qd + 3]);
        *(u32x2*)(dst + 8 * qd + 4 * hi) = w0; *(u32x2*)(dst + 32 + 8 * qd + 4 * hi) = w1;
    }
}

__device__ __forceinline__ void moba_unit(const Params& P, LDSP unsigned char* lds, int b, int h, int blk) {
    unsigned char* ws = P.ws;
    const int tid = opaque_tid(), lane = tid & 63, wid = tid >> 6, r32 = lane & 31, hi = lane >> 5;
    const bf16_t* qa = (const bf16_t*)(ws + OFF_R1);
    const bf16_t* ka = (const bf16_t*)(ws + OFF_R1 + 32 * MiB);
    const bf16_t* va = (const bf16_t*)(ws + OFF_R1 + 64 * MiB);
    bf16_t* ya = (bf16_t*)(ws + OFF_YA);
    const float* kmean = (const float*)(ws + OFF_KMEAN) + (size_t)((b * 8 + h) * 16) * 64;
    LDSP float* km = (LDSP float*)(lds + A_MISC);
    LDSP unsigned short* sel16 = (LDSP unsigned short*)(lds + A_MISC + 4096);
    __syncthreads();
    for (int i = tid; i < blk * 64; i += NTHREADS) km[i] = kmean[i];
    __syncthreads();
    {
        const int qi = tid >> 1, hf = tid & 1;
        const bf16_t* qrow = qa + (size_t)(b * SEQ + blk * 256 + qi) * 512 + h * 64 + hf * 32;
        float q[32];
#pragma unroll
        for (int c = 0; c < 4; ++c) { float f[8]; cvt8(*(const u32x4*)(qrow + c * 8), f);
#pragma unroll
            for (int i = 0; i < 8; ++i) q[c * 8 + i] = f[i]; }
        float g0 = -INFINITY, g1 = -INFINITY, g2 = -INFINITY; int i0 = -1, i1 = -1, i2 = -1;
        for (int j = 0; j < blk; ++j) {
            float d = 0.f;
#pragma unroll
            for (int i = 0; i < 32; ++i) d += q[i] * km[j * 64 + hf * 32 + i];
            d += __shfl_xor(d, 1);
            if (d > g0) { g2 = g1; i2 = i1; g1 = g0; i1 = i0; g0 = d; i0 = j; }
            else if (d > g1) { g2 = g1; i2 = i1; g1 = d; i1 = j; }
            else if (d > g2) { g2 = d; i2 = j; }
        }
        unsigned mask = 0;
        if (i0 >= 0) mask |= 1u << i0;
        if (i1 >= 0) mask |= 1u << i1;
        if (i2 >= 0) mask |= 1u << i2;
        if (hf == 0) sel16[qi] = (unsigned short)mask;
    }
    __syncthreads();
    const int qloc = wid * 32 + r32;
    const size_t qrow_g = (size_t)(b * SEQ + blk * 256 + qloc);
    bf16x8 qf[4];
#pragma unroll
    for (int d0 = 0; d0 < 4; ++d0) qf[d0] = *(const bf16x8*)(qa + qrow_g * 512 + h * 64 + d0 * 16 + hi * 8);
    const unsigned selbits = sel16[qloc];
    ASt st; ast_reset(st);
    const bf16_t* kbase = ka + (size_t)(b * SEQ) * 512 + h * 64;
    const bf16_t* vbase = va + (size_t)(b * SEQ) * 512 + h * 64;
    auto moba_tp = [=](int ti) -> TP { const int jb = ti >> 2, t4 = ti & 3; const bool past = jb < blk;
        int l_ = lane; asm volatile("" : "+v"(l_)); const int w_ = __builtin_amdgcn_readfirstlane(wid), ql_ = w_ * 32 + (l_ & 31);
        TP t; t.rowoff = past ? !((selbits >> jb) & 1u) : (64 * t4 > ql_); t.nm = !past && (64 * t4 + 63 > w_ * 32); t.kl = 0; t.kh = past ? 63 : ql_ - 64 * t4; return t; };
    KV_LOOP_PAIR(4 * (blk + 1), kbase + (size_t)i * 64 * 512, (size_t)16 * 1024 * 1024, 512, moba_tp);
    const float lt = st.l + swap32f(st.l);
    const float inv = 1.0f / lt;
#pragma unroll
    for (int r = 0; r < 16; ++r) { st.o0[r] *= inv; st.o1[r] *= inv; }
    { const int t2 = opaque_tid(), l2 = t2 & 63;
      const size_t row2 = (size_t)(b * SEQ + blk * 256 + (t2 >> 6) * 32 + (l2 & 31));
      store_ot((bf16_t*)(P.ws + OFF_YA) + row2 * 512 + h * 64, st.o0, st.o1, l2 >> 5); }
}

__device__ __forceinline__ void nsa_unit(const Params& P, LDSP unsigned char* lds, int b, int g, int c) {
    unsigned char* ws = P.ws;
    const int tid = opaque_tid(), lane = tid & 63, wid = tid >> 6, r32 = lane & 31, hi = lane >> 5;
    const bf16_t* qb = (const bf16_t*)(ws + OFF_R1 + 96 * MiB);
    const bf16_t* kc = (const bf16_t*)(ws + OFF_KC) + (size_t)(b * 2 + g) * 256 * 64;
    const bf16_t* vc = (const bf16_t*)(ws + OFF_VC) + (size_t)(b * 2 + g) * 256 * 64;
    const bf16_t* ks = (const bf16_t*)(ws + OFF_R2 + 16 * MiB) + (size_t)(b * SEQ) * 128 + g * 64;
    const bf16_t* vs = (const bf16_t*)(ws + OFF_R2 + 24 * MiB) + (size_t)(b * SEQ) * 128 + g * 64;
    const bf16_t* kw = (const bf16_t*)(ws + OFF_R2 + 32 * MiB) + (size_t)(b * SEQ) * 128 + g * 64;
    const bf16_t* vw = (const bf16_t*)(ws + OFF_R2 + 40 * MiB) + (size_t)(b * SEQ) * 128 + g * 64;
    const float* bgate = (const float*)(ws + OFF_BGATE);
    bf16_t* yb = (bf16_t*)(ws + OFF_YB);
    LDSP float* gs = (LDSP float*)(lds + A_GS);
    LDSP float* es = (LDSP float*)(lds + A_ES);
    LDSP unsigned long long* selm = (LDSP unsigned long long*)(lds + A_MISC);
    const int ql = wid * 8 + (r32 >> 2), hr = r32 & 3, head = g * 4 + hr, pos = c * 64 + ql;
    const size_t trow = (size_t)(b * SEQ + pos);
    bf16x8 qf[4];
#pragma unroll
    for (int d0 = 0; d0 < 4; ++d0) qf[d0] = *(const bf16x8*)(qb + trow * 512 + head * 64 + d0 * 16 + hi * 8);
    const int nmax = (pos >= 31) ? ((pos - 31) >> 4) : -1;
    const int ntc = ((4 * c + 2) >> 6) + 1;
    ASt st; ast_reset(st);
    __syncthreads();
    {
        const int wu_ = __builtin_amdgcn_readfirstlane(wid);
#pragma unroll 1
        for (int i = 0; i < ntc; ++i) kv_dma(kc + (size_t)i * 64 * 64, vc + (size_t)i * 64 * 64, 64, lds + i * 16384, wu_, lane);
        asm volatile("s_waitcnt vmcnt(0)" ::: "memory");
        __syncthreads();
    }
#pragma unroll 1
    for (int i = 0; i < ntc; ++i) attn_tile<1>(st, qf, lds + i * 16384, lane, nmax < 0, 0, nmax - 64 * i, true, 0.f, nullptr, nullptr, 0, 0);
    {
        const float lt = st.l + swap32f(st.l);
        const float linv = (lt > 0.f) ? 1.0f / lt : 0.f;
#pragma unroll 1
        for (int i = 0; i < ntc; ++i) attn_tile<2>(st, qf, lds + i * 16384, lane, nmax < 0, 0, nmax - 64 * i, true, linv, gs, es, 16 * i, ql);
    }
    LDSP float* yl = (LDSP float*)(lds + A_Y) + wid * 2048 + lane;
    __syncthreads();
    for (int qq = 0; qq < 8; ++qq) {
        const int q = wid * 8 + qq, j = lane;
        unsigned long long m;
        if (c < 16) m = (2ull << c) - 1ull;
        else {
            const bool cand = (j >= 1 && j <= c - 2);
            float imp = 0.f;
            if (cand) imp = gs[q * 64 + j] + es[q * 64 + j - 1];
            int rank = 0;
            for (int jp = 1; jp <= c - 2; ++jp) {
                const float o = __uint_as_float(__builtin_amdgcn_readlane(__float_as_uint(imp), jp));
                rank += (o > imp || (o == imp && jp < j)) ? 1 : 0;
            }
            const bool sel = (j == 0) || (j == c) || (j == c - 1) || (cand && rank < 13);
            m = __ballot(sel);
        }
        if (lane == 0) selm[q] = m;
    }
    __syncthreads();
    { const int t2 = opaque_tid(), l2 = t2 & 63; const size_t trow2 = (size_t)(b * SEQ + c * 64 + (t2 >> 6) * 8 + ((l2 & 31) >> 2)); const int head2 = g * 4 + (l2 & 3);
      const float gt0 = ((const float*)(P.ws + OFF_BGATE))[trow2 * 24 + head2 * 3 + 0];
#pragma unroll
    for (int r = 0; r < 16; ++r) { yl[r * 64] = gt0 * st.o0[r]; yl[(16 + r) * 64] = gt0 * st.o1[r]; } }
    const unsigned long long selmask = selm[ql];
    ast_reset(st);
    auto slc_tp = [=](int ti) -> TP { int l_ = lane; asm volatile("" : "+v"(l_)); const int ql_ = __builtin_amdgcn_readfirstlane(wid) * 8 + ((l_ & 31) >> 2);
        TP t; t.rowoff = !((selmask >> ti) & 1ull); t.nm = (ti == c); t.kl = 0; t.kh = (ti == c) ? ql_ : 63; return t; };
    KV_LOOP_PAIR(c + 1, ks + (size_t)i * 64 * 128, (size_t)4 * 1024 * 1024, 128, slc_tp);
    {
        const float lt = st.l + swap32f(st.l);
        const int t2 = opaque_tid(), l2 = t2 & 63; const size_t trow2 = (size_t)(b * SEQ + c * 64 + (t2 >> 6) * 8 + ((l2 & 31) >> 2)); const int head2 = g * 4 + (l2 & 3);
        LDSP float* yl = (LDSP float*)(lds + A_Y) + (t2 >> 6) * 2048 + l2;
        const float sc = ((const float*)(P.ws + OFF_BGATE))[trow2 * 24 + head2 * 3 + 1] / lt;
#pragma unroll
        for (int r = 0; r < 16; ++r) { yl[r * 64] += sc * st.o0[r]; yl[(16 + r) * 64] += sc * st.o1[r]; }
    }
    ast_reset(st);
    const int j0 = (c >= 8) ? c - 8 : 0;
    auto win_tp = [=](int ti) -> TP { const int j = j0 + ti; const bool first = (j == c - 8), own = (j == c);
        int l_ = lane; asm volatile("" : "+v"(l_)); const int ql_ = __builtin_amdgcn_readfirstlane(wid) * 8 + ((l_ & 31) >> 2);
        TP t; t.rowoff = false; t.nm = first || own; t.kl = first ? ql_ + 1 : 0; t.kh = own ? ql_ : 63; return t; };
    KV_LOOP_PAIR(c - j0 + 1, kw + (size_t)(j0 + i) * 64 * 128, (size_t)4 * 1024 * 1024, 128, win_tp);
    {
        const float lt = st.l + swap32f(st.l);
        const int t2 = opaque_tid(), l2 = t2 & 63; const size_t trow2 = (size_t)(b * SEQ + c * 64 + (t2 >> 6) * 8 + ((l2 & 31) >> 2)); const int head2 = g * 4 + (l2 & 3);
        LDSP float* yl = (LDSP float*)(lds + A_Y) + (t2 >> 6) * 2048 + l2;
        const float sc = ((const float*)(P.ws + OFF_BGATE))[trow2 * 24 + head2 * 3 + 2] / lt;
        f32x16 y0, y1;
#pragma unroll
        for (int r = 0; r < 16; ++r) { y0[r] = yl[r * 64] + sc * st.o0[r]; y1[r] = yl[(16 + r) * 64] + sc * st.o1[r]; }
        store_ot((bf16_t*)(P.ws + OFF_YB) + trow2 * 512 + head2 * 64, y0, y1, l2 >> 5);
    }
}

__device__ __forceinline__ void phase_attn(const Params& P, LDSP unsigned char* lds, int vcu, int G) {
    const int nloc = (G == 256) ? 8 : (2048 - vcu + G - 1) / G;
    for (int k = 0; k < nloc; ++k) {
        int u;
        if (G == 256) {
            const int kk = k >> 1;
            if (!(k & 1)) { const int bh = vcu >> 2, jm = vcu & 3; const int blk = (kk == 0) ? 15 - jm : (kk == 1) ? 8 + jm : (kk == 2) ? 7 - jm : jm; u = bh * 16 + blk; }
            else { const int bg = vcu >> 4, jn = vcu & 15; const int c = (kk == 0) ? 63 - jn : (kk == 1) ? 32 + jn : (kk == 2) ? 31 - jn : jn; u = 1024 + bg * 64 + c; }
        } else u = vcu + k * G;
        if (u < 1024) moba_unit(P, lds, u >> 7, (u >> 4) & 7, u & 15);
        else { const int v = u - 1024; nsa_unit(P, lds, v >> 7, (v >> 6) & 1, v & 63); }
    }
}

struct EpiUp {
    const Params* P;
    __device__ __forceinline__ void operator()(f32x4 (&acc)[2][2][4][2], const pg8::Unit& u, int wr, int wc, int fr, int fq) const {
        const unsigned char* g8 = P->ws + OFF_R3;
        bf16_t* mg = (bf16_t*)(P->ws + OFF_MERGED);
        u32x2 gg[2][2][2]; u32x4 pp[2][2][2];
#define EU_LOAD(S) do { _Pragma("unroll") for (int mm = 0; mm < 2; ++mm) _Pragma("unroll") for (int bj = 0; bj < 2; ++bj) { \
            const size_t row_ = (size_t)(u.pm * 256 + ((S) >> 1) * 128 + wr * 64 + (2 * ((S) & 1) + mm) * 16 + fr); const int col_ = u.pn * 256 + bj * 128 + wc * 32 + 8 * fq; \
            gg[(S) & 1][mm][bj] = *(const u32x2*)(g8 + row_ * 2048 + (u.z ? 1024 : 0) + col_); pp[(S) & 1][mm][bj] = (u32x4){0u, 0u, 0u, 0u}; if (u.z) pp[(S) & 1][mm][bj] = *(const u32x4*)(mg + row_ * 1024 + col_); } } while (0)
        EU_LOAD(0);
#pragma unroll
        for (int s = 0; s < 4; ++s) {
            if (s + 1 < 4) EU_LOAD(s + 1);
            const int ai = s >> 1;
#pragma unroll
            for (int mm = 0; mm < 2; ++mm) {
                const int m = 2 * (s & 1) + mm;
                const int row = u.pm * 256 + ai * 128 + wr * 64 + m * 16 + fr;
#pragma unroll
                for (int bj = 0; bj < 2; ++bj) {
                    bf16_t* rp = mg + (size_t)row * 1024 + u.pn * 256 + bj * 128 + wc * 32 + 8 * fq;
                    const u32x2 gq = gg[s & 1][mm][bj];
                    float gf[8];
                    gf[0] = (float)(gq.x & 0xFFu); gf[1] = (float)((gq.x >> 8) & 0xFFu); gf[2] = (float)((gq.x >> 16) & 0xFFu); gf[3] = (float)(gq.x >> 24);
                    gf[4] = (float)(gq.y & 0xFFu); gf[5] = (float)((gq.y >> 8) & 0xFFu); gf[6] = (float)((gq.y >> 16) & 0xFFu); gf[7] = (float)(gq.y >> 24);
                    float pf[8]; cvt8(pp[s & 1][mm][bj], pf);
                    float o[8];
#pragma unroll
                    for (int n = 0; n < 2; ++n)
#pragma unroll
                        for (int i = 0; i < 4; ++i) o[4 * n + i] = __builtin_fmaf(gf[4 * n + i] * (1.0f / 255.0f), acc[ai][bj][m][n][i], pf[4 * n + i]);
                    u32x4 w; w.x = pk2(o[0], o[1]); w.y = pk2(o[2], o[3]); w.z = pk2(o[4], o[5]); w.w = pk2(o[6], o[7]);
                    *(u32x4*)rp = w;
                }
            }
        }
#undef EU_LOAD
    }
};
__device__ __forceinline__ void phase_up(const Params& P, LDSP unsigned char* lds, int vcu, int G) {
    pg8::Sched S; S.A0 = (const bf16_t*)(P.ws + OFF_YA); S.A1 = (const bf16_t*)(P.ws + OFF_YB);
    S.B0 = (const bf16_t*)(P.ws + OFF_WUPA_T); S.B1 = (const bf16_t*)(P.ws + OFF_WUPB_T);
    S.lda = 512; S.ldb = 512; S.K = 512; S.nM = T / 256; S.nN = DM / 256; S.NZ = 2; S.G = G; S.c = blockIdx.x;
    EpiUp E{&P};
    pg8::gemm_phase(lds, S, E);
}

struct EpiOut {
    const Params* P;
    __device__ __forceinline__ void operator()(f32x4 (&acc)[2][2][4][2], const pg8::Unit& u, int wr, int wc, int fr, int fq) const {
        bf16_t* x1b = (bf16_t*)(P->ws + OFF_R0);
        float* rs2 = (float*)(P->ws + OFF_RS2);
        u32x4 xall[2][4][2];
#pragma unroll
        for (int ai = 0; ai < 2; ++ai)
#pragma unroll
            for (int m = 0; m < 4; ++m)
#pragma unroll
                for (int bj = 0; bj < 2; ++bj) xall[ai][m][bj] = *(const u32x4*)(x1b + (size_t)(u.pm * 256 + ai * 128 + wr * 64 + m * 16 + fr) * DM + u.pn * 256 + bj * 128 + wc * 32 + 8 * fq);
#pragma unroll
        for (int ai = 0; ai < 2; ++ai)
#pragma unroll
            for (int m = 0; m < 4; ++m) {
                const int row = u.pm * 256 + ai * 128 + wr * 64 + m * 16 + fr;
                float ss = 0.f;
                u32x4 xv[2] = {xall[ai][m][0], xall[ai][m][1]};
#pragma unroll
                for (int bj = 0; bj < 2; ++bj) {
                    const size_t off = (size_t)row * DM + u.pn * 256 + bj * 128 + wc * 32 + 8 * fq;
                    f32x4 o0, o1;
                    o0.x = bf_lo(xv[bj].x) + acc[ai][bj][m][0].x; o0.y = bf_hi(xv[bj].x) + acc[ai][bj][m][0].y;
                    o0.z = bf_lo(xv[bj].y) + acc[ai][bj][m][0].z; o0.w = bf_hi(xv[bj].y) + acc[ai][bj][m][0].w;
                    o1.x = bf_lo(xv[bj].z) + acc[ai][bj][m][1].x; o1.y = bf_hi(xv[bj].z) + acc[ai][bj][m][1].y;
                    o1.z = bf_lo(xv[bj].w) + acc[ai][bj][m][1].z; o1.w = bf_hi(xv[bj].w) + acc[ai][bj][m][1].w;
                    u32x4 w; w.x = pk2(o0.x, o0.y); w.y = pk2(o0.z, o0.w); w.z = pk2(o1.x, o1.y); w.w = pk2(o1.z, o1.w);
                    *(u32x4*)(x1b + off) = w;
                    ss += ((o0.x * o0.x + o0.y * o0.y) + (o0.z * o0.z + o0.w * o0.w)) + ((o1.x * o1.x + o1.y * o1.y) + (o1.z * o1.z + o1.w * o1.w));
                }
                ss = sum_xor16(ss); ss = sum_xor32(ss);
                if (fq == 0) atomicAdd(rs2 + row, ss);
            }
    }
};
__device__ __forceinline__ void phase_out(const Params& P, LDSP unsigned char* lds, int vcu, int G) {
    pg8::Sched S; S.A0 = S.A1 = (const bf16_t*)(P.ws + OFF_MERGED); S.B0 = S.B1 = (const bf16_t*)(P.ws + OFF_WOUT_T);
    S.lda = 1024; S.ldb = DM; S.K = DM; S.nM = T / 256; S.nN = DM / 256; S.NZ = 1; S.G = G; S.c = blockIdx.x;
    EpiOut E{&P};
    pg8::gemm_phase(lds, S, E);
}

struct EpiPq {
    const Params* P;
    __device__ __forceinline__ void operator()(f32x4 (&acc)[2][2][4][2], const pg8::Unit& u, int wr, int wc, int fr, int fq) const {
        bf16_t* qp = (bf16_t*)(P->ws + OFF_R1);
        const float* rs2 = (const float*)(P->ws + OFF_RS2);
        float rr[2][4];
#pragma unroll
        for (int ai = 0; ai < 2; ++ai)
#pragma unroll
            for (int m = 0; m < 4; ++m) rr[ai][m] = __builtin_amdgcn_rsqf(rs2[u.pm * 256 + ai * 128 + wr * 64 + m * 16 + fr] * (1.0f / DM) + NORM_EPS);
#pragma unroll
        for (int ai = 0; ai < 2; ++ai)
#pragma unroll
            for (int m = 0; m < 4; ++m) {
                const int row = u.pm * 256 + ai * 128 + wr * 64 + m * 16 + fr;
                const float r = rr[ai][m];
#pragma unroll
                for (int bj = 0; bj < 2; ++bj) {
                    const f32x4 a0 = acc[ai][bj][m][0], a1 = acc[ai][bj][m][1];
                    u32x4 w; w.x = pk2(a0[0] * r, a0[1] * r); w.y = pk2(a0[2] * r, a0[3] * r); w.z = pk2(a1[0] * r, a1[1] * r); w.w = pk2(a1[2] * r, a1[3] * r);
                    *(u32x4*)(qp + (size_t)row * 2048 + u.pn * 256 + bj * 128 + wc * 32 + 8 * fq) = w;
                }
            }
    }
};
__device__ __forceinline__ void phase_pq(const Params& P, LDSP unsigned char* lds, int vcu, int G) {
    pg8::Sched S; S.A0 = S.A1 = (const bf16_t*)(P.ws + OFF_R0); S.B0 = S.B1 = (const bf16_t*)(P.ws + OFF_WPQ_T);
    S.lda = DM; S.ldb = DM; S.K = DM; S.nM = T / 256; S.nN = 2048 / 256; S.NZ = 1; S.G = G; S.c = blockIdx.x;
    EpiPq E{&P};
    pg8::gemm_phase(lds, S, E);
}

__device__ __forceinline__ unsigned f2ord(float f) { const unsigned u = __float_as_uint(f); return u ^ ((unsigned)((int)u >> 31) | 0x80000000u); }
__device__ __forceinline__ float ord2f(unsigned o) { const unsigned u = (o & 0x80000000u) ? (o ^ 0x80000000u) : ~o; return __uint_as_float(u); }
__device__ __forceinline__ void ins16(unsigned (&top)[16], unsigned x) {
#pragma unroll
    for (int j = 0; j < 16; ++j) { const unsigned t = max(x, top[j]); x = min(x, top[j]); top[j] = t; }
}
__device__ __forceinline__ int crow(int r, int hi) { return (r & 3) + 8 * (r >> 2) + 4 * hi; }
__device__ __forceinline__ void ce_desc(unsigned& a, unsigned& b) { const unsigned hi_ = max(a, b), lo_ = min(a, b); a = hi_; b = lo_; }
__device__ __forceinline__ void bitonic_merge16_desc(unsigned (&a)[16]) {
#pragma unroll
    for (int j = 8; j > 0; j >>= 1)
#pragma unroll
        for (int i = 0; i < 16; ++i) { const int l = i ^ j; if (l > i) ce_desc(a[i], a[l]); }
}
__device__ __forceinline__ void sort16_desc(unsigned (&a)[16]) {
#pragma unroll
    for (int k = 2; k <= 16; k <<= 1)
#pragma unroll
        for (int j = k >> 1; j > 0; j >>= 1)
#pragma unroll
            for (int i = 0; i < 16; ++i) { const int l = i ^ j; if (l > i) { if ((i & k) == 0) ce_desc(a[i], a[l]); else ce_desc(a[l], a[i]); } }
}
__device__ __forceinline__ void merge_top16(unsigned (&top)[16], const unsigned (&blk)[16]) {
#pragma unroll
    for (int i = 0; i < 16; ++i) top[i] = max(top[i], blk[15 - i]);
    bitonic_merge16_desc(top);
}
constexpr int cand_prefix(int i) { int n = 0; for (int a = 0; a < i; ++a) n += 16 / (a + 1); return n; }

constexpr int P8_KOFF = 0, P8_IDX = 65536;
__device__ __forceinline__ void phase_topk(const Params& P, LDSP unsigned char* lds, int vcu, int G) {
    unsigned char* ws = P.ws;
    const bf16_t* qp = (const bf16_t*)(ws + OFF_R1);
    int* experts = (int*)(ws + OFF_EXPERTS);
    float* gates = (float*)(ws + OFF_GATES);
    const int tid = opaque_tid(), lane = tid & 63, wave = tid >> 6, r32 = lane & 31, hi = lane >> 5;
    {
        static_assert(2 * 128 * 16 == 8 * NTHREADS, "sub-key staging: eight 16-byte pieces per thread");
        u32x4 kvv[8];
#pragma unroll
        for (int q = 0; q < 8; ++q) { const int i = tid + NTHREADS * q, w = i >> 11, row = (i >> 4) & 127, ch = i & 15;
            kvv[q] = *(const u32x4*)((const bf16_t*)(ws + (w ? OFF_K2B : OFF_K1B)) + row * 128 + ch * 8); }
#pragma unroll
        for (int q = 0; q < 8; ++q) { const int i = tid + NTHREADS * q, w = i >> 11, row = (i >> 4) & 127, ch = i & 15;
            *(LDSP u32x4*)(lds + P8_KOFF + w * 32768 + row * 256 + ((ch ^ (row & 15)) << 4)) = kvv[q]; }
    }
    __syncthreads();
    LDSP unsigned char* myidx = lds + P8_IDX + (wave * 64 + lane) * 32;
    const int gw = vcu * NWAVES + wave, NGW = G * NWAVES;
    for (int item = gw; item < (T / 32) * 8; item += NGW) {
        const int tg = item >> 3, h = item & 7;
        const int tok = tg * 32 + r32;
        unsigned tops[2][16];
#pragma unroll
        for (int L = 0; L < 2; ++L) {
            bf16x8 qf[8];
            const bf16_t* qrow = qp + (size_t)tok * 2048 + h * 256 + L * 128 + hi * 8;
#pragma unroll
            for (int s8 = 0; s8 < 8; ++s8) qf[s8] = *(const bf16x8*)(qrow + s8 * 16);
            unsigned top[16];
#pragma unroll
            for (int kb = 0; kb < 4; ++kb) {
                f32x16 acc = {0.f, 0.f, 0.f, 0.f, 0.f, 0.f, 0.f, 0.f, 0.f, 0.f, 0.f, 0.f, 0.f, 0.f, 0.f, 0.f};
                const int row = kb * 32 + r32;
#pragma unroll
                for (int s8 = 0; s8 < 8; ++s8) {
                    const bf16x8 kf = *(const LDSP bf16x8*)(lds + P8_KOFF + L * 32768 + row * 256 + (((2 * s8 + hi) ^ (row & 15)) << 4));
                    acc = __builtin_amdgcn_mfma_f32_32x32x16_bf16(kf, qf[s8], acc, 0, 0, 0);
                }
                unsigned blk[16];
#pragma unroll
                for (int r = 0; r < 16; ++r) {
                    const int key = kb * 32 + (r & 3) + 8 * (r >> 2) + 4 * hi;
                    blk[r] = (f2ord(acc[r]) & ~0x7Fu) | (unsigned)(127 - key);
                }
                sort16_desc(blk);
                if (kb == 0) {
#pragma unroll
                    for (int j = 0; j < 16; ++j) top[j] = blk[j];
                } else merge_top16(top, blk);
            }
            unsigned oth[16];
#pragma unroll
            for (int j = 0; j < 16; ++j) oth[j] = (unsigned)__shfl_xor((int)top[j], 32);
            merge_top16(top, oth);
#pragma unroll
            for (int j = 0; j < 16; ++j) tops[L][j] = top[j];
        }
        float v1[16], v2[16];
#pragma unroll
        for (int j = 0; j < 16; j += 4) {
            unsigned w1 = 0, w2 = 0;
#pragma unroll
            for (int q = 0; q < 4; ++q) { w1 |= (127u - (tops[0][j + q] & 127u)) << (8 * q); w2 |= (127u - (tops[1][j + q] & 127u)) << (8 * q); }
            *(LDSP unsigned*)(myidx + j) = w1; *(LDSP unsigned*)(myidx + 16 + j) = w2;
        }
#pragma unroll
        for (int j = 0; j < 16; ++j) { v1[j] = ord2f(tops[0][j] & ~0x7Fu); v2[j] = ord2f(tops[1][j] & ~0x7Fu); }
        unsigned ct[16];
        {
            unsigned blk0[16], blk1[16];
            { const float a_ = hi ? v1[0] : v1[0], b_ = hi ? v2[1] : v2[0]; blk0[0] = (f2ord(a_ + b_) & ~0xFFu) | (unsigned)(hi ? 254 : 255); }
            { const float a_ = hi ? v1[0] : v1[0], b_ = hi ? v2[3] : v2[2]; blk0[1] = (f2ord(a_ + b_) & ~0xFFu) | (unsigned)(hi ? 252 : 253); }
            { const float a_ = hi ? v1[0] : v1[0], b_ = hi ? v2[5] : v2[4]; blk0[2] = (f2ord(a_ + b_) & ~0xFFu) | (unsigned)(hi ? 250 : 251); }
            { const float a_ = hi ? v1[0] : v1[0], b_ = hi ? v2[7] : v2[6]; blk0[3] = (f2ord(a_ + b_) & ~0xFFu) | (unsigned)(hi ? 248 : 249); }
            { const float a_ = hi ? v1[0] : v1[0], b_ = hi ? v2[9] : v2[8]; blk0[4] = (f2ord(a_ + b_) & ~0xFFu) | (unsigned)(hi ? 246 : 247); }
            { const float a_ = hi ? v1[0] : v1[0], b_ = hi ? v2[11] : v2[10]; blk0[5] = (f2ord(a_ + b_) & ~0xFFu) | (unsigned)(hi ? 244 : 245); }
            { const float a_ = hi ? v1[0] : v1[0], b_ = hi ? v2[13] : v2[12]; blk0[6] = (f2ord(a_ + b_) & ~0xFFu) | (unsigned)(hi ? 242 : 243); }
            { const float a_ = hi ? v1[0] : v1[0], b_ = hi ? v2[15] : v2[14]; blk0[7] = (f2ord(a_ + b_) & ~0xFFu) | (unsigned)(hi ? 240 : 241); }
            { const float a_ = hi ? v1[1] : v1[1], b_ = hi ? v2[1] : v2[0]; blk0[8] = (f2ord(a_ + b_) & ~0xFFu) | (unsigned)(hi ? 238 : 239); }
            { const float a_ = hi ? v1[1] : v1[1], b_ = hi ? v2[3] : v2[2]; blk0[9] = (f2ord(a_ + b_) & ~0xFFu) | (unsigned)(hi ? 236 : 237); }
            { const float a_ = hi ? v1[1] : v1[1], b_ = hi ? v2[5] : v2[4]; blk0[10] = (f2ord(a_ + b_) & ~0xFFu) | (unsigned)(hi ? 234 : 235); }
            { const float a_ = hi ? v1[1] : v1[1], b_ = hi ? v2[7] : v2[6]; blk0[11] = (f2ord(a_ + b_) & ~0xFFu) | (unsigned)(hi ? 232 : 233); }
            { const float a_ = hi ? v1[2] : v1[2], b_ = hi ? v2[1] : v2[0]; blk0[12] = (f2ord(a_ + b_) & ~0xFFu) | (unsigned)(hi ? 222 : 223); }
            { const float a_ = hi ? v1[2] : v1[2], b_ = hi ? v2[3] : v2[2]; blk0[13] = (f2ord(a_ + b_) & ~0xFFu) | (unsigned)(hi ? 220 : 221); }
            { const float a_ = hi ? v1[3] : v1[2], b_ = hi ? v2[0] : v2[4]; blk0[14] = (f2ord(a_ + b_) & ~0xFFu) | (unsigned)(hi ? 207 : 219); }
            { const float a_ = hi ? v1[3] : v1[3], b_ = hi ? v2[2] : v2[1]; blk0[15] = (f2ord(a_ + b_) & ~0xFFu) | (unsigned)(hi ? 205 : 206); }
            { const float a_ = hi ? v1[4] : v1[3], b_ = hi ? v2[0] : v2[3]; blk1[0] = (f2ord(a_ + b_) & ~0xFFu) | (unsigned)(hi ? 191 : 204); }
            { const float a_ = hi ? v1[4] : v1[4], b_ = hi ? v2[2] : v2[1]; blk1[1] = (f2ord(a_ + b_) & ~0xFFu) | (unsigned)(hi ? 189 : 190); }
            { const float a_ = hi ? v1[5] : v1[5], b_ = hi ? v2[1] : v2[0]; blk1[2] = (f2ord(a_ + b_) & ~0xFFu) | (unsigned)(hi ? 174 : 175); }
            { const float a_ = hi ? v1[6] : v1[6], b_ = hi ? v2[1] : v2[0]; blk1[3] = (f2ord(a_ + b_) & ~0xFFu) | (unsigned)(hi ? 158 : 159); }
            { const float a_ = hi ? v1[7] : v1[7], b_ = hi ? v2[1] : v2[0]; blk1[4] = (f2ord(a_ + b_) & ~0xFFu) | (unsigned)(hi ? 142 : 143); }
            { const float a_ = hi ? v1[9] : v1[8], b_ = hi ? v2[0] : v2[0]; blk1[5] = (f2ord(a_ + b_) & ~0xFFu) | (unsigned)(hi ? 111 : 127); }
            { const float a_ = hi ? v1[11] : v1[10], b_ = hi ? v2[0] : v2[0]; blk1[6] = (f2ord(a_ + b_) & ~0xFFu) | (unsigned)(hi ? 79 : 95); }
            { const float a_ = hi ? v1[13] : v1[12], b_ = hi ? v2[0] : v2[0]; blk1[7] = (f2ord(a_ + b_) & ~0xFFu) | (unsigned)(hi ? 47 : 63); }
            { const float a_ = hi ? v1[15] : v1[14], b_ = hi ? v2[0] : v2[0]; blk1[8] = (f2ord(a_ + b_) & ~0xFFu) | (unsigned)(hi ? 15 : 31); }
            blk1[9] = 0u;
            blk1[10] = 0u;
            blk1[11] = 0u;
            blk1[12] = 0u;
            blk1[13] = 0u;
            blk1[14] = 0u;
            blk1[15] = 0u;
            sort16_desc(blk0); sort16_desc(blk1);
#pragma unroll
            for (int j = 0; j < 16; ++j) ct[j] = blk0[j];
            merge_top16(ct, blk1);
            unsigned oth[16];
#pragma unroll
            for (int j = 0; j < 16; ++j) oth[j] = (unsigned)__shfl_xor((int)ct[j], 32);
            merge_top16(ct, oth);
        }
        float vals[16], ssum = 0.f;
        const float vmax = ord2f(ct[0] & ~0xFFu);
#pragma unroll
        for (int k = 0; k < 16; ++k) { vals[k] = __expf(ord2f(ct[k] & ~0xFFu) - vmax); ssum += vals[k]; }
        const float inv = 1.0f / ssum;
        asm volatile("s_waitcnt lgkmcnt(0)" ::: "memory");
        if (hi == 0) {
            int* ep = experts + (size_t)tok * 128 + h * 16;
            int* etp = (int*)(ws + OFF_ET) + (size_t)tok * 128 + 2 * h;
            int eall[16];
#pragma unroll
            for (int k = 0; k < 16; k += 4) {
                int e4[4];
#pragma unroll
                for (int q = 0; q < 4; ++q) {
                    const unsigned flat = 255u - (ct[k + q] & 255u);
                    const int i1 = myidx[flat >> 4], i2 = myidx[16 + (flat & 15)];
                    e4[q] = i1 * 128 + i2;
                }
                *(u32x4*)(ep + k) = (u32x4){(unsigned)e4[0] | pk2(0.f, vals[k] * inv), (unsigned)e4[1] | pk2(0.f, vals[k + 1] * inv), (unsigned)e4[2] | pk2(0.f, vals[k + 2] * inv), (unsigned)e4[3] | pk2(0.f, vals[k + 3] * inv)};
#pragma unroll
                for (int q = 0; q < 4; ++q) eall[k + q] = e4[q];
            }
#pragma unroll
            for (int g8 = 0; g8 < 8; ++g8) *(u32x2*)(etp + g8 * 16) = (u32x2){(unsigned)eall[g8], (unsigned)eall[g8 + 8]};
        }
        asm volatile("s_waitcnt lgkmcnt(0)" ::: "memory");
    }
}

__device__ __forceinline__ void peer_slice_map(const Params& P, LDSP unsigned char* lds, int vcu, int G, int wave, int& slice, int& half, int& wslot, int& nslot) {
    volatile LDSP unsigned* bst = (volatile LDSP unsigned*)(lds + LDS_BYTES - 16);
    LDSP unsigned* info = (LDSP unsigned*)(lds + LDS_BYTES - 64);
    __syncthreads();
    if (threadIdx.x == 0) {
        unsigned* bar = (unsigned*)(P.ws + 16384);
        const unsigned x = (unsigned)__builtin_amdgcn_s_getreg((3 << 11) | 20) & 0xFu;
        bool ok = true; unsigned sum = 0, mine = 0;
        for (unsigned j = 0; j < 16; ++j) { const unsigned c = __hip_atomic_load(&bar[256 + 64 * j], __ATOMIC_RELAXED, __HIP_MEMORY_SCOPE_AGENT); sum += c; if (j < 8 && c == 0) ok = false; if (j >= 8 && c != 0) ok = false; if (j == x) mine = c; }
        ok = ok && (sum == (unsigned)G) && (bst[2] < mine);
        info[0] = ok ? 1u : 0u; info[1] = x; info[2] = mine; info[3] = bst[2];
    }
    __syncthreads();
    if (info[0]) { slice = (int)(info[1] & 3u); half = (int)(info[1] >> 2); wslot = (int)info[3] * NWAVES + wave; nslot = (int)info[2] * NWAVES; }
    else if ((G & 7) == 0) { const int g8 = vcu / (G >> 3); slice = g8 & 3; half = g8 >> 2; wslot = (vcu % (G >> 3)) * NWAVES + wave; nslot = (G >> 3) * NWAVES; }
    else { slice = -1; half = 0; wslot = vcu * NWAVES + wave; nslot = G * NWAVES; }
}
struct PeerMetaA { int eA, eB; u32x4 h0, h1, h2, h3; float ss; };
struct PeerMetaB { int eA, eB; float aA, aB; };
#define PEER_IDX(m, j) __shfl(((j) < 8) ? (m).eA : (m).eB, (8 * (j) + grp) & 63)
__device__ __forceinline__ float dpp_xor1(float v) { return __builtin_bit_cast(float, __builtin_amdgcn_mov_dpp(__builtin_bit_cast(int, v), 0xB1, 0xF, 0xF, true)); }
__device__ __forceinline__ float dpp_xor2(float v) { return __builtin_bit_cast(float, __builtin_amdgcn_mov_dpp(__builtin_bit_cast(int, v), 0x4E, 0xF, 0xF, true)); }
__device__ __forceinline__ float dpp_hmirror(float v) { return __builtin_bit_cast(float, __builtin_amdgcn_mov_dpp(__builtin_bit_cast(int, v), 0x141, 0xF, 0xF, true)); }
__device__ __forceinline__ float dpp_ror8(float v) { return __builtin_bit_cast(float, __builtin_amdgcn_mov_dpp(__builtin_bit_cast(int, v), 0x128, 0xF, 0xF, true)); }
__device__ __forceinline__ float swap32_sum(float X, float Y) {
    const auto r = __builtin_amdgcn_permlane32_swap(__float_as_uint(X), __float_as_uint(Y), false, false);
    return __uint_as_float(r[0]) + __uint_as_float(r[1]);
}
__device__ __forceinline__ float swap16_sum(float X, float Y) {
    const auto r = __builtin_amdgcn_permlane16_swap(__float_as_uint(X), __float_as_uint(Y), false, false);
    return __uint_as_float(r[0]) + __uint_as_float(r[1]);
}
__device__ __forceinline__ void cvt32_fp4_pk(const u32x4 w, f32x2 (&f)[16]) {
#pragma unroll
    for (int q = 0; q < 4; ++q) {
        f[4 * q]     = __builtin_amdgcn_cvt_scalef32_pk_f32_fp4(w[q], 1.0f, 0); f[4 * q + 1] = __builtin_amdgcn_cvt_scalef32_pk_f32_fp4(w[q], 1.0f, 1);
        f[4 * q + 2] = __builtin_amdgcn_cvt_scalef32_pk_f32_fp4(w[q], 1.0f, 2); f[4 * q + 3] = __builtin_amdgcn_cvt_scalef32_pk_f32_fp4(w[q], 1.0f, 3);
    }
}
#define PA_T(it) ((slice >= 0) ? (2 * (it) + half) : ((it) >> 2))
#define PA_X(it) ((slice >= 0) ? slice : ((it) & 3))
__device__ __forceinline__ void phase_peer_a(const Params& P, LDSP unsigned char* lds, int vcu, int G) {
    unsigned char* ws = P.ws;
    const bf16_t* x1b = (const bf16_t*)(ws + OFF_R0);
    const float* rs2 = (const float*)(ws + OFF_RS2);
    const unsigned char* U4 = ws + OFF_U;
    const int* experts = (const int*)(ws + OFF_EXPERTS);
    float* apart = (float*)(ws + OFF_R1);
    const int tid = opaque_tid(), lane = tid & 63, wave = tid >> 6, grp = lane >> 3, sub = lane & 7;
    const bool b2 = lane & 4, b1 = lane & 2, b0 = lane & 1;
    int slice, half, wslot, nslot;
    peer_slice_map(P, lds, vcu, G, wave, slice, half, wslot, nslot);
    const int nitems = (slice >= 0) ? T / 2 : T * 4;
#define PA_META(m, it) do { const int it_ = ((it) < nitems) ? (it) : wslot; { const int t_ = PA_T(it_), x_ = PA_X(it_); \
        (m).eA = experts[(size_t)t_ * 128 + lane] & 0xFFFF; (m).eB = experts[(size_t)t_ * 128 + 64 + lane] & 0xFFFF; const u32x4* hp_ = (const u32x4*)(x1b + (size_t)t_ * DM + 256 * x_ + 32 * sub); \
        (m).h0 = __builtin_nontemporal_load(hp_); (m).h1 = __builtin_nontemporal_load(hp_ + 1); (m).h2 = __builtin_nontemporal_load(hp_ + 2); (m).h3 = __builtin_nontemporal_load(hp_ + 3); (m).ss = rs2[t_]; } } while (0)
#define PA_GATHER(R, m, it, J0) do { const int x_ = PA_X(it); _Pragma("unroll") for (int j = 0; j < 8; ++j) { const int e_ = PEER_IDX(m, (J0) + j); \
        (R)[j] = *(const u32x4*)(U4 + (((unsigned)x_ * (unsigned)PEER_NE + (unsigned)e_) * 128u + 16u * (unsigned)sub)); } } while (0)
#define PA_COMPUTE(R, J0) do { _Pragma("unroll") for (int j = 0; j < 8; ++j) { asm volatile("" : "+v"((R)[j])); int ah = 0, al = 0; \
        _Pragma("unroll") for (int q = 0; q < 4; ++q) { ah = __builtin_amdgcn_sdot8((int)(R)[j][q], (int)HQ[q], ah, false); al = __builtin_amdgcn_sdot8((int)(R)[j][q], (int)LQ[q], al, false); } \
        part[(J0) + j] = (float)(ah * 16 + al); asm volatile("" : "+v"(part[(J0) + j])); } } while (0)
    PeerMetaA m0, m1, m2;
    m0.eA = m0.eB = m1.eA = m1.eB = m2.eA = m2.eB = 0; m0.ss = m1.ss = m2.ss = 1.f;
    m0.h0 = m0.h1 = m0.h2 = m0.h3 = m1.h0 = m1.h1 = m1.h2 = m1.h3 = m2.h0 = m2.h1 = m2.h2 = m2.h3 = (u32x4){0u, 0u, 0u, 0u};
    u32x4 R0[8], R1[8];
    PA_META(m0, wslot); PA_META(m1, wslot + nslot);
    if (wslot >= nitems) return;
    PA_GATHER(R0, m0, wslot, 0); PA_GATHER(R1, m0, wslot, 8);
#pragma unroll 1
    for (int it = wslot; it < nitems; it += nslot) {
        PA_META(m2, it + 2 * nslot);
        unsigned HQ[4], LQ[4]; float part[16];
        { const float inv = (119.0f / 8.0f) * __builtin_amdgcn_rsqf(m0.ss * (1.0f / DM) + NORM_EPS); const f32x2 inv2 = {inv, inv}, magic2 = {12582920.0f, 12582920.0f};
          typedef short s16x2 __attribute__((ext_vector_type(2)));
          const s16x2 lo2 = {(short)-112, (short)-112}, hi2 = {(short)127, (short)127};
          constexpr unsigned M = 0x000F000Fu;
#define PA_H(Q, W) do { unsigned p_[4]; _Pragma("unroll") for (int w = 0; w < 4; ++w) { const unsigned wd = (W)[w]; const f32x2 f = {__uint_as_float(wd << 16), __uint_as_float(wd & 0xffff0000u)}; \
              const f32x2 t = __builtin_elementwise_fma(f, inv2, magic2);                                     \
              const unsigned pk_ = __builtin_amdgcn_perm(__float_as_uint(t.y), __float_as_uint(t.x), 0x05040100u); \
              p_[w] = __builtin_bit_cast(unsigned, __builtin_elementwise_min(__builtin_elementwise_max(__builtin_bit_cast(s16x2, pk_), lo2), hi2)); } \
          HQ[Q] = ((p_[0] >> 4) & M) | (p_[1] & (M << 4)) | ((p_[2] << 4) & (M << 8)) | ((p_[3] << 8) & (M << 12)); \
          LQ[Q] = ((p_[0] & M) | ((p_[1] << 4) & (M << 4)) | ((p_[2] << 8) & (M << 8)) | ((p_[3] << 12) & (M << 12))) ^ 0x88888888u; } while (0)
          PA_H(0, m0.h0); PA_H(1, m0.h1); PA_H(2, m0.h2); PA_H(3, m0.h3);
#undef PA_H
        }
        PA_COMPUTE(R0, 0);
        const int itn = (it + nslot < nitems) ? it + nslot : it;
        PA_GATHER(R0, m1, itn, 0);
        PA_COMPUTE(R1, 8);
        PA_GATHER(R1, m1, itn, 8);
        float q8[8], q4[4], q2[2];
#pragma unroll
        for (int i = 0; i < 8; ++i) { const float send = b2 ? part[i] : part[i + 8], keep = b2 ? part[i + 8] : part[i]; q8[i] = keep + dpp_hmirror(send); }
#pragma unroll
        for (int i = 0; i < 4; ++i) { const float send = b1 ? q8[i] : q8[i + 4], keep = b1 ? q8[i + 4] : q8[i]; q4[i] = keep + dpp_xor2(send); }
#pragma unroll
        for (int i = 0; i < 2; ++i) { const float send = b0 ? q4[i] : q4[i + 2], keep = b0 ? q4[i + 2] : q4[i]; q2[i] = keep + dpp_xor1(send); }
        ((unsigned*)apart)[((size_t)PA_X(it) * T + PA_T(it)) * 64 + 8 * sub + grp] = pk2(q2[0], q2[1]);
        m0 = m1; m1 = m2;
    }
#undef PA_META
#undef PA_GATHER
#undef PA_COMPUTE
}
__device__ __forceinline__ void phase_peer_w(const Params& P, LDSP unsigned char* lds, int vcu, int G) {
    unsigned char* ws = P.ws;
    float* gates = (float*)(ws + OFF_GATES);
    const float* apart = (const float*)(ws + OFF_R1);
    const int* experts = (const int*)(ws + OFF_EXPERTS);
    const LDSP f32x2* suv = (const LDSP f32x2*)lds;
    {
        static_assert(PEER_NE / 2 == 16 * NTHREADS, "scale table staging: sixteen 16-byte pieces per thread");
        f32x4 tv[16];
#pragma unroll
        for (int i = 0; i < 16; ++i) tv[i] = *(const f32x4*)(ws + OFF_PSCALE + (size_t)16 * (threadIdx.x + NTHREADS * i));
#pragma unroll
        for (int i = 0; i < 16; ++i) *(LDSP f32x4*)(lds + 16 * (threadIdx.x + NTHREADS * i)) = tv[i];
    }
    __syncthreads();
    const size_t gt = (size_t)(vcu * NTHREADS + threadIdx.x), NGT = (size_t)G * NTHREADS;
    for (size_t i4 = gt; i4 < (size_t)T * 32; i4 += NGT) {
        const size_t i = i4 * 4; const int t = (int)(i >> 7), k = (int)(i & 127);
        f32x4 a = {0.f, 0.f, 0.f, 0.f};
        u32x4 araw[4];
#pragma unroll
        for (int xs = 0; xs < 4; ++xs) araw[xs] = *(const u32x4*)((const unsigned*)apart + ((size_t)xs * T + t) * 64 + 8 * (k >> 4) + (k & 7));
        const bool shi = (k >> 3) & 1;
#pragma unroll
        for (int xs = 0; xs < 4; ++xs) { a.x += shi ? bf_hi(araw[xs].x) : bf_lo(araw[xs].x); a.y += shi ? bf_hi(araw[xs].y) : bf_lo(araw[xs].y);
                                         a.z += shi ? bf_hi(araw[xs].z) : bf_lo(araw[xs].z); a.w += shi ? bf_hi(araw[xs].w) : bf_lo(araw[xs].w); }
        const u32x4 eg = *(const u32x4*)(experts + i);
        const u32x4 e4 = {eg.x & 0xFFFFu, eg.y & 0xFFFFu, eg.z & 0xFFFFu, eg.w & 0xFFFFu};
        const f32x4 g4 = {bf_hi(eg.x), bf_hi(eg.y), bf_hi(eg.z), bf_hi(eg.w)};
        const f32x2 s0 = suv[e4.x], s1 = suv[e4.y], s2 = suv[e4.z], s3 = suv[e4.w];
        f32x4 o;
        o.x = gelu_tanh(a.x * s0.x * (8.0f / 119.0f)) * g4.x * s0.y; o.y = gelu_tanh(a.y * s1.x * (8.0f / 119.0f)) * g4.y * s1.y;
        o.z = gelu_tanh(a.z * s2.x * (8.0f / 119.0f)) * g4.z * s2.y; o.w = gelu_tanh(a.w * s3.x * (8.0f / 119.0f)) * g4.w * s3.y;
        float* wtp = (float*)(ws + OFF_WT) + (size_t)t * 128 + (k & 7) * 16 + (k >> 3);
        wtp[0] = o.x; wtp[16] = o.y; wtp[32] = o.z; wtp[48] = o.w;
    }
}
__device__ __forceinline__ void phase_peer_b(const Params& P, LDSP unsigned char* lds, int vcu, int G) {
    unsigned char* ws = P.ws;
    const unsigned char* V4 = ws + OFF_V;
    const int* eT = (const int*)(ws + OFF_ET);
    const float* wT = (const float*)(ws + OFF_WT);
    const int tid = opaque_tid(), lane = tid & 63, wave = tid >> 6, grp = lane >> 3, sub = lane & 7;
    const bool b3 = lane & 8;
    int slice, half, wslot, nslot;
    peer_slice_map(P, lds, vcu, G, wave, slice, half, wslot, nslot);
    const int nitems = (slice >= 0) ? T / 2 : T * 4;
    if (wslot >= nitems) return;
#define PB_LOAD16(DST, SRC, it) do { const int it_ = ((it) < nitems) ? (it) : wslot; const u32x4* p_ = (const u32x4*)((SRC) + (size_t)PA_T(it_) * 128 + grp * 16); \
        _Pragma("unroll") for (int q = 0; q < 4; ++q) { const u32x4 v_ = p_[q]; (DST)[4 * q] = v_.x; (DST)[4 * q + 1] = v_.y; (DST)[4 * q + 2] = v_.z; (DST)[4 * q + 3] = v_.w; } } while (0)
#define PB_GATHER(R, E, it, J0) do { const int x_ = PA_X(it); _Pragma("unroll") for (int j = 0; j < 8; ++j) \
        (R)[j] = *(const u32x4*)(V4 + (((unsigned)x_ * (unsigned)PEER_NE + (E)[(J0) + j]) * 128u + 16u * (unsigned)sub)); } while (0)
#define PB_COMPUTE(R, W, J0) do { _Pragma("unroll") for (int j = 0; j < 8; ++j) { f32x2 f[16]; asm volatile("" : "+v"((R)[j])); cvt32_fp4_pk((R)[j], f); const float wk = __uint_as_float((W)[(J0) + j]); const f32x2 wk2 = {wk, wk}; \
        _Pragma("unroll") for (int i = 0; i < 16; ++i) acc2[i] = __builtin_elementwise_fma(wk2, f[i], acc2[i]); \
        asm volatile("" : "+v"(acc2[0]), "+v"(acc2[1]), "+v"(acc2[2]), "+v"(acc2[3]), "+v"(acc2[4]), "+v"(acc2[5]), "+v"(acc2[6]), "+v"(acc2[7])); \
        asm volatile("" : "+v"(acc2[8]), "+v"(acc2[9]), "+v"(acc2[10]), "+v"(acc2[11]), "+v"(acc2[12]), "+v"(acc2[13]), "+v"(acc2[14]), "+v"(acc2[15])); } } while (0)
#define PB_ITEM(WC, WN, EN, EL, it) do { \
          \
        const int c32 = ((lane & 32) ? 16 : 0) + ((lane & 16) ? 8 : 0) + (b3 ? 4 : 0); \
        const size_t oidx = (size_t)PA_T(it) * DM + 256 * PA_X(it) + 32 * sub + c32; \
        const u32x2 xr = *(const u32x2*)((const bf16_t*)(P.ws + OFF_R0) + oidx);         \
        PB_LOAD16(WN, (const unsigned*)wT, (it) + nslot); PB_LOAD16(EL, (const unsigned*)eT, (it) + 2 * nslot); \
        f32x2 acc2[16]; \
        _Pragma("unroll") for (int i = 0; i < 16; ++i) acc2[i] = (f32x2){0.f, 0.f}; \
        PB_COMPUTE(R0, WC, 0); \
        const int itn = ((it) + nslot < nitems) ? (it) + nslot : (it); \
        PB_GATHER(R0, EN, itn, 0); \
        PB_COMPUTE(R1, WC, 8); \
        PB_GATHER(R1, EN, itn, 8); \
          \
        float acc[32]; \
        _Pragma("unroll") for (int i = 0; i < 16; ++i) { acc[2 * i] = acc2[i].x; acc[2 * i + 1] = acc2[i].y; } \
        float q16[16], q8[8], q4[4]; \
        _Pragma("unroll") for (int i = 0; i < 16; ++i) q16[i] = swap32_sum(acc[i], acc[i + 16]); \
        _Pragma("unroll") for (int i = 0; i < 8; ++i) q8[i] = swap16_sum(q16[i], q16[i + 8]); \
        _Pragma("unroll") for (int i = 0; i < 4; ++i) { const float send = b3 ? q8[i] : q8[i + 4], keep = b3 ? q8[i + 4] : q8[i]; q4[i] = keep + dpp_ror8(send); } \
        f32x4 o; \
        o.x = __uint_as_float(xr.x << 16) + q4[0]; o.y = __uint_as_float(xr.x & 0xffff0000u) + q4[1]; o.z = __uint_as_float(xr.y << 16) + q4[2]; o.w = __uint_as_float(xr.y & 0xffff0000u) + q4[3]; \
        __builtin_nontemporal_store(o, (f32x4*)(P.out + oidx)); } while (0)
    unsigned e0[16], e1[16], w0[16], w1[16];
    u32x4 R0[8], R1[8];
    PB_LOAD16(w0, (const unsigned*)wT, wslot); PB_LOAD16(e0, (const unsigned*)eT, wslot); PB_LOAD16(e1, (const unsigned*)eT, wslot + nslot);
    PB_GATHER(R0, e0, wslot, 0); PB_GATHER(R1, e0, wslot, 8);
#pragma unroll 1
    for (int it = wslot; it < nitems; it += 2 * nslot) {
        PB_ITEM(w0, w1, e1, e0, it);
        if (it + nslot >= nitems) break;
        PB_ITEM(w1, w0, e0, e1, it + nslot);
    }
#undef PB_LOAD16
#undef PB_ITEM
#undef PB_GATHER
#undef PB_COMPUTE
#undef PA_T
#undef PA_X
}

#ifndef SELFCHECK
#define SELFCHECK 0
#endif
#if SELFCHECK
constexpr size_t OFF_CHK = 512 * 1024;
__device__ __forceinline__ void wave_argmax(float& v, int& i) {
#pragma unroll
    for (int o = 1; o < 64; o <<= 1) {
        const float ov = __shfl_xor(v, o); const int oi = __shfl_xor(i, o);
        if (ov > v || (ov == v && oi < i)) { v = ov; i = oi; }
    }
}
struct NaiveAcc { float m, l; float o[64]; };
__device__ __forceinline__ float wave_max(float v) {
#pragma unroll
    for (int o = 1; o < 64; o <<= 1) v = fmaxf(v, __shfl_xor(v, o));
    return v;
}
__device__ __forceinline__ void nacc_reset(NaiveAcc& a) { a.m = -1.0e30f; a.l = 0.f;
#pragma unroll
    for (int d = 0; d < 64; ++d) a.o[d] = 0.f; }
__device__ __forceinline__ float dot64(LDSP const float* qs, const bf16_t* krow) {
    float s = 0.f;
#pragma unroll
    for (int c = 0; c < 8; ++c) { float f[8]; cvt8(*(const u32x4*)(krow + c * 8), f);
#pragma unroll
        for (int i = 0; i < 8; ++i) s += qs[c * 8 + i] * f[i]; }
    return s;
}
__device__ __forceinline__ void axpy64(NaiveAcc& a, float alpha, float p, const bf16_t* vrow) {
#pragma unroll
    for (int c = 0; c < 8; ++c) { float f[8]; cvt8(*(const u32x4*)(vrow + c * 8), f);
#pragma unroll
        for (int i = 0; i < 8; ++i) a.o[c * 8 + i] = a.o[c * 8 + i] * alpha + p * f[i]; }
}
__device__ __forceinline__ void naive_chunk(NaiveAcc& a, LDSP const float* qs, const bf16_t* krow, const bf16_t* vrow, bool valid) {
    float s = dot64(qs, krow);
    if (!valid) s = -INFINITY;
    const float mnew = fmaxf(a.m, wave_max(s));
    const float alpha = exp2f(a.m - mnew), p = valid ? exp2f(s - mnew) : 0.f;
    a.l = a.l * alpha + p; a.m = mnew;
    axpy64(a, alpha, p, vrow);
}
__device__ __forceinline__ float nacc_final(NaiveAcc& a, int lane) {
    const float l = wave_sum(a.l);
    const float inv = (l > 0.f) ? 1.0f / l : 0.f;
    const bool b5 = lane & 32, b4 = lane & 16, b3 = lane & 8, b2 = lane & 4, b1 = lane & 2, b0 = lane & 1;
    float q32[32], q16[16], q8[8], q4[4], q2[2];
#pragma unroll
    for (int i = 0; i < 32; ++i) { const float send = b5 ? a.o[i] : a.o[i + 32], keep = b5 ? a.o[i + 32] : a.o[i]; q32[i] = keep + __shfl_xor(send, 32); }
#pragma unroll
    for (int i = 0; i < 16; ++i) { const float send = b4 ? q32[i] : q32[i + 16], keep = b4 ? q32[i + 16] : q32[i]; q16[i] = keep + __shfl_xor(send, 16); }
#pragma unroll
    for (int i = 0; i < 8; ++i) { const float send = b3 ? q16[i] : q16[i + 8], keep = b3 ? q16[i + 8] : q16[i]; q8[i] = keep + __shfl_xor(send, 8); }
#pragma unroll
    for (int i = 0; i < 4; ++i) { const float send = b2 ? q8[i] : q8[i + 4], keep = b2 ? q8[i + 4] : q8[i]; q4[i] = keep + __shfl_xor(send, 4); }
#pragma unroll
    for (int i = 0; i < 2; ++i) { const float send = b1 ? q4[i] : q4[i + 2], keep = b1 ? q4[i + 2] : q4[i]; q2[i] = keep + __shfl_xor(send, 2); }
    const float send = b0 ? q2[0] : q2[1], keep = b0 ? q2[1] : q2[0];
    return (keep + __shfl_xor(send, 1)) * inv;
}
__device__ __forceinline__ float cmp_err(float ref, const bf16_t* got, int lane) {
    const float e = wave_max(fabsf(ref - bf2f(got[lane]))), mx = wave_max(fabsf(ref));
    return e / (mx + 1e-3f);
}
__device__ __forceinline__ void phase_selfcheck(const Params& P, LDSP unsigned char* lds, int vcu, int G) {
    unsigned char* ws = P.ws;
    const int tid = opaque_tid(), lane = tid & 63, wave = tid >> 6;
    const int gw = vcu * NWAVES + wave, NGW = G * NWAVES;
    unsigned* cnt = (unsigned*)(ws + OFF_CHK);
    const bf16_t* qa = (const bf16_t*)(ws + OFF_R1);
    const bf16_t* ka = (const bf16_t*)(ws + OFF_R1 + 32 * MiB);
    const bf16_t* va = (const bf16_t*)(ws + OFF_R1 + 64 * MiB);
    const bf16_t* qb = (const bf16_t*)(ws + OFF_R1 + 96 * MiB);
    const bf16_t* ya = (const bf16_t*)(ws + OFF_YA);
    const bf16_t* yb = (const bf16_t*)(ws + OFF_YB);
    const float* kmean = (const float*)(ws + OFF_KMEAN);
    const float* bgate = (const float*)(ws + OFF_BGATE);
    LDSP float* psum = (LDSP float*)(lds + wave * 4096);
    LDSP float* qs = psum + 320;
    LDSP float* ocs = psum + 384;
    constexpr int NS = 537;
#pragma unroll 1
    for (int item = gw; item < NS * 8; item += NGW) {
        const int t = 37 + 61 * (item >> 3), h = item & 7, b = t >> 12, pos = t & (SEQ - 1), own = pos >> 8;
        qs[lane] = bf2f(qa[(size_t)t * 512 + h * 64 + lane]);
        asm volatile("s_waitcnt lgkmcnt(0)" ::: "memory");
        float g0 = -INFINITY, g1 = -INFINITY, g2 = -INFINITY; int i0 = -1, i1 = -1, i2 = -1;
#pragma unroll 1
        for (int j = 0; j < own; ++j) {
            const float* km = kmean + (size_t)((b * 8 + h) * 16 + j) * 64;
            float d = 0.f;
#pragma unroll 8
            for (int i = 0; i < 64; ++i) d += qs[i] * km[i];
            if (d > g0) { g2 = g1; i2 = i1; g1 = g0; i1 = i0; g0 = d; i0 = j; }
            else if (d > g1) { g2 = g1; i2 = i1; g1 = d; i1 = j; }
            else if (d > g2) { g2 = d; i2 = j; }
        }
        NaiveAcc a; nacc_reset(a);
#pragma unroll 1
        for (int j = 0; j <= own; ++j) {
            if (j < own && j != i0 && j != i1 && j != i2) continue;
#pragma unroll 1
            for (int ck = 0; ck < 4; ++ck) {
                const int kp = j * 256 + ck * 64 + lane;
                const size_t kr = (size_t)(b * SEQ + kp) * 512 + h * 64;
                naive_chunk(a, qs, ka + kr, va + kr, kp <= pos);
            }
        }
        const float om = nacc_final(a, lane);
        const float e = cmp_err(om, ya + (size_t)t * 512 + h * 64, lane);
        if (lane == 0 && !(e < 0.05f)) atomicAdd(cnt + 0, 1u);
        asm volatile("s_waitcnt lgkmcnt(0)" ::: "memory");
    }
#pragma unroll 1
    for (int item = gw; item < NS * 2; item += NGW) {
        const int t = 37 + 61 * (item >> 1), g = item & 1, b = t >> 12, pos = t & (SEQ - 1), own = pos >> 6;
        const bf16_t* kc = (const bf16_t*)(ws + OFF_KC) + (size_t)(b * 2 + g) * 256 * 64;
        const bf16_t* vc = (const bf16_t*)(ws + OFF_VC) + (size_t)(b * 2 + g) * 256 * 64;
        const bf16_t* ks = (const bf16_t*)(ws + OFF_R2 + 16 * MiB) + (size_t)(b * SEQ) * 128 + g * 64;
        const bf16_t* vs = (const bf16_t*)(ws + OFF_R2 + 24 * MiB) + (size_t)(b * SEQ) * 128 + g * 64;
        const bf16_t* kw = (const bf16_t*)(ws + OFF_R2 + 32 * MiB) + (size_t)(b * SEQ) * 128 + g * 64;
        const bf16_t* vw = (const bf16_t*)(ws + OFF_R2 + 40 * MiB) + (size_t)(b * SEQ) * 128 + g * 64;
        for (int i = lane; i < 320; i += 64) psum[i] = 0.f;
        asm volatile("s_waitcnt lgkmcnt(0)" ::: "memory");
        const int ncmp_vis = (pos >= 31) ? ((pos - 31) >> 4) + 1 : 0;
#pragma unroll 1
        for (int r = 0; r < 4; ++r) {
            qs[lane] = bf2f(qb[(size_t)t * 512 + (g * 4 + r) * 64 + lane]);
            asm volatile("s_waitcnt lgkmcnt(0)" ::: "memory");
            float mx = -INFINITY;
#pragma unroll 1
            for (int ck = 0; ck < 4; ++ck) { const int n = ck * 64 + lane;
                const float sdot = dot64(qs, kc + (size_t)n * 64);
                mx = fmaxf(mx, (n < ncmp_vis) ? sdot : -INFINITY); }
            mx = wave_max(mx);
            float l = 0.f;
#pragma unroll 1
            for (int ck = 0; ck < 4; ++ck) { const int n = ck * 64 + lane;
                const float sdot = dot64(qs, kc + (size_t)n * 64);
                l += (n < ncmp_vis) ? exp2f(sdot - mx) : 0.f; }
            l = wave_sum(l);
            const float inv = (l > 0.f) ? 1.0f / l : 0.f;
            NaiveAcc a; nacc_reset(a);
#pragma unroll 1
            for (int ck = 0; ck < 4; ++ck) { const int n = ck * 64 + lane;
                const float sdot = dot64(qs, kc + (size_t)n * 64);
                const float pr = (n < ncmp_vis) ? exp2f(sdot - mx) * inv : 0.f;
                psum[n] += pr;
                axpy64(a, 1.0f, pr, vc + (size_t)n * 64); }
            a.l = (lane == 0) ? 1.f : 0.f;
            ocs[r * 64 + lane] = nacc_final(a, lane);
            asm volatile("s_waitcnt lgkmcnt(0)" ::: "memory");
        }
        {
            const int j = lane;
            float imp = 0.f;
            for (int n = 4 * j - 1; n <= 4 * j + 3; ++n) if (n >= 0 && n < 255) imp += psum[n];
            if (j == 0 || j == own || j == own - 1) imp = 1.0e30f;
            if (j > own) imp = -1.0e30f;
            unsigned long long sel = 0ull;
#pragma unroll 1
            for (int r = 0; r < 16; ++r) {
                float v = imp; int i = j;
                wave_argmax(v, i);
                if (v > -0.5e30f) sel |= 1ull << i;
                if (i == j) imp = -3.0e38f;
            }
            psum[256] = __uint_as_float((unsigned)sel); psum[257] = __uint_as_float((unsigned)(sel >> 32));
            asm volatile("s_waitcnt lgkmcnt(0)" ::: "memory");
        }
        const unsigned long long sel = ((unsigned long long)__float_as_uint(psum[257]) << 32) | __float_as_uint(psum[256]);
#pragma unroll 1
        for (int r = 0; r < 4; ++r) {
            const int head = g * 4 + r;
            qs[lane] = bf2f(qb[(size_t)t * 512 + head * 64 + lane]);
            asm volatile("s_waitcnt lgkmcnt(0)" ::: "memory");
            const float gt0 = bgate[(size_t)t * 24 + head * 3], gt1 = bgate[(size_t)t * 24 + head * 3 + 1], gt2 = bgate[(size_t)t * 24 + head * 3 + 2];
            float y = gt0 * ocs[r * 64 + lane];
            NaiveAcc a; nacc_reset(a);
#pragma unroll 1
            for (int j = 0; j <= own; ++j) {
                if (!((sel >> j) & 1ull)) continue;
                const int kp = j * 64 + lane;
                naive_chunk(a, qs, ks + (size_t)kp * 128, vs + (size_t)kp * 128, kp <= pos);
            }
            y += gt1 * nacc_final(a, lane);
            nacc_reset(a);
#pragma unroll 1
            for (int ck = 0; ck < 9; ++ck) {
                const int kp = pos - 575 + ck * 64 + lane;
                const bool valid = kp >= 0 && kp <= pos && kp > pos - 512;
                const int kpc = kp < 0 ? 0 : kp;
                naive_chunk(a, qs, kw + (size_t)kpc * 128, vw + (size_t)kpc * 128, valid);
            }
            y += gt2 * nacc_final(a, lane);
            const float e = cmp_err(y, yb + (size_t)t * 512 + head * 64, lane);
            if (lane == 0 && !(e < 0.05f)) atomicAdd(cnt + 1, 1u);
            asm volatile("s_waitcnt lgkmcnt(0)" ::: "memory");
        }
    }
}

__device__ __forceinline__ void phase_selfcheck2(const Params& P, LDSP unsigned char* lds, int vcu, int G) {
    unsigned char* ws = P.ws;
    const int tid = opaque_tid(), lane = tid & 63, wave = tid >> 6;
    const int gw = vcu * NWAVES + wave, NGW = G * NWAVES;
    unsigned* cnt = (unsigned*)(ws + OFF_CHK);
    LDSP float* hs = (LDSP float*)(lds + wave * 8192);
    const float* x = P.in[I_X]; const float* g1 = P.in[I_NORM1]; const float* w = P.in[I_WIN];
    constexpr int NS = 192, NGRP = 14;
#pragma unroll 1
    for (int item = gw; item < NS * NGRP; item += NGW) {
        const int si = item / NGRP, grp = item % NGRP;
        const int t = 11 + 167 * si, b = t >> 12, pos = t & (SEQ - 1);
        const int hsel = si & 7, gsel = si & 1;
        float ss = 0.f;
        for (int i = lane; i < DM; i += 64) { const float v = x[(size_t)t * DM + i]; ss += v * v; }
        ss = wave_sum(ss);
        const float rs = 1.0f / sqrtf(ss / DM + NORM_EPS);
        for (int i = lane; i < DM; i += 64) hs[i] = x[(size_t)t * DM + i] * rs * g1[i];
        asm volatile("s_waitcnt lgkmcnt(0)" ::: "memory");
        int col0, kind; const float* gain = nullptr; float oscale = 1.f; const bf16_t* got = nullptr; int ncols = 64;
        const bf16_t* R1 = (const bf16_t*)(ws + OFF_R1); const bf16_t* R2 = (const bf16_t*)(ws + OFF_R2); const bf16_t* R3 = (const bf16_t*)(ws + OFF_R3);
        const size_t M32 = (size_t)16 * 1024 * 1024;
        switch (grp) {
        case 0: col0 = hsel * 64;          kind = 1; gain = P.in[I_AQG]; oscale = QSCALE; got = R1 + (size_t)t * 512 + hsel * 64; break;
        case 1: col0 = 512 + hsel * 64;    kind = 1; gain = P.in[I_AKG]; got = R1 + M32 + (size_t)t * 512 + hsel * 64; break;
        case 2: col0 = 1024 + hsel * 64;   kind = 0; got = R1 + 2 * M32 + (size_t)t * 512 + hsel * 64; break;
        case 3: col0 = 1536 + hsel * 64;   kind = 1; gain = P.in[I_BQG]; oscale = QSCALE; got = R1 + 3 * M32 + (size_t)t * 512 + hsel * 64; break;
        case 4: col0 = 2048 + gsel * 64;   kind = 0; got = R2 + ((size_t)((b * 2 + gsel) * SEQ + pos)) * 64; break;
        case 5: col0 = 2176 + gsel * 64;   kind = 0; got = R2 + M32 / 4 + ((size_t)((b * 2 + gsel) * SEQ + pos)) * 64; break;
        case 6: col0 = 2304 + gsel * 64;   kind = 1; gain = P.in[I_BKSG]; got = R2 + 2 * (M32 / 4) + (size_t)t * 128 + gsel * 64; break;
        case 7: col0 = 2432 + gsel * 64;   kind = 0; got = R2 + 3 * (M32 / 4) + (size_t)t * 128 + gsel * 64; break;
        case 8: col0 = 2560 + gsel * 64;   kind = 1; gain = P.in[I_BKWG]; got = R2 + 4 * (M32 / 4) + (size_t)t * 128 + gsel * 64; break;
        case 9: col0 = 2688 + gsel * 64;   kind = 0; got = R2 + 5 * (M32 / 4) + (size_t)t * 128 + gsel * 64; break;
        case 10: col0 = 2840 + hsel * 64;        kind = 2; got = R3 + (size_t)t * 2048 + hsel * 64; break;
        case 11: col0 = 2840 + 1024 + hsel * 64; kind = 2; got = R3 + (size_t)t * 2048 + 1024 + hsel * 64; break;
        case 12: col0 = 2840 + 1024 + 512 + hsel * 64; kind = 2; got = R3 + (size_t)t * 2048 + 1536 + hsel * 64; break;
        default: col0 = 2816; kind = 3; ncols = 24; break;
        }
        float acc = 0.f;
        if (lane < ncols) {
#pragma unroll 4
            for (int k = 0; k < DM; ++k) acc += hs[k] * w[(size_t)k * 4888 + col0 + lane];
        }
        float ref;
        if (kind == 1) {
            const float ssq = wave_sum(acc * acc);
            float y = acc / sqrtf(ssq / 64.0f + NORM_EPS) * gain[lane];
            const float ya_ = __shfl(y, (lane + 8) & 63), yb_ = __shfl(y, (lane - 8) & 63);
            const int f = lane & 7;
            const float ang = (float)pos * powf(500000.0f, -(float)(2 * f) / 16.0f);
            const float c = cosf(ang), sn = sinf(ang);
            if (lane < 8) y = y * c - ya_ * sn; else if (lane < 16) y = y * c + yb_ * sn;
            ref = y * oscale;
        } else if (kind == 2) {
            ref = 1.0f / (1.0f + expf(-(acc + P.in[I_BMERGE][col0 - 2840 + lane])));
        } else if (kind == 3) {
            ref = 1.0f / (1.0f + expf(-acc));
        } else ref = acc;
        float gotv;
        if (kind == 3) gotv = (lane < 24) ? ((const float*)(ws + OFF_BGATE))[(size_t)t * 24 + lane] : 0.f;
        else if (kind == 2) gotv = (float)(ws + OFF_R3)[(size_t)t * 2048 + (col0 - 2840) + lane] * (1.0f / 255.0f);
        else gotv = bf2f(got[lane]);
        if (kind == 3 && lane >= 24) ref = 0.f;
        const float e = wave_max(fabsf(ref - gotv)) / (wave_max(fabsf(ref)) + 1e-3f);
        if (lane == 0 && !(e < 0.03f)) atomicAdd(cnt + 0, 1u);
        asm volatile("s_waitcnt lgkmcnt(0)" ::: "memory");
    }
#pragma unroll 1
    for (int item = gw; item < 1024; item += NGW) {
        const int b = item >> 7, h = (item >> 4) & 7, blk = item & 15;
        const bf16_t* p = (const bf16_t*)(ws + OFF_R1 + 32 * MiB) + (size_t)(b * SEQ + blk * 256) * 512 + h * 64 + lane;
        float sref = 0.f;
        for (int k = 0; k < 256; ++k) sref += bf2f(p[(size_t)k * 512]);
        const float gotv = ((const float*)(ws + OFF_KMEAN))[(size_t)item * 64 + lane];
        const float e = wave_max(fabsf(sref - gotv)) / (wave_max(fabsf(sref)) + 1e-2f);
        if (lane == 0 && !(e < 0.03f)) atomicAdd(cnt + 1, 1u);
    }
#pragma unroll 1
    for (int item = gw; item < 96 * 2; item += NGW) {
        const int si = item >> 1, kv = item & 1;
        const int slab = si & 15, n = (si * 37 + 3) % 255;
        const bf16_t* raw = (const bf16_t*)(ws + OFF_R2 + (size_t)kv * 8 * MiB) + (size_t)slab * SEQ * 64 + (size_t)n * 16 * 64;
        const float* posv = P.in[kv ? I_CPV : I_CPK]; const float* w1 = P.in[kv ? I_CVW1 : I_CKW1]; const float* b1 = P.in[kv ? I_CVB1 : I_CKB1];
        const float* w2 = P.in[kv ? I_CVW2 : I_CKW2]; const float* b2 = P.in[kv ? I_CVB2 : I_CKB2];
        float hacc[4] = {0.f, 0.f, 0.f, 0.f};
#pragma unroll 1
        for (int i = 0; i < 2048; ++i) {
            const float a = bf2f(raw[i]) + posv[i];
#pragma unroll
            for (int u = 0; u < 4; ++u) hacc[u] += a * w1[(size_t)i * 256 + lane + 64 * u];
        }
#pragma unroll
        for (int u = 0; u < 4; ++u) { const float z = hacc[u] + b1[lane + 64 * u]; hs[1024 + lane + 64 * u] = 0.5f * z * (1.0f + tanhf(0.7978845608028654f * (z + 0.044715f * z * z * z))); }
        asm volatile("s_waitcnt lgkmcnt(0)" ::: "memory");
        float o = b2[lane];
#pragma unroll 4
        for (int j = 0; j < 256; ++j) o += hs[1024 + j] * w2[(size_t)j * 64 + lane];
        if (!kv) { const float ssq = wave_sum(o * o); o = o / sqrtf(ssq / 64.0f + NORM_EPS) * P.in[I_BKCG][lane]; }
        const float gotv = bf2f(((const bf16_t*)(ws + (kv ? OFF_VC : OFF_KC)))[((size_t)slab * 256 + n) * 64 + lane]);
        const float e = wave_max(fabsf(o - gotv)) / (wave_max(fabsf(o)) + 1e-3f);
        if (lane == 0 && !(e < 0.03f)) atomicAdd(cnt + 1, 1u);
        asm volatile("s_waitcnt lgkmcnt(0)" ::: "memory");
    }
}
#endif

#define XB_TMO      128
#define XB_XCNT(j)  (256  + 64 * (j))
#define XB_XSUB(j)  (1280 + 64 * (j))
#define XB_XGEN(j)  (2304 + 64 * (j))
#define XB_TOP      3328
#define XB_TOPGEN   3392
#define XCD_BAR_WORDS 3456
#define XB_SPIN_CAP (1u << 22)
__device__ __forceinline__ unsigned xb_ld(unsigned* p)              { return __hip_atomic_load(p, __ATOMIC_RELAXED, __HIP_MEMORY_SCOPE_AGENT); }
__device__ __forceinline__ unsigned xb_add(unsigned* p, unsigned v) { return __hip_atomic_fetch_add(p, v, __ATOMIC_RELAXED, __HIP_MEMORY_SCOPE_AGENT); }
__device__ __forceinline__ unsigned xb_xcc_id() { return (unsigned)__builtin_amdgcn_s_getreg((3 << 11) | 20) & 0xFu; }
#define XB_SPIN(cond, bar) do { unsigned _sp = 0; while (cond) { __builtin_amdgcn_s_sleep(1); \
    if ((++_sp & 255u) == 0u) { if (xb_ld(&(bar)[XB_TMO])) break; if (_sp > XB_SPIN_CAP) { atomicAdd(&(bar)[XB_TMO], 1u); break; } } } } while (0)
struct XcdBarrier { unsigned* bar; unsigned x; volatile LDSP unsigned* st; };
__device__ __forceinline__ XcdBarrier xcd_barrier_post(unsigned* bar, volatile LDSP unsigned* st) {
    XcdBarrier b; b.bar = bar; b.x = xb_xcc_id(); b.st = st;
    if (threadIdx.x == 0) (void)xb_add(&bar[XB_XCNT(b.x)], 1u);
    return b;
}
__device__ __forceinline__ void xcd_barrier_complete(unsigned* bar, unsigned x, unsigned& nloc, unsigned& nx) {
    const unsigned G = gridDim.x * gridDim.y * gridDim.z;
    unsigned sum, cnt, mine, sp = 0u;
    for (;;) {
        sum = 0u; cnt = 0u; mine = 0u;
#pragma unroll
        for (unsigned j = 0; j < 16; ++j) { const unsigned c = xb_ld(&bar[XB_XCNT(j)]); sum += c; cnt += (c > 0u) ? 1u : 0u; mine = (j == x) ? c : mine; }
        if (sum == G) break;
        __builtin_amdgcn_s_sleep(1);
        if ((++sp & 255u) == 0u) { if (xb_ld(&bar[XB_TMO])) break; if (sp > XB_SPIN_CAP) { atomicAdd(&bar[XB_TMO], 1u); break; } }
    }
    nloc = mine > 0u ? mine : 1u; nx = cnt > 0u ? cnt : 1u;
}
template <bool TAIL = true>
__device__ __forceinline__ void xcd_barrier(const XcdBarrier& b) {
    asm volatile("s_waitcnt vmcnt(0)" ::: "memory");
    __syncthreads();
    if (threadIdx.x == 0) {
        unsigned* bar = b.bar;
        __builtin_amdgcn_s_waitcnt(0);
        unsigned nloc = b.st[0], nx = b.st[1];
        if (nloc == 0u) { xcd_barrier_complete(bar, b.x, nloc, nx); b.st[0] = nloc; b.st[1] = nx; }
        const unsigned old = xb_add(&bar[XB_XSUB(b.x)], 1u);
        const unsigned gen = old / nloc;
        if (old + 1u == (gen + 1u) * nloc) {
            __builtin_amdgcn_fence(__ATOMIC_RELEASE, "agent");
            asm volatile("s_waitcnt vmcnt(0)" ::: "memory");
            const unsigned og = xb_add(&bar[XB_TOP], 1u);
            const unsigned tg = og / nx;
            if (og + 1u == (tg + 1u) * nx) xb_add(&bar[XB_TOPGEN], 1u);
            else XB_SPIN(xb_ld(&bar[XB_TOPGEN]) == tg, bar);
            __builtin_amdgcn_fence(__ATOMIC_ACQUIRE, "agent");
            xb_add(&bar[XB_XGEN(b.x)], 1u);
            asm volatile("s_waitcnt vmcnt(0)" ::: "memory");
        } else {
            XB_SPIN(xb_ld(&bar[XB_XGEN(b.x)]) == gen, bar);
            __builtin_amdgcn_fence(__ATOMIC_ACQUIRE, "agent");
            asm volatile("s_waitcnt vmcnt(0)" ::: "memory");
        }
    }
    if (TAIL) __syncthreads();
}

__global__ void __launch_bounds__(NTHREADS, 2) fwd_kernel(Params P) {
    extern __shared__ __attribute__((aligned(16))) unsigned char lds_raw[];
    LDSP unsigned char* lds = (LDSP unsigned char*)lds_raw;
    const int G = gridDim.x, bx = blockIdx.x;
    const int vcu = (G % 8 == 0) ? (bx % 8) * (G / 8) + bx / 8 : bx;
    const int lo = P.ph_lo, hi = P.ph_hi;
    volatile LDSP unsigned* bst = (volatile LDSP unsigned*)(lds + LDS_BYTES - 16);
    if (threadIdx.x == 0) { bst[0] = 0u; bst[1] = 0u; bst[2] = 0u; bst[3] = 0u; }
    __syncthreads();
    const XcdBarrier xbar = xcd_barrier_post((unsigned*)(P.ws + 16384), bst);
    if (threadIdx.x == 0) bst[2] = xb_add((unsigned*)(P.ws + 32768) + 64 * xbar.x, 1u);
#define IN(k) (lo <= (k) && (k) < hi)
#define SEAM(k) do { if (IN(k) && IN((k) + 1)) xcd_barrier(xbar); } while (0)
    if (IN(0)) phase_prep(P, lds, vcu, G);
    SEAM(0);
    if (IN(1)) phase_proj(P, lds, vcu, G);
    SEAM(1);
    if (IN(2)) phase_cmp(P, lds, vcu, G);
    SEAM(2);
    if (IN(4)) phase_attn(P, lds, vcu, G);
    SEAM(4);
#if SELFCHECK == 1
    phase_selfcheck(P, lds, vcu, G);
    xcd_barrier(xbar);
#elif SELFCHECK == 2
    phase_selfcheck2(P, lds, vcu, G);
    xcd_barrier(xbar);
#endif
    if (IN(5)) phase_up(P, lds, vcu, G);
    SEAM(5);
    if (IN(6)) phase_out(P, lds, vcu, G);
    SEAM(6);
    if (IN(7)) phase_pq(P, lds, vcu, G);
    if (IN(7) && IN(8)) xcd_barrier<false>(xbar); else __syncthreads();
    if (IN(8)) phase_topk(P, lds, vcu, G);
    SEAM(8);
    if (IN(9)) { phase_peer_a(P, lds, vcu, G); xcd_barrier<false>(xbar); phase_peer_w(P, lds, vcu, G); xcd_barrier(xbar); phase_peer_b(P, lds, vcu, G); }
#if SELFCHECK
    xcd_barrier(xbar);
    if (bx == 0 && threadIdx.x == 0) {
        const unsigned* cnt = (const unsigned*)(P.ws + OFF_CHK);
        P.out[0] += 1000.0f * (float)cnt[0];
        P.out[1] += 1000000.0f * (float)cnt[1];
    }
#endif
#undef IN
#undef SEAM
}

extern "C" void kernel_launch(void* const* d_in, const int* in_sizes, int n_in, void* d_out, int out_size, void* d_ws, size_t ws_size, hipStream_t stream) {
    static int grid = 0;
    if (grid == 0) {
        if (n_in != 29 || ws_size < WS_END) { fprintf(stderr, "kernel_launch: unexpected n_in %d / ws_size %zu\n", n_in, ws_size); grid = -1; return; }
        int dev = 0, cus = 0, per_cu = 0;
        (void)hipGetDevice(&dev);
        (void)hipDeviceGetAttribute(&cus, hipDeviceAttributeMultiprocessorCount, dev);
        (void)hipFuncSetAttribute((const void*)fwd_kernel, hipFuncAttributeMaxDynamicSharedMemorySize, LDS_BYTES);
        (void)hipOccupancyMaxActiveBlocksPerMultiprocessor(&per_cu, (const void*)fwd_kernel, NTHREADS, LDS_BYTES);
        if (per_cu < 1) { fprintf(stderr, "kernel_launch: occupancy query says %d blocks per CU\n", per_cu); grid = -1; return; }
        grid = cus;
    }
    if (grid < 0) return;
    Params p{};
    for (int i = 0; i < 29; ++i) p.in[i] = (const float*)d_in[i];
    p.out = (float*)d_out; p.ws = (unsigned char*)d_ws;
    (void)hipMemsetAsync(d_ws, 0, 65536, stream);
    p.ph_lo = 0; p.ph_hi = 10;
    hipLaunchKernelGGL(fwd_kernel, dim3(grid), dim3(NTHREADS), LDS_BYTES, stream, p);
}
```
